# Optimizing an MI355X kernel written in HIP

```python
import math
import jax, jax.numpy as jnp
from jax import lax
import numpy as np

D_MODEL = 2048
BATCH = 32
SEQ = 256
DEPTH = 2
DEC_BATCH = 2
DEC_SEQ = 1024
PAST_LEN = 256

GRID_W = 64
Q_BLOCK = 128
ROPE_THETA = 10000.0
EPS = 1e-6
N_EVEN = (DEPTH + 1) // 2
N_ODD = DEPTH // 2
H_A = 8
DK_A = 64
DV_A = 2 * DK_A
W_A = H_A * DV_A
POOL_WINDOWS = (2, 4, 8, 16)
N_POOL = len(POOL_WINDOWS)
W_B = D_MODEL - W_A
GW_B = W_B // N_POOL
EVEN_IN = 3 * W_A + W_B + (W_A + W_B)
HD_C = 128
H_C = D_MODEL // HD_C
KVH_C = 4
G_C = H_C // KVH_C
W_C = H_C * HD_C
ODD_IN = W_C + 2 * KVH_C * HD_C + W_C

kernel_name = "hybrid_diffattn_pool_gqa_prefix_dit_step"


def rmsnorm(x, w):
    xf = x.astype(jnp.float32)
    y = xf * lax.rsqrt(jnp.mean(xf * xf, axis=-1, keepdims=True) + EPS) * w.astype(jnp.float32)
    return y.astype(x.dtype)


def axial_rope_tables(n_tokens, dim):
    rows = n_tokens // GRID_W
    row = jnp.repeat(jnp.arange(rows), GRID_W).astype(jnp.float32)
    col = jnp.tile(jnp.arange(GRID_W), rows).astype(jnp.float32)
    quarter = dim // 4
    freqs = ROPE_THETA ** (-jnp.arange(quarter, dtype=jnp.float32) / quarter)
    ar = row[:, None] * freqs
    ac = col[:, None] * freqs
    cos = jnp.concatenate([jnp.cos(ar), jnp.cos(ar), jnp.cos(ac), jnp.cos(ac)], axis=-1)
    sin = jnp.concatenate([jnp.sin(ar), jnp.sin(ar), jnp.sin(ac), jnp.sin(ac)], axis=-1)
    return cos, sin


def apply_rope(x, cos, sin):
    xf = x.astype(jnp.float32)
    x0, x1, x2, x3 = jnp.split(xf, 4, axis=-1)
    rot = jnp.concatenate([-x1, x0, -x3, x2], axis=-1)
    shape = (cos.shape[0],) + (1,) * (x.ndim - 3) + (cos.shape[-1],)
    return (xf * cos.reshape(shape) + rot * sin.reshape(shape)).astype(x.dtype)


def sweep_query_blocks(fn, q):
    lead, L, d = q.shape[:-2], q.shape[-2], q.shape[-1]
    nb = L // Q_BLOCK
    qb = jnp.moveaxis(q.reshape(*lead, nb, Q_BLOCK, d), -3, 0)
    ob = lax.map(fn, qb)
    ob = jnp.moveaxis(ob, 0, -3)
    return ob.reshape(*ob.shape[:-3], L, ob.shape[-1])


def modulate(x, cond, norm_w, ada_w, ada_b):
    m = jax.nn.silu(cond) @ ada_w + ada_b
    shift, scale, gate = jnp.split(m, 3, axis=-1)
    h = rmsnorm(x, norm_w) * (1 + scale[:, None]) + shift[:, None]
    return h, gate[:, None]


def diff_attention(q, k, v, lam, lam_init, subln_w):
    k1, k2 = k[..., :DK_A], k[..., DK_A:]
    vf = v.astype(jnp.float32)
    scale = DK_A ** -0.5

    def block(qb):
        s1 = jnp.einsum('bhqd,bhkd->bhqk', qb[:, :, 0], k1).astype(jnp.float32) * scale
        s2 = jnp.einsum('bhqd,bhkd->bhqk', qb[:, :, 1], k2).astype(jnp.float32) * scale
        p = jax.nn.softmax(s1, axis=-1) - lam * jax.nn.softmax(s2, axis=-1)
        return jnp.einsum('bhqk,bhkd->bhqd', p, vf)

    o = sweep_query_blocks(block, q)
    o = rmsnorm(o, subln_w) * (1.0 - lam_init)
    return o.astype(v.dtype)


def multiscale_pool(u, pool_w, pool_scale):
    B, L, _ = u.shape
    ug = u.reshape(B, L, N_POOL, GW_B).astype(jnp.float32)
    S = jnp.concatenate([jnp.zeros((B, 1, N_POOL, GW_B), jnp.float32),
                         jnp.cumsum(ug, axis=1)], axis=1)
    t = np.arange(L)[:, None]
    half = np.array(POOL_WINDOWS)[None, :] // 2
    lo = np.clip(t - half, 0, L)
    hi = np.clip(t + half, 0, L)
    gidx = np.arange(N_POOL)[None, :]
    cnt = jnp.asarray((hi - lo).astype(np.float32))[None, :, :, None]
    mean = (S[:, hi, gidx] - S[:, lo, gidx]) / cnt
    out = jnp.einsum('blgc,gcd->blgd', mean - ug, pool_w.astype(jnp.float32))
    return (out.reshape(B, L, W_B) * pool_scale).astype(u.dtype)


def even_mixer(h, p, lam, lam_init, rope, ctx_k, ctx_v):
    B, L, _ = h.shape
    proj = h @ p['w_in']
    q, k, v, u, g = jnp.split(proj, [W_A, 2 * W_A, 3 * W_A, 3 * W_A + W_B], axis=-1)
    q = rmsnorm(q.reshape(B, L, H_A, 2, DK_A), p['q_norm_w'])
    k = rmsnorm(k.reshape(B, L, H_A, 2, DK_A), p['k_norm_w'])
    if rope is not None:
        q = apply_rope(q, *rope)
        k = apply_rope(k, *rope)
    q = q.transpose(0, 2, 3, 1, 4)
    k_own = k.transpose(0, 2, 1, 3, 4).reshape(B, H_A, L, 2 * DK_A)
    v_own = v.reshape(B, L, H_A, DV_A).transpose(0, 2, 1, 3)
    if ctx_k is None:
        k_all, v_all = k_own, v_own
    else:
        k_all = jnp.concatenate([ctx_k.astype(k_own.dtype), k_own], axis=2)
        v_all = jnp.concatenate([ctx_v.astype(v_own.dtype), v_own], axis=2)
    attn = diff_attention(q, k_all, v_all, lam, lam_init, p['subln_w'])
    attn = attn.transpose(0, 2, 1, 3).reshape(B, L, W_A)
    pool = multiscale_pool(u, p['pool_w'], p['pool_scale'])
    y = jnp.concatenate([attn, pool], axis=-1) * jax.nn.silu(g)
    return y @ p['w_out'], k_own, v_own


def gqa_attention(q, k, v):
    vf = v.astype(jnp.float32)
    scale = HD_C ** -0.5

    def block(qb):
        s = jnp.einsum('bgrqd,bgkd->bgrqk', qb, k).astype(jnp.float32) * scale
        return jnp.einsum('bgrqk,bgkd->bgrqd', jax.nn.softmax(s, axis=-1), vf)

    return sweep_query_blocks(block, q).astype(v.dtype)


def odd_mixer(h, p, rope, ctx_k, ctx_v):
    B, L, _ = h.shape
    proj = h @ p['w_in']
    q, k, v, g = jnp.split(proj, [W_C, W_C + KVH_C * HD_C, W_C + 2 * KVH_C * HD_C], axis=-1)
    q = rmsnorm(q.reshape(B, L, H_C, HD_C), p['q_norm_w'])
    k = rmsnorm(k.reshape(B, L, KVH_C, HD_C), p['k_norm_w'])
    if rope is not None:
        q = apply_rope(q, *rope)
        k = apply_rope(k, *rope)
    q = q.reshape(B, L, KVH_C, G_C, HD_C).transpose(0, 2, 3, 1, 4)
    k_own = k.transpose(0, 2, 1, 3)
    v_own = v.reshape(B, L, KVH_C, HD_C).transpose(0, 2, 1, 3)
    if ctx_k is None:
        k_all, v_all = k_own, v_own
    else:
        k_all = jnp.concatenate([ctx_k.astype(k_own.dtype), k_own], axis=2)
        v_all = jnp.concatenate([ctx_v.astype(v_own.dtype), v_own], axis=2)
    o = gqa_attention(q, k_all, v_all)
    o = o.transpose(0, 3, 1, 2, 4).reshape(B, L, W_C)
    return (o * jax.nn.silu(g)) @ p['w_out'], k_own, v_own


def setup_inputs(seed: int = 0) -> dict:
    key = jax.random.key(seed)
    ks = jax.random.split(key, 32)
    f32 = jnp.float32
    nrm = lambda k, shape, s=1.0: (jax.random.normal(k, shape, f32) * s).astype(f32)
    D = D_MODEL
    return {
        'x_prompt': nrm(ks[0], (BATCH, SEQ, D)),
        'x_sample': nrm(ks[1], (DEC_BATCH, DEC_SEQ, D)),
        'cache_a_k': nrm(ks[2], (DEC_BATCH, N_EVEN, H_A, PAST_LEN, 2 * DK_A)),
        'cache_a_v': nrm(ks[3], (DEC_BATCH, N_EVEN, H_A, PAST_LEN, DV_A)),
        'cache_c_k': nrm(ks[4], (DEC_BATCH, N_ODD, KVH_C, PAST_LEN, HD_C)),
        'cache_c_v': nrm(ks[5], (DEC_BATCH, N_ODD, KVH_C, PAST_LEN, HD_C)),
        'c': nrm(ks[6], (DEC_BATCH, D)),
        'c_ctx': nrm(ks[7], (D,)),
        'norm_w': 1.0 + nrm(ks[8], (DEPTH, D), 0.05),
        'ada_w': nrm(ks[9], (DEPTH, D, 3 * D), D ** -0.5),
        'ada_b': nrm(ks[10], (DEPTH, 3 * D), 0.02),
        'even_w_in': nrm(ks[11], (N_EVEN, D, EVEN_IN), D ** -0.5),
        'even_q_norm_w': 1.0 + nrm(ks[12], (N_EVEN, DK_A), 0.05),
        'even_k_norm_w': 1.0 + nrm(ks[13], (N_EVEN, DK_A), 0.05),
        'even_lam_q1': nrm(ks[14], (N_EVEN, DK_A), 0.1),
        'even_lam_k1': nrm(ks[15], (N_EVEN, DK_A), 0.1),
        'even_lam_q2': nrm(ks[16], (N_EVEN, DK_A), 0.1),
        'even_lam_k2': nrm(ks[17], (N_EVEN, DK_A), 0.1),
        'even_subln_w': 1.0 + nrm(ks[18], (N_EVEN, DV_A), 0.05),
        'even_pool_w': nrm(ks[19], (N_EVEN, N_POOL, GW_B, GW_B), GW_B ** -0.5),
        'even_pool_scale': 1.0 + nrm(ks[20], (N_EVEN, W_B), 0.1),
        'even_w_out': nrm(ks[21], (N_EVEN, W_A + W_B, D), (W_A + W_B) ** -0.5),
        'gqa_w_in': nrm(ks[22], (N_ODD, D, ODD_IN), D ** -0.5),
        'gqa_q_norm_w': 1.0 + nrm(ks[23], (N_ODD, HD_C), 0.05),
        'gqa_k_norm_w': 1.0 + nrm(ks[24], (N_ODD, HD_C), 0.05),
        'gqa_w_out': nrm(ks[25], (N_ODD, W_C, D), W_C ** -0.5),
    }


def reference(x_prompt, x_sample, cache_a_k, cache_a_v, cache_c_k, cache_c_v, c, c_ctx,
              norm_w, ada_w, ada_b,
              even_w_in, even_q_norm_w, even_k_norm_w, even_lam_q1, even_lam_k1,
              even_lam_q2, even_lam_k2, even_subln_w, even_pool_w, even_pool_scale,
              even_w_out, gqa_w_in, gqa_q_norm_w, gqa_k_norm_w, gqa_w_out):
    n_lat = x_sample.shape[1]
    rope_a = axial_rope_tables(n_lat, DK_A)
    rope_c = axial_rope_tables(n_lat, HD_C)
    cond_ctx = jnp.broadcast_to(c_ctx[None, :], (x_prompt.shape[0], D_MODEL))

    y_p, y_s = x_prompt, x_sample
    new_a_k, new_a_v, new_c_k, new_c_v = [], [], [], []
    for i in range(DEPTH):
        h_p, gate_p = modulate(y_p, cond_ctx, norm_w[i], ada_w[i], ada_b[i])
        h_s, gate_s = modulate(y_s, c, norm_w[i], ada_w[i], ada_b[i])
        if i % 2 == 0:
            j = i // 2
            p = {'w_in': even_w_in[j], 'q_norm_w': even_q_norm_w[j], 'k_norm_w': even_k_norm_w[j],
                 'subln_w': even_subln_w[j], 'pool_w': even_pool_w[j],
                 'pool_scale': even_pool_scale[j], 'w_out': even_w_out[j]}
            lam_init = 0.8 - 0.6 * math.exp(-0.3 * i)
            lam = (jnp.exp(jnp.sum(even_lam_q1[j].astype(jnp.float32) * even_lam_k1[j].astype(jnp.float32)))
                   - jnp.exp(jnp.sum(even_lam_q2[j].astype(jnp.float32) * even_lam_k2[j].astype(jnp.float32)))
                   + lam_init)
            out_p, k_new, v_new = even_mixer(h_p, p, lam, lam_init, None, None, None)
            out_s, _, _ = even_mixer(h_s, p, lam, lam_init, rope_a, cache_a_k[:, j], cache_a_v[:, j])
            new_a_k.append(k_new)
            new_a_v.append(v_new)
        else:
            j = i // 2
            p = {'w_in': gqa_w_in[j], 'q_norm_w': gqa_q_norm_w[j], 'k_norm_w': gqa_k_norm_w[j],
                 'w_out': gqa_w_out[j]}
            out_p, k_new, v_new = odd_mixer(h_p, p, None, None, None)
            out_s, _, _ = odd_mixer(h_s, p, rope_c, cache_c_k[:, j], cache_c_v[:, j])
            new_c_k.append(k_new)
            new_c_v.append(v_new)
        y_p = y_p + gate_p * out_p
        y_s = y_s + gate_s * out_s

    state_a_k = jnp.stack(new_a_k, axis=1)
    state_a_v = jnp.stack(new_a_v, axis=1)
    state_c_k = jnp.stack(new_c_k, axis=1)
    state_c_v = jnp.stack(new_c_v, axis=1)
    return (y_p, y_s, state_a_k, state_a_v, state_c_k, state_c_v)
```

```cpp
#include <hip/hip_runtime.h>
#include <cstdio>
#include <cstdint>

typedef unsigned short bf16_t;
typedef float f32x4 __attribute__((ext_vector_type(4)));
typedef unsigned u32x4 __attribute__((ext_vector_type(4)));
typedef unsigned u32x2 __attribute__((ext_vector_type(2)));

constexpr int DM = 2048, NBP = 32, SEQP = 256, NBS = 2, SEQS = 1024, PAST = 256;
constexpr int MP = NBP * SEQP, MS = NBS * SEQS, MT = MP + MS;
constexpr int HA = 8, DKA = 64, DVA = 128, WA = 1024, WB = 1024, GWB = 256;
constexpr int EVEN_IN = 6144, ODD_IN = 5120;
constexpr int HC = 16, KVH = 4, HDC = 128;
constexpr int LKS = PAST + SEQS;
constexpr float EPS = 1e-6f;
constexpr float LOG2E = 1.4426950408889634f;
constexpr float C2A = 0.125f * LOG2E;
constexpr float C2C = 0.08838834764831845f * LOG2E;

constexpr size_t MiB = 1u << 20;
constexpr size_t WS_CTL = 0;
constexpr size_t WS_MOD = 1 * MiB;
constexpr size_t WS_ROPE = 2 * MiB;
constexpr size_t WS_WINE = 4 * MiB;
constexpr size_t WS_WOUTE = 28 * MiB;
constexpr size_t WS_WINO = 36 * MiB;
constexpr size_t WS_WOUTO = 56 * MiB;
constexpr size_t WS_POOLW = 64 * MiB;
constexpr size_t WS_HY = 65 * MiB;
constexpr size_t WS_PR = 105 * MiB;
constexpr size_t WS_Q = 225 * MiB;
constexpr size_t WS_KP = 265 * MiB;
constexpr size_t WS_VP = 281 * MiB;
constexpr size_t WS_KSA = 297 * MiB;
constexpr size_t WS_VSA = 302 * MiB;
constexpr size_t WS_KSC = 307 * MiB;
constexpr size_t WS_VSC = 310 * MiB;
constexpr size_t WS_UA = 313 * MiB;
constexpr size_t WS_END = 333 * MiB;

struct Params {
    const float* x_prompt; const float* x_sample; const float* cache_a_k; const float* cache_a_v; const float* cache_c_k; const float* cache_c_v;
    const float* c; const float* c_ctx; const float* norm_w; const float* ada_w; const float* ada_b;
    const float* even_w_in; const float* even_q_norm_w; const float* even_k_norm_w; const float* lam_q1; const float* lam_k1; const float* lam_q2; const float* lam_k2;
    const float* subln_w; const float* pool_w; const float* pool_scale; const float* even_w_out;
    const float* gqa_w_in; const float* gqa_q_norm_w; const float* gqa_k_norm_w; const float* gqa_w_out;
    float* out; unsigned char* ws;
};

__device__ __forceinline__ unsigned f2bf(float f) { unsigned u = __builtin_bit_cast(unsigned, f); return (u + 0x7fffu + ((u >> 16) & 1u)) >> 16; }
__device__ __forceinline__ unsigned pk2(float lo, float hi) { return f2bf(lo) | (f2bf(hi) << 16); }
__device__ __forceinline__ float bf2f(unsigned h) { return __builtin_bit_cast(float, h << 16); }
__device__ __forceinline__ float bflo(unsigned w) { return __builtin_bit_cast(float, w << 16); }
__device__ __forceinline__ float bfhi(unsigned w) { return __builtin_bit_cast(float, w & 0xffff0000u); }
__device__ __forceinline__ float siluf(float x) { return x / (1.f + __expf(-x)); }
__device__ __forceinline__ float wave_sum(float v) {
#pragma unroll
    for (int o = 1; o < 64; o <<= 1) v += __shfl_xor(v, o);
    return v;
}
__device__ __forceinline__ float wave_max(float v) {
#pragma unroll
    for (int o = 1; o < 64; o <<= 1) v = fmaxf(v, __shfl_xor(v, o));
    return v;
}
__device__ __forceinline__ const float* xrow_ptr(const Params& p, int m) { return m < MP ? p.x_prompt + (size_t)m * DM : p.x_sample + (size_t)(m - MP) * DM; }
__device__ __forceinline__ int cond_row(int m) { return m < MP ? 0 : 1 + ((m - MP) >> 10); }

__device__ __forceinline__ void mod_items(const Params& p, float* sl  , int bid, int nb) {
    float* mod = (float*)(p.ws + WS_MOD);
    const int tid = threadIdx.x, nthr = blockDim.x;
    for (int it = bid; it < 256; it += nb) {
        const int l = it >> 7, kc = (it >> 2) & 31, nc = it & 3;
        __syncthreads();
        for (int i = tid; i < 192; i += nthr) { const int r = i >> 6, kk = i & 63, k = kc * 64 + kk; const float cv = r == 0 ? p.c_ctx[k] : p.c[(r - 1) * DM + k]; sl[i] = siluf(cv); }
        __syncthreads();
        for (int q = tid; q < 384; q += nthr) {
            const int n = nc * 1536 + q * 4;
            const float* w = p.ada_w + ((size_t)l * DM + kc * 64) * 6144 + n;
            f32x4 a0 = {0.f, 0.f, 0.f, 0.f}, a1 = a0, a2 = a0;
#pragma unroll 16
            for (int kk = 0; kk < 64; ++kk) { const f32x4 wv = *(const f32x4*)(w + (size_t)kk * 6144); a0 += wv * sl[kk]; a1 += wv * sl[64 + kk]; a2 += wv * sl[128 + kk]; }
            if (kc == 0) { const f32x4 b = *(const f32x4*)(p.ada_b + l * 6144 + n); a0 += b; a1 += b; a2 += b; }
            float* m0 = mod + (size_t)(l * 3) * 6144 + n;
#pragma unroll
            for (int e = 0; e < 4; ++e) { atomicAdd(m0 + e, a0[e]); atomicAdd(m0 + 6144 + e, a1[e]); atomicAdd(m0 + 2 * 6144 + e, a2[e]); }
        }
    }
}

__device__ __forceinline__ void transpose_item(const float* W, int K, int N, bf16_t* WT, float* scr, int item, int lane) {
    const int nblk = N / 32, kb = item / nblk, nb = item % nblk, k0 = 64 * kb, n0 = 32 * nb;
#pragma unroll 8
    for (int i = 0; i < 32; ++i) { const int kk = 2 * i + (lane >> 5); scr[kk * 33 + (lane & 31)] = W[(size_t)(k0 + kk) * N + n0 + (lane & 31)]; }
    __builtin_amdgcn_s_waitcnt(0xc07f); asm volatile("" ::: "memory");
    const int c = lane & 7;
#pragma unroll
    for (int j = 0; j < 4; ++j) { const int n = (lane >> 3) + 8 * j; const float* s = scr + (8 * c) * 33 + n;
        u32x4 o; o.x = pk2(s[0 * 33], s[1 * 33]); o.y = pk2(s[2 * 33], s[3 * 33]); o.z = pk2(s[4 * 33], s[5 * 33]); o.w = pk2(s[6 * 33], s[7 * 33]);
        *(u32x4*)(WT + (size_t)(n0 + n) * K + k0 + 8 * c) = o; }
    __builtin_amdgcn_s_waitcnt(0xc07f); asm volatile("" ::: "memory");
}
__device__ __forceinline__ void weights_items(const Params& p, float* scr  , int gw, int ngw, int lane) {
    constexpr int I_WINE = 32 * (EVEN_IN / 32), I_WOUT = 32 * (DM / 32), I_WINO = 32 * (ODD_IN / 32), I_POOL = 4 * (256 / 32);
    constexpr int NITEMS = I_WINE + I_WOUT + I_WINO + I_WOUT + 4 * I_POOL;
    for (int it = gw; it < NITEMS; it += ngw) {
        int r = it;
        if (r < I_WINE) { transpose_item(p.even_w_in, DM, EVEN_IN, (bf16_t*)(p.ws + WS_WINE), scr, r, lane); continue; } r -= I_WINE;
        if (r < I_WOUT) { transpose_item(p.even_w_out, DM, DM, (bf16_t*)(p.ws + WS_WOUTE), scr, r, lane); continue; } r -= I_WOUT;
        if (r < I_WINO) { transpose_item(p.gqa_w_in, DM, ODD_IN, (bf16_t*)(p.ws + WS_WINO), scr, r, lane); continue; } r -= I_WINO;
        if (r < I_WOUT) { transpose_item(p.gqa_w_out, DM, DM, (bf16_t*)(p.ws + WS_WOUTO), scr, r, lane); continue; } r -= I_WOUT;
        const int g = r / I_POOL; r -= g * I_POOL;
        transpose_item(p.pool_w + (size_t)g * 65536, 256, 256, (bf16_t*)(p.ws + WS_POOLW) + (size_t)g * 65536, scr, r, lane);
    }
}
__device__ __forceinline__ void caches_rope_items(const Params& p, long gt, long ngt) {
    constexpr long NA = 2L * 8 * 256 * 128 / 4, NC = 2L * 4 * 256 * 128 / 4;
    for (long i = gt; i < 2 * NA + 2 * NC; i += ngt) {
        long j = i; const float* src; bf16_t* dst;
        if (j < NA) { src = p.cache_a_k; dst = (bf16_t*)(p.ws + WS_KSA); } else if ((j -= NA) < NA) { src = p.cache_a_v; dst = (bf16_t*)(p.ws + WS_VSA); }
        else if ((j -= NA) < NC) { src = p.cache_c_k; dst = (bf16_t*)(p.ws + WS_KSC); } else { j -= NC; src = p.cache_c_v; dst = (bf16_t*)(p.ws + WS_VSC); }
        const long e = j * 4, bh = e / (256 * 128), rem = e % (256 * 128);
        const f32x4 v = *(const f32x4*)(src + e);
        u32x2 o; o.x = pk2(v[0], v[1]); o.y = pk2(v[2], v[3]);
        *(u32x2*)(dst + bh * (LKS * 128) + rem) = o;
    }
    float* ropeA = (float*)(p.ws + WS_ROPE); float* ropeC = ropeA + 2 * 1024 * 64;
    for (long i = gt; i < 1024L * 64 + 1024L * 128; i += ngt) {
        const bool isA = i < 1024L * 64; const long j = isA ? i : i - 1024L * 64; const int dim = isA ? 64 : 128, quarter = dim / 4;
        const int t = (int)(j / dim), d = (int)(j % dim); const int qd = d / quarter, fi = d % quarter;
        const float freq = powf(10000.0f, -(float)fi / (float)quarter);
        const float pos = (qd < 2) ? (float)(t / 64) : (float)(t % 64);
        const float ang = pos * freq;
        float* base = isA ? ropeA : ropeC;
        base[j] = cosf(ang); base[(size_t)1024 * dim + j] = sinf(ang);
    }
}

__device__ __forceinline__ void modulate_rows(const Params& p, int layer, int gw, int ngw, int lane) {
    const float* mod = (const float*)(p.ws + WS_MOD) + (size_t)layer * 3 * 6144;
    const float* nw = p.norm_w + layer * DM;
    bf16_t* H = (bf16_t*)(p.ws + WS_HY);
    for (int m = gw; m < MT; m += ngw) {
        const float* xr = layer == 0 ? xrow_ptr(p, m) : p.out + (size_t)m * DM;
        const float* mr = mod + (size_t)cond_row(m) * 6144;
        f32x4 v[8]; float ss = 0.f;
#pragma unroll
        for (int j = 0; j < 8; ++j) { v[j] = *(const f32x4*)(xr + 4 * lane + 256 * j); ss += (v[j][0] * v[j][0] + v[j][1] * v[j][1]) + (v[j][2] * v[j][2] + v[j][3] * v[j][3]); }
        const float rstd = 1.0f / sqrtf(wave_sum(ss) * (1.f / DM) + EPS);
#pragma unroll
        for (int j = 0; j < 8; ++j) { const int k = 4 * lane + 256 * j;
            const f32x4 w = *(const f32x4*)(nw + k), sh = *(const f32x4*)(mr + k), sc = *(const f32x4*)(mr + 2048 + k);
            const f32x4 h = v[j] * rstd * w * (sc + 1.0f) + sh;
            u32x2 o; o.x = pk2(h[0], h[1]); o.y = pk2(h[2], h[3]);
            *(u32x2*)(H + (size_t)m * DM + k) = o; }
    }
}

template <int DIM>
__device__ __forceinline__ f32x4 norm_rope4(f32x4 v, int lg  , const float* w, bool rope, const float* cosr, const float* sinr) {
    float ss = (v[0] * v[0] + v[1] * v[1]) + (v[2] * v[2] + v[3] * v[3]);
#pragma unroll
    for (int o = 1; o < DIM / 4; o <<= 1) ss += __shfl_xor(ss, o);
    const float r = 1.0f / sqrtf(ss * (1.f / DIM) + EPS);
    const f32x4 wv = *(const f32x4*)(w + 4 * lg);
    f32x4 y = v * r * wv;
    f32x4 pr;
#pragma unroll
    for (int e = 0; e < 4; ++e) pr[e] = __shfl_xor(y[e], DIM / 16);
    if (rope) {
        const f32x4 cs = *(const f32x4*)(cosr + 4 * lg), sn = *(const f32x4*)(sinr + 4 * lg);
        const bool odd = ((lg / (DIM / 16)) & 1) != 0;
        y = odd ? (y * cs + pr * sn) : (y * cs - pr * sn);
    }
    return y;
}

__device__ __forceinline__ void post0_rows(const Params& p, int gw, int ngw, int lane) {
    const bf16_t* PR = (const bf16_t*)(p.ws + WS_PR);
    bf16_t* QA = (bf16_t*)(p.ws + WS_Q); bf16_t* UA = (bf16_t*)(p.ws + WS_UA);
    const float* ropeA = (const float*)(p.ws + WS_ROPE);
    float* new_a_k = p.out + (size_t)MT * DM; float* new_a_v = new_a_k + (size_t)NBP * HA * SEQP * 128;
    for (int m = gw; m < MT; m += ngw) {
        const bool smp = m >= MP; const int b = smp ? (m - MP) >> 10 : m >> 8, t = smp ? (m - MP) & 1023 : m & 255;
        const bf16_t* pr = PR + (size_t)m * EVEN_IN;
        const float* cosr = ropeA + (size_t)t * 64; const float* sinr = ropeA + 1024 * 64 + (size_t)t * 64;
        const int sub = lane >> 4, lg = lane & 15;
#pragma unroll 2
        for (int st = 0; st < 8; ++st) {
            const int grp = st * 4 + sub;
            const u32x2 raw = *(const u32x2*)(pr + grp * 64 + 4 * lg);
            f32x4 v = {bflo(raw.x), bfhi(raw.x), bflo(raw.y), bfhi(raw.y)};
            const bool isk = grp >= 16;
            f32x4 y = norm_rope4<64>(v, lg, isk ? p.even_k_norm_w : p.even_q_norm_w, smp, cosr, sinr);
            if (!isk) { y = y * C2A; u32x2 o; o.x = pk2(y[0], y[1]); o.y = pk2(y[2], y[3]); *(u32x2*)(QA + (size_t)m * 1024 + grp * 64 + 4 * lg) = o; }
            else { const int g2 = grp - 16, h = g2 >> 1, j = g2 & 1;
                u32x2 o; o.x = pk2(y[0], y[1]); o.y = pk2(y[2], y[3]);
                if (smp) *(u32x2*)((bf16_t*)(p.ws + WS_KSA) + ((size_t)(b * HA + h) * LKS + PAST + t) * 128 + j * 64 + 4 * lg) = o;
                else { const size_t off = ((size_t)(b * HA + h) * SEQP + t) * 128 + j * 64 + 4 * lg; *(u32x2*)((bf16_t*)(p.ws + WS_KP) + off) = o; *(f32x4*)(new_a_k + off) = y; } }
        }
#pragma unroll
        for (int i = 0; i < 2; ++i) { const int c = 8 * lane + 512 * i, h = c >> 7, d = c & 127;
            const u32x4 raw = *(const u32x4*)(pr + 2048 + c);
            if (smp) *(u32x4*)((bf16_t*)(p.ws + WS_VSA) + ((size_t)(b * HA + h) * LKS + PAST + t) * 128 + d) = raw;
            else { const size_t off = ((size_t)(b * HA + h) * SEQP + t) * 128 + d; *(u32x4*)((bf16_t*)(p.ws + WS_VP) + off) = raw;
                *(f32x4*)(new_a_v + off) = (f32x4){bflo(raw.x), bfhi(raw.x), bflo(raw.y), bfhi(raw.y)}; *(f32x4*)(new_a_v + off + 4) = (f32x4){bflo(raw.z), bfhi(raw.z), bflo(raw.w), bfhi(raw.w)}; } }
        const int L = smp ? SEQS : SEQP;
#pragma unroll
        for (int i = 0; i < 2; ++i) { const int ch = lane + 64 * i, c = 8 * ch, g = ch >> 5, half = 1 << g;
            const int lo = max(t - half, 0), hi = min(t + half, L);
            float s[8] = {0.f, 0.f, 0.f, 0.f, 0.f, 0.f, 0.f, 0.f};
            for (int tt = lo; tt < hi; ++tt) { const u32x4 raw = *(const u32x4*)(pr + (ptrdiff_t)(tt - t) * EVEN_IN + 3072 + c);
                s[0] += bflo(raw.x); s[1] += bfhi(raw.x); s[2] += bflo(raw.y); s[3] += bfhi(raw.y); s[4] += bflo(raw.z); s[5] += bfhi(raw.z); s[6] += bflo(raw.w); s[7] += bfhi(raw.w); }
            const float inv = 1.0f / (float)(hi - lo);
            const u32x4 own = *(const u32x4*)(pr + 3072 + c);
            u32x4 o; o.x = pk2(s[0] * inv - bflo(own.x), s[1] * inv - bfhi(own.x)); o.y = pk2(s[2] * inv - bflo(own.y), s[3] * inv - bfhi(own.y));
            o.z = pk2(s[4] * inv - bflo(own.z), s[5] * inv - bfhi(own.z)); o.w = pk2(s[6] * inv - bflo(own.w), s[7] * inv - bfhi(own.w));
            *(u32x4*)(UA + (size_t)m * 1024 + c) = o; }
    }
}

__device__ __forceinline__ void post1_rows(const Params& p, int gw, int ngw, int lane) {
    const bf16_t* PR = (const bf16_t*)(p.ws + WS_PR);
    bf16_t* QC = (bf16_t*)(p.ws + WS_Q);
    const float* ropeC = (const float*)(p.ws + WS_ROPE) + 2 * 1024 * 64;
    float* new_c_k = p.out + (size_t)MT * DM + 2 * (size_t)NBP * HA * SEQP * 128; float* new_c_v = new_c_k + (size_t)NBP * KVH * SEQP * 128;
    for (int m = gw; m < MT; m += ngw) {
        const bool smp = m >= MP; const int b = smp ? (m - MP) >> 10 : m >> 8, t = smp ? (m - MP) & 1023 : m & 255;
        const bf16_t* pr = PR + (size_t)m * ODD_IN;
        const float* cosr = ropeC + (size_t)t * 128; const float* sinr = ropeC + 1024 * 128 + (size_t)t * 128;
        const int sub = lane >> 5, lg = lane & 31;
#pragma unroll 2
        for (int st = 0; st < 10; ++st) {
            const int grp = st * 2 + sub;
            const u32x2 raw = *(const u32x2*)(pr + grp * 128 + 4 * lg);
            f32x4 v = {bflo(raw.x), bfhi(raw.x), bflo(raw.y), bfhi(raw.y)};
            const bool isk = grp >= 16;
            f32x4 y = norm_rope4<128>(v, lg, isk ? p.gqa_k_norm_w : p.gqa_q_norm_w, smp, cosr, sinr);
            if (!isk) { y = y * C2C; u32x2 o; o.x = pk2(y[0], y[1]); o.y = pk2(y[2], y[3]); *(u32x2*)(QC + (size_t)m * DM + grp * 128 + 4 * lg) = o; }
            else { const int kh = grp - 16;
                u32x2 o; o.x = pk2(y[0], y[1]); o.y = pk2(y[2], y[3]);
                if (smp) *(u32x2*)((bf16_t*)(p.ws + WS_KSC) + ((size_t)(b * KVH + kh) * LKS + PAST + t) * 128 + 4 * lg) = o;
                else { const size_t off = ((size_t)(b * KVH + kh) * SEQP + t) * 128 + 4 * lg; *(u32x2*)((bf16_t*)(p.ws + WS_KP) + off) = o; *(f32x4*)(new_c_k + off) = y; } }
        }
        { const int c = 8 * lane, kh = c >> 7, d = c & 127;
            const u32x4 raw = *(const u32x4*)(pr + 2560 + c);
            if (smp) *(u32x4*)((bf16_t*)(p.ws + WS_VSC) + ((size_t)(b * KVH + kh) * LKS + PAST + t) * 128 + d) = raw;
            else { const size_t off = ((size_t)(b * KVH + kh) * SEQP + t) * 128 + d; *(u32x4*)((bf16_t*)(p.ws + WS_VP) + off) = raw;
                *(f32x4*)(new_c_v + off) = (f32x4){bflo(raw.x), bfhi(raw.x), bflo(raw.y), bfhi(raw.y)}; *(f32x4*)(new_c_v + off + 4) = (f32x4){bflo(raw.z), bfhi(raw.z), bflo(raw.w), bfhi(raw.w)}; } }
    }
}

struct EpiStoreBf16 { bf16_t* C; int ldc; int pad; __device__ void operator()(int r, int c, float v) const { C[(size_t)r * ldc + c] = (bf16_t)f2bf(v); } };
struct EpiPool { bf16_t* Y; const bf16_t* PR; const float* pscale; int g; int pad;
    __device__ void operator()(int r, int c, float v) const { const int cc = g * 256 + c; const float gt = bf2f(PR[(size_t)r * EVEN_IN + 4096 + 1024 + cc]);
        Y[(size_t)r * DM + 1024 + cc] = (bf16_t)f2bf(v * pscale[cc] * siluf(gt)); } };
struct EpiResid { const float* x_prompt; const float* x_sample; const float* base; const float* gate; float* out;
    __device__ void operator()(int r, int c, float v) const { const float bs = base ? base[(size_t)r * DM + c] : (r < MP ? x_prompt[(size_t)r * DM + c] : x_sample[(size_t)(r - MP) * DM + c]);
        out[(size_t)r * DM + c] = bs + gate[(size_t)cond_row(r) * 6144 + c] * v; } };
template <class Epi>
__global__ __launch_bounds__(256) void gemm_naive(const bf16_t* A, int lda, const bf16_t* Bt, int ldb, int M, int N, int K, Epi E) {
    __shared__ float As[16][65], Bs[16][65];
    const int tid = threadIdx.x, tx = tid & 15, ty = tid >> 4;
    const int nbn = N / 64, bm = blockIdx.x / nbn, bn = blockIdx.x % nbn;
    float acc[4][4] = {};
    const int lr = tid >> 2, lc = (tid & 3) * 4;
    for (int k0 = 0; k0 < K; k0 += 16) {
        const u32x2 ra = *(const u32x2*)(A + (size_t)(bm * 64 + lr) * lda + k0 + lc), rb = *(const u32x2*)(Bt + (size_t)(bn * 64 + lr) * ldb + k0 + lc);
        __syncthreads();
        As[lc + 0][lr] = bflo(ra.x); As[lc + 1][lr] = bfhi(ra.x); As[lc + 2][lr] = bflo(ra.y); As[lc + 3][lr] = bfhi(ra.y);
        Bs[lc + 0][lr] = bflo(rb.x); Bs[lc + 1][lr] = bfhi(rb.x); Bs[lc + 2][lr] = bflo(rb.y); Bs[lc + 3][lr] = bfhi(rb.y);
        __syncthreads();
#pragma unroll
        for (int kk = 0; kk < 16; ++kk) { float a[4], b[4];
#pragma unroll
            for (int i = 0; i < 4; ++i) { a[i] = As[kk][ty * 4 + i]; b[i] = Bs[kk][tx * 4 + i]; }
#pragma unroll
            for (int i = 0; i < 4; ++i)
#pragma unroll
                for (int j = 0; j < 4; ++j) acc[i][j] += a[i] * b[j]; }
    }
#pragma unroll
    for (int i = 0; i < 4; ++i)
#pragma unroll
        for (int j = 0; j < 4; ++j) E(bm * 64 + ty * 4 + i, bn * 64 + tx * 4 + j, acc[i][j]);
}

__device__ __forceinline__ void diffattn_tasks(const Params& p, float* s1  , long gw, long ngw, int lane) {
    float* s2 = s1 + LKS; float* qs = s2 + LKS;
    const bf16_t* QA = (const bf16_t*)(p.ws + WS_Q); const bf16_t* PR = (const bf16_t*)(p.ws + WS_PR); bf16_t* Y = (bf16_t*)(p.ws + WS_HY);
    const float lam_init = 0.2f;
    const float lam = expf(wave_sum(p.lam_q1[lane] * p.lam_k1[lane])) - expf(wave_sum(p.lam_q2[lane] * p.lam_k2[lane])) + lam_init;
    for (long task = gw; task < (long)MT * HA; task += ngw) {
        const int m = (int)(task / HA), h = (int)(task % HA);
        const bool smp = m >= MP; const int b = smp ? (m - MP) >> 10 : m >> 8; const int Lk = smp ? LKS : SEQP;
        const bf16_t* Kb = smp ? (const bf16_t*)(p.ws + WS_KSA) + (size_t)(b * HA + h) * LKS * 128 : (const bf16_t*)(p.ws + WS_KP) + (size_t)(b * HA + h) * SEQP * 128;
        const bf16_t* Vb = smp ? (const bf16_t*)(p.ws + WS_VSA) + (size_t)(b * HA + h) * LKS * 128 : (const bf16_t*)(p.ws + WS_VP) + (size_t)(b * HA + h) * SEQP * 128;
        { const unsigned w = *(const unsigned*)(QA + (size_t)m * 1024 + h * 128 + 2 * lane); qs[2 * lane] = bflo(w); qs[2 * lane + 1] = bfhi(w); }
        __builtin_amdgcn_s_waitcnt(0xc07f); asm volatile("" ::: "memory");
        float m1 = -1e30f, m2 = -1e30f;
        for (int j = lane; j < Lk; j += 64) { const bf16_t* kr = Kb + (size_t)j * 128; float a1 = 0.f, a2 = 0.f;
#pragma unroll
            for (int d8 = 0; d8 < 8; ++d8) { const u32x4 w1 = *(const u32x4*)(kr + d8 * 8), w2 = *(const u32x4*)(kr + 64 + d8 * 8); const float* q1 = qs + d8 * 8; const float* q2 = qs + 64 + d8 * 8;
                a1 += q1[0] * bflo(w1.x) + q1[1] * bfhi(w1.x) + q1[2] * bflo(w1.y) + q1[3] * bfhi(w1.y) + q1[4] * bflo(w1.z) + q1[5] * bfhi(w1.z) + q1[6] * bflo(w1.w) + q1[7] * bfhi(w1.w);
                a2 += q2[0] * bflo(w2.x) + q2[1] * bfhi(w2.x) + q2[2] * bflo(w2.y) + q2[3] * bfhi(w2.y) + q2[4] * bflo(w2.z) + q2[5] * bfhi(w2.z) + q2[6] * bflo(w2.w) + q2[7] * bfhi(w2.w); }
            s1[j] = a1; s2[j] = a2; m1 = fmaxf(m1, a1); m2 = fmaxf(m2, a2); }
        m1 = wave_max(m1); m2 = wave_max(m2);
        float l1 = 0.f, l2 = 0.f;
        for (int j = lane; j < Lk; j += 64) { const float e1 = exp2f(s1[j] - m1), e2 = exp2f(s2[j] - m2); s1[j] = e1; s2[j] = e2; l1 += e1; l2 += e2; }
        l1 = wave_sum(l1); l2 = wave_sum(l2);
        const float i1 = 1.f / l1, i2 = lam / l2;
        for (int j = lane; j < Lk; j += 64) s1[j] = s1[j] * i1 - s2[j] * i2;
        __builtin_amdgcn_s_waitcnt(0xc07f); asm volatile("" ::: "memory");
        float o0 = 0.f, o1 = 0.f;
        for (int j = 0; j < Lk; ++j) { const unsigned w = *(const unsigned*)(Vb + (size_t)j * 128 + 2 * lane); const float pj = s1[j]; o0 += pj * bflo(w); o1 += pj * bfhi(w); }
        const float r = 1.0f / sqrtf(wave_sum(o0 * o0 + o1 * o1) * (1.f / 128.f) + EPS);
        const unsigned gw = *(const unsigned*)(PR + (size_t)m * EVEN_IN + 4096 + h * 128 + 2 * lane);
        const float y0 = o0 * r * p.subln_w[2 * lane] * (1.f - lam_init) * siluf(bflo(gw)), y1 = o1 * r * p.subln_w[2 * lane + 1] * (1.f - lam_init) * siluf(bfhi(gw));
        *(unsigned*)(Y + (size_t)m * DM + h * 128 + 2 * lane) = pk2(y0, y1);
        __builtin_amdgcn_s_waitcnt(0xc07f); asm volatile("" ::: "memory");
    }
}
__device__ __forceinline__ void gqa_tasks(const Params& p, float* s1  , long gw, long ngw, int lane) {
    float* qs = s1 + LKS;
    const bf16_t* QC = (const bf16_t*)(p.ws + WS_Q); const bf16_t* PR = (const bf16_t*)(p.ws + WS_PR); bf16_t* Y = (bf16_t*)(p.ws + WS_HY);
    for (long task = gw; task < (long)MT * HC; task += ngw) {
        const int m = (int)(task / HC), hq = (int)(task % HC), kh = hq >> 2;
        const bool smp = m >= MP; const int b = smp ? (m - MP) >> 10 : m >> 8; const int Lk = smp ? LKS : SEQP;
        const bf16_t* Kb = smp ? (const bf16_t*)(p.ws + WS_KSC) + (size_t)(b * KVH + kh) * LKS * 128 : (const bf16_t*)(p.ws + WS_KP) + (size_t)(b * KVH + kh) * SEQP * 128;
        const bf16_t* Vb = smp ? (const bf16_t*)(p.ws + WS_VSC) + (size_t)(b * KVH + kh) * LKS * 128 : (const bf16_t*)(p.ws + WS_VP) + (size_t)(b * KVH + kh) * SEQP * 128;
        { const unsigned w = *(const unsigned*)(QC + (size_t)m * DM + hq * 128 + 2 * lane); qs[2 * lane] = bflo(w); qs[2 * lane + 1] = bfhi(w); }
        __builtin_amdgcn_s_waitcnt(0xc07f); asm volatile("" ::: "memory");
        float m1 = -1e30f;
        for (int j = lane; j < Lk; j += 64) { const bf16_t* kr = Kb + (size_t)j * 128; float a1 = 0.f;
#pragma unroll
            for (int d8 = 0; d8 < 16; ++d8) { const u32x4 w1 = *(const u32x4*)(kr + d8 * 8); const float* q1 = qs + d8 * 8;
                a1 += q1[0] * bflo(w1.x) + q1[1] * bfhi(w1.x) + q1[2] * bflo(w1.y) + q1[3] * bfhi(w1.y) + q1[4] * bflo(w1.z) + q1[5] * bfhi(w1.z) + q1[6] * bflo(w1.w) + q1[7] * bfhi(w1.w); }
            s1[j] = a1; m1 = fmaxf(m1, a1); }
        m1 = wave_max(m1);
        float l1 = 0.f;
        for (int j = lane; j < Lk; j += 64) { const float e1 = exp2f(s1[j] - m1); s1[j] = e1; l1 += e1; }
        l1 = wave_sum(l1);
        __builtin_amdgcn_s_waitcnt(0xc07f); asm volatile("" ::: "memory");
        float o0 = 0.f, o1 = 0.f;
        for (int j = 0; j < Lk; ++j) { const unsigned w = *(const unsigned*)(Vb + (size_t)j * 128 + 2 * lane); const float pj = s1[j]; o0 += pj * bflo(w); o1 += pj * bfhi(w); }
        const float il = 1.f / l1;
        const unsigned gw = *(const unsigned*)(PR + (size_t)m * ODD_IN + 3072 + hq * 128 + 2 * lane);
        *(unsigned*)(Y + (size_t)m * DM + hq * 128 + 2 * lane) = pk2(o0 * il * siluf(bflo(gw)), o1 * il * siluf(bfhi(gw)));
        __builtin_amdgcn_s_waitcnt(0xc07f); asm volatile("" ::: "memory");
    }
}

__global__ __launch_bounds__(256) void diffattn_naive(Params p) { __shared__ float sh[4][2 * LKS + 128]; diffattn_tasks(p, sh[threadIdx.x >> 6], (long)blockIdx.x * 4 + (threadIdx.x >> 6), (long)gridDim.x * 4, threadIdx.x & 63); }
__global__ __launch_bounds__(256) void gqa_naive(Params p) { __shared__ float sh[4][LKS + 128]; gqa_tasks(p, sh[threadIdx.x >> 6], (long)blockIdx.x * 4 + (threadIdx.x >> 6), (long)gridDim.x * 4, threadIdx.x & 63); }
__global__ __launch_bounds__(512) void k_prologue(Params p) {
    __shared__ float scr[8 * 64 * 33];
    const int wid = threadIdx.x >> 6, lane = threadIdx.x & 63;
    mod_items(p, scr, blockIdx.x, gridDim.x);
    __syncthreads();
    weights_items(p, scr + wid * 64 * 33, blockIdx.x * 8 + wid, gridDim.x * 8, lane);
    caches_rope_items(p, (long)blockIdx.x * 512 + threadIdx.x, (long)gridDim.x * 512);
}
__global__ __launch_bounds__(512) void k_modulate(Params p, int layer) { modulate_rows(p, layer, blockIdx.x * 8 + (threadIdx.x >> 6), gridDim.x * 8, threadIdx.x & 63); }
__global__ __launch_bounds__(512) void k_post0(Params p) { post0_rows(p, blockIdx.x * 8 + (threadIdx.x >> 6), gridDim.x * 8, threadIdx.x & 63); }
__global__ __launch_bounds__(512) void k_post1(Params p) { post1_rows(p, blockIdx.x * 8 + (threadIdx.x >> 6), gridDim.x * 8, threadIdx.x & 63); }


namespace pg8 {
#define PG8_LAS __attribute__((address_space(3)))
typedef short bf16x8 __attribute__((ext_vector_type(8)));
constexpr int BM = 256, BK = 64, HALF = 128, HTB = HALF * BK * 2  , STAGE_BYTES = 8 * HTB, NXCD = 8, WGM = 8;
__host__ __device__ __forceinline__ int lds_byte(int r, int c) { const int st = (r >> 4) * 2 + (c >> 5), rr = r & 15, cc = c & 31, ob = rr * 64 + cc * 2; return st * 1024 + (ob ^ (((ob >> 9) & 1) << 5)); }
__host__ __device__ __forceinline__ void stage_rc(int b, int& R, int& C) { const int st = b / 1024, sb = b % 1024, swz = sb ^ (((sb >> 9) & 1) << 5); R = (st >> 1) * 16 + swz / 64; C = (st & 1) * 32 + (swz % 64) / 2; }
__host__ __device__ __forceinline__ int perm32(int rho) { const int n = rho >> 4, i = rho & 15; return 8 * (i >> 2) + 4 * n + (i & 3); }
struct Unit { int pm, pn; };
struct Gemm { const bf16_t* A; const bf16_t* Bt; int M, N, K, lda, ldb, a_pn_off; };
struct StaticOrder {
    int nM, nN, nwg, G, c;
    __host__ __device__ void init(int M, int N, int G_, int c_) { nM = M / BM; nN = N / BM; nwg = nM * nN; G = G_; c = c_; }
    __host__ __device__ bool next(int i, Unit& u) const {
        const long L = (long)i * G + c; if (L >= nwg) return false;
        int wgid = (int)L; { const int q = nwg / NXCD, r = nwg % NXCD, xcd = wgid % NXCD, off = wgid / NXCD; wgid = (xcd < r ? xcd * (q + 1) : r * (q + 1) + (xcd - r) * q) + off; }
        const int nig = WGM * nN, gid = wgid / nig, fm = gid * WGM, gsz = (nM - fm) < WGM ? (nM - fm) : WGM;
        u.pm = fm + ((wgid % nig) % gsz); u.pn = (wgid % nig) / gsz; return true;
    }
    __device__ __forceinline__ void a_ready(const Unit&) const {}
    __device__ __forceinline__ void done(const Unit&) const {}
};
__device__ __forceinline__ unsigned cvt_pk_bf16(float lo, float hi) { unsigned r; asm volatile("v_cvt_pk_bf16_f32 %0, %1, %2" : "=v"(r) : "v"(lo), "v"(hi)); return r; }
struct EpiBf16 {
    static constexpr bool PERM = true, AFTER_DRAIN = false;
    bf16_t* O; int ldc; int pad;
    __device__ __forceinline__ void operator()(const f32x4 (&acc)[2][2][4][2], const Unit& u, int wr, int wc, int fr, int fq) const {
        const int row0 = u.pm * BM + wr * 64 + fr, col0 = u.pn * BM + wc * 32 + 8 * fq;
#pragma unroll
        for (int ai = 0; ai < 2; ++ai)
#pragma unroll
            for (int m = 0; m < 4; ++m) { bf16_t* rowp = O + (size_t)(row0 + ai * HALF + m * 16) * ldc + col0;
#pragma unroll
                for (int bj = 0; bj < 2; ++bj) { const f32x4 v0 = acc[ai][bj][m][0], v1 = acc[ai][bj][m][1];
                    u32x4 w; w.x = cvt_pk_bf16(v0[0], v0[1]); w.y = cvt_pk_bf16(v0[2], v0[3]); w.z = cvt_pk_bf16(v1[0], v1[1]); w.w = cvt_pk_bf16(v1[2], v1[3]);
                    *(u32x4*)(rowp + bj * HALF) = w; } }
    }
};
struct EpiPoolF {
    static constexpr bool PERM = true, AFTER_DRAIN = false;
    bf16_t* Y; const bf16_t* PR; const float* pscale;
    __device__ __forceinline__ void operator()(const f32x4 (&acc)[2][2][4][2], const Unit& u, int wr, int wc, int fr, int fq) const {
        const int row0 = u.pm * BM + wr * 64 + fr, col0 = u.pn * BM + wc * 32 + 8 * fq;
        f32x4 ps[2][2];
#pragma unroll
        for (int bj = 0; bj < 2; ++bj) { ps[bj][0] = *(const f32x4*)(pscale + col0 + bj * HALF); ps[bj][1] = *(const f32x4*)(pscale + col0 + bj * HALF + 4); }
#pragma unroll
        for (int ai = 0; ai < 2; ++ai)
#pragma unroll
            for (int m = 0; m < 4; ++m) { const size_t r = (size_t)(row0 + ai * HALF + m * 16);
#pragma unroll
                for (int bj = 0; bj < 2; ++bj) { const int c = col0 + bj * HALF;
                    const u32x4 g = *(const u32x4*)(PR + r * EVEN_IN + 5120 + c);
                    const f32x4 v0 = acc[ai][bj][m][0] * ps[bj][0], v1 = acc[ai][bj][m][1] * ps[bj][1];
                    u32x4 w; w.x = cvt_pk_bf16(v0[0] * siluf(bflo(g.x)), v0[1] * siluf(bfhi(g.x))); w.y = cvt_pk_bf16(v0[2] * siluf(bflo(g.y)), v0[3] * siluf(bfhi(g.y)));
                    w.z = cvt_pk_bf16(v1[0] * siluf(bflo(g.z)), v1[1] * siluf(bfhi(g.z))); w.w = cvt_pk_bf16(v1[2] * siluf(bflo(g.w)), v1[3] * siluf(bfhi(g.w)));
                    *(u32x4*)(Y + r * DM + 1024 + c) = w; } }
    }
};
struct EpiResidF {
    static constexpr bool PERM = false, AFTER_DRAIN = false;
    const float* xp; const float* xs; const float* base; const float* gate; float* out;
    __device__ __forceinline__ void operator()(const f32x4 (&acc)[2][2][4][2], const Unit& u, int wr, int wc, int fr, int fq) const {
        const int row0 = u.pm * BM + wr * 64 + fr, col0 = u.pn * BM + wc * 32 + 4 * fq;
        const int cr = u.pm < 32 ? 0 : 1 + ((u.pm - 32) >> 2);
        f32x4 gv[2][2];
#pragma unroll
        for (int bj = 0; bj < 2; ++bj)
#pragma unroll
            for (int n = 0; n < 2; ++n) gv[bj][n] = *(const f32x4*)(gate + (size_t)cr * 6144 + col0 + bj * HALF + n * 16);
#pragma unroll
        for (int ai = 0; ai < 2; ++ai)
#pragma unroll
            for (int m = 0; m < 4; ++m) { const int r = row0 + ai * HALF + m * 16;
                const float* bp = (base ? base + (size_t)r * DM : (r < MP ? xp + (size_t)r * DM : xs + (size_t)(r - MP) * DM)) + col0; float* op = out + (size_t)r * DM + col0;
#pragma unroll
                for (int bj = 0; bj < 2; ++bj)
#pragma unroll
                    for (int n = 0; n < 2; ++n) { const f32x4 b = *(const f32x4*)(bp + bj * HALF + n * 16); *(f32x4*)(op + bj * HALF + n * 16) = b + gv[bj][n] * acc[ai][bj][m][n]; }
                if (m & 1) asm volatile("" ::: "memory"); }
    }
};

template <class Epi, class Sched, bool ALIGN_EPI = false, bool SP2 = false>
__device__ __forceinline__ void gemm_phase(PG8_LAS unsigned char* lds, const Gemm g, const Sched& S, const Epi& E) {
    const int tid = threadIdx.x, wid = __builtin_amdgcn_readfirstlane(tid >> 6), lane = tid & 63, wr = wid >> 2, wc = wid & 3, fr = lane & 15, fq = lane >> 4;
    const int K = g.K, nt = K / BK;
    unsigned voffA[2], voffB[2];
#pragma unroll
    for (int i = 0; i < 2; ++i) { int R, C; stage_rc(tid * 16 + i * 8192, R, C); const int Rb = Epi::PERM ? ((R & ~31) + perm32(R & 31)) : R;
        voffA[i] = (unsigned)(R * g.lda + C) * 2u; voffB[i] = (unsigned)(Rb * g.ldb + C) * 2u; }
    const size_t kstep = (size_t)(BK * 2);
    const size_t hstepA = (size_t)HALF * g.lda * 2, hstepB = (size_t)HALF * g.ldb * 2;
    const size_t tstepA = 2 * hstepA, tstepB = 2 * hstepB;
    const unsigned ldsw = (unsigned)wid * 1024u;
    const int aoff = lds_byte(wr * 64 + fr, fq * 8), boff = lds_byte(wc * 32 + fr, fq * 8);
#define PG8_SA(b, h) (((b) * 2 + (h)) * HTB)
#define PG8_SB(b, h) ((4 + (b) * 2 + (h)) * HTB)
#define PG8_STAGE(bufoff, gbase, voff) do { _Pragma("unroll") for (int _i = 0; _i < 2; ++_i) \
        __builtin_amdgcn_global_load_lds((const unsigned*)((const char*)(gbase) + (voff)[_i]), (PG8_LAS unsigned*)(lds + (bufoff) + ldsw + _i * 8192), 16, 0, 0); } while (0)
#define PG8_LDA(dst, b, h) do { _Pragma("unroll") for (int m = 0; m < 4; ++m) _Pragma("unroll") for (int k = 0; k < 2; ++k) dst[m][k] = *(const PG8_LAS bf16x8*)(lds + PG8_SA(b, h) + aoff + m * 2048 + k * 1024); } while (0)
#define PG8_LDB(dst, b, h) do { _Pragma("unroll") for (int n = 0; n < 2; ++n) _Pragma("unroll") for (int k = 0; k < 2; ++k) dst[n][k] = *(const PG8_LAS bf16x8*)(lds + PG8_SB(b, h) + boff + n * 2048 + k * 1024); } while (0)
#define PG8_MMA(ai, bj, At, Bt) do { __builtin_amdgcn_s_setprio(1); _Pragma("unroll") for (int m = 0; m < 4; ++m) _Pragma("unroll") for (int n = 0; n < 2; ++n) _Pragma("unroll") for (int k = 0; k < 2; ++k) \
        acc[ai][bj][m][n] = __builtin_amdgcn_mfma_f32_16x16x32_bf16(Bt[n][k], At[m][k], acc[ai][bj][m][n], 0, 0, 0); __builtin_amdgcn_s_setprio(0); } while (0)
#define PG8_WAIT_V(n) asm volatile("s_waitcnt vmcnt(" #n ")" ::: "memory")
#define PG8_WAIT_L(n) asm volatile("s_waitcnt lgkmcnt(" #n ")" ::: "memory")
#define PG8_BAR __builtin_amdgcn_s_barrier()
#define PG8_SCHED __builtin_amdgcn_sched_barrier(0)
    Unit cur, nxt; int ui = 0;
    if (!S.next(0, cur)) return;
    f32x4 acc[2][2][4][2];
#pragma unroll
    for (int a = 0; a < 2; ++a)
#pragma unroll
        for (int b = 0; b < 2; ++b)
#pragma unroll
            for (int m = 0; m < 4; ++m)
#pragma unroll
                for (int n = 0; n < 2; ++n) acc[a][b][m][n] = (f32x4){0.f, 0.f, 0.f, 0.f};
    bf16x8 At[4][2], B0[2][2], B1[2][2];
    const char* cA = (const char*)g.A + (size_t)cur.pm * tstepA + (size_t)cur.pn * g.a_pn_off * 2; const char* cB = (const char*)g.Bt + (size_t)cur.pn * tstepB;
    S.a_ready(cur);
    if constexpr (SP2) {
        PG8_STAGE(PG8_SB(0, 0), cB, voffB); PG8_STAGE(PG8_SB(0, 1), cB + hstepB, voffB); PG8_STAGE(PG8_SA(0, 0), cA, voffA); PG8_STAGE(PG8_SA(0, 1), cA + hstepA, voffA);
        if (wr == 1) PG8_BAR;
        PG8_WAIT_V(2); PG8_BAR;
        PG8_STAGE(PG8_SB(1, 0), cB + kstep, voffB); PG8_STAGE(PG8_SA(1, 0), cA + kstep, voffA); PG8_STAGE(PG8_SB(1, 1), cB + hstepB + kstep, voffB);
        PG8_WAIT_V(6); PG8_BAR;
    } else {
        PG8_STAGE(PG8_SB(0, 0), cB, voffB); PG8_STAGE(PG8_SA(0, 0), cA, voffA); PG8_STAGE(PG8_SB(0, 1), cB + hstepB, voffB); PG8_STAGE(PG8_SA(0, 1), cA + hstepA, voffA);
        if (wr == 1) PG8_BAR;
        PG8_WAIT_V(4); PG8_BAR;
        PG8_STAGE(PG8_SB(1, 0), cB + kstep, voffB); PG8_STAGE(PG8_SA(1, 0), cA + kstep, voffA); PG8_STAGE(PG8_SB(1, 1), cB + hstepB + kstep, voffB);
        PG8_WAIT_V(6); PG8_BAR;
    }
    for (;;) {
        const bool has_next = S.next(ui + 1, nxt);
        const char* nA = has_next ? (const char*)g.A + (size_t)nxt.pm * tstepA + (size_t)nxt.pn * g.a_pn_off * 2 : cA; const char* nB = has_next ? (const char*)g.Bt + (size_t)nxt.pn * tstepB : cB;
        for (int t = 0; t < nt; t += 2) {
            const bool last = (t == nt - 2);
            const char* a1 = cA + (size_t)(t + 1) * kstep;
            const char* a2 = last ? nA : cA + (size_t)(t + 2) * kstep; const char* b2 = last ? nB : cB + (size_t)(t + 2) * kstep;
            const char* a3 = a2 + kstep; const char* b3 = b2 + kstep;
            if (last && has_next) S.a_ready(nxt);
            if constexpr (SP2) {
            PG8_LDB(B0, 0, 0); PG8_LDB(B1, 0, 1); PG8_SCHED; PG8_LDA(At, 0, 0); PG8_STAGE(PG8_SA(1, 1), a1 + hstepA, voffA);
            PG8_WAIT_V(8); PG8_WAIT_L(0); PG8_BAR; PG8_MMA(0, 0, At, B0); PG8_MMA(0, 1, At, B1); PG8_BAR; PG8_SCHED;
            PG8_LDA(At, 0, 1); PG8_STAGE(PG8_SB(0, 0), b2, voffB); PG8_STAGE(PG8_SB(0, 1), b2 + hstepB, voffB); PG8_STAGE(PG8_SA(0, 0), a2, voffA);
            PG8_WAIT_V(8); PG8_WAIT_L(0); PG8_BAR; PG8_MMA(1, 0, At, B0); PG8_MMA(1, 1, At, B1); PG8_BAR; PG8_SCHED;
            PG8_LDB(B0, 1, 0); PG8_LDB(B1, 1, 1); PG8_SCHED; PG8_LDA(At, 1, 0); PG8_STAGE(PG8_SA(0, 1), a2 + hstepA, voffA);
            PG8_WAIT_V(8); PG8_WAIT_L(0); PG8_BAR; PG8_MMA(0, 0, At, B0); PG8_MMA(0, 1, At, B1); PG8_BAR; PG8_SCHED;
            PG8_LDA(At, 1, 1); PG8_STAGE(PG8_SB(1, 0), b3, voffB); PG8_STAGE(PG8_SB(1, 1), b3 + hstepB, voffB); PG8_STAGE(PG8_SA(1, 0), a3, voffA);
            PG8_WAIT_V(8); PG8_WAIT_L(0); PG8_BAR; PG8_MMA(1, 0, At, B0); PG8_MMA(1, 1, At, B1); PG8_BAR; PG8_SCHED;
            } else {
            PG8_LDB(B0, 0, 0); PG8_SCHED; PG8_LDA(At, 0, 0); PG8_STAGE(PG8_SA(1, 1), a1 + hstepA, voffA);
            PG8_WAIT_L(8); PG8_BAR; PG8_WAIT_L(0); PG8_MMA(0, 0, At, B0); PG8_BAR; PG8_SCHED;
            PG8_LDB(B1, 0, 1); PG8_STAGE(PG8_SB(0, 0), b2, voffB);
            PG8_BAR; PG8_WAIT_L(0); PG8_MMA(0, 1, At, B1); PG8_BAR;
            PG8_LDA(At, 0, 1); PG8_STAGE(PG8_SA(0, 0), a2, voffA);
            PG8_BAR; PG8_WAIT_L(0); PG8_MMA(1, 0, At, B0); PG8_BAR; PG8_SCHED;
            PG8_STAGE(PG8_SB(0, 1), b2 + hstepB, voffB);
            PG8_WAIT_V(6); PG8_BAR; PG8_MMA(1, 1, At, B1); PG8_BAR;
            PG8_LDB(B0, 1, 0); PG8_SCHED; PG8_LDA(At, 1, 0); PG8_STAGE(PG8_SA(0, 1), a2 + hstepA, voffA);
            PG8_WAIT_L(8); PG8_BAR; PG8_WAIT_L(0); PG8_MMA(0, 0, At, B0); PG8_BAR; PG8_SCHED;
            PG8_LDB(B1, 1, 1); PG8_STAGE(PG8_SB(1, 0), b3, voffB);
            PG8_BAR; PG8_WAIT_L(0); PG8_MMA(0, 1, At, B1); PG8_BAR;
            PG8_LDA(At, 1, 1); PG8_STAGE(PG8_SA(1, 0), a3, voffA);
            PG8_BAR; PG8_WAIT_L(0); PG8_MMA(1, 0, At, B0); PG8_BAR; PG8_SCHED;
            PG8_STAGE(PG8_SB(1, 1), b3 + hstepB, voffB);
            PG8_WAIT_V(6); PG8_BAR; PG8_MMA(1, 1, At, B1); PG8_BAR;
            }
        }
        if constexpr (ALIGN_EPI) { if (wr == 0) PG8_BAR; }
        if constexpr (!Epi::AFTER_DRAIN) { E(acc, cur, wr, wc, fr, fq); S.done(cur); }
        if (!has_next) break;
#pragma unroll
        for (int a = 0; a < 2; ++a)
#pragma unroll
            for (int b = 0; b < 2; ++b)
#pragma unroll
                for (int m = 0; m < 4; ++m)
#pragma unroll
                    for (int n = 0; n < 2; ++n) acc[a][b][m][n] = (f32x4){0.f, 0.f, 0.f, 0.f};
        cur = nxt; cA = nA; cB = nB; ++ui;
        if constexpr (ALIGN_EPI) { if (wr == 1) PG8_BAR; }
    }
    PG8_WAIT_V(0);
    if constexpr (!ALIGN_EPI) { if (wr == 0) PG8_BAR; }
    PG8_BAR;
#undef PG8_SA
#undef PG8_SB
#undef PG8_STAGE
#undef PG8_LDA
#undef PG8_LDB
#undef PG8_MMA
#undef PG8_WAIT_V
#undef PG8_WAIT_L
#undef PG8_BAR
#undef PG8_SCHED
}
}

constexpr int NWAVES = 8;
constexpr int RING_OFF = 0, RING_BYTES = 131072;
constexpr int LDSCTL_OFF = RING_BYTES, MISC_OFF = LDSCTL_OFF + 320;
constexpr int LDS_BYTES = 147456;
constexpr int CW_BAR = 4096;
#define GAS __attribute__((address_space(1)))
#define LAS __attribute__((address_space(3)))
typedef GAS unsigned gu32;
#define RLX_AGENT __ATOMIC_RELAXED, __HIP_MEMORY_SCOPE_AGENT
#define XB_TMO      128
#define XB_XCNT(j)  (256  + 64 * (j))
#define XB_XSUB(j)  (1280 + 64 * (j))
#define XB_XGEN(j)  (2304 + 64 * (j))
#define XB_TOP      3328
#define XB_TOPGEN   3392
#define XCD_BAR_WORDS 3456
#define XB_SPIN_CAP (1u << 18)
__device__ __forceinline__ unsigned xb_ld(unsigned* p)              { return __hip_atomic_load(p, __ATOMIC_RELAXED, __HIP_MEMORY_SCOPE_AGENT); }
__device__ __forceinline__ unsigned xb_add(unsigned* p, unsigned v) { return __hip_atomic_fetch_add(p, v, __ATOMIC_RELAXED, __HIP_MEMORY_SCOPE_AGENT); }
__device__ __forceinline__ unsigned xb_xcc_id() { return (unsigned)__builtin_amdgcn_s_getreg((3 << 11) | 20) & 0xFu; }
#define XB_SPIN(cond, bar) do { unsigned _sp = 0; while (cond) { __builtin_amdgcn_s_sleep(1); \
    if ((++_sp & 255u) == 0u) { if (xb_ld(&(bar)[XB_TMO])) break; if (_sp > XB_SPIN_CAP) { atomicAdd(&(bar)[XB_TMO], 1u); break; } } } } while (0)
struct XcdBarrier { unsigned* bar; unsigned x; volatile LAS unsigned* st; };
__device__ __forceinline__ XcdBarrier xcd_barrier_post(unsigned* bar, volatile LAS unsigned* st) {
    XcdBarrier b; b.bar = bar; b.x = xb_xcc_id(); b.st = st;
    if (threadIdx.x == 0) (void)xb_add(&bar[XB_XCNT(b.x)], 1u);
    return b;
}
__device__ __forceinline__ void xcd_barrier_complete(unsigned* bar, unsigned x, unsigned& nloc, unsigned& nx) {
    const unsigned G = gridDim.x * gridDim.y * gridDim.z;
    unsigned sum, cnt, mine, sp = 0u;
    for (;;) {
        sum = 0u; cnt = 0u; mine = 0u;
#pragma unroll
        for (unsigned j = 0; j < 16; ++j) { const unsigned c = xb_ld(&bar[XB_XCNT(j)]); sum += c; cnt += (c > 0u) ? 1u : 0u; mine = (j == x) ? c : mine; }
        if (sum == G) break;
        __builtin_amdgcn_s_sleep(1);
        if ((++sp & 255u) == 0u) { if (xb_ld(&bar[XB_TMO])) break; if (sp > XB_SPIN_CAP) { atomicAdd(&bar[XB_TMO], 1u); break; } }
    }
    nloc = mine > 0u ? mine : 1u; nx = cnt > 0u ? cnt : 1u;
}
__device__ __forceinline__ void xcd_barrier(const XcdBarrier& b) {
    asm volatile("s_waitcnt vmcnt(0)" ::: "memory");
    __syncthreads();
    if (threadIdx.x == 0) {
        unsigned* bar = b.bar;
        __builtin_amdgcn_s_waitcnt(0);
        unsigned nloc = b.st[0], nx = b.st[1];
        if (nloc == 0u) { xcd_barrier_complete(bar, b.x, nloc, nx); b.st[0] = nloc; b.st[1] = nx; }
        const unsigned old = xb_add(&bar[XB_XSUB(b.x)], 1u);
        const unsigned gen = old / nloc;
        if (old + 1u == (gen + 1u) * nloc) {
            __builtin_amdgcn_fence(__ATOMIC_RELEASE, "agent");
            asm volatile("s_waitcnt vmcnt(0)" ::: "memory");
            const unsigned og = xb_add(&bar[XB_TOP], 1u);
            const unsigned tg = og / nx;
            if (og + 1u == (tg + 1u) * nx) xb_add(&bar[XB_TOPGEN], 1u);
            else XB_SPIN(xb_ld(&bar[XB_TOPGEN]) == tg, bar);
            __builtin_amdgcn_fence(__ATOMIC_ACQUIRE, "agent");
            xb_add(&bar[XB_XGEN(b.x)], 1u);
            asm volatile("s_waitcnt vmcnt(0)" ::: "memory");
        } else {
            XB_SPIN(xb_ld(&bar[XB_XGEN(b.x)]) == gen, bar);
            __builtin_amdgcn_fence(__ATOMIC_ACQUIRE, "agent");
            asm volatile("s_waitcnt vmcnt(0)" ::: "memory");
        }
    }
    __syncthreads();
}

struct MegaArgs { Params p; int ph_lo, ph_hi; };
constexpr int N_PHASES = 11;
__global__ void __launch_bounds__(NWAVES * 64, 2) mega_fwd(MegaArgs args) {
    extern __shared__ __attribute__((aligned(16))) unsigned char lds[];
    const Params& p = args.p;
    LAS unsigned char* ldsl = (LAS unsigned char*)lds;
    volatile LAS unsigned* MISC = (volatile LAS unsigned*)(ldsl + MISC_OFF);
    const int tid = threadIdx.x, lane = tid & 63, wave = __builtin_amdgcn_readfirstlane(tid >> 6);
    const int G = gridDim.x, bx = blockIdx.x;
    const int vcu = (G % 8 == 0) ? (bx % 8) * (G / 8) + bx / 8 : bx;
    for (int u = tid; u < (LDS_BYTES - LDSCTL_OFF) / 4; u += NWAVES * 64) ((LAS unsigned*)(ldsl + LDSCTL_OFF))[u] = 0u;
    __syncthreads();
    unsigned char* ws = p.ws;
    XcdBarrier bar = xcd_barrier_post((unsigned*)(ws + WS_CTL) + CW_BAR, MISC + 8);
    const int lo = args.ph_lo, hi = args.ph_hi;
    const int gw = vcu * NWAVES + wave, ngw = G * NWAVES;
#define IN(k) (lo <= (k) && (k) < hi)
#define SEAM(k) do { if (IN(k) && IN((k) + 1)) xcd_barrier(bar); } while (0)
    if (IN(0)) {
        float* scr = (float*)lds;
        mod_items(p, scr, bx, G);
        __syncthreads();
        weights_items(p, (float*)(lds + wave * 16384), gw, ngw, lane);
        caches_rope_items(p, (long)bx * 512 + tid, (long)G * 512);
    }
    SEAM(0);
    if (IN(1)) modulate_rows(p, 0, gw, ngw, lane);
    SEAM(1);
    if (IN(2)) {
        pg8::Gemm g{(const bf16_t*)(ws + WS_HY), (const bf16_t*)(ws + WS_WINE), MT, EVEN_IN, DM, DM, DM, 0}; pg8::StaticOrder S; S.init(MT, EVEN_IN, G, bx);
        pg8::EpiBf16 E{(bf16_t*)(ws + WS_PR), EVEN_IN, 0};
        pg8::gemm_phase<pg8::EpiBf16, pg8::StaticOrder, true, true>(ldsl + RING_OFF, g, S, E);
    }
    SEAM(2);
    if (IN(3)) post0_rows(p, gw, ngw, lane);
    SEAM(3);
    if (IN(4)) {
        { pg8::Gemm g{(const bf16_t*)(ws + WS_UA), (const bf16_t*)(ws + WS_POOLW), MT, 1024, 256, 1024, 256, 256}; pg8::StaticOrder S; S.init(MT, 1024, G, bx);
          pg8::EpiPoolF E{(bf16_t*)(ws + WS_HY), (const bf16_t*)(ws + WS_PR), p.pool_scale};
          pg8::gemm_phase<pg8::EpiPoolF, pg8::StaticOrder, true, true>(ldsl + RING_OFF, g, S, E); }
        __syncthreads();
        diffattn_tasks(p, (float*)(lds + wave * 16384), gw, ngw, lane);
    }
    SEAM(4);
    if (IN(5)) {
        pg8::Gemm g{(const bf16_t*)(ws + WS_HY), (const bf16_t*)(ws + WS_WOUTE), MT, DM, DM, DM, DM, 0}; pg8::StaticOrder S; S.init(MT, DM, G, bx);
        pg8::EpiResidF E{p.x_prompt, p.x_sample, nullptr, (const float*)(ws + WS_MOD) + 4096, p.out};
        pg8::gemm_phase<pg8::EpiResidF, pg8::StaticOrder, true, true>(ldsl + RING_OFF, g, S, E);
    }
    SEAM(5);
    if (IN(6)) modulate_rows(p, 1, gw, ngw, lane);
    SEAM(6);
    if (IN(7)) {
        pg8::Gemm g{(const bf16_t*)(ws + WS_HY), (const bf16_t*)(ws + WS_WINO), MT, ODD_IN, DM, DM, DM, 0}; pg8::StaticOrder S; S.init(MT, ODD_IN, G, bx);
        pg8::EpiBf16 E{(bf16_t*)(ws + WS_PR), ODD_IN, 0};
        pg8::gemm_phase<pg8::EpiBf16, pg8::StaticOrder, true, true>(ldsl + RING_OFF, g, S, E);
    }
    SEAM(7);
    if (IN(8)) post1_rows(p, gw, ngw, lane);
    SEAM(8);
    if (IN(9)) gqa_tasks(p, (float*)(lds + wave * 16384), gw, ngw, lane);
    SEAM(9);
    if (IN(10)) {
        pg8::Gemm g{(const bf16_t*)(ws + WS_HY), (const bf16_t*)(ws + WS_WOUTO), MT, DM, DM, DM, DM, 0}; pg8::StaticOrder S; S.init(MT, DM, G, bx);
        pg8::EpiResidF E{p.x_prompt, p.x_sample, p.out, (const float*)(ws + WS_MOD) + 3 * 6144 + 4096, p.out};
        pg8::gemm_phase<pg8::EpiResidF, pg8::StaticOrder, true, true>(ldsl + RING_OFF, g, S, E);
    }
#undef IN
#undef SEAM
}

#ifndef MK_PER_PHASE
#define MK_PER_PHASE 0
#endif
extern "C" void kernel_launch(void* const* d_in, const int* in_sizes, int n_in, void* d_out, int out_size, void* d_ws, size_t ws_size, hipStream_t stream) {
    if (n_in != 26 || ws_size < WS_END || out_size != MT * DM + 2 * NBP * HA * SEQP * 128 + 2 * NBP * KVH * SEQP * 128) {
        fprintf(stderr, "kernel_launch: unexpected shapes n_in %d ws %zu out %d\n", n_in, ws_size, out_size); return; }
    static int ready = 0;
    if (!ready) {
        if (hipFuncSetAttribute((const void*)mega_fwd, hipFuncAttributeMaxDynamicSharedMemorySize, LDS_BYTES) != hipSuccess) { fprintf(stderr, "kernel_launch: hipFuncSetAttribute failed\n"); return; }
        ready = 1;
    }
    MegaArgs a{};
    const float** pin = (const float**)&a.p;
    for (int i = 0; i < 26; ++i) pin[i] = (const float*)d_in[i];
    a.p.out = (float*)d_out; a.p.ws = (unsigned char*)d_ws;
    (void)hipMemsetAsync((unsigned char*)d_ws + WS_CTL, 0, 2 * MiB, stream);
#if MK_PER_PHASE
    for (int ph = 0; ph < N_PHASES; ++ph) { a.ph_lo = ph; a.ph_hi = ph + 1; hipLaunchKernelGGL(mega_fwd, dim3(256), dim3(NWAVES * 64), LDS_BYTES, stream, a); }
#else
    a.ph_lo = 0; a.ph_hi = N_PHASES; hipLaunchKernelGGL(mega_fwd, dim3(256), dim3(NWAVES * 64), LDS_BYTES, stream, a);
#endif
}
```

```cpp
#include <hip/hip_runtime.h>
#include <cstdio>
#include <cstdint>

typedef unsigned short bf16_t;
typedef float f32x4 __attribute__((ext_vector_type(4)));
typedef unsigned u32x4 __attribute__((ext_vector_type(4)));
typedef unsigned u32x2 __attribute__((ext_vector_type(2)));

constexpr int DM = 2048, NBP = 32, SEQP = 256, NBS = 2, SEQS = 1024, PAST = 256;
constexpr int MP = NBP * SEQP, MS = NBS * SEQS, MT = MP + MS;
constexpr int HA = 8, DKA = 64, DVA = 128, WA = 1024, WB = 1024, GWB = 256;
constexpr int EVEN_IN = 6144, ODD_IN = 5120;
constexpr int HC = 16, KVH = 4, HDC = 128;
constexpr int LKS = PAST + SEQS;
constexpr float EPS = 1e-6f;
constexpr float LOG2E = 1.4426950408889634f;
constexpr float C2A = 0.125f * LOG2E;
constexpr float C2C = 0.08838834764831845f * LOG2E;

constexpr size_t MiB = 1u << 20;
constexpr size_t WS_CTL = 0;
constexpr size_t WS_MOD = 1 * MiB;
constexpr size_t WS_ROPE = 2 * MiB;
constexpr size_t WS_WINE = 4 * MiB;
constexpr size_t WS_WOUTE = 28 * MiB;
constexpr size_t WS_WINO = 36 * MiB;
constexpr size_t WS_WOUTO = 56 * MiB;
constexpr size_t WS_POOLW = 64 * MiB;
constexpr size_t WS_HY = 65 * MiB;
constexpr size_t WS_PR = 105 * MiB;
constexpr size_t WS_Q = 225 * MiB;
constexpr size_t WS_KP = 265 * MiB;
constexpr size_t WS_VP = 281 * MiB;
constexpr size_t WS_KSA = 297 * MiB;
constexpr size_t WS_VSA = 302 * MiB;
constexpr size_t WS_KSC = 307 * MiB;
constexpr size_t WS_VSC = 310 * MiB;
constexpr size_t WS_UA = 313 * MiB;
constexpr size_t WS_END = 333 * MiB;

struct Params {
    const float* x_prompt; const float* x_sample; const float* cache_a_k; const float* cache_a_v; const float* cache_c_k; const float* cache_c_v;
    const float* c; const float* c_ctx; const float* norm_w; const float* ada_w; const float* ada_b;
    const float* even_w_in; const float* even_q_norm_w; const float* even_k_norm_w; const float* lam_q1; const float* lam_k1; const float* lam_q2; const float* lam_k2;
    const float* subln_w; const float* pool_w; const float* pool_scale; const float* even_w_out;
    const float* gqa_w_in; const float* gqa_q_norm_w; const float* gqa_k_norm_w; const float* gqa_w_out;
    float* out; unsigned char* ws;
};

__device__ __forceinline__ unsigned f2bf(float f) { unsigned u = __builtin_bit_cast(unsigned, f); return (u + 0x7fffu + ((u >> 16) & 1u)) >> 16; }
__device__ __forceinline__ unsigned pk2(float lo, float hi) { return f2bf(lo) | (f2bf(hi) << 16); }
__device__ __forceinline__ float bf2f(unsigned h) { return __builtin_bit_cast(float, h << 16); }
__device__ __forceinline__ float bflo(unsigned w) { return __builtin_bit_cast(float, w << 16); }
__device__ __forceinline__ float bfhi(unsigned w) { return __builtin_bit_cast(float, w & 0xffff0000u); }
__device__ __forceinline__ float siluf(float x) { return x / (1.f + __expf(-x)); }
__device__ __forceinline__ float wave_sum(float v) {
#pragma unroll
    for (int o = 1; o < 64; o <<= 1) v += __shfl_xor(v, o);
    return v;
}
__device__ __forceinline__ float wave_max(float v) {
#pragma unroll
    for (int o = 1; o < 64; o <<= 1) v = fmaxf(v, __shfl_xor(v, o));
    return v;
}
__device__ __forceinline__ int fresh_lane() { int l; asm volatile("v_mbcnt_lo_u32_b32 %0, -1, 0\n\tv_mbcnt_hi_u32_b32 %0, -1, %0" : "=v"(l)); return l; }
__device__ __forceinline__ const float* xrow_ptr(const Params& p, int m) { return m < MP ? p.x_prompt + (size_t)m * DM : p.x_sample + (size_t)(m - MP) * DM; }
__device__ __forceinline__ int cond_row(int m) { return m < MP ? 0 : 1 + ((m - MP) >> 10); }

__device__ __forceinline__ void mod_items(const Params& p, float* sl  , int bid, int nb, int tid, int nthr) {
    float* mod = (float*)(p.ws + WS_MOD);
    for (int it = bid; it < 256; it += nb) {
        const int l = it >> 7, kc = (it >> 2) & 31, nc = it & 3;
        __syncthreads();
        for (int i = tid; i < 192; i += nthr) { const int r = i >> 6, kk = i & 63, k = kc * 64 + kk; const float cv = r == 0 ? p.c_ctx[k] : p.c[(r - 1) * DM + k]; sl[i] = siluf(cv); }
        __syncthreads();
        for (int q = tid; q < 384; q += nthr) {
            const int n = nc * 1536 + q * 4;
            const float* w = p.ada_w + ((size_t)l * DM + kc * 64) * 6144 + n;
            f32x4 a0 = {0.f, 0.f, 0.f, 0.f}, a1 = a0, a2 = a0;
#pragma unroll 16
            for (int kk = 0; kk < 64; ++kk) { const f32x4 wv = *(const f32x4*)(w + (size_t)kk * 6144); a0 += wv * sl[kk]; a1 += wv * sl[64 + kk]; a2 += wv * sl[128 + kk]; }
            if (kc == 0) { const f32x4 b = *(const f32x4*)(p.ada_b + l * 6144 + n); a0 += b; a1 += b; a2 += b; }
            float* m0 = mod + (size_t)(l * 3) * 6144 + n;
#pragma unroll
            for (int e = 0; e < 4; ++e) { atomicAdd(m0 + e, a0[e]); atomicAdd(m0 + 6144 + e, a1[e]); atomicAdd(m0 + 2 * 6144 + e, a2[e]); }
        }
    }
}

__device__ __forceinline__ void transpose_item(const float* W, int K, int N, bf16_t* WT, float* scr, int item, int lane) {
    const int nblk = N / 32, kb = item / nblk, nb = item % nblk, k0 = 64 * kb, n0 = 32 * nb;
#pragma unroll 8
    for (int i = 0; i < 32; ++i) { const int kk = 2 * i + (lane >> 5); scr[kk * 33 + (lane & 31)] = W[(size_t)(k0 + kk) * N + n0 + (lane & 31)]; }
    __builtin_amdgcn_s_waitcnt(0xc07f); asm volatile("" ::: "memory");
    const int c = lane & 7;
#pragma unroll
    for (int j = 0; j < 4; ++j) { const int n = (lane >> 3) + 8 * j; const float* s = scr + (8 * c) * 33 + n;
        u32x4 o; o.x = pk2(s[0 * 33], s[1 * 33]); o.y = pk2(s[2 * 33], s[3 * 33]); o.z = pk2(s[4 * 33], s[5 * 33]); o.w = pk2(s[6 * 33], s[7 * 33]);
        *(u32x4*)(WT + (size_t)(n0 + n) * K + k0 + 8 * c) = o; }
    __builtin_amdgcn_s_waitcnt(0xc07f); asm volatile("" ::: "memory");
}
__device__ __forceinline__ void weights_items(const Params& p, float* scr  , int gw, int ngw, int lane) {
    constexpr int I_WINE = 32 * (EVEN_IN / 32), I_WOUT = 32 * (DM / 32), I_WINO = 32 * (ODD_IN / 32), I_POOL = 4 * (256 / 32);
    constexpr int NITEMS = I_WINE + I_WOUT + I_WINO + I_WOUT + 4 * I_POOL;
    for (int it = gw; it < NITEMS; it += ngw) {
        int r = it;
        if (r < I_WINE) { transpose_item(p.even_w_in, DM, EVEN_IN, (bf16_t*)(p.ws + WS_WINE), scr, r, lane); continue; } r -= I_WINE;
        if (r < I_WOUT) { transpose_item(p.even_w_out, DM, DM, (bf16_t*)(p.ws + WS_WOUTE), scr, r, lane); continue; } r -= I_WOUT;
        if (r < I_WINO) { transpose_item(p.gqa_w_in, DM, ODD_IN, (bf16_t*)(p.ws + WS_WINO), scr, r, lane); continue; } r -= I_WINO;
        if (r < I_WOUT) { transpose_item(p.gqa_w_out, DM, DM, (bf16_t*)(p.ws + WS_WOUTO), scr, r, lane); continue; } r -= I_WOUT;
        const int g = r / I_POOL; r -= g * I_POOL;
        transpose_item(p.pool_w + (size_t)g * 65536, 256, 256, (bf16_t*)(p.ws + WS_POOLW) + (size_t)g * 65536, scr, r, lane);
    }
}
__device__ __forceinline__ void caches_rope_items(const Params& p, long gt, long ngt) {
    constexpr long NA = 2L * 8 * 256 * 128 / 4, NC = 2L * 4 * 256 * 128 / 4;
    for (long i = gt; i < 2 * NA + 2 * NC; i += ngt) {
        long j = i; const float* src; bf16_t* dst;
        if (j < NA) { src = p.cache_a_k; dst = (bf16_t*)(p.ws + WS_KSA); } else if ((j -= NA) < NA) { src = p.cache_a_v; dst = (bf16_t*)(p.ws + WS_VSA); }
        else if ((j -= NA) < NC) { src = p.cache_c_k; dst = (bf16_t*)(p.ws + WS_KSC); } else { j -= NC; src = p.cache_c_v; dst = (bf16_t*)(p.ws + WS_VSC); }
        const long e = j * 4, bh = e / (256 * 128), rem = e % (256 * 128);
        const f32x4 v = *(const f32x4*)(src + e);
        u32x2 o; o.x = pk2(v[0], v[1]); o.y = pk2(v[2], v[3]);
        *(u32x2*)(dst + bh * (LKS * 128) + rem) = o;
    }
    float* ropeA = (float*)(p.ws + WS_ROPE); float* ropeC = ropeA + 2 * 1024 * 64;
    for (long i = gt; i < 1024L * 64 + 1024L * 128; i += ngt) {
        const bool isA = i < 1024L * 64; const long j = isA ? i : i - 1024L * 64; const int dim = isA ? 64 : 128, quarter = dim / 4;
        const int t = (int)(j / dim), d = (int)(j % dim); const int qd = d / quarter, fi = d % quarter;
        const float freq = powf(10000.0f, -(float)fi / (float)quarter);
        const float pos = (qd < 2) ? (float)(t / 64) : (float)(t % 64);
        const float ang = pos * freq;
        float* base = isA ? ropeA : ropeC;
        base[j] = cosf(ang); base[(size_t)1024 * dim + j] = sinf(ang);
    }
}

__device__ __forceinline__ void modulate_rows(const Params& p, int layer, int gw, int ngw, int lane) {
    const float* mod = (const float*)(p.ws + WS_MOD) + (size_t)layer * 3 * 6144;
    const float* nw = p.norm_w + layer * DM;
    bf16_t* H = (bf16_t*)(p.ws + WS_HY);
    for (int m = gw; m < MT; m += ngw) {
        const float* xr = layer == 0 ? xrow_ptr(p, m) : p.out + (size_t)m * DM;
        const float* mr = mod + (size_t)cond_row(m) * 6144;
        f32x4 v[8]; float ss = 0.f;
#pragma unroll
        for (int j = 0; j < 8; ++j) { v[j] = *(const f32x4*)(xr + 4 * lane + 256 * j); ss += (v[j][0] * v[j][0] + v[j][1] * v[j][1]) + (v[j][2] * v[j][2] + v[j][3] * v[j][3]); }
        const float rstd = 1.0f / sqrtf(wave_sum(ss) * (1.f / DM) + EPS);
#pragma unroll
        for (int j = 0; j < 8; ++j) { const int k = 4 * lane + 256 * j;
            const f32x4 w = *(const f32x4*)(nw + k), sh = *(const f32x4*)(mr + k), sc = *(const f32x4*)(mr + 2048 + k);
            const f32x4 h = v[j] * rstd * w * (sc + 1.0f) + sh;
            u32x2 o; o.x = pk2(h[0], h[1]); o.y = pk2(h[2], h[3]);
            *(u32x2*)(H + (size_t)m * DM + k) = o; }
    }
}

template <int DIM>
__device__ __forceinline__ f32x4 norm_rope4(f32x4 v, int lg  , const float* w, bool rope, const float* cosr, const float* sinr) {
    float ss = (v[0] * v[0] + v[1] * v[1]) + (v[2] * v[2] + v[3] * v[3]);
#pragma unroll
    for (int o = 1; o < DIM / 4; o <<= 1) ss += __shfl_xor(ss, o);
    const float r = 1.0f / sqrtf(ss * (1.f / DIM) + EPS);
    const f32x4 wv = *(const f32x4*)(w + 4 * lg);
    f32x4 y = v * r * wv;
    f32x4 pr;
#pragma unroll
    for (int e = 0; e < 4; ++e) pr[e] = __shfl_xor(y[e], DIM / 16);
    if (rope) {
        const f32x4 cs = *(const f32x4*)(cosr + 4 * lg), sn = *(const f32x4*)(sinr + 4 * lg);
        const bool odd = ((lg / (DIM / 16)) & 1) != 0;
        y = odd ? (y * cs + pr * sn) : (y * cs - pr * sn);
    }
    return y;
}

__device__ __forceinline__ void post0_rows(const Params& p, int gw, int ngw, int lane) {
    const bf16_t* PR = (const bf16_t*)(p.ws + WS_PR);
    bf16_t* QA = (bf16_t*)(p.ws + WS_Q); bf16_t* UA = (bf16_t*)(p.ws + WS_UA);
    const float* ropeA = (const float*)(p.ws + WS_ROPE);
    float* new_a_k = p.out + (size_t)MT * DM; float* new_a_v = new_a_k + (size_t)NBP * HA * SEQP * 128;
    for (int m = gw; m < MT; m += ngw) {
        const bool smp = m >= MP; const int b = smp ? (m - MP) >> 10 : m >> 8, t = smp ? (m - MP) & 1023 : m & 255;
        const bf16_t* pr = PR + (size_t)m * EVEN_IN;
        const float* cosr = ropeA + (size_t)t * 64; const float* sinr = ropeA + 1024 * 64 + (size_t)t * 64;
        const int sub = lane >> 4, lg = lane & 15;
#pragma unroll 2
        for (int st = 0; st < 8; ++st) {
            const int grp = st * 4 + sub;
            const u32x2 raw = *(const u32x2*)(pr + grp * 64 + 4 * lg);
            f32x4 v = {bflo(raw.x), bfhi(raw.x), bflo(raw.y), bfhi(raw.y)};
            const bool isk = grp >= 16;
            f32x4 y = norm_rope4<64>(v, lg, isk ? p.even_k_norm_w : p.even_q_norm_w, smp, cosr, sinr);
            if (!isk) { y = y * C2A; u32x2 o; o.x = pk2(y[0], y[1]); o.y = pk2(y[2], y[3]); *(u32x2*)(QA + (size_t)m * 1024 + grp * 64 + 4 * lg) = o; }
            else { const int g2 = grp - 16, h = g2 >> 1, j = g2 & 1;
                u32x2 o; o.x = pk2(y[0], y[1]); o.y = pk2(y[2], y[3]);
                if (smp) *(u32x2*)((bf16_t*)(p.ws + WS_KSA) + ((size_t)(b * HA + h) * LKS + PAST + t) * 128 + j * 64 + 4 * lg) = o;
                else { const size_t off = ((size_t)(b * HA + h) * SEQP + t) * 128 + j * 64 + 4 * lg; *(u32x2*)((bf16_t*)(p.ws + WS_KP) + off) = o; *(f32x4*)(new_a_k + off) = y; } }
        }
#pragma unroll
        for (int i = 0; i < 2; ++i) { const int c = 8 * lane + 512 * i, h = c >> 7, d = c & 127;
            const u32x4 raw = *(const u32x4*)(pr + 2048 + c);
            if (smp) *(u32x4*)((bf16_t*)(p.ws + WS_VSA) + ((size_t)(b * HA + h) * LKS + PAST + t) * 128 + d) = raw;
            else { const size_t off = ((size_t)(b * HA + h) * SEQP + t) * 128 + d; *(u32x4*)((bf16_t*)(p.ws + WS_VP) + off) = raw;
                *(f32x4*)(new_a_v + off) = (f32x4){bflo(raw.x), bfhi(raw.x), bflo(raw.y), bfhi(raw.y)}; *(f32x4*)(new_a_v + off + 4) = (f32x4){bflo(raw.z), bfhi(raw.z), bflo(raw.w), bfhi(raw.w)}; } }
        const int L = smp ? SEQS : SEQP;
#pragma unroll
        for (int i = 0; i < 2; ++i) { const int ch = lane + 64 * i, c = 8 * ch, g = ch >> 5, half = 1 << g;
            const int lo = max(t - half, 0), hi = min(t + half, L);
            float s[8] = {0.f, 0.f, 0.f, 0.f, 0.f, 0.f, 0.f, 0.f};
            for (int tt = lo; tt < hi; ++tt) { const u32x4 raw = *(const u32x4*)(pr + (ptrdiff_t)(tt - t) * EVEN_IN + 3072 + c);
                s[0] += bflo(raw.x); s[1] += bfhi(raw.x); s[2] += bflo(raw.y); s[3] += bfhi(raw.y); s[4] += bflo(raw.z); s[5] += bfhi(raw.z); s[6] += bflo(raw.w); s[7] += bfhi(raw.w); }
            const float inv = 1.0f / (float)(hi - lo);
            const u32x4 own = *(const u32x4*)(pr + 3072 + c);
            u32x4 o; o.x = pk2(s[0] * inv - bflo(own.x), s[1] * inv - bfhi(own.x)); o.y = pk2(s[2] * inv - bflo(own.y), s[3] * inv - bfhi(own.y));
            o.z = pk2(s[4] * inv - bflo(own.z), s[5] * inv - bfhi(own.z)); o.w = pk2(s[6] * inv - bflo(own.w), s[7] * inv - bfhi(own.w));
            *(u32x4*)(UA + (size_t)m * 1024 + c) = o; }
    }
}

__device__ __forceinline__ void post1_rows(const Params& p, int gw, int ngw, int lane) {
    const bf16_t* PR = (const bf16_t*)(p.ws + WS_PR);
    bf16_t* QC = (bf16_t*)(p.ws + WS_Q);
    const float* ropeC = (const float*)(p.ws + WS_ROPE) + 2 * 1024 * 64;
    float* new_c_k = p.out + (size_t)MT * DM + 2 * (size_t)NBP * HA * SEQP * 128; float* new_c_v = new_c_k + (size_t)NBP * KVH * SEQP * 128;
    for (int m = gw; m < MT; m += ngw) {
        const bool smp = m >= MP; const int b = smp ? (m - MP) >> 10 : m >> 8, t = smp ? (m - MP) & 1023 : m & 255;
        const bf16_t* pr = PR + (size_t)m * ODD_IN;
        const float* cosr = ropeC + (size_t)t * 128; const float* sinr = ropeC + 1024 * 128 + (size_t)t * 128;
        const int sub = lane >> 5, lg = lane & 31;
#pragma unroll 2
        for (int st = 0; st < 10; ++st) {
            const int grp = st * 2 + sub;
            const u32x2 raw = *(const u32x2*)(pr + grp * 128 + 4 * lg);
            f32x4 v = {bflo(raw.x), bfhi(raw.x), bflo(raw.y), bfhi(raw.y)};
            const bool isk = grp >= 16;
            f32x4 y = norm_rope4<128>(v, lg, isk ? p.gqa_k_norm_w : p.gqa_q_norm_w, smp, cosr, sinr);
            if (!isk) { y = y * C2C; u32x2 o; o.x = pk2(y[0], y[1]); o.y = pk2(y[2], y[3]); *(u32x2*)(QC + (size_t)m * DM + grp * 128 + 4 * lg) = o; }
            else { const int kh = grp - 16;
                u32x2 o; o.x = pk2(y[0], y[1]); o.y = pk2(y[2], y[3]);
                if (smp) *(u32x2*)((bf16_t*)(p.ws + WS_KSC) + ((size_t)(b * KVH + kh) * LKS + PAST + t) * 128 + 4 * lg) = o;
                else { const size_t off = ((size_t)(b * KVH + kh) * SEQP + t) * 128 + 4 * lg; *(u32x2*)((bf16_t*)(p.ws + WS_KP) + off) = o; *(f32x4*)(new_c_k + off) = y; } }
        }
        { const int c = 8 * lane, kh = c >> 7, d = c & 127;
            const u32x4 raw = *(const u32x4*)(pr + 2560 + c);
            if (smp) *(u32x4*)((bf16_t*)(p.ws + WS_VSC) + ((size_t)(b * KVH + kh) * LKS + PAST + t) * 128 + d) = raw;
            else { const size_t off = ((size_t)(b * KVH + kh) * SEQP + t) * 128 + d; *(u32x4*)((bf16_t*)(p.ws + WS_VP) + off) = raw;
                *(f32x4*)(new_c_v + off) = (f32x4){bflo(raw.x), bfhi(raw.x), bflo(raw.y), bfhi(raw.y)}; *(f32x4*)(new_c_v + off + 4) = (f32x4){bflo(raw.z), bfhi(raw.z), bflo(raw.w), bfhi(raw.w)}; } }
    }
}

struct EpiStoreBf16 { bf16_t* C; int ldc; int pad; __device__ void operator()(int r, int c, float v) const { C[(size_t)r * ldc + c] = (bf16_t)f2bf(v); } };
struct EpiPool { bf16_t* Y; const bf16_t* PR; const float* pscale; int g; int pad;
    __device__ void operator()(int r, int c, float v) const { const int cc = g * 256 + c; const float gt = bf2f(PR[(size_t)r * EVEN_IN + 4096 + 1024 + cc]);
        Y[(size_t)r * DM + 1024 + cc] = (bf16_t)f2bf(v * pscale[cc] * siluf(gt)); } };
struct EpiResid { const float* x_prompt; const float* x_sample; const float* base; const float* gate; float* out;
    __device__ void operator()(int r, int c, float v) const { const float bs = base ? base[(size_t)r * DM + c] : (r < MP ? x_prompt[(size_t)r * DM + c] : x_sample[(size_t)(r - MP) * DM + c]);
        out[(size_t)r * DM + c] = bs + gate[(size_t)cond_row(r) * 6144 + c] * v; } };
template <class Epi>
__global__ __launch_bounds__(256) void gemm_naive(const bf16_t* A, int lda, const bf16_t* Bt, int ldb, int M, int N, int K, Epi E) {
    __shared__ float As[16][65], Bs[16][65];
    const int tid = threadIdx.x, tx = tid & 15, ty = tid >> 4;
    const int nbn = N / 64, bm = blockIdx.x / nbn, bn = blockIdx.x % nbn;
    float acc[4][4] = {};
    const int lr = tid >> 2, lc = (tid & 3) * 4;
    for (int k0 = 0; k0 < K; k0 += 16) {
        const u32x2 ra = *(const u32x2*)(A + (size_t)(bm * 64 + lr) * lda + k0 + lc), rb = *(const u32x2*)(Bt + (size_t)(bn * 64 + lr) * ldb + k0 + lc);
        __syncthreads();
        As[lc + 0][lr] = bflo(ra.x); As[lc + 1][lr] = bfhi(ra.x); As[lc + 2][lr] = bflo(ra.y); As[lc + 3][lr] = bfhi(ra.y);
        Bs[lc + 0][lr] = bflo(rb.x); Bs[lc + 1][lr] = bfhi(rb.x); Bs[lc + 2][lr] = bflo(rb.y); Bs[lc + 3][lr] = bfhi(rb.y);
        __syncthreads();
#pragma unroll
        for (int kk = 0; kk < 16; ++kk) { float a[4], b[4];
#pragma unroll
            for (int i = 0; i < 4; ++i) { a[i] = As[kk][ty * 4 + i]; b[i] = Bs[kk][tx * 4 + i]; }
#pragma unroll
            for (int i = 0; i < 4; ++i)
#pragma unroll
                for (int j = 0; j < 4; ++j) acc[i][j] += a[i] * b[j]; }
    }
#pragma unroll
    for (int i = 0; i < 4; ++i)
#pragma unroll
        for (int j = 0; j < 4; ++j) E(bm * 64 + ty * 4 + i, bn * 64 + tx * 4 + j, acc[i][j]);
}

__device__ __forceinline__ void diffattn_tasks(const Params& p, float* s1  , long gw, long ngw, int lane) {
    float* s2 = s1 + LKS; float* qs = s2 + LKS;
    const bf16_t* QA = (const bf16_t*)(p.ws + WS_Q); const bf16_t* PR = (const bf16_t*)(p.ws + WS_PR); bf16_t* Y = (bf16_t*)(p.ws + WS_HY);
    const float lam_init = 0.2f;
    const float lam = expf(wave_sum(p.lam_q1[lane] * p.lam_k1[lane])) - expf(wave_sum(p.lam_q2[lane] * p.lam_k2[lane])) + lam_init;
    for (long task = gw; task < (long)MT * HA; task += ngw) {
        const int m = (int)(task / HA), h = (int)(task % HA);
        const bool smp = m >= MP; const int b = smp ? (m - MP) >> 10 : m >> 8; const int Lk = smp ? LKS : SEQP;
        const bf16_t* Kb = smp ? (const bf16_t*)(p.ws + WS_KSA) + (size_t)(b * HA + h) * LKS * 128 : (const bf16_t*)(p.ws + WS_KP) + (size_t)(b * HA + h) * SEQP * 128;
        const bf16_t* Vb = smp ? (const bf16_t*)(p.ws + WS_VSA) + (size_t)(b * HA + h) * LKS * 128 : (const bf16_t*)(p.ws + WS_VP) + (size_t)(b * HA + h) * SEQP * 128;
        { const unsigned w = *(const unsigned*)(QA + (size_t)m * 1024 + h * 128 + 2 * lane); qs[2 * lane] = bflo(w); qs[2 * lane + 1] = bfhi(w); }
        __builtin_amdgcn_s_waitcnt(0xc07f); asm volatile("" ::: "memory");
        float m1 = -1e30f, m2 = -1e30f;
        for (int j = lane; j < Lk; j += 64) { const bf16_t* kr = Kb + (size_t)j * 128; float a1 = 0.f, a2 = 0.f;
#pragma unroll
            for (int d8 = 0; d8 < 8; ++d8) { const u32x4 w1 = *(const u32x4*)(kr + d8 * 8), w2 = *(const u32x4*)(kr + 64 + d8 * 8); const float* q1 = qs + d8 * 8; const float* q2 = qs + 64 + d8 * 8;
                a1 += q1[0] * bflo(w1.x) + q1[1] * bfhi(w1.x) + q1[2] * bflo(w1.y) + q1[3] * bfhi(w1.y) + q1[4] * bflo(w1.z) + q1[5] * bfhi(w1.z) + q1[6] * bflo(w1.w) + q1[7] * bfhi(w1.w);
                a2 += q2[0] * bflo(w2.x) + q2[1] * bfhi(w2.x) + q2[2] * bflo(w2.y) + q2[3] * bfhi(w2.y) + q2[4] * bflo(w2.z) + q2[5] * bfhi(w2.z) + q2[6] * bflo(w2.w) + q2[7] * bfhi(w2.w); }
            s1[j] = a1; s2[j] = a2; m1 = fmaxf(m1, a1); m2 = fmaxf(m2, a2); }
        m1 = wave_max(m1); m2 = wave_max(m2);
        float l1 = 0.f, l2 = 0.f;
        for (int j = lane; j < Lk; j += 64) { const float e1 = exp2f(s1[j] - m1), e2 = exp2f(s2[j] - m2); s1[j] = e1; s2[j] = e2; l1 += e1; l2 += e2; }
        l1 = wave_sum(l1); l2 = wave_sum(l2);
        const float i1 = 1.f / l1, i2 = lam / l2;
        for (int j = lane; j < Lk; j += 64) s1[j] = s1[j] * i1 - s2[j] * i2;
        __builtin_amdgcn_s_waitcnt(0xc07f); asm volatile("" ::: "memory");
        float o0 = 0.f, o1 = 0.f;
        for (int j = 0; j < Lk; ++j) { const unsigned w = *(const unsigned*)(Vb + (size_t)j * 128 + 2 * lane); const float pj = s1[j]; o0 += pj * bflo(w); o1 += pj * bfhi(w); }
        const float r = 1.0f / sqrtf(wave_sum(o0 * o0 + o1 * o1) * (1.f / 128.f) + EPS);
        const unsigned gw = *(const unsigned*)(PR + (size_t)m * EVEN_IN + 4096 + h * 128 + 2 * lane);
        const float y0 = o0 * r * p.subln_w[2 * lane] * (1.f - lam_init) * siluf(bflo(gw)), y1 = o1 * r * p.subln_w[2 * lane + 1] * (1.f - lam_init) * siluf(bfhi(gw));
        *(unsigned*)(Y + (size_t)m * DM + h * 128 + 2 * lane) = pk2(y0, y1);
        __builtin_amdgcn_s_waitcnt(0xc07f); asm volatile("" ::: "memory");
    }
}
__device__ __forceinline__ void gqa_tasks(const Params& p, float* s1  , long gw, long ngw, int lane) {
    float* qs = s1 + LKS;
    const bf16_t* QC = (const bf16_t*)(p.ws + WS_Q); const bf16_t* PR = (const bf16_t*)(p.ws + WS_PR); bf16_t* Y = (bf16_t*)(p.ws + WS_HY);
    for (long task = gw; task < (long)MT * HC; task += ngw) {
        const int m = (int)(task / HC), hq = (int)(task % HC), kh = hq >> 2;
        const bool smp = m >= MP; const int b = smp ? (m - MP) >> 10 : m >> 8; const int Lk = smp ? LKS : SEQP;
        const bf16_t* Kb = smp ? (const bf16_t*)(p.ws + WS_KSC) + (size_t)(b * KVH + kh) * LKS * 128 : (const bf16_t*)(p.ws + WS_KP) + (size_t)(b * KVH + kh) * SEQP * 128;
        const bf16_t* Vb = smp ? (const bf16_t*)(p.ws + WS_VSC) + (size_t)(b * KVH + kh) * LKS * 128 : (const bf16_t*)(p.ws + WS_VP) + (size_t)(b * KVH + kh) * SEQP * 128;
        { const unsigned w = *(const unsigned*)(QC + (size_t)m * DM + hq * 128 + 2 * lane); qs[2 * lane] = bflo(w); qs[2 * lane + 1] = bfhi(w); }
        __builtin_amdgcn_s_waitcnt(0xc07f); asm volatile("" ::: "memory");
        float m1 = -1e30f;
        for (int j = lane; j < Lk; j += 64) { const bf16_t* kr = Kb + (size_t)j * 128; float a1 = 0.f;
#pragma unroll
            for (int d8 = 0; d8 < 16; ++d8) { const u32x4 w1 = *(const u32x4*)(kr + d8 * 8); const float* q1 = qs + d8 * 8;
                a1 += q1[0] * bflo(w1.x) + q1[1] * bfhi(w1.x) + q1[2] * bflo(w1.y) + q1[3] * bfhi(w1.y) + q1[4] * bflo(w1.z) + q1[5] * bfhi(w1.z) + q1[6] * bflo(w1.w) + q1[7] * bfhi(w1.w); }
            s1[j] = a1; m1 = fmaxf(m1, a1); }
        m1 = wave_max(m1);
        float l1 = 0.f;
        for (int j = lane; j < Lk; j += 64) { const float e1 = exp2f(s1[j] - m1); s1[j] = e1; l1 += e1; }
        l1 = wave_sum(l1);
        __builtin_amdgcn_s_waitcnt(0xc07f); asm volatile("" ::: "memory");
        float o0 = 0.f, o1 = 0.f;
        for (int j = 0; j < Lk; ++j) { const unsigned w = *(const unsigned*)(Vb + (size_t)j * 128 + 2 * lane); const float pj = s1[j]; o0 += pj * bflo(w); o1 += pj * bfhi(w); }
        const float il = 1.f / l1;
        const unsigned gw = *(const unsigned*)(PR + (size_t)m * ODD_IN + 3072 + hq * 128 + 2 * lane);
        *(unsigned*)(Y + (size_t)m * DM + hq * 128 + 2 * lane) = pk2(o0 * il * siluf(bflo(gw)), o1 * il * siluf(bfhi(gw)));
        __builtin_amdgcn_s_waitcnt(0xc07f); asm volatile("" ::: "memory");
    }
}

__global__ __launch_bounds__(256) void diffattn_naive(Params p) { __shared__ float sh[4][2 * LKS + 128]; diffattn_tasks(p, sh[threadIdx.x >> 6], (long)blockIdx.x * 4 + (threadIdx.x >> 6), (long)gridDim.x * 4, threadIdx.x & 63); }
__global__ __launch_bounds__(256) void gqa_naive(Params p) { __shared__ float sh[4][LKS + 128]; gqa_tasks(p, sh[threadIdx.x >> 6], (long)blockIdx.x * 4 + (threadIdx.x >> 6), (long)gridDim.x * 4, threadIdx.x & 63); }
__global__ __launch_bounds__(512) void k_prologue(Params p) {
    __shared__ float scr[8 * 64 * 33];
    const int wid = threadIdx.x >> 6, lane = threadIdx.x & 63;
    mod_items(p, scr, blockIdx.x, gridDim.x, threadIdx.x, blockDim.x);
    __syncthreads();
    weights_items(p, scr + wid * 64 * 33, blockIdx.x * 8 + wid, gridDim.x * 8, lane);
    caches_rope_items(p, (long)blockIdx.x * 512 + threadIdx.x, (long)gridDim.x * 512);
}
__global__ __launch_bounds__(512) void k_modulate(Params p, int layer) { modulate_rows(p, layer, blockIdx.x * 8 + (threadIdx.x >> 6), gridDim.x * 8, threadIdx.x & 63); }
__global__ __launch_bounds__(512) void k_post0(Params p) { post0_rows(p, blockIdx.x * 8 + (threadIdx.x >> 6), gridDim.x * 8, threadIdx.x & 63); }
__global__ __launch_bounds__(512) void k_post1(Params p) { post1_rows(p, blockIdx.x * 8 + (threadIdx.x >> 6), gridDim.x * 8, threadIdx.x & 63); }


namespace pg8 {
#define PG8_LAS __attribute__((address_space(3)))
typedef short bf16x8 __attribute__((ext_vector_type(8)));
constexpr int BM = 256, BK = 64, HALF = 128, HTB = HALF * BK * 2  , STAGE_BYTES = 8 * HTB, NXCD = 8, WGM = 8;
__host__ __device__ __forceinline__ int lds_byte(int r, int c) { const int st = (r >> 4) * 2 + (c >> 5), rr = r & 15, cc = c & 31, ob = rr * 64 + cc * 2; return st * 1024 + (ob ^ (((ob >> 9) & 1) << 5)); }
__host__ __device__ __forceinline__ void stage_rc(int b, int& R, int& C) { const int st = b / 1024, sb = b % 1024, swz = sb ^ (((sb >> 9) & 1) << 5); R = (st >> 1) * 16 + swz / 64; C = (st & 1) * 32 + (swz % 64) / 2; }
__host__ __device__ __forceinline__ int perm32(int rho) { const int n = rho >> 4, i = rho & 15; return 8 * (i >> 2) + 4 * n + (i & 3); }
struct Unit { int pm, pn; };
struct Gemm { const bf16_t* A; const bf16_t* Bt; int M, N, K, lda, ldb, a_pn_off; };
struct StaticOrder {
    int nM, nN, nwg, G, c;
    __host__ __device__ void init(int M, int N, int G_, int c_) { nM = M / BM; nN = N / BM; nwg = nM * nN; G = G_; c = c_; }
    __host__ __device__ bool next(int i, Unit& u) const {
        const long L = (long)i * G + c; if (L >= nwg) return false;
        int wgid = (int)L; { const int q = nwg / NXCD, r = nwg % NXCD, xcd = wgid % NXCD, off = wgid / NXCD; wgid = (xcd < r ? xcd * (q + 1) : r * (q + 1) + (xcd - r) * q) + off; }
        const int nig = WGM * nN, gid = wgid / nig, fm = gid * WGM, gsz = (nM - fm) < WGM ? (nM - fm) : WGM;
        u.pm = fm + ((wgid % nig) % gsz); u.pn = (wgid % nig) / gsz; return true;
    }
    __device__ __forceinline__ void a_ready(const Unit&) const {}
    __device__ __forceinline__ void done(const Unit&) const {}
};
__device__ __forceinline__ unsigned cvt_pk_bf16(float lo, float hi) { unsigned r; asm volatile("v_cvt_pk_bf16_f32 %0, %1, %2" : "=v"(r) : "v"(lo), "v"(hi)); return r; }
struct EpiBf16 {
    static constexpr bool PERM = true, AFTER_DRAIN = false;
    bf16_t* O; int ldc; int pad;
    __device__ __forceinline__ void operator()(const f32x4 (&acc)[2][2][4][2], const Unit& u, int wr, int wc, int fr, int fq) const {
        const int row0 = u.pm * BM + wr * 64 + fr, col0 = u.pn * BM + wc * 32 + 8 * fq;
#pragma unroll
        for (int ai = 0; ai < 2; ++ai)
#pragma unroll
            for (int m = 0; m < 4; ++m) { bf16_t* rowp = O + (size_t)(row0 + ai * HALF + m * 16) * ldc + col0;
#pragma unroll
                for (int bj = 0; bj < 2; ++bj) { const f32x4 v0 = acc[ai][bj][m][0], v1 = acc[ai][bj][m][1];
                    u32x4 w; w.x = cvt_pk_bf16(v0[0], v0[1]); w.y = cvt_pk_bf16(v0[2], v0[3]); w.z = cvt_pk_bf16(v1[0], v1[1]); w.w = cvt_pk_bf16(v1[2], v1[3]);
                    *(u32x4*)(rowp + bj * HALF) = w; } }
    }
};
struct EpiPoolF {
    static constexpr bool PERM = true, AFTER_DRAIN = false;
    bf16_t* Y; const bf16_t* PR; const float* pscale;
    __device__ __forceinline__ void operator()(const f32x4 (&acc)[2][2][4][2], const Unit& u, int wr, int wc, int fr, int fq) const {
        const int row0 = u.pm * BM + wr * 64 + fr, col0 = u.pn * BM + wc * 32 + 8 * fq;
        f32x4 ps[2][2];
#pragma unroll
        for (int bj = 0; bj < 2; ++bj) { ps[bj][0] = *(const f32x4*)(pscale + col0 + bj * HALF); ps[bj][1] = *(const f32x4*)(pscale + col0 + bj * HALF + 4); }
#pragma unroll
        for (int ai = 0; ai < 2; ++ai)
#pragma unroll
            for (int m = 0; m < 4; ++m) { const size_t r = (size_t)(row0 + ai * HALF + m * 16);
#pragma unroll
                for (int bj = 0; bj < 2; ++bj) { const int c = col0 + bj * HALF;
                    const u32x4 g = *(const u32x4*)(PR + r * EVEN_IN + 5120 + c);
                    const f32x4 v0 = acc[ai][bj][m][0] * ps[bj][0], v1 = acc[ai][bj][m][1] * ps[bj][1];
                    u32x4 w; w.x = cvt_pk_bf16(v0[0] * siluf(bflo(g.x)), v0[1] * siluf(bfhi(g.x))); w.y = cvt_pk_bf16(v0[2] * siluf(bflo(g.y)), v0[3] * siluf(bfhi(g.y)));
                    w.z = cvt_pk_bf16(v1[0] * siluf(bflo(g.z)), v1[1] * siluf(bfhi(g.z))); w.w = cvt_pk_bf16(v1[2] * siluf(bflo(g.w)), v1[3] * siluf(bfhi(g.w)));
                    *(u32x4*)(Y + r * DM + 1024 + c) = w; } }
    }
};
struct EpiResidF {
    static constexpr bool PERM = false, AFTER_DRAIN = false;
    const float* xp; const float* xs; const float* base; const float* gate; float* out;
    __device__ __forceinline__ void operator()(const f32x4 (&acc)[2][2][4][2], const Unit& u, int wr, int wc, int fr, int fq) const {
        const int row0 = u.pm * BM + wr * 64 + fr, col0 = u.pn * BM + wc * 32 + 4 * fq;
        const int cr = u.pm < 32 ? 0 : 1 + ((u.pm - 32) >> 2);
        f32x4 gv[2][2];
#pragma unroll
        for (int bj = 0; bj < 2; ++bj)
#pragma unroll
            for (int n = 0; n < 2; ++n) gv[bj][n] = *(const f32x4*)(gate + (size_t)cr * 6144 + col0 + bj * HALF + n * 16);
#pragma unroll
        for (int ai = 0; ai < 2; ++ai)
#pragma unroll
            for (int m = 0; m < 4; ++m) { const int r = row0 + ai * HALF + m * 16;
                const float* bp = (base ? base + (size_t)r * DM : (r < MP ? xp + (size_t)r * DM : xs + (size_t)(r - MP) * DM)) + col0; float* op = out + (size_t)r * DM + col0;
#pragma unroll
                for (int bj = 0; bj < 2; ++bj)
#pragma unroll
                    for (int n = 0; n < 2; ++n) { const f32x4 b = *(const f32x4*)(bp + bj * HALF + n * 16); *(f32x4*)(op + bj * HALF + n * 16) = b + gv[bj][n] * acc[ai][bj][m][n]; }
                if (m & 1) asm volatile("" ::: "memory"); }
    }
};

template <class Epi, class Sched, bool ALIGN_EPI = false, bool SP2 = false>
__device__ __forceinline__ void gemm_phase(PG8_LAS unsigned char* lds, const Gemm g, const Sched& S, const Epi& E, const int tid) {
    const int wid = __builtin_amdgcn_readfirstlane(tid >> 6), lane = tid & 63, wr = wid >> 2, wc = wid & 3, fr = lane & 15, fq = lane >> 4;
    const int K = g.K, nt = K / BK;
    unsigned voffA[2], voffB[2];
#pragma unroll
    for (int i = 0; i < 2; ++i) { int R, C; stage_rc(tid * 16 + i * 8192, R, C); const int Rb = Epi::PERM ? ((R & ~31) + perm32(R & 31)) : R;
        voffA[i] = (unsigned)(R * g.lda + C) * 2u; voffB[i] = (unsigned)(Rb * g.ldb + C) * 2u; }
    const size_t kstep = (size_t)(BK * 2);
    const size_t hstepA = (size_t)HALF * g.lda * 2, hstepB = (size_t)HALF * g.ldb * 2;
    const size_t tstepA = 2 * hstepA, tstepB = 2 * hstepB;
    const unsigned ldsw = (unsigned)wid * 1024u;
    const int aoff = lds_byte(wr * 64 + fr, fq * 8), boff = lds_byte(wc * 32 + fr, fq * 8);
#define PG8_SA(b, h) (((b) * 2 + (h)) * HTB)
#define PG8_SB(b, h) ((4 + (b) * 2 + (h)) * HTB)
#define PG8_STAGE(bufoff, gbase, voff) do { _Pragma("unroll") for (int _i = 0; _i < 2; ++_i) \
        __builtin_amdgcn_global_load_lds((const unsigned*)((const char*)(gbase) + (voff)[_i]), (PG8_LAS unsigned*)(lds + (bufoff) + ldsw + _i * 8192), 16, 0, 0); } while (0)
#define PG8_LDA(dst, b, h) do { _Pragma("unroll") for (int m = 0; m < 4; ++m) _Pragma("unroll") for (int k = 0; k < 2; ++k) dst[m][k] = *(const PG8_LAS bf16x8*)(lds + PG8_SA(b, h) + aoff + m * 2048 + k * 1024); } while (0)
#define PG8_LDB(dst, b, h) do { _Pragma("unroll") for (int n = 0; n < 2; ++n) _Pragma("unroll") for (int k = 0; k < 2; ++k) dst[n][k] = *(const PG8_LAS bf16x8*)(lds + PG8_SB(b, h) + boff + n * 2048 + k * 1024); } while (0)
#define PG8_MMA(ai, bj, At, Bt) do { __builtin_amdgcn_s_setprio(1); _Pragma("unroll") for (int m = 0; m < 4; ++m) _Pragma("unroll") for (int n = 0; n < 2; ++n) _Pragma("unroll") for (int k = 0; k < 2; ++k) \
        acc[ai][bj][m][n] = __builtin_amdgcn_mfma_f32_16x16x32_bf16(Bt[n][k], At[m][k], acc[ai][bj][m][n], 0, 0, 0); __builtin_amdgcn_s_setprio(0); } while (0)
#define PG8_WAIT_V(n) asm volatile("s_waitcnt vmcnt(" #n ")" ::: "memory")
#define PG8_WAIT_L(n) asm volatile("s_waitcnt lgkmcnt(" #n ")" ::: "memory")
#define PG8_BAR __builtin_amdgcn_s_barrier()
#define PG8_SCHED __builtin_amdgcn_sched_barrier(0)
    Unit cur, nxt; int ui = 0;
    if (!S.next(0, cur)) return;
    f32x4 acc[2][2][4][2];
#pragma unroll
    for (int a = 0; a < 2; ++a)
#pragma unroll
        for (int b = 0; b < 2; ++b)
#pragma unroll
            for (int m = 0; m < 4; ++m)
#pragma unroll
                for (int n = 0; n < 2; ++n) acc[a][b][m][n] = (f32x4){0.f, 0.f, 0.f, 0.f};
    bf16x8 At[4][2], B0[2][2], B1[2][2];
    const char* cA = (const char*)g.A + (size_t)cur.pm * tstepA + (size_t)cur.pn * g.a_pn_off * 2; const char* cB = (const char*)g.Bt + (size_t)cur.pn * tstepB;
    S.a_ready(cur);
    if constexpr (SP2) {
        PG8_STAGE(PG8_SB(0, 0), cB, voffB); PG8_STAGE(PG8_SB(0, 1), cB + hstepB, voffB); PG8_STAGE(PG8_SA(0, 0), cA, voffA); PG8_STAGE(PG8_SA(0, 1), cA + hstepA, voffA);
        if (wr == 1) PG8_BAR;
        PG8_WAIT_V(2); PG8_BAR;
        PG8_STAGE(PG8_SB(1, 0), cB + kstep, voffB); PG8_STAGE(PG8_SA(1, 0), cA + kstep, voffA); PG8_STAGE(PG8_SB(1, 1), cB + hstepB + kstep, voffB);
        PG8_WAIT_V(6); PG8_BAR;
    } else {
        PG8_STAGE(PG8_SB(0, 0), cB, voffB); PG8_STAGE(PG8_SA(0, 0), cA, voffA); PG8_STAGE(PG8_SB(0, 1), cB + hstepB, voffB); PG8_STAGE(PG8_SA(0, 1), cA + hstepA, voffA);
        if (wr == 1) PG8_BAR;
        PG8_WAIT_V(4); PG8_BAR;
        PG8_STAGE(PG8_SB(1, 0), cB + kstep, voffB); PG8_STAGE(PG8_SA(1, 0), cA + kstep, voffA); PG8_STAGE(PG8_SB(1, 1), cB + hstepB + kstep, voffB);
        PG8_WAIT_V(6); PG8_BAR;
    }
    for (;;) {
        const bool has_next = S.next(ui + 1, nxt);
        const char* nA = has_next ? (const char*)g.A + (size_t)nxt.pm * tstepA + (size_t)nxt.pn * g.a_pn_off * 2 : cA; const char* nB = has_next ? (const char*)g.Bt + (size_t)nxt.pn * tstepB : cB;
        for (int t = 0; t < nt; t += 2) {
            const bool last = (t == nt - 2);
            const char* a1 = cA + (size_t)(t + 1) * kstep;
            const char* a2 = last ? nA : cA + (size_t)(t + 2) * kstep; const char* b2 = last ? nB : cB + (size_t)(t + 2) * kstep;
            const char* a3 = a2 + kstep; const char* b3 = b2 + kstep;
            if (last && has_next) S.a_ready(nxt);
            if constexpr (SP2) {
            PG8_LDB(B0, 0, 0); PG8_LDB(B1, 0, 1); PG8_SCHED; PG8_LDA(At, 0, 0); PG8_STAGE(PG8_SA(1, 1), a1 + hstepA, voffA);
            PG8_WAIT_V(8); PG8_WAIT_L(0); PG8_BAR; PG8_MMA(0, 0, At, B0); PG8_MMA(0, 1, At, B1); PG8_BAR; PG8_SCHED;
            PG8_LDA(At, 0, 1); PG8_STAGE(PG8_SB(0, 0), b2, voffB); PG8_STAGE(PG8_SB(0, 1), b2 + hstepB, voffB); PG8_STAGE(PG8_SA(0, 0), a2, voffA);
            PG8_WAIT_V(8); PG8_WAIT_L(0); PG8_BAR; PG8_MMA(1, 0, At, B0); PG8_MMA(1, 1, At, B1); PG8_BAR; PG8_SCHED;
            PG8_LDB(B0, 1, 0); PG8_LDB(B1, 1, 1); PG8_SCHED; PG8_LDA(At, 1, 0); PG8_STAGE(PG8_SA(0, 1), a2 + hstepA, voffA);
            PG8_WAIT_V(8); PG8_WAIT_L(0); PG8_BAR; PG8_MMA(0, 0, At, B0); PG8_MMA(0, 1, At, B1); PG8_BAR; PG8_SCHED;
            PG8_LDA(At, 1, 1); PG8_STAGE(PG8_SB(1, 0), b3, voffB); PG8_STAGE(PG8_SB(1, 1), b3 + hstepB, voffB); PG8_STAGE(PG8_SA(1, 0), a3, voffA);
            PG8_WAIT_V(8); PG8_WAIT_L(0); PG8_BAR; PG8_MMA(1, 0, At, B0); PG8_MMA(1, 1, At, B1); PG8_BAR; PG8_SCHED;
            } else {
            PG8_LDB(B0, 0, 0); PG8_SCHED; PG8_LDA(At, 0, 0); PG8_STAGE(PG8_SA(1, 1), a1 + hstepA, voffA);
            PG8_WAIT_L(8); PG8_BAR; PG8_WAIT_L(0); PG8_MMA(0, 0, At, B0); PG8_BAR; PG8_SCHED;
            PG8_LDB(B1, 0, 1); PG8_STAGE(PG8_SB(0, 0), b2, voffB);
            PG8_BAR; PG8_WAIT_L(0); PG8_MMA(0, 1, At, B1); PG8_BAR;
            PG8_LDA(At, 0, 1); PG8_STAGE(PG8_SA(0, 0), a2, voffA);
            PG8_BAR; PG8_WAIT_L(0); PG8_MMA(1, 0, At, B0); PG8_BAR; PG8_SCHED;
            PG8_STAGE(PG8_SB(0, 1), b2 + hstepB, voffB);
            PG8_WAIT_V(6); PG8_BAR; PG8_MMA(1, 1, At, B1); PG8_BAR;
            PG8_LDB(B0, 1, 0); PG8_SCHED; PG8_LDA(At, 1, 0); PG8_STAGE(PG8_SA(0, 1), a2 + hstepA, voffA);
            PG8_WAIT_L(8); PG8_BAR; PG8_WAIT_L(0); PG8_MMA(0, 0, At, B0); PG8_BAR; PG8_SCHED;
            PG8_LDB(B1, 1, 1); PG8_STAGE(PG8_SB(1, 0), b3, voffB);
            PG8_BAR; PG8_WAIT_L(0); PG8_MMA(0, 1, At, B1); PG8_BAR;
            PG8_LDA(At, 1, 1); PG8_STAGE(PG8_SA(1, 0), a3, voffA);
            PG8_BAR; PG8_WAIT_L(0); PG8_MMA(1, 0, At, B0); PG8_BAR; PG8_SCHED;
            PG8_STAGE(PG8_SB(1, 1), b3 + hstepB, voffB);
            PG8_WAIT_V(6); PG8_BAR; PG8_MMA(1, 1, At, B1); PG8_BAR;
            }
        }
        if constexpr (ALIGN_EPI) { if (wr == 0) PG8_BAR; }
        if constexpr (!Epi::AFTER_DRAIN) { E(acc, cur, wr, wc, fr, fq); S.done(cur); }
        if (!has_next) break;
#pragma unroll
        for (int a = 0; a < 2; ++a)
#pragma unroll
            for (int b = 0; b < 2; ++b)
#pragma unroll
                for (int m = 0; m < 4; ++m)
#pragma unroll
                    for (int n = 0; n < 2; ++n) acc[a][b][m][n] = (f32x4){0.f, 0.f, 0.f, 0.f};
        cur = nxt; cA = nA; cB = nB; ++ui;
        if constexpr (ALIGN_EPI) { if (wr == 1) PG8_BAR; }
    }
    PG8_WAIT_V(0);
    if constexpr (!ALIGN_EPI) { if (wr == 0) PG8_BAR; }
    PG8_BAR;
#undef PG8_SA
#undef PG8_SB
#undef PG8_STAGE
#undef PG8_LDA
#undef PG8_LDB
#undef PG8_MMA
#undef PG8_WAIT_V
#undef PG8_WAIT_L
#undef PG8_BAR
#undef PG8_SCHED
}
}

namespace att {
using bf16x8 = __attribute__((ext_vector_type(8))) short;
using s16x4  = __attribute__((ext_vector_type(4))) short;
using f32x16 = __attribute__((ext_vector_type(16))) float;
constexpr int QBLK = 32, KVBLK = 64, LDK = 128;
constexpr int SHM_V = KVBLK * 128 * 2, SHM_K = KVBLK * 128 * 2;
constexpr int WS_OFF = 2 * SHM_V + 2 * SHM_K;
constexpr int STG_OFF = 72 * 1024;
constexpr float THRL = 8.f * LOG2E;
#define KSWZ(row, colB) ((row) * 256 + ((colB) ^ (((row) & 7) << 4)))
#define SBAR() __builtin_amdgcn_sched_barrier(0)
__device__ __forceinline__ int crow(int r, int hi) { return (r & 3) + 8 * (r >> 2) + 4 * hi; }
__device__ __forceinline__ unsigned cvtpk(float lo, float hi) { unsigned r; asm volatile("v_cvt_pk_bf16_f32 %0, %1, %2" : "=v"(r) : "v"(lo), "v"(hi)); return r; }
__device__ __forceinline__ void partialSM(f32x16& p0, f32x16& p1, float& m_reg, float& mn, float& alpha) {
  float pmax = p0[0]; for (int r = 1; r < 16; ++r) pmax = fmaxf(pmax, p0[r]); for (int r = 0; r < 16; ++r) pmax = fmaxf(pmax, p1[r]);
  { auto rr = __builtin_amdgcn_permlane32_swap(__float_as_uint(pmax), __float_as_uint(pmax), false, false);
    pmax = fmaxf(__uint_as_float(rr[0]), __uint_as_float(rr[1])); }
  if (__builtin_expect(__all(pmax - m_reg <= THRL), 1)) { mn = m_reg; alpha = 1.f; }
  else { mn = fmaxf(m_reg, pmax); alpha = __builtin_amdgcn_exp2f(m_reg - mn); m_reg = mn; }
  for (int r = 0; r < 16; ++r) p0[r] = p0[r] - mn; for (int r = 0; r < 16; ++r) p1[r] = p1[r] - mn;
  for (int r = 0; r < 16; ++r) p0[r] = __builtin_amdgcn_exp2f(p0[r]);
}
__device__ __forceinline__ void finishSM(f32x16& p0, f32x16& p1, float alpha, float& l_reg, bf16x8& pa0, bf16x8& pa1, bf16x8& pa2, bf16x8& pa3) {
  for (int r = 0; r < 16; ++r) p1[r] = __builtin_amdgcn_exp2f(p1[r]);
  float ps = 0; for (int r = 0; r < 16; ++r) ps += p0[r]; for (int r = 0; r < 16; ++r) ps += p1[r];
  { auto rr = __builtin_amdgcn_permlane32_swap(__float_as_uint(ps), __float_as_uint(ps), false, false);
    ps = __uint_as_float(rr[0]) + __uint_as_float(rr[1]); }
  l_reg = l_reg * alpha + ps;
#define PK4(P, BASE, OUT) do { unsigned a0 = cvtpk(P[BASE + 0], P[BASE + 1]), a1 = cvtpk(P[BASE + 2], P[BASE + 3]);   \
    unsigned b0 = cvtpk(P[BASE + 4], P[BASE + 5]), b1 = cvtpk(P[BASE + 6], P[BASE + 7]);                              \
    auto r0 = __builtin_amdgcn_permlane32_swap(a0, b0, false, false); auto r1 = __builtin_amdgcn_permlane32_swap(a1, b1, false, false); \
    u32x4 w = {r0[0], r1[0], r0[1], r1[1]}; OUT = *reinterpret_cast<bf16x8*>(&w); } while (0)
  PK4(p0, 0, pa0); PK4(p0, 8, pa1); PK4(p1, 0, pa2); PK4(p1, 8, pa3);
#undef PK4
}
template <int ND0> __device__ __forceinline__ void qkt(f32x16& p0, f32x16& p1, const char* Ks, const bf16x8* qr, int r32, int hi, int kcol0) {
  p0 = f32x16{}; p1 = f32x16{};
#pragma unroll
  for (int d0 = 0; d0 < ND0; ++d0) { int cb = (kcol0 + d0 * 16 + hi * 8) * 2;
    bf16x8 b0 = *reinterpret_cast<const bf16x8*>(Ks + KSWZ(r32, cb));
    bf16x8 b1 = *reinterpret_cast<const bf16x8*>(Ks + KSWZ(32 + r32, cb));
    p0 = __builtin_amdgcn_mfma_f32_32x32x16_bf16(b0, qr[d0], p0, 0, 0, 0);
    p1 = __builtin_amdgcn_mfma_f32_32x32x16_bf16(b1, qr[d0], p1, 0, 0, 0); }
}
__device__ __forceinline__ int v_st(int k, int c) { const int kk = (k & ~0xC) | ((k & 4) << 1) | ((k & 8) >> 1); return ((kk >> 3) * 4 + (c >> 5)) * 512 + ((kk & 7) * 32 + (c & 31)) * 2; }
__device__ __forceinline__ int v_rd_base(int lane) { return ((lane & 3) << 3) | (((lane >> 2) & 3) << 6) | (((lane >> 4) & 1) << 5) | (((lane >> 5) & 1) << 8); }
constexpr int v_rd_off(int d0, int ks, int half) { return d0 * 512 + ks * 4096 + half * 2048; }
template <int OFF> __device__ __forceinline__ s16x4 tr_read(int vb) {
  s16x4 r; asm volatile("ds_read_b64_tr_b16 %0, %1 offset:%2" : "=&v"(r) : "v"(vb), "i"(OFF) : "memory"); return r;
}
template <int D0> __device__ __forceinline__ void pv_one(f32x16& od, int vb, bf16x8 pa0, bf16x8 pa1, bf16x8 pa2, bf16x8 pa3) {
  const s16x4 l0 = tr_read<v_rd_off(D0, 0, 0)>(vb), h0 = tr_read<v_rd_off(D0, 0, 1)>(vb), l1 = tr_read<v_rd_off(D0, 1, 0)>(vb), h1 = tr_read<v_rd_off(D0, 1, 1)>(vb);
  const s16x4 l2 = tr_read<v_rd_off(D0, 2, 0)>(vb), h2 = tr_read<v_rd_off(D0, 2, 1)>(vb), l3 = tr_read<v_rd_off(D0, 3, 0)>(vb), h3 = tr_read<v_rd_off(D0, 3, 1)>(vb);
  asm volatile("s_waitcnt lgkmcnt(0)" ::: "memory"); SBAR();
#define PK(L, H) (bf16x8){L[0], L[1], L[2], L[3], H[0], H[1], H[2], H[3]}
  od = __builtin_amdgcn_mfma_f32_32x32x16_bf16(pa0, PK(l0, h0), od, 0, 0, 0);
  od = __builtin_amdgcn_mfma_f32_32x32x16_bf16(pa1, PK(l1, h1), od, 0, 0, 0);
  od = __builtin_amdgcn_mfma_f32_32x32x16_bf16(pa2, PK(l2, h2), od, 0, 0, 0);
  od = __builtin_amdgcn_mfma_f32_32x32x16_bf16(pa3, PK(l3, h3), od, 0, 0, 0);
#undef PK
}
__device__ __forceinline__ void pv_d0(f32x16* o, int vb, bf16x8 pa0, bf16x8 pa1, bf16x8 pa2, bf16x8 pa3) {
  pv_one<0>(o[0], vb, pa0, pa1, pa2, pa3); pv_one<1>(o[1], vb, pa0, pa1, pa2, pa3); pv_one<2>(o[2], vb, pa0, pa1, pa2, pa3); pv_one<3>(o[3], vb, pa0, pa1, pa2, pa3);
}
template <int ND0>
__device__ __forceinline__ void attn_core(const bf16_t* Qw, const bf16_t* __restrict__ Kh, const bf16_t* __restrict__ Vh, int seq, int kcol0, char* lds, f32x16 (&o)[4], float& l_reg, const int wid, const int lane) {
  const int tid = wid * 64 + lane, r32 = lane & 31, hi = lane >> 5;
  char* V_lds = lds; char* K_lds = lds + 2 * SHM_V;
  float* ws = (float*)(lds + WS_OFF) + wid * 64; float* al_l = ws + 32;
  float m_reg = -1e30f; l_reg = 0; bf16x8 qr[ND0];
#pragma unroll
  for (int d = 0; d < 4; ++d) o[d] = f32x16{};
#pragma unroll
  for (int d0 = 0; d0 < ND0; ++d0) qr[d0] = *reinterpret_cast<const bf16x8*>(Qw + d0 * 16);
  const int sr = tid >> 4, sc = (tid & 15) * 8, vst0 = v_st(sr, sc), vst1 = v_st(32 + sr, sc);
  const int vb0 = (int)(uintptr_t)V_lds + v_rd_base(lane);
  struct { bf16x8 vs0, vs1, ks0, ks1; } sr_[2];
#define SLOAD(i, k0) do { sr_[i].vs0 = *reinterpret_cast<const bf16x8*>(&Vh[(long)((k0) + sr) * LDK + sc]); sr_[i].vs1 = *reinterpret_cast<const bf16x8*>(&Vh[(long)((k0) + 32 + sr) * LDK + sc]); \
    sr_[i].ks0 = *reinterpret_cast<const bf16x8*>(&Kh[(long)((k0) + sr) * LDK + sc]); sr_[i].ks1 = *reinterpret_cast<const bf16x8*>(&Kh[(long)((k0) + 32 + sr) * LDK + sc]); } while (0)
#define SWRITE(b, i) do { *(bf16x8*)(V_lds + (b) * SHM_V + vst0) = sr_[i].vs0;          \
    *(bf16x8*)(V_lds + (b) * SHM_V + vst1) = sr_[i].vs1; int kc = sc * 2;               \
    *(bf16x8*)(K_lds + (b) * SHM_K + KSWZ(sr, kc)) = sr_[i].ks0;                       \
    *(bf16x8*)(K_lds + (b) * SHM_K + KSWZ(32 + sr, kc)) = sr_[i].ks1; } while (0)
#define SWAIT() asm volatile("s_waitcnt vmcnt(4)" ::: "memory")
#define RESC(a) do { if (__any((a) < 1.f)) { if (hi == 0) al_l[r32] = (a); asm volatile("s_waitcnt lgkmcnt(0)" ::: "memory"); \
    for (int d = 0; d < 4; ++d) for (int r = 0; r < 16; ++r) o[d][r] *= al_l[crow(r, hi)]; } } while (0)
  f32x16 pA0, pA1, pB0, pB1; float mnA, mnB, alA, alB; bf16x8 pa0, pa1, pa2, pa3; const int NT = seq / KVBLK;
  constexpr int SE = 0, SO = 1;
  SLOAD(SE, 0); asm volatile("s_waitcnt vmcnt(0)" ::: "memory"); SWRITE(0, SE); __syncthreads();
  qkt<ND0>(pA0, pA1, K_lds, qr, r32, hi, kcol0); partialSM(pA0, pA1, m_reg, mnA, alA);
  SLOAD(SO, KVBLK); if (2 < NT) SLOAD(SE, 2 * KVBLK);
  SWAIT(); SWRITE(1, SO); __syncthreads();
  for (int j = 1; j + 1 < NT; j += 2) {
    SBAR(); qkt<ND0>(pB0, pB1, K_lds + SHM_K, qr, r32, hi, kcol0);
    finishSM(pA0, pA1, alA, l_reg, pa0, pa1, pa2, pa3); SBAR();
    SLOAD(SO, (j + 2) * KVBLK); SBAR();
    pv_d0(o, vb0, pa0, pa1, pa2, pa3); partialSM(pB0, pB1, m_reg, mnB, alB);
    __syncthreads(); SWAIT(); SWRITE(0, SE);
    RESC(alB); __syncthreads();
    SBAR(); qkt<ND0>(pA0, pA1, K_lds, qr, r32, hi, kcol0);
    finishSM(pB0, pB1, alB, l_reg, pa0, pa1, pa2, pa3); SBAR();
    if (j + 3 < NT) SLOAD(SE, (j + 3) * KVBLK); SBAR();
    pv_d0(o, vb0 + SHM_V, pa0, pa1, pa2, pa3); partialSM(pA0, pA1, m_reg, mnA, alA);
    __syncthreads(); SWAIT(); SWRITE(1, SO);
    RESC(alA); __syncthreads();
  }
  SBAR(); qkt<ND0>(pB0, pB1, K_lds + SHM_K, qr, r32, hi, kcol0);
  finishSM(pA0, pA1, alA, l_reg, pa0, pa1, pa2, pa3); SBAR();
  pv_d0(o, vb0, pa0, pa1, pa2, pa3); partialSM(pB0, pB1, m_reg, mnB, alB);
  __syncthreads(); RESC(alB);
  finishSM(pB0, pB1, alB, l_reg, pa0, pa1, pa2, pa3); SBAR();
  pv_d0(o, vb0 + SHM_V, pa0, pa1, pa2, pa3);
#undef SLOAD
#undef SWRITE
#undef SWAIT
#undef RESC
}
__device__ __forceinline__ void row_inv_l(float l_reg, char* lds, int wid, int r32, int hi, float (&rli)[16]) {
  float* li_l = (float*)(lds + WS_OFF) + wid * 64;
  if (hi == 0) li_l[r32] = l_reg; asm volatile("s_waitcnt lgkmcnt(0)" ::: "memory");
#pragma unroll
  for (int r = 0; r < 16; ++r) rli[r] = __builtin_amdgcn_rcpf(li_l[crow(r, hi)]);
}
__device__ __forceinline__ void store_rows_gated(const f32x16 (&v)[4], char* stg, bf16_t* Yrow0  , const bf16_t* Grow0, int gpitch, int lane, int r32, int hi) {
  bf16_t* st = (bf16_t*)stg;
#pragma unroll
  for (int r = 0; r < 16; ++r) { const int orow = crow(r, hi);
#pragma unroll
    for (int d0 = 0; d0 < 4; ++d0) st[orow * 128 + d0 * 32 + r32] = (bf16_t)f2bf(v[d0][r]); }
  asm volatile("s_waitcnt lgkmcnt(0)" ::: "memory");
  const bf16_t* gp = Grow0 + (size_t)(lane >> 4) * gpitch + (lane & 15) * 8; bf16_t* yp = Yrow0 + (size_t)(lane >> 4) * DM + (lane & 15) * 8; const bf16_t* sp = st + (lane >> 4) * 128 + (lane & 15) * 8;
#pragma unroll 1
  for (int i = 0; i < 8; ++i, gp += 4 * (size_t)gpitch, yp += 4 * DM, sp += 4 * 128) {
    const u32x4 x = *(const u32x4*)sp, g = *(const u32x4*)gp;
    u32x4 w; w.x = pk2(bflo(x.x) * siluf(bflo(g.x)), bfhi(x.x) * siluf(bfhi(g.x))); w.y = pk2(bflo(x.y) * siluf(bflo(g.y)), bfhi(x.y) * siluf(bfhi(g.y)));
    w.z = pk2(bflo(x.z) * siluf(bflo(g.z)), bfhi(x.z) * siluf(bfhi(g.z))); w.w = pk2(bflo(x.w) * siluf(bflo(g.w)), bfhi(x.w) * siluf(bfhi(g.w)));
    *(u32x4*)yp = w; }
  asm volatile("s_waitcnt lgkmcnt(0)" ::: "memory");
}
__device__ __forceinline__ void gqa_unit(const Params& p, char* lds, int m0, int hq, const bf16_t* Kh, const bf16_t* Vh, int seq, const int wid) {
  const int lane = fresh_lane(), r32 = lane & 31, hi = lane >> 5;
  const bf16_t* QC = (const bf16_t*)(p.ws + WS_Q); const bf16_t* PR = (const bf16_t*)(p.ws + WS_PR); bf16_t* Y = (bf16_t*)(p.ws + WS_HY);
  f32x16 o[4]; float l_reg;
  attn_core<8>(QC + (size_t)(m0 + wid * QBLK + r32) * DM + hq * 128 + hi * 8, Kh, Vh, seq, 0, lds, o, l_reg, wid, lane);
  float rli[16]; row_inv_l(l_reg, lds, wid, r32, hi, rli);
#pragma unroll
  for (int d0 = 0; d0 < 4; ++d0)
#pragma unroll
    for (int r = 0; r < 16; ++r) o[d0][r] *= rli[r];
  __syncthreads();
  const size_t row0 = (size_t)(m0 + wid * QBLK);
  store_rows_gated(o, lds + wid * 8192, Y + row0 * DM + hq * 128, PR + row0 * ODD_IN + 3072 + hq * 128, ODD_IN, lane, r32, hi);
  __syncthreads();
}
__device__ __forceinline__ void gqa_phase(const Params& p, char* lds, int vcu, int G, const int wid) {
  for (int v = vcu; v < 256; v += G) {
    const bool smp = v < 128; const int n = smp ? 1 : 4;
    for (int i = 0; i < n; ++i) {
      int m0, hq, bk, seq; const bf16_t* Kb; const bf16_t* Vb;
      if (smp) { const int qb = v & 3, g = (v >> 2) & 3; bk = v >> 4; m0 = MP + (bk >> 2) * SEQS + qb * 256; hq = (bk & 3) * 4 + g; seq = LKS;
        Kb = (const bf16_t*)(p.ws + WS_KSC) + (size_t)bk * LKS * 128; Vb = (const bf16_t*)(p.ws + WS_VSC) + (size_t)bk * LKS * 128; }
      else { bk = v - 128; m0 = (bk >> 2) * SEQP; hq = (bk & 3) * 4 + i; seq = SEQP;
        Kb = (const bf16_t*)(p.ws + WS_KP) + (size_t)bk * SEQP * 128; Vb = (const bf16_t*)(p.ws + WS_VP) + (size_t)bk * SEQP * 128; }
      gqa_unit(p, lds, m0, hq, Kb, Vb, seq, wid);
    }
  }
}
__device__ __forceinline__ void diff_unit(const Params& p, char* lds, int m0, int h, const bf16_t* Kh, const bf16_t* Vh, int seq, float lam, const int wid) {
  const int lane = fresh_lane(), r32 = lane & 31, hi = lane >> 5, rg = wid & 3, mp = wid >> 2;
  const bf16_t* QA = (const bf16_t*)(p.ws + WS_Q); const bf16_t* PR = (const bf16_t*)(p.ws + WS_PR); bf16_t* Y = (bf16_t*)(p.ws + WS_HY);
  f32x16 o[4]; float l_reg;
  attn_core<4>(QA + (size_t)(m0 + rg * QBLK + r32) * 1024 + h * 128 + mp * 64 + hi * 8, Kh, Vh, seq, mp * 64, lds, o, l_reg, wid, lane);
  float rli[16]; row_inv_l(l_reg, lds, wid, r32, hi, rli);
  __syncthreads();
  float* ex = (float*)lds + rg * 4096 + lane;
  if (mp == 1) {
#pragma unroll
    for (int d0 = 0; d0 < 4; ++d0)
#pragma unroll
      for (int r = 0; r < 16; ++r) ex[(d0 * 16 + r) * 64] = o[d0][r] * (rli[r] * lam);
  }
  __syncthreads();
  if (mp == 0) {
    float ss[16];
#pragma unroll
    for (int r = 0; r < 16; ++r) ss[r] = 0.f;
#pragma unroll
    for (int d0 = 0; d0 < 4; ++d0)
#pragma unroll
      for (int r = 0; r < 16; ++r) { const float v = o[d0][r] * rli[r] - ex[(d0 * 16 + r) * 64]; o[d0][r] = v; ss[r] += v * v; }
#pragma unroll
    for (int r = 0; r < 16; ++r) {
#pragma unroll
      for (int of = 1; of < 32; of <<= 1) ss[r] += __shfl_xor(ss[r], of);
      ss[r] = 0.8f / sqrtf(ss[r] * (1.f / 128.f) + EPS); }
#pragma unroll
    for (int d0 = 0; d0 < 4; ++d0) { const float sw = p.subln_w[d0 * 32 + r32];
#pragma unroll
      for (int r = 0; r < 16; ++r) o[d0][r] *= ss[r] * sw; }
    const size_t row0 = (size_t)(m0 + rg * QBLK);
    store_rows_gated(o, lds + STG_OFF + rg * 8192, Y + row0 * DM + h * 128, PR + row0 * EVEN_IN + 4096 + h * 128, EVEN_IN, lane, r32, hi);
  }
  __syncthreads();
}
__device__ __forceinline__ void diff_phase(const Params& p, char* lds, int vcu, int G, const int wid) {
  const int lane = fresh_lane();
  const float lam = expf(wave_sum(p.lam_q1[lane] * p.lam_k1[lane])) - expf(wave_sum(p.lam_q2[lane] * p.lam_k2[lane])) + 0.2f;
  for (int v = vcu; v < 256; v += G) {
    const bool smp = v < 128; const int n = smp ? 1 : 4;
    for (int i = 0; i < n; ++i) {
      int m0, h, bh, seq; const bf16_t* Kb; const bf16_t* Vb;
      if (smp) { const int qb = v & 7; bh = v >> 3; h = bh & 7; m0 = MP + (bh >> 3) * SEQS + qb * 128; seq = LKS;
        Kb = (const bf16_t*)(p.ws + WS_KSA) + (size_t)bh * LKS * 128; Vb = (const bf16_t*)(p.ws + WS_VSA) + (size_t)bh * LKS * 128; }
      else { const int pu = (v - 128) * 4 + i, qb = pu & 1; bh = pu >> 1; h = bh & 7; m0 = (bh >> 3) * SEQP + qb * 128; seq = SEQP;
        Kb = (const bf16_t*)(p.ws + WS_KP) + (size_t)bh * SEQP * 128; Vb = (const bf16_t*)(p.ws + WS_VP) + (size_t)bh * SEQP * 128; }
      diff_unit(p, lds, m0, h, Kb, Vb, seq, lam, wid);
    }
  }
}
#undef KSWZ
#undef SBAR
}

constexpr int NWAVES = 8;
constexpr int RING_OFF = 0, RING_BYTES = 131072;
constexpr int LDSCTL_OFF = RING_BYTES, MISC_OFF = LDSCTL_OFF + 320;
constexpr int LDS_BYTES = 147456;
constexpr int CW_BAR = 4096;
#define GAS __attribute__((address_space(1)))
#define LAS __attribute__((address_space(3)))
typedef GAS unsigned gu32;
#define RLX_AGENT __ATOMIC_RELAXED, __HIP_MEMORY_SCOPE_AGENT
#define XB_TMO      128
#define XB_XCNT(j)  (256  + 64 * (j))
#define XB_XSUB(j)  (1280 + 64 * (j))
#define XB_XGEN(j)  (2304 + 64 * (j))
#define XB_TOP      3328
#define XB_TOPGEN   3392
#define XCD_BAR_WORDS 3456
#define XB_SPIN_CAP (1u << 18)
__device__ __forceinline__ unsigned xb_ld(unsigned* p)              { return __hip_atomic_load(p, __ATOMIC_RELAXED, __HIP_MEMORY_SCOPE_AGENT); }
__device__ __forceinline__ unsigned xb_add(unsigned* p, unsigned v) { return __hip_atomic_fetch_add(p, v, __ATOMIC_RELAXED, __HIP_MEMORY_SCOPE_AGENT); }
__device__ __forceinline__ unsigned xb_xcc_id() { return (unsigned)__builtin_amdgcn_s_getreg((3 << 11) | 20) & 0xFu; }
#define XB_SPIN(cond, bar) do { unsigned _sp = 0; while (cond) { __builtin_amdgcn_s_sleep(1); \
    if ((++_sp & 255u) == 0u) { if (xb_ld(&(bar)[XB_TMO])) break; if (_sp > XB_SPIN_CAP) { atomicAdd(&(bar)[XB_TMO], 1u); break; } } } } while (0)
struct XcdBarrier { unsigned* bar; unsigned x; volatile LAS unsigned* st; };
__device__ __forceinline__ XcdBarrier xcd_barrier_post(unsigned* bar, volatile LAS unsigned* st) {
    XcdBarrier b; b.bar = bar; b.x = xb_xcc_id(); b.st = st;
    if (threadIdx.x == 0) (void)xb_add(&bar[XB_XCNT(b.x)], 1u);
    return b;
}
__device__ __forceinline__ void xcd_barrier_complete(unsigned* bar, unsigned x, unsigned& nloc, unsigned& nx) {
    const unsigned G = gridDim.x * gridDim.y * gridDim.z;
    unsigned sum, cnt, mine, sp = 0u;
    for (;;) {
        sum = 0u; cnt = 0u; mine = 0u;
#pragma unroll
        for (unsigned j = 0; j < 16; ++j) { const unsigned c = xb_ld(&bar[XB_XCNT(j)]); sum += c; cnt += (c > 0u) ? 1u : 0u; mine = (j == x) ? c : mine; }
        if (sum == G) break;
        __builtin_amdgcn_s_sleep(1);
        if ((++sp & 255u) == 0u) { if (xb_ld(&bar[XB_TMO])) break; if (sp > XB_SPIN_CAP) { atomicAdd(&bar[XB_TMO], 1u); break; } }
    }
    nloc = mine > 0u ? mine : 1u; nx = cnt > 0u ? cnt : 1u;
}
__device__ __forceinline__ void xcd_barrier(const XcdBarrier& b) {
    asm volatile("s_waitcnt vmcnt(0)" ::: "memory");
    __syncthreads();
    if (threadIdx.x == 0) {
        unsigned* bar = b.bar;
        __builtin_amdgcn_s_waitcnt(0);
        unsigned nloc = b.st[0], nx = b.st[1];
        if (nloc == 0u) { xcd_barrier_complete(bar, b.x, nloc, nx); b.st[0] = nloc; b.st[1] = nx; }
        const unsigned old = xb_add(&bar[XB_XSUB(b.x)], 1u);
        const unsigned gen = old / nloc;
        if (old + 1u == (gen + 1u) * nloc) {
            __builtin_amdgcn_fence(__ATOMIC_RELEASE, "agent");
            asm volatile("s_waitcnt vmcnt(0)" ::: "memory");
            const unsigned og = xb_add(&bar[XB_TOP], 1u);
            const unsigned tg = og / nx;
            if (og + 1u == (tg + 1u) * nx) xb_add(&bar[XB_TOPGEN], 1u);
            else XB_SPIN(xb_ld(&bar[XB_TOPGEN]) == tg, bar);
            __builtin_amdgcn_fence(__ATOMIC_ACQUIRE, "agent");
            xb_add(&bar[XB_XGEN(b.x)], 1u);
            asm volatile("s_waitcnt vmcnt(0)" ::: "memory");
        } else {
            XB_SPIN(xb_ld(&bar[XB_XGEN(b.x)]) == gen, bar);
            __builtin_amdgcn_fence(__ATOMIC_ACQUIRE, "agent");
            asm volatile("s_waitcnt vmcnt(0)" ::: "memory");
        }
    }
    __syncthreads();
}

struct MegaArgs { Params p; int ph_lo, ph_hi; };
constexpr int N_PHASES = 11;
__global__ void __launch_bounds__(NWAVES * 64, 2) mega_fwd(MegaArgs args) {
    extern __shared__ __attribute__((aligned(16))) unsigned char lds[];
    const Params& p = args.p;
    LAS unsigned char* ldsl = (LAS unsigned char*)lds;
    volatile LAS unsigned* MISC = (volatile LAS unsigned*)(ldsl + MISC_OFF);
    const int wave = __builtin_amdgcn_readfirstlane(threadIdx.x >> 6);
    const int G = gridDim.x, bx = blockIdx.x;
    const int vcu = (G % 8 == 0) ? (bx % 8) * (G / 8) + bx / 8 : bx;
    for (int u = threadIdx.x; u < (LDS_BYTES - LDSCTL_OFF) / 4; u += NWAVES * 64) ((LAS unsigned*)(ldsl + LDSCTL_OFF))[u] = 0u;
    __syncthreads();
    unsigned char* ws = p.ws;
    XcdBarrier bar = xcd_barrier_post((unsigned*)(ws + WS_CTL) + CW_BAR, MISC + 8);
    const int lo = args.ph_lo, hi = args.ph_hi;
    const int gw = vcu * NWAVES + wave, ngw = G * NWAVES;
#define IN(k) (lo <= (k) && (k) < hi)
#define SEAM(k) do { if (IN(k) && IN((k) + 1)) xcd_barrier(bar); } while (0)
    if (IN(0)) {
        float* scr = (float*)lds; const int lane = fresh_lane(), tid = wave * 64 + lane;
        mod_items(p, scr, bx, G, tid, NWAVES * 64);
        __syncthreads();
        weights_items(p, (float*)(lds + wave * 16384), gw, ngw, lane);
        caches_rope_items(p, (long)bx * 512 + tid, (long)G * 512);
    }
    SEAM(0);
    if (IN(1)) modulate_rows(p, 0, gw, ngw, fresh_lane());
    SEAM(1);
    if (IN(2)) {
        pg8::Gemm g{(const bf16_t*)(ws + WS_HY), (const bf16_t*)(ws + WS_WINE), MT, EVEN_IN, DM, DM, DM, 0}; pg8::StaticOrder S; S.init(MT, EVEN_IN, G, bx);
        pg8::EpiBf16 E{(bf16_t*)(ws + WS_PR), EVEN_IN, 0};
        pg8::gemm_phase<pg8::EpiBf16, pg8::StaticOrder, true, true>(ldsl + RING_OFF, g, S, E, wave * 64 + fresh_lane());
    }
    SEAM(2);
    if (IN(3)) post0_rows(p, gw, ngw, fresh_lane());
    SEAM(3);
    if (IN(4)) {
        { pg8::Gemm g{(const bf16_t*)(ws + WS_UA), (const bf16_t*)(ws + WS_POOLW), MT, 1024, 256, 1024, 256, 256}; pg8::StaticOrder S; S.init(MT, 1024, G, bx);
          pg8::EpiPoolF E{(bf16_t*)(ws + WS_HY), (const bf16_t*)(ws + WS_PR), p.pool_scale};
          pg8::gemm_phase<pg8::EpiPoolF, pg8::StaticOrder, true, true>(ldsl + RING_OFF, g, S, E, wave * 64 + fresh_lane()); }
        __syncthreads();
        att::diff_phase(p, (char*)lds, vcu, G, wave);
    }
    SEAM(4);
    if (IN(5)) {
        pg8::Gemm g{(const bf16_t*)(ws + WS_HY), (const bf16_t*)(ws + WS_WOUTE), MT, DM, DM, DM, DM, 0}; pg8::StaticOrder S; S.init(MT, DM, G, bx);
        pg8::EpiResidF E{p.x_prompt, p.x_sample, nullptr, (const float*)(ws + WS_MOD) + 4096, p.out};
        pg8::gemm_phase<pg8::EpiResidF, pg8::StaticOrder, true, true>(ldsl + RING_OFF, g, S, E, wave * 64 + fresh_lane());
    }
    SEAM(5);
    if (IN(6)) modulate_rows(p, 1, gw, ngw, fresh_lane());
    SEAM(6);
    if (IN(7)) {
        pg8::Gemm g{(const bf16_t*)(ws + WS_HY), (const bf16_t*)(ws + WS_WINO), MT, ODD_IN, DM, DM, DM, 0}; pg8::StaticOrder S; S.init(MT, ODD_IN, G, bx);
        pg8::EpiBf16 E{(bf16_t*)(ws + WS_PR), ODD_IN, 0};
        pg8::gemm_phase<pg8::EpiBf16, pg8::StaticOrder, true, true>(ldsl + RING_OFF, g, S, E, wave * 64 + fresh_lane());
    }
    SEAM(7);
    if (IN(8)) post1_rows(p, gw, ngw, fresh_lane());
    SEAM(8);
    if (IN(9)) att::gqa_phase(p, (char*)lds, vcu, G, wave);
    SEAM(9);
    if (IN(10)) {
        pg8::Gemm g{(const bf16_t*)(ws + WS_HY), (const bf16_t*)(ws + WS_WOUTO), MT, DM, DM, DM, DM, 0}; pg8::StaticOrder S; S.init(MT, DM, G, bx);
        pg8::EpiResidF E{p.x_prompt, p.x_sample, p.out, (const float*)(ws + WS_MOD) + 3 * 6144 + 4096, p.out};
        pg8::gemm_phase<pg8::EpiResidF, pg8::StaticOrder, true, true>(ldsl + RING_OFF, g, S, E, wave * 64 + fresh_lane());
    }
#undef IN
#undef SEAM
}

#ifndef MK_PER_PHASE
#define MK_PER_PHASE 0
#endif
extern "C" void kernel_launch(void* const* d_in, const int* in_sizes, int n_in, void* d_out, int out_size, void* d_ws, size_t ws_size, hipStream_t stream) {
    if (n_in != 26 || ws_size < WS_END || out_size != MT * DM + 2 * NBP * HA * SEQP * 128 + 2 * NBP * KVH * SEQP * 128) {
        fprintf(stderr, "kernel_launch: unexpected shapes n_in %d ws %zu out %d\n", n_in, ws_size, out_size); return; }
    static int ready = 0;
    if (!ready) {
        if (hipFuncSetAttribute((const void*)mega_fwd, hipFuncAttributeMaxDynamicSharedMemorySize, LDS_BYTES) != hipSuccess) { fprintf(stderr, "kernel_launch: hipFuncSetAttribute failed\n"); return; }
        ready = 1;
    }
    MegaArgs a{};
    const float** pin = (const float**)&a.p;
    for (int i = 0; i < 26; ++i) pin[i] = (const float*)d_in[i];
    a.p.out = (float*)d_out; a.p.ws = (unsigned char*)d_ws;
    (void)hipMemsetAsync((unsigned char*)d_ws + WS_CTL, 0, 2 * MiB, stream);
#if MK_PER_PHASE
    for (int ph = 0; ph < N_PHASES; ++ph) { a.ph_lo = ph; a.ph_hi = ph + 1; hipLaunchKernelGGL(mega_fwd, dim3(256), dim3(NWAVES * 64), LDS_BYTES, stream, a); }
#else
    a.ph_lo = 0; a.ph_hi = N_PHASES; hipLaunchKernelGGL(mega_fwd, dim3(256), dim3(NWAVES * 64), LDS_BYTES, stream, a);
#endif
}
```

```cpp
#include <hip/hip_runtime.h>
#include <cstdio>
#include <cstdint>

typedef unsigned short bf16_t;
typedef float f32x4 __attribute__((ext_vector_type(4)));
typedef unsigned u32x4 __attribute__((ext_vector_type(4)));
typedef unsigned u32x2 __attribute__((ext_vector_type(2)));

constexpr int DM = 2048, NBP = 32, SEQP = 256, NBS = 2, SEQS = 1024, PAST = 256;
constexpr int MP = NBP * SEQP, MS = NBS * SEQS, MT = MP + MS;
constexpr int HA = 8, DKA = 64, DVA = 128, WA = 1024, WB = 1024, GWB = 256;
constexpr int EVEN_IN = 6144, ODD_IN = 5120;
constexpr int HC = 16, KVH = 4, HDC = 128;
constexpr int LKS = PAST + SEQS;
constexpr float EPS = 1e-6f;
constexpr float LOG2E = 1.4426950408889634f;
constexpr float C2A = 0.125f * LOG2E;
constexpr float C2C = 0.08838834764831845f * LOG2E;

constexpr size_t MiB = 1u << 20;
constexpr size_t WS_CTL = 0;
constexpr size_t WS_MOD = 1 * MiB;
constexpr size_t WS_ROPE = 2 * MiB;
constexpr size_t WS_WINE = 4 * MiB;
constexpr size_t WS_WOUTE = 28 * MiB;
constexpr size_t WS_WINO = 36 * MiB;
constexpr size_t WS_WOUTO = 56 * MiB;
constexpr size_t WS_POOLW = 64 * MiB;
constexpr size_t WS_HY = 65 * MiB;
constexpr size_t WS_PR = 105 * MiB;
constexpr size_t WS_Q = 225 * MiB;
constexpr size_t WS_KP = 265 * MiB;
constexpr size_t WS_VP = 281 * MiB;
constexpr size_t WS_KSA = 297 * MiB;
constexpr size_t WS_VSA = 302 * MiB;
constexpr size_t WS_KSC = 307 * MiB;
constexpr size_t WS_VSC = 310 * MiB;
constexpr size_t WS_UA = 313 * MiB;
constexpr size_t WS_END = 333 * MiB;

struct Params {
    const float* x_prompt; const float* x_sample; const float* cache_a_k; const float* cache_a_v; const float* cache_c_k; const float* cache_c_v;
    const float* c; const float* c_ctx; const float* norm_w; const float* ada_w; const float* ada_b;
    const float* even_w_in; const float* even_q_norm_w; const float* even_k_norm_w; const float* lam_q1; const float* lam_k1; const float* lam_q2; const float* lam_k2;
    const float* subln_w; const float* pool_w; const float* pool_scale; const float* even_w_out;
    const float* gqa_w_in; const float* gqa_q_norm_w; const float* gqa_k_norm_w; const float* gqa_w_out;
    float* out; unsigned char* ws;
};

__device__ __forceinline__ unsigned f2bf(float f) { unsigned u = __builtin_bit_cast(unsigned, f); return (u + 0x7fffu + ((u >> 16) & 1u)) >> 16; }
__device__ __forceinline__ unsigned pk2(float lo, float hi) { return f2bf(lo) | (f2bf(hi) << 16); }
__device__ __forceinline__ float bf2f(unsigned h) { return __builtin_bit_cast(float, h << 16); }
__device__ __forceinline__ float bflo(unsigned w) { return __builtin_bit_cast(float, w << 16); }
__device__ __forceinline__ float bfhi(unsigned w) { return __builtin_bit_cast(float, w & 0xffff0000u); }
__device__ __forceinline__ float siluf(float x) { return x / (1.f + __expf(-x)); }
__device__ __forceinline__ float wave_sum(float v) {
#pragma unroll
    for (int o = 1; o < 64; o <<= 1) v += __shfl_xor(v, o);
    return v;
}
__device__ __forceinline__ float wave_max(float v) {
#pragma unroll
    for (int o = 1; o < 64; o <<= 1) v = fmaxf(v, __shfl_xor(v, o));
    return v;
}
__device__ __forceinline__ int fresh_lane() { int l; asm volatile("v_mbcnt_lo_u32_b32 %0, -1, 0\n\tv_mbcnt_hi_u32_b32 %0, -1, %0" : "=v"(l)); return l; }
__device__ __forceinline__ const float* xrow_ptr(const Params& p, int m) { return m < MP ? p.x_prompt + (size_t)m * DM : p.x_sample + (size_t)(m - MP) * DM; }
__device__ __forceinline__ int cond_row(int m) { return m < MP ? 0 : 1 + ((m - MP) >> 10); }

__device__ __forceinline__ void mod_items(const Params& p, float* sl  , int bid, int nb, int tid, int nthr) {
    float* mod = (float*)(p.ws + WS_MOD);
    for (int it = bid; it < 256; it += nb) {
        const int l = it >> 7, kc = (it >> 2) & 31, nc = it & 3;
        __syncthreads();
        for (int i = tid; i < 192; i += nthr) { const int r = i >> 6, kk = i & 63, k = kc * 64 + kk; const float cv = r == 0 ? p.c_ctx[k] : p.c[(r - 1) * DM + k]; sl[i] = siluf(cv); }
        __syncthreads();
        for (int q = tid; q < 384; q += nthr) {
            const int n = nc * 1536 + q * 4;
            const float* w = p.ada_w + ((size_t)l * DM + kc * 64) * 6144 + n;
            f32x4 a0 = {0.f, 0.f, 0.f, 0.f}, a1 = a0, a2 = a0;
#pragma unroll 16
            for (int kk = 0; kk < 64; ++kk) { const f32x4 wv = *(const f32x4*)(w + (size_t)kk * 6144); a0 += wv * sl[kk]; a1 += wv * sl[64 + kk]; a2 += wv * sl[128 + kk]; }
            if (kc == 0) { const f32x4 b = *(const f32x4*)(p.ada_b + l * 6144 + n); a0 += b; a1 += b; a2 += b; }
            float* m0 = mod + (size_t)(l * 3) * 6144 + n;
#pragma unroll
            for (int e = 0; e < 4; ++e) { atomicAdd(m0 + e, a0[e]); atomicAdd(m0 + 6144 + e, a1[e]); atomicAdd(m0 + 2 * 6144 + e, a2[e]); }
        }
    }
}

__device__ __forceinline__ void transpose_item(const float* W, int K, int N, bf16_t* WT, float* scr, int item, int lane) {
    const int nblk = N / 32, kb = item / nblk, nb = item % nblk, k0 = 64 * kb, n0 = 32 * nb;
#pragma unroll 8
    for (int i = 0; i < 32; ++i) { const int kk = 2 * i + (lane >> 5); scr[kk * 33 + (lane & 31)] = W[(size_t)(k0 + kk) * N + n0 + (lane & 31)]; }
    __builtin_amdgcn_s_waitcnt(0xc07f); asm volatile("" ::: "memory");
    const int c = lane & 7;
#pragma unroll
    for (int j = 0; j < 4; ++j) { const int n = (lane >> 3) + 8 * j; const float* s = scr + (8 * c) * 33 + n;
        u32x4 o; o.x = pk2(s[0 * 33], s[1 * 33]); o.y = pk2(s[2 * 33], s[3 * 33]); o.z = pk2(s[4 * 33], s[5 * 33]); o.w = pk2(s[6 * 33], s[7 * 33]);
        *(u32x4*)(WT + (size_t)(n0 + n) * K + k0 + 8 * c) = o; }
    __builtin_amdgcn_s_waitcnt(0xc07f); asm volatile("" ::: "memory");
}
__device__ __forceinline__ void weights_items(const Params& p, float* scr  , int gw, int ngw, int lane) {
    constexpr int I_WINE = 32 * (EVEN_IN / 32), I_WOUT = 32 * (DM / 32), I_WINO = 32 * (ODD_IN / 32), I_POOL = 4 * (256 / 32);
    constexpr int NITEMS = I_WINE + I_WOUT + I_WINO + I_WOUT + 4 * I_POOL;
    for (int it = gw; it < NITEMS; it += ngw) {
        int r = it;
        if (r < I_WINE) { transpose_item(p.even_w_in, DM, EVEN_IN, (bf16_t*)(p.ws + WS_WINE), scr, r, lane); continue; } r -= I_WINE;
        if (r < I_WOUT) { transpose_item(p.even_w_out, DM, DM, (bf16_t*)(p.ws + WS_WOUTE), scr, r, lane); continue; } r -= I_WOUT;
        if (r < I_WINO) { transpose_item(p.gqa_w_in, DM, ODD_IN, (bf16_t*)(p.ws + WS_WINO), scr, r, lane); continue; } r -= I_WINO;
        if (r < I_WOUT) { transpose_item(p.gqa_w_out, DM, DM, (bf16_t*)(p.ws + WS_WOUTO), scr, r, lane); continue; } r -= I_WOUT;
        const int g = r / I_POOL; r -= g * I_POOL;
        transpose_item(p.pool_w + (size_t)g * 65536, 256, 256, (bf16_t*)(p.ws + WS_POOLW) + (size_t)g * 65536, scr, r, lane);
    }
}
__device__ __forceinline__ void caches_rope_items(const Params& p, long gt, long ngt) {
    constexpr long NA = 2L * 8 * 256 * 128 / 4, NC = 2L * 4 * 256 * 128 / 4;
    for (long i = gt; i < 2 * NA + 2 * NC; i += ngt) {
        long j = i; const float* src; bf16_t* dst;
        if (j < NA) { src = p.cache_a_k; dst = (bf16_t*)(p.ws + WS_KSA); } else if ((j -= NA) < NA) { src = p.cache_a_v; dst = (bf16_t*)(p.ws + WS_VSA); }
        else if ((j -= NA) < NC) { src = p.cache_c_k; dst = (bf16_t*)(p.ws + WS_KSC); } else { j -= NC; src = p.cache_c_v; dst = (bf16_t*)(p.ws + WS_VSC); }
        const long e = j * 4, bh = e / (256 * 128), rem = e % (256 * 128);
        const f32x4 v = *(const f32x4*)(src + e);
        u32x2 o; o.x = pk2(v[0], v[1]); o.y = pk2(v[2], v[3]);
        *(u32x2*)(dst + bh * (LKS * 128) + rem) = o;
    }
    float* ropeA = (float*)(p.ws + WS_ROPE); float* ropeC = ropeA + 2 * 1024 * 64;
    for (long i = gt; i < 1024L * 64 + 1024L * 128; i += ngt) {
        const bool isA = i < 1024L * 64; const long j = isA ? i : i - 1024L * 64; const int dim = isA ? 64 : 128, quarter = dim / 4;
        const int t = (int)(j / dim), d = (int)(j % dim); const int qd = d / quarter, fi = d % quarter;
        const float freq = powf(10000.0f, -(float)fi / (float)quarter);
        const float pos = (qd < 2) ? (float)(t / 64) : (float)(t % 64);
        const float ang = pos * freq;
        float* base = isA ? ropeA : ropeC;
        base[j] = cosf(ang); base[(size_t)1024 * dim + j] = sinf(ang);
    }
}

__device__ __forceinline__ void modulate_rows(const Params& p, int layer, int gw, int ngw, int lane) {
    const float* mod = (const float*)(p.ws + WS_MOD) + (size_t)layer * 3 * 6144;
    const float* nw = p.norm_w + layer * DM;
    bf16_t* H = (bf16_t*)(p.ws + WS_HY);
    for (int m = gw; m < MT; m += ngw) {
        const float* xr = layer == 0 ? xrow_ptr(p, m) : p.out + (size_t)m * DM;
        const float* mr = mod + (size_t)cond_row(m) * 6144;
        f32x4 v[8]; float ss = 0.f;
#pragma unroll
        for (int j = 0; j < 8; ++j) { v[j] = *(const f32x4*)(xr + 4 * lane + 256 * j); ss += (v[j][0] * v[j][0] + v[j][1] * v[j][1]) + (v[j][2] * v[j][2] + v[j][3] * v[j][3]); }
        const float rstd = 1.0f / sqrtf(wave_sum(ss) * (1.f / DM) + EPS);
#pragma unroll
        for (int j = 0; j < 8; ++j) { const int k = 4 * lane + 256 * j;
            const f32x4 w = *(const f32x4*)(nw + k), sh = *(const f32x4*)(mr + k), sc = *(const f32x4*)(mr + 2048 + k);
            const f32x4 h = v[j] * rstd * w * (sc + 1.0f) + sh;
            u32x2 o; o.x = pk2(h[0], h[1]); o.y = pk2(h[2], h[3]);
            *(u32x2*)(H + (size_t)m * DM + k) = o; }
    }
}

template <int DIM>
__device__ __forceinline__ f32x4 norm_rope4(f32x4 v, int lg  , const float* w, bool rope, const float* cosr, const float* sinr) {
    float ss = (v[0] * v[0] + v[1] * v[1]) + (v[2] * v[2] + v[3] * v[3]);
#pragma unroll
    for (int o = 1; o < DIM / 4; o <<= 1) ss += __shfl_xor(ss, o);
    const float r = 1.0f / sqrtf(ss * (1.f / DIM) + EPS);
    const f32x4 wv = *(const f32x4*)(w + 4 * lg);
    f32x4 y = v * r * wv;
    f32x4 pr;
#pragma unroll
    for (int e = 0; e < 4; ++e) pr[e] = __shfl_xor(y[e], DIM / 16);
    if (rope) {
        const f32x4 cs = *(const f32x4*)(cosr + 4 * lg), sn = *(const f32x4*)(sinr + 4 * lg);
        const bool odd = ((lg / (DIM / 16)) & 1) != 0;
        y = odd ? (y * cs + pr * sn) : (y * cs - pr * sn);
    }
    return y;
}

__device__ __forceinline__ void post0_rows(const Params& p, int gw, int ngw, int lane) {
    const bf16_t* PR = (const bf16_t*)(p.ws + WS_PR);
    bf16_t* QA = (bf16_t*)(p.ws + WS_Q); bf16_t* UA = (bf16_t*)(p.ws + WS_UA);
    const float* ropeA = (const float*)(p.ws + WS_ROPE);
    float* new_a_k = p.out + (size_t)MT * DM; float* new_a_v = new_a_k + (size_t)NBP * HA * SEQP * 128;
    for (int m = gw; m < MT; m += ngw) {
        const bool smp = m >= MP; const int b = smp ? (m - MP) >> 10 : m >> 8, t = smp ? (m - MP) & 1023 : m & 255;
        const bf16_t* pr = PR + (size_t)m * EVEN_IN;
        const float* cosr = ropeA + (size_t)t * 64; const float* sinr = ropeA + 1024 * 64 + (size_t)t * 64;
        const int sub = lane >> 4, lg = lane & 15;
#pragma unroll 2
        for (int st = 0; st < 8; ++st) {
            const int grp = st * 4 + sub;
            const u32x2 raw = *(const u32x2*)(pr + grp * 64 + 4 * lg);
            f32x4 v = {bflo(raw.x), bfhi(raw.x), bflo(raw.y), bfhi(raw.y)};
            const bool isk = grp >= 16;
            f32x4 y = norm_rope4<64>(v, lg, isk ? p.even_k_norm_w : p.even_q_norm_w, smp, cosr, sinr);
            if (!isk) { y = y * C2A; u32x2 o; o.x = pk2(y[0], y[1]); o.y = pk2(y[2], y[3]); *(u32x2*)(QA + (size_t)m * 1024 + grp * 64 + 4 * lg) = o; }
            else { const int g2 = grp - 16, h = g2 >> 1, j = g2 & 1;
                u32x2 o; o.x = pk2(y[0], y[1]); o.y = pk2(y[2], y[3]);
                if (smp) *(u32x2*)((bf16_t*)(p.ws + WS_KSA) + ((size_t)(b * HA + h) * LKS + PAST + t) * 128 + j * 64 + 4 * lg) = o;
                else { const size_t off = ((size_t)(b * HA + h) * SEQP + t) * 128 + j * 64 + 4 * lg; *(u32x2*)((bf16_t*)(p.ws + WS_KP) + off) = o; *(f32x4*)(new_a_k + off) = y; } }
        }
#pragma unroll
        for (int i = 0; i < 2; ++i) { const int c = 8 * lane + 512 * i, h = c >> 7, d = c & 127;
            const u32x4 raw = *(const u32x4*)(pr + 2048 + c);
            if (smp) *(u32x4*)((bf16_t*)(p.ws + WS_VSA) + ((size_t)(b * HA + h) * LKS + PAST + t) * 128 + d) = raw;
            else { const size_t off = ((size_t)(b * HA + h) * SEQP + t) * 128 + d; *(u32x4*)((bf16_t*)(p.ws + WS_VP) + off) = raw;
                *(f32x4*)(new_a_v + off) = (f32x4){bflo(raw.x), bfhi(raw.x), bflo(raw.y), bfhi(raw.y)}; *(f32x4*)(new_a_v + off + 4) = (f32x4){bflo(raw.z), bfhi(raw.z), bflo(raw.w), bfhi(raw.w)}; } }
        const int L = smp ? SEQS : SEQP;
#pragma unroll
        for (int i = 0; i < 2; ++i) { const int ch = lane + 64 * i, c = 8 * ch, g = ch >> 5, half = 1 << g;
            const int lo = max(t - half, 0), hi = min(t + half, L);
            float s[8] = {0.f, 0.f, 0.f, 0.f, 0.f, 0.f, 0.f, 0.f};
            for (int tt = lo; tt < hi; ++tt) { const u32x4 raw = *(const u32x4*)(pr + (ptrdiff_t)(tt - t) * EVEN_IN + 3072 + c);
                s[0] += bflo(raw.x); s[1] += bfhi(raw.x); s[2] += bflo(raw.y); s[3] += bfhi(raw.y); s[4] += bflo(raw.z); s[5] += bfhi(raw.z); s[6] += bflo(raw.w); s[7] += bfhi(raw.w); }
            const float inv = 1.0f / (float)(hi - lo);
            const u32x4 own = *(const u32x4*)(pr + 3072 + c);
            u32x4 o; o.x = pk2(s[0] * inv - bflo(own.x), s[1] * inv - bfhi(own.x)); o.y = pk2(s[2] * inv - bflo(own.y), s[3] * inv - bfhi(own.y));
            o.z = pk2(s[4] * inv - bflo(own.z), s[5] * inv - bfhi(own.z)); o.w = pk2(s[6] * inv - bflo(own.w), s[7] * inv - bfhi(own.w));
            *(u32x4*)(UA + (size_t)m * 1024 + c) = o; }
    }
}

__device__ __forceinline__ void post1_rows(const Params& p, int gw, int ngw, int lane) {
    const bf16_t* PR = (const bf16_t*)(p.ws + WS_PR);
    bf16_t* QC = (bf16_t*)(p.ws + WS_Q);
    const float* ropeC = (const float*)(p.ws + WS_ROPE) + 2 * 1024 * 64;
    float* new_c_k = p.out + (size_t)MT * DM + 2 * (size_t)NBP * HA * SEQP * 128; float* new_c_v = new_c_k + (size_t)NBP * KVH * SEQP * 128;
    for (int m = gw; m < MT; m += ngw) {
        const bool smp = m >= MP; const int b = smp ? (m - MP) >> 10 : m >> 8, t = smp ? (m - MP) & 1023 : m & 255;
        const bf16_t* pr = PR + (size_t)m * ODD_IN;
        const float* cosr = ropeC + (size_t)t * 128; const float* sinr = ropeC + 1024 * 128 + (size_t)t * 128;
        const int sub = lane >> 5, lg = lane & 31;
#pragma unroll 2
        for (int st = 0; st < 10; ++st) {
            const int grp = st * 2 + sub;
            const u32x2 raw = *(const u32x2*)(pr + grp * 128 + 4 * lg);
            f32x4 v = {bflo(raw.x), bfhi(raw.x), bflo(raw.y), bfhi(raw.y)};
            const bool isk = grp >= 16;
            f32x4 y = norm_rope4<128>(v, lg, isk ? p.gqa_k_norm_w : p.gqa_q_norm_w, smp, cosr, sinr);
            if (!isk) { y = y * C2C; u32x2 o; o.x = pk2(y[0], y[1]); o.y = pk2(y[2], y[3]); *(u32x2*)(QC + (size_t)m * DM + grp * 128 + 4 * lg) = o; }
            else { const int kh = grp - 16;
                u32x2 o; o.x = pk2(y[0], y[1]); o.y = pk2(y[2], y[3]);
                if (smp) *(u32x2*)((bf16_t*)(p.ws + WS_KSC) + ((size_t)(b * KVH + kh) * LKS + PAST + t) * 128 + 4 * lg) = o;
                else { const size_t off = ((size_t)(b * KVH + kh) * SEQP + t) * 128 + 4 * lg; *(u32x2*)((bf16_t*)(p.ws + WS_KP) + off) = o; *(f32x4*)(new_c_k + off) = y; } }
        }
        { const int c = 8 * lane, kh = c >> 7, d = c & 127;
            const u32x4 raw = *(const u32x4*)(pr + 2560 + c);
            if (smp) *(u32x4*)((bf16_t*)(p.ws + WS_VSC) + ((size_t)(b * KVH + kh) * LKS + PAST + t) * 128 + d) = raw;
            else { const size_t off = ((size_t)(b * KVH + kh) * SEQP + t) * 128 + d; *(u32x4*)((bf16_t*)(p.ws + WS_VP) + off) = raw;
                *(f32x4*)(new_c_v + off) = (f32x4){bflo(raw.x), bfhi(raw.x), bflo(raw.y), bfhi(raw.y)}; *(f32x4*)(new_c_v + off + 4) = (f32x4){bflo(raw.z), bfhi(raw.z), bflo(raw.w), bfhi(raw.w)}; } }
    }
}

struct EpiStoreBf16 { bf16_t* C; int ldc; int pad; __device__ void operator()(int r, int c, float v) const { C[(size_t)r * ldc + c] = (bf16_t)f2bf(v); } };
struct EpiPool { bf16_t* Y; const bf16_t* PR; const float* pscale; int g; int pad;
    __device__ void operator()(int r, int c, float v) const { const int cc = g * 256 + c; const float gt = bf2f(PR[(size_t)r * EVEN_IN + 4096 + 1024 + cc]);
        Y[(size_t)r * DM + 1024 + cc] = (bf16_t)f2bf(v * pscale[cc] * siluf(gt)); } };
struct EpiResid { const float* x_prompt; const float* x_sample; const float* base; const float* gate; float* out;
    __device__ void operator()(int r, int c, float v) const { const float bs = base ? base[(size_t)r * DM + c] : (r < MP ? x_prompt[(size_t)r * DM + c] : x_sample[(size_t)(r - MP) * DM + c]);
        out[(size_t)r * DM + c] = bs + gate[(size_t)cond_row(r) * 6144 + c] * v; } };
template <class Epi>
__global__ __launch_bounds__(256) void gemm_naive(const bf16_t* A, int lda, const bf16_t* Bt, int ldb, int M, int N, int K, Epi E) {
    __shared__ float As[16][65], Bs[16][65];
    const int tid = threadIdx.x, tx = tid & 15, ty = tid >> 4;
    const int nbn = N / 64, bm = blockIdx.x / nbn, bn = blockIdx.x % nbn;
    float acc[4][4] = {};
    const int lr = tid >> 2, lc = (tid & 3) * 4;
    for (int k0 = 0; k0 < K; k0 += 16) {
        const u32x2 ra = *(const u32x2*)(A + (size_t)(bm * 64 + lr) * lda + k0 + lc), rb = *(const u32x2*)(Bt + (size_t)(bn * 64 + lr) * ldb + k0 + lc);
        __syncthreads();
        As[lc + 0][lr] = bflo(ra.x); As[lc + 1][lr] = bfhi(ra.x); As[lc + 2][lr] = bflo(ra.y); As[lc + 3][lr] = bfhi(ra.y);
        Bs[lc + 0][lr] = bflo(rb.x); Bs[lc + 1][lr] = bfhi(rb.x); Bs[lc + 2][lr] = bflo(rb.y); Bs[lc + 3][lr] = bfhi(rb.y);
        __syncthreads();
#pragma unroll
        for (int kk = 0; kk < 16; ++kk) { float a[4], b[4];
#pragma unroll
            for (int i = 0; i < 4; ++i) { a[i] = As[kk][ty * 4 + i]; b[i] = Bs[kk][tx * 4 + i]; }
#pragma unroll
            for (int i = 0; i < 4; ++i)
#pragma unroll
                for (int j = 0; j < 4; ++j) acc[i][j] += a[i] * b[j]; }
    }
#pragma unroll
    for (int i = 0; i < 4; ++i)
#pragma unroll
        for (int j = 0; j < 4; ++j) E(bm * 64 + ty * 4 + i, bn * 64 + tx * 4 + j, acc[i][j]);
}

__device__ __forceinline__ void diffattn_tasks(const Params& p, float* s1  , long gw, long ngw, int lane) {
    float* s2 = s1 + LKS; float* qs = s2 + LKS;
    const bf16_t* QA = (const bf16_t*)(p.ws + WS_Q); const bf16_t* PR = (const bf16_t*)(p.ws + WS_PR); bf16_t* Y = (bf16_t*)(p.ws + WS_HY);
    const float lam_init = 0.2f;
    const float lam = expf(wave_sum(p.lam_q1[lane] * p.lam_k1[lane])) - expf(wave_sum(p.lam_q2[lane] * p.lam_k2[lane])) + lam_init;
    for (long task = gw; task < (long)MT * HA; task += ngw) {
        const int m = (int)(task / HA), h = (int)(task % HA);
        const bool smp = m >= MP; const int b = smp ? (m - MP) >> 10 : m >> 8; const int Lk = smp ? LKS : SEQP;
        const bf16_t* Kb = smp ? (const bf16_t*)(p.ws + WS_KSA) + (size_t)(b * HA + h) * LKS * 128 : (const bf16_t*)(p.ws + WS_KP) + (size_t)(b * HA + h) * SEQP * 128;
        const bf16_t* Vb = smp ? (const bf16_t*)(p.ws + WS_VSA) + (size_t)(b * HA + h) * LKS * 128 : (const bf16_t*)(p.ws + WS_VP) + (size_t)(b * HA + h) * SEQP * 128;
        { const unsigned w = *(const unsigned*)(QA + (size_t)m * 1024 + h * 128 + 2 * lane); qs[2 * lane] = bflo(w); qs[2 * lane + 1] = bfhi(w); }
        __builtin_amdgcn_s_waitcnt(0xc07f); asm volatile("" ::: "memory");
        float m1 = -1e30f, m2 = -1e30f;
        for (int j = lane; j < Lk; j += 64) { const bf16_t* kr = Kb + (size_t)j * 128; float a1 = 0.f, a2 = 0.f;
#pragma unroll
            for (int d8 = 0; d8 < 8; ++d8) { const u32x4 w1 = *(const u32x4*)(kr + d8 * 8), w2 = *(const u32x4*)(kr + 64 + d8 * 8); const float* q1 = qs + d8 * 8; const float* q2 = qs + 64 + d8 * 8;
                a1 += q1[0] * bflo(w1.x) + q1[1] * bfhi(w1.x) + q1[2] * bflo(w1.y) + q1[3] * bfhi(w1.y) + q1[4] * bflo(w1.z) + q1[5] * bfhi(w1.z) + q1[6] * bflo(w1.w) + q1[7] * bfhi(w1.w);
                a2 += q2[0] * bflo(w2.x) + q2[1] * bfhi(w2.x) + q2[2] * bflo(w2.y) + q2[3] * bfhi(w2.y) + q2[4] * bflo(w2.z) + q2[5] * bfhi(w2.z) + q2[6] * bflo(w2.w) + q2[7] * bfhi(w2.w); }
            s1[j] = a1; s2[j] = a2; m1 = fmaxf(m1, a1); m2 = fmaxf(m2, a2); }
        m1 = wave_max(m1); m2 = wave_max(m2);
        float l1 = 0.f, l2 = 0.f;
        for (int j = lane; j < Lk; j += 64) { const float e1 = exp2f(s1[j] - m1), e2 = exp2f(s2[j] - m2); s1[j] = e1; s2[j] = e2; l1 += e1; l2 += e2; }
        l1 = wave_sum(l1); l2 = wave_sum(l2);
        const float i1 = 1.f / l1, i2 = lam / l2;
        for (int j = lane; j < Lk; j += 64) s1[j] = s1[j] * i1 - s2[j] * i2;
        __builtin_amdgcn_s_waitcnt(0xc07f); asm volatile("" ::: "memory");
        float o0 = 0.f, o1 = 0.f;
        for (int j = 0; j < Lk; ++j) { const unsigned w = *(const unsigned*)(Vb + (size_t)j * 128 + 2 * lane); const float pj = s1[j]; o0 += pj * bflo(w); o1 += pj * bfhi(w); }
        const float r = 1.0f / sqrtf(wave_sum(o0 * o0 + o1 * o1) * (1.f / 128.f) + EPS);
        const unsigned gw = *(const unsigned*)(PR + (size_t)m * EVEN_IN + 4096 + h * 128 + 2 * lane);
        const float y0 = o0 * r * p.subln_w[2 * lane] * (1.f - lam_init) * siluf(bflo(gw)), y1 = o1 * r * p.subln_w[2 * lane + 1] * (1.f - lam_init) * siluf(bfhi(gw));
        *(unsigned*)(Y + (size_t)m * DM + h * 128 + 2 * lane) = pk2(y0, y1);
        __builtin_amdgcn_s_waitcnt(0xc07f); asm volatile("" ::: "memory");
    }
}
__device__ __forceinline__ void gqa_tasks(const Params& p, float* s1  , long gw, long ngw, int lane) {
    float* qs = s1 + LKS;
    const bf16_t* QC = (const bf16_t*)(p.ws + WS_Q); const bf16_t* PR = (const bf16_t*)(p.ws + WS_PR); bf16_t* Y = (bf16_t*)(p.ws + WS_HY);
    for (long task = gw; task < (long)MT * HC; task += ngw) {
        const int m = (int)(task / HC), hq = (int)(task % HC), kh = hq >> 2;
        const bool smp = m >= MP; const int b = smp ? (m - MP) >> 10 : m >> 8; const int Lk = smp ? LKS : SEQP;
        const bf16_t* Kb = smp ? (const bf16_t*)(p.ws + WS_KSC) + (size_t)(b * KVH + kh) * LKS * 128 : (const bf16_t*)(p.ws + WS_KP) + (size_t)(b * KVH + kh) * SEQP * 128;
        const bf16_t* Vb = smp ? (const bf16_t*)(p.ws + WS_VSC) + (size_t)(b * KVH + kh) * LKS * 128 : (const bf16_t*)(p.ws + WS_VP) + (size_t)(b * KVH + kh) * SEQP * 128;
        { const unsigned w = *(const unsigned*)(QC + (size_t)m * DM + hq * 128 + 2 * lane); qs[2 * lane] = bflo(w); qs[2 * lane + 1] = bfhi(w); }
        __builtin_amdgcn_s_waitcnt(0xc07f); asm volatile("" ::: "memory");
        float m1 = -1e30f;
        for (int j = lane; j < Lk; j += 64) { const bf16_t* kr = Kb + (size_t)j * 128; float a1 = 0.f;
#pragma unroll
            for (int d8 = 0; d8 < 16; ++d8) { const u32x4 w1 = *(const u32x4*)(kr + d8 * 8); const float* q1 = qs + d8 * 8;
                a1 += q1[0] * bflo(w1.x) + q1[1] * bfhi(w1.x) + q1[2] * bflo(w1.y) + q1[3] * bfhi(w1.y) + q1[4] * bflo(w1.z) + q1[5] * bfhi(w1.z) + q1[6] * bflo(w1.w) + q1[7] * bfhi(w1.w); }
            s1[j] = a1; m1 = fmaxf(m1, a1); }
        m1 = wave_max(m1);
        float l1 = 0.f;
        for (int j = lane; j < Lk; j += 64) { const float e1 = exp2f(s1[j] - m1); s1[j] = e1; l1 += e1; }
        l1 = wave_sum(l1);
        __builtin_amdgcn_s_waitcnt(0xc07f); asm volatile("" ::: "memory");
        float o0 = 0.f, o1 = 0.f;
        for (int j = 0; j < Lk; ++j) { const unsigned w = *(const unsigned*)(Vb + (size_t)j * 128 + 2 * lane); const float pj = s1[j]; o0 += pj * bflo(w); o1 += pj * bfhi(w); }
        const float il = 1.f / l1;
        const unsigned gw = *(const unsigned*)(PR + (size_t)m * ODD_IN + 3072 + hq * 128 + 2 * lane);
        *(unsigned*)(Y + (size_t)m * DM + hq * 128 + 2 * lane) = pk2(o0 * il * siluf(bflo(gw)), o1 * il * siluf(bfhi(gw)));
        __builtin_amdgcn_s_waitcnt(0xc07f); asm volatile("" ::: "memory");
    }
}

__global__ __launch_bounds__(256) void diffattn_naive(Params p) { __shared__ float sh[4][2 * LKS + 128]; diffattn_tasks(p, sh[threadIdx.x >> 6], (long)blockIdx.x * 4 + (threadIdx.x >> 6), (long)gridDim.x * 4, threadIdx.x & 63); }
__global__ __launch_bounds__(256) void gqa_naive(Params p) { __shared__ float sh[4][LKS + 128]; gqa_tasks(p, sh[threadIdx.x >> 6], (long)blockIdx.x * 4 + (threadIdx.x >> 6), (long)gridDim.x * 4, threadIdx.x & 63); }
__global__ __launch_bounds__(512) void k_prologue(Params p) {
    __shared__ float scr[8 * 64 * 33];
    const int wid = threadIdx.x >> 6, lane = threadIdx.x & 63;
    mod_items(p, scr, blockIdx.x, gridDim.x, threadIdx.x, blockDim.x);
    __syncthreads();
    weights_items(p, scr + wid * 64 * 33, blockIdx.x * 8 + wid, gridDim.x * 8, lane);
    caches_rope_items(p, (long)blockIdx.x * 512 + threadIdx.x, (long)gridDim.x * 512);
}
__global__ __launch_bounds__(512) void k_modulate(Params p, int layer) { modulate_rows(p, layer, blockIdx.x * 8 + (threadIdx.x >> 6), gridDim.x * 8, threadIdx.x & 63); }
__global__ __launch_bounds__(512) void k_post0(Params p) { post0_rows(p, blockIdx.x * 8 + (threadIdx.x >> 6), gridDim.x * 8, threadIdx.x & 63); }
__global__ __launch_bounds__(512) void k_post1(Params p) { post1_rows(p, blockIdx.x * 8 + (threadIdx.x >> 6), gridDim.x * 8, threadIdx.x & 63); }


namespace pg8 {
#define PG8_LAS __attribute__((address_space(3)))
typedef short bf16x8 __attribute__((ext_vector_type(8)));
constexpr int BM = 256, BK = 64, HALF = 128, HTB = HALF * BK * 2  , STAGE_BYTES = 8 * HTB, NXCD = 8, WGM = 8;
__host__ __device__ __forceinline__ int lds_byte(int r, int c) { const int st = (r >> 4) * 2 + (c >> 5), rr = r & 15, cc = c & 31, ob = rr * 64 + cc * 2; return st * 1024 + (ob ^ (((ob >> 9) & 1) << 5)); }
__host__ __device__ __forceinline__ void stage_rc(int b, int& R, int& C) { const int st = b / 1024, sb = b % 1024, swz = sb ^ (((sb >> 9) & 1) << 5); R = (st >> 1) * 16 + swz / 64; C = (st & 1) * 32 + (swz % 64) / 2; }
__host__ __device__ __forceinline__ int perm32(int rho) { const int n = rho >> 4, i = rho & 15; return 8 * (i >> 2) + 4 * n + (i & 3); }
struct Unit { int pm, pn; };
struct Gemm { const bf16_t* A; const bf16_t* Bt; int M, N, K, lda, ldb, a_pn_off; };
struct StaticOrder {
    int nM, nN, nwg, G, c;
    __host__ __device__ void init(int M, int N, int G_, int c_) { nM = M / BM; nN = N / BM; nwg = nM * nN; G = G_; c = c_; }
    __host__ __device__ bool next(int i, Unit& u) const {
        const long L = (long)i * G + c; if (L >= nwg) return false;
        int wgid = (int)L; { const int q = nwg / NXCD, r = nwg % NXCD, xcd = wgid % NXCD, off = wgid / NXCD; wgid = (xcd < r ? xcd * (q + 1) : r * (q + 1) + (xcd - r) * q) + off; }
        const int nig = WGM * nN, gid = wgid / nig, fm = gid * WGM, gsz = (nM - fm) < WGM ? (nM - fm) : WGM;
        u.pm = fm + ((wgid % nig) % gsz); u.pn = (wgid % nig) / gsz; return true;
    }
    __device__ __forceinline__ void a_ready(const Unit&) const {}
    __device__ __forceinline__ void done(const Unit&) const {}
};
__device__ __forceinline__ unsigned cvt_pk_bf16(float lo, float hi) { unsigned r; asm volatile("v_cvt_pk_bf16_f32 %0, %1, %2" : "=v"(r) : "v"(lo), "v"(hi)); return r; }
struct EpiBf16 {
    static constexpr bool PERM = true, AFTER_DRAIN = false;
    bf16_t* O; int ldc; int pad;
    __device__ __forceinline__ void operator()(const f32x4 (&acc)[2][2][4][2], const Unit& u, int wr, int wc, int fr, int fq) const {
        const int row0 = u.pm * BM + wr * 64 + fr, col0 = u.pn * BM + wc * 32 + 8 * fq;
#pragma unroll
        for (int ai = 0; ai < 2; ++ai)
#pragma unroll
            for (int m = 0; m < 4; ++m) { bf16_t* rowp = O + (size_t)(row0 + ai * HALF + m * 16) * ldc + col0;
#pragma unroll
                for (int bj = 0; bj < 2; ++bj) { const f32x4 v0 = acc[ai][bj][m][0], v1 = acc[ai][bj][m][1];
                    u32x4 w; w.x = cvt_pk_bf16(v0[0], v0[1]); w.y = cvt_pk_bf16(v0[2], v0[3]); w.z = cvt_pk_bf16(v1[0], v1[1]); w.w = cvt_pk_bf16(v1[2], v1[3]);
                    *(u32x4*)(rowp + bj * HALF) = w; } }
    }
};
struct EpiPoolF {
    static constexpr bool PERM = true, AFTER_DRAIN = false;
    bf16_t* Y; const bf16_t* PR; const float* pscale;
    __device__ __forceinline__ void operator()(const f32x4 (&acc)[2][2][4][2], const Unit& u, int wr, int wc, int fr, int fq) const {
        const int row0 = u.pm * BM + wr * 64 + fr, col0 = u.pn * BM + wc * 32 + 8 * fq;
        f32x4 ps[2][2];
#pragma unroll
        for (int bj = 0; bj < 2; ++bj) { ps[bj][0] = *(const f32x4*)(pscale + col0 + bj * HALF); ps[bj][1] = *(const f32x4*)(pscale + col0 + bj * HALF + 4); }
#pragma unroll
        for (int ai = 0; ai < 2; ++ai)
#pragma unroll
            for (int m = 0; m < 4; ++m) { const size_t r = (size_t)(row0 + ai * HALF + m * 16);
#pragma unroll
                for (int bj = 0; bj < 2; ++bj) { const int c = col0 + bj * HALF;
                    const u32x4 g = *(const u32x4*)(PR + r * EVEN_IN + 5120 + c);
                    const f32x4 v0 = acc[ai][bj][m][0] * ps[bj][0], v1 = acc[ai][bj][m][1] * ps[bj][1];
                    u32x4 w; w.x = cvt_pk_bf16(v0[0] * siluf(bflo(g.x)), v0[1] * siluf(bfhi(g.x))); w.y = cvt_pk_bf16(v0[2] * siluf(bflo(g.y)), v0[3] * siluf(bfhi(g.y)));
                    w.z = cvt_pk_bf16(v1[0] * siluf(bflo(g.z)), v1[1] * siluf(bfhi(g.z))); w.w = cvt_pk_bf16(v1[2] * siluf(bflo(g.w)), v1[3] * siluf(bfhi(g.w)));
                    *(u32x4*)(Y + r * DM + 1024 + c) = w; } }
    }
};
struct EpiResidF {
    static constexpr bool PERM = false, AFTER_DRAIN = false;
    const float* xp; const float* xs; const float* base; const float* gate; float* out;
    __device__ __forceinline__ void operator()(const f32x4 (&acc)[2][2][4][2], const Unit& u, int wr, int wc, int fr, int fq) const {
        const int row0 = u.pm * BM + wr * 64 + fr, col0 = u.pn * BM + wc * 32 + 4 * fq;
        const int cr = u.pm < 32 ? 0 : 1 + ((u.pm - 32) >> 2);
        f32x4 gv[2][2];
#pragma unroll
        for (int bj = 0; bj < 2; ++bj)
#pragma unroll
            for (int n = 0; n < 2; ++n) gv[bj][n] = *(const f32x4*)(gate + (size_t)cr * 6144 + col0 + bj * HALF + n * 16);
#pragma unroll
        for (int ai = 0; ai < 2; ++ai)
#pragma unroll
            for (int m = 0; m < 4; ++m) { const int r = row0 + ai * HALF + m * 16;
                const float* bp = (base ? base + (size_t)r * DM : (r < MP ? xp + (size_t)r * DM : xs + (size_t)(r - MP) * DM)) + col0; float* op = out + (size_t)r * DM + col0;
#pragma unroll
                for (int bj = 0; bj < 2; ++bj)
#pragma unroll
                    for (int n = 0; n < 2; ++n) { const f32x4 b = *(const f32x4*)(bp + bj * HALF + n * 16); *(f32x4*)(op + bj * HALF + n * 16) = b + gv[bj][n] * acc[ai][bj][m][n]; }
                if (m & 1) asm volatile("" ::: "memory"); }
    }
};

template <class Epi, class Sched, bool ALIGN_EPI = false, bool SP2 = false>
__device__ __forceinline__ void gemm_phase(PG8_LAS unsigned char* lds, const Gemm g, const Sched& S, const Epi& E, const int tid) {
    const int wid = __builtin_amdgcn_readfirstlane(tid >> 6), lane = tid & 63, wr = wid >> 2, wc = wid & 3, fr = lane & 15, fq = lane >> 4;
    const int K = g.K, nt = K / BK;
    unsigned voffA[2], voffB[2];
#pragma unroll
    for (int i = 0; i < 2; ++i) { int R, C; stage_rc(tid * 16 + i * 8192, R, C); const int Rb = Epi::PERM ? ((R & ~31) + perm32(R & 31)) : R;
        voffA[i] = (unsigned)(R * g.lda + C) * 2u; voffB[i] = (unsigned)(Rb * g.ldb + C) * 2u; }
    const size_t kstep = (size_t)(BK * 2);
    const size_t hstepA = (size_t)HALF * g.lda * 2, hstepB = (size_t)HALF * g.ldb * 2;
    const size_t tstepA = 2 * hstepA, tstepB = 2 * hstepB;
    const unsigned ldsw = (unsigned)wid * 1024u;
    const int aoff = lds_byte(wr * 64 + fr, fq * 8), boff = lds_byte(wc * 32 + fr, fq * 8);
#define PG8_SA(b, h) (((b) * 2 + (h)) * HTB)
#define PG8_SB(b, h) ((4 + (b) * 2 + (h)) * HTB)
#define PG8_STAGE(bufoff, gbase, voff) do { _Pragma("unroll") for (int _i = 0; _i < 2; ++_i) \
        __builtin_amdgcn_global_load_lds((const unsigned*)((const char*)(gbase) + (voff)[_i]), (PG8_LAS unsigned*)(lds + (bufoff) + ldsw + _i * 8192), 16, 0, 0); } while (0)
#define PG8_LDA(dst, b, h) do { _Pragma("unroll") for (int m = 0; m < 4; ++m) _Pragma("unroll") for (int k = 0; k < 2; ++k) dst[m][k] = *(const PG8_LAS bf16x8*)(lds + PG8_SA(b, h) + aoff + m * 2048 + k * 1024); } while (0)
#define PG8_LDB(dst, b, h) do { _Pragma("unroll") for (int n = 0; n < 2; ++n) _Pragma("unroll") for (int k = 0; k < 2; ++k) dst[n][k] = *(const PG8_LAS bf16x8*)(lds + PG8_SB(b, h) + boff + n * 2048 + k * 1024); } while (0)
#define PG8_MMA(ai, bj, At, Bt) do { __builtin_amdgcn_s_setprio(1); _Pragma("unroll") for (int m = 0; m < 4; ++m) _Pragma("unroll") for (int n = 0; n < 2; ++n) _Pragma("unroll") for (int k = 0; k < 2; ++k) \
        acc[ai][bj][m][n] = __builtin_amdgcn_mfma_f32_16x16x32_bf16(Bt[n][k], At[m][k], acc[ai][bj][m][n], 0, 0, 0); __builtin_amdgcn_s_setprio(0); } while (0)
#define PG8_WAIT_V(n) asm volatile("s_waitcnt vmcnt(" #n ")" ::: "memory")
#define PG8_WAIT_L(n) asm volatile("s_waitcnt lgkmcnt(" #n ")" ::: "memory")
#define PG8_BAR __builtin_amdgcn_s_barrier()
#define PG8_SCHED __builtin_amdgcn_sched_barrier(0)
    Unit cur, nxt; int ui = 0;
    if (!S.next(0, cur)) return;
    f32x4 acc[2][2][4][2];
#pragma unroll
    for (int a = 0; a < 2; ++a)
#pragma unroll
        for (int b = 0; b < 2; ++b)
#pragma unroll
            for (int m = 0; m < 4; ++m)
#pragma unroll
                for (int n = 0; n < 2; ++n) acc[a][b][m][n] = (f32x4){0.f, 0.f, 0.f, 0.f};
    bf16x8 At[4][2], B0[2][2], B1[2][2];
    const char* cA = (const char*)g.A + (size_t)cur.pm * tstepA + (size_t)cur.pn * g.a_pn_off * 2; const char* cB = (const char*)g.Bt + (size_t)cur.pn * tstepB;
    S.a_ready(cur);
    if constexpr (SP2) {
        PG8_STAGE(PG8_SB(0, 0), cB, voffB); PG8_STAGE(PG8_SB(0, 1), cB + hstepB, voffB); PG8_STAGE(PG8_SA(0, 0), cA, voffA); PG8_STAGE(PG8_SA(0, 1), cA + hstepA, voffA);
        if (wr == 1) PG8_BAR;
        PG8_WAIT_V(2); PG8_BAR;
        PG8_STAGE(PG8_SB(1, 0), cB + kstep, voffB); PG8_STAGE(PG8_SA(1, 0), cA + kstep, voffA); PG8_STAGE(PG8_SB(1, 1), cB + hstepB + kstep, voffB);
        PG8_WAIT_V(6); PG8_BAR;
    } else {
        PG8_STAGE(PG8_SB(0, 0), cB, voffB); PG8_STAGE(PG8_SA(0, 0), cA, voffA); PG8_STAGE(PG8_SB(0, 1), cB + hstepB, voffB); PG8_STAGE(PG8_SA(0, 1), cA + hstepA, voffA);
        if (wr == 1) PG8_BAR;
        PG8_WAIT_V(4); PG8_BAR;
        PG8_STAGE(PG8_SB(1, 0), cB + kstep, voffB); PG8_STAGE(PG8_SA(1, 0), cA + kstep, voffA); PG8_STAGE(PG8_SB(1, 1), cB + hstepB + kstep, voffB);
        PG8_WAIT_V(6); PG8_BAR;
    }
    for (;;) {
        const bool has_next = S.next(ui + 1, nxt);
        const char* nA = has_next ? (const char*)g.A + (size_t)nxt.pm * tstepA + (size_t)nxt.pn * g.a_pn_off * 2 : cA; const char* nB = has_next ? (const char*)g.Bt + (size_t)nxt.pn * tstepB : cB;
        for (int t = 0; t < nt; t += 2) {
            const bool last = (t == nt - 2);
            const char* a1 = cA + (size_t)(t + 1) * kstep;
            const char* a2 = last ? nA : cA + (size_t)(t + 2) * kstep; const char* b2 = last ? nB : cB + (size_t)(t + 2) * kstep;
            const char* a3 = a2 + kstep; const char* b3 = b2 + kstep;
            if (last && has_next) S.a_ready(nxt);
            if constexpr (SP2) {
            PG8_LDB(B0, 0, 0); PG8_LDB(B1, 0, 1); PG8_SCHED; PG8_LDA(At, 0, 0); PG8_STAGE(PG8_SA(1, 1), a1 + hstepA, voffA);
            PG8_WAIT_V(8); PG8_WAIT_L(0); PG8_BAR; PG8_MMA(0, 0, At, B0); PG8_MMA(0, 1, At, B1); PG8_BAR; PG8_SCHED;
            PG8_LDA(At, 0, 1); PG8_STAGE(PG8_SB(0, 0), b2, voffB); PG8_STAGE(PG8_SB(0, 1), b2 + hstepB, voffB); PG8_STAGE(PG8_SA(0, 0), a2, voffA);
            PG8_WAIT_V(8); PG8_WAIT_L(0); PG8_BAR; PG8_MMA(1, 0, At, B0); PG8_MMA(1, 1, At, B1); PG8_BAR; PG8_SCHED;
            PG8_LDB(B0, 1, 0); PG8_LDB(B1, 1, 1); PG8_SCHED; PG8_LDA(At, 1, 0); PG8_STAGE(PG8_SA(0, 1), a2 + hstepA, voffA);
            PG8_WAIT_V(8); PG8_WAIT_L(0); PG8_BAR; PG8_MMA(0, 0, At, B0); PG8_MMA(0, 1, At, B1); PG8_BAR; PG8_SCHED;
            PG8_LDA(At, 1, 1); PG8_STAGE(PG8_SB(1, 0), b3, voffB); PG8_STAGE(PG8_SB(1, 1), b3 + hstepB, voffB); PG8_STAGE(PG8_SA(1, 0), a3, voffA);
            PG8_WAIT_V(8); PG8_WAIT_L(0); PG8_BAR; PG8_MMA(1, 0, At, B0); PG8_MMA(1, 1, At, B1); PG8_BAR; PG8_SCHED;
            } else {
            PG8_LDB(B0, 0, 0); PG8_SCHED; PG8_LDA(At, 0, 0); PG8_STAGE(PG8_SA(1, 1), a1 + hstepA, voffA);
            PG8_WAIT_L(8); PG8_BAR; PG8_WAIT_L(0); PG8_MMA(0, 0, At, B0); PG8_BAR; PG8_SCHED;
            PG8_LDB(B1, 0, 1); PG8_STAGE(PG8_SB(0, 0), b2, voffB);
            PG8_BAR; PG8_WAIT_L(0); PG8_MMA(0, 1, At, B1); PG8_BAR;
            PG8_LDA(At, 0, 1); PG8_STAGE(PG8_SA(0, 0), a2, voffA);
            PG8_BAR; PG8_WAIT_L(0); PG8_MMA(1, 0, At, B0); PG8_BAR; PG8_SCHED;
            PG8_STAGE(PG8_SB(0, 1), b2 + hstepB, voffB);
            PG8_WAIT_V(6); PG8_BAR; PG8_MMA(1, 1, At, B1); PG8_BAR;
            PG8_LDB(B0, 1, 0); PG8_SCHED; PG8_LDA(At, 1, 0); PG8_STAGE(PG8_SA(0, 1), a2 + hstepA, voffA);
            PG8_WAIT_L(8); PG8_BAR; PG8_WAIT_L(0); PG8_MMA(0, 0, At, B0); PG8_BAR; PG8_SCHED;
            PG8_LDB(B1, 1, 1); PG8_STAGE(PG8_SB(1, 0), b3, voffB);
            PG8_BAR; PG8_WAIT_L(0); PG8_MMA(0, 1, At, B1); PG8_BAR;
            PG8_LDA(At, 1, 1); PG8_STAGE(PG8_SA(1, 0), a3, voffA);
            PG8_BAR; PG8_WAIT_L(0); PG8_MMA(1, 0, At, B0); PG8_BAR; PG8_SCHED;
            PG8_STAGE(PG8_SB(1, 1), b3 + hstepB, voffB);
            PG8_WAIT_V(6); PG8_BAR; PG8_MMA(1, 1, At, B1); PG8_BAR;
            }
        }
        if constexpr (ALIGN_EPI) { if (wr == 0) PG8_BAR; }
        if constexpr (!Epi::AFTER_DRAIN) { E(acc, cur, wr, wc, fr, fq); S.done(cur); }
        if (!has_next) break;
#pragma unroll
        for (int a = 0; a < 2; ++a)
#pragma unroll
            for (int b = 0; b < 2; ++b)
#pragma unroll
                for (int m = 0; m < 4; ++m)
#pragma unroll
                    for (int n = 0; n < 2; ++n) acc[a][b][m][n] = (f32x4){0.f, 0.f, 0.f, 0.f};
        cur = nxt; cA = nA; cB = nB; ++ui;
        if constexpr (ALIGN_EPI) { if (wr == 1) PG8_BAR; }
    }
    PG8_WAIT_V(0);
    if constexpr (!ALIGN_EPI) { if (wr == 0) PG8_BAR; }
    PG8_BAR;
#undef PG8_SA
#undef PG8_SB
#undef PG8_STAGE
#undef PG8_LDA
#undef PG8_LDB
#undef PG8_MMA
#undef PG8_WAIT_V
#undef PG8_WAIT_L
#undef PG8_BAR
#undef PG8_SCHED
}
}

namespace att {
using bf16x8 = __attribute__((ext_vector_type(8))) short;
using s16x4  = __attribute__((ext_vector_type(4))) short;
using f32x16 = __attribute__((ext_vector_type(16))) float;
constexpr int QBLK = 32, KVBLK = 64, LDK = 128;
constexpr int SHM_V = KVBLK * 128 * 2, SHM_K = KVBLK * 128 * 2;
constexpr int WS_OFF = 2 * SHM_V + 2 * SHM_K;
constexpr int STG_OFF = 72 * 1024;
constexpr float THRL = 8.f * LOG2E;
#define KSWZ(row, colB) ((row) * 256 + ((colB) ^ (((row) & 7) << 4)))
#define SBAR() __builtin_amdgcn_sched_barrier(0)
__device__ __forceinline__ int crow(int r, int hi) { return (r & 3) + 8 * (r >> 2) + 4 * hi; }
__device__ __forceinline__ unsigned cvtpk(float lo, float hi) { unsigned r; asm volatile("v_cvt_pk_bf16_f32 %0, %1, %2" : "=v"(r) : "v"(lo), "v"(hi)); return r; }
__device__ __forceinline__ void partialSM(f32x16& p0, f32x16& p1, float& m_reg, float& mn, float& alpha) {
  float pmax = p0[0]; for (int r = 1; r < 16; ++r) pmax = fmaxf(pmax, p0[r]); for (int r = 0; r < 16; ++r) pmax = fmaxf(pmax, p1[r]);
  { auto rr = __builtin_amdgcn_permlane32_swap(__float_as_uint(pmax), __float_as_uint(pmax), false, false);
    pmax = fmaxf(__uint_as_float(rr[0]), __uint_as_float(rr[1])); }
  if (__builtin_expect(__all(pmax - m_reg <= THRL), 1)) { mn = m_reg; alpha = 1.f; }
  else { mn = fmaxf(m_reg, pmax); alpha = __builtin_amdgcn_exp2f(m_reg - mn); m_reg = mn; }
  for (int r = 0; r < 16; ++r) p0[r] = p0[r] - mn; for (int r = 0; r < 16; ++r) p1[r] = p1[r] - mn;
  for (int r = 0; r < 16; ++r) p0[r] = __builtin_amdgcn_exp2f(p0[r]);
}
__device__ __forceinline__ void finishSM(f32x16& p0, f32x16& p1, float alpha, float& l_reg, bf16x8& pa0, bf16x8& pa1, bf16x8& pa2, bf16x8& pa3) {
  for (int r = 0; r < 16; ++r) p1[r] = __builtin_amdgcn_exp2f(p1[r]);
  float ps = 0; for (int r = 0; r < 16; ++r) ps += p0[r]; for (int r = 0; r < 16; ++r) ps += p1[r];
  { auto rr = __builtin_amdgcn_permlane32_swap(__float_as_uint(ps), __float_as_uint(ps), false, false);
    ps = __uint_as_float(rr[0]) + __uint_as_float(rr[1]); }
  l_reg = l_reg * alpha + ps;
#define PK4(P, BASE, OUT) do { unsigned a0 = cvtpk(P[BASE + 0], P[BASE + 1]), a1 = cvtpk(P[BASE + 2], P[BASE + 3]);   \
    unsigned b0 = cvtpk(P[BASE + 4], P[BASE + 5]), b1 = cvtpk(P[BASE + 6], P[BASE + 7]);                              \
    auto r0 = __builtin_amdgcn_permlane32_swap(a0, b0, false, false); auto r1 = __builtin_amdgcn_permlane32_swap(a1, b1, false, false); \
    u32x4 w = {r0[0], r1[0], r0[1], r1[1]}; OUT = *reinterpret_cast<bf16x8*>(&w); } while (0)
  PK4(p0, 0, pa0); PK4(p0, 8, pa1); PK4(p1, 0, pa2); PK4(p1, 8, pa3);
#undef PK4
}
template <int ND0> __device__ __forceinline__ void qkt(f32x16& p0, f32x16& p1, const char* Ks, const bf16x8* qr, int r32, int hi, int kcol0) {
  p0 = f32x16{}; p1 = f32x16{};
#pragma unroll
  for (int d0 = 0; d0 < ND0; ++d0) { int cb = (kcol0 + d0 * 16 + hi * 8) * 2;
    bf16x8 b0 = *reinterpret_cast<const bf16x8*>(Ks + KSWZ(r32, cb));
    bf16x8 b1 = *reinterpret_cast<const bf16x8*>(Ks + KSWZ(32 + r32, cb));
    p0 = __builtin_amdgcn_mfma_f32_32x32x16_bf16(b0, qr[d0], p0, 0, 0, 0);
    p1 = __builtin_amdgcn_mfma_f32_32x32x16_bf16(b1, qr[d0], p1, 0, 0, 0); }
}
__device__ __forceinline__ int v_st(int k, int c) { const int kk = (k & ~0xC) | ((k & 4) << 1) | ((k & 8) >> 1); return ((kk >> 3) * 4 + (c >> 5)) * 512 + ((kk & 7) * 32 + (c & 31)) * 2; }
__device__ __forceinline__ int v_rd_base(int lane) { return ((lane & 3) << 3) | (((lane >> 2) & 3) << 6) | (((lane >> 4) & 1) << 5) | (((lane >> 5) & 1) << 8); }
constexpr int v_rd_off(int d0, int ks, int half) { return d0 * 512 + ks * 4096 + half * 2048; }
template <int OFF> __device__ __forceinline__ s16x4 tr_read(int vb) {
  s16x4 r; asm volatile("ds_read_b64_tr_b16 %0, %1 offset:%2" : "=&v"(r) : "v"(vb), "i"(OFF) : "memory"); return r;
}
template <int D0> __device__ __forceinline__ void pv_one(f32x16& od, int vb, bf16x8 pa0, bf16x8 pa1, bf16x8 pa2, bf16x8 pa3) {
  const s16x4 l0 = tr_read<v_rd_off(D0, 0, 0)>(vb), h0 = tr_read<v_rd_off(D0, 0, 1)>(vb), l1 = tr_read<v_rd_off(D0, 1, 0)>(vb), h1 = tr_read<v_rd_off(D0, 1, 1)>(vb);
  const s16x4 l2 = tr_read<v_rd_off(D0, 2, 0)>(vb), h2 = tr_read<v_rd_off(D0, 2, 1)>(vb), l3 = tr_read<v_rd_off(D0, 3, 0)>(vb), h3 = tr_read<v_rd_off(D0, 3, 1)>(vb);
  asm volatile("s_waitcnt lgkmcnt(0)" ::: "memory"); SBAR();
#define PK(L, H) (bf16x8){L[0], L[1], L[2], L[3], H[0], H[1], H[2], H[3]}
  od = __builtin_amdgcn_mfma_f32_32x32x16_bf16(pa0, PK(l0, h0), od, 0, 0, 0);
  od = __builtin_amdgcn_mfma_f32_32x32x16_bf16(pa1, PK(l1, h1), od, 0, 0, 0);
  od = __builtin_amdgcn_mfma_f32_32x32x16_bf16(pa2, PK(l2, h2), od, 0, 0, 0);
  od = __builtin_amdgcn_mfma_f32_32x32x16_bf16(pa3, PK(l3, h3), od, 0, 0, 0);
#undef PK
}
__device__ __forceinline__ void pv_d0(f32x16* o, int vb, bf16x8 pa0, bf16x8 pa1, bf16x8 pa2, bf16x8 pa3) {
  pv_one<0>(o[0], vb, pa0, pa1, pa2, pa3); pv_one<1>(o[1], vb, pa0, pa1, pa2, pa3); pv_one<2>(o[2], vb, pa0, pa1, pa2, pa3); pv_one<3>(o[3], vb, pa0, pa1, pa2, pa3);
}
template <int ND0>
__device__ __forceinline__ void attn_core(const bf16_t* Qw, const bf16_t* __restrict__ Kh, const bf16_t* __restrict__ Vh, int seq, int kcol0, char* lds, f32x16 (&o)[4], float& l_reg, const int wid, const int lane) {
  const int tid = wid * 64 + lane, r32 = lane & 31, hi = lane >> 5;
  char* V_lds = lds; char* K_lds = lds + 2 * SHM_V;
  float* ws = (float*)(lds + WS_OFF) + wid * 64; float* al_l = ws + 32;
  float m_reg = -1e30f; l_reg = 0; bf16x8 qr[ND0];
#pragma unroll
  for (int d = 0; d < 4; ++d) o[d] = f32x16{};
#pragma unroll
  for (int d0 = 0; d0 < ND0; ++d0) qr[d0] = *reinterpret_cast<const bf16x8*>(Qw + d0 * 16);
  const int sr = tid >> 4, sc = (tid & 15) * 8, vst0 = v_st(sr, sc), vst1 = v_st(32 + sr, sc);
  const int vb0 = (int)(uintptr_t)V_lds + v_rd_base(lane);
  struct { bf16x8 vs0, vs1, ks0, ks1; } sr_[1];
#define SLOAD(i, k0) do { sr_[i].vs0 = *reinterpret_cast<const bf16x8*>(&Vh[(long)((k0) + sr) * LDK + sc]); sr_[i].vs1 = *reinterpret_cast<const bf16x8*>(&Vh[(long)((k0) + 32 + sr) * LDK + sc]); \
    sr_[i].ks0 = *reinterpret_cast<const bf16x8*>(&Kh[(long)((k0) + sr) * LDK + sc]); sr_[i].ks1 = *reinterpret_cast<const bf16x8*>(&Kh[(long)((k0) + 32 + sr) * LDK + sc]); } while (0)
#define SWRITE(b, i) do { *(bf16x8*)(V_lds + (b) * SHM_V + vst0) = sr_[i].vs0;          \
    *(bf16x8*)(V_lds + (b) * SHM_V + vst1) = sr_[i].vs1; int kc = sc * 2;               \
    *(bf16x8*)(K_lds + (b) * SHM_K + KSWZ(sr, kc)) = sr_[i].ks0;                       \
    *(bf16x8*)(K_lds + (b) * SHM_K + KSWZ(32 + sr, kc)) = sr_[i].ks1; } while (0)
#define SWAIT() asm volatile("s_waitcnt vmcnt(0)" ::: "memory")
#define RESC(a) do { if (__any((a) < 1.f)) { if (hi == 0) al_l[r32] = (a); asm volatile("s_waitcnt lgkmcnt(0)" ::: "memory"); \
    for (int d = 0; d < 4; ++d) for (int r = 0; r < 16; ++r) o[d][r] *= al_l[crow(r, hi)]; } } while (0)
  f32x16 pA0, pA1, pB0, pB1; float mnA, mnB, alA, alB; bf16x8 pa0, pa1, pa2, pa3; const int NT = seq / KVBLK;
  SLOAD(0, 0); asm volatile("s_waitcnt vmcnt(0)" ::: "memory"); SWRITE(0, 0); __syncthreads();
  qkt<ND0>(pA0, pA1, K_lds, qr, r32, hi, kcol0); partialSM(pA0, pA1, m_reg, mnA, alA);
  SLOAD(0, KVBLK);
  SWAIT(); SWRITE(1, 0); __syncthreads();
  for (int j = 1; j + 1 < NT; j += 2) {
    SBAR(); qkt<ND0>(pB0, pB1, K_lds + SHM_K, qr, r32, hi, kcol0);
    finishSM(pA0, pA1, alA, l_reg, pa0, pa1, pa2, pa3); SBAR();
    SLOAD(0, (j + 1) * KVBLK); SBAR();
    pv_d0(o, vb0, pa0, pa1, pa2, pa3); partialSM(pB0, pB1, m_reg, mnB, alB);
    __syncthreads(); SWAIT(); SWRITE(0, 0);
    RESC(alB); __syncthreads();
    SBAR(); qkt<ND0>(pA0, pA1, K_lds, qr, r32, hi, kcol0);
    finishSM(pB0, pB1, alB, l_reg, pa0, pa1, pa2, pa3); SBAR();
    SLOAD(0, (j + 2) * KVBLK); SBAR();
    pv_d0(o, vb0 + SHM_V, pa0, pa1, pa2, pa3); partialSM(pA0, pA1, m_reg, mnA, alA);
    __syncthreads(); SWAIT(); SWRITE(1, 0);
    RESC(alA); __syncthreads();
  }
  SBAR(); qkt<ND0>(pB0, pB1, K_lds + SHM_K, qr, r32, hi, kcol0);
  finishSM(pA0, pA1, alA, l_reg, pa0, pa1, pa2, pa3); SBAR();
  pv_d0(o, vb0, pa0, pa1, pa2, pa3); partialSM(pB0, pB1, m_reg, mnB, alB);
  __syncthreads(); RESC(alB);
  finishSM(pB0, pB1, alB, l_reg, pa0, pa1, pa2, pa3); SBAR();
  pv_d0(o, vb0 + SHM_V, pa0, pa1, pa2, pa3);
#undef SLOAD
#undef SWRITE
#undef SWAIT
#undef RESC
}
__device__ __forceinline__ void row_inv_l(float l_reg, char* lds, int wid, int r32, int hi, float (&rli)[16]) {
  float* li_l = (float*)(lds + WS_OFF) + wid * 64;
  if (hi == 0) li_l[r32] = l_reg; asm volatile("s_waitcnt lgkmcnt(0)" ::: "memory");
#pragma unroll
  for (int r = 0; r < 16; ++r) rli[r] = __builtin_amdgcn_rcpf(li_l[crow(r, hi)]);
}
__device__ __forceinline__ void store_rows_gated(const f32x16 (&v)[4], char* stg, bf16_t* Yrow0  , const bf16_t* Grow0, int gpitch, int lane, int r32, int hi) {
  bf16_t* st = (bf16_t*)stg;
#pragma unroll
  for (int r = 0; r < 16; ++r) { const int orow = crow(r, hi);
#pragma unroll
    for (int d0 = 0; d0 < 4; ++d0) st[orow * 128 + d0 * 32 + r32] = (bf16_t)f2bf(v[d0][r]); }
  asm volatile("s_waitcnt lgkmcnt(0)" ::: "memory");
  const bf16_t* gp = Grow0 + (size_t)(lane >> 4) * gpitch + (lane & 15) * 8; bf16_t* yp = Yrow0 + (size_t)(lane >> 4) * DM + (lane & 15) * 8; const bf16_t* sp = st + (lane >> 4) * 128 + (lane & 15) * 8;
  u32x4 g[8];
#pragma unroll
  for (int i = 0; i < 8; ++i) { g[i] = *(const u32x4*)gp; gp += 4 * (size_t)gpitch; asm volatile("" : "+v"(gp)); }
#pragma unroll
  for (int i = 0; i < 8; ++i) {
    const u32x4 x = *(const u32x4*)(sp + i * 4 * 128);
    u32x4 w; w.x = pk2(bflo(x.x) * siluf(bflo(g[i].x)), bfhi(x.x) * siluf(bfhi(g[i].x))); w.y = pk2(bflo(x.y) * siluf(bflo(g[i].y)), bfhi(x.y) * siluf(bfhi(g[i].y)));
    w.z = pk2(bflo(x.z) * siluf(bflo(g[i].z)), bfhi(x.z) * siluf(bfhi(g[i].z))); w.w = pk2(bflo(x.w) * siluf(bflo(g[i].w)), bfhi(x.w) * siluf(bfhi(g[i].w)));
    *(u32x4*)yp = w; yp += 4 * DM; asm volatile("" : "+v"(yp)); }
  asm volatile("s_waitcnt lgkmcnt(0)" ::: "memory");
}
__device__ __forceinline__ void gqa_unit(const Params& p, char* lds, int m0, int hq, const bf16_t* Kh, const bf16_t* Vh, int seq, const int wid) {
  const int lane = fresh_lane(), r32 = lane & 31, hi = lane >> 5;
  const bf16_t* QC = (const bf16_t*)(p.ws + WS_Q); const bf16_t* PR = (const bf16_t*)(p.ws + WS_PR); bf16_t* Y = (bf16_t*)(p.ws + WS_HY);
  f32x16 o[4]; float l_reg;
  attn_core<8>(QC + (size_t)(m0 + wid * QBLK + r32) * DM + hq * 128 + hi * 8, Kh, Vh, seq, 0, lds, o, l_reg, wid, lane);
  float rli[16]; row_inv_l(l_reg, lds, wid, r32, hi, rli);
#pragma unroll
  for (int d0 = 0; d0 < 4; ++d0)
#pragma unroll
    for (int r = 0; r < 16; ++r) o[d0][r] *= rli[r];
  __syncthreads();
  const size_t row0 = (size_t)(m0 + wid * QBLK);
  store_rows_gated(o, lds + wid * 8192, Y + row0 * DM + hq * 128, PR + row0 * ODD_IN + 3072 + hq * 128, ODD_IN, lane, r32, hi);
  __syncthreads();
}
constexpr int RES_WS = 131072 + 1024, RES_EX = 131072 + 4096;
__device__ __forceinline__ void load_kv_resident(const bf16_t* __restrict__ Kh, const bf16_t* __restrict__ Vh, char* lds, int tid) {
  bf16x8 kr[8], vr[8];
#pragma unroll
  for (int i = 0; i < 8; ++i) { const int c = tid + 512 * i; kr[i] = *reinterpret_cast<const bf16x8*>(Kh + (size_t)c * 8); vr[i] = *reinterpret_cast<const bf16x8*>(Vh + (size_t)c * 8); }
#pragma unroll
  for (int i = 0; i < 8; ++i) { const int c = tid + 512 * i, key = c >> 4, col = (c & 15) * 8, t = key >> 6, k = key & 63;
    *(bf16x8*)(lds + 65536 + t * 16384 + v_st(k, col)) = vr[i];
    *(bf16x8*)(lds + t * 16384 + KSWZ(k, col * 2)) = kr[i]; }
}
template <int ND0>
__device__ __forceinline__ void attn_core_res(const bf16_t* Qw, int kcol0, char* lds, f32x16 (&o)[4], float& l_reg, const int wid, const int lane) {
  const int r32 = lane & 31, hi = lane >> 5;
  const char* K_lds = lds; float* al_l = (float*)(lds + RES_WS) + wid * 64 + 32;
  float m_reg = -1e30f; l_reg = 0; bf16x8 qr[ND0];
#pragma unroll
  for (int d = 0; d < 4; ++d) o[d] = f32x16{};
#pragma unroll
  for (int d0 = 0; d0 < ND0; ++d0) qr[d0] = *reinterpret_cast<const bf16x8*>(Qw + d0 * 16);
  const int vb0 = (int)(uintptr_t)(lds + 65536) + v_rd_base(lane);
#define RESC(a) do { if (__any((a) < 1.f)) { if (hi == 0) al_l[r32] = (a); asm volatile("s_waitcnt lgkmcnt(0)" ::: "memory"); \
    for (int d = 0; d < 4; ++d) for (int r = 0; r < 16; ++r) o[d][r] *= al_l[crow(r, hi)]; } } while (0)
  f32x16 pA0, pA1, pB0, pB1; float mnA, mnB, alA, alB; bf16x8 pa0, pa1, pa2, pa3;
  qkt<ND0>(pA0, pA1, K_lds, qr, r32, hi, kcol0); partialSM(pA0, pA1, m_reg, mnA, alA);
  SBAR(); qkt<ND0>(pB0, pB1, K_lds + 16384, qr, r32, hi, kcol0);
  finishSM(pA0, pA1, alA, l_reg, pa0, pa1, pa2, pa3); SBAR();
  pv_d0(o, vb0, pa0, pa1, pa2, pa3); partialSM(pB0, pB1, m_reg, mnB, alB); RESC(alB);
  SBAR(); qkt<ND0>(pA0, pA1, K_lds + 2 * 16384, qr, r32, hi, kcol0);
  finishSM(pB0, pB1, alB, l_reg, pa0, pa1, pa2, pa3); SBAR();
  pv_d0(o, vb0 + 16384, pa0, pa1, pa2, pa3); partialSM(pA0, pA1, m_reg, mnA, alA); RESC(alA);
  SBAR(); qkt<ND0>(pB0, pB1, K_lds + 3 * 16384, qr, r32, hi, kcol0);
  finishSM(pA0, pA1, alA, l_reg, pa0, pa1, pa2, pa3); SBAR();
  pv_d0(o, vb0 + 2 * 16384, pa0, pa1, pa2, pa3); partialSM(pB0, pB1, m_reg, mnB, alB); RESC(alB);
  finishSM(pB0, pB1, alB, l_reg, pa0, pa1, pa2, pa3); SBAR();
  pv_d0(o, vb0 + 3 * 16384, pa0, pa1, pa2, pa3);
#undef RESC
}
__device__ __forceinline__ void row_inv_l_res(float l_reg, char* lds, int wid, int r32, int hi, float (&rli)[16]) {
  float* li_l = (float*)(lds + RES_WS) + wid * 64;
  if (hi == 0) li_l[r32] = l_reg; asm volatile("s_waitcnt lgkmcnt(0)" ::: "memory");
#pragma unroll
  for (int r = 0; r < 16; ++r) rli[r] = __builtin_amdgcn_rcpf(li_l[crow(r, hi)]);
}
__device__ __forceinline__ void store_direct_gated(const f32x16 (&v)[4], char* stg  , bf16_t* Y0  , const bf16_t* G0, int gpitch, int lane, int r32, int hi) {
  bf16_t* st = (bf16_t*)stg;
  const bf16_t* gp = G0 + (size_t)(lane >> 4) * gpitch + (lane & 15) * 8; bf16_t* yp = Y0 + (size_t)(lane >> 4) * DM + (lane & 15) * 8; const bf16_t* sp = st + (lane >> 4) * 128 + (lane & 15) * 8;
  u32x4 g[8];
#pragma unroll
  for (int i = 0; i < 8; ++i) { g[i] = *(const u32x4*)gp; gp += 4 * (size_t)gpitch; asm volatile("" : "+v"(gp)); }
#pragma unroll
  for (int j = 0; j < 4; ++j) {
#pragma unroll
    for (int rr = 0; rr < 4; ++rr)
#pragma unroll
      for (int d0 = 0; d0 < 4; ++d0) st[(rr + 4 * hi) * 128 + d0 * 32 + r32] = (bf16_t)f2bf(v[d0][4 * j + rr]);
    asm volatile("s_waitcnt lgkmcnt(0)" ::: "memory");
#pragma unroll
    for (int i = 0; i < 2; ++i) {
      const u32x4 x = *(const u32x4*)(sp + i * 4 * 128); const u32x4 gg = g[2 * j + i];
      u32x4 w; w.x = pk2(bflo(x.x) * siluf(bflo(gg.x)), bfhi(x.x) * siluf(bfhi(gg.x))); w.y = pk2(bflo(x.y) * siluf(bflo(gg.y)), bfhi(x.y) * siluf(bfhi(gg.y)));
      w.z = pk2(bflo(x.z) * siluf(bflo(gg.z)), bfhi(x.z) * siluf(bfhi(gg.z))); w.w = pk2(bflo(x.w) * siluf(bflo(gg.w)), bfhi(x.w) * siluf(bfhi(gg.w)));
      *(u32x4*)yp = w; yp += 4 * DM; asm volatile("" : "+v"(yp)); }
    asm volatile("s_waitcnt lgkmcnt(0)" ::: "memory");
  }
}
__device__ __forceinline__ void gqa_prompt_slot(const Params& p, char* lds, int bk, const int wid) {
  const int lane = fresh_lane(), r32 = lane & 31, hi = lane >> 5;
  const bf16_t* QC = (const bf16_t*)(p.ws + WS_Q); const bf16_t* PR = (const bf16_t*)(p.ws + WS_PR); bf16_t* Y = (bf16_t*)(p.ws + WS_HY);
  load_kv_resident((const bf16_t*)(p.ws + WS_KP) + (size_t)bk * SEQP * 128, (const bf16_t*)(p.ws + WS_VP) + (size_t)bk * SEQP * 128, lds, wid * 64 + lane);
  __syncthreads();
  const int m0 = (bk >> 2) * SEQP;
  for (int g = 0; g < 4; ++g) {
    const int hq = (bk & 3) * 4 + g;
    f32x16 o[4]; float l_reg;
    const size_t row0 = (size_t)(m0 + wid * QBLK);
    attn_core_res<8>(QC + (row0 + r32) * DM + hq * 128 + hi * 8, 0, lds, o, l_reg, wid, lane);
    float rli[16]; row_inv_l_res(l_reg, lds, wid, r32, hi, rli);
#pragma unroll
    for (int d0 = 0; d0 < 4; ++d0)
#pragma unroll
      for (int r = 0; r < 16; ++r) o[d0][r] *= rli[r];
    store_direct_gated(o, lds + RES_EX + wid * 2048, Y + row0 * DM + hq * 128, PR + row0 * ODD_IN + 3072 + hq * 128, ODD_IN, lane, r32, hi);
  }
  __syncthreads();
}
__device__ __forceinline__ void diff_prompt_slot(const Params& p, char* lds, int slot  , float lam, const int wid) {
  const int lane = fresh_lane(), r32 = lane & 31, hi = lane >> 5, rg = wid & 3, mp = wid >> 2;
  const bf16_t* QA = (const bf16_t*)(p.ws + WS_Q); const bf16_t* PR = (const bf16_t*)(p.ws + WS_PR); bf16_t* Y = (bf16_t*)(p.ws + WS_HY);
  for (int hh = 0; hh < 2; ++hh) {
    const int bh = slot * 2 + hh, h = bh & 7, b = bh >> 3;
    load_kv_resident((const bf16_t*)(p.ws + WS_KP) + (size_t)bh * SEQP * 128, (const bf16_t*)(p.ws + WS_VP) + (size_t)bh * SEQP * 128, lds, wid * 64 + lane);
    __syncthreads();
    for (int qb = 0; qb < 2; ++qb) {
      const size_t row0 = (size_t)(b * SEQP + qb * 128 + rg * QBLK);
      f32x16 o[4]; float l_reg;
      attn_core_res<4>(QA + (row0 + r32) * 1024 + h * 128 + mp * 64 + hi * 8, mp * 64, lds, o, l_reg, wid, lane);
      float rli[16]; row_inv_l_res(l_reg, lds, wid, r32, hi, rli);
      float* ex = (float*)(lds + RES_EX) + rg * 1024 + lane;
      float ss[16];
#pragma unroll
      for (int r = 0; r < 16; ++r) ss[r] = 0.f;
#pragma unroll
      for (int d0 = 0; d0 < 4; ++d0) {
        if (mp == 1) {
#pragma unroll
          for (int r = 0; r < 16; ++r) ex[r * 64] = o[d0][r] * (rli[r] * lam); }
        __syncthreads();
        if (mp == 0) {
#pragma unroll
          for (int r = 0; r < 16; ++r) { const float v = o[d0][r] * rli[r] - ex[r * 64]; o[d0][r] = v; ss[r] += v * v; } }
        __syncthreads();
      }
      if (mp == 0) {
#pragma unroll
        for (int r = 0; r < 16; ++r) {
#pragma unroll
          for (int of = 1; of < 32; of <<= 1) ss[r] += __shfl_xor(ss[r], of);
          ss[r] = 0.8f / sqrtf(ss[r] * (1.f / 128.f) + EPS); }
#pragma unroll
        for (int d0 = 0; d0 < 4; ++d0) { const float sw = p.subln_w[d0 * 32 + r32];
#pragma unroll
          for (int r = 0; r < 16; ++r) o[d0][r] *= ss[r] * sw; }
        store_direct_gated(o, lds + RES_EX + 16384 + rg * 2048, Y + row0 * DM + h * 128, PR + row0 * EVEN_IN + 4096 + h * 128, EVEN_IN, lane, r32, hi);
      }
    }
    __syncthreads();
  }
}
__device__ __forceinline__ void gqa_phase(const Params& p, char* lds, int vcu, int G, const int wid, const int mode) {
  for (int v = vcu; v < 256; v += G) {
    if (v < 128) { if (mode & 1) continue;
      const int qb = v & 3, g = (v >> 2) & 3, bk = v >> 4;
      gqa_unit(p, lds, MP + (bk >> 2) * SEQS + qb * 256, (bk & 3) * 4 + g, (const bf16_t*)(p.ws + WS_KSC) + (size_t)bk * LKS * 128, (const bf16_t*)(p.ws + WS_VSC) + (size_t)bk * LKS * 128, LKS, wid); }
    else { if (mode & 2) continue; gqa_prompt_slot(p, lds, v - 128, wid); }
  }
}
__device__ __forceinline__ void diff_unit(const Params& p, char* lds, int m0, int h, const bf16_t* Kh, const bf16_t* Vh, int seq, float lam, const int wid) {
  const int lane = fresh_lane(), r32 = lane & 31, hi = lane >> 5, rg = wid & 3, mp = wid >> 2;
  const bf16_t* QA = (const bf16_t*)(p.ws + WS_Q); const bf16_t* PR = (const bf16_t*)(p.ws + WS_PR); bf16_t* Y = (bf16_t*)(p.ws + WS_HY);
  f32x16 o[4]; float l_reg;
  attn_core<4>(QA + (size_t)(m0 + rg * QBLK + r32) * 1024 + h * 128 + mp * 64 + hi * 8, Kh, Vh, seq, mp * 64, lds, o, l_reg, wid, lane);
  float rli[16]; row_inv_l(l_reg, lds, wid, r32, hi, rli);
  __syncthreads();
  float* ex = (float*)lds + rg * 4096 + lane;
  if (mp == 1) {
#pragma unroll
    for (int d0 = 0; d0 < 4; ++d0)
#pragma unroll
      for (int r = 0; r < 16; ++r) ex[(d0 * 16 + r) * 64] = o[d0][r] * (rli[r] * lam);
  }
  __syncthreads();
  if (mp == 0) {
    float ss[16];
#pragma unroll
    for (int r = 0; r < 16; ++r) ss[r] = 0.f;
#pragma unroll
    for (int d0 = 0; d0 < 4; ++d0)
#pragma unroll
      for (int r = 0; r < 16; ++r) { const float v = o[d0][r] * rli[r] - ex[(d0 * 16 + r) * 64]; o[d0][r] = v; ss[r] += v * v; }
#pragma unroll
    for (int r = 0; r < 16; ++r) {
#pragma unroll
      for (int of = 1; of < 32; of <<= 1) ss[r] += __shfl_xor(ss[r], of);
      ss[r] = 0.8f / sqrtf(ss[r] * (1.f / 128.f) + EPS); }
#pragma unroll
    for (int d0 = 0; d0 < 4; ++d0) { const float sw = p.subln_w[d0 * 32 + r32];
#pragma unroll
      for (int r = 0; r < 16; ++r) o[d0][r] *= ss[r] * sw; }
    const size_t row0 = (size_t)(m0 + rg * QBLK);
    store_rows_gated(o, lds + STG_OFF + rg * 8192, Y + row0 * DM + h * 128, PR + row0 * EVEN_IN + 4096 + h * 128, EVEN_IN, lane, r32, hi);
  }
  __syncthreads();
}
__device__ __forceinline__ void diff_phase(const Params& p, char* lds, int vcu, int G, const int wid, const int mode) {
  const int lane = fresh_lane();
  const float lam = expf(wave_sum(p.lam_q1[lane] * p.lam_k1[lane])) - expf(wave_sum(p.lam_q2[lane] * p.lam_k2[lane])) + 0.2f;
  for (int v = vcu; v < 256; v += G) {
    if (v < 128) { if (mode & 1) continue;
      const int qb = v & 7, bh = v >> 3;
      diff_unit(p, lds, MP + (bh >> 3) * SEQS + qb * 128, bh & 7, (const bf16_t*)(p.ws + WS_KSA) + (size_t)bh * LKS * 128, (const bf16_t*)(p.ws + WS_VSA) + (size_t)bh * LKS * 128, LKS, lam, wid); }
    else { if (mode & 2) continue; diff_prompt_slot(p, lds, v - 128, lam, wid); }
  }
}
#undef KSWZ
#undef SBAR
}

constexpr int NWAVES = 8;
constexpr int RING_OFF = 0, RING_BYTES = 131072;
constexpr int LDSCTL_OFF = RING_BYTES, MISC_OFF = LDSCTL_OFF + 320;
constexpr int LDS_BYTES = 163840;
constexpr int RES_WS_OFF = RING_BYTES + 1024, RES_EX_OFF = RING_BYTES + 4096;
constexpr int CW_BAR = 4096;
#define GAS __attribute__((address_space(1)))
#define LAS __attribute__((address_space(3)))
typedef GAS unsigned gu32;
#define RLX_AGENT __ATOMIC_RELAXED, __HIP_MEMORY_SCOPE_AGENT
#define XB_TMO      128
#define XB_XCNT(j)  (256  + 64 * (j))
#define XB_XSUB(j)  (1280 + 64 * (j))
#define XB_XGEN(j)  (2304 + 64 * (j))
#define XB_TOP      3328
#define XB_TOPGEN   3392
#define XCD_BAR_WORDS 3456
#define XB_SPIN_CAP (1u << 18)
__device__ __forceinline__ unsigned xb_ld(unsigned* p)              { return __hip_atomic_load(p, __ATOMIC_RELAXED, __HIP_MEMORY_SCOPE_AGENT); }
__device__ __forceinline__ unsigned xb_add(unsigned* p, unsigned v) { return __hip_atomic_fetch_add(p, v, __ATOMIC_RELAXED, __HIP_MEMORY_SCOPE_AGENT); }
__device__ __forceinline__ unsigned xb_xcc_id() { return (unsigned)__builtin_amdgcn_s_getreg((3 << 11) | 20) & 0xFu; }
#define XB_SPIN(cond, bar) do { unsigned _sp = 0; while (cond) { __builtin_amdgcn_s_sleep(1); \
    if ((++_sp & 255u) == 0u) { if (xb_ld(&(bar)[XB_TMO])) break; if (_sp > XB_SPIN_CAP) { atomicAdd(&(bar)[XB_TMO], 1u); break; } } } } while (0)
struct XcdBarrier { unsigned* bar; unsigned x; volatile LAS unsigned* st; };
__device__ __forceinline__ XcdBarrier xcd_barrier_post(unsigned* bar, volatile LAS unsigned* st) {
    XcdBarrier b; b.bar = bar; b.x = xb_xcc_id(); b.st = st;
    if (threadIdx.x == 0) (void)xb_add(&bar[XB_XCNT(b.x)], 1u);
    return b;
}
__device__ __forceinline__ void xcd_barrier_complete(unsigned* bar, unsigned x, unsigned& nloc, unsigned& nx) {
    const unsigned G = gridDim.x * gridDim.y * gridDim.z;
    unsigned sum, cnt, mine, sp = 0u;
    for (;;) {
        sum = 0u; cnt = 0u; mine = 0u;
#pragma unroll
        for (unsigned j = 0; j < 16; ++j) { const unsigned c = xb_ld(&bar[XB_XCNT(j)]); sum += c; cnt += (c > 0u) ? 1u : 0u; mine = (j == x) ? c : mine; }
        if (sum == G) break;
        __builtin_amdgcn_s_sleep(1);
        if ((++sp & 255u) == 0u) { if (xb_ld(&bar[XB_TMO])) break; if (sp > XB_SPIN_CAP) { atomicAdd(&bar[XB_TMO], 1u); break; } }
    }
    nloc = mine > 0u ? mine : 1u; nx = cnt > 0u ? cnt : 1u;
}
__device__ __forceinline__ void xcd_barrier(const XcdBarrier& b) {
    asm volatile("s_waitcnt vmcnt(0)" ::: "memory");
    __syncthreads();
    if (threadIdx.x == 0) {
        unsigned* bar = b.bar;
        __builtin_amdgcn_s_waitcnt(0);
        unsigned nloc = b.st[0], nx = b.st[1];
        if (nloc == 0u) { xcd_barrier_complete(bar, b.x, nloc, nx); b.st[0] = nloc; b.st[1] = nx; }
        const unsigned old = xb_add(&bar[XB_XSUB(b.x)], 1u);
        const unsigned gen = old / nloc;
        if (old + 1u == (gen + 1u) * nloc) {
            __builtin_amdgcn_fence(__ATOMIC_RELEASE, "agent");
            asm volatile("s_waitcnt vmcnt(0)" ::: "memory");
            const unsigned og = xb_add(&bar[XB_TOP], 1u);
            const unsigned tg = og / nx;
            if (og + 1u == (tg + 1u) * nx) xb_add(&bar[XB_TOPGEN], 1u);
            else XB_SPIN(xb_ld(&bar[XB_TOPGEN]) == tg, bar);
            __builtin_amdgcn_fence(__ATOMIC_ACQUIRE, "agent");
            xb_add(&bar[XB_XGEN(b.x)], 1u);
            asm volatile("s_waitcnt vmcnt(0)" ::: "memory");
        } else {
            XB_SPIN(xb_ld(&bar[XB_XGEN(b.x)]) == gen, bar);
            __builtin_amdgcn_fence(__ATOMIC_ACQUIRE, "agent");
            asm volatile("s_waitcnt vmcnt(0)" ::: "memory");
        }
    }
    __syncthreads();
}

struct MegaArgs { Params p; int ph_lo, ph_hi, mode, pad; };
constexpr int N_PHASES = 11;
#ifndef DUP_PHASE
#define DUP_PHASE -1
#endif
__global__ void __launch_bounds__(NWAVES * 64, 2) mega_fwd(MegaArgs args) {
    extern __shared__ __attribute__((aligned(16))) unsigned char lds[];
    const Params& p = args.p;
    LAS unsigned char* ldsl = (LAS unsigned char*)lds;
    volatile LAS unsigned* MISC = (volatile LAS unsigned*)(ldsl + MISC_OFF);
    const int wave = __builtin_amdgcn_readfirstlane(threadIdx.x >> 6);
    const int G = gridDim.x, bx = blockIdx.x;
    const int vcu = (G % 8 == 0) ? (bx % 8) * (G / 8) + bx / 8 : bx;
    for (int u = threadIdx.x; u < (LDS_BYTES - LDSCTL_OFF) / 4; u += NWAVES * 64) ((LAS unsigned*)(ldsl + LDSCTL_OFF))[u] = 0u;
    __syncthreads();
    unsigned char* ws = p.ws;
    XcdBarrier bar = xcd_barrier_post((unsigned*)(ws + WS_CTL) + CW_BAR, MISC + 8);
    const int lo = args.ph_lo, hi = args.ph_hi;
    const int gw = vcu * NWAVES + wave, ngw = G * NWAVES;
#define IN(k) (lo <= (k) && (k) < hi)
#define SEAM(k) do { if (IN(k) && IN((k) + 1)) xcd_barrier(bar); } while (0)
#define REP(k) for (int rep_ = 0; rep_ < ((k) == DUP_PHASE ? 2 : 1); ++rep_, ((k) == DUP_PHASE && rep_ < 2 ? xcd_barrier(bar) : (void)0))
    if (IN(0)) REP(0) {
        float* scr = (float*)lds; const int lane = fresh_lane(), tid = wave * 64 + lane;
        if (rep_ == 0) mod_items(p, scr, bx, G, tid, NWAVES * 64);
        __syncthreads();
        weights_items(p, (float*)(lds + wave * 16384), gw, ngw, lane);
        caches_rope_items(p, (long)bx * 512 + tid, (long)G * 512);
    }
    SEAM(0);
    if (IN(1)) REP(1) modulate_rows(p, 0, gw, ngw, fresh_lane());
    SEAM(1);
    if (IN(2)) REP(2) {
        pg8::Gemm g{(const bf16_t*)(ws + WS_HY), (const bf16_t*)(ws + WS_WINE), MT, EVEN_IN, DM, DM, DM, 0}; pg8::StaticOrder S; S.init(MT, EVEN_IN, G, bx);
        pg8::EpiBf16 E{(bf16_t*)(ws + WS_PR), EVEN_IN, 0};
        pg8::gemm_phase<pg8::EpiBf16, pg8::StaticOrder, true, true>(ldsl + RING_OFF, g, S, E, wave * 64 + fresh_lane());
    }
    SEAM(2);
    if (IN(3)) REP(3) post0_rows(p, gw, ngw, fresh_lane());
    SEAM(3);
    if (IN(4)) REP(4) {
        if (!(args.mode & 4)) { pg8::Gemm g{(const bf16_t*)(ws + WS_UA), (const bf16_t*)(ws + WS_POOLW), MT, 1024, 256, 1024, 256, 256}; pg8::StaticOrder S; S.init(MT, 1024, G, bx);
          pg8::EpiPoolF E{(bf16_t*)(ws + WS_HY), (const bf16_t*)(ws + WS_PR), p.pool_scale};
          pg8::gemm_phase<pg8::EpiPoolF, pg8::StaticOrder, true, true>(ldsl + RING_OFF, g, S, E, wave * 64 + fresh_lane()); }
        __syncthreads();
        att::diff_phase(p, (char*)lds, vcu, G, wave, args.mode);
    }
    SEAM(4);
    if (IN(5)) REP(5) {
        pg8::Gemm g{(const bf16_t*)(ws + WS_HY), (const bf16_t*)(ws + WS_WOUTE), MT, DM, DM, DM, DM, 0}; pg8::StaticOrder S; S.init(MT, DM, G, bx);
        pg8::EpiResidF E{p.x_prompt, p.x_sample, nullptr, (const float*)(ws + WS_MOD) + 4096, p.out};
        pg8::gemm_phase<pg8::EpiResidF, pg8::StaticOrder, true, true>(ldsl + RING_OFF, g, S, E, wave * 64 + fresh_lane());
    }
    SEAM(5);
    if (IN(6)) REP(6) modulate_rows(p, 1, gw, ngw, fresh_lane());
    SEAM(6);
    if (IN(7)) REP(7) {
        pg8::Gemm g{(const bf16_t*)(ws + WS_HY), (const bf16_t*)(ws + WS_WINO), MT, ODD_IN, DM, DM, DM, 0}; pg8::StaticOrder S; S.init(MT, ODD_IN, G, bx);
        pg8::EpiBf16 E{(bf16_t*)(ws + WS_PR), ODD_IN, 0};
        pg8::gemm_phase<pg8::EpiBf16, pg8::StaticOrder, true, true>(ldsl + RING_OFF, g, S, E, wave * 64 + fresh_lane());
    }
    SEAM(7);
    if (IN(8)) REP(8) post1_rows(p, gw, ngw, fresh_lane());
    SEAM(8);
    if (IN(9)) REP(9) att::gqa_phase(p, (char*)lds, vcu, G, wave, args.mode);
    SEAM(9);
    if (IN(10)) {
        pg8::Gemm g{(const bf16_t*)(ws + WS_HY), (const bf16_t*)(ws + WS_WOUTO), MT, DM, DM, DM, DM, 0}; pg8::StaticOrder S; S.init(MT, DM, G, bx);
        pg8::EpiResidF E{p.x_prompt, p.x_sample, p.out, (const float*)(ws + WS_MOD) + 3 * 6144 + 4096, p.out};
        pg8::gemm_phase<pg8::EpiResidF, pg8::StaticOrder, true, true>(ldsl + RING_OFF, g, S, E, wave * 64 + fresh_lane());
    }
#undef IN
#undef SEAM
}

#ifndef MK_PER_PHASE
#define MK_PER_PHASE 0
#endif
extern "C" void kernel_launch(void* const* d_in, const int* in_sizes, int n_in, void* d_out, int out_size, void* d_ws, size_t ws_size, hipStream_t stream) {
    if (n_in != 26 || ws_size < WS_END || out_size != MT * DM + 2 * NBP * HA * SEQP * 128 + 2 * NBP * KVH * SEQP * 128) {
        fprintf(stderr, "kernel_launch: unexpected shapes n_in %d ws %zu out %d\n", n_in, ws_size, out_size); return; }
    static int ready = 0;
    if (!ready) {
        if (hipFuncSetAttribute((const void*)mega_fwd, hipFuncAttributeMaxDynamicSharedMemorySize, LDS_BYTES) != hipSuccess) { fprintf(stderr, "kernel_launch: hipFuncSetAttribute failed\n"); return; }
        ready = 1;
    }
    MegaArgs a{};
    const float** pin = (const float**)&a.p;
    for (int i = 0; i < 26; ++i) pin[i] = (const float*)d_in[i];
    a.p.out = (float*)d_out; a.p.ws = (unsigned char*)d_ws;
#ifdef EXTRA_PHASE
    (void)hipMemsetAsync((unsigned char*)d_ws + WS_CTL, 0, 2 * MiB, stream);
    a.ph_lo = EXTRA_PHASE; a.ph_hi = EXTRA_PHASE + 1; hipLaunchKernelGGL(mega_fwd, dim3(256), dim3(NWAVES * 64), LDS_BYTES, stream, a);
#endif
    (void)hipMemsetAsync((unsigned char*)d_ws + WS_CTL, 0, 2 * MiB, stream);
#if MK_PER_PHASE
    for (int ph = 0; ph < N_PHASES; ++ph) { a.ph_lo = ph; a.ph_hi = ph + 1; hipLaunchKernelGGL(mega_fwd, dim3(256), dim3(NWAVES * 64), LDS_BYTES, stream, a); }
#else
    a.ph_lo = 0; a.ph_hi = N_PHASES; hipLaunchKernelGGL(mega_fwd, dim3(256), dim3(NWAVES * 64), LDS_BYTES, stream, a);
#endif
#ifdef EXTRA_AFTER
    (void)hipMemsetAsync((unsigned char*)d_ws + WS_CTL, 0, 1 * MiB, stream);
    a.ph_lo = EXTRA_AFTER; a.ph_hi = EXTRA_AFTER + 1; a.mode = EXTRA_MODE; hipLaunchKernelGGL(mega_fwd, dim3(256), dim3(NWAVES * 64), LDS_BYTES, stream, a);
#endif
}
```

```cpp
#include <hip/hip_runtime.h>
#include <cstdio>
#include <cstdint>

typedef unsigned short bf16_t;
typedef float f32x4 __attribute__((ext_vector_type(4)));
typedef unsigned u32x4 __attribute__((ext_vector_type(4)));
typedef unsigned u32x2 __attribute__((ext_vector_type(2)));

constexpr int DM = 2048, NBP = 32, SEQP = 256, NBS = 2, SEQS = 1024, PAST = 256;
constexpr int MP = NBP * SEQP, MS = NBS * SEQS, MT = MP + MS;
constexpr int HA = 8, DKA = 64, DVA = 128, WA = 1024, WB = 1024, GWB = 256;
constexpr int EVEN_IN = 6144, ODD_IN = 5120;
constexpr int HC = 16, KVH = 4, HDC = 128;
constexpr int LKS = PAST + SEQS;
constexpr float EPS = 1e-6f;
constexpr float LOG2E = 1.4426950408889634f;
constexpr float C2A = 0.125f * LOG2E;
constexpr float C2C = 0.08838834764831845f * LOG2E;

constexpr size_t MiB = 1u << 20;
constexpr size_t WS_CTL = 0;
constexpr size_t WS_MOD = 1 * MiB;
constexpr size_t WS_ROPE = 2 * MiB;
constexpr size_t WS_WINE = 4 * MiB;
constexpr size_t WS_WOUTE = 28 * MiB;
constexpr size_t WS_WINO = 36 * MiB;
constexpr size_t WS_WOUTO = 56 * MiB;
constexpr size_t WS_POOLW = 64 * MiB;
constexpr size_t WS_HY = 65 * MiB;
constexpr size_t WS_PR = 105 * MiB;
constexpr size_t WS_Q = 225 * MiB;
constexpr size_t WS_KP = 265 * MiB;
constexpr size_t WS_VP = 281 * MiB;
constexpr size_t WS_KSA = 297 * MiB;
constexpr size_t WS_VSA = 302 * MiB;
constexpr size_t WS_KSC = 307 * MiB;
constexpr size_t WS_VSC = 310 * MiB;
constexpr size_t WS_UA = 313 * MiB;
constexpr size_t WS_SG = WS_PR;
constexpr size_t WS_END = 333 * MiB;

struct Params {
    const float* x_prompt; const float* x_sample; const float* cache_a_k; const float* cache_a_v; const float* cache_c_k; const float* cache_c_v;
    const float* c; const float* c_ctx; const float* norm_w; const float* ada_w; const float* ada_b;
    const float* even_w_in; const float* even_q_norm_w; const float* even_k_norm_w; const float* lam_q1; const float* lam_k1; const float* lam_q2; const float* lam_k2;
    const float* subln_w; const float* pool_w; const float* pool_scale; const float* even_w_out;
    const float* gqa_w_in; const float* gqa_q_norm_w; const float* gqa_k_norm_w; const float* gqa_w_out;
    float* out; unsigned char* ws;
};

__device__ __forceinline__ unsigned f2bf(float f) { unsigned u = __builtin_bit_cast(unsigned, f); return (u + 0x7fffu + ((u >> 16) & 1u)) >> 16; }
__device__ __forceinline__ unsigned pk2(float lo, float hi) { return f2bf(lo) | (f2bf(hi) << 16); }
__device__ __forceinline__ float bf2f(unsigned h) { return __builtin_bit_cast(float, h << 16); }
__device__ __forceinline__ float bflo(unsigned w) { return __builtin_bit_cast(float, w << 16); }
__device__ __forceinline__ float bfhi(unsigned w) { return __builtin_bit_cast(float, w & 0xffff0000u); }
__device__ __forceinline__ float siluf(float x) { return x / (1.f + __expf(-x)); }
__device__ __forceinline__ float wave_sum(float v) {
#pragma unroll
    for (int o = 1; o < 64; o <<= 1) v += __shfl_xor(v, o);
    return v;
}
__device__ __forceinline__ float wave_max(float v) {
#pragma unroll
    for (int o = 1; o < 64; o <<= 1) v = fmaxf(v, __shfl_xor(v, o));
    return v;
}
__device__ __forceinline__ int fresh_lane() { int l; asm volatile("v_mbcnt_lo_u32_b32 %0, -1, 0\n\tv_mbcnt_hi_u32_b32 %0, -1, %0" : "=v"(l)); return l; }
__device__ __forceinline__ const float* xrow_ptr(const Params& p, int m) { return m < MP ? p.x_prompt + (size_t)m * DM : p.x_sample + (size_t)(m - MP) * DM; }
__device__ __forceinline__ int cond_row(int m) { return m < MP ? 0 : 1 + ((m - MP) >> 10); }

__device__ __forceinline__ void mod_items(const Params& p, float* sl  , int bid, int nb, int tid, int nthr) {
    float* mod = (float*)(p.ws + WS_MOD);
    for (int it = bid; it < 256; it += nb) {
        const int l = it >> 7, kc = (it >> 2) & 31, nc = it & 3;
        __syncthreads();
        for (int i = tid; i < 192; i += nthr) { const int r = i >> 6, kk = i & 63, k = kc * 64 + kk; const float cv = r == 0 ? p.c_ctx[k] : p.c[(r - 1) * DM + k]; sl[i] = siluf(cv); }
        __syncthreads();
        for (int q = tid; q < 384; q += nthr) {
            const int n = nc * 1536 + q * 4;
            const float* w = p.ada_w + ((size_t)l * DM + kc * 64) * 6144 + n;
            f32x4 a0 = {0.f, 0.f, 0.f, 0.f}, a1 = a0, a2 = a0;
#pragma unroll 16
            for (int kk = 0; kk < 64; ++kk) { const f32x4 wv = *(const f32x4*)(w + (size_t)kk * 6144); a0 += wv * sl[kk]; a1 += wv * sl[64 + kk]; a2 += wv * sl[128 + kk]; }
            if (kc == 0) { const f32x4 b = *(const f32x4*)(p.ada_b + l * 6144 + n); a0 += b; a1 += b; a2 += b; }
            float* m0 = mod + (size_t)(l * 3) * 6144 + n;
#pragma unroll
            for (int e = 0; e < 4; ++e) { atomicAdd(m0 + e, a0[e]); atomicAdd(m0 + 6144 + e, a1[e]); atomicAdd(m0 + 2 * 6144 + e, a2[e]); }
        }
    }
}

__device__ __forceinline__ void transpose_item(const float* W, int K, int N, bf16_t* WT, float* scr, int item, int lane) {
    const int nblk = N / 32, kb = item / nblk, nb = item % nblk, k0 = 64 * kb, n0 = 32 * nb;
#pragma unroll 8
    for (int i = 0; i < 32; ++i) { const int kk = 2 * i + (lane >> 5); scr[kk * 33 + (lane & 31)] = W[(size_t)(k0 + kk) * N + n0 + (lane & 31)]; }
    __builtin_amdgcn_s_waitcnt(0xc07f); asm volatile("" ::: "memory");
    const int c = lane & 7;
#pragma unroll
    for (int j = 0; j < 4; ++j) { const int n = (lane >> 3) + 8 * j; const float* s = scr + (8 * c) * 33 + n;
        u32x4 o; o.x = pk2(s[0 * 33], s[1 * 33]); o.y = pk2(s[2 * 33], s[3 * 33]); o.z = pk2(s[4 * 33], s[5 * 33]); o.w = pk2(s[6 * 33], s[7 * 33]);
        *(u32x4*)(WT + (size_t)(n0 + n) * K + k0 + 8 * c) = o; }
    __builtin_amdgcn_s_waitcnt(0xc07f); asm volatile("" ::: "memory");
}
template <int PERMK> __device__ __forceinline__ int pos_of_col(int n) {
    if (PERMK == 1) { if (n >= 2048) return n; const int c = n & 255, wc = c >> 6, dim = c & 63, q = dim >> 4, ii = dim & 15; return (n & ~255) + 128 * (q & 1) + 32 * wc + (q >> 1) * 16 + ii; }
    if (PERMK == 2) { if (n >= 2560) return n; const int c = n & 255, hl = c >> 7, dim = c & 127, qd = dim >> 5, i = dim & 31; return (n & ~255) + 128 * (qd & 1) + 32 * (2 * hl + (qd >> 1)) + i; }
    return n;
}
template <int PERMK> __device__ __forceinline__ void transpose_item64(const float* W, int K, int N, bf16_t* WT, bf16_t* scr, int item, int lane) {
    const int nblk = N / 64, kb = item / nblk, nb = item % nblk, k0 = 64 * kb, n0 = 64 * nb;
    const int nq = lane & 15, kr = lane >> 4;
    f32x4 v[16];
    const float* src = W + (size_t)(k0 + kr) * N + n0 + 4 * nq;
#pragma unroll
    for (int i = 0; i < 16; ++i) v[i] = *(const f32x4*)(src + (size_t)(4 * i) * N);
#pragma unroll
    for (int i = 0; i < 16; ++i) { const int k = 4 * i + kr;
#pragma unroll
        for (int e = 0; e < 4; ++e) scr[(4 * nq + e) * 72 + k] = (bf16_t)f2bf(v[i][e]); }
    __builtin_amdgcn_s_waitcnt(0xc07f); asm volatile("" ::: "memory");
#pragma unroll
    for (int j = 0; j < 8; ++j) { const int idx = lane + 64 * j, n = idx >> 3, c = idx & 7;
        *(u32x4*)(WT + (size_t)pos_of_col<PERMK>(n0 + n) * K + k0 + 8 * c) = *(const u32x4*)(scr + n * 72 + 8 * c); }
    __builtin_amdgcn_s_waitcnt(0xc07f); asm volatile("" ::: "memory");
}
__device__ __forceinline__ void weights_items(const Params& p, float* scrf  , int gw, int ngw, int lane) {
    bf16_t* scr = (bf16_t*)scrf;
    constexpr int I_WINE = 32 * (EVEN_IN / 64), I_WOUT = 32 * (DM / 64), I_WINO = 32 * (ODD_IN / 64), I_POOL = 4 * 4;
    constexpr int NITEMS = I_WINE + I_WOUT + I_WINO + I_WOUT + 4 * I_POOL;
    for (int it = gw; it < NITEMS; it += ngw) {
        int r = it;
        if (r < I_WINE) { transpose_item64<0>(p.even_w_in, DM, EVEN_IN, (bf16_t*)(p.ws + WS_WINE), scr, r, lane); continue; } r -= I_WINE;
        if (r < I_WOUT) { transpose_item64<0>(p.even_w_out, DM, DM, (bf16_t*)(p.ws + WS_WOUTE), scr, r, lane); continue; } r -= I_WOUT;
        if (r < I_WINO) { transpose_item64<2>(p.gqa_w_in, DM, ODD_IN, (bf16_t*)(p.ws + WS_WINO), scr, r, lane); continue; } r -= I_WINO;
        if (r < I_WOUT) { transpose_item64<0>(p.gqa_w_out, DM, DM, (bf16_t*)(p.ws + WS_WOUTO), scr, r, lane); continue; } r -= I_WOUT;
        const int g = r / I_POOL; r -= g * I_POOL;
        transpose_item64<0>(p.pool_w + (size_t)g * 65536, 256, 256, (bf16_t*)(p.ws + WS_POOLW) + (size_t)g * 65536, scr, r, lane);
    }
}
__device__ __forceinline__ void caches_rope_items(const Params& p, long gt, long ngt) {
    constexpr long NA = 2L * 8 * 256 * 128 / 4, NC = 2L * 4 * 256 * 128 / 4;
    for (long i = gt; i < 2 * NA + 2 * NC; i += ngt) {
        long j = i; const float* src; bf16_t* dst;
        if (j < NA) { src = p.cache_a_k; dst = (bf16_t*)(p.ws + WS_KSA); } else if ((j -= NA) < NA) { src = p.cache_a_v; dst = (bf16_t*)(p.ws + WS_VSA); }
        else if ((j -= NA) < NC) { src = p.cache_c_k; dst = (bf16_t*)(p.ws + WS_KSC); } else { j -= NC; src = p.cache_c_v; dst = (bf16_t*)(p.ws + WS_VSC); }
        const long e = j * 4, bh = e / (256 * 128), rem = e % (256 * 128);
        const f32x4 v = *(const f32x4*)(src + e);
        u32x2 o; o.x = pk2(v[0], v[1]); o.y = pk2(v[2], v[3]);
        *(u32x2*)(dst + bh * (LKS * 128) + rem) = o;
    }
    float* ropeA = (float*)(p.ws + WS_ROPE); float* ropeC = ropeA + 2 * 1024 * 64;
    for (long i = gt; i < 1024L * 64 + 1024L * 128; i += ngt) {
        const bool isA = i < 1024L * 64; const long j = isA ? i : i - 1024L * 64; const int dim = isA ? 64 : 128, quarter = dim / 4;
        const int t = (int)(j / dim), d = (int)(j % dim); const int qd = d / quarter, fi = d % quarter;
        const float freq = powf(10000.0f, -(float)fi / (float)quarter);
        const float pos = (qd < 2) ? (float)(t / 64) : (float)(t % 64);
        const float ang = pos * freq;
        float* base = isA ? ropeA : ropeC;
        base[j] = cosf(ang); base[(size_t)1024 * dim + j] = sinf(ang);
    }
}

__device__ __forceinline__ void modulate_rows(const Params& p, int layer, int gw, int ngw, int lane) {
    const float* mod = (const float*)(p.ws + WS_MOD) + (size_t)layer * 3 * 6144;
    const float* nw = p.norm_w + layer * DM;
    bf16_t* H = (bf16_t*)(p.ws + WS_HY);
    for (int m = gw; m < MT; m += ngw) {
        const float* xr = layer == 0 ? xrow_ptr(p, m) : p.out + (size_t)m * DM;
        const float* mr = mod + (size_t)cond_row(m) * 6144;
        f32x4 v[8]; float ss = 0.f;
#pragma unroll
        for (int j = 0; j < 8; ++j) { v[j] = *(const f32x4*)(xr + 4 * lane + 256 * j); ss += (v[j][0] * v[j][0] + v[j][1] * v[j][1]) + (v[j][2] * v[j][2] + v[j][3] * v[j][3]); }
        const float rstd = 1.0f / sqrtf(wave_sum(ss) * (1.f / DM) + EPS);
#pragma unroll
        for (int j = 0; j < 8; ++j) { const int k = 4 * lane + 256 * j;
            const f32x4 w = *(const f32x4*)(nw + k), sh = *(const f32x4*)(mr + k), sc = *(const f32x4*)(mr + 2048 + k);
            const f32x4 h = v[j] * rstd * w * (sc + 1.0f) + sh;
            u32x2 o; o.x = pk2(h[0], h[1]); o.y = pk2(h[2], h[3]);
            *(u32x2*)(H + (size_t)m * DM + k) = o; }
    }
}

template <int DIM>
__device__ __forceinline__ f32x4 norm_rope4(f32x4 v, int lg  , const float* w, bool rope, const float* cosr, const float* sinr) {
    float ss = (v[0] * v[0] + v[1] * v[1]) + (v[2] * v[2] + v[3] * v[3]);
#pragma unroll
    for (int o = 1; o < DIM / 4; o <<= 1) ss += __shfl_xor(ss, o);
    const float r = 1.0f / sqrtf(ss * (1.f / DIM) + EPS);
    const f32x4 wv = *(const f32x4*)(w + 4 * lg);
    f32x4 y = v * r * wv;
    f32x4 pr;
#pragma unroll
    for (int e = 0; e < 4; ++e) pr[e] = __shfl_xor(y[e], DIM / 16);
    if (rope) {
        const f32x4 cs = *(const f32x4*)(cosr + 4 * lg), sn = *(const f32x4*)(sinr + 4 * lg);
        const bool odd = ((lg / (DIM / 16)) & 1) != 0;
        y = odd ? (y * cs + pr * sn) : (y * cs - pr * sn);
    }
    return y;
}

__device__ __forceinline__ void post0_rows(const Params& p, int gw, int ngw, int lane) {
    const bf16_t* PR = (const bf16_t*)(p.ws + WS_PR);
    bf16_t* QA = (bf16_t*)(p.ws + WS_Q); bf16_t* UA = (bf16_t*)(p.ws + WS_UA);
    const float* ropeA = (const float*)(p.ws + WS_ROPE);
    float* new_a_k = p.out + (size_t)MT * DM; float* new_a_v = new_a_k + (size_t)NBP * HA * SEQP * 128;
    for (int m = gw; m < MT; m += ngw) {
        const bool smp = m >= MP; const int b = smp ? (m - MP) >> 10 : m >> 8, t = smp ? (m - MP) & 1023 : m & 255;
        const bf16_t* pr = PR + (size_t)m * EVEN_IN;
        const float* cosr = ropeA + (size_t)t * 64; const float* sinr = ropeA + 1024 * 64 + (size_t)t * 64;
        const int sub = lane >> 4, lg = lane & 15;
#pragma unroll 2
        for (int st = 0; st < 8; ++st) {
            const int grp = st * 4 + sub;
            const u32x2 raw = *(const u32x2*)(pr + grp * 64 + 4 * lg);
            f32x4 v = {bflo(raw.x), bfhi(raw.x), bflo(raw.y), bfhi(raw.y)};
            const bool isk = grp >= 16;
            f32x4 y = norm_rope4<64>(v, lg, isk ? p.even_k_norm_w : p.even_q_norm_w, smp, cosr, sinr);
            if (!isk) { y = y * C2A; u32x2 o; o.x = pk2(y[0], y[1]); o.y = pk2(y[2], y[3]); *(u32x2*)(QA + (size_t)m * 1024 + grp * 64 + 4 * lg) = o; }
            else { const int g2 = grp - 16, h = g2 >> 1, j = g2 & 1;
                u32x2 o; o.x = pk2(y[0], y[1]); o.y = pk2(y[2], y[3]);
                if (smp) *(u32x2*)((bf16_t*)(p.ws + WS_KSA) + ((size_t)(b * HA + h) * LKS + PAST + t) * 128 + j * 64 + 4 * lg) = o;
                else { const size_t off = ((size_t)(b * HA + h) * SEQP + t) * 128 + j * 64 + 4 * lg; *(u32x2*)((bf16_t*)(p.ws + WS_KP) + off) = o; *(f32x4*)(new_a_k + off) = y; } }
        }
#pragma unroll
        for (int i = 0; i < 2; ++i) { const int c = 8 * lane + 512 * i, h = c >> 7, d = c & 127;
            const u32x4 raw = *(const u32x4*)(pr + 2048 + c);
            if (smp) *(u32x4*)((bf16_t*)(p.ws + WS_VSA) + ((size_t)(b * HA + h) * LKS + PAST + t) * 128 + d) = raw;
            else { const size_t off = ((size_t)(b * HA + h) * SEQP + t) * 128 + d; *(u32x4*)((bf16_t*)(p.ws + WS_VP) + off) = raw;
                *(f32x4*)(new_a_v + off) = (f32x4){bflo(raw.x), bfhi(raw.x), bflo(raw.y), bfhi(raw.y)}; *(f32x4*)(new_a_v + off + 4) = (f32x4){bflo(raw.z), bfhi(raw.z), bflo(raw.w), bfhi(raw.w)}; } }
        const int L = smp ? SEQS : SEQP;
#pragma unroll
        for (int i = 0; i < 2; ++i) { const int ch = lane + 64 * i, c = 8 * ch, g = ch >> 5, half = 1 << g;
            const int lo = max(t - half, 0), hi = min(t + half, L);
            float s[8] = {0.f, 0.f, 0.f, 0.f, 0.f, 0.f, 0.f, 0.f};
            for (int tt = lo; tt < hi; ++tt) { const u32x4 raw = *(const u32x4*)(pr + (ptrdiff_t)(tt - t) * EVEN_IN + 3072 + c);
                s[0] += bflo(raw.x); s[1] += bfhi(raw.x); s[2] += bflo(raw.y); s[3] += bfhi(raw.y); s[4] += bflo(raw.z); s[5] += bfhi(raw.z); s[6] += bflo(raw.w); s[7] += bfhi(raw.w); }
            const float inv = 1.0f / (float)(hi - lo);
            const u32x4 own = *(const u32x4*)(pr + 3072 + c);
            u32x4 o; o.x = pk2(s[0] * inv - bflo(own.x), s[1] * inv - bfhi(own.x)); o.y = pk2(s[2] * inv - bflo(own.y), s[3] * inv - bfhi(own.y));
            o.z = pk2(s[4] * inv - bflo(own.z), s[5] * inv - bfhi(own.z)); o.w = pk2(s[6] * inv - bflo(own.w), s[7] * inv - bfhi(own.w));
            *(u32x4*)(UA + (size_t)m * 1024 + c) = o; }
    }
}

__device__ __forceinline__ void post1_rows(const Params& p, int gw, int ngw, int lane) {
    const bf16_t* PR = (const bf16_t*)(p.ws + WS_PR);
    bf16_t* QC = (bf16_t*)(p.ws + WS_Q);
    const float* ropeC = (const float*)(p.ws + WS_ROPE) + 2 * 1024 * 64;
    float* new_c_k = p.out + (size_t)MT * DM + 2 * (size_t)NBP * HA * SEQP * 128; float* new_c_v = new_c_k + (size_t)NBP * KVH * SEQP * 128;
    for (int m = gw; m < MT; m += ngw) {
        const bool smp = m >= MP; const int b = smp ? (m - MP) >> 10 : m >> 8, t = smp ? (m - MP) & 1023 : m & 255;
        const bf16_t* pr = PR + (size_t)m * ODD_IN;
        const float* cosr = ropeC + (size_t)t * 128; const float* sinr = ropeC + 1024 * 128 + (size_t)t * 128;
        const int sub = lane >> 5, lg = lane & 31;
#pragma unroll 2
        for (int st = 0; st < 10; ++st) {
            const int grp = st * 2 + sub;
            const u32x2 raw = *(const u32x2*)(pr + grp * 128 + 4 * lg);
            f32x4 v = {bflo(raw.x), bfhi(raw.x), bflo(raw.y), bfhi(raw.y)};
            const bool isk = grp >= 16;
            f32x4 y = norm_rope4<128>(v, lg, isk ? p.gqa_k_norm_w : p.gqa_q_norm_w, smp, cosr, sinr);
            if (!isk) { y = y * C2C; u32x2 o; o.x = pk2(y[0], y[1]); o.y = pk2(y[2], y[3]); *(u32x2*)(QC + (size_t)m * DM + grp * 128 + 4 * lg) = o; }
            else { const int kh = grp - 16;
                u32x2 o; o.x = pk2(y[0], y[1]); o.y = pk2(y[2], y[3]);
                if (smp) *(u32x2*)((bf16_t*)(p.ws + WS_KSC) + ((size_t)(b * KVH + kh) * LKS + PAST + t) * 128 + 4 * lg) = o;
                else { const size_t off = ((size_t)(b * KVH + kh) * SEQP + t) * 128 + 4 * lg; *(u32x2*)((bf16_t*)(p.ws + WS_KP) + off) = o; *(f32x4*)(new_c_k + off) = y; } }
        }
        { const int c = 8 * lane, kh = c >> 7, d = c & 127;
            const u32x4 raw = *(const u32x4*)(pr + 2560 + c);
            if (smp) *(u32x4*)((bf16_t*)(p.ws + WS_VSC) + ((size_t)(b * KVH + kh) * LKS + PAST + t) * 128 + d) = raw;
            else { const size_t off = ((size_t)(b * KVH + kh) * SEQP + t) * 128 + d; *(u32x4*)((bf16_t*)(p.ws + WS_VP) + off) = raw;
                *(f32x4*)(new_c_v + off) = (f32x4){bflo(raw.x), bfhi(raw.x), bflo(raw.y), bfhi(raw.y)}; *(f32x4*)(new_c_v + off + 4) = (f32x4){bflo(raw.z), bfhi(raw.z), bflo(raw.w), bfhi(raw.w)}; } }
    }
}

struct EpiStoreBf16 { bf16_t* C; int ldc; int pad; __device__ void operator()(int r, int c, float v) const { C[(size_t)r * ldc + c] = (bf16_t)f2bf(v); } };
struct EpiPool { bf16_t* Y; const bf16_t* PR; const float* pscale; int g; int pad;
    __device__ void operator()(int r, int c, float v) const { const int cc = g * 256 + c; const float gt = bf2f(PR[(size_t)r * EVEN_IN + 4096 + 1024 + cc]);
        Y[(size_t)r * DM + 1024 + cc] = (bf16_t)f2bf(v * pscale[cc] * siluf(gt)); } };
struct EpiResid { const float* x_prompt; const float* x_sample; const float* base; const float* gate; float* out;
    __device__ void operator()(int r, int c, float v) const { const float bs = base ? base[(size_t)r * DM + c] : (r < MP ? x_prompt[(size_t)r * DM + c] : x_sample[(size_t)(r - MP) * DM + c]);
        out[(size_t)r * DM + c] = bs + gate[(size_t)cond_row(r) * 6144 + c] * v; } };
template <class Epi>
__global__ __launch_bounds__(256) void gemm_naive(const bf16_t* A, int lda, const bf16_t* Bt, int ldb, int M, int N, int K, Epi E) {
    __shared__ float As[16][65], Bs[16][65];
    const int tid = threadIdx.x, tx = tid & 15, ty = tid >> 4;
    const int nbn = N / 64, bm = blockIdx.x / nbn, bn = blockIdx.x % nbn;
    float acc[4][4] = {};
    const int lr = tid >> 2, lc = (tid & 3) * 4;
    for (int k0 = 0; k0 < K; k0 += 16) {
        const u32x2 ra = *(const u32x2*)(A + (size_t)(bm * 64 + lr) * lda + k0 + lc), rb = *(const u32x2*)(Bt + (size_t)(bn * 64 + lr) * ldb + k0 + lc);
        __syncthreads();
        As[lc + 0][lr] = bflo(ra.x); As[lc + 1][lr] = bfhi(ra.x); As[lc + 2][lr] = bflo(ra.y); As[lc + 3][lr] = bfhi(ra.y);
        Bs[lc + 0][lr] = bflo(rb.x); Bs[lc + 1][lr] = bfhi(rb.x); Bs[lc + 2][lr] = bflo(rb.y); Bs[lc + 3][lr] = bfhi(rb.y);
        __syncthreads();
#pragma unroll
        for (int kk = 0; kk < 16; ++kk) { float a[4], b[4];
#pragma unroll
            for (int i = 0; i < 4; ++i) { a[i] = As[kk][ty * 4 + i]; b[i] = Bs[kk][tx * 4 + i]; }
#pragma unroll
            for (int i = 0; i < 4; ++i)
#pragma unroll
                for (int j = 0; j < 4; ++j) acc[i][j] += a[i] * b[j]; }
    }
#pragma unroll
    for (int i = 0; i < 4; ++i)
#pragma unroll
        for (int j = 0; j < 4; ++j) E(bm * 64 + ty * 4 + i, bn * 64 + tx * 4 + j, acc[i][j]);
}

__device__ __forceinline__ void diffattn_tasks(const Params& p, float* s1  , long gw, long ngw, int lane) {
    float* s2 = s1 + LKS; float* qs = s2 + LKS;
    const bf16_t* QA = (const bf16_t*)(p.ws + WS_Q); const bf16_t* PR = (const bf16_t*)(p.ws + WS_PR); bf16_t* Y = (bf16_t*)(p.ws + WS_HY);
    const float lam_init = 0.2f;
    const float lam = expf(wave_sum(p.lam_q1[lane] * p.lam_k1[lane])) - expf(wave_sum(p.lam_q2[lane] * p.lam_k2[lane])) + lam_init;
    for (long task = gw; task < (long)MT * HA; task += ngw) {
        const int m = (int)(task / HA), h = (int)(task % HA);
        const bool smp = m >= MP; const int b = smp ? (m - MP) >> 10 : m >> 8; const int Lk = smp ? LKS : SEQP;
        const bf16_t* Kb = smp ? (const bf16_t*)(p.ws + WS_KSA) + (size_t)(b * HA + h) * LKS * 128 : (const bf16_t*)(p.ws + WS_KP) + (size_t)(b * HA + h) * SEQP * 128;
        const bf16_t* Vb = smp ? (const bf16_t*)(p.ws + WS_VSA) + (size_t)(b * HA + h) * LKS * 128 : (const bf16_t*)(p.ws + WS_VP) + (size_t)(b * HA + h) * SEQP * 128;
        { const unsigned w = *(const unsigned*)(QA + (size_t)m * 1024 + h * 128 + 2 * lane); qs[2 * lane] = bflo(w); qs[2 * lane + 1] = bfhi(w); }
        __builtin_amdgcn_s_waitcnt(0xc07f); asm volatile("" ::: "memory");
        float m1 = -1e30f, m2 = -1e30f;
        for (int j = lane; j < Lk; j += 64) { const bf16_t* kr = Kb + (size_t)j * 128; float a1 = 0.f, a2 = 0.f;
#pragma unroll
            for (int d8 = 0; d8 < 8; ++d8) { const u32x4 w1 = *(const u32x4*)(kr + d8 * 8), w2 = *(const u32x4*)(kr + 64 + d8 * 8); const float* q1 = qs + d8 * 8; const float* q2 = qs + 64 + d8 * 8;
                a1 += q1[0] * bflo(w1.x) + q1[1] * bfhi(w1.x) + q1[2] * bflo(w1.y) + q1[3] * bfhi(w1.y) + q1[4] * bflo(w1.z) + q1[5] * bfhi(w1.z) + q1[6] * bflo(w1.w) + q1[7] * bfhi(w1.w);
                a2 += q2[0] * bflo(w2.x) + q2[1] * bfhi(w2.x) + q2[2] * bflo(w2.y) + q2[3] * bfhi(w2.y) + q2[4] * bflo(w2.z) + q2[5] * bfhi(w2.z) + q2[6] * bflo(w2.w) + q2[7] * bfhi(w2.w); }
            s1[j] = a1; s2[j] = a2; m1 = fmaxf(m1, a1); m2 = fmaxf(m2, a2); }
        m1 = wave_max(m1); m2 = wave_max(m2);
        float l1 = 0.f, l2 = 0.f;
        for (int j = lane; j < Lk; j += 64) { const float e1 = exp2f(s1[j] - m1), e2 = exp2f(s2[j] - m2); s1[j] = e1; s2[j] = e2; l1 += e1; l2 += e2; }
        l1 = wave_sum(l1); l2 = wave_sum(l2);
        const float i1 = 1.f / l1, i2 = lam / l2;
        for (int j = lane; j < Lk; j += 64) s1[j] = s1[j] * i1 - s2[j] * i2;
        __builtin_amdgcn_s_waitcnt(0xc07f); asm volatile("" ::: "memory");
        float o0 = 0.f, o1 = 0.f;
        for (int j = 0; j < Lk; ++j) { const unsigned w = *(const unsigned*)(Vb + (size_t)j * 128 + 2 * lane); const float pj = s1[j]; o0 += pj * bflo(w); o1 += pj * bfhi(w); }
        const float r = 1.0f / sqrtf(wave_sum(o0 * o0 + o1 * o1) * (1.f / 128.f) + EPS);
        const unsigned gw = *(const unsigned*)(PR + (size_t)m * EVEN_IN + 4096 + h * 128 + 2 * lane);
        const float y0 = o0 * r * p.subln_w[2 * lane] * (1.f - lam_init) * siluf(bflo(gw)), y1 = o1 * r * p.subln_w[2 * lane + 1] * (1.f - lam_init) * siluf(bfhi(gw));
        *(unsigned*)(Y + (size_t)m * DM + h * 128 + 2 * lane) = pk2(y0, y1);
        __builtin_amdgcn_s_waitcnt(0xc07f); asm volatile("" ::: "memory");
    }
}
__device__ __forceinline__ void gqa_tasks(const Params& p, float* s1  , long gw, long ngw, int lane) {
    float* qs = s1 + LKS;
    const bf16_t* QC = (const bf16_t*)(p.ws + WS_Q); const bf16_t* PR = (const bf16_t*)(p.ws + WS_PR); bf16_t* Y = (bf16_t*)(p.ws + WS_HY);
    for (long task = gw; task < (long)MT * HC; task += ngw) {
        const int m = (int)(task / HC), hq = (int)(task % HC), kh = hq >> 2;
        const bool smp = m >= MP; const int b = smp ? (m - MP) >> 10 : m >> 8; const int Lk = smp ? LKS : SEQP;
        const bf16_t* Kb = smp ? (const bf16_t*)(p.ws + WS_KSC) + (size_t)(b * KVH + kh) * LKS * 128 : (const bf16_t*)(p.ws + WS_KP) + (size_t)(b * KVH + kh) * SEQP * 128;
        const bf16_t* Vb = smp ? (const bf16_t*)(p.ws + WS_VSC) + (size_t)(b * KVH + kh) * LKS * 128 : (const bf16_t*)(p.ws + WS_VP) + (size_t)(b * KVH + kh) * SEQP * 128;
        { const unsigned w = *(const unsigned*)(QC + (size_t)m * DM + hq * 128 + 2 * lane); qs[2 * lane] = bflo(w); qs[2 * lane + 1] = bfhi(w); }
        __builtin_amdgcn_s_waitcnt(0xc07f); asm volatile("" ::: "memory");
        float m1 = -1e30f;
        for (int j = lane; j < Lk; j += 64) { const bf16_t* kr = Kb + (size_t)j * 128; float a1 = 0.f;
#pragma unroll
            for (int d8 = 0; d8 < 16; ++d8) { const u32x4 w1 = *(const u32x4*)(kr + d8 * 8); const float* q1 = qs + d8 * 8;
                a1 += q1[0] * bflo(w1.x) + q1[1] * bfhi(w1.x) + q1[2] * bflo(w1.y) + q1[3] * bfhi(w1.y) + q1[4] * bflo(w1.z) + q1[5] * bfhi(w1.z) + q1[6] * bflo(w1.w) + q1[7] * bfhi(w1.w); }
            s1[j] = a1; m1 = fmaxf(m1, a1); }
        m1 = wave_max(m1);
        float l1 = 0.f;
        for (int j = lane; j < Lk; j += 64) { const float e1 = exp2f(s1[j] - m1); s1[j] = e1; l1 += e1; }
        l1 = wave_sum(l1);
        __builtin_amdgcn_s_waitcnt(0xc07f); asm volatile("" ::: "memory");
        float o0 = 0.f, o1 = 0.f;
        for (int j = 0; j < Lk; ++j) { const unsigned w = *(const unsigned*)(Vb + (size_t)j * 128 + 2 * lane); const float pj = s1[j]; o0 += pj * bflo(w); o1 += pj * bfhi(w); }
        const float il = 1.f / l1;
        const unsigned gw = *(const unsigned*)(PR + (size_t)m * ODD_IN + 3072 + hq * 128 + 2 * lane);
        *(unsigned*)(Y + (size_t)m * DM + hq * 128 + 2 * lane) = pk2(o0 * il * siluf(bflo(gw)), o1 * il * siluf(bfhi(gw)));
        __builtin_amdgcn_s_waitcnt(0xc07f); asm volatile("" ::: "memory");
    }
}

__global__ __launch_bounds__(256) void diffattn_naive(Params p) { __shared__ float sh[4][2 * LKS + 128]; diffattn_tasks(p, sh[threadIdx.x >> 6], (long)blockIdx.x * 4 + (threadIdx.x >> 6), (long)gridDim.x * 4, threadIdx.x & 63); }
__global__ __launch_bounds__(256) void gqa_naive(Params p) { __shared__ float sh[4][LKS + 128]; gqa_tasks(p, sh[threadIdx.x >> 6], (long)blockIdx.x * 4 + (threadIdx.x >> 6), (long)gridDim.x * 4, threadIdx.x & 63); }
__global__ __launch_bounds__(512) void k_prologue(Params p) {
    __shared__ float scr[8 * 2304];
    const int wid = threadIdx.x >> 6, lane = threadIdx.x & 63;
    mod_items(p, scr, blockIdx.x, gridDim.x, threadIdx.x, blockDim.x);
    __syncthreads();
    weights_items(p, scr + wid * 2304, blockIdx.x * 8 + wid, gridDim.x * 8, lane);
    caches_rope_items(p, (long)blockIdx.x * 512 + threadIdx.x, (long)gridDim.x * 512);
}
__global__ __launch_bounds__(512) void k_modulate(Params p, int layer) { modulate_rows(p, layer, blockIdx.x * 8 + (threadIdx.x >> 6), gridDim.x * 8, threadIdx.x & 63); }
__global__ __launch_bounds__(512) void k_post0(Params p) { post0_rows(p, blockIdx.x * 8 + (threadIdx.x >> 6), gridDim.x * 8, threadIdx.x & 63); }
__global__ __launch_bounds__(512) void k_post1(Params p) { post1_rows(p, blockIdx.x * 8 + (threadIdx.x >> 6), gridDim.x * 8, threadIdx.x & 63); }


namespace pg8 {
#define PG8_LAS __attribute__((address_space(3)))
typedef short bf16x8 __attribute__((ext_vector_type(8)));
constexpr int BM = 256, BK = 64, HALF = 128, HTB = HALF * BK * 2  , STAGE_BYTES = 8 * HTB, NXCD = 8, WGM = 8;
__host__ __device__ __forceinline__ int lds_byte(int r, int c) { const int st = (r >> 4) * 2 + (c >> 5), rr = r & 15, cc = c & 31, ob = rr * 64 + cc * 2; return st * 1024 + (ob ^ (((ob >> 9) & 1) << 5)); }
__host__ __device__ __forceinline__ void stage_rc(int b, int& R, int& C) { const int st = b / 1024, sb = b % 1024, swz = sb ^ (((sb >> 9) & 1) << 5); R = (st >> 1) * 16 + swz / 64; C = (st & 1) * 32 + (swz % 64) / 2; }
__host__ __device__ __forceinline__ int perm32(int rho) { const int n = rho >> 4, i = rho & 15; return 8 * (i >> 2) + 4 * n + (i & 3); }
struct Unit { int pm, pn; };
struct Gemm { const bf16_t* A; const bf16_t* Bt; int M, N, K, lda, ldb, a_pn_off; };
struct StaticOrder {
    int nM, nN, nwg, G, c;
    __host__ __device__ void init(int M, int N, int G_, int c_) { nM = M / BM; nN = N / BM; nwg = nM * nN; G = G_; c = c_; }
    __host__ __device__ bool next(int i, Unit& u) const {
        const long L = (long)i * G + c; if (L >= nwg) return false;
        int wgid = (int)L; { const int q = nwg / NXCD, r = nwg % NXCD, xcd = wgid % NXCD, off = wgid / NXCD; wgid = (xcd < r ? xcd * (q + 1) : r * (q + 1) + (xcd - r) * q) + off; }
        const int nig = WGM * nN, gid = wgid / nig, fm = gid * WGM, gsz = (nM - fm) < WGM ? (nM - fm) : WGM;
        u.pm = fm + ((wgid % nig) % gsz); u.pn = (wgid % nig) / gsz; return true;
    }
    __device__ __forceinline__ void a_ready(const Unit&) const {}
    __device__ __forceinline__ void done(const Unit&) const {}
};
__device__ __forceinline__ unsigned cvt_pk_bf16(float lo, float hi) { unsigned r; asm volatile("v_cvt_pk_bf16_f32 %0, %1, %2" : "=v"(r) : "v"(lo), "v"(hi)); return r; }
struct EpiBf16 {
    static constexpr bool PERM = true, AFTER_DRAIN = false;
    bf16_t* O; int ldc; int pad;
    __device__ __forceinline__ void operator()(const f32x4 (&acc)[2][2][4][2], const Unit& u, int wr, int wc, int fr, int fq) const {
        const int row0 = u.pm * BM + wr * 64 + fr, col0 = u.pn * BM + wc * 32 + 8 * fq;
#pragma unroll
        for (int ai = 0; ai < 2; ++ai)
#pragma unroll
            for (int m = 0; m < 4; ++m) { bf16_t* rowp = O + (size_t)(row0 + ai * HALF + m * 16) * ldc + col0;
#pragma unroll
                for (int bj = 0; bj < 2; ++bj) { const f32x4 v0 = acc[ai][bj][m][0], v1 = acc[ai][bj][m][1];
                    u32x4 w; w.x = cvt_pk_bf16(v0[0], v0[1]); w.y = cvt_pk_bf16(v0[2], v0[3]); w.z = cvt_pk_bf16(v1[0], v1[1]); w.w = cvt_pk_bf16(v1[2], v1[3]);
                    *(u32x4*)(rowp + bj * HALF) = w; } }
    }
};
struct EpiPoolF {
    static constexpr bool PERM = true, AFTER_DRAIN = false;
    bf16_t* Y; const bf16_t* PR; const float* pscale;
    __device__ __forceinline__ void operator()(const f32x4 (&acc)[2][2][4][2], const Unit& u, int wr, int wc, int fr, int fq) const {
        const int row0 = u.pm * BM + wr * 64 + fr, col0 = u.pn * BM + wc * 32 + 8 * fq;
        f32x4 ps[2][2];
#pragma unroll
        for (int bj = 0; bj < 2; ++bj) { ps[bj][0] = *(const f32x4*)(pscale + col0 + bj * HALF); ps[bj][1] = *(const f32x4*)(pscale + col0 + bj * HALF + 4); }
#pragma unroll
        for (int ai = 0; ai < 2; ++ai)
#pragma unroll
            for (int m = 0; m < 4; ++m) { const size_t r = (size_t)(row0 + ai * HALF + m * 16);
#pragma unroll
                for (int bj = 0; bj < 2; ++bj) { const int c = col0 + bj * HALF;
                    const u32x4 g = *(const u32x4*)(PR + r * EVEN_IN + 5120 + c);
                    const f32x4 v0 = acc[ai][bj][m][0] * ps[bj][0], v1 = acc[ai][bj][m][1] * ps[bj][1];
                    u32x4 w; w.x = cvt_pk_bf16(v0[0] * siluf(bflo(g.x)), v0[1] * siluf(bfhi(g.x))); w.y = cvt_pk_bf16(v0[2] * siluf(bflo(g.y)), v0[3] * siluf(bfhi(g.y)));
                    w.z = cvt_pk_bf16(v1[0] * siluf(bflo(g.z)), v1[1] * siluf(bfhi(g.z))); w.w = cvt_pk_bf16(v1[2] * siluf(bflo(g.w)), v1[3] * siluf(bfhi(g.w)));
                    *(u32x4*)(Y + r * DM + 1024 + c) = w; } }
    }
};
struct EpiProj1 {
    static constexpr bool PERM = true, AFTER_DRAIN = false;
    unsigned char* ws; const float* qw; const float* kw; float* nck; float* ncv; PG8_LAS float* xs;
    __device__ __forceinline__ void operator()(const f32x4 (&acc)[2][2][4][2], const Unit& u, int wr, int wc, int fr, int fq) const {
        const int pm = u.pm, pn = u.pn;
        const bool smp = pm >= 32; const int b = smp ? (pm - 32) >> 2 : pm, tb = (smp ? ((pm - 32) & 3) * 256 : 0) + wr * 64 + fr;
        const size_t rowb = (size_t)pm * 256 + wr * 64 + fr;
        if (pn < 10) {
            const bool isk = pn >= 8; const int hl = wc >> 1, w1 = wc & 1, head = (isk ? (pn - 8) : pn) * 2 + hl;
            const float* w = isk ? kw : qw;
            f32x4 wv[2][2];
#pragma unroll
            for (int bj = 0; bj < 2; ++bj)
#pragma unroll
                for (int n = 0; n < 2; ++n) wv[bj][n] = *(const f32x4*)(w + (2 * w1 + bj) * 32 + 8 * fq + 4 * n);
            PG8_LAS float* xo = xs + (wr * 4 + wc) * 128; PG8_LAS float* xp = xs + (wr * 4 + (wc ^ 1)) * 128;
#pragma unroll
            for (int ai = 0; ai < 2; ++ai)
#pragma unroll
                for (int m = 0; m < 4; ++m) { float ss = 0.f;
#pragma unroll
                    for (int bj = 0; bj < 2; ++bj)
#pragma unroll
                        for (int n = 0; n < 2; ++n) { const f32x4 x = acc[ai][bj][m][n]; ss += (x[0] * x[0] + x[1] * x[1]) + (x[2] * x[2] + x[3] * x[3]); }
                    ss += __shfl_xor(ss, 16); ss += __shfl_xor(ss, 32);
                    if (fq == 0) xo[ai * 64 + m * 16 + fr] = ss; }
            asm volatile("s_waitcnt lgkmcnt(0)" ::: "memory"); __builtin_amdgcn_s_barrier(); asm volatile("" ::: "memory");
            const float* ropeC = (const float*)(ws + WS_ROPE) + 2 * 1024 * 64;
#pragma unroll
            for (int ai = 0; ai < 2; ++ai)
#pragma unroll
                for (int m = 0; m < 4; ++m) { const int idx = ai * 64 + m * 16 + fr, t = tb + ai * 128 + m * 16; const size_t row = rowb + ai * 128 + m * 16;
                    const float rinv = 1.0f / sqrtf((xo[idx] + xp[idx]) * (1.f / 128.f) + EPS);
                    f32x4 y[2][2];
#pragma unroll
                    for (int bj = 0; bj < 2; ++bj)
#pragma unroll
                        for (int n = 0; n < 2; ++n) y[bj][n] = acc[ai][bj][m][n] * rinv * wv[bj][n];
                    if (smp) {
#pragma unroll
                        for (int n = 0; n < 2; ++n) { const f32x4 cs = *(const f32x4*)(ropeC + (size_t)t * 128 + 64 * w1 + 8 * fq + 4 * n), sn = *(const f32x4*)(ropeC + 1024 * 128 + (size_t)t * 128 + 64 * w1 + 8 * fq + 4 * n);
                            const f32x4 a = y[0][n], bb = y[1][n]; y[0][n] = a * cs - bb * sn; y[1][n] = bb * cs + a * sn; } }
                    if (!isk) { bf16_t* qp = (bf16_t*)(ws + WS_Q) + row * DM + head * 128 + 8 * fq;
#pragma unroll
                        for (int bj = 0; bj < 2; ++bj) { const f32x4 v0 = y[bj][0] * C2C, v1 = y[bj][1] * C2C;
                            u32x4 o; o.x = cvt_pk_bf16(v0[0], v0[1]); o.y = cvt_pk_bf16(v0[2], v0[3]); o.z = cvt_pk_bf16(v1[0], v1[1]); o.w = cvt_pk_bf16(v1[2], v1[3]);
                            *(u32x4*)(qp + (2 * w1 + bj) * 32) = o; } }
                    else { const size_t koff = smp ? ((size_t)(b * KVH + head) * LKS + PAST + t) * 128 : ((size_t)(b * KVH + head) * SEQP + t) * 128;
                        bf16_t* kp = (bf16_t*)(ws + (smp ? WS_KSC : WS_KP)) + koff + 8 * fq;
#pragma unroll
                        for (int bj = 0; bj < 2; ++bj) { const f32x4 v0 = y[bj][0], v1 = y[bj][1];
                            u32x4 o; o.x = cvt_pk_bf16(v0[0], v0[1]); o.y = cvt_pk_bf16(v0[2], v0[3]); o.z = cvt_pk_bf16(v1[0], v1[1]); o.w = cvt_pk_bf16(v1[2], v1[3]);
                            *(u32x4*)(kp + (2 * w1 + bj) * 32) = o;
                            if (!smp) { float* fp = nck + koff + 8 * fq + (2 * w1 + bj) * 32; *(f32x4*)fp = v0; *(f32x4*)(fp + 4) = v1; } } }
                }
        } else if (pn < 12) {
#pragma unroll
            for (int ai = 0; ai < 2; ++ai)
#pragma unroll
                for (int m = 0; m < 4; ++m) { const int t = tb + ai * 128 + m * 16;
#pragma unroll
                    for (int bj = 0; bj < 2; ++bj) { const int kvh = (pn - 10) * 2 + bj, d = 32 * wc + 8 * fq;
                        const size_t voff = (smp ? ((size_t)(b * KVH + kvh) * LKS + PAST + t) * 128 : ((size_t)(b * KVH + kvh) * SEQP + t) * 128) + d;
                        const f32x4 v0 = acc[ai][bj][m][0], v1 = acc[ai][bj][m][1];
                        u32x4 o; o.x = cvt_pk_bf16(v0[0], v0[1]); o.y = cvt_pk_bf16(v0[2], v0[3]); o.z = cvt_pk_bf16(v1[0], v1[1]); o.w = cvt_pk_bf16(v1[2], v1[3]);
                        *(u32x4*)((bf16_t*)(ws + (smp ? WS_VSC : WS_VP)) + voff) = o;
                        if (!smp) { *(f32x4*)(ncv + voff) = v0; *(f32x4*)(ncv + voff + 4) = v1; } } }
        } else {
            bf16_t* sg = (bf16_t*)(ws + WS_SG) + (pn - 12) * 256 + 32 * wc + 8 * fq;
#pragma unroll
            for (int ai = 0; ai < 2; ++ai)
#pragma unroll
                for (int m = 0; m < 4; ++m) { const size_t row = rowb + ai * 128 + m * 16;
#pragma unroll
                    for (int bj = 0; bj < 2; ++bj) { const f32x4 v0 = acc[ai][bj][m][0], v1 = acc[ai][bj][m][1];
                        u32x4 o; o.x = cvt_pk_bf16(siluf(v0[0]), siluf(v0[1])); o.y = cvt_pk_bf16(siluf(v0[2]), siluf(v0[3])); o.z = cvt_pk_bf16(siluf(v1[0]), siluf(v1[1])); o.w = cvt_pk_bf16(siluf(v1[2]), siluf(v1[3]));
                        *(u32x4*)(sg + row * DM + bj * HALF) = o; } }
        }
    }
};
struct EpiResidF {
    static constexpr bool PERM = false, AFTER_DRAIN = false;
    const float* xp; const float* xs; const float* base; const float* gate; float* out;
    __device__ __forceinline__ void operator()(const f32x4 (&acc)[2][2][4][2], const Unit& u, int wr, int wc, int fr, int fq) const {
        const int row0 = u.pm * BM + wr * 64 + fr, col0 = u.pn * BM + wc * 32 + 4 * fq;
        const int cr = u.pm < 32 ? 0 : 1 + ((u.pm - 32) >> 2);
        f32x4 gv[2][2];
#pragma unroll
        for (int bj = 0; bj < 2; ++bj)
#pragma unroll
            for (int n = 0; n < 2; ++n) gv[bj][n] = *(const f32x4*)(gate + (size_t)cr * 6144 + col0 + bj * HALF + n * 16);
#pragma unroll
        for (int ai = 0; ai < 2; ++ai)
#pragma unroll
            for (int m = 0; m < 4; ++m) { const int r = row0 + ai * HALF + m * 16;
                const float* bp = (base ? base + (size_t)r * DM : (r < MP ? xp + (size_t)r * DM : xs + (size_t)(r - MP) * DM)) + col0; float* op = out + (size_t)r * DM + col0;
#pragma unroll
                for (int bj = 0; bj < 2; ++bj)
#pragma unroll
                    for (int n = 0; n < 2; ++n) { const f32x4 b = *(const f32x4*)(bp + bj * HALF + n * 16); *(f32x4*)(op + bj * HALF + n * 16) = b + gv[bj][n] * acc[ai][bj][m][n]; }
                if (m & 1) asm volatile("" ::: "memory"); }
    }
};

template <class Epi, class Sched, bool ALIGN_EPI = false, bool SP2 = false>
__device__ __forceinline__ void gemm_phase(PG8_LAS unsigned char* lds, const Gemm g, const Sched& S, const Epi& E, const int tid) {
    const int wid = __builtin_amdgcn_readfirstlane(tid >> 6), lane = tid & 63, wr = wid >> 2, wc = wid & 3, fr = lane & 15, fq = lane >> 4;
    const int K = g.K, nt = K / BK;
    unsigned voffA[2], voffB[2];
#pragma unroll
    for (int i = 0; i < 2; ++i) { int R, C; stage_rc(tid * 16 + i * 8192, R, C); const int Rb = Epi::PERM ? ((R & ~31) + perm32(R & 31)) : R;
        voffA[i] = (unsigned)(R * g.lda + C) * 2u; voffB[i] = (unsigned)(Rb * g.ldb + C) * 2u; }
    const size_t kstep = (size_t)(BK * 2);
    const size_t hstepA = (size_t)HALF * g.lda * 2, hstepB = (size_t)HALF * g.ldb * 2;
    const size_t tstepA = 2 * hstepA, tstepB = 2 * hstepB;
    const unsigned ldsw = (unsigned)wid * 1024u;
    const int aoff = lds_byte(wr * 64 + fr, fq * 8), boff = lds_byte(wc * 32 + fr, fq * 8);
#define PG8_SA(b, h) (((b) * 2 + (h)) * HTB)
#define PG8_SB(b, h) ((4 + (b) * 2 + (h)) * HTB)
#define PG8_STAGE(bufoff, gbase, voff) do { _Pragma("unroll") for (int _i = 0; _i < 2; ++_i) \
        __builtin_amdgcn_global_load_lds((const unsigned*)((const char*)(gbase) + (voff)[_i]), (PG8_LAS unsigned*)(lds + (bufoff) + ldsw + _i * 8192), 16, 0, 0); } while (0)
#define PG8_LDA(dst, b, h) do { _Pragma("unroll") for (int m = 0; m < 4; ++m) _Pragma("unroll") for (int k = 0; k < 2; ++k) dst[m][k] = *(const PG8_LAS bf16x8*)(lds + PG8_SA(b, h) + aoff + m * 2048 + k * 1024); } while (0)
#define PG8_LDB(dst, b, h) do { _Pragma("unroll") for (int n = 0; n < 2; ++n) _Pragma("unroll") for (int k = 0; k < 2; ++k) dst[n][k] = *(const PG8_LAS bf16x8*)(lds + PG8_SB(b, h) + boff + n * 2048 + k * 1024); } while (0)
#define PG8_MMA(ai, bj, At, Bt) do { __builtin_amdgcn_s_setprio(1); _Pragma("unroll") for (int m = 0; m < 4; ++m) _Pragma("unroll") for (int n = 0; n < 2; ++n) _Pragma("unroll") for (int k = 0; k < 2; ++k) \
        acc[ai][bj][m][n] = __builtin_amdgcn_mfma_f32_16x16x32_bf16(Bt[n][k], At[m][k], acc[ai][bj][m][n], 0, 0, 0); __builtin_amdgcn_s_setprio(0); } while (0)
#define PG8_WAIT_V(n) asm volatile("s_waitcnt vmcnt(" #n ")" ::: "memory")
#define PG8_WAIT_L(n) asm volatile("s_waitcnt lgkmcnt(" #n ")" ::: "memory")
#define PG8_BAR __builtin_amdgcn_s_barrier()
#define PG8_SCHED __builtin_amdgcn_sched_barrier(0)
    Unit cur, nxt; int ui = 0;
    if (!S.next(0, cur)) return;
    f32x4 acc[2][2][4][2];
#pragma unroll
    for (int a = 0; a < 2; ++a)
#pragma unroll
        for (int b = 0; b < 2; ++b)
#pragma unroll
            for (int m = 0; m < 4; ++m)
#pragma unroll
                for (int n = 0; n < 2; ++n) acc[a][b][m][n] = (f32x4){0.f, 0.f, 0.f, 0.f};
    bf16x8 At[4][2], B0[2][2], B1[2][2];
    const char* cA = (const char*)g.A + (size_t)cur.pm * tstepA + (size_t)cur.pn * g.a_pn_off * 2; const char* cB = (const char*)g.Bt + (size_t)cur.pn * tstepB;
    S.a_ready(cur);
    if constexpr (SP2) {
        PG8_STAGE(PG8_SB(0, 0), cB, voffB); PG8_STAGE(PG8_SB(0, 1), cB + hstepB, voffB); PG8_STAGE(PG8_SA(0, 0), cA, voffA); PG8_STAGE(PG8_SA(0, 1), cA + hstepA, voffA);
        if (wr == 1) PG8_BAR;
        PG8_WAIT_V(2); PG8_BAR;
        PG8_STAGE(PG8_SB(1, 0), cB + kstep, voffB); PG8_STAGE(PG8_SA(1, 0), cA + kstep, voffA); PG8_STAGE(PG8_SB(1, 1), cB + hstepB + kstep, voffB);
        PG8_WAIT_V(6); PG8_BAR;
    } else {
        PG8_STAGE(PG8_SB(0, 0), cB, voffB); PG8_STAGE(PG8_SA(0, 0), cA, voffA); PG8_STAGE(PG8_SB(0, 1), cB + hstepB, voffB); PG8_STAGE(PG8_SA(0, 1), cA + hstepA, voffA);
        if (wr == 1) PG8_BAR;
        PG8_WAIT_V(4); PG8_BAR;
        PG8_STAGE(PG8_SB(1, 0), cB + kstep, voffB); PG8_STAGE(PG8_SA(1, 0), cA + kstep, voffA); PG8_STAGE(PG8_SB(1, 1), cB + hstepB + kstep, voffB);
        PG8_WAIT_V(6); PG8_BAR;
    }
    for (;;) {
        const bool has_next = S.next(ui + 1, nxt);
        const char* nA = has_next ? (const char*)g.A + (size_t)nxt.pm * tstepA + (size_t)nxt.pn * g.a_pn_off * 2 : cA; const char* nB = has_next ? (const char*)g.Bt + (size_t)nxt.pn * tstepB : cB;
        for (int t = 0; t < nt; t += 2) {
            const bool last = (t == nt - 2);
            const char* a1 = cA + (size_t)(t + 1) * kstep;
            const char* a2 = last ? nA : cA + (size_t)(t + 2) * kstep; const char* b2 = last ? nB : cB + (size_t)(t + 2) * kstep;
            const char* a3 = a2 + kstep; const char* b3 = b2 + kstep;
            if (last && has_next) S.a_ready(nxt);
            if constexpr (SP2) {
            PG8_LDB(B0, 0, 0); PG8_LDB(B1, 0, 1); PG8_SCHED; PG8_LDA(At, 0, 0); PG8_STAGE(PG8_SA(1, 1), a1 + hstepA, voffA);
            PG8_WAIT_V(8); PG8_WAIT_L(0); PG8_BAR; PG8_MMA(0, 0, At, B0); PG8_MMA(0, 1, At, B1); PG8_BAR; PG8_SCHED;
            PG8_LDA(At, 0, 1); PG8_STAGE(PG8_SB(0, 0), b2, voffB); PG8_STAGE(PG8_SB(0, 1), b2 + hstepB, voffB); PG8_STAGE(PG8_SA(0, 0), a2, voffA);
            PG8_WAIT_V(8); PG8_WAIT_L(0); PG8_BAR; PG8_MMA(1, 0, At, B0); PG8_MMA(1, 1, At, B1); PG8_BAR; PG8_SCHED;
            PG8_LDB(B0, 1, 0); PG8_LDB(B1, 1, 1); PG8_SCHED; PG8_LDA(At, 1, 0); PG8_STAGE(PG8_SA(0, 1), a2 + hstepA, voffA);
            PG8_WAIT_V(8); PG8_WAIT_L(0); PG8_BAR; PG8_MMA(0, 0, At, B0); PG8_MMA(0, 1, At, B1); PG8_BAR; PG8_SCHED;
            PG8_LDA(At, 1, 1); PG8_STAGE(PG8_SB(1, 0), b3, voffB); PG8_STAGE(PG8_SB(1, 1), b3 + hstepB, voffB); PG8_STAGE(PG8_SA(1, 0), a3, voffA);
            PG8_WAIT_V(8); PG8_WAIT_L(0); PG8_BAR; PG8_MMA(1, 0, At, B0); PG8_MMA(1, 1, At, B1); PG8_BAR; PG8_SCHED;
            } else {
            PG8_LDB(B0, 0, 0); PG8_SCHED; PG8_LDA(At, 0, 0); PG8_STAGE(PG8_SA(1, 1), a1 + hstepA, voffA);
            PG8_WAIT_L(8); PG8_BAR; PG8_WAIT_L(0); PG8_MMA(0, 0, At, B0); PG8_BAR; PG8_SCHED;
            PG8_LDB(B1, 0, 1); PG8_STAGE(PG8_SB(0, 0), b2, voffB);
            PG8_BAR; PG8_WAIT_L(0); PG8_MMA(0, 1, At, B1); PG8_BAR;
            PG8_LDA(At, 0, 1); PG8_STAGE(PG8_SA(0, 0), a2, voffA);
            PG8_BAR; PG8_WAIT_L(0); PG8_MMA(1, 0, At, B0); PG8_BAR; PG8_SCHED;
            PG8_STAGE(PG8_SB(0, 1), b2 + hstepB, voffB);
            PG8_WAIT_V(6); PG8_BAR; PG8_MMA(1, 1, At, B1); PG8_BAR;
            PG8_LDB(B0, 1, 0); PG8_SCHED; PG8_LDA(At, 1, 0); PG8_STAGE(PG8_SA(0, 1), a2 + hstepA, voffA);
            PG8_WAIT_L(8); PG8_BAR; PG8_WAIT_L(0); PG8_MMA(0, 0, At, B0); PG8_BAR; PG8_SCHED;
            PG8_LDB(B1, 1, 1); PG8_STAGE(PG8_SB(1, 0), b3, voffB);
            PG8_BAR; PG8_WAIT_L(0); PG8_MMA(0, 1, At, B1); PG8_BAR;
            PG8_LDA(At, 1, 1); PG8_STAGE(PG8_SA(1, 0), a3, voffA);
            PG8_BAR; PG8_WAIT_L(0); PG8_MMA(1, 0, At, B0); PG8_BAR; PG8_SCHED;
            PG8_STAGE(PG8_SB(1, 1), b3 + hstepB, voffB);
            PG8_WAIT_V(6); PG8_BAR; PG8_MMA(1, 1, At, B1); PG8_BAR;
            }
        }
        if constexpr (ALIGN_EPI) { if (wr == 0) PG8_BAR; }
        if constexpr (!Epi::AFTER_DRAIN) { E(acc, cur, wr, wc, fr, fq); S.done(cur); }
        if (!has_next) break;
#pragma unroll
        for (int a = 0; a < 2; ++a)
#pragma unroll
            for (int b = 0; b < 2; ++b)
#pragma unroll
                for (int m = 0; m < 4; ++m)
#pragma unroll
                    for (int n = 0; n < 2; ++n) acc[a][b][m][n] = (f32x4){0.f, 0.f, 0.f, 0.f};
        cur = nxt; cA = nA; cB = nB; ++ui;
        if constexpr (ALIGN_EPI) { if (wr == 1) PG8_BAR; }
    }
    PG8_WAIT_V(0);
    if constexpr (!ALIGN_EPI) { if (wr == 0) PG8_BAR; }
    PG8_BAR;
#undef PG8_SA
#undef PG8_SB
#undef PG8_STAGE
#undef PG8_LDA
#undef PG8_LDB
#undef PG8_MMA
#undef PG8_WAIT_V
#undef PG8_WAIT_L
#undef PG8_BAR
#undef PG8_SCHED
}
}

namespace att {
#define GATE(x) (SILU ? siluf(x) : (x))
using bf16x8 = __attribute__((ext_vector_type(8))) short;
using s16x4  = __attribute__((ext_vector_type(4))) short;
using f32x16 = __attribute__((ext_vector_type(16))) float;
constexpr int QBLK = 32, KVBLK = 64, LDK = 128;
constexpr int SHM_V = KVBLK * 128 * 2, SHM_K = KVBLK * 128 * 2;
constexpr int WS_OFF = 2 * SHM_V + 2 * SHM_K;
constexpr int STG_OFF = 72 * 1024;
constexpr float THRL = 8.f * LOG2E;
#define KSWZ(row, colB) ((row) * 256 + ((colB) ^ (((row) & 7) << 4)))
#define SBAR() __builtin_amdgcn_sched_barrier(0)
__device__ __forceinline__ int crow(int r, int hi) { return (r & 3) + 8 * (r >> 2) + 4 * hi; }
__device__ __forceinline__ unsigned cvtpk(float lo, float hi) { unsigned r; asm volatile("v_cvt_pk_bf16_f32 %0, %1, %2" : "=v"(r) : "v"(lo), "v"(hi)); return r; }
__device__ __forceinline__ void partialSM(f32x16& p0, f32x16& p1, float& m_reg, float& mn, float& alpha) {
  float pmax = p0[0]; for (int r = 1; r < 16; ++r) pmax = fmaxf(pmax, p0[r]); for (int r = 0; r < 16; ++r) pmax = fmaxf(pmax, p1[r]);
  { auto rr = __builtin_amdgcn_permlane32_swap(__float_as_uint(pmax), __float_as_uint(pmax), false, false);
    pmax = fmaxf(__uint_as_float(rr[0]), __uint_as_float(rr[1])); }
  if (__builtin_expect(__all(pmax - m_reg <= THRL), 1)) { mn = m_reg; alpha = 1.f; }
  else { mn = fmaxf(m_reg, pmax); alpha = __builtin_amdgcn_exp2f(m_reg - mn); m_reg = mn; }
  for (int r = 0; r < 16; ++r) p0[r] = p0[r] - mn; for (int r = 0; r < 16; ++r) p1[r] = p1[r] - mn;
  for (int r = 0; r < 16; ++r) p0[r] = __builtin_amdgcn_exp2f(p0[r]);
}
__device__ __forceinline__ void finishSM(f32x16& p0, f32x16& p1, float alpha, float& l_reg, bf16x8& pa0, bf16x8& pa1, bf16x8& pa2, bf16x8& pa3) {
  for (int r = 0; r < 16; ++r) p1[r] = __builtin_amdgcn_exp2f(p1[r]);
  float ps = 0; for (int r = 0; r < 16; ++r) ps += p0[r]; for (int r = 0; r < 16; ++r) ps += p1[r];
  { auto rr = __builtin_amdgcn_permlane32_swap(__float_as_uint(ps), __float_as_uint(ps), false, false);
    ps = __uint_as_float(rr[0]) + __uint_as_float(rr[1]); }
  l_reg = l_reg * alpha + ps;
#define PK4(P, BASE, OUT) do { unsigned a0 = cvtpk(P[BASE + 0], P[BASE + 1]), a1 = cvtpk(P[BASE + 2], P[BASE + 3]);   \
    unsigned b0 = cvtpk(P[BASE + 4], P[BASE + 5]), b1 = cvtpk(P[BASE + 6], P[BASE + 7]);                              \
    auto r0 = __builtin_amdgcn_permlane32_swap(a0, b0, false, false); auto r1 = __builtin_amdgcn_permlane32_swap(a1, b1, false, false); \
    u32x4 w = {r0[0], r1[0], r0[1], r1[1]}; OUT = *reinterpret_cast<bf16x8*>(&w); } while (0)
  PK4(p0, 0, pa0); PK4(p0, 8, pa1); PK4(p1, 0, pa2); PK4(p1, 8, pa3);
#undef PK4
}
template <int ND0> __device__ __forceinline__ void qkt(f32x16& p0, f32x16& p1, const char* Ks, const bf16x8* qr, int r32, int hi, int kcol0) {
  p0 = f32x16{}; p1 = f32x16{};
#pragma unroll
  for (int d0 = 0; d0 < ND0; ++d0) { int cb = (kcol0 + d0 * 16 + hi * 8) * 2;
    bf16x8 b0 = *reinterpret_cast<const bf16x8*>(Ks + KSWZ(r32, cb));
    bf16x8 b1 = *reinterpret_cast<const bf16x8*>(Ks + KSWZ(32 + r32, cb));
    p0 = __builtin_amdgcn_mfma_f32_32x32x16_bf16(b0, qr[d0], p0, 0, 0, 0);
    p1 = __builtin_amdgcn_mfma_f32_32x32x16_bf16(b1, qr[d0], p1, 0, 0, 0); }
}
__device__ __forceinline__ int v_st(int k, int c) { const int kk = (k & ~0xC) | ((k & 4) << 1) | ((k & 8) >> 1); return ((kk >> 3) * 4 + (c >> 5)) * 512 + ((kk & 7) * 32 + (c & 31)) * 2; }
__device__ __forceinline__ int v_rd_base(int lane) { return ((lane & 3) << 3) | (((lane >> 2) & 3) << 6) | (((lane >> 4) & 1) << 5) | (((lane >> 5) & 1) << 8); }
constexpr int v_rd_off(int d0, int ks, int half) { return d0 * 512 + ks * 4096 + half * 2048; }
template <int OFF> __device__ __forceinline__ s16x4 tr_read(int vb) {
  s16x4 r; asm volatile("ds_read_b64_tr_b16 %0, %1 offset:%2" : "=&v"(r) : "v"(vb), "i"(OFF) : "memory"); return r;
}
template <int D0> __device__ __forceinline__ void pv_one(f32x16& od, int vb, bf16x8 pa0, bf16x8 pa1, bf16x8 pa2, bf16x8 pa3) {
  const s16x4 l0 = tr_read<v_rd_off(D0, 0, 0)>(vb), h0 = tr_read<v_rd_off(D0, 0, 1)>(vb), l1 = tr_read<v_rd_off(D0, 1, 0)>(vb), h1 = tr_read<v_rd_off(D0, 1, 1)>(vb);
  const s16x4 l2 = tr_read<v_rd_off(D0, 2, 0)>(vb), h2 = tr_read<v_rd_off(D0, 2, 1)>(vb), l3 = tr_read<v_rd_off(D0, 3, 0)>(vb), h3 = tr_read<v_rd_off(D0, 3, 1)>(vb);
  asm volatile("s_waitcnt lgkmcnt(0)" ::: "memory"); SBAR();
#define PK(L, H) (bf16x8){L[0], L[1], L[2], L[3], H[0], H[1], H[2], H[3]}
  od = __builtin_amdgcn_mfma_f32_32x32x16_bf16(pa0, PK(l0, h0), od, 0, 0, 0);
  od = __builtin_amdgcn_mfma_f32_32x32x16_bf16(pa1, PK(l1, h1), od, 0, 0, 0);
  od = __builtin_amdgcn_mfma_f32_32x32x16_bf16(pa2, PK(l2, h2), od, 0, 0, 0);
  od = __builtin_amdgcn_mfma_f32_32x32x16_bf16(pa3, PK(l3, h3), od, 0, 0, 0);
#undef PK
}
__device__ __forceinline__ void pv_d0(f32x16* o, int vb, bf16x8 pa0, bf16x8 pa1, bf16x8 pa2, bf16x8 pa3) {
  pv_one<0>(o[0], vb, pa0, pa1, pa2, pa3); pv_one<1>(o[1], vb, pa0, pa1, pa2, pa3); pv_one<2>(o[2], vb, pa0, pa1, pa2, pa3); pv_one<3>(o[3], vb, pa0, pa1, pa2, pa3);
}
template <int ND0>
__device__ __forceinline__ void attn_core(const bf16_t* Qw, const bf16_t* __restrict__ Kh, const bf16_t* __restrict__ Vh, int seq, int kcol0, char* lds, f32x16 (&o)[4], float& l_reg, const int wid, const int lane) {
  const int tid = wid * 64 + lane, r32 = lane & 31, hi = lane >> 5;
  char* V_lds = lds; char* K_lds = lds + 2 * SHM_V;
  float* ws = (float*)(lds + WS_OFF) + wid * 64; float* al_l = ws + 32;
  float m_reg = -1e30f; l_reg = 0; bf16x8 qr[ND0];
#pragma unroll
  for (int d = 0; d < 4; ++d) o[d] = f32x16{};
#pragma unroll
  for (int d0 = 0; d0 < ND0; ++d0) qr[d0] = *reinterpret_cast<const bf16x8*>(Qw + d0 * 16);
  const int sr = tid >> 4, sc = (tid & 15) * 8, vst0 = v_st(sr, sc), vst1 = v_st(32 + sr, sc);
  const int vb0 = (int)(uintptr_t)V_lds + v_rd_base(lane);
  struct { bf16x8 vs0, vs1, ks0, ks1; } sr_[1];
#define SLOAD(i, k0) do { sr_[i].vs0 = *reinterpret_cast<const bf16x8*>(&Vh[(long)((k0) + sr) * LDK + sc]); sr_[i].vs1 = *reinterpret_cast<const bf16x8*>(&Vh[(long)((k0) + 32 + sr) * LDK + sc]); \
    sr_[i].ks0 = *reinterpret_cast<const bf16x8*>(&Kh[(long)((k0) + sr) * LDK + sc]); sr_[i].ks1 = *reinterpret_cast<const bf16x8*>(&Kh[(long)((k0) + 32 + sr) * LDK + sc]); } while (0)
#define SWRITE(b, i) do { *(bf16x8*)(V_lds + (b) * SHM_V + vst0) = sr_[i].vs0;          \
    *(bf16x8*)(V_lds + (b) * SHM_V + vst1) = sr_[i].vs1; int kc = sc * 2;               \
    *(bf16x8*)(K_lds + (b) * SHM_K + KSWZ(sr, kc)) = sr_[i].ks0;                       \
    *(bf16x8*)(K_lds + (b) * SHM_K + KSWZ(32 + sr, kc)) = sr_[i].ks1; } while (0)
#define SWAIT() asm volatile("s_waitcnt vmcnt(0)" ::: "memory")
#define RESC(a) do { if (__any((a) < 1.f)) { if (hi == 0) al_l[r32] = (a); asm volatile("s_waitcnt lgkmcnt(0)" ::: "memory"); \
    for (int d = 0; d < 4; ++d) for (int r = 0; r < 16; ++r) o[d][r] *= al_l[crow(r, hi)]; } } while (0)
  f32x16 pA0, pA1, pB0, pB1; float mnA, mnB, alA, alB; bf16x8 pa0, pa1, pa2, pa3; const int NT = seq / KVBLK;
  SLOAD(0, 0); asm volatile("s_waitcnt vmcnt(0)" ::: "memory"); SWRITE(0, 0); __syncthreads();
  qkt<ND0>(pA0, pA1, K_lds, qr, r32, hi, kcol0); partialSM(pA0, pA1, m_reg, mnA, alA);
  SLOAD(0, KVBLK);
  SWAIT(); SWRITE(1, 0); __syncthreads();
  for (int j = 1; j + 1 < NT; j += 2) {
    SBAR(); qkt<ND0>(pB0, pB1, K_lds + SHM_K, qr, r32, hi, kcol0);
    finishSM(pA0, pA1, alA, l_reg, pa0, pa1, pa2, pa3); SBAR();
    SLOAD(0, (j + 1) * KVBLK); SBAR();
    pv_d0(o, vb0, pa0, pa1, pa2, pa3); partialSM(pB0, pB1, m_reg, mnB, alB);
    __syncthreads(); SWAIT(); SWRITE(0, 0);
    RESC(alB); __syncthreads();
    SBAR(); qkt<ND0>(pA0, pA1, K_lds, qr, r32, hi, kcol0);
    finishSM(pB0, pB1, alB, l_reg, pa0, pa1, pa2, pa3); SBAR();
    SLOAD(0, (j + 2) * KVBLK); SBAR();
    pv_d0(o, vb0 + SHM_V, pa0, pa1, pa2, pa3); partialSM(pA0, pA1, m_reg, mnA, alA);
    __syncthreads(); SWAIT(); SWRITE(1, 0);
    RESC(alA); __syncthreads();
  }
  SBAR(); qkt<ND0>(pB0, pB1, K_lds + SHM_K, qr, r32, hi, kcol0);
  finishSM(pA0, pA1, alA, l_reg, pa0, pa1, pa2, pa3); SBAR();
  pv_d0(o, vb0, pa0, pa1, pa2, pa3); partialSM(pB0, pB1, m_reg, mnB, alB);
  __syncthreads(); RESC(alB);
  finishSM(pB0, pB1, alB, l_reg, pa0, pa1, pa2, pa3); SBAR();
  pv_d0(o, vb0 + SHM_V, pa0, pa1, pa2, pa3);
#undef SLOAD
#undef SWRITE
#undef SWAIT
#undef RESC
}
__device__ __forceinline__ void row_inv_l(float l_reg, char* lds, int wid, int r32, int hi, float (&rli)[16]) {
  float* li_l = (float*)(lds + WS_OFF) + wid * 64;
  if (hi == 0) li_l[r32] = l_reg; asm volatile("s_waitcnt lgkmcnt(0)" ::: "memory");
#pragma unroll
  for (int r = 0; r < 16; ++r) rli[r] = __builtin_amdgcn_rcpf(li_l[crow(r, hi)]);
}
template <bool SILU> __device__ __forceinline__ void store_rows_gated(const f32x16 (&v)[4], char* stg, bf16_t* Yrow0  , const bf16_t* Grow0, int gpitch, int lane, int r32, int hi) {
  bf16_t* st = (bf16_t*)stg;
#pragma unroll
  for (int r = 0; r < 16; ++r) { const int orow = crow(r, hi);
#pragma unroll
    for (int d0 = 0; d0 < 4; ++d0) st[orow * 128 + d0 * 32 + r32] = (bf16_t)f2bf(v[d0][r]); }
  asm volatile("s_waitcnt lgkmcnt(0)" ::: "memory");
  const bf16_t* gp = Grow0 + (size_t)(lane >> 4) * gpitch + (lane & 15) * 8; bf16_t* yp = Yrow0 + (size_t)(lane >> 4) * DM + (lane & 15) * 8; const bf16_t* sp = st + (lane >> 4) * 128 + (lane & 15) * 8;
  u32x4 g[8];
#pragma unroll
  for (int i = 0; i < 8; ++i) { g[i] = *(const u32x4*)gp; gp += 4 * (size_t)gpitch; asm volatile("" : "+v"(gp)); }
#pragma unroll
  for (int i = 0; i < 8; ++i) {
    const u32x4 x = *(const u32x4*)(sp + i * 4 * 128);
    u32x4 w; w.x = pk2(bflo(x.x) * GATE(bflo(g[i].x)), bfhi(x.x) * GATE(bfhi(g[i].x))); w.y = pk2(bflo(x.y) * GATE(bflo(g[i].y)), bfhi(x.y) * GATE(bfhi(g[i].y)));
    w.z = pk2(bflo(x.z) * GATE(bflo(g[i].z)), bfhi(x.z) * GATE(bfhi(g[i].z))); w.w = pk2(bflo(x.w) * GATE(bflo(g[i].w)), bfhi(x.w) * GATE(bfhi(g[i].w)));
    *(u32x4*)yp = w; yp += 4 * DM; asm volatile("" : "+v"(yp)); }
  asm volatile("s_waitcnt lgkmcnt(0)" ::: "memory");
}
__device__ __forceinline__ void gqa_unit(const Params& p, char* lds, int m0, int hq, const bf16_t* Kh, const bf16_t* Vh, int seq, const int wid) {
  const int lane = fresh_lane(), r32 = lane & 31, hi = lane >> 5;
  const bf16_t* QC = (const bf16_t*)(p.ws + WS_Q); const bf16_t* PR = (const bf16_t*)(p.ws + WS_PR); bf16_t* Y = (bf16_t*)(p.ws + WS_HY);
  f32x16 o[4]; float l_reg;
  attn_core<8>(QC + (size_t)(m0 + wid * QBLK + r32) * DM + hq * 128 + hi * 8, Kh, Vh, seq, 0, lds, o, l_reg, wid, lane);
  float rli[16]; row_inv_l(l_reg, lds, wid, r32, hi, rli);
#pragma unroll
  for (int d0 = 0; d0 < 4; ++d0)
#pragma unroll
    for (int r = 0; r < 16; ++r) o[d0][r] *= rli[r];
  __syncthreads();
  const size_t row0 = (size_t)(m0 + wid * QBLK);
  store_rows_gated<false>(o, lds + wid * 8192, Y + row0 * DM + hq * 128, (const bf16_t*)(p.ws + WS_SG) + row0 * DM + hq * 128, DM, lane, r32, hi);
  __syncthreads();
}
constexpr int RES_WS = 131072 + 1024, RES_EX = 131072 + 4096;
__device__ __forceinline__ void load_kv_resident(const bf16_t* __restrict__ Kh, const bf16_t* __restrict__ Vh, char* lds, int tid) {
  bf16x8 kr[8], vr[8];
#pragma unroll
  for (int i = 0; i < 8; ++i) { const int c = tid + 512 * i; kr[i] = *reinterpret_cast<const bf16x8*>(Kh + (size_t)c * 8); vr[i] = *reinterpret_cast<const bf16x8*>(Vh + (size_t)c * 8); }
#pragma unroll
  for (int i = 0; i < 8; ++i) { const int c = tid + 512 * i, key = c >> 4, col = (c & 15) * 8, t = key >> 6, k = key & 63;
    *(bf16x8*)(lds + 65536 + t * 16384 + v_st(k, col)) = vr[i];
    *(bf16x8*)(lds + t * 16384 + KSWZ(k, col * 2)) = kr[i]; }
}
template <int ND0>
__device__ __forceinline__ void attn_core_res(const bf16_t* Qw, int kcol0, char* lds, f32x16 (&o)[4], float& l_reg, const int wid, const int lane) {
  const int r32 = lane & 31, hi = lane >> 5;
  const char* K_lds = lds; float* al_l = (float*)(lds + RES_WS) + wid * 64 + 32;
  float m_reg = -1e30f; l_reg = 0; bf16x8 qr[ND0];
#pragma unroll
  for (int d = 0; d < 4; ++d) o[d] = f32x16{};
#pragma unroll
  for (int d0 = 0; d0 < ND0; ++d0) qr[d0] = *reinterpret_cast<const bf16x8*>(Qw + d0 * 16);
  const int vb0 = (int)(uintptr_t)(lds + 65536) + v_rd_base(lane);
#define RESC(a) do { if (__any((a) < 1.f)) { if (hi == 0) al_l[r32] = (a); asm volatile("s_waitcnt lgkmcnt(0)" ::: "memory"); \
    for (int d = 0; d < 4; ++d) for (int r = 0; r < 16; ++r) o[d][r] *= al_l[crow(r, hi)]; } } while (0)
  f32x16 pA0, pA1, pB0, pB1; float mnA, mnB, alA, alB; bf16x8 pa0, pa1, pa2, pa3;
  qkt<ND0>(pA0, pA1, K_lds, qr, r32, hi, kcol0); partialSM(pA0, pA1, m_reg, mnA, alA);
  SBAR(); qkt<ND0>(pB0, pB1, K_lds + 16384, qr, r32, hi, kcol0);
  finishSM(pA0, pA1, alA, l_reg, pa0, pa1, pa2, pa3); SBAR();
  pv_d0(o, vb0, pa0, pa1, pa2, pa3); partialSM(pB0, pB1, m_reg, mnB, alB); RESC(alB);
  SBAR(); qkt<ND0>(pA0, pA1, K_lds + 2 * 16384, qr, r32, hi, kcol0);
  finishSM(pB0, pB1, alB, l_reg, pa0, pa1, pa2, pa3); SBAR();
  pv_d0(o, vb0 + 16384, pa0, pa1, pa2, pa3); partialSM(pA0, pA1, m_reg, mnA, alA); RESC(alA);
  SBAR(); qkt<ND0>(pB0, pB1, K_lds + 3 * 16384, qr, r32, hi, kcol0);
  finishSM(pA0, pA1, alA, l_reg, pa0, pa1, pa2, pa3); SBAR();
  pv_d0(o, vb0 + 2 * 16384, pa0, pa1, pa2, pa3); partialSM(pB0, pB1, m_reg, mnB, alB); RESC(alB);
  finishSM(pB0, pB1, alB, l_reg, pa0, pa1, pa2, pa3); SBAR();
  pv_d0(o, vb0 + 3 * 16384, pa0, pa1, pa2, pa3);
#undef RESC
}
__device__ __forceinline__ void row_inv_l_res(float l_reg, char* lds, int wid, int r32, int hi, float (&rli)[16]) {
  float* li_l = (float*)(lds + RES_WS) + wid * 64;
  if (hi == 0) li_l[r32] = l_reg; asm volatile("s_waitcnt lgkmcnt(0)" ::: "memory");
#pragma unroll
  for (int r = 0; r < 16; ++r) rli[r] = __builtin_amdgcn_rcpf(li_l[crow(r, hi)]);
}
template <bool SILU> __device__ __forceinline__ void store_direct_gated(const f32x16 (&v)[4], char* stg  , bf16_t* Y0  , const bf16_t* G0, int gpitch, int lane, int r32, int hi) {
  bf16_t* st = (bf16_t*)stg;
  const bf16_t* gp = G0 + (size_t)(lane >> 4) * gpitch + (lane & 15) * 8; bf16_t* yp = Y0 + (size_t)(lane >> 4) * DM + (lane & 15) * 8; const bf16_t* sp = st + (lane >> 4) * 128 + (lane & 15) * 8;
  u32x4 g[8];
#pragma unroll
  for (int i = 0; i < 8; ++i) { g[i] = *(const u32x4*)gp; gp += 4 * (size_t)gpitch; asm volatile("" : "+v"(gp)); }
#pragma unroll
  for (int j = 0; j < 4; ++j) {
#pragma unroll
    for (int rr = 0; rr < 4; ++rr)
#pragma unroll
      for (int d0 = 0; d0 < 4; ++d0) st[(rr + 4 * hi) * 128 + d0 * 32 + r32] = (bf16_t)f2bf(v[d0][4 * j + rr]);
    asm volatile("s_waitcnt lgkmcnt(0)" ::: "memory");
#pragma unroll
    for (int i = 0; i < 2; ++i) {
      const u32x4 x = *(const u32x4*)(sp + i * 4 * 128); const u32x4 gg = g[2 * j + i];
      u32x4 w; w.x = pk2(bflo(x.x) * GATE(bflo(gg.x)), bfhi(x.x) * GATE(bfhi(gg.x))); w.y = pk2(bflo(x.y) * GATE(bflo(gg.y)), bfhi(x.y) * GATE(bfhi(gg.y)));
      w.z = pk2(bflo(x.z) * GATE(bflo(gg.z)), bfhi(x.z) * GATE(bfhi(gg.z))); w.w = pk2(bflo(x.w) * GATE(bflo(gg.w)), bfhi(x.w) * GATE(bfhi(gg.w)));
      *(u32x4*)yp = w; yp += 4 * DM; asm volatile("" : "+v"(yp)); }
    asm volatile("s_waitcnt lgkmcnt(0)" ::: "memory");
  }
}
__device__ __forceinline__ void gqa_prompt_slot(const Params& p, char* lds, int bk, const int wid) {
  const int lane = fresh_lane(), r32 = lane & 31, hi = lane >> 5;
  const bf16_t* QC = (const bf16_t*)(p.ws + WS_Q); const bf16_t* PR = (const bf16_t*)(p.ws + WS_PR); bf16_t* Y = (bf16_t*)(p.ws + WS_HY);
  load_kv_resident((const bf16_t*)(p.ws + WS_KP) + (size_t)bk * SEQP * 128, (const bf16_t*)(p.ws + WS_VP) + (size_t)bk * SEQP * 128, lds, wid * 64 + lane);
  __syncthreads();
  const int m0 = (bk >> 2) * SEQP;
  for (int g = 0; g < 4; ++g) {
    const int hq = (bk & 3) * 4 + g;
    f32x16 o[4]; float l_reg;
    const size_t row0 = (size_t)(m0 + wid * QBLK);
    attn_core_res<8>(QC + (row0 + r32) * DM + hq * 128 + hi * 8, 0, lds, o, l_reg, wid, lane);
    float rli[16]; row_inv_l_res(l_reg, lds, wid, r32, hi, rli);
#pragma unroll
    for (int d0 = 0; d0 < 4; ++d0)
#pragma unroll
      for (int r = 0; r < 16; ++r) o[d0][r] *= rli[r];
    store_direct_gated<false>(o, lds + RES_EX + wid * 2048, Y + row0 * DM + hq * 128, (const bf16_t*)(p.ws + WS_SG) + row0 * DM + hq * 128, DM, lane, r32, hi);
  }
  __syncthreads();
}
__device__ __forceinline__ void diff_prompt_slot(const Params& p, char* lds, int slot  , float lam, const int wid) {
  const int lane = fresh_lane(), r32 = lane & 31, hi = lane >> 5, rg = wid & 3, mp = wid >> 2;
  const bf16_t* QA = (const bf16_t*)(p.ws + WS_Q); const bf16_t* PR = (const bf16_t*)(p.ws + WS_PR); bf16_t* Y = (bf16_t*)(p.ws + WS_HY);
  for (int hh = 0; hh < 2; ++hh) {
    const int bh = slot * 2 + hh, h = bh & 7, b = bh >> 3;
    load_kv_resident((const bf16_t*)(p.ws + WS_KP) + (size_t)bh * SEQP * 128, (const bf16_t*)(p.ws + WS_VP) + (size_t)bh * SEQP * 128, lds, wid * 64 + lane);
    __syncthreads();
    for (int qb = 0; qb < 2; ++qb) {
      const size_t row0 = (size_t)(b * SEQP + qb * 128 + rg * QBLK);
      f32x16 o[4]; float l_reg;
      attn_core_res<4>(QA + (row0 + r32) * 1024 + h * 128 + mp * 64 + hi * 8, mp * 64, lds, o, l_reg, wid, lane);
      float rli[16]; row_inv_l_res(l_reg, lds, wid, r32, hi, rli);
      float* ex = (float*)(lds + RES_EX) + rg * 1024 + lane;
      float ss[16];
#pragma unroll
      for (int r = 0; r < 16; ++r) ss[r] = 0.f;
#pragma unroll
      for (int d0 = 0; d0 < 4; ++d0) {
        if (mp == 1) {
#pragma unroll
          for (int r = 0; r < 16; ++r) ex[r * 64] = o[d0][r] * (rli[r] * lam); }
        __syncthreads();
        if (mp == 0) {
#pragma unroll
          for (int r = 0; r < 16; ++r) { const float v = o[d0][r] * rli[r] - ex[r * 64]; o[d0][r] = v; ss[r] += v * v; } }
        __syncthreads();
      }
      if (mp == 0) {
#pragma unroll
        for (int r = 0; r < 16; ++r) {
#pragma unroll
          for (int of = 1; of < 32; of <<= 1) ss[r] += __shfl_xor(ss[r], of);
          ss[r] = 0.8f / sqrtf(ss[r] * (1.f / 128.f) + EPS); }
#pragma unroll
        for (int d0 = 0; d0 < 4; ++d0) { const float sw = p.subln_w[d0 * 32 + r32];
#pragma unroll
          for (int r = 0; r < 16; ++r) o[d0][r] *= ss[r] * sw; }
        store_direct_gated<true>(o, lds + RES_EX + 16384 + rg * 2048, Y + row0 * DM + h * 128, PR + row0 * EVEN_IN + 4096 + h * 128, EVEN_IN, lane, r32, hi);
      }
    }
    __syncthreads();
  }
}
__device__ __forceinline__ void gqa_phase(const Params& p, char* lds, int vcu, int G, const int wid, const int mode) {
  for (int v = vcu; v < 256; v += G) {
    if (v < 128) { if (mode & 1) continue;
      const int qb = v & 3, g = (v >> 2) & 3, bk = v >> 4;
      gqa_unit(p, lds, MP + (bk >> 2) * SEQS + qb * 256, (bk & 3) * 4 + g, (const bf16_t*)(p.ws + WS_KSC) + (size_t)bk * LKS * 128, (const bf16_t*)(p.ws + WS_VSC) + (size_t)bk * LKS * 128, LKS, wid); }
    else { if (mode & 2) continue; gqa_prompt_slot(p, lds, v - 128, wid); }
  }
}
__device__ __forceinline__ void diff_unit(const Params& p, char* lds, int m0, int h, const bf16_t* Kh, const bf16_t* Vh, int seq, float lam, const int wid) {
  const int lane = fresh_lane(), r32 = lane & 31, hi = lane >> 5, rg = wid & 3, mp = wid >> 2;
  const bf16_t* QA = (const bf16_t*)(p.ws + WS_Q); const bf16_t* PR = (const bf16_t*)(p.ws + WS_PR); bf16_t* Y = (bf16_t*)(p.ws + WS_HY);
  f32x16 o[4]; float l_reg;
  attn_core<4>(QA + (size_t)(m0 + rg * QBLK + r32) * 1024 + h * 128 + mp * 64 + hi * 8, Kh, Vh, seq, mp * 64, lds, o, l_reg, wid, lane);
  float rli[16]; row_inv_l(l_reg, lds, wid, r32, hi, rli);
  __syncthreads();
  float* ex = (float*)lds + rg * 4096 + lane;
  if (mp == 1) {
#pragma unroll
    for (int d0 = 0; d0 < 4; ++d0)
#pragma unroll
      for (int r = 0; r < 16; ++r) ex[(d0 * 16 + r) * 64] = o[d0][r] * (rli[r] * lam);
  }
  __syncthreads();
  if (mp == 0) {
    float ss[16];
#pragma unroll
    for (int r = 0; r < 16; ++r) ss[r] = 0.f;
#pragma unroll
    for (int d0 = 0; d0 < 4; ++d0)
#pragma unroll
      for (int r = 0; r < 16; ++r) { const float v = o[d0][r] * rli[r] - ex[(d0 * 16 + r) * 64]; o[d0][r] = v; ss[r] += v * v; }
#pragma unroll
    for (int r = 0; r < 16; ++r) {
#pragma unroll
      for (int of = 1; of < 32; of <<= 1) ss[r] += __shfl_xor(ss[r], of);
      ss[r] = 0.8f / sqrtf(ss[r] * (1.f / 128.f) + EPS); }
#pragma unroll
    for (int d0 = 0; d0 < 4; ++d0) { const float sw = p.subln_w[d0 * 32 + r32];
#pragma unroll
      for (int r = 0; r < 16; ++r) o[d0][r] *= ss[r] * sw; }
    const size_t row0 = (size_t)(m0 + rg * QBLK);
    store_rows_gated<true>(o, lds + STG_OFF + rg * 8192, Y + row0 * DM + h * 128, PR + row0 * EVEN_IN + 4096 + h * 128, EVEN_IN, lane, r32, hi);
  }
  __syncthreads();
}
__device__ __forceinline__ void diff_phase(const Params& p, char* lds, int vcu, int G, const int wid, const int mode) {
  const int lane = fresh_lane();
  const float lam = expf(wave_sum(p.lam_q1[lane] * p.lam_k1[lane])) - expf(wave_sum(p.lam_q2[lane] * p.lam_k2[lane])) + 0.2f;
  for (int v = vcu; v < 256; v += G) {
    if (v < 128) { if (mode & 1) continue;
      const int qb = v & 7, bh = v >> 3;
      diff_unit(p, lds, MP + (bh >> 3) * SEQS + qb * 128, bh & 7, (const bf16_t*)(p.ws + WS_KSA) + (size_t)bh * LKS * 128, (const bf16_t*)(p.ws + WS_VSA) + (size_t)bh * LKS * 128, LKS, lam, wid); }
    else { if (mode & 2) continue; diff_prompt_slot(p, lds, v - 128, lam, wid); }
  }
}
#undef KSWZ
#undef SBAR
}

constexpr int NWAVES = 8;
constexpr int RING_OFF = 0, RING_BYTES = 131072;
constexpr int LDSCTL_OFF = RING_BYTES, MISC_OFF = LDSCTL_OFF + 320;
constexpr int LDS_BYTES = 163840;
constexpr int RES_WS_OFF = RING_BYTES + 1024, RES_EX_OFF = RING_BYTES + 4096;
constexpr int CW_BAR = 4096;
#define GAS __attribute__((address_space(1)))
#define LAS __attribute__((address_space(3)))
typedef GAS unsigned gu32;
#define RLX_AGENT __ATOMIC_RELAXED, __HIP_MEMORY_SCOPE_AGENT
#define XB_TMO      128
#define XB_XCNT(j)  (256  + 64 * (j))
#define XB_XSUB(j)  (1280 + 64 * (j))
#define XB_XGEN(j)  (2304 + 64 * (j))
#define XB_TOP      3328
#define XB_TOPGEN   3392
#define XCD_BAR_WORDS 3456
#define XB_SPIN_CAP (1u << 18)
__device__ __forceinline__ unsigned xb_ld(unsigned* p)              { return __hip_atomic_load(p, __ATOMIC_RELAXED, __HIP_MEMORY_SCOPE_AGENT); }
__device__ __forceinline__ unsigned xb_add(unsigned* p, unsigned v) { return __hip_atomic_fetch_add(p, v, __ATOMIC_RELAXED, __HIP_MEMORY_SCOPE_AGENT); }
__device__ __forceinline__ unsigned xb_xcc_id() { return (unsigned)__builtin_amdgcn_s_getreg((3 << 11) | 20) & 0xFu; }
#define XB_SPIN(cond, bar) do { unsigned _sp = 0; while (cond) { __builtin_amdgcn_s_sleep(1); \
    if ((++_sp & 255u) == 0u) { if (xb_ld(&(bar)[XB_TMO])) break; if (_sp > XB_SPIN_CAP) { atomicAdd(&(bar)[XB_TMO], 1u); break; } } } } while (0)
struct XcdBarrier { unsigned* bar; unsigned x; volatile LAS unsigned* st; };
__device__ __forceinline__ XcdBarrier xcd_barrier_post(unsigned* bar, volatile LAS unsigned* st) {
    XcdBarrier b; b.bar = bar; b.x = xb_xcc_id(); b.st = st;
    if (threadIdx.x == 0) (void)xb_add(&bar[XB_XCNT(b.x)], 1u);
    return b;
}
__device__ __forceinline__ void xcd_barrier_complete(unsigned* bar, unsigned x, unsigned& nloc, unsigned& nx) {
    const unsigned G = gridDim.x * gridDim.y * gridDim.z;
    unsigned sum, cnt, mine, sp = 0u;
    for (;;) {
        sum = 0u; cnt = 0u; mine = 0u;
#pragma unroll
        for (unsigned j = 0; j < 16; ++j) { const unsigned c = xb_ld(&bar[XB_XCNT(j)]); sum += c; cnt += (c > 0u) ? 1u : 0u; mine = (j == x) ? c : mine; }
        if (sum == G) break;
        __builtin_amdgcn_s_sleep(1);
        if ((++sp & 255u) == 0u) { if (xb_ld(&bar[XB_TMO])) break; if (sp > XB_SPIN_CAP) { atomicAdd(&bar[XB_TMO], 1u); break; } }
    }
    nloc = mine > 0u ? mine : 1u; nx = cnt > 0u ? cnt : 1u;
}
__device__ __forceinline__ void xcd_barrier(const XcdBarrier& b) {
    asm volatile("s_waitcnt vmcnt(0)" ::: "memory");
    __syncthreads();
    if (threadIdx.x == 0) {
        unsigned* bar = b.bar;
        __builtin_amdgcn_s_waitcnt(0);
        unsigned nloc = b.st[0], nx = b.st[1];
        if (nloc == 0u) { xcd_barrier_complete(bar, b.x, nloc, nx); b.st[0] = nloc; b.st[1] = nx; }
        const unsigned old = xb_add(&bar[XB_XSUB(b.x)], 1u);
        const unsigned gen = old / nloc;
        if (old + 1u == (gen + 1u) * nloc) {
            __builtin_amdgcn_fence(__ATOMIC_RELEASE, "agent");
            asm volatile("s_waitcnt vmcnt(0)" ::: "memory");
            const unsigned og = xb_add(&bar[XB_TOP], 1u);
            const unsigned tg = og / nx;
            if (og + 1u == (tg + 1u) * nx) xb_add(&bar[XB_TOPGEN], 1u);
            else XB_SPIN(xb_ld(&bar[XB_TOPGEN]) == tg, bar);
            __builtin_amdgcn_fence(__ATOMIC_ACQUIRE, "agent");
            xb_add(&bar[XB_XGEN(b.x)], 1u);
            asm volatile("s_waitcnt vmcnt(0)" ::: "memory");
        } else {
            XB_SPIN(xb_ld(&bar[XB_XGEN(b.x)]) == gen, bar);
            __builtin_amdgcn_fence(__ATOMIC_ACQUIRE, "agent");
            asm volatile("s_waitcnt vmcnt(0)" ::: "memory");
        }
    }
    __syncthreads();
}

struct MegaArgs { Params p; int ph_lo, ph_hi, mode, pad; };
constexpr int N_PHASES = 11;
#ifndef DUP_PHASE
#define DUP_PHASE -1
#endif
__global__ void __launch_bounds__(NWAVES * 64, 2) mega_fwd(MegaArgs args) {
    extern __shared__ __attribute__((aligned(16))) unsigned char lds[];
    const Params& p = args.p;
    LAS unsigned char* ldsl = (LAS unsigned char*)lds;
    volatile LAS unsigned* MISC = (volatile LAS unsigned*)(ldsl + MISC_OFF);
    const int wave = __builtin_amdgcn_readfirstlane(threadIdx.x >> 6);
    const int G = gridDim.x, bx = blockIdx.x;
    const int vcu = (G % 8 == 0) ? (bx % 8) * (G / 8) + bx / 8 : bx;
    for (int u = threadIdx.x; u < (LDS_BYTES - LDSCTL_OFF) / 4; u += NWAVES * 64) ((LAS unsigned*)(ldsl + LDSCTL_OFF))[u] = 0u;
    __syncthreads();
    unsigned char* ws = p.ws;
    XcdBarrier bar = xcd_barrier_post((unsigned*)(ws + WS_CTL) + CW_BAR, MISC + 8);
    const int lo = args.ph_lo, hi = args.ph_hi;
    const int gw = vcu * NWAVES + wave, ngw = G * NWAVES;
#define IN(k) (lo <= (k) && (k) < hi)
#define SEAM(k) do { if (IN(k) && (IN((k) + 1) || ((k) == 7 && IN(9)))) xcd_barrier(bar); } while (0)
#define REP(k) for (int rep_ = 0; rep_ < ((k) == DUP_PHASE ? 2 : 1); ++rep_, ((k) == DUP_PHASE && rep_ < 2 ? xcd_barrier(bar) : (void)0))
    if (IN(0)) REP(0) {
        float* scr = (float*)lds; const int lane = fresh_lane(), tid = wave * 64 + lane;
        if (rep_ == 0 && !(args.mode & 8)) mod_items(p, scr, bx, G, tid, NWAVES * 64);
        __syncthreads();
        if (!(args.mode & 16)) weights_items(p, (float*)(lds + wave * 16384), gw, ngw, lane);
        if (!(args.mode & 32)) caches_rope_items(p, (long)bx * 512 + tid, (long)G * 512);
    }
    SEAM(0);
    if (IN(1)) REP(1) modulate_rows(p, 0, gw, ngw, fresh_lane());
    SEAM(1);
    if (IN(2)) REP(2) {
        pg8::Gemm g{(const bf16_t*)(ws + WS_HY), (const bf16_t*)(ws + WS_WINE), MT, EVEN_IN, DM, DM, DM, 0}; pg8::StaticOrder S; S.init(MT, EVEN_IN, G, bx);
        pg8::EpiBf16 E{(bf16_t*)(ws + WS_PR), EVEN_IN, 0};
        pg8::gemm_phase<pg8::EpiBf16, pg8::StaticOrder, true, true>(ldsl + RING_OFF, g, S, E, wave * 64 + fresh_lane());
    }
    SEAM(2);
    if (IN(3)) REP(3) post0_rows(p, gw, ngw, fresh_lane());
    SEAM(3);
    if (IN(4)) REP(4) {
        if (!(args.mode & 4)) { pg8::Gemm g{(const bf16_t*)(ws + WS_UA), (const bf16_t*)(ws + WS_POOLW), MT, 1024, 256, 1024, 256, 256}; pg8::StaticOrder S; S.init(MT, 1024, G, bx);
          pg8::EpiPoolF E{(bf16_t*)(ws + WS_HY), (const bf16_t*)(ws + WS_PR), p.pool_scale};
          pg8::gemm_phase<pg8::EpiPoolF, pg8::StaticOrder, true, true>(ldsl + RING_OFF, g, S, E, wave * 64 + fresh_lane()); }
        __syncthreads();
        att::diff_phase(p, (char*)lds, vcu, G, wave, args.mode);
    }
    SEAM(4);
    if (IN(5)) REP(5) {
        pg8::Gemm g{(const bf16_t*)(ws + WS_HY), (const bf16_t*)(ws + WS_WOUTE), MT, DM, DM, DM, DM, 0}; pg8::StaticOrder S; S.init(MT, DM, G, bx);
        pg8::EpiResidF E{p.x_prompt, p.x_sample, nullptr, (const float*)(ws + WS_MOD) + 4096, p.out};
        pg8::gemm_phase<pg8::EpiResidF, pg8::StaticOrder, true, true>(ldsl + RING_OFF, g, S, E, wave * 64 + fresh_lane());
    }
    SEAM(5);
    if (IN(6)) REP(6) modulate_rows(p, 1, gw, ngw, fresh_lane());
    SEAM(6);
    if (IN(7)) REP(7) {
        pg8::Gemm g{(const bf16_t*)(ws + WS_HY), (const bf16_t*)(ws + WS_WINO), MT, ODD_IN, DM, DM, DM, 0}; pg8::StaticOrder S; S.init(MT, ODD_IN, G, bx);
        float* nck = p.out + (size_t)MT * DM + 2 * (size_t)NBP * HA * SEQP * 128;
        pg8::EpiProj1 E{ws, p.gqa_q_norm_w, p.gqa_k_norm_w, nck, nck + (size_t)NBP * KVH * SEQP * 128, (LAS float*)(ldsl + RES_EX_OFF)};
        pg8::gemm_phase<pg8::EpiProj1, pg8::StaticOrder, true, true>(ldsl + RING_OFF, g, S, E, wave * 64 + fresh_lane());
    }
    SEAM(7);
    if (IN(9)) REP(9) att::gqa_phase(p, (char*)lds, vcu, G, wave, args.mode);
    SEAM(9);
    if (IN(10)) {
        pg8::Gemm g{(const bf16_t*)(ws + WS_HY), (const bf16_t*)(ws + WS_WOUTO), MT, DM, DM, DM, DM, 0}; pg8::StaticOrder S; S.init(MT, DM, G, bx);
        pg8::EpiResidF E{p.x_prompt, p.x_sample, p.out, (const float*)(ws + WS_MOD) + 3 * 6144 + 4096, p.out};
        pg8::gemm_phase<pg8::EpiResidF, pg8::StaticOrder, true, true>(ldsl + RING_OFF, g, S, E, wave * 64 + fresh_lane());
    }
#undef IN
#undef SEAM
}

#ifndef MK_PER_PHASE
#define MK_PER_PHASE 0
#endif
extern "C" void kernel_launch(void* const* d_in, const int* in_sizes, int n_in, void* d_out, int out_size, void* d_ws, size_t ws_size, hipStream_t stream) {
    if (n_in != 26 || ws_size < WS_END || out_size != MT * DM + 2 * NBP * HA * SEQP * 128 + 2 * NBP * KVH * SEQP * 128) {
        fprintf(stderr, "kernel_launch: unexpected shapes n_in %d ws %zu out %d\n", n_in, ws_size, out_size); return; }
    static int ready = 0;
    if (!ready) {
        if (hipFuncSetAttribute((const void*)mega_fwd, hipFuncAttributeMaxDynamicSharedMemorySize, LDS_BYTES) != hipSuccess) { fprintf(stderr, "kernel_launch: hipFuncSetAttribute failed\n"); return; }
        ready = 1;
    }
    MegaArgs a{};
    const float** pin = (const float**)&a.p;
    for (int i = 0; i < 26; ++i) pin[i] = (const float*)d_in[i];
    a.p.out = (float*)d_out; a.p.ws = (unsigned char*)d_ws;
#ifdef EXTRA_PHASE
    (void)hipMemsetAsync((unsigned char*)d_ws + WS_CTL, 0, 2 * MiB, stream);
    a.ph_lo = EXTRA_PHASE; a.ph_hi = EXTRA_PHASE + 1; hipLaunchKernelGGL(mega_fwd, dim3(256), dim3(NWAVES * 64), LDS_BYTES, stream, a);
#endif
    (void)hipMemsetAsync((unsigned char*)d_ws + WS_CTL, 0, 2 * MiB, stream);
#if MK_PER_PHASE
    for (int ph = 0; ph < N_PHASES; ++ph) { a.ph_lo = ph; a.ph_hi = ph + 1; hipLaunchKernelGGL(mega_fwd, dim3(256), dim3(NWAVES * 64), LDS_BYTES, stream, a); }
#else
    a.ph_lo = 0; a.ph_hi = N_PHASES; hipLaunchKernelGGL(mega_fwd, dim3(256), dim3(NWAVES * 64), LDS_BYTES, stream, a);
#endif
#ifdef EXTRA_AFTER
    (void)hipMemsetAsync((unsigned char*)d_ws + WS_CTL, 0, 1 * MiB, stream);
    a.ph_lo = EXTRA_AFTER; a.ph_hi = EXTRA_AFTER + 1; a.mode = EXTRA_MODE; hipLaunchKernelGGL(mega_fwd, dim3(256), dim3(NWAVES * 64), LDS_BYTES, stream, a);
#endif
}
```

```cpp
#include <hip/hip_runtime.h>
#include <cstdio>
#include <cstdint>

typedef unsigned short bf16_t;
typedef float f32x4 __attribute__((ext_vector_type(4)));
typedef unsigned u32x4 __attribute__((ext_vector_type(4)));
typedef unsigned u32x2 __attribute__((ext_vector_type(2)));

constexpr int DM = 2048, NBP = 32, SEQP = 256, NBS = 2, SEQS = 1024, PAST = 256;
constexpr int MP = NBP * SEQP, MS = NBS * SEQS, MT = MP + MS;
constexpr int HA = 8, DKA = 64, DVA = 128, WA = 1024, WB = 1024, GWB = 256;
constexpr int EVEN_IN = 6144, ODD_IN = 5120;
constexpr int HC = 16, KVH = 4, HDC = 128;
constexpr int LKS = PAST + SEQS;
constexpr float EPS = 1e-6f;
constexpr float LOG2E = 1.4426950408889634f;
constexpr float C2A = 0.125f * LOG2E;
constexpr float C2C = 0.08838834764831845f * LOG2E;

constexpr size_t MiB = 1u << 20;
constexpr size_t WS_CTL = 0;
constexpr size_t WS_MOD = 1 * MiB;
constexpr size_t WS_ROPE = 2 * MiB;
constexpr size_t WS_WINE = 4 * MiB;
constexpr size_t WS_WOUTE = 28 * MiB;
constexpr size_t WS_WINO = 36 * MiB;
constexpr size_t WS_WOUTO = 56 * MiB;
constexpr size_t WS_POOLW = 64 * MiB;
constexpr size_t WS_HY = 65 * MiB;
constexpr size_t WS_PR = 105 * MiB;
constexpr size_t WS_Q = 225 * MiB;
constexpr size_t WS_KP = 265 * MiB;
constexpr size_t WS_VP = 281 * MiB;
constexpr size_t WS_KSA = 297 * MiB;
constexpr size_t WS_VSA = 302 * MiB;
constexpr size_t WS_KSC = 307 * MiB;
constexpr size_t WS_VSC = 310 * MiB;
constexpr size_t WS_UA = 313 * MiB;
constexpr size_t WS_SG = WS_PR;
constexpr size_t WS_U = WS_PR + 40 * MiB;
constexpr size_t WS_END = 333 * MiB;

struct Params {
    const float* x_prompt; const float* x_sample; const float* cache_a_k; const float* cache_a_v; const float* cache_c_k; const float* cache_c_v;
    const float* c; const float* c_ctx; const float* norm_w; const float* ada_w; const float* ada_b;
    const float* even_w_in; const float* even_q_norm_w; const float* even_k_norm_w; const float* lam_q1; const float* lam_k1; const float* lam_q2; const float* lam_k2;
    const float* subln_w; const float* pool_w; const float* pool_scale; const float* even_w_out;
    const float* gqa_w_in; const float* gqa_q_norm_w; const float* gqa_k_norm_w; const float* gqa_w_out;
    float* out; unsigned char* ws;
};

__device__ __forceinline__ unsigned f2bf(float f) { unsigned u = __builtin_bit_cast(unsigned, f); return (u + 0x7fffu + ((u >> 16) & 1u)) >> 16; }
__device__ __forceinline__ unsigned pk2(float lo, float hi) { return f2bf(lo) | (f2bf(hi) << 16); }
__device__ __forceinline__ float bf2f(unsigned h) { return __builtin_bit_cast(float, h << 16); }
__device__ __forceinline__ float bflo(unsigned w) { return __builtin_bit_cast(float, w << 16); }
__device__ __forceinline__ float bfhi(unsigned w) { return __builtin_bit_cast(float, w & 0xffff0000u); }
__device__ __forceinline__ float siluf(float x) { return x / (1.f + __expf(-x)); }
__device__ __forceinline__ float wave_sum(float v) {
#pragma unroll
    for (int o = 1; o < 64; o <<= 1) v += __shfl_xor(v, o);
    return v;
}
__device__ __forceinline__ float wave_max(float v) {
#pragma unroll
    for (int o = 1; o < 64; o <<= 1) v = fmaxf(v, __shfl_xor(v, o));
    return v;
}
__device__ __forceinline__ int fresh_lane() { int l; asm volatile("v_mbcnt_lo_u32_b32 %0, -1, 0\n\tv_mbcnt_hi_u32_b32 %0, -1, %0" : "=v"(l)); return l; }
__device__ __forceinline__ const float* xrow_ptr(const Params& p, int m) { return m < MP ? p.x_prompt + (size_t)m * DM : p.x_sample + (size_t)(m - MP) * DM; }
__device__ __forceinline__ int cond_row(int m) { return m < MP ? 0 : 1 + ((m - MP) >> 10); }

__device__ __forceinline__ void mod_items(const Params& p, float* sl  , int bid, int nb, int tid, int nthr) {
    float* mod = (float*)(p.ws + WS_MOD);
    for (int it = bid; it < 256; it += nb) {
        const int l = it >> 7, kc = (it >> 2) & 31, nc = it & 3;
        __syncthreads();
        for (int i = tid; i < 192; i += nthr) { const int r = i >> 6, kk = i & 63, k = kc * 64 + kk; const float cv = r == 0 ? p.c_ctx[k] : p.c[(r - 1) * DM + k]; sl[i] = siluf(cv); }
        __syncthreads();
        for (int q = tid; q < 384; q += nthr) {
            const int n = nc * 1536 + q * 4;
            const float* w = p.ada_w + ((size_t)l * DM + kc * 64) * 6144 + n;
            f32x4 a0 = {0.f, 0.f, 0.f, 0.f}, a1 = a0, a2 = a0;
#pragma unroll 16
            for (int kk = 0; kk < 64; ++kk) { const f32x4 wv = *(const f32x4*)(w + (size_t)kk * 6144); a0 += wv * sl[kk]; a1 += wv * sl[64 + kk]; a2 += wv * sl[128 + kk]; }
            if (kc == 0) { const f32x4 b = *(const f32x4*)(p.ada_b + l * 6144 + n); a0 += b; a1 += b; a2 += b; }
            float* m0 = mod + (size_t)(l * 3) * 6144 + n;
#pragma unroll
            for (int e = 0; e < 4; ++e) { atomicAdd(m0 + e, a0[e]); atomicAdd(m0 + 6144 + e, a1[e]); atomicAdd(m0 + 2 * 6144 + e, a2[e]); }
        }
    }
}

__device__ __forceinline__ void transpose_item(const float* W, int K, int N, bf16_t* WT, float* scr, int item, int lane) {
    const int nblk = N / 32, kb = item / nblk, nb = item % nblk, k0 = 64 * kb, n0 = 32 * nb;
#pragma unroll 8
    for (int i = 0; i < 32; ++i) { const int kk = 2 * i + (lane >> 5); scr[kk * 33 + (lane & 31)] = W[(size_t)(k0 + kk) * N + n0 + (lane & 31)]; }
    __builtin_amdgcn_s_waitcnt(0xc07f); asm volatile("" ::: "memory");
    const int c = lane & 7;
#pragma unroll
    for (int j = 0; j < 4; ++j) { const int n = (lane >> 3) + 8 * j; const float* s = scr + (8 * c) * 33 + n;
        u32x4 o; o.x = pk2(s[0 * 33], s[1 * 33]); o.y = pk2(s[2 * 33], s[3 * 33]); o.z = pk2(s[4 * 33], s[5 * 33]); o.w = pk2(s[6 * 33], s[7 * 33]);
        *(u32x4*)(WT + (size_t)(n0 + n) * K + k0 + 8 * c) = o; }
    __builtin_amdgcn_s_waitcnt(0xc07f); asm volatile("" ::: "memory");
}
template <int PERMK> __device__ __forceinline__ int pos_of_col(int n) {
    if (PERMK == 1) { if (n >= 2048) return n; const int c = n & 255, wc = c >> 6, dim = c & 63, q = dim >> 4, ii = dim & 15; return (n & ~255) + 128 * (q & 1) + 32 * wc + (q >> 1) * 16 + ii; }
    if (PERMK == 2) { if (n >= 2560) return n; const int c = n & 255, hl = c >> 7, dim = c & 127, qd = dim >> 5, i = dim & 31; return (n & ~255) + 128 * (qd & 1) + 32 * (2 * hl + (qd >> 1)) + i; }
    return n;
}
template <int PERMK> __device__ __forceinline__ void transpose_item64(const float* W, int K, int N, bf16_t* WT, bf16_t* scr, int item, int lane) {
    const int nblk = N / 64, kb = item / nblk, nb = item % nblk, k0 = 64 * kb, n0 = 64 * nb;
    const int nq = lane & 15, kr = lane >> 4;
    f32x4 v[16];
    const float* src = W + (size_t)(k0 + kr) * N + n0 + 4 * nq;
#pragma unroll
    for (int i = 0; i < 16; ++i) v[i] = *(const f32x4*)(src + (size_t)(4 * i) * N);
#pragma unroll
    for (int i = 0; i < 16; ++i) { const int k = 4 * i + kr;
#pragma unroll
        for (int e = 0; e < 4; ++e) scr[(4 * nq + e) * 72 + k] = (bf16_t)f2bf(v[i][e]); }
    __builtin_amdgcn_s_waitcnt(0xc07f); asm volatile("" ::: "memory");
#pragma unroll
    for (int j = 0; j < 8; ++j) { const int idx = lane + 64 * j, n = idx >> 3, c = idx & 7;
        *(u32x4*)(WT + (size_t)pos_of_col<PERMK>(n0 + n) * K + k0 + 8 * c) = *(const u32x4*)(scr + n * 72 + 8 * c); }
    __builtin_amdgcn_s_waitcnt(0xc07f); asm volatile("" ::: "memory");
}
__device__ __forceinline__ void weights_items(const Params& p, float* scrf  , int gw, int ngw, int lane) {
    bf16_t* scr = (bf16_t*)scrf;
    constexpr int I_WINE = 32 * (EVEN_IN / 64), I_WOUT = 32 * (DM / 64), I_WINO = 32 * (ODD_IN / 64), I_POOL = 4 * 4;
    constexpr int NITEMS = I_WINE + I_WOUT + I_WINO + I_WOUT + 4 * I_POOL;
    for (int it = gw; it < NITEMS; it += ngw) {
        int r = it;
        if (r < I_WINE) { transpose_item64<1>(p.even_w_in, DM, EVEN_IN, (bf16_t*)(p.ws + WS_WINE), scr, r, lane); continue; } r -= I_WINE;
        if (r < I_WOUT) { transpose_item64<0>(p.even_w_out, DM, DM, (bf16_t*)(p.ws + WS_WOUTE), scr, r, lane); continue; } r -= I_WOUT;
        if (r < I_WINO) { transpose_item64<2>(p.gqa_w_in, DM, ODD_IN, (bf16_t*)(p.ws + WS_WINO), scr, r, lane); continue; } r -= I_WINO;
        if (r < I_WOUT) { transpose_item64<0>(p.gqa_w_out, DM, DM, (bf16_t*)(p.ws + WS_WOUTO), scr, r, lane); continue; } r -= I_WOUT;
        const int g = r / I_POOL; r -= g * I_POOL;
        transpose_item64<0>(p.pool_w + (size_t)g * 65536, 256, 256, (bf16_t*)(p.ws + WS_POOLW) + (size_t)g * 65536, scr, r, lane);
    }
}
__device__ __forceinline__ void caches_rope_items(const Params& p, long gt, long ngt) {
    constexpr long NA = 2L * 8 * 256 * 128 / 4, NC = 2L * 4 * 256 * 128 / 4;
    for (long i = gt; i < 2 * NA + 2 * NC; i += ngt) {
        long j = i; const float* src; bf16_t* dst;
        if (j < NA) { src = p.cache_a_k; dst = (bf16_t*)(p.ws + WS_KSA); } else if ((j -= NA) < NA) { src = p.cache_a_v; dst = (bf16_t*)(p.ws + WS_VSA); }
        else if ((j -= NA) < NC) { src = p.cache_c_k; dst = (bf16_t*)(p.ws + WS_KSC); } else { j -= NC; src = p.cache_c_v; dst = (bf16_t*)(p.ws + WS_VSC); }
        const long e = j * 4, bh = e / (256 * 128), rem = e % (256 * 128);
        const f32x4 v = *(const f32x4*)(src + e);
        u32x2 o; o.x = pk2(v[0], v[1]); o.y = pk2(v[2], v[3]);
        *(u32x2*)(dst + bh * (LKS * 128) + rem) = o;
    }
    float* ropeA = (float*)(p.ws + WS_ROPE); float* ropeC = ropeA + 2 * 1024 * 64;
    for (long i = gt; i < 1024L * 64 + 1024L * 128; i += ngt) {
        const bool isA = i < 1024L * 64; const long j = isA ? i : i - 1024L * 64; const int dim = isA ? 64 : 128, quarter = dim / 4;
        const int t = (int)(j / dim), d = (int)(j % dim); const int qd = d / quarter, fi = d % quarter;
        const float freq = powf(10000.0f, -(float)fi / (float)quarter);
        const float pos = (qd < 2) ? (float)(t / 64) : (float)(t % 64);
        const float ang = pos * freq;
        float* base = isA ? ropeA : ropeC;
        base[j] = cosf(ang); base[(size_t)1024 * dim + j] = sinf(ang);
    }
}

__device__ __forceinline__ void modulate_rows(const Params& p, int layer, int gw, int ngw, int lane) {
    const float* mod = (const float*)(p.ws + WS_MOD) + (size_t)layer * 3 * 6144;
    const float* nw = p.norm_w + layer * DM;
    bf16_t* H = (bf16_t*)(p.ws + WS_HY);
    for (int m = gw; m < MT; m += ngw) {
        const float* xr = layer == 0 ? xrow_ptr(p, m) : p.out + (size_t)m * DM;
        const float* mr = mod + (size_t)cond_row(m) * 6144;
        f32x4 v[8]; float ss = 0.f;
#pragma unroll
        for (int j = 0; j < 8; ++j) { v[j] = *(const f32x4*)(xr + 4 * lane + 256 * j); ss += (v[j][0] * v[j][0] + v[j][1] * v[j][1]) + (v[j][2] * v[j][2] + v[j][3] * v[j][3]); }
        const float rstd = 1.0f / sqrtf(wave_sum(ss) * (1.f / DM) + EPS);
#pragma unroll
        for (int j = 0; j < 8; ++j) { const int k = 4 * lane + 256 * j;
            const f32x4 w = *(const f32x4*)(nw + k), sh = *(const f32x4*)(mr + k), sc = *(const f32x4*)(mr + 2048 + k);
            const f32x4 h = v[j] * rstd * w * (sc + 1.0f) + sh;
            u32x2 o; o.x = pk2(h[0], h[1]); o.y = pk2(h[2], h[3]);
            *(u32x2*)(H + (size_t)m * DM + k) = o; }
    }
}

template <int DIM>
__device__ __forceinline__ f32x4 norm_rope4(f32x4 v, int lg  , const float* w, bool rope, const float* cosr, const float* sinr) {
    float ss = (v[0] * v[0] + v[1] * v[1]) + (v[2] * v[2] + v[3] * v[3]);
#pragma unroll
    for (int o = 1; o < DIM / 4; o <<= 1) ss += __shfl_xor(ss, o);
    const float r = 1.0f / sqrtf(ss * (1.f / DIM) + EPS);
    const f32x4 wv = *(const f32x4*)(w + 4 * lg);
    f32x4 y = v * r * wv;
    f32x4 pr;
#pragma unroll
    for (int e = 0; e < 4; ++e) pr[e] = __shfl_xor(y[e], DIM / 16);
    if (rope) {
        const f32x4 cs = *(const f32x4*)(cosr + 4 * lg), sn = *(const f32x4*)(sinr + 4 * lg);
        const bool odd = ((lg / (DIM / 16)) & 1) != 0;
        y = odd ? (y * cs + pr * sn) : (y * cs - pr * sn);
    }
    return y;
}

__device__ __forceinline__ void post0_rows(const Params& p, int gw, int ngw, int lane) {
    const bf16_t* PR = (const bf16_t*)(p.ws + WS_PR);
    bf16_t* QA = (bf16_t*)(p.ws + WS_Q); bf16_t* UA = (bf16_t*)(p.ws + WS_UA);
    const float* ropeA = (const float*)(p.ws + WS_ROPE);
    float* new_a_k = p.out + (size_t)MT * DM; float* new_a_v = new_a_k + (size_t)NBP * HA * SEQP * 128;
    for (int m = gw; m < MT; m += ngw) {
        const bool smp = m >= MP; const int b = smp ? (m - MP) >> 10 : m >> 8, t = smp ? (m - MP) & 1023 : m & 255;
        const bf16_t* pr = PR + (size_t)m * EVEN_IN;
        const float* cosr = ropeA + (size_t)t * 64; const float* sinr = ropeA + 1024 * 64 + (size_t)t * 64;
        const int sub = lane >> 4, lg = lane & 15;
#pragma unroll 2
        for (int st = 0; st < 8; ++st) {
            const int grp = st * 4 + sub;
            const u32x2 raw = *(const u32x2*)(pr + grp * 64 + 4 * lg);
            f32x4 v = {bflo(raw.x), bfhi(raw.x), bflo(raw.y), bfhi(raw.y)};
            const bool isk = grp >= 16;
            f32x4 y = norm_rope4<64>(v, lg, isk ? p.even_k_norm_w : p.even_q_norm_w, smp, cosr, sinr);
            if (!isk) { y = y * C2A; u32x2 o; o.x = pk2(y[0], y[1]); o.y = pk2(y[2], y[3]); *(u32x2*)(QA + (size_t)m * 1024 + grp * 64 + 4 * lg) = o; }
            else { const int g2 = grp - 16, h = g2 >> 1, j = g2 & 1;
                u32x2 o; o.x = pk2(y[0], y[1]); o.y = pk2(y[2], y[3]);
                if (smp) *(u32x2*)((bf16_t*)(p.ws + WS_KSA) + ((size_t)(b * HA + h) * LKS + PAST + t) * 128 + j * 64 + 4 * lg) = o;
                else { const size_t off = ((size_t)(b * HA + h) * SEQP + t) * 128 + j * 64 + 4 * lg; *(u32x2*)((bf16_t*)(p.ws + WS_KP) + off) = o; *(f32x4*)(new_a_k + off) = y; } }
        }
#pragma unroll
        for (int i = 0; i < 2; ++i) { const int c = 8 * lane + 512 * i, h = c >> 7, d = c & 127;
            const u32x4 raw = *(const u32x4*)(pr + 2048 + c);
            if (smp) *(u32x4*)((bf16_t*)(p.ws + WS_VSA) + ((size_t)(b * HA + h) * LKS + PAST + t) * 128 + d) = raw;
            else { const size_t off = ((size_t)(b * HA + h) * SEQP + t) * 128 + d; *(u32x4*)((bf16_t*)(p.ws + WS_VP) + off) = raw;
                *(f32x4*)(new_a_v + off) = (f32x4){bflo(raw.x), bfhi(raw.x), bflo(raw.y), bfhi(raw.y)}; *(f32x4*)(new_a_v + off + 4) = (f32x4){bflo(raw.z), bfhi(raw.z), bflo(raw.w), bfhi(raw.w)}; } }
        const int L = smp ? SEQS : SEQP;
#pragma unroll
        for (int i = 0; i < 2; ++i) { const int ch = lane + 64 * i, c = 8 * ch, g = ch >> 5, half = 1 << g;
            const int lo = max(t - half, 0), hi = min(t + half, L);
            float s[8] = {0.f, 0.f, 0.f, 0.f, 0.f, 0.f, 0.f, 0.f};
            for (int tt = lo; tt < hi; ++tt) { const u32x4 raw = *(const u32x4*)(pr + (ptrdiff_t)(tt - t) * EVEN_IN + 3072 + c);
                s[0] += bflo(raw.x); s[1] += bfhi(raw.x); s[2] += bflo(raw.y); s[3] += bfhi(raw.y); s[4] += bflo(raw.z); s[5] += bfhi(raw.z); s[6] += bflo(raw.w); s[7] += bfhi(raw.w); }
            const float inv = 1.0f / (float)(hi - lo);
            const u32x4 own = *(const u32x4*)(pr + 3072 + c);
            u32x4 o; o.x = pk2(s[0] * inv - bflo(own.x), s[1] * inv - bfhi(own.x)); o.y = pk2(s[2] * inv - bflo(own.y), s[3] * inv - bfhi(own.y));
            o.z = pk2(s[4] * inv - bflo(own.z), s[5] * inv - bfhi(own.z)); o.w = pk2(s[6] * inv - bflo(own.w), s[7] * inv - bfhi(own.w));
            *(u32x4*)(UA + (size_t)m * 1024 + c) = o; }
    }
}

__device__ __forceinline__ void pool_rows(const Params& p, int gw, int ngw, int lane) {
    const bf16_t* U = (const bf16_t*)(p.ws + WS_U); bf16_t* UA = (bf16_t*)(p.ws + WS_UA);
    for (int m = gw; m < MT; m += ngw) {
        const bool smp = m >= MP; const int t = smp ? (m - MP) & 1023 : m & 255, L = smp ? SEQS : SEQP;
        const bf16_t* pr = U + (size_t)m * 1024;
#pragma unroll
        for (int i = 0; i < 2; ++i) { const int ch = lane + 64 * i, c = 8 * ch, g = ch >> 5, half = 1 << g;
            const int lo = max(t - half, 0), hi = min(t + half, L);
            float s[8] = {0.f, 0.f, 0.f, 0.f, 0.f, 0.f, 0.f, 0.f};
            for (int tt = lo; tt < hi; ++tt) { const u32x4 raw = *(const u32x4*)(pr + (ptrdiff_t)(tt - t) * 1024 + c);
                s[0] += bflo(raw.x); s[1] += bfhi(raw.x); s[2] += bflo(raw.y); s[3] += bfhi(raw.y); s[4] += bflo(raw.z); s[5] += bfhi(raw.z); s[6] += bflo(raw.w); s[7] += bfhi(raw.w); }
            const float inv = 1.0f / (float)(hi - lo);
            const u32x4 own = *(const u32x4*)(pr + c);
            u32x4 o; o.x = pk2(s[0] * inv - bflo(own.x), s[1] * inv - bfhi(own.x)); o.y = pk2(s[2] * inv - bflo(own.y), s[3] * inv - bfhi(own.y));
            o.z = pk2(s[4] * inv - bflo(own.z), s[5] * inv - bfhi(own.z)); o.w = pk2(s[6] * inv - bflo(own.w), s[7] * inv - bfhi(own.w));
            *(u32x4*)(UA + (size_t)m * 1024 + c) = o; }
    }
}
__device__ __forceinline__ void post1_rows(const Params& p, int gw, int ngw, int lane) {
    const bf16_t* PR = (const bf16_t*)(p.ws + WS_PR);
    bf16_t* QC = (bf16_t*)(p.ws + WS_Q);
    const float* ropeC = (const float*)(p.ws + WS_ROPE) + 2 * 1024 * 64;
    float* new_c_k = p.out + (size_t)MT * DM + 2 * (size_t)NBP * HA * SEQP * 128; float* new_c_v = new_c_k + (size_t)NBP * KVH * SEQP * 128;
    for (int m = gw; m < MT; m += ngw) {
        const bool smp = m >= MP; const int b = smp ? (m - MP) >> 10 : m >> 8, t = smp ? (m - MP) & 1023 : m & 255;
        const bf16_t* pr = PR + (size_t)m * ODD_IN;
        const float* cosr = ropeC + (size_t)t * 128; const float* sinr = ropeC + 1024 * 128 + (size_t)t * 128;
        const int sub = lane >> 5, lg = lane & 31;
#pragma unroll 2
        for (int st = 0; st < 10; ++st) {
            const int grp = st * 2 + sub;
            const u32x2 raw = *(const u32x2*)(pr + grp * 128 + 4 * lg);
            f32x4 v = {bflo(raw.x), bfhi(raw.x), bflo(raw.y), bfhi(raw.y)};
            const bool isk = grp >= 16;
            f32x4 y = norm_rope4<128>(v, lg, isk ? p.gqa_k_norm_w : p.gqa_q_norm_w, smp, cosr, sinr);
            if (!isk) { y = y * C2C; u32x2 o; o.x = pk2(y[0], y[1]); o.y = pk2(y[2], y[3]); *(u32x2*)(QC + (size_t)m * DM + grp * 128 + 4 * lg) = o; }
            else { const int kh = grp - 16;
                u32x2 o; o.x = pk2(y[0], y[1]); o.y = pk2(y[2], y[3]);
                if (smp) *(u32x2*)((bf16_t*)(p.ws + WS_KSC) + ((size_t)(b * KVH + kh) * LKS + PAST + t) * 128 + 4 * lg) = o;
                else { const size_t off = ((size_t)(b * KVH + kh) * SEQP + t) * 128 + 4 * lg; *(u32x2*)((bf16_t*)(p.ws + WS_KP) + off) = o; *(f32x4*)(new_c_k + off) = y; } }
        }
        { const int c = 8 * lane, kh = c >> 7, d = c & 127;
            const u32x4 raw = *(const u32x4*)(pr + 2560 + c);
            if (smp) *(u32x4*)((bf16_t*)(p.ws + WS_VSC) + ((size_t)(b * KVH + kh) * LKS + PAST + t) * 128 + d) = raw;
            else { const size_t off = ((size_t)(b * KVH + kh) * SEQP + t) * 128 + d; *(u32x4*)((bf16_t*)(p.ws + WS_VP) + off) = raw;
                *(f32x4*)(new_c_v + off) = (f32x4){bflo(raw.x), bfhi(raw.x), bflo(raw.y), bfhi(raw.y)}; *(f32x4*)(new_c_v + off + 4) = (f32x4){bflo(raw.z), bfhi(raw.z), bflo(raw.w), bfhi(raw.w)}; } }
    }
}

struct EpiStoreBf16 { bf16_t* C; int ldc; int pad; __device__ void operator()(int r, int c, float v) const { C[(size_t)r * ldc + c] = (bf16_t)f2bf(v); } };
struct EpiPool { bf16_t* Y; const bf16_t* PR; const float* pscale; int g; int pad;
    __device__ void operator()(int r, int c, float v) const { const int cc = g * 256 + c; const float gt = bf2f(PR[(size_t)r * EVEN_IN + 4096 + 1024 + cc]);
        Y[(size_t)r * DM + 1024 + cc] = (bf16_t)f2bf(v * pscale[cc] * siluf(gt)); } };
struct EpiResid { const float* x_prompt; const float* x_sample; const float* base; const float* gate; float* out;
    __device__ void operator()(int r, int c, float v) const { const float bs = base ? base[(size_t)r * DM + c] : (r < MP ? x_prompt[(size_t)r * DM + c] : x_sample[(size_t)(r - MP) * DM + c]);
        out[(size_t)r * DM + c] = bs + gate[(size_t)cond_row(r) * 6144 + c] * v; } };
template <class Epi>
__global__ __launch_bounds__(256) void gemm_naive(const bf16_t* A, int lda, const bf16_t* Bt, int ldb, int M, int N, int K, Epi E) {
    __shared__ float As[16][65], Bs[16][65];
    const int tid = threadIdx.x, tx = tid & 15, ty = tid >> 4;
    const int nbn = N / 64, bm = blockIdx.x / nbn, bn = blockIdx.x % nbn;
    float acc[4][4] = {};
    const int lr = tid >> 2, lc = (tid & 3) * 4;
    for (int k0 = 0; k0 < K; k0 += 16) {
        const u32x2 ra = *(const u32x2*)(A + (size_t)(bm * 64 + lr) * lda + k0 + lc), rb = *(const u32x2*)(Bt + (size_t)(bn * 64 + lr) * ldb + k0 + lc);
        __syncthreads();
        As[lc + 0][lr] = bflo(ra.x); As[lc + 1][lr] = bfhi(ra.x); As[lc + 2][lr] = bflo(ra.y); As[lc + 3][lr] = bfhi(ra.y);
        Bs[lc + 0][lr] = bflo(rb.x); Bs[lc + 1][lr] = bfhi(rb.x); Bs[lc + 2][lr] = bflo(rb.y); Bs[lc + 3][lr] = bfhi(rb.y);
        __syncthreads();
#pragma unroll
        for (int kk = 0; kk < 16; ++kk) { float a[4], b[4];
#pragma unroll
            for (int i = 0; i < 4; ++i) { a[i] = As[kk][ty * 4 + i]; b[i] = Bs[kk][tx * 4 + i]; }
#pragma unroll
            for (int i = 0; i < 4; ++i)
#pragma unroll
                for (int j = 0; j < 4; ++j) acc[i][j] += a[i] * b[j]; }
    }
#pragma unroll
    for (int i = 0; i < 4; ++i)
#pragma unroll
        for (int j = 0; j < 4; ++j) E(bm * 64 + ty * 4 + i, bn * 64 + tx * 4 + j, acc[i][j]);
}

__device__ __forceinline__ void diffattn_tasks(const Params& p, float* s1  , long gw, long ngw, int lane) {
    float* s2 = s1 + LKS; float* qs = s2 + LKS;
    const bf16_t* QA = (const bf16_t*)(p.ws + WS_Q); const bf16_t* PR = (const bf16_t*)(p.ws + WS_PR); bf16_t* Y = (bf16_t*)(p.ws + WS_HY);
    const float lam_init = 0.2f;
    const float lam = expf(wave_sum(p.lam_q1[lane] * p.lam_k1[lane])) - expf(wave_sum(p.lam_q2[lane] * p.lam_k2[lane])) + lam_init;
    for (long task = gw; task < (long)MT * HA; task += ngw) {
        const int m = (int)(task / HA), h = (int)(task % HA);
        const bool smp = m >= MP; const int b = smp ? (m - MP) >> 10 : m >> 8; const int Lk = smp ? LKS : SEQP;
        const bf16_t* Kb = smp ? (const bf16_t*)(p.ws + WS_KSA) + (size_t)(b * HA + h) * LKS * 128 : (const bf16_t*)(p.ws + WS_KP) + (size_t)(b * HA + h) * SEQP * 128;
        const bf16_t* Vb = smp ? (const bf16_t*)(p.ws + WS_VSA) + (size_t)(b * HA + h) * LKS * 128 : (const bf16_t*)(p.ws + WS_VP) + (size_t)(b * HA + h) * SEQP * 128;
        { const unsigned w = *(const unsigned*)(QA + (size_t)m * 1024 + h * 128 + 2 * lane); qs[2 * lane] = bflo(w); qs[2 * lane + 1] = bfhi(w); }
        __builtin_amdgcn_s_waitcnt(0xc07f); asm volatile("" ::: "memory");
        float m1 = -1e30f, m2 = -1e30f;
        for (int j = lane; j < Lk; j += 64) { const bf16_t* kr = Kb + (size_t)j * 128; float a1 = 0.f, a2 = 0.f;
#pragma unroll
            for (int d8 = 0; d8 < 8; ++d8) { const u32x4 w1 = *(const u32x4*)(kr + d8 * 8), w2 = *(const u32x4*)(kr + 64 + d8 * 8); const float* q1 = qs + d8 * 8; const float* q2 = qs + 64 + d8 * 8;
                a1 += q1[0] * bflo(w1.x) + q1[1] * bfhi(w1.x) + q1[2] * bflo(w1.y) + q1[3] * bfhi(w1.y) + q1[4] * bflo(w1.z) + q1[5] * bfhi(w1.z) + q1[6] * bflo(w1.w) + q1[7] * bfhi(w1.w);
                a2 += q2[0] * bflo(w2.x) + q2[1] * bfhi(w2.x) + q2[2] * bflo(w2.y) + q2[3] * bfhi(w2.y) + q2[4] * bflo(w2.z) + q2[5] * bfhi(w2.z) + q2[6] * bflo(w2.w) + q2[7] * bfhi(w2.w); }
            s1[j] = a1; s2[j] = a2; m1 = fmaxf(m1, a1); m2 = fmaxf(m2, a2); }
        m1 = wave_max(m1); m2 = wave_max(m2);
        float l1 = 0.f, l2 = 0.f;
        for (int j = lane; j < Lk; j += 64) { const float e1 = exp2f(s1[j] - m1), e2 = exp2f(s2[j] - m2); s1[j] = e1; s2[j] = e2; l1 += e1; l2 += e2; }
        l1 = wave_sum(l1); l2 = wave_sum(l2);
        const float i1 = 1.f / l1, i2 = lam / l2;
        for (int j = lane; j < Lk; j += 64) s1[j] = s1[j] * i1 - s2[j] * i2;
        __builtin_amdgcn_s_waitcnt(0xc07f); asm volatile("" ::: "memory");
        float o0 = 0.f, o1 = 0.f;
        for (int j = 0; j < Lk; ++j) { const unsigned w = *(const unsigned*)(Vb + (size_t)j * 128 + 2 * lane); const float pj = s1[j]; o0 += pj * bflo(w); o1 += pj * bfhi(w); }
        const float r = 1.0f / sqrtf(wave_sum(o0 * o0 + o1 * o1) * (1.f / 128.f) + EPS);
        const unsigned gw = *(const unsigned*)(PR + (size_t)m * EVEN_IN + 4096 + h * 128 + 2 * lane);
        const float y0 = o0 * r * p.subln_w[2 * lane] * (1.f - lam_init) * siluf(bflo(gw)), y1 = o1 * r * p.subln_w[2 * lane + 1] * (1.f - lam_init) * siluf(bfhi(gw));
        *(unsigned*)(Y + (size_t)m * DM + h * 128 + 2 * lane) = pk2(y0, y1);
        __builtin_amdgcn_s_waitcnt(0xc07f); asm volatile("" ::: "memory");
    }
}
__device__ __forceinline__ void gqa_tasks(const Params& p, float* s1  , long gw, long ngw, int lane) {
    float* qs = s1 + LKS;
    const bf16_t* QC = (const bf16_t*)(p.ws + WS_Q); const bf16_t* PR = (const bf16_t*)(p.ws + WS_PR); bf16_t* Y = (bf16_t*)(p.ws + WS_HY);
    for (long task = gw; task < (long)MT * HC; task += ngw) {
        const int m = (int)(task / HC), hq = (int)(task % HC), kh = hq >> 2;
        const bool smp = m >= MP; const int b = smp ? (m - MP) >> 10 : m >> 8; const int Lk = smp ? LKS : SEQP;
        const bf16_t* Kb = smp ? (const bf16_t*)(p.ws + WS_KSC) + (size_t)(b * KVH + kh) * LKS * 128 : (const bf16_t*)(p.ws + WS_KP) + (size_t)(b * KVH + kh) * SEQP * 128;
        const bf16_t* Vb = smp ? (const bf16_t*)(p.ws + WS_VSC) + (size_t)(b * KVH + kh) * LKS * 128 : (const bf16_t*)(p.ws + WS_VP) + (size_t)(b * KVH + kh) * SEQP * 128;
        { const unsigned w = *(const unsigned*)(QC + (size_t)m * DM + hq * 128 + 2 * lane); qs[2 * lane] = bflo(w); qs[2 * lane + 1] = bfhi(w); }
        __builtin_amdgcn_s_waitcnt(0xc07f); asm volatile("" ::: "memory");
        float m1 = -1e30f;
        for (int j = lane; j < Lk; j += 64) { const bf16_t* kr = Kb + (size_t)j * 128; float a1 = 0.f;
#pragma unroll
            for (int d8 = 0; d8 < 16; ++d8) { const u32x4 w1 = *(const u32x4*)(kr + d8 * 8); const float* q1 = qs + d8 * 8;
                a1 += q1[0] * bflo(w1.x) + q1[1] * bfhi(w1.x) + q1[2] * bflo(w1.y) + q1[3] * bfhi(w1.y) + q1[4] * bflo(w1.z) + q1[5] * bfhi(w1.z) + q1[6] * bflo(w1.w) + q1[7] * bfhi(w1.w); }
            s1[j] = a1; m1 = fmaxf(m1, a1); }
        m1 = wave_max(m1);
        float l1 = 0.f;
        for (int j = lane; j < Lk; j += 64) { const float e1 = exp2f(s1[j] - m1); s1[j] = e1; l1 += e1; }
        l1 = wave_sum(l1);
        __builtin_amdgcn_s_waitcnt(0xc07f); asm volatile("" ::: "memory");
        float o0 = 0.f, o1 = 0.f;
        for (int j = 0; j < Lk; ++j) { const unsigned w = *(const unsigned*)(Vb + (size_t)j * 128 + 2 * lane); const float pj = s1[j]; o0 += pj * bflo(w); o1 += pj * bfhi(w); }
        const float il = 1.f / l1;
        const unsigned gw = *(const unsigned*)(PR + (size_t)m * ODD_IN + 3072 + hq * 128 + 2 * lane);
        *(unsigned*)(Y + (size_t)m * DM + hq * 128 + 2 * lane) = pk2(o0 * il * siluf(bflo(gw)), o1 * il * siluf(bfhi(gw)));
        __builtin_amdgcn_s_waitcnt(0xc07f); asm volatile("" ::: "memory");
    }
}

__global__ __launch_bounds__(256) void diffattn_naive(Params p) { __shared__ float sh[4][2 * LKS + 128]; diffattn_tasks(p, sh[threadIdx.x >> 6], (long)blockIdx.x * 4 + (threadIdx.x >> 6), (long)gridDim.x * 4, threadIdx.x & 63); }
__global__ __launch_bounds__(256) void gqa_naive(Params p) { __shared__ float sh[4][LKS + 128]; gqa_tasks(p, sh[threadIdx.x >> 6], (long)blockIdx.x * 4 + (threadIdx.x >> 6), (long)gridDim.x * 4, threadIdx.x & 63); }
__global__ __launch_bounds__(512) void k_prologue(Params p) {
    __shared__ float scr[8 * 2304];
    const int wid = threadIdx.x >> 6, lane = threadIdx.x & 63;
    mod_items(p, scr, blockIdx.x, gridDim.x, threadIdx.x, blockDim.x);
    __syncthreads();
    weights_items(p, scr + wid * 2304, blockIdx.x * 8 + wid, gridDim.x * 8, lane);
    caches_rope_items(p, (long)blockIdx.x * 512 + threadIdx.x, (long)gridDim.x * 512);
}
__global__ __launch_bounds__(512) void k_modulate(Params p, int layer) { modulate_rows(p, layer, blockIdx.x * 8 + (threadIdx.x >> 6), gridDim.x * 8, threadIdx.x & 63); }
__global__ __launch_bounds__(512) void k_post0(Params p) { post0_rows(p, blockIdx.x * 8 + (threadIdx.x >> 6), gridDim.x * 8, threadIdx.x & 63); }
__global__ __launch_bounds__(512) void k_post1(Params p) { post1_rows(p, blockIdx.x * 8 + (threadIdx.x >> 6), gridDim.x * 8, threadIdx.x & 63); }


namespace pg8 {
#define PG8_LAS __attribute__((address_space(3)))
typedef short bf16x8 __attribute__((ext_vector_type(8)));
constexpr int BM = 256, BK = 64, HALF = 128, HTB = HALF * BK * 2  , STAGE_BYTES = 8 * HTB, NXCD = 8, WGM = 8;
__host__ __device__ __forceinline__ int lds_byte(int r, int c) { const int st = (r >> 4) * 2 + (c >> 5), rr = r & 15, cc = c & 31, ob = rr * 64 + cc * 2; return st * 1024 + (ob ^ (((ob >> 9) & 1) << 5)); }
__host__ __device__ __forceinline__ void stage_rc(int b, int& R, int& C) { const int st = b / 1024, sb = b % 1024, swz = sb ^ (((sb >> 9) & 1) << 5); R = (st >> 1) * 16 + swz / 64; C = (st & 1) * 32 + (swz % 64) / 2; }
__host__ __device__ __forceinline__ int perm32(int rho) { const int n = rho >> 4, i = rho & 15; return 8 * (i >> 2) + 4 * n + (i & 3); }
struct Unit { int pm, pn; };
struct Gemm { const bf16_t* A; const bf16_t* Bt; int M, N, K, lda, ldb, a_pn_off; };
struct StaticOrder {
    int nM, nN, nwg, G, c;
    __host__ __device__ void init(int M, int N, int G_, int c_) { nM = M / BM; nN = N / BM; nwg = nM * nN; G = G_; c = c_; }
    __host__ __device__ bool next(int i, Unit& u) const {
        const long L = (long)i * G + c; if (L >= nwg) return false;
        int wgid = (int)L; { const int q = nwg / NXCD, r = nwg % NXCD, xcd = wgid % NXCD, off = wgid / NXCD; wgid = (xcd < r ? xcd * (q + 1) : r * (q + 1) + (xcd - r) * q) + off; }
        const int nig = WGM * nN, gid = wgid / nig, fm = gid * WGM, gsz = (nM - fm) < WGM ? (nM - fm) : WGM;
        u.pm = fm + ((wgid % nig) % gsz); u.pn = (wgid % nig) / gsz; return true;
    }
    __device__ __forceinline__ void a_ready(const Unit&) const {}
    __device__ __forceinline__ void done(const Unit&) const {}
};
__device__ __forceinline__ unsigned cvt_pk_bf16(float lo, float hi) { unsigned r; asm volatile("v_cvt_pk_bf16_f32 %0, %1, %2" : "=v"(r) : "v"(lo), "v"(hi)); return r; }
struct EpiBf16 {
    static constexpr bool PERM = true, AFTER_DRAIN = false;
    bf16_t* O; int ldc; int pad;
    __device__ __forceinline__ void operator()(const f32x4 (&acc)[2][2][4][2], const Unit& u, int wr, int wc, int fr, int fq) const {
        const int row0 = u.pm * BM + wr * 64 + fr, col0 = u.pn * BM + wc * 32 + 8 * fq;
#pragma unroll
        for (int ai = 0; ai < 2; ++ai)
#pragma unroll
            for (int m = 0; m < 4; ++m) { bf16_t* rowp = O + (size_t)(row0 + ai * HALF + m * 16) * ldc + col0;
#pragma unroll
                for (int bj = 0; bj < 2; ++bj) { const f32x4 v0 = acc[ai][bj][m][0], v1 = acc[ai][bj][m][1];
                    u32x4 w; w.x = cvt_pk_bf16(v0[0], v0[1]); w.y = cvt_pk_bf16(v0[2], v0[3]); w.z = cvt_pk_bf16(v1[0], v1[1]); w.w = cvt_pk_bf16(v1[2], v1[3]);
                    *(u32x4*)(rowp + bj * HALF) = w; } }
    }
};
struct EpiPoolF {
    static constexpr bool PERM = true, AFTER_DRAIN = false;
    bf16_t* Y; const bf16_t* SG; const float* pscale;
    __device__ __forceinline__ void operator()(const f32x4 (&acc)[2][2][4][2], const Unit& u, int wr, int wc, int fr, int fq) const {
        const int row0 = u.pm * BM + wr * 64 + fr, col0 = u.pn * BM + wc * 32 + 8 * fq;
        f32x4 ps[2][2];
#pragma unroll
        for (int bj = 0; bj < 2; ++bj) { ps[bj][0] = *(const f32x4*)(pscale + col0 + bj * HALF); ps[bj][1] = *(const f32x4*)(pscale + col0 + bj * HALF + 4); }
#pragma unroll
        for (int ai = 0; ai < 2; ++ai)
#pragma unroll
            for (int m = 0; m < 4; ++m) { const size_t r = (size_t)(row0 + ai * HALF + m * 16);
#pragma unroll
                for (int bj = 0; bj < 2; ++bj) { const int c = col0 + bj * HALF;
                    const u32x4 g = *(const u32x4*)(SG + r * DM + 1024 + c);
                    const f32x4 v0 = acc[ai][bj][m][0] * ps[bj][0], v1 = acc[ai][bj][m][1] * ps[bj][1];
                    u32x4 w; w.x = cvt_pk_bf16(v0[0] * bflo(g.x), v0[1] * bfhi(g.x)); w.y = cvt_pk_bf16(v0[2] * bflo(g.y), v0[3] * bfhi(g.y));
                    w.z = cvt_pk_bf16(v1[0] * bflo(g.z), v1[1] * bfhi(g.z)); w.w = cvt_pk_bf16(v1[2] * bflo(g.w), v1[3] * bfhi(g.w));
                    *(u32x4*)(Y + r * DM + 1024 + c) = w; } }
    }
};
struct EpiProj0 {
    static constexpr bool PERM = true, AFTER_DRAIN = false;
    unsigned char* ws; const float* qw; const float* kw; float* nak; float* nav;
    __device__ __forceinline__ void operator()(const f32x4 (&acc)[2][2][4][2], const Unit& u, int wr, int wc, int fr, int fq) const {
        const int pm = u.pm, pn = u.pn;
        const bool smp = pm >= 32; const int b = smp ? (pm - 32) >> 2 : pm, tb = (smp ? ((pm - 32) & 3) * 256 : 0) + wr * 64 + fr;
        const size_t rowb = (size_t)pm * 256 + wr * 64 + fr;
        if (pn < 8) {
            const bool isk = pn >= 4; const int hl = wc >> 1, j = wc & 1, h = (pn & 3) * 2 + hl, dim_a = 8 * fq + 16 * (fq >> 1);
            const float* w = isk ? kw : qw;
            f32x4 wv[2][2];
#pragma unroll
            for (int bj = 0; bj < 2; ++bj)
#pragma unroll
                for (int n = 0; n < 2; ++n) wv[bj][n] = *(const f32x4*)(w + dim_a + 16 * bj + 4 * n);
            const float* ropeA = (const float*)(ws + WS_ROPE);
#pragma unroll
            for (int ai = 0; ai < 2; ++ai)
#pragma unroll
                for (int m = 0; m < 4; ++m) { const int t = tb + ai * 128 + m * 16; const size_t row = rowb + ai * 128 + m * 16;
                    float ss = 0.f;
#pragma unroll
                    for (int bj = 0; bj < 2; ++bj)
#pragma unroll
                        for (int n = 0; n < 2; ++n) { const f32x4 x = acc[ai][bj][m][n]; ss += (x[0] * x[0] + x[1] * x[1]) + (x[2] * x[2] + x[3] * x[3]); }
                    ss += __shfl_xor(ss, 16); ss += __shfl_xor(ss, 32);
                    const float rinv = 1.0f / sqrtf(ss * (1.f / 64.f) + EPS);
                    f32x4 y[2][2];
#pragma unroll
                    for (int bj = 0; bj < 2; ++bj)
#pragma unroll
                        for (int n = 0; n < 2; ++n) y[bj][n] = acc[ai][bj][m][n] * rinv * wv[bj][n];
                    if (smp) {
#pragma unroll
                        for (int n = 0; n < 2; ++n) { const f32x4 cs = *(const f32x4*)(ropeA + (size_t)t * 64 + dim_a + 4 * n), sn = *(const f32x4*)(ropeA + 1024 * 64 + (size_t)t * 64 + dim_a + 4 * n);
                            const f32x4 a = y[0][n], bb = y[1][n]; y[0][n] = a * cs - bb * sn; y[1][n] = bb * cs + a * sn; } }
                    if (!isk) { bf16_t* qp = (bf16_t*)(ws + WS_Q) + row * 1024 + pn * 256 + wc * 64 + dim_a;
#pragma unroll
                        for (int bj = 0; bj < 2; ++bj) { const f32x4 v0 = y[bj][0] * C2A, v1 = y[bj][1] * C2A;
                            u32x4 o; o.x = cvt_pk_bf16(v0[0], v0[1]); o.y = cvt_pk_bf16(v0[2], v0[3]); o.z = cvt_pk_bf16(v1[0], v1[1]); o.w = cvt_pk_bf16(v1[2], v1[3]);
                            *(u32x4*)(qp + 16 * bj) = o; } }
                    else { const int hh = (pn - 4) * 2 + hl;
                        const size_t koff = (smp ? ((size_t)(b * HA + hh) * LKS + PAST + t) * 128 : ((size_t)(b * HA + hh) * SEQP + t) * 128) + j * 64 + dim_a;
                        bf16_t* kp = (bf16_t*)(ws + (smp ? WS_KSA : WS_KP)) + koff;
#pragma unroll
                        for (int bj = 0; bj < 2; ++bj) { const f32x4 v0 = y[bj][0], v1 = y[bj][1];
                            u32x4 o; o.x = cvt_pk_bf16(v0[0], v0[1]); o.y = cvt_pk_bf16(v0[2], v0[3]); o.z = cvt_pk_bf16(v1[0], v1[1]); o.w = cvt_pk_bf16(v1[2], v1[3]);
                            *(u32x4*)(kp + 16 * bj) = o;
                            if (!smp) { float* fp = nak + koff + 16 * bj; *(f32x4*)fp = v0; *(f32x4*)(fp + 4) = v1; } } }
                }
        } else if (pn < 12) {
#pragma unroll
            for (int ai = 0; ai < 2; ++ai)
#pragma unroll
                for (int m = 0; m < 4; ++m) { const int t = tb + ai * 128 + m * 16;
#pragma unroll
                    for (int bj = 0; bj < 2; ++bj) { const int hh = (pn - 8) * 2 + bj, d = 32 * wc + 8 * fq;
                        const size_t voff = (smp ? ((size_t)(b * HA + hh) * LKS + PAST + t) * 128 : ((size_t)(b * HA + hh) * SEQP + t) * 128) + d;
                        const f32x4 v0 = acc[ai][bj][m][0], v1 = acc[ai][bj][m][1];
                        u32x4 o; o.x = cvt_pk_bf16(v0[0], v0[1]); o.y = cvt_pk_bf16(v0[2], v0[3]); o.z = cvt_pk_bf16(v1[0], v1[1]); o.w = cvt_pk_bf16(v1[2], v1[3]);
                        *(u32x4*)((bf16_t*)(ws + (smp ? WS_VSA : WS_VP)) + voff) = o;
                        if (!smp) { *(f32x4*)(nav + voff) = v0; *(f32x4*)(nav + voff + 4) = v1; } } }
        } else if (pn < 16) {
            bf16_t* up = (bf16_t*)(ws + WS_U) + (pn - 12) * 256 + 32 * wc + 8 * fq;
#pragma unroll
            for (int ai = 0; ai < 2; ++ai)
#pragma unroll
                for (int m = 0; m < 4; ++m) { const size_t row = rowb + ai * 128 + m * 16;
#pragma unroll
                    for (int bj = 0; bj < 2; ++bj) { const f32x4 v0 = acc[ai][bj][m][0], v1 = acc[ai][bj][m][1];
                        u32x4 o; o.x = cvt_pk_bf16(v0[0], v0[1]); o.y = cvt_pk_bf16(v0[2], v0[3]); o.z = cvt_pk_bf16(v1[0], v1[1]); o.w = cvt_pk_bf16(v1[2], v1[3]);
                        *(u32x4*)(up + row * 1024 + bj * HALF) = o; } }
        } else {
            bf16_t* sg = (bf16_t*)(ws + WS_SG) + (pn - 16) * 256 + 32 * wc + 8 * fq;
#pragma unroll
            for (int ai = 0; ai < 2; ++ai)
#pragma unroll
                for (int m = 0; m < 4; ++m) { const size_t row = rowb + ai * 128 + m * 16;
#pragma unroll
                    for (int bj = 0; bj < 2; ++bj) { const f32x4 v0 = acc[ai][bj][m][0], v1 = acc[ai][bj][m][1];
                        u32x4 o; o.x = cvt_pk_bf16(siluf(v0[0]), siluf(v0[1])); o.y = cvt_pk_bf16(siluf(v0[2]), siluf(v0[3])); o.z = cvt_pk_bf16(siluf(v1[0]), siluf(v1[1])); o.w = cvt_pk_bf16(siluf(v1[2]), siluf(v1[3]));
                        *(u32x4*)(sg + row * DM + bj * HALF) = o; } }
        }
    }
};
struct EpiProj1 {
    static constexpr bool PERM = true, AFTER_DRAIN = false;
    unsigned char* ws; const float* qw; const float* kw; float* nck; float* ncv; PG8_LAS float* xs;
    __device__ __forceinline__ void operator()(const f32x4 (&acc)[2][2][4][2], const Unit& u, int wr, int wc, int fr, int fq) const {
        const int pm = u.pm, pn = u.pn;
        const bool smp = pm >= 32; const int b = smp ? (pm - 32) >> 2 : pm, tb = (smp ? ((pm - 32) & 3) * 256 : 0) + wr * 64 + fr;
        const size_t rowb = (size_t)pm * 256 + wr * 64 + fr;
        if (pn < 10) {
            const bool isk = pn >= 8; const int hl = wc >> 1, w1 = wc & 1, head = (isk ? (pn - 8) : pn) * 2 + hl;
            const float* w = isk ? kw : qw;
            f32x4 wv[2][2];
#pragma unroll
            for (int bj = 0; bj < 2; ++bj)
#pragma unroll
                for (int n = 0; n < 2; ++n) wv[bj][n] = *(const f32x4*)(w + (2 * w1 + bj) * 32 + 8 * fq + 4 * n);
            PG8_LAS float* xo = xs + (wr * 4 + wc) * 128; PG8_LAS float* xp = xs + (wr * 4 + (wc ^ 1)) * 128;
#pragma unroll
            for (int ai = 0; ai < 2; ++ai)
#pragma unroll
                for (int m = 0; m < 4; ++m) { float ss = 0.f;
#pragma unroll
                    for (int bj = 0; bj < 2; ++bj)
#pragma unroll
                        for (int n = 0; n < 2; ++n) { const f32x4 x = acc[ai][bj][m][n]; ss += (x[0] * x[0] + x[1] * x[1]) + (x[2] * x[2] + x[3] * x[3]); }
                    ss += __shfl_xor(ss, 16); ss += __shfl_xor(ss, 32);
                    if (fq == 0) xo[ai * 64 + m * 16 + fr] = ss; }
            asm volatile("s_waitcnt lgkmcnt(0)" ::: "memory"); __builtin_amdgcn_s_barrier(); asm volatile("" ::: "memory");
            const float* ropeC = (const float*)(ws + WS_ROPE) + 2 * 1024 * 64;
#pragma unroll
            for (int ai = 0; ai < 2; ++ai)
#pragma unroll
                for (int m = 0; m < 4; ++m) { const int idx = ai * 64 + m * 16 + fr, t = tb + ai * 128 + m * 16; const size_t row = rowb + ai * 128 + m * 16;
                    const float rinv = 1.0f / sqrtf((xo[idx] + xp[idx]) * (1.f / 128.f) + EPS);
                    f32x4 y[2][2];
#pragma unroll
                    for (int bj = 0; bj < 2; ++bj)
#pragma unroll
                        for (int n = 0; n < 2; ++n) y[bj][n] = acc[ai][bj][m][n] * rinv * wv[bj][n];
                    if (smp) {
#pragma unroll
                        for (int n = 0; n < 2; ++n) { const f32x4 cs = *(const f32x4*)(ropeC + (size_t)t * 128 + 64 * w1 + 8 * fq + 4 * n), sn = *(const f32x4*)(ropeC + 1024 * 128 + (size_t)t * 128 + 64 * w1 + 8 * fq + 4 * n);
                            const f32x4 a = y[0][n], bb = y[1][n]; y[0][n] = a * cs - bb * sn; y[1][n] = bb * cs + a * sn; } }
                    if (!isk) { bf16_t* qp = (bf16_t*)(ws + WS_Q) + row * DM + head * 128 + 8 * fq;
#pragma unroll
                        for (int bj = 0; bj < 2; ++bj) { const f32x4 v0 = y[bj][0] * C2C, v1 = y[bj][1] * C2C;
                            u32x4 o; o.x = cvt_pk_bf16(v0[0], v0[1]); o.y = cvt_pk_bf16(v0[2], v0[3]); o.z = cvt_pk_bf16(v1[0], v1[1]); o.w = cvt_pk_bf16(v1[2], v1[3]);
                            *(u32x4*)(qp + (2 * w1 + bj) * 32) = o; } }
                    else { const size_t koff = smp ? ((size_t)(b * KVH + head) * LKS + PAST + t) * 128 : ((size_t)(b * KVH + head) * SEQP + t) * 128;
                        bf16_t* kp = (bf16_t*)(ws + (smp ? WS_KSC : WS_KP)) + koff + 8 * fq;
#pragma unroll
                        for (int bj = 0; bj < 2; ++bj) { const f32x4 v0 = y[bj][0], v1 = y[bj][1];
                            u32x4 o; o.x = cvt_pk_bf16(v0[0], v0[1]); o.y = cvt_pk_bf16(v0[2], v0[3]); o.z = cvt_pk_bf16(v1[0], v1[1]); o.w = cvt_pk_bf16(v1[2], v1[3]);
                            *(u32x4*)(kp + (2 * w1 + bj) * 32) = o;
                            if (!smp) { float* fp = nck + koff + 8 * fq + (2 * w1 + bj) * 32; *(f32x4*)fp = v0; *(f32x4*)(fp + 4) = v1; } } }
                }
        } else if (pn < 12) {
#pragma unroll
            for (int ai = 0; ai < 2; ++ai)
#pragma unroll
                for (int m = 0; m < 4; ++m) { const int t = tb + ai * 128 + m * 16;
#pragma unroll
                    for (int bj = 0; bj < 2; ++bj) { const int kvh = (pn - 10) * 2 + bj, d = 32 * wc + 8 * fq;
                        const size_t voff = (smp ? ((size_t)(b * KVH + kvh) * LKS + PAST + t) * 128 : ((size_t)(b * KVH + kvh) * SEQP + t) * 128) + d;
                        const f32x4 v0 = acc[ai][bj][m][0], v1 = acc[ai][bj][m][1];
                        u32x4 o; o.x = cvt_pk_bf16(v0[0], v0[1]); o.y = cvt_pk_bf16(v0[2], v0[3]); o.z = cvt_pk_bf16(v1[0], v1[1]); o.w = cvt_pk_bf16(v1[2], v1[3]);
                        *(u32x4*)((bf16_t*)(ws + (smp ? WS_VSC : WS_VP)) + voff) = o;
                        if (!smp) { *(f32x4*)(ncv + voff) = v0; *(f32x4*)(ncv + voff + 4) = v1; } } }
        } else {
            bf16_t* sg = (bf16_t*)(ws + WS_SG) + (pn - 12) * 256 + 32 * wc + 8 * fq;
#pragma unroll
            for (int ai = 0; ai < 2; ++ai)
#pragma unroll
                for (int m = 0; m < 4; ++m) { const size_t row = rowb + ai * 128 + m * 16;
#pragma unroll
                    for (int bj = 0; bj < 2; ++bj) { const f32x4 v0 = acc[ai][bj][m][0], v1 = acc[ai][bj][m][1];
                        u32x4 o; o.x = cvt_pk_bf16(siluf(v0[0]), siluf(v0[1])); o.y = cvt_pk_bf16(siluf(v0[2]), siluf(v0[3])); o.z = cvt_pk_bf16(siluf(v1[0]), siluf(v1[1])); o.w = cvt_pk_bf16(siluf(v1[2]), siluf(v1[3]));
                        *(u32x4*)(sg + row * DM + bj * HALF) = o; } }
        }
    }
};
struct EpiResidF {
    static constexpr bool PERM = false, AFTER_DRAIN = false;
    const float* xp; const float* xs; const float* base; const float* gate; float* out;
    __device__ __forceinline__ void operator()(const f32x4 (&acc)[2][2][4][2], const Unit& u, int wr, int wc, int fr, int fq) const {
        const int row0 = u.pm * BM + wr * 64 + fr, col0 = u.pn * BM + wc * 32 + 4 * fq;
        const int cr = u.pm < 32 ? 0 : 1 + ((u.pm - 32) >> 2);
        f32x4 gv[2][2];
#pragma unroll
        for (int bj = 0; bj < 2; ++bj)
#pragma unroll
            for (int n = 0; n < 2; ++n) gv[bj][n] = *(const f32x4*)(gate + (size_t)cr * 6144 + col0 + bj * HALF + n * 16);
#pragma unroll
        for (int ai = 0; ai < 2; ++ai)
#pragma unroll
            for (int m = 0; m < 4; ++m) { const int r = row0 + ai * HALF + m * 16;
                const float* bp = (base ? base + (size_t)r * DM : (r < MP ? xp + (size_t)r * DM : xs + (size_t)(r - MP) * DM)) + col0; float* op = out + (size_t)r * DM + col0;
#pragma unroll
                for (int bj = 0; bj < 2; ++bj)
#pragma unroll
                    for (int n = 0; n < 2; ++n) { const f32x4 b = *(const f32x4*)(bp + bj * HALF + n * 16); *(f32x4*)(op + bj * HALF + n * 16) = b + gv[bj][n] * acc[ai][bj][m][n]; }
                if (m & 1) asm volatile("" ::: "memory"); }
    }
};

template <class Epi, class Sched, bool ALIGN_EPI = false, bool SP2 = false>
__device__ __forceinline__ void gemm_phase(PG8_LAS unsigned char* lds, const Gemm g, const Sched& S, const Epi& E, const int tid) {
    const int wid = __builtin_amdgcn_readfirstlane(tid >> 6), lane = tid & 63, wr = wid >> 2, wc = wid & 3, fr = lane & 15, fq = lane >> 4;
    const int K = g.K, nt = K / BK;
    unsigned voffA[2], voffB[2];
#pragma unroll
    for (int i = 0; i < 2; ++i) { int R, C; stage_rc(tid * 16 + i * 8192, R, C); const int Rb = Epi::PERM ? ((R & ~31) + perm32(R & 31)) : R;
        voffA[i] = (unsigned)(R * g.lda + C) * 2u; voffB[i] = (unsigned)(Rb * g.ldb + C) * 2u; }
    const size_t kstep = (size_t)(BK * 2);
    const size_t hstepA = (size_t)HALF * g.lda * 2, hstepB = (size_t)HALF * g.ldb * 2;
    const size_t tstepA = 2 * hstepA, tstepB = 2 * hstepB;
    const unsigned ldsw = (unsigned)wid * 1024u;
    const int aoff = lds_byte(wr * 64 + fr, fq * 8), boff = lds_byte(wc * 32 + fr, fq * 8);
#define PG8_SA(b, h) (((b) * 2 + (h)) * HTB)
#define PG8_SB(b, h) ((4 + (b) * 2 + (h)) * HTB)
#define PG8_STAGE(bufoff, gbase, voff) do { _Pragma("unroll") for (int _i = 0; _i < 2; ++_i) \
        __builtin_amdgcn_global_load_lds((const unsigned*)((const char*)(gbase) + (voff)[_i]), (PG8_LAS unsigned*)(lds + (bufoff) + ldsw + _i * 8192), 16, 0, 0); } while (0)
#define PG8_LDA(dst, b, h) do { _Pragma("unroll") for (int m = 0; m < 4; ++m) _Pragma("unroll") for (int k = 0; k < 2; ++k) dst[m][k] = *(const PG8_LAS bf16x8*)(lds + PG8_SA(b, h) + aoff + m * 2048 + k * 1024); } while (0)
#define PG8_LDB(dst, b, h) do { _Pragma("unroll") for (int n = 0; n < 2; ++n) _Pragma("unroll") for (int k = 0; k < 2; ++k) dst[n][k] = *(const PG8_LAS bf16x8*)(lds + PG8_SB(b, h) + boff + n * 2048 + k * 1024); } while (0)
#define PG8_MMA(ai, bj, At, Bt) do { __builtin_amdgcn_s_setprio(1); _Pragma("unroll") for (int m = 0; m < 4; ++m) _Pragma("unroll") for (int n = 0; n < 2; ++n) _Pragma("unroll") for (int k = 0; k < 2; ++k) \
        acc[ai][bj][m][n] = __builtin_amdgcn_mfma_f32_16x16x32_bf16(Bt[n][k], At[m][k], acc[ai][bj][m][n], 0, 0, 0); __builtin_amdgcn_s_setprio(0); } while (0)
#define PG8_WAIT_V(n) asm volatile("s_waitcnt vmcnt(" #n ")" ::: "memory")
#define PG8_WAIT_L(n) asm volatile("s_waitcnt lgkmcnt(" #n ")" ::: "memory")
#define PG8_BAR __builtin_amdgcn_s_barrier()
#define PG8_SCHED __builtin_amdgcn_sched_barrier(0)
    Unit cur, nxt; int ui = 0;
    if (!S.next(0, cur)) return;
    f32x4 acc[2][2][4][2];
#pragma unroll
    for (int a = 0; a < 2; ++a)
#pragma unroll
        for (int b = 0; b < 2; ++b)
#pragma unroll
            for (int m = 0; m < 4; ++m)
#pragma unroll
                for (int n = 0; n < 2; ++n) acc[a][b][m][n] = (f32x4){0.f, 0.f, 0.f, 0.f};
    bf16x8 At[4][2], B0[2][2], B1[2][2];
    const char* cA = (const char*)g.A + (size_t)cur.pm * tstepA + (size_t)cur.pn * g.a_pn_off * 2; const char* cB = (const char*)g.Bt + (size_t)cur.pn * tstepB;
    S.a_ready(cur);
    if constexpr (SP2) {
        PG8_STAGE(PG8_SB(0, 0), cB, voffB); PG8_STAGE(PG8_SB(0, 1), cB + hstepB, voffB); PG8_STAGE(PG8_SA(0, 0), cA, voffA); PG8_STAGE(PG8_SA(0, 1), cA + hstepA, voffA);
        if (wr == 1) PG8_BAR;
        PG8_WAIT_V(2); PG8_BAR;
        PG8_STAGE(PG8_SB(1, 0), cB + kstep, voffB); PG8_STAGE(PG8_SA(1, 0), cA + kstep, voffA); PG8_STAGE(PG8_SB(1, 1), cB + hstepB + kstep, voffB);
        PG8_WAIT_V(6); PG8_BAR;
    } else {
        PG8_STAGE(PG8_SB(0, 0), cB, voffB); PG8_STAGE(PG8_SA(0, 0), cA, voffA); PG8_STAGE(PG8_SB(0, 1), cB + hstepB, voffB); PG8_STAGE(PG8_SA(0, 1), cA + hstepA, voffA);
        if (wr == 1) PG8_BAR;
        PG8_WAIT_V(4); PG8_BAR;
        PG8_STAGE(PG8_SB(1, 0), cB + kstep, voffB); PG8_STAGE(PG8_SA(1, 0), cA + kstep, voffA); PG8_STAGE(PG8_SB(1, 1), cB + hstepB + kstep, voffB);
        PG8_WAIT_V(6); PG8_BAR;
    }
    for (;;) {
        const bool has_next = S.next(ui + 1, nxt);
        const char* nA = has_next ? (const char*)g.A + (size_t)nxt.pm * tstepA + (size_t)nxt.pn * g.a_pn_off * 2 : cA; const char* nB = has_next ? (const char*)g.Bt + (size_t)nxt.pn * tstepB : cB;
        for (int t = 0; t < nt; t += 2) {
            const bool last = (t == nt - 2);
            const char* a1 = cA + (size_t)(t + 1) * kstep;
            const char* a2 = last ? nA : cA + (size_t)(t + 2) * kstep; const char* b2 = last ? nB : cB + (size_t)(t + 2) * kstep;
            const char* a3 = a2 + kstep; const char* b3 = b2 + kstep;
            if (last && has_next) S.a_ready(nxt);
            if constexpr (SP2) {
            PG8_LDB(B0, 0, 0); PG8_LDB(B1, 0, 1); PG8_SCHED; PG8_LDA(At, 0, 0); PG8_STAGE(PG8_SA(1, 1), a1 + hstepA, voffA);
            PG8_WAIT_V(8); PG8_WAIT_L(0); PG8_BAR; PG8_MMA(0, 0, At, B0); PG8_MMA(0, 1, At, B1); PG8_BAR; PG8_SCHED;
            PG8_LDA(At, 0, 1); PG8_STAGE(PG8_SB(0, 0), b2, voffB); PG8_STAGE(PG8_SB(0, 1), b2 + hstepB, voffB); PG8_STAGE(PG8_SA(0, 0), a2, voffA);
            PG8_WAIT_V(8); PG8_WAIT_L(0); PG8_BAR; PG8_MMA(1, 0, At, B0); PG8_MMA(1, 1, At, B1); PG8_BAR; PG8_SCHED;
            PG8_LDB(B0, 1, 0); PG8_LDB(B1, 1, 1); PG8_SCHED; PG8_LDA(At, 1, 0); PG8_STAGE(PG8_SA(0, 1), a2 + hstepA, voffA);
            PG8_WAIT_V(8); PG8_WAIT_L(0); PG8_BAR; PG8_MMA(0, 0, At, B0); PG8_MMA(0, 1, At, B1); PG8_BAR; PG8_SCHED;
            PG8_LDA(At, 1, 1); PG8_STAGE(PG8_SB(1, 0), b3, voffB); PG8_STAGE(PG8_SB(1, 1), b3 + hstepB, voffB); PG8_STAGE(PG8_SA(1, 0), a3, voffA);
            PG8_WAIT_V(8); PG8_WAIT_L(0); PG8_BAR; PG8_MMA(1, 0, At, B0); PG8_MMA(1, 1, At, B1); PG8_BAR; PG8_SCHED;
            } else {
            PG8_LDB(B0, 0, 0); PG8_SCHED; PG8_LDA(At, 0, 0); PG8_STAGE(PG8_SA(1, 1), a1 + hstepA, voffA);
            PG8_WAIT_L(8); PG8_BAR; PG8_WAIT_L(0); PG8_MMA(0, 0, At, B0); PG8_BAR; PG8_SCHED;
            PG8_LDB(B1, 0, 1); PG8_STAGE(PG8_SB(0, 0), b2, voffB);
            PG8_BAR; PG8_WAIT_L(0); PG8_MMA(0, 1, At, B1); PG8_BAR;
            PG8_LDA(At, 0, 1); PG8_STAGE(PG8_SA(0, 0), a2, voffA);
            PG8_BAR; PG8_WAIT_L(0); PG8_MMA(1, 0, At, B0); PG8_BAR; PG8_SCHED;
            PG8_STAGE(PG8_SB(0, 1), b2 + hstepB, voffB);
            PG8_WAIT_V(6); PG8_BAR; PG8_MMA(1, 1, At, B1); PG8_BAR;
            PG8_LDB(B0, 1, 0); PG8_SCHED; PG8_LDA(At, 1, 0); PG8_STAGE(PG8_SA(0, 1), a2 + hstepA, voffA);
            PG8_WAIT_L(8); PG8_BAR; PG8_WAIT_L(0); PG8_MMA(0, 0, At, B0); PG8_BAR; PG8_SCHED;
            PG8_LDB(B1, 1, 1); PG8_STAGE(PG8_SB(1, 0), b3, voffB);
            PG8_BAR; PG8_WAIT_L(0); PG8_MMA(0, 1, At, B1); PG8_BAR;
            PG8_LDA(At, 1, 1); PG8_STAGE(PG8_SA(1, 0), a3, voffA);
            PG8_BAR; PG8_WAIT_L(0); PG8_MMA(1, 0, At, B0); PG8_BAR; PG8_SCHED;
            PG8_STAGE(PG8_SB(1, 1), b3 + hstepB, voffB);
            PG8_WAIT_V(6); PG8_BAR; PG8_MMA(1, 1, At, B1); PG8_BAR;
            }
        }
        if constexpr (ALIGN_EPI) { if (wr == 0) PG8_BAR; }
        if constexpr (!Epi::AFTER_DRAIN) { E(acc, cur, wr, wc, fr, fq); S.done(cur); }
        if (!has_next) break;
#pragma unroll
        for (int a = 0; a < 2; ++a)
#pragma unroll
            for (int b = 0; b < 2; ++b)
#pragma unroll
                for (int m = 0; m < 4; ++m)
#pragma unroll
                    for (int n = 0; n < 2; ++n) acc[a][b][m][n] = (f32x4){0.f, 0.f, 0.f, 0.f};
        cur = nxt; cA = nA; cB = nB; ++ui;
        if constexpr (ALIGN_EPI) { if (wr == 1) PG8_BAR; }
    }
    PG8_WAIT_V(0);
    if constexpr (!ALIGN_EPI) { if (wr == 0) PG8_BAR; }
    PG8_BAR;
#undef PG8_SA
#undef PG8_SB
#undef PG8_STAGE
#undef PG8_LDA
#undef PG8_LDB
#undef PG8_MMA
#undef PG8_WAIT_V
#undef PG8_WAIT_L
#undef PG8_BAR
#undef PG8_SCHED
}
}

namespace att {
#define GATE(x) (SILU ? siluf(x) : (x))
using bf16x8 = __attribute__((ext_vector_type(8))) short;
using s16x4  = __attribute__((ext_vector_type(4))) short;
using f32x16 = __attribute__((ext_vector_type(16))) float;
constexpr int QBLK = 32, KVBLK = 64, LDK = 128;
constexpr int SHM_V = KVBLK * 128 * 2, SHM_K = KVBLK * 128 * 2;
constexpr int WS_OFF = 2 * SHM_V + 2 * SHM_K;
constexpr int STG_OFF = 72 * 1024;
constexpr float THRL = 8.f * LOG2E;
#define KSWZ(row, colB) ((row) * 256 + ((colB) ^ (((row) & 7) << 4)))
#define SBAR() __builtin_amdgcn_sched_barrier(0)
__device__ __forceinline__ int crow(int r, int hi) { return (r & 3) + 8 * (r >> 2) + 4 * hi; }
__device__ __forceinline__ unsigned cvtpk(float lo, float hi) { unsigned r; asm volatile("v_cvt_pk_bf16_f32 %0, %1, %2" : "=v"(r) : "v"(lo), "v"(hi)); return r; }
__device__ __forceinline__ void partialSM(f32x16& p0, f32x16& p1, float& m_reg, float& mn, float& alpha) {
  float pmax = p0[0]; for (int r = 1; r < 16; ++r) pmax = fmaxf(pmax, p0[r]); for (int r = 0; r < 16; ++r) pmax = fmaxf(pmax, p1[r]);
  { auto rr = __builtin_amdgcn_permlane32_swap(__float_as_uint(pmax), __float_as_uint(pmax), false, false);
    pmax = fmaxf(__uint_as_float(rr[0]), __uint_as_float(rr[1])); }
  if (__builtin_expect(__all(pmax - m_reg <= THRL), 1)) { mn = m_reg; alpha = 1.f; }
  else { mn = fmaxf(m_reg, pmax); alpha = __builtin_amdgcn_exp2f(m_reg - mn); m_reg = mn; }
  for (int r = 0; r < 16; ++r) p0[r] = p0[r] - mn; for (int r = 0; r < 16; ++r) p1[r] = p1[r] - mn;
  for (int r = 0; r < 16; ++r) p0[r] = __builtin_amdgcn_exp2f(p0[r]);
}
__device__ __forceinline__ void finishSM(f32x16& p0, f32x16& p1, float alpha, float& l_reg, bf16x8& pa0, bf16x8& pa1, bf16x8& pa2, bf16x8& pa3) {
  for (int r = 0; r < 16; ++r) p1[r] = __builtin_amdgcn_exp2f(p1[r]);
  float ps = 0; for (int r = 0; r < 16; ++r) ps += p0[r]; for (int r = 0; r < 16; ++r) ps += p1[r];
  { auto rr = __builtin_amdgcn_permlane32_swap(__float_as_uint(ps), __float_as_uint(ps), false, false);
    ps = __uint_as_float(rr[0]) + __uint_as_float(rr[1]); }
  l_reg = l_reg * alpha + ps;
#define PK4(P, BASE, OUT) do { unsigned a0 = cvtpk(P[BASE + 0], P[BASE + 1]), a1 = cvtpk(P[BASE + 2], P[BASE + 3]);   \
    unsigned b0 = cvtpk(P[BASE + 4], P[BASE + 5]), b1 = cvtpk(P[BASE + 6], P[BASE + 7]);                              \
    auto r0 = __builtin_amdgcn_permlane32_swap(a0, b0, false, false); auto r1 = __builtin_amdgcn_permlane32_swap(a1, b1, false, false); \
    u32x4 w = {r0[0], r1[0], r0[1], r1[1]}; OUT = *reinterpret_cast<bf16x8*>(&w); } while (0)
  PK4(p0, 0, pa0); PK4(p0, 8, pa1); PK4(p1, 0, pa2); PK4(p1, 8, pa3);
#undef PK4
}
template <int ND0> __device__ __forceinline__ void qkt(f32x16& p0, f32x16& p1, const char* Ks, const bf16x8* qr, int r32, int hi, int kcol0) {
  p0 = f32x16{}; p1 = f32x16{};
#pragma unroll
  for (int d0 = 0; d0 < ND0; ++d0) { int cb = (kcol0 + d0 * 16 + hi * 8) * 2;
    bf16x8 b0 = *reinterpret_cast<const bf16x8*>(Ks + KSWZ(r32, cb));
    bf16x8 b1 = *reinterpret_cast<const bf16x8*>(Ks + KSWZ(32 + r32, cb));
    p0 = __builtin_amdgcn_mfma_f32_32x32x16_bf16(b0, qr[d0], p0, 0, 0, 0);
    p1 = __builtin_amdgcn_mfma_f32_32x32x16_bf16(b1, qr[d0], p1, 0, 0, 0); }
}
__device__ __forceinline__ int v_st(int k, int c) { const int kk = (k & ~0xC) | ((k & 4) << 1) | ((k & 8) >> 1); return ((kk >> 3) * 4 + (c >> 5)) * 512 + ((kk & 7) * 32 + (c & 31)) * 2; }
__device__ __forceinline__ int v_rd_base(int lane) { return ((lane & 3) << 3) | (((lane >> 2) & 3) << 6) | (((lane >> 4) & 1) << 5) | (((lane >> 5) & 1) << 8); }
constexpr int v_rd_off(int d0, int ks, int half) { return d0 * 512 + ks * 4096 + half * 2048; }
template <int OFF> __device__ __forceinline__ s16x4 tr_read(int vb) {
  s16x4 r; asm volatile("ds_read_b64_tr_b16 %0, %1 offset:%2" : "=&v"(r) : "v"(vb), "i"(OFF) : "memory"); return r;
}
template <int D0> __device__ __forceinline__ void pv_one(f32x16& od, int vb, bf16x8 pa0, bf16x8 pa1, bf16x8 pa2, bf16x8 pa3) {
  const s16x4 l0 = tr_read<v_rd_off(D0, 0, 0)>(vb), h0 = tr_read<v_rd_off(D0, 0, 1)>(vb), l1 = tr_read<v_rd_off(D0, 1, 0)>(vb), h1 = tr_read<v_rd_off(D0, 1, 1)>(vb);
  const s16x4 l2 = tr_read<v_rd_off(D0, 2, 0)>(vb), h2 = tr_read<v_rd_off(D0, 2, 1)>(vb), l3 = tr_read<v_rd_off(D0, 3, 0)>(vb), h3 = tr_read<v_rd_off(D0, 3, 1)>(vb);
  asm volatile("s_waitcnt lgkmcnt(0)" ::: "memory"); SBAR();
#define PK(L, H) (bf16x8){L[0], L[1], L[2], L[3], H[0], H[1], H[2], H[3]}
  od = __builtin_amdgcn_mfma_f32_32x32x16_bf16(pa0, PK(l0, h0), od, 0, 0, 0);
  od = __builtin_amdgcn_mfma_f32_32x32x16_bf16(pa1, PK(l1, h1), od, 0, 0, 0);
  od = __builtin_amdgcn_mfma_f32_32x32x16_bf16(pa2, PK(l2, h2), od, 0, 0, 0);
  od = __builtin_amdgcn_mfma_f32_32x32x16_bf16(pa3, PK(l3, h3), od, 0, 0, 0);
#undef PK
}
__device__ __forceinline__ void pv_d0(f32x16* o, int vb, bf16x8 pa0, bf16x8 pa1, bf16x8 pa2, bf16x8 pa3) {
  pv_one<0>(o[0], vb, pa0, pa1, pa2, pa3); pv_one<1>(o[1], vb, pa0, pa1, pa2, pa3); pv_one<2>(o[2], vb, pa0, pa1, pa2, pa3); pv_one<3>(o[3], vb, pa0, pa1, pa2, pa3);
}
template <int ND0>
__device__ __forceinline__ void attn_core(const bf16_t* Qw, const bf16_t* __restrict__ Kh, const bf16_t* __restrict__ Vh, int seq, int kcol0, char* lds, f32x16 (&o)[4], float& l_reg, const int wid, const int lane) {
  const int tid = wid * 64 + lane, r32 = lane & 31, hi = lane >> 5;
  char* V_lds = lds; char* K_lds = lds + 2 * SHM_V;
  float* ws = (float*)(lds + WS_OFF) + wid * 64; float* al_l = ws + 32;
  float m_reg = -1e30f; l_reg = 0; bf16x8 qr[ND0];
#pragma unroll
  for (int d = 0; d < 4; ++d) o[d] = f32x16{};
#pragma unroll
  for (int d0 = 0; d0 < ND0; ++d0) qr[d0] = *reinterpret_cast<const bf16x8*>(Qw + d0 * 16);
  const int sr = tid >> 4, sc = (tid & 15) * 8, vst0 = v_st(sr, sc), vst1 = v_st(32 + sr, sc);
  const int vb0 = (int)(uintptr_t)V_lds + v_rd_base(lane);
  struct { bf16x8 vs0, vs1, ks0, ks1; } sr_[1];
#define SLOAD(i, k0) do { sr_[i].vs0 = *reinterpret_cast<const bf16x8*>(&Vh[(long)((k0) + sr) * LDK + sc]); sr_[i].vs1 = *reinterpret_cast<const bf16x8*>(&Vh[(long)((k0) + 32 + sr) * LDK + sc]); \
    sr_[i].ks0 = *reinterpret_cast<const bf16x8*>(&Kh[(long)((k0) + sr) * LDK + sc]); sr_[i].ks1 = *reinterpret_cast<const bf16x8*>(&Kh[(long)((k0) + 32 + sr) * LDK + sc]); } while (0)
#define SWRITE(b, i) do { *(bf16x8*)(V_lds + (b) * SHM_V + vst0) = sr_[i].vs0;          \
    *(bf16x8*)(V_lds + (b) * SHM_V + vst1) = sr_[i].vs1; int kc = sc * 2;               \
    *(bf16x8*)(K_lds + (b) * SHM_K + KSWZ(sr, kc)) = sr_[i].ks0;                       \
    *(bf16x8*)(K_lds + (b) * SHM_K + KSWZ(32 + sr, kc)) = sr_[i].ks1; } while (0)
#define SWAIT() asm volatile("s_waitcnt vmcnt(0)" ::: "memory")
#define RESC(a) do { if (__any((a) < 1.f)) { if (hi == 0) al_l[r32] = (a); asm volatile("s_waitcnt lgkmcnt(0)" ::: "memory"); \
    for (int d = 0; d < 4; ++d) for (int r = 0; r < 16; ++r) o[d][r] *= al_l[crow(r, hi)]; } } while (0)
  f32x16 pA0, pA1, pB0, pB1; float mnA, mnB, alA, alB; bf16x8 pa0, pa1, pa2, pa3; const int NT = seq / KVBLK;
  SLOAD(0, 0); asm volatile("s_waitcnt vmcnt(0)" ::: "memory"); SWRITE(0, 0); __syncthreads();
  qkt<ND0>(pA0, pA1, K_lds, qr, r32, hi, kcol0); partialSM(pA0, pA1, m_reg, mnA, alA);
  SLOAD(0, KVBLK);
  SWAIT(); SWRITE(1, 0); __syncthreads();
  for (int j = 1; j + 1 < NT; j += 2) {
    SBAR(); qkt<ND0>(pB0, pB1, K_lds + SHM_K, qr, r32, hi, kcol0);
    finishSM(pA0, pA1, alA, l_reg, pa0, pa1, pa2, pa3); SBAR();
    SLOAD(0, (j + 1) * KVBLK); SBAR();
    pv_d0(o, vb0, pa0, pa1, pa2, pa3); partialSM(pB0, pB1, m_reg, mnB, alB);
    __syncthreads(); SWAIT(); SWRITE(0, 0);
    RESC(alB); __syncthreads();
    SBAR(); qkt<ND0>(pA0, pA1, K_lds, qr, r32, hi, kcol0);
    finishSM(pB0, pB1, alB, l_reg, pa0, pa1, pa2, pa3); SBAR();
    SLOAD(0, (j + 2) * KVBLK); SBAR();
    pv_d0(o, vb0 + SHM_V, pa0, pa1, pa2, pa3); partialSM(pA0, pA1, m_reg, mnA, alA);
    __syncthreads(); SWAIT(); SWRITE(1, 0);
    RESC(alA); __syncthreads();
  }
  SBAR(); qkt<ND0>(pB0, pB1, K_lds + SHM_K, qr, r32, hi, kcol0);
  finishSM(pA0, pA1, alA, l_reg, pa0, pa1, pa2, pa3); SBAR();
  pv_d0(o, vb0, pa0, pa1, pa2, pa3); partialSM(pB0, pB1, m_reg, mnB, alB);
  __syncthreads(); RESC(alB);
  finishSM(pB0, pB1, alB, l_reg, pa0, pa1, pa2, pa3); SBAR();
  pv_d0(o, vb0 + SHM_V, pa0, pa1, pa2, pa3);
#undef SLOAD
#undef SWRITE
#undef SWAIT
#undef RESC
}
__device__ __forceinline__ void row_inv_l(float l_reg, char* lds, int wid, int r32, int hi, float (&rli)[16]) {
  float* li_l = (float*)(lds + WS_OFF) + wid * 64;
  if (hi == 0) li_l[r32] = l_reg; asm volatile("s_waitcnt lgkmcnt(0)" ::: "memory");
#pragma unroll
  for (int r = 0; r < 16; ++r) rli[r] = __builtin_amdgcn_rcpf(li_l[crow(r, hi)]);
}
template <bool SILU> __device__ __forceinline__ void store_rows_gated(const f32x16 (&v)[4], char* stg, bf16_t* Yrow0  , const bf16_t* Grow0, int gpitch, int lane, int r32, int hi) {
  bf16_t* st = (bf16_t*)stg;
#pragma unroll
  for (int r = 0; r < 16; ++r) { const int orow = crow(r, hi);
#pragma unroll
    for (int d0 = 0; d0 < 4; ++d0) st[orow * 128 + d0 * 32 + r32] = (bf16_t)f2bf(v[d0][r]); }
  asm volatile("s_waitcnt lgkmcnt(0)" ::: "memory");
  const bf16_t* gp = Grow0 + (size_t)(lane >> 4) * gpitch + (lane & 15) * 8; bf16_t* yp = Yrow0 + (size_t)(lane >> 4) * DM + (lane & 15) * 8; const bf16_t* sp = st + (lane >> 4) * 128 + (lane & 15) * 8;
  u32x4 g[8];
#pragma unroll
  for (int i = 0; i < 8; ++i) { g[i] = *(const u32x4*)gp; gp += 4 * (size_t)gpitch; asm volatile("" : "+v"(gp)); }
#pragma unroll
  for (int i = 0; i < 8; ++i) {
    const u32x4 x = *(const u32x4*)(sp + i * 4 * 128);
    u32x4 w; w.x = pk2(bflo(x.x) * GATE(bflo(g[i].x)), bfhi(x.x) * GATE(bfhi(g[i].x))); w.y = pk2(bflo(x.y) * GATE(bflo(g[i].y)), bfhi(x.y) * GATE(bfhi(g[i].y)));
    w.z = pk2(bflo(x.z) * GATE(bflo(g[i].z)), bfhi(x.z) * GATE(bfhi(g[i].z))); w.w = pk2(bflo(x.w) * GATE(bflo(g[i].w)), bfhi(x.w) * GATE(bfhi(g[i].w)));
    *(u32x4*)yp = w; yp += 4 * DM; asm volatile("" : "+v"(yp)); }
  asm volatile("s_waitcnt lgkmcnt(0)" ::: "memory");
}
__device__ __forceinline__ void gqa_unit(const Params& p, char* lds, int m0, int hq, const bf16_t* Kh, const bf16_t* Vh, int seq, const int wid) {
  const int lane = fresh_lane(), r32 = lane & 31, hi = lane >> 5;
  const bf16_t* QC = (const bf16_t*)(p.ws + WS_Q); const bf16_t* PR = (const bf16_t*)(p.ws + WS_PR); bf16_t* Y = (bf16_t*)(p.ws + WS_HY);
  f32x16 o[4]; float l_reg;
  attn_core<8>(QC + (size_t)(m0 + wid * QBLK + r32) * DM + hq * 128 + hi * 8, Kh, Vh, seq, 0, lds, o, l_reg, wid, lane);
  float rli[16]; row_inv_l(l_reg, lds, wid, r32, hi, rli);
#pragma unroll
  for (int d0 = 0; d0 < 4; ++d0)
#pragma unroll
    for (int r = 0; r < 16; ++r) o[d0][r] *= rli[r];
  __syncthreads();
  const size_t row0 = (size_t)(m0 + wid * QBLK);
  store_rows_gated<false>(o, lds + wid * 8192, Y + row0 * DM + hq * 128, (const bf16_t*)(p.ws + WS_SG) + row0 * DM + hq * 128, DM, lane, r32, hi);
  __syncthreads();
}
constexpr int RES_WS = 131072 + 1024, RES_EX = 131072 + 4096;
__device__ __forceinline__ void load_kv_resident(const bf16_t* __restrict__ Kh, const bf16_t* __restrict__ Vh, char* lds, int tid) {
  bf16x8 kr[8], vr[8];
#pragma unroll
  for (int i = 0; i < 8; ++i) { const int c = tid + 512 * i; kr[i] = *reinterpret_cast<const bf16x8*>(Kh + (size_t)c * 8); vr[i] = *reinterpret_cast<const bf16x8*>(Vh + (size_t)c * 8); }
#pragma unroll
  for (int i = 0; i < 8; ++i) { const int c = tid + 512 * i, key = c >> 4, col = (c & 15) * 8, t = key >> 6, k = key & 63;
    *(bf16x8*)(lds + 65536 + t * 16384 + v_st(k, col)) = vr[i];
    *(bf16x8*)(lds + t * 16384 + KSWZ(k, col * 2)) = kr[i]; }
}
template <int ND0>
__device__ __forceinline__ void attn_core_res(const bf16_t* Qw, int kcol0, char* lds, f32x16 (&o)[4], float& l_reg, const int wid, const int lane) {
  const int r32 = lane & 31, hi = lane >> 5;
  const char* K_lds = lds; float* al_l = (float*)(lds + RES_WS) + wid * 64 + 32;
  float m_reg = -1e30f; l_reg = 0; bf16x8 qr[ND0];
#pragma unroll
  for (int d = 0; d < 4; ++d) o[d] = f32x16{};
#pragma unroll
  for (int d0 = 0; d0 < ND0; ++d0) qr[d0] = *reinterpret_cast<const bf16x8*>(Qw + d0 * 16);
  const int vb0 = (int)(uintptr_t)(lds + 65536) + v_rd_base(lane);
#define RESC(a) do { if (__any((a) < 1.f)) { if (hi == 0) al_l[r32] = (a); asm volatile("s_waitcnt lgkmcnt(0)" ::: "memory"); \
    for (int d = 0; d < 4; ++d) for (int r = 0; r < 16; ++r) o[d][r] *= al_l[crow(r, hi)]; } } while (0)
  f32x16 pA0, pA1, pB0, pB1; float mnA, mnB, alA, alB; bf16x8 pa0, pa1, pa2, pa3;
  qkt<ND0>(pA0, pA1, K_lds, qr, r32, hi, kcol0); partialSM(pA0, pA1, m_reg, mnA, alA);
  SBAR(); qkt<ND0>(pB0, pB1, K_lds + 16384, qr, r32, hi, kcol0);
  finishSM(pA0, pA1, alA, l_reg, pa0, pa1, pa2, pa3); SBAR();
  pv_d0(o, vb0, pa0, pa1, pa2, pa3); partialSM(pB0, pB1, m_reg, mnB, alB); RESC(alB);
  SBAR(); qkt<ND0>(pA0, pA1, K_lds + 2 * 16384, qr, r32, hi, kcol0);
  finishSM(pB0, pB1, alB, l_reg, pa0, pa1, pa2, pa3); SBAR();
  pv_d0(o, vb0 + 16384, pa0, pa1, pa2, pa3); partialSM(pA0, pA1, m_reg, mnA, alA); RESC(alA);
  SBAR(); qkt<ND0>(pB0, pB1, K_lds + 3 * 16384, qr, r32, hi, kcol0);
  finishSM(pA0, pA1, alA, l_reg, pa0, pa1, pa2, pa3); SBAR();
  pv_d0(o, vb0 + 2 * 16384, pa0, pa1, pa2, pa3); partialSM(pB0, pB1, m_reg, mnB, alB); RESC(alB);
  finishSM(pB0, pB1, alB, l_reg, pa0, pa1, pa2, pa3); SBAR();
  pv_d0(o, vb0 + 3 * 16384, pa0, pa1, pa2, pa3);
#undef RESC
}
__device__ __forceinline__ void row_inv_l_res(float l_reg, char* lds, int wid, int r32, int hi, float (&rli)[16]) {
  float* li_l = (float*)(lds + RES_WS) + wid * 64;
  if (hi == 0) li_l[r32] = l_reg; asm volatile("s_waitcnt lgkmcnt(0)" ::: "memory");
#pragma unroll
  for (int r = 0; r < 16; ++r) rli[r] = __builtin_amdgcn_rcpf(li_l[crow(r, hi)]);
}
template <bool SILU> __device__ __forceinline__ void store_direct_gated(const f32x16 (&v)[4], char* stg  , bf16_t* Y0  , const bf16_t* G0, int gpitch, int lane, int r32, int hi) {
  bf16_t* st = (bf16_t*)stg;
  const bf16_t* gp = G0 + (size_t)(lane >> 4) * gpitch + (lane & 15) * 8; bf16_t* yp = Y0 + (size_t)(lane >> 4) * DM + (lane & 15) * 8; const bf16_t* sp = st + (lane >> 4) * 128 + (lane & 15) * 8;
  u32x4 g[8];
#pragma unroll
  for (int i = 0; i < 8; ++i) { g[i] = *(const u32x4*)gp; gp += 4 * (size_t)gpitch; asm volatile("" : "+v"(gp)); }
#pragma unroll
  for (int j = 0; j < 4; ++j) {
#pragma unroll
    for (int rr = 0; rr < 4; ++rr)
#pragma unroll
      for (int d0 = 0; d0 < 4; ++d0) st[(rr + 4 * hi) * 128 + d0 * 32 + r32] = (bf16_t)f2bf(v[d0][4 * j + rr]);
    asm volatile("s_waitcnt lgkmcnt(0)" ::: "memory");
#pragma unroll
    for (int i = 0; i < 2; ++i) {
      const u32x4 x = *(const u32x4*)(sp + i * 4 * 128); const u32x4 gg = g[2 * j + i];
      u32x4 w; w.x = pk2(bflo(x.x) * GATE(bflo(gg.x)), bfhi(x.x) * GATE(bfhi(gg.x))); w.y = pk2(bflo(x.y) * GATE(bflo(gg.y)), bfhi(x.y) * GATE(bfhi(gg.y)));
      w.z = pk2(bflo(x.z) * GATE(bflo(gg.z)), bfhi(x.z) * GATE(bfhi(gg.z))); w.w = pk2(bflo(x.w) * GATE(bflo(gg.w)), bfhi(x.w) * GATE(bfhi(gg.w)));
      *(u32x4*)yp = w; yp += 4 * DM; asm volatile("" : "+v"(yp)); }
    asm volatile("s_waitcnt lgkmcnt(0)" ::: "memory");
  }
}
__device__ __forceinline__ void gqa_prompt_slot(const Params& p, char* lds, int bk, const int wid) {
  const int lane = fresh_lane(), r32 = lane & 31, hi = lane >> 5;
  const bf16_t* QC = (const bf16_t*)(p.ws + WS_Q); const bf16_t* PR = (const bf16_t*)(p.ws + WS_PR); bf16_t* Y = (bf16_t*)(p.ws + WS_HY);
  load_kv_resident((const bf16_t*)(p.ws + WS_KP) + (size_t)bk * SEQP * 128, (const bf16_t*)(p.ws + WS_VP) + (size_t)bk * SEQP * 128, lds, wid * 64 + lane);
  __syncthreads();
  const int m0 = (bk >> 2) * SEQP;
  for (int g = 0; g < 4; ++g) {
    const int hq = (bk & 3) * 4 + g;
    f32x16 o[4]; float l_reg;
    const size_t row0 = (size_t)(m0 + wid * QBLK);
    attn_core_res<8>(QC + (row0 + r32) * DM + hq * 128 + hi * 8, 0, lds, o, l_reg, wid, lane);
    float rli[16]; row_inv_l_res(l_reg, lds, wid, r32, hi, rli);
#pragma unroll
    for (int d0 = 0; d0 < 4; ++d0)
#pragma unroll
      for (int r = 0; r < 16; ++r) o[d0][r] *= rli[r];
    store_direct_gated<false>(o, lds + RES_EX + wid * 2048, Y + row0 * DM + hq * 128, (const bf16_t*)(p.ws + WS_SG) + row0 * DM + hq * 128, DM, lane, r32, hi);
  }
  __syncthreads();
}
__device__ __forceinline__ void diff_prompt_slot(const Params& p, char* lds, int slot  , float lam, const int wid) {
  const int lane = fresh_lane(), r32 = lane & 31, hi = lane >> 5, rg = wid & 3, mp = wid >> 2;
  const bf16_t* QA = (const bf16_t*)(p.ws + WS_Q); const bf16_t* PR = (const bf16_t*)(p.ws + WS_PR); bf16_t* Y = (bf16_t*)(p.ws + WS_HY);
  for (int hh = 0; hh < 2; ++hh) {
    const int bh = slot * 2 + hh, h = bh & 7, b = bh >> 3;
    load_kv_resident((const bf16_t*)(p.ws + WS_KP) + (size_t)bh * SEQP * 128, (const bf16_t*)(p.ws + WS_VP) + (size_t)bh * SEQP * 128, lds, wid * 64 + lane);
    __syncthreads();
    for (int qb = 0; qb < 2; ++qb) {
      const size_t row0 = (size_t)(b * SEQP + qb * 128 + rg * QBLK);
      f32x16 o[4]; float l_reg;
      attn_core_res<4>(QA + (row0 + r32) * 1024 + h * 128 + mp * 64 + hi * 8, mp * 64, lds, o, l_reg, wid, lane);
      float rli[16]; row_inv_l_res(l_reg, lds, wid, r32, hi, rli);
      float* ex = (float*)(lds + RES_EX) + rg * 1024 + lane;
      float ss[16];
#pragma unroll
      for (int r = 0; r < 16; ++r) ss[r] = 0.f;
#pragma unroll
      for (int d0 = 0; d0 < 4; ++d0) {
        if (mp == 1) {
#pragma unroll
          for (int r = 0; r < 16; ++r) ex[r * 64] = o[d0][r] * (rli[r] * lam); }
        __syncthreads();
        if (mp == 0) {
#pragma unroll
          for (int r = 0; r < 16; ++r) { const float v = o[d0][r] * rli[r] - ex[r * 64]; o[d0][r] = v; ss[r] += v * v; } }
        __syncthreads();
      }
      if (mp == 0) {
#pragma unroll
        for (int r = 0; r < 16; ++r) {
#pragma unroll
          for (int of = 1; of < 32; of <<= 1) ss[r] += __shfl_xor(ss[r], of);
          ss[r] = 0.8f / sqrtf(ss[r] * (1.f / 128.f) + EPS); }
#pragma unroll
        for (int d0 = 0; d0 < 4; ++d0) { const float sw = p.subln_w[d0 * 32 + r32];
#pragma unroll
          for (int r = 0; r < 16; ++r) o[d0][r] *= ss[r] * sw; }
        store_direct_gated<false>(o, lds + RES_EX + 16384 + rg * 2048, Y + row0 * DM + h * 128, (const bf16_t*)(p.ws + WS_SG) + row0 * DM + h * 128, DM, lane, r32, hi);
      }
    }
    __syncthreads();
  }
}
__device__ __forceinline__ void gqa_phase(const Params& p, char* lds, int vcu, int G, const int wid, const int mode) {
  for (int v = vcu; v < 256; v += G) {
    if (v < 128) { if (mode & 1) continue;
      const int qb = v & 3, g = (v >> 2) & 3, bk = v >> 4;
      gqa_unit(p, lds, MP + (bk >> 2) * SEQS + qb * 256, (bk & 3) * 4 + g, (const bf16_t*)(p.ws + WS_KSC) + (size_t)bk * LKS * 128, (const bf16_t*)(p.ws + WS_VSC) + (size_t)bk * LKS * 128, LKS, wid); }
    else { if (mode & 2) continue; gqa_prompt_slot(p, lds, v - 128, wid); }
  }
}
__device__ __forceinline__ void diff_unit(const Params& p, char* lds, int m0, int h, const bf16_t* Kh, const bf16_t* Vh, int seq, float lam, const int wid) {
  const int lane = fresh_lane(), r32 = lane & 31, hi = lane >> 5, rg = wid & 3, mp = wid >> 2;
  const bf16_t* QA = (const bf16_t*)(p.ws + WS_Q); const bf16_t* PR = (const bf16_t*)(p.ws + WS_PR); bf16_t* Y = (bf16_t*)(p.ws + WS_HY);
  f32x16 o[4]; float l_reg;
  attn_core<4>(QA + (size_t)(m0 + rg * QBLK + r32) * 1024 + h * 128 + mp * 64 + hi * 8, Kh, Vh, seq, mp * 64, lds, o, l_reg, wid, lane);
  float rli[16]; row_inv_l(l_reg, lds, wid, r32, hi, rli);
  __syncthreads();
  float* ex = (float*)lds + rg * 4096 + lane;
  if (mp == 1) {
#pragma unroll
    for (int d0 = 0; d0 < 4; ++d0)
#pragma unroll
      for (int r = 0; r < 16; ++r) ex[(d0 * 16 + r) * 64] = o[d0][r] * (rli[r] * lam);
  }
  __syncthreads();
  if (mp == 0) {
    float ss[16];
#pragma unroll
    for (int r = 0; r < 16; ++r) ss[r] = 0.f;
#pragma unroll
    for (int d0 = 0; d0 < 4; ++d0)
#pragma unroll
      for (int r = 0; r < 16; ++r) { const float v = o[d0][r] * rli[r] - ex[(d0 * 16 + r) * 64]; o[d0][r] = v; ss[r] += v * v; }
#pragma unroll
    for (int r = 0; r < 16; ++r) {
#pragma unroll
      for (int of = 1; of < 32; of <<= 1) ss[r] += __shfl_xor(ss[r], of);
      ss[r] = 0.8f / sqrtf(ss[r] * (1.f / 128.f) + EPS); }
#pragma unroll
    for (int d0 = 0; d0 < 4; ++d0) { const float sw = p.subln_w[d0 * 32 + r32];
#pragma unroll
      for (int r = 0; r < 16; ++r) o[d0][r] *= ss[r] * sw; }
    const size_t row0 = (size_t)(m0 + rg * QBLK);
    store_rows_gated<false>(o, lds + STG_OFF + rg * 8192, Y + row0 * DM + h * 128, (const bf16_t*)(p.ws + WS_SG) + row0 * DM + h * 128, DM, lane, r32, hi);
  }
  __syncthreads();
}
__device__ __forceinline__ void diff_phase(const Params& p, char* lds, int vcu, int G, const int wid, const int mode) {
  const int lane = fresh_lane();
  const float lam = expf(wave_sum(p.lam_q1[lane] * p.lam_k1[lane])) - expf(wave_sum(p.lam_q2[lane] * p.lam_k2[lane])) + 0.2f;
  for (int v = vcu; v < 256; v += G) {
    if (v < 128) { if (mode & 1) continue;
      const int qb = v & 7, bh = v >> 3;
      diff_unit(p, lds, MP + (bh >> 3) * SEQS + qb * 128, bh & 7, (const bf16_t*)(p.ws + WS_KSA) + (size_t)bh * LKS * 128, (const bf16_t*)(p.ws + WS_VSA) + (size_t)bh * LKS * 128, LKS, lam, wid); }
    else { if (mode & 2) continue; diff_prompt_slot(p, lds, v - 128, lam, wid); }
  }
}
#undef KSWZ
#undef SBAR
}

constexpr int NWAVES = 8;
constexpr int RING_OFF = 0, RING_BYTES = 131072;
constexpr int LDSCTL_OFF = RING_BYTES, MISC_OFF = LDSCTL_OFF + 320;
constexpr int LDS_BYTES = 163840;
constexpr int RES_WS_OFF = RING_BYTES + 1024, RES_EX_OFF = RING_BYTES + 4096;
constexpr int CW_BAR = 4096;
#define GAS __attribute__((address_space(1)))
#define LAS __attribute__((address_space(3)))
typedef GAS unsigned gu32;
#define RLX_AGENT __ATOMIC_RELAXED, __HIP_MEMORY_SCOPE_AGENT
#define XB_TMO      128
#define XB_XCNT(j)  (256  + 64 * (j))
#define XB_XSUB(j)  (1280 + 64 * (j))
#define XB_XGEN(j)  (2304 + 64 * (j))
#define XB_TOP      3328
#define XB_TOPGEN   3392
#define XCD_BAR_WORDS 3456
#define XB_SPIN_CAP (1u << 18)
__device__ __forceinline__ unsigned xb_ld(unsigned* p)              { return __hip_atomic_load(p, __ATOMIC_RELAXED, __HIP_MEMORY_SCOPE_AGENT); }
__device__ __forceinline__ unsigned xb_add(unsigned* p, unsigned v) { return __hip_atomic_fetch_add(p, v, __ATOMIC_RELAXED, __HIP_MEMORY_SCOPE_AGENT); }
__device__ __forceinline__ unsigned xb_xcc_id() { return (unsigned)__builtin_amdgcn_s_getreg((3 << 11) | 20) & 0xFu; }
#define XB_SPIN(cond, bar) do { unsigned _sp = 0; while (cond) { __builtin_amdgcn_s_sleep(1); \
    if ((++_sp & 255u) == 0u) { if (xb_ld(&(bar)[XB_TMO])) break; if (_sp > XB_SPIN_CAP) { atomicAdd(&(bar)[XB_TMO], 1u); break; } } } } while (0)
struct XcdBarrier { unsigned* bar; unsigned x; volatile LAS unsigned* st; };
__device__ __forceinline__ XcdBarrier xcd_barrier_post(unsigned* bar, volatile LAS unsigned* st) {
    XcdBarrier b; b.bar = bar; b.x = xb_xcc_id(); b.st = st;
    if (threadIdx.x == 0) (void)xb_add(&bar[XB_XCNT(b.x)], 1u);
    return b;
}
__device__ __forceinline__ void xcd_barrier_complete(unsigned* bar, unsigned x, unsigned& nloc, unsigned& nx) {
    const unsigned G = gridDim.x * gridDim.y * gridDim.z;
    unsigned sum, cnt, mine, sp = 0u;
    for (;;) {
        sum = 0u; cnt = 0u; mine = 0u;
#pragma unroll
        for (unsigned j = 0; j < 16; ++j) { const unsigned c = xb_ld(&bar[XB_XCNT(j)]); sum += c; cnt += (c > 0u) ? 1u : 0u; mine = (j == x) ? c : mine; }
        if (sum == G) break;
        __builtin_amdgcn_s_sleep(1);
        if ((++sp & 255u) == 0u) { if (xb_ld(&bar[XB_TMO])) break; if (sp > XB_SPIN_CAP) { atomicAdd(&bar[XB_TMO], 1u); break; } }
    }
    nloc = mine > 0u ? mine : 1u; nx = cnt > 0u ? cnt : 1u;
}
__device__ __forceinline__ void xcd_barrier(const XcdBarrier& b) {
    asm volatile("s_waitcnt vmcnt(0)" ::: "memory");
    __syncthreads();
    if (threadIdx.x == 0) {
        unsigned* bar = b.bar;
        __builtin_amdgcn_s_waitcnt(0);
        unsigned nloc = b.st[0], nx = b.st[1];
        if (nloc == 0u) { xcd_barrier_complete(bar, b.x, nloc, nx); b.st[0] = nloc; b.st[1] = nx; }
        const unsigned old = xb_add(&bar[XB_XSUB(b.x)], 1u);
        const unsigned gen = old / nloc;
        if (old + 1u == (gen + 1u) * nloc) {
            __builtin_amdgcn_fence(__ATOMIC_RELEASE, "agent");
            asm volatile("s_waitcnt vmcnt(0)" ::: "memory");
            const unsigned og = xb_add(&bar[XB_TOP], 1u);
            const unsigned tg = og / nx;
            if (og + 1u == (tg + 1u) * nx) xb_add(&bar[XB_TOPGEN], 1u);
            else XB_SPIN(xb_ld(&bar[XB_TOPGEN]) == tg, bar);
            __builtin_amdgcn_fence(__ATOMIC_ACQUIRE, "agent");
            xb_add(&bar[XB_XGEN(b.x)], 1u);
            asm volatile("s_waitcnt vmcnt(0)" ::: "memory");
        } else {
            XB_SPIN(xb_ld(&bar[XB_XGEN(b.x)]) == gen, bar);
            __builtin_amdgcn_fence(__ATOMIC_ACQUIRE, "agent");
            asm volatile("s_waitcnt vmcnt(0)" ::: "memory");
        }
    }
    __syncthreads();
}

struct MegaArgs { Params p; int ph_lo, ph_hi, mode, pad; };
constexpr int N_PHASES = 11;
#ifndef DUP_PHASE
#define DUP_PHASE -1
#endif
__global__ void __launch_bounds__(NWAVES * 64, 2) mega_fwd(MegaArgs args) {
    extern __shared__ __attribute__((aligned(16))) unsigned char lds[];
    const Params& p = args.p;
    LAS unsigned char* ldsl = (LAS unsigned char*)lds;
    volatile LAS unsigned* MISC = (volatile LAS unsigned*)(ldsl + MISC_OFF);
    const int wave = __builtin_amdgcn_readfirstlane(threadIdx.x >> 6);
    const int G = gridDim.x, bx = blockIdx.x;
    const int vcu = (G % 8 == 0) ? (bx % 8) * (G / 8) + bx / 8 : bx;
    for (int u = threadIdx.x; u < (LDS_BYTES - LDSCTL_OFF) / 4; u += NWAVES * 64) ((LAS unsigned*)(ldsl + LDSCTL_OFF))[u] = 0u;
    __syncthreads();
    unsigned char* ws = p.ws;
    XcdBarrier bar = xcd_barrier_post((unsigned*)(ws + WS_CTL) + CW_BAR, MISC + 8);
    const int lo = args.ph_lo, hi = args.ph_hi;
    const int gw = vcu * NWAVES + wave, ngw = G * NWAVES;
#define IN(k) (lo <= (k) && (k) < hi)
#define SEAM(k) do { if (IN(k) && (IN((k) + 1) || ((k) == 7 && IN(9)))) xcd_barrier(bar); } while (0)
#define REP(k) for (int rep_ = 0; rep_ < ((k) == DUP_PHASE ? 2 : 1); ++rep_, ((k) == DUP_PHASE && rep_ < 2 ? xcd_barrier(bar) : (void)0))
    if (IN(0)) REP(0) {
        float* scr = (float*)lds; const int lane = fresh_lane(), tid = wave * 64 + lane;
        if (rep_ == 0 && !(args.mode & 8)) mod_items(p, scr, bx, G, tid, NWAVES * 64);
        __syncthreads();
        if (!(args.mode & 16)) weights_items(p, (float*)(lds + wave * 16384), gw, ngw, lane);
        if (!(args.mode & 32)) caches_rope_items(p, (long)bx * 512 + tid, (long)G * 512);
    }
    SEAM(0);
    if (IN(1)) REP(1) modulate_rows(p, 0, gw, ngw, fresh_lane());
    SEAM(1);
    if (IN(2)) REP(2) {
        pg8::Gemm g{(const bf16_t*)(ws + WS_HY), (const bf16_t*)(ws + WS_WINE), MT, EVEN_IN, DM, DM, DM, 0}; pg8::StaticOrder S; S.init(MT, EVEN_IN, G, bx);
        float* nak = p.out + (size_t)MT * DM;
        pg8::EpiProj0 E{ws, p.even_q_norm_w, p.even_k_norm_w, nak, nak + (size_t)NBP * HA * SEQP * 128};
        pg8::gemm_phase<pg8::EpiProj0, pg8::StaticOrder, true, true>(ldsl + RING_OFF, g, S, E, wave * 64 + fresh_lane());
    }
    SEAM(2);
    if (IN(3)) REP(3) pool_rows(p, gw, ngw, fresh_lane());
    SEAM(3);
    if (IN(4)) REP(4) {
        if (!(args.mode & 4)) { pg8::Gemm g{(const bf16_t*)(ws + WS_UA), (const bf16_t*)(ws + WS_POOLW), MT, 1024, 256, 1024, 256, 256}; pg8::StaticOrder S; S.init(MT, 1024, G, bx);
          pg8::EpiPoolF E{(bf16_t*)(ws + WS_HY), (const bf16_t*)(ws + WS_SG), p.pool_scale};
          pg8::gemm_phase<pg8::EpiPoolF, pg8::StaticOrder, true, true>(ldsl + RING_OFF, g, S, E, wave * 64 + fresh_lane()); }
        __syncthreads();
        att::diff_phase(p, (char*)lds, vcu, G, wave, args.mode);
    }
    SEAM(4);
    if (IN(5)) REP(5) {
        pg8::Gemm g{(const bf16_t*)(ws + WS_HY), (const bf16_t*)(ws + WS_WOUTE), MT, DM, DM, DM, DM, 0}; pg8::StaticOrder S; S.init(MT, DM, G, bx);
        pg8::EpiResidF E{p.x_prompt, p.x_sample, nullptr, (const float*)(ws + WS_MOD) + 4096, p.out};
        pg8::gemm_phase<pg8::EpiResidF, pg8::StaticOrder, true, true>(ldsl + RING_OFF, g, S, E, wave * 64 + fresh_lane());
    }
    SEAM(5);
    if (IN(6)) REP(6) modulate_rows(p, 1, gw, ngw, fresh_lane());
    SEAM(6);
    if (IN(7)) REP(7) {
        pg8::Gemm g{(const bf16_t*)(ws + WS_HY), (const bf16_t*)(ws + WS_WINO), MT, ODD_IN, DM, DM, DM, 0}; pg8::StaticOrder S; S.init(MT, ODD_IN, G, bx);
        float* nck = p.out + (size_t)MT * DM + 2 * (size_t)NBP * HA * SEQP * 128;
        pg8::EpiProj1 E{ws, p.gqa_q_norm_w, p.gqa_k_norm_w, nck, nck + (size_t)NBP * KVH * SEQP * 128, (LAS float*)(ldsl + RES_EX_OFF)};
        pg8::gemm_phase<pg8::EpiProj1, pg8::StaticOrder, true, true>(ldsl + RING_OFF, g, S, E, wave * 64 + fresh_lane());
    }
    SEAM(7);
    if (IN(9)) REP(9) att::gqa_phase(p, (char*)lds, vcu, G, wave, args.mode);
    SEAM(9);
    if (IN(10)) {
        pg8::Gemm g{(const bf16_t*)(ws + WS_HY), (const bf16_t*)(ws + WS_WOUTO), MT, DM, DM, DM, DM, 0}; pg8::StaticOrder S; S.init(MT, DM, G, bx);
        pg8::EpiResidF E{p.x_prompt, p.x_sample, p.out, (const float*)(ws + WS_MOD) + 3 * 6144 + 4096, p.out};
        pg8::gemm_phase<pg8::EpiResidF, pg8::StaticOrder, true, true>(ldsl + RING_OFF, g, S, E, wave * 64 + fresh_lane());
    }
#undef IN
#undef SEAM
}

#ifndef MK_PER_PHASE
#define MK_PER_PHASE 0
#endif
extern "C" void kernel_launch(void* const* d_in, const int* in_sizes, int n_in, void* d_out, int out_size, void* d_ws, size_t ws_size, hipStream_t stream) {
    if (n_in != 26 || ws_size < WS_END || out_size != MT * DM + 2 * NBP * HA * SEQP * 128 + 2 * NBP * KVH * SEQP * 128) {
        fprintf(stderr, "kernel_launch: unexpected shapes n_in %d ws %zu out %d\n", n_in, ws_size, out_size); return; }
    static int ready = 0;
    if (!ready) {
        if (hipFuncSetAttribute((const void*)mega_fwd, hipFuncAttributeMaxDynamicSharedMemorySize, LDS_BYTES) != hipSuccess) { fprintf(stderr, "kernel_launch: hipFuncSetAttribute failed\n"); return; }
        ready = 1;
    }
    MegaArgs a{};
    const float** pin = (const float**)&a.p;
    for (int i = 0; i < 26; ++i) pin[i] = (const float*)d_in[i];
    a.p.out = (float*)d_out; a.p.ws = (unsigned char*)d_ws;
#ifdef EXTRA_PHASE
    (void)hipMemsetAsync((unsigned char*)d_ws + WS_CTL, 0, 2 * MiB, stream);
    a.ph_lo = EXTRA_PHASE; a.ph_hi = EXTRA_PHASE + 1; hipLaunchKernelGGL(mega_fwd, dim3(256), dim3(NWAVES * 64), LDS_BYTES, stream, a);
#endif
    (void)hipMemsetAsync((unsigned char*)d_ws + WS_CTL, 0, 2 * MiB, stream);
#if MK_PER_PHASE
    for (int ph = 0; ph < N_PHASES; ++ph) { a.ph_lo = ph; a.ph_hi = ph + 1; hipLaunchKernelGGL(mega_fwd, dim3(256), dim3(NWAVES * 64), LDS_BYTES, stream, a); }
#else
    a.ph_lo = 0; a.ph_hi = N_PHASES; hipLaunchKernelGGL(mega_fwd, dim3(256), dim3(NWAVES * 64), LDS_BYTES, stream, a);
#endif
#ifdef EXTRA_AFTER
    (void)hipMemsetAsync((unsigned char*)d_ws + WS_CTL, 0, 1 * MiB, stream);
    a.ph_lo = EXTRA_AFTER; a.ph_hi = EXTRA_AFTER + 1; a.mode = EXTRA_MODE; hipLaunchKernelGGL(mega_fwd, dim3(256), dim3(NWAVES * 64), LDS_BYTES, stream, a);
#endif
}
```

```cpp
#include <hip/hip_runtime.h>
#include <cstdio>
#include <cstdint>

typedef unsigned short bf16_t;
typedef float f32x4 __attribute__((ext_vector_type(4)));
typedef unsigned u32x4 __attribute__((ext_vector_type(4)));
typedef unsigned u32x2 __attribute__((ext_vector_type(2)));

constexpr int DM = 2048, NBP = 32, SEQP = 256, NBS = 2, SEQS = 1024, PAST = 256;
constexpr int MP = NBP * SEQP, MS = NBS * SEQS, MT = MP + MS;
constexpr int HA = 8, DKA = 64, DVA = 128, WA = 1024, WB = 1024, GWB = 256;
constexpr int EVEN_IN = 6144, ODD_IN = 5120;
constexpr int HC = 16, KVH = 4, HDC = 128;
constexpr int LKS = PAST + SEQS;
constexpr float EPS = 1e-6f;
constexpr float LOG2E = 1.4426950408889634f;
constexpr float C2A = 0.125f * LOG2E;
constexpr float C2C = 0.08838834764831845f * LOG2E;

constexpr size_t MiB = 1u << 20;
constexpr size_t WS_CTL = 0;
constexpr size_t WS_MOD = 1 * MiB;
constexpr size_t WS_ROPE = 2 * MiB;
constexpr size_t WS_WINE = 4 * MiB;
constexpr size_t WS_WOUTE = 28 * MiB;
constexpr size_t WS_WINO = 36 * MiB;
constexpr size_t WS_WOUTO = 56 * MiB;
constexpr size_t WS_POOLW = 64 * MiB;
constexpr size_t WS_HY = 65 * MiB;
constexpr size_t WS_PR = 105 * MiB;
constexpr size_t WS_Q = 225 * MiB;
constexpr size_t WS_KP = 265 * MiB;
constexpr size_t WS_VP = 281 * MiB;
constexpr size_t WS_KSA = 297 * MiB;
constexpr size_t WS_VSA = 302 * MiB;
constexpr size_t WS_KSC = 307 * MiB;
constexpr size_t WS_VSC = 310 * MiB;
constexpr size_t WS_UA = 313 * MiB;
constexpr size_t WS_SG = WS_PR;
constexpr size_t WS_U = WS_PR + 40 * MiB;
constexpr size_t WS_H1 = 333 * MiB;
constexpr size_t WS_WU = WS_UA;
constexpr size_t WS_END = 373 * MiB;
constexpr size_t WS_CW1 = WS_MOD + 256 * 1024;
constexpr size_t WS_B2P = WS_MOD + 320 * 1024;
constexpr size_t WS_RSS = WS_MOD + 512 * 1024;

struct Params {
    const float* x_prompt; const float* x_sample; const float* cache_a_k; const float* cache_a_v; const float* cache_c_k; const float* cache_c_v;
    const float* c; const float* c_ctx; const float* norm_w; const float* ada_w; const float* ada_b;
    const float* even_w_in; const float* even_q_norm_w; const float* even_k_norm_w; const float* lam_q1; const float* lam_k1; const float* lam_q2; const float* lam_k2;
    const float* subln_w; const float* pool_w; const float* pool_scale; const float* even_w_out;
    const float* gqa_w_in; const float* gqa_q_norm_w; const float* gqa_k_norm_w; const float* gqa_w_out;
    float* out; unsigned char* ws;
};

__device__ __forceinline__ unsigned f2bf(float f) { unsigned u = __builtin_bit_cast(unsigned, f); return (u + 0x7fffu + ((u >> 16) & 1u)) >> 16; }
__device__ __forceinline__ unsigned pk2(float lo, float hi) { return f2bf(lo) | (f2bf(hi) << 16); }
__device__ __forceinline__ float bf2f(unsigned h) { return __builtin_bit_cast(float, h << 16); }
__device__ __forceinline__ float bflo(unsigned w) { return __builtin_bit_cast(float, w << 16); }
__device__ __forceinline__ float bfhi(unsigned w) { return __builtin_bit_cast(float, w & 0xffff0000u); }
__device__ __forceinline__ float siluf(float x) { return x / (1.f + __expf(-x)); }
__device__ __forceinline__ float wave_sum(float v) {
#pragma unroll
    for (int o = 1; o < 64; o <<= 1) v += __shfl_xor(v, o);
    return v;
}
__device__ __forceinline__ float wave_max(float v) {
#pragma unroll
    for (int o = 1; o < 64; o <<= 1) v = fmaxf(v, __shfl_xor(v, o));
    return v;
}
__device__ __forceinline__ int fresh_lane() { int l; asm volatile("v_mbcnt_lo_u32_b32 %0, -1, 0\n\tv_mbcnt_hi_u32_b32 %0, -1, %0" : "=v"(l)); return l; }
__device__ __forceinline__ const float* xrow_ptr(const Params& p, int m) { return m < MP ? p.x_prompt + (size_t)m * DM : p.x_sample + (size_t)(m - MP) * DM; }
__device__ __forceinline__ int cond_row(int m) { return m < MP ? 0 : 1 + ((m - MP) >> 10); }

__device__ __forceinline__ void mod_items(const Params& p, float* sl  , int bid, int nb, int tid, int nthr) {
    float* mod = (float*)(p.ws + WS_MOD);
    for (int it = bid; it < 256; it += nb) {
        const int l = it >> 7, kc = (it >> 2) & 31, nc = it & 3;
        __syncthreads();
        for (int i = tid; i < 192; i += nthr) { const int r = i >> 6, kk = i & 63, k = kc * 64 + kk; const float cv = r == 0 ? p.c_ctx[k] : p.c[(r - 1) * DM + k]; sl[i] = siluf(cv); }
        __syncthreads();
        for (int q = tid; q < 384; q += nthr) {
            const int n = nc * 1536 + q * 4;
            const float* w = p.ada_w + ((size_t)l * DM + kc * 64) * 6144 + n;
            f32x4 a0 = {0.f, 0.f, 0.f, 0.f}, a1 = a0, a2 = a0;
#pragma unroll 16
            for (int kk = 0; kk < 64; ++kk) { const f32x4 wv = *(const f32x4*)(w + (size_t)kk * 6144); a0 += wv * sl[kk]; a1 += wv * sl[64 + kk]; a2 += wv * sl[128 + kk]; }
            if (kc == 0) { const f32x4 b = *(const f32x4*)(p.ada_b + l * 6144 + n); a0 += b; a1 += b; a2 += b; }
            float* m0 = mod + (size_t)(l * 3) * 6144 + n;
#pragma unroll
            for (int e = 0; e < 4; ++e) { atomicAdd(m0 + e, a0[e]); atomicAdd(m0 + 6144 + e, a1[e]); atomicAdd(m0 + 2 * 6144 + e, a2[e]); }
        }
    }
}

__device__ __forceinline__ void transpose_item(const float* W, int K, int N, bf16_t* WT, float* scr, int item, int lane) {
    const int nblk = N / 32, kb = item / nblk, nb = item % nblk, k0 = 64 * kb, n0 = 32 * nb;
#pragma unroll 8
    for (int i = 0; i < 32; ++i) { const int kk = 2 * i + (lane >> 5); scr[kk * 33 + (lane & 31)] = W[(size_t)(k0 + kk) * N + n0 + (lane & 31)]; }
    __builtin_amdgcn_s_waitcnt(0xc07f); asm volatile("" ::: "memory");
    const int c = lane & 7;
#pragma unroll
    for (int j = 0; j < 4; ++j) { const int n = (lane >> 3) + 8 * j; const float* s = scr + (8 * c) * 33 + n;
        u32x4 o; o.x = pk2(s[0 * 33], s[1 * 33]); o.y = pk2(s[2 * 33], s[3 * 33]); o.z = pk2(s[4 * 33], s[5 * 33]); o.w = pk2(s[6 * 33], s[7 * 33]);
        *(u32x4*)(WT + (size_t)(n0 + n) * K + k0 + 8 * c) = o; }
    __builtin_amdgcn_s_waitcnt(0xc07f); asm volatile("" ::: "memory");
}
template <int PERMK> __device__ __forceinline__ int pos_of_col(int n) {
    if (PERMK == 1) { if (n >= 2048) return n; const int c = n & 255, wc = c >> 6, dim = c & 63, q = dim >> 4, ii = dim & 15; return (n & ~255) + 128 * (q & 1) + 32 * wc + (q >> 1) * 16 + ii; }
    if (PERMK == 2) { if (n >= 2560) return n; const int c = n & 255, hl = c >> 7, dim = c & 127, qd = dim >> 5, i = dim & 31; return (n & ~255) + 128 * (qd & 1) + 32 * (2 * hl + (qd >> 1)) + i; }
    return n;
}
template <int PERMK> __device__ __forceinline__ void transpose_item64(const float* W, int K, int N, bf16_t* WT, bf16_t* scr, int item, int lane) {
    const int nblk = N / 64, kb = item / nblk, nb = item % nblk, k0 = 64 * kb, n0 = 64 * nb;
    const int nq = lane & 15, kr = lane >> 4;
    f32x4 v[16];
    const float* src = W + (size_t)(k0 + kr) * N + n0 + 4 * nq;
#pragma unroll
    for (int i = 0; i < 16; ++i) v[i] = *(const f32x4*)(src + (size_t)(4 * i) * N);
#pragma unroll
    for (int i = 0; i < 16; ++i) { const int k = 4 * i + kr;
#pragma unroll
        for (int e = 0; e < 4; ++e) scr[(4 * nq + e) * 72 + k] = (bf16_t)f2bf(v[i][e]); }
    __builtin_amdgcn_s_waitcnt(0xc07f); asm volatile("" ::: "memory");
#pragma unroll
    for (int j = 0; j < 8; ++j) { const int idx = lane + 64 * j, n = idx >> 3, c = idx & 7;
        *(u32x4*)(WT + (size_t)pos_of_col<PERMK>(n0 + n) * K + k0 + 8 * c) = *(const u32x4*)(scr + n * 72 + 8 * c); }
    __builtin_amdgcn_s_waitcnt(0xc07f); asm volatile("" ::: "memory");
}
__device__ __forceinline__ void convert_item64(const float* W, int N, bf16_t* WU, int ldu, int ncol0, int item, int nblk0, int lane) {
    const int nblk = N / 64, kb = item / nblk, nb = item % nblk, k0 = 64 * kb, n0 = 64 * nb;
    const int nq = lane & 15, kr = lane >> 4;
    const float* src = W + (size_t)(k0 + kr) * N + n0 + 4 * nq;
    f32x4 v[16];
#pragma unroll
    for (int i = 0; i < 16; ++i) v[i] = *(const f32x4*)(src + (size_t)(4 * i) * N);
#pragma unroll
    for (int i = 0; i < 16; ++i) { u32x2 o; o.x = pk2(v[i][0], v[i][1]); o.y = pk2(v[i][2], v[i][3]); *(u32x2*)(WU + (size_t)(k0 + 4 * i + kr) * ldu + (n0 - ncol0) + 4 * nq) = o; }
}
__device__ __forceinline__ void weights_items(const Params& p, float* scrf  , int gw, int ngw, int lane) {
    bf16_t* scr = (bf16_t*)scrf;
    constexpr int I_WINE = 32 * (EVEN_IN / 64), I_WOUT = 32 * (DM / 64), I_WINO = 32 * (ODD_IN / 64), I_POOL = 4 * 4;
    constexpr int NITEMS = I_WINE + I_WOUT + I_WINO + I_WOUT + 4 * I_POOL;
    for (int it = gw; it < NITEMS; it += ngw) {
        int r = it;
        if (r < I_WINE) { const int nb = r % (EVEN_IN / 64);
            if (nb >= 48 && nb < 64) convert_item64(p.even_w_in, EVEN_IN, (bf16_t*)(p.ws + WS_WU), 1024, 3072, r, 0, lane);
            else transpose_item64<1>(p.even_w_in, DM, EVEN_IN, (bf16_t*)(p.ws + WS_WINE), scr, r, lane);
            continue; } r -= I_WINE;
        if (r < I_WOUT) { transpose_item64<0>(p.even_w_out, DM, DM, (bf16_t*)(p.ws + WS_WOUTE), scr, r, lane); continue; } r -= I_WOUT;
        if (r < I_WINO) { transpose_item64<2>(p.gqa_w_in, DM, ODD_IN, (bf16_t*)(p.ws + WS_WINO), scr, r, lane); continue; } r -= I_WINO;
        if (r < I_WOUT) { transpose_item64<0>(p.gqa_w_out, DM, DM, (bf16_t*)(p.ws + WS_WOUTO), scr, r, lane); continue; } r -= I_WOUT;
        const int g = r / I_POOL; r -= g * I_POOL;
        transpose_item64<0>(p.pool_w + (size_t)g * 65536, 256, 256, (bf16_t*)(p.ws + WS_POOLW) + (size_t)g * 65536, scr, r, lane);
    }
}
__device__ __forceinline__ void caches_rope_items(const Params& p, long gt, long ngt) {
    constexpr long NA = 2L * 8 * 256 * 128 / 4, NC = 2L * 4 * 256 * 128 / 4;
    for (long i = gt; i < 2 * NA + 2 * NC; i += ngt) {
        long j = i; const float* src; bf16_t* dst;
        if (j < NA) { src = p.cache_a_k; dst = (bf16_t*)(p.ws + WS_KSA); } else if ((j -= NA) < NA) { src = p.cache_a_v; dst = (bf16_t*)(p.ws + WS_VSA); }
        else if ((j -= NA) < NC) { src = p.cache_c_k; dst = (bf16_t*)(p.ws + WS_KSC); } else { j -= NC; src = p.cache_c_v; dst = (bf16_t*)(p.ws + WS_VSC); }
        const long e = j * 4, bh = e / (256 * 128), rem = e % (256 * 128);
        const f32x4 v = *(const f32x4*)(src + e);
        u32x2 o; o.x = pk2(v[0], v[1]); o.y = pk2(v[2], v[3]);
        *(u32x2*)(dst + bh * (LKS * 128) + rem) = o;
    }
    float* ropeA = (float*)(p.ws + WS_ROPE); float* ropeC = ropeA + 2 * 1024 * 64;
    for (long i = gt; i < 1024L * 64 + 1024L * 128; i += ngt) {
        const bool isA = i < 1024L * 64; const long j = isA ? i : i - 1024L * 64; const int dim = isA ? 64 : 128, quarter = dim / 4;
        const int t = (int)(j / dim), d = (int)(j % dim); const int qd = d / quarter, fi = d % quarter;
        const float freq = powf(10000.0f, -(float)fi / (float)quarter);
        const float pos = (qd < 2) ? (float)(t / 64) : (float)(t % 64);
        const float ang = pos * freq;
        float* base = isA ? ropeA : ropeC;
        base[j] = cosf(ang); base[(size_t)1024 * dim + j] = sinf(ang);
    }
}

__device__ __forceinline__ void modulate_rows(const Params& p, int layer, int gw, int ngw, int lane) {
    const float* mod = (const float*)(p.ws + WS_MOD) + (size_t)layer * 3 * 6144;
    const float* nw = p.norm_w + layer * DM;
    bf16_t* H = (bf16_t*)(p.ws + WS_HY);
    for (int m = gw; m < MT; m += ngw) {
        const float* xr = layer == 0 ? xrow_ptr(p, m) : p.out + (size_t)m * DM;
        const float* mr = mod + (size_t)cond_row(m) * 6144;
        f32x4 v[8]; float ss = 0.f;
#pragma unroll
        for (int j = 0; j < 8; ++j) { v[j] = *(const f32x4*)(xr + 4 * lane + 256 * j); ss += (v[j][0] * v[j][0] + v[j][1] * v[j][1]) + (v[j][2] * v[j][2] + v[j][3] * v[j][3]); }
        const float rstd = 1.0f / sqrtf(wave_sum(ss) * (1.f / DM) + EPS);
#pragma unroll
        for (int j = 0; j < 8; ++j) { const int k = 4 * lane + 256 * j;
            const f32x4 w = *(const f32x4*)(nw + k), sh = *(const f32x4*)(mr + k), sc = *(const f32x4*)(mr + 2048 + k);
            const f32x4 h = v[j] * rstd * w * (sc + 1.0f) + sh;
            u32x2 o; o.x = pk2(h[0], h[1]); o.y = pk2(h[2], h[3]);
            *(u32x2*)(H + (size_t)m * DM + k) = o; }
    }
}

__device__ __forceinline__ void mod1_tables(const Params& p, int gw, int ngw, int lane) {
    const float* mod1 = (const float*)(p.ws + WS_MOD) + 3 * 6144;
    float* cw1 = (float*)(p.ws + WS_CW1); float* b2p = (float*)(p.ws + WS_B2P);
    for (int i = gw * 64 + lane; i < 3 * DM; i += ngw * 64) { const int cr = i / DM, k = i % DM; cw1[i] = p.norm_w[DM + k] * (1.f + mod1[cr * 6144 + 2048 + k]); }
    const bf16_t* W = (const bf16_t*)(p.ws + WS_WINO);
    for (int r = gw; r < ODD_IN; r += ngw) {
        float a0 = 0.f, a1 = 0.f, a2 = 0.f;
#pragma unroll
        for (int j = 0; j < 4; ++j) { const int k = 8 * lane + 512 * j; const u32x4 w = *(const u32x4*)(W + (size_t)r * DM + k);
            const float wf[8] = {bflo(w.x), bfhi(w.x), bflo(w.y), bfhi(w.y), bflo(w.z), bfhi(w.z), bflo(w.w), bfhi(w.w)};
#pragma unroll
            for (int e = 0; e < 8; ++e) { a0 += wf[e] * mod1[k + e]; a1 += wf[e] * mod1[6144 + k + e]; a2 += wf[e] * mod1[2 * 6144 + k + e]; } }
        a0 = wave_sum(a0); a1 = wave_sum(a1); a2 = wave_sum(a2);
        if (lane == 0) { b2p[r] = a0; b2p[ODD_IN + r] = a1; b2p[2 * ODD_IN + r] = a2; }
    }
}
template <int DIM>
__device__ __forceinline__ f32x4 norm_rope4(f32x4 v, int lg  , const float* w, bool rope, const float* cosr, const float* sinr) {
    float ss = (v[0] * v[0] + v[1] * v[1]) + (v[2] * v[2] + v[3] * v[3]);
#pragma unroll
    for (int o = 1; o < DIM / 4; o <<= 1) ss += __shfl_xor(ss, o);
    const float r = 1.0f / sqrtf(ss * (1.f / DIM) + EPS);
    const f32x4 wv = *(const f32x4*)(w + 4 * lg);
    f32x4 y = v * r * wv;
    f32x4 pr;
#pragma unroll
    for (int e = 0; e < 4; ++e) pr[e] = __shfl_xor(y[e], DIM / 16);
    if (rope) {
        const f32x4 cs = *(const f32x4*)(cosr + 4 * lg), sn = *(const f32x4*)(sinr + 4 * lg);
        const bool odd = ((lg / (DIM / 16)) & 1) != 0;
        y = odd ? (y * cs + pr * sn) : (y * cs - pr * sn);
    }
    return y;
}

__device__ __forceinline__ void post0_rows(const Params& p, int gw, int ngw, int lane) {
    const bf16_t* PR = (const bf16_t*)(p.ws + WS_PR);
    bf16_t* QA = (bf16_t*)(p.ws + WS_Q); bf16_t* UA = (bf16_t*)(p.ws + WS_UA);
    const float* ropeA = (const float*)(p.ws + WS_ROPE);
    float* new_a_k = p.out + (size_t)MT * DM; float* new_a_v = new_a_k + (size_t)NBP * HA * SEQP * 128;
    for (int m = gw; m < MT; m += ngw) {
        const bool smp = m >= MP; const int b = smp ? (m - MP) >> 10 : m >> 8, t = smp ? (m - MP) & 1023 : m & 255;
        const bf16_t* pr = PR + (size_t)m * EVEN_IN;
        const float* cosr = ropeA + (size_t)t * 64; const float* sinr = ropeA + 1024 * 64 + (size_t)t * 64;
        const int sub = lane >> 4, lg = lane & 15;
#pragma unroll 2
        for (int st = 0; st < 8; ++st) {
            const int grp = st * 4 + sub;
            const u32x2 raw = *(const u32x2*)(pr + grp * 64 + 4 * lg);
            f32x4 v = {bflo(raw.x), bfhi(raw.x), bflo(raw.y), bfhi(raw.y)};
            const bool isk = grp >= 16;
            f32x4 y = norm_rope4<64>(v, lg, isk ? p.even_k_norm_w : p.even_q_norm_w, smp, cosr, sinr);
            if (!isk) { y = y * C2A; u32x2 o; o.x = pk2(y[0], y[1]); o.y = pk2(y[2], y[3]); *(u32x2*)(QA + (size_t)m * 1024 + grp * 64 + 4 * lg) = o; }
            else { const int g2 = grp - 16, h = g2 >> 1, j = g2 & 1;
                u32x2 o; o.x = pk2(y[0], y[1]); o.y = pk2(y[2], y[3]);
                if (smp) *(u32x2*)((bf16_t*)(p.ws + WS_KSA) + ((size_t)(b * HA + h) * LKS + PAST + t) * 128 + j * 64 + 4 * lg) = o;
                else { const size_t off = ((size_t)(b * HA + h) * SEQP + t) * 128 + j * 64 + 4 * lg; *(u32x2*)((bf16_t*)(p.ws + WS_KP) + off) = o; *(f32x4*)(new_a_k + off) = y; } }
        }
#pragma unroll
        for (int i = 0; i < 2; ++i) { const int c = 8 * lane + 512 * i, h = c >> 7, d = c & 127;
            const u32x4 raw = *(const u32x4*)(pr + 2048 + c);
            if (smp) *(u32x4*)((bf16_t*)(p.ws + WS_VSA) + ((size_t)(b * HA + h) * LKS + PAST + t) * 128 + d) = raw;
            else { const size_t off = ((size_t)(b * HA + h) * SEQP + t) * 128 + d; *(u32x4*)((bf16_t*)(p.ws + WS_VP) + off) = raw;
                *(f32x4*)(new_a_v + off) = (f32x4){bflo(raw.x), bfhi(raw.x), bflo(raw.y), bfhi(raw.y)}; *(f32x4*)(new_a_v + off + 4) = (f32x4){bflo(raw.z), bfhi(raw.z), bflo(raw.w), bfhi(raw.w)}; } }
        const int L = smp ? SEQS : SEQP;
#pragma unroll
        for (int i = 0; i < 2; ++i) { const int ch = lane + 64 * i, c = 8 * ch, g = ch >> 5, half = 1 << g;
            const int lo = max(t - half, 0), hi = min(t + half, L);
            float s[8] = {0.f, 0.f, 0.f, 0.f, 0.f, 0.f, 0.f, 0.f};
            for (int tt = lo; tt < hi; ++tt) { const u32x4 raw = *(const u32x4*)(pr + (ptrdiff_t)(tt - t) * EVEN_IN + 3072 + c);
                s[0] += bflo(raw.x); s[1] += bfhi(raw.x); s[2] += bflo(raw.y); s[3] += bfhi(raw.y); s[4] += bflo(raw.z); s[5] += bfhi(raw.z); s[6] += bflo(raw.w); s[7] += bfhi(raw.w); }
            const float inv = 1.0f / (float)(hi - lo);
            const u32x4 own = *(const u32x4*)(pr + 3072 + c);
            u32x4 o; o.x = pk2(s[0] * inv - bflo(own.x), s[1] * inv - bfhi(own.x)); o.y = pk2(s[2] * inv - bflo(own.y), s[3] * inv - bfhi(own.y));
            o.z = pk2(s[4] * inv - bflo(own.z), s[5] * inv - bfhi(own.z)); o.w = pk2(s[6] * inv - bflo(own.w), s[7] * inv - bfhi(own.w));
            *(u32x4*)(UA + (size_t)m * 1024 + c) = o; }
    }
}

__device__ __forceinline__ void pool_rows(const Params& p, int gw, int ngw, int lane) {
    const bf16_t* U = (const bf16_t*)(p.ws + WS_U); bf16_t* UA = (bf16_t*)(p.ws + WS_UA);
    for (int m = gw; m < MT; m += ngw) {
        const bool smp = m >= MP; const int t = smp ? (m - MP) & 1023 : m & 255, L = smp ? SEQS : SEQP;
        const bf16_t* pr = U + (size_t)m * 1024;
#pragma unroll
        for (int i = 0; i < 2; ++i) { const int ch = lane + 64 * i, c = 8 * ch, g = ch >> 5, half = 1 << g;
            const int lo = max(t - half, 0), hi = min(t + half, L);
            float s[8] = {0.f, 0.f, 0.f, 0.f, 0.f, 0.f, 0.f, 0.f};
            for (int tt = lo; tt < hi; ++tt) { const u32x4 raw = *(const u32x4*)(pr + (ptrdiff_t)(tt - t) * 1024 + c);
                s[0] += bflo(raw.x); s[1] += bfhi(raw.x); s[2] += bflo(raw.y); s[3] += bfhi(raw.y); s[4] += bflo(raw.z); s[5] += bfhi(raw.z); s[6] += bflo(raw.w); s[7] += bfhi(raw.w); }
            const float inv = 1.0f / (float)(hi - lo);
            const u32x4 own = *(const u32x4*)(pr + c);
            u32x4 o; o.x = pk2(s[0] * inv - bflo(own.x), s[1] * inv - bfhi(own.x)); o.y = pk2(s[2] * inv - bflo(own.y), s[3] * inv - bfhi(own.y));
            o.z = pk2(s[4] * inv - bflo(own.z), s[5] * inv - bfhi(own.z)); o.w = pk2(s[6] * inv - bflo(own.w), s[7] * inv - bfhi(own.w));
            *(u32x4*)(UA + (size_t)m * 1024 + c) = o; }
    }
}
__device__ __forceinline__ void post1_rows(const Params& p, int gw, int ngw, int lane) {
    const bf16_t* PR = (const bf16_t*)(p.ws + WS_PR);
    bf16_t* QC = (bf16_t*)(p.ws + WS_Q);
    const float* ropeC = (const float*)(p.ws + WS_ROPE) + 2 * 1024 * 64;
    float* new_c_k = p.out + (size_t)MT * DM + 2 * (size_t)NBP * HA * SEQP * 128; float* new_c_v = new_c_k + (size_t)NBP * KVH * SEQP * 128;
    for (int m = gw; m < MT; m += ngw) {
        const bool smp = m >= MP; const int b = smp ? (m - MP) >> 10 : m >> 8, t = smp ? (m - MP) & 1023 : m & 255;
        const bf16_t* pr = PR + (size_t)m * ODD_IN;
        const float* cosr = ropeC + (size_t)t * 128; const float* sinr = ropeC + 1024 * 128 + (size_t)t * 128;
        const int sub = lane >> 5, lg = lane & 31;
#pragma unroll 2
        for (int st = 0; st < 10; ++st) {
            const int grp = st * 2 + sub;
            const u32x2 raw = *(const u32x2*)(pr + grp * 128 + 4 * lg);
            f32x4 v = {bflo(raw.x), bfhi(raw.x), bflo(raw.y), bfhi(raw.y)};
            const bool isk = grp >= 16;
            f32x4 y = norm_rope4<128>(v, lg, isk ? p.gqa_k_norm_w : p.gqa_q_norm_w, smp, cosr, sinr);
            if (!isk) { y = y * C2C; u32x2 o; o.x = pk2(y[0], y[1]); o.y = pk2(y[2], y[3]); *(u32x2*)(QC + (size_t)m * DM + grp * 128 + 4 * lg) = o; }
            else { const int kh = grp - 16;
                u32x2 o; o.x = pk2(y[0], y[1]); o.y = pk2(y[2], y[3]);
                if (smp) *(u32x2*)((bf16_t*)(p.ws + WS_KSC) + ((size_t)(b * KVH + kh) * LKS + PAST + t) * 128 + 4 * lg) = o;
                else { const size_t off = ((size_t)(b * KVH + kh) * SEQP + t) * 128 + 4 * lg; *(u32x2*)((bf16_t*)(p.ws + WS_KP) + off) = o; *(f32x4*)(new_c_k + off) = y; } }
        }
        { const int c = 8 * lane, kh = c >> 7, d = c & 127;
            const u32x4 raw = *(const u32x4*)(pr + 2560 + c);
            if (smp) *(u32x4*)((bf16_t*)(p.ws + WS_VSC) + ((size_t)(b * KVH + kh) * LKS + PAST + t) * 128 + d) = raw;
            else { const size_t off = ((size_t)(b * KVH + kh) * SEQP + t) * 128 + d; *(u32x4*)((bf16_t*)(p.ws + WS_VP) + off) = raw;
                *(f32x4*)(new_c_v + off) = (f32x4){bflo(raw.x), bfhi(raw.x), bflo(raw.y), bfhi(raw.y)}; *(f32x4*)(new_c_v + off + 4) = (f32x4){bflo(raw.z), bfhi(raw.z), bflo(raw.w), bfhi(raw.w)}; } }
    }
}

struct EpiStoreBf16 { bf16_t* C; int ldc; int pad; __device__ void operator()(int r, int c, float v) const { C[(size_t)r * ldc + c] = (bf16_t)f2bf(v); } };
struct EpiPool { bf16_t* Y; const bf16_t* PR; const float* pscale; int g; int pad;
    __device__ void operator()(int r, int c, float v) const { const int cc = g * 256 + c; const float gt = bf2f(PR[(size_t)r * EVEN_IN + 4096 + 1024 + cc]);
        Y[(size_t)r * DM + 1024 + cc] = (bf16_t)f2bf(v * pscale[cc] * siluf(gt)); } };
struct EpiResid { const float* x_prompt; const float* x_sample; const float* base; const float* gate; float* out;
    __device__ void operator()(int r, int c, float v) const { const float bs = base ? base[(size_t)r * DM + c] : (r < MP ? x_prompt[(size_t)r * DM + c] : x_sample[(size_t)(r - MP) * DM + c]);
        out[(size_t)r * DM + c] = bs + gate[(size_t)cond_row(r) * 6144 + c] * v; } };
template <class Epi>
__global__ __launch_bounds__(256) void gemm_naive(const bf16_t* A, int lda, const bf16_t* Bt, int ldb, int M, int N, int K, Epi E) {
    __shared__ float As[16][65], Bs[16][65];
    const int tid = threadIdx.x, tx = tid & 15, ty = tid >> 4;
    const int nbn = N / 64, bm = blockIdx.x / nbn, bn = blockIdx.x % nbn;
    float acc[4][4] = {};
    const int lr = tid >> 2, lc = (tid & 3) * 4;
    for (int k0 = 0; k0 < K; k0 += 16) {
        const u32x2 ra = *(const u32x2*)(A + (size_t)(bm * 64 + lr) * lda + k0 + lc), rb = *(const u32x2*)(Bt + (size_t)(bn * 64 + lr) * ldb + k0 + lc);
        __syncthreads();
        As[lc + 0][lr] = bflo(ra.x); As[lc + 1][lr] = bfhi(ra.x); As[lc + 2][lr] = bflo(ra.y); As[lc + 3][lr] = bfhi(ra.y);
        Bs[lc + 0][lr] = bflo(rb.x); Bs[lc + 1][lr] = bfhi(rb.x); Bs[lc + 2][lr] = bflo(rb.y); Bs[lc + 3][lr] = bfhi(rb.y);
        __syncthreads();
#pragma unroll
        for (int kk = 0; kk < 16; ++kk) { float a[4], b[4];
#pragma unroll
            for (int i = 0; i < 4; ++i) { a[i] = As[kk][ty * 4 + i]; b[i] = Bs[kk][tx * 4 + i]; }
#pragma unroll
            for (int i = 0; i < 4; ++i)
#pragma unroll
                for (int j = 0; j < 4; ++j) acc[i][j] += a[i] * b[j]; }
    }
#pragma unroll
    for (int i = 0; i < 4; ++i)
#pragma unroll
        for (int j = 0; j < 4; ++j) E(bm * 64 + ty * 4 + i, bn * 64 + tx * 4 + j, acc[i][j]);
}

__device__ __forceinline__ void diffattn_tasks(const Params& p, float* s1  , long gw, long ngw, int lane) {
    float* s2 = s1 + LKS; float* qs = s2 + LKS;
    const bf16_t* QA = (const bf16_t*)(p.ws + WS_Q); const bf16_t* PR = (const bf16_t*)(p.ws + WS_PR); bf16_t* Y = (bf16_t*)(p.ws + WS_HY);
    const float lam_init = 0.2f;
    const float lam = expf(wave_sum(p.lam_q1[lane] * p.lam_k1[lane])) - expf(wave_sum(p.lam_q2[lane] * p.lam_k2[lane])) + lam_init;
    for (long task = gw; task < (long)MT * HA; task += ngw) {
        const int m = (int)(task / HA), h = (int)(task % HA);
        const bool smp = m >= MP; const int b = smp ? (m - MP) >> 10 : m >> 8; const int Lk = smp ? LKS : SEQP;
        const bf16_t* Kb = smp ? (const bf16_t*)(p.ws + WS_KSA) + (size_t)(b * HA + h) * LKS * 128 : (const bf16_t*)(p.ws + WS_KP) + (size_t)(b * HA + h) * SEQP * 128;
        const bf16_t* Vb = smp ? (const bf16_t*)(p.ws + WS_VSA) + (size_t)(b * HA + h) * LKS * 128 : (const bf16_t*)(p.ws + WS_VP) + (size_t)(b * HA + h) * SEQP * 128;
        { const unsigned w = *(const unsigned*)(QA + (size_t)m * 1024 + h * 128 + 2 * lane); qs[2 * lane] = bflo(w); qs[2 * lane + 1] = bfhi(w); }
        __builtin_amdgcn_s_waitcnt(0xc07f); asm volatile("" ::: "memory");
        float m1 = -1e30f, m2 = -1e30f;
        for (int j = lane; j < Lk; j += 64) { const bf16_t* kr = Kb + (size_t)j * 128; float a1 = 0.f, a2 = 0.f;
#pragma unroll
            for (int d8 = 0; d8 < 8; ++d8) { const u32x4 w1 = *(const u32x4*)(kr + d8 * 8), w2 = *(const u32x4*)(kr + 64 + d8 * 8); const float* q1 = qs + d8 * 8; const float* q2 = qs + 64 + d8 * 8;
                a1 += q1[0] * bflo(w1.x) + q1[1] * bfhi(w1.x) + q1[2] * bflo(w1.y) + q1[3] * bfhi(w1.y) + q1[4] * bflo(w1.z) + q1[5] * bfhi(w1.z) + q1[6] * bflo(w1.w) + q1[7] * bfhi(w1.w);
                a2 += q2[0] * bflo(w2.x) + q2[1] * bfhi(w2.x) + q2[2] * bflo(w2.y) + q2[3] * bfhi(w2.y) + q2[4] * bflo(w2.z) + q2[5] * bfhi(w2.z) + q2[6] * bflo(w2.w) + q2[7] * bfhi(w2.w); }
            s1[j] = a1; s2[j] = a2; m1 = fmaxf(m1, a1); m2 = fmaxf(m2, a2); }
        m1 = wave_max(m1); m2 = wave_max(m2);
        float l1 = 0.f, l2 = 0.f;
        for (int j = lane; j < Lk; j += 64) { const float e1 = exp2f(s1[j] - m1), e2 = exp2f(s2[j] - m2); s1[j] = e1; s2[j] = e2; l1 += e1; l2 += e2; }
        l1 = wave_sum(l1); l2 = wave_sum(l2);
        const float i1 = 1.f / l1, i2 = lam / l2;
        for (int j = lane; j < Lk; j += 64) s1[j] = s1[j] * i1 - s2[j] * i2;
        __builtin_amdgcn_s_waitcnt(0xc07f); asm volatile("" ::: "memory");
        float o0 = 0.f, o1 = 0.f;
        for (int j = 0; j < Lk; ++j) { const unsigned w = *(const unsigned*)(Vb + (size_t)j * 128 + 2 * lane); const float pj = s1[j]; o0 += pj * bflo(w); o1 += pj * bfhi(w); }
        const float r = 1.0f / sqrtf(wave_sum(o0 * o0 + o1 * o1) * (1.f / 128.f) + EPS);
        const unsigned gw = *(const unsigned*)(PR + (size_t)m * EVEN_IN + 4096 + h * 128 + 2 * lane);
        const float y0 = o0 * r * p.subln_w[2 * lane] * (1.f - lam_init) * siluf(bflo(gw)), y1 = o1 * r * p.subln_w[2 * lane + 1] * (1.f - lam_init) * siluf(bfhi(gw));
        *(unsigned*)(Y + (size_t)m * DM + h * 128 + 2 * lane) = pk2(y0, y1);
        __builtin_amdgcn_s_waitcnt(0xc07f); asm volatile("" ::: "memory");
    }
}
__device__ __forceinline__ void gqa_tasks(const Params& p, float* s1  , long gw, long ngw, int lane) {
    float* qs = s1 + LKS;
    const bf16_t* QC = (const bf16_t*)(p.ws + WS_Q); const bf16_t* PR = (const bf16_t*)(p.ws + WS_PR); bf16_t* Y = (bf16_t*)(p.ws + WS_HY);
    for (long task = gw; task < (long)MT * HC; task += ngw) {
        const int m = (int)(task / HC), hq = (int)(task % HC), kh = hq >> 2;
        const bool smp = m >= MP; const int b = smp ? (m - MP) >> 10 : m >> 8; const int Lk = smp ? LKS : SEQP;
        const bf16_t* Kb = smp ? (const bf16_t*)(p.ws + WS_KSC) + (size_t)(b * KVH + kh) * LKS * 128 : (const bf16_t*)(p.ws + WS_KP) + (size_t)(b * KVH + kh) * SEQP * 128;
        const bf16_t* Vb = smp ? (const bf16_t*)(p.ws + WS_VSC) + (size_t)(b * KVH + kh) * LKS * 128 : (const bf16_t*)(p.ws + WS_VP) + (size_t)(b * KVH + kh) * SEQP * 128;
        { const unsigned w = *(const unsigned*)(QC + (size_t)m * DM + hq * 128 + 2 * lane); qs[2 * lane] = bflo(w); qs[2 * lane + 1] = bfhi(w); }
        __builtin_amdgcn_s_waitcnt(0xc07f); asm volatile("" ::: "memory");
        float m1 = -1e30f;
        for (int j = lane; j < Lk; j += 64) { const bf16_t* kr = Kb + (size_t)j * 128; float a1 = 0.f;
#pragma unroll
            for (int d8 = 0; d8 < 16; ++d8) { const u32x4 w1 = *(const u32x4*)(kr + d8 * 8); const float* q1 = qs + d8 * 8;
                a1 += q1[0] * bflo(w1.x) + q1[1] * bfhi(w1.x) + q1[2] * bflo(w1.y) + q1[3] * bfhi(w1.y) + q1[4] * bflo(w1.z) + q1[5] * bfhi(w1.z) + q1[6] * bflo(w1.w) + q1[7] * bfhi(w1.w); }
            s1[j] = a1; m1 = fmaxf(m1, a1); }
        m1 = wave_max(m1);
        float l1 = 0.f;
        for (int j = lane; j < Lk; j += 64) { const float e1 = exp2f(s1[j] - m1); s1[j] = e1; l1 += e1; }
        l1 = wave_sum(l1);
        __builtin_amdgcn_s_waitcnt(0xc07f); asm volatile("" ::: "memory");
        float o0 = 0.f, o1 = 0.f;
        for (int j = 0; j < Lk; ++j) { const unsigned w = *(const unsigned*)(Vb + (size_t)j * 128 + 2 * lane); const float pj = s1[j]; o0 += pj * bflo(w); o1 += pj * bfhi(w); }
        const float il = 1.f / l1;
        const unsigned gw = *(const unsigned*)(PR + (size_t)m * ODD_IN + 3072 + hq * 128 + 2 * lane);
        *(unsigned*)(Y + (size_t)m * DM + hq * 128 + 2 * lane) = pk2(o0 * il * siluf(bflo(gw)), o1 * il * siluf(bfhi(gw)));
        __builtin_amdgcn_s_waitcnt(0xc07f); asm volatile("" ::: "memory");
    }
}

__global__ __launch_bounds__(256) void diffattn_naive(Params p) { __shared__ float sh[4][2 * LKS + 128]; diffattn_tasks(p, sh[threadIdx.x >> 6], (long)blockIdx.x * 4 + (threadIdx.x >> 6), (long)gridDim.x * 4, threadIdx.x & 63); }
__global__ __launch_bounds__(256) void gqa_naive(Params p) { __shared__ float sh[4][LKS + 128]; gqa_tasks(p, sh[threadIdx.x >> 6], (long)blockIdx.x * 4 + (threadIdx.x >> 6), (long)gridDim.x * 4, threadIdx.x & 63); }
__global__ __launch_bounds__(512) void k_prologue(Params p) {
    __shared__ float scr[8 * 2304];
    const int wid = threadIdx.x >> 6, lane = threadIdx.x & 63;
    mod_items(p, scr, blockIdx.x, gridDim.x, threadIdx.x, blockDim.x);
    __syncthreads();
    weights_items(p, scr + wid * 2304, blockIdx.x * 8 + wid, gridDim.x * 8, lane);
    caches_rope_items(p, (long)blockIdx.x * 512 + threadIdx.x, (long)gridDim.x * 512);
}
__global__ __launch_bounds__(512) void k_modulate(Params p, int layer) { modulate_rows(p, layer, blockIdx.x * 8 + (threadIdx.x >> 6), gridDim.x * 8, threadIdx.x & 63); }
__global__ __launch_bounds__(512) void k_post0(Params p) { post0_rows(p, blockIdx.x * 8 + (threadIdx.x >> 6), gridDim.x * 8, threadIdx.x & 63); }
__global__ __launch_bounds__(512) void k_post1(Params p) { post1_rows(p, blockIdx.x * 8 + (threadIdx.x >> 6), gridDim.x * 8, threadIdx.x & 63); }


namespace pg8 {
#define PG8_LAS __attribute__((address_space(3)))
typedef short bf16x8 __attribute__((ext_vector_type(8)));
constexpr int BM = 256, BK = 64, HALF = 128, HTB = HALF * BK * 2  , STAGE_BYTES = 8 * HTB, NXCD = 8, WGM = 8;
__host__ __device__ __forceinline__ int lds_byte(int r, int c) { const int st = (r >> 4) * 2 + (c >> 5), rr = r & 15, cc = c & 31, ob = rr * 64 + cc * 2; return st * 1024 + (ob ^ (((ob >> 9) & 1) << 5)); }
__host__ __device__ __forceinline__ void stage_rc(int b, int& R, int& C) { const int st = b / 1024, sb = b % 1024, swz = sb ^ (((sb >> 9) & 1) << 5); R = (st >> 1) * 16 + swz / 64; C = (st & 1) * 32 + (swz % 64) / 2; }
__host__ __device__ __forceinline__ int perm32(int rho) { const int n = rho >> 4, i = rho & 15; return 8 * (i >> 2) + 4 * n + (i & 3); }
struct Unit { int pm, pn, kt0, nkt, slab; };
struct Gemm { const bf16_t* A; const bf16_t* Bt; int M, N, K, lda, ldb, a_pn_off, b_pm_off, pad; };
struct StaticOrder {
    int nM, nN, nwg, G, c, KT, nfull, split;
    __host__ __device__ void init(int M, int N, int K, int G_, int c_, bool allow_split) { nM = M / BM; nN = N / BM; nwg = nM * nN; G = G_; c = c_; KT = K / BK;
        const int rem = nwg % G; split = (allow_split && rem && G % rem == 0 && (G % 8) == 0 && ((G / 8) % (G / rem)) == 0 && (KT % (2 * (G / rem))) == 0) ? G / rem : 1; nfull = split > 1 ? nwg - rem : nwg; }
    __host__ __device__ void tile(int wgid, Unit& u) const { const int nig = WGM * nN, gid = wgid / nig, fm = gid * WGM, gsz = (nM - fm) < WGM ? (nM - fm) : WGM; u.pm = fm + ((wgid % nig) % gsz); u.pn = (wgid % nig) / gsz; }
    __host__ __device__ bool next(int i, Unit& u) const {
        const long L = (long)i * G + c;
        if (L < nfull) { int wgid = (int)L; { const int q = nfull / NXCD, r = nfull % NXCD, xcd = wgid % NXCD, off = wgid / NXCD; wgid = (xcd < r ? xcd * (q + 1) : r * (q + 1) + (xcd - r) * q) + off; }
            tile(wgid, u); u.kt0 = 0; u.nkt = KT; u.slab = -1; return true; }
        if (split > 1 && L < nfull + G) { const int xcd = c % 8, q = c / 8, ks = q % split, j = (q / split) * 8 + xcd;
            tile(nfull + j, u); u.nkt = KT / split; u.kt0 = ks * u.nkt; u.slab = j * split + ks; return true; }
        return false;
    }
    __device__ __forceinline__ void a_ready(const Unit&) const {}
    __device__ __forceinline__ void done(const Unit&) const {}
};
__device__ __forceinline__ unsigned cvt_pk_bf16(float lo, float hi) { unsigned r; asm volatile("v_cvt_pk_bf16_f32 %0, %1, %2" : "=v"(r) : "v"(lo), "v"(hi)); return r; }
__device__ __forceinline__ void slab_store(const f32x4 (&acc)[2][2][4][2], float* slabs, const Unit& u, int wr, int wc, int fr, int fq) {
    float* sp = slabs + (size_t)u.slab * 65536 + (size_t)(wr * 64 + fr) * 256 + wc * 32 + 8 * fq;
#pragma unroll
    for (int ai = 0; ai < 2; ++ai)
#pragma unroll
        for (int m = 0; m < 4; ++m)
#pragma unroll
            for (int bj = 0; bj < 2; ++bj) { float* q = sp + (size_t)(ai * HALF + m * 16) * 256 + bj * HALF; *(f32x4*)q = acc[ai][bj][m][0]; *(f32x4*)(q + 4) = acc[ai][bj][m][1]; }
}
struct EpiBf16 {
    static constexpr bool PERM = true, AFTER_DRAIN = false;
    bf16_t* O; int ldc; int pad;
    __device__ __forceinline__ void operator()(const f32x4 (&acc)[2][2][4][2], const Unit& u, int wr, int wc, int fr, int fq) const {
        asm volatile("" : "+v"(fr), "+v"(fq));
        const int row0 = u.pm * BM + wr * 64 + fr, col0 = u.pn * BM + wc * 32 + 8 * fq;
#pragma unroll
        for (int ai = 0; ai < 2; ++ai)
#pragma unroll
            for (int m = 0; m < 4; ++m) { bf16_t* rowp = O + (size_t)(row0 + ai * HALF + m * 16) * ldc + col0;
#pragma unroll
                for (int bj = 0; bj < 2; ++bj) { const f32x4 v0 = acc[ai][bj][m][0], v1 = acc[ai][bj][m][1];
                    u32x4 w; w.x = cvt_pk_bf16(v0[0], v0[1]); w.y = cvt_pk_bf16(v0[2], v0[3]); w.z = cvt_pk_bf16(v1[0], v1[1]); w.w = cvt_pk_bf16(v1[2], v1[3]);
                    *(u32x4*)(rowp + bj * HALF) = w; } }
    }
};
struct EpiPoolF {
    static constexpr bool PERM = true, AFTER_DRAIN = false;
    bf16_t* Y; const bf16_t* SG; const float* pscale;
    __device__ __forceinline__ void operator()(const f32x4 (&acc)[2][2][4][2], const Unit& u, int wr, int wc, int fr, int fq) const {
        asm volatile("" : "+v"(fr), "+v"(fq));
        const int row0 = u.pm * BM + wr * 64 + fr, col0 = u.pn * BM + wc * 32 + 8 * fq;
        f32x4 ps[2][2];
#pragma unroll
        for (int bj = 0; bj < 2; ++bj) { ps[bj][0] = *(const f32x4*)(pscale + col0 + bj * HALF); ps[bj][1] = *(const f32x4*)(pscale + col0 + bj * HALF + 4); }
#pragma unroll
        for (int ai = 0; ai < 2; ++ai)
#pragma unroll
            for (int m = 0; m < 4; ++m) { const size_t r = (size_t)(row0 + ai * HALF + m * 16);
#pragma unroll
                for (int bj = 0; bj < 2; ++bj) { const int c = col0 + bj * HALF;
                    const u32x4 g = *(const u32x4*)(SG + r * DM + 1024 + c);
                    const f32x4 v0 = acc[ai][bj][m][0] * ps[bj][0], v1 = acc[ai][bj][m][1] * ps[bj][1];
                    u32x4 w; w.x = cvt_pk_bf16(v0[0] * bflo(g.x), v0[1] * bfhi(g.x)); w.y = cvt_pk_bf16(v0[2] * bflo(g.y), v0[3] * bfhi(g.y));
                    w.z = cvt_pk_bf16(v1[0] * bflo(g.z), v1[1] * bfhi(g.z)); w.w = cvt_pk_bf16(v1[2] * bflo(g.w), v1[3] * bfhi(g.w));
                    *(u32x4*)(Y + r * DM + 1024 + c) = w; } }
    }
};
struct EpiProj0 {
    static constexpr bool PERM = true, AFTER_DRAIN = false;
    unsigned char* ws; const float* qw; const float* kw; float* nak; float* nav;
    __device__ __forceinline__ void operator()(const f32x4 (&acc)[2][2][4][2], const Unit& u, int wr, int wc, int fr, int fq) const {
        asm volatile("" : "+v"(fr), "+v"(fq));
        const int pm = u.pm, pn = u.pn;
        const bool smp = pm >= 32; const int b = smp ? (pm - 32) >> 2 : pm, tb = (smp ? ((pm - 32) & 3) * 256 : 0) + wr * 64 + fr;
        const size_t rowb = (size_t)pm * 256 + wr * 64 + fr;
        if (pn < 8) {
            const bool isk = pn >= 4; const int hl = wc >> 1, j = wc & 1, h = (pn & 3) * 2 + hl, dim_a = 8 * fq + 16 * (fq >> 1);
            const float* w = isk ? kw : qw;
            f32x4 wv[2][2];
#pragma unroll
            for (int bj = 0; bj < 2; ++bj)
#pragma unroll
                for (int n = 0; n < 2; ++n) wv[bj][n] = *(const f32x4*)(w + dim_a + 16 * bj + 4 * n);
            const float* ropeA = (const float*)(ws + WS_ROPE);
#pragma unroll
            for (int ai = 0; ai < 2; ++ai)
#pragma unroll
                for (int m = 0; m < 4; ++m) { const int t = tb + ai * 128 + m * 16; const size_t row = rowb + ai * 128 + m * 16;
                    float ss = 0.f;
#pragma unroll
                    for (int bj = 0; bj < 2; ++bj)
#pragma unroll
                        for (int n = 0; n < 2; ++n) { const f32x4 x = acc[ai][bj][m][n]; ss += (x[0] * x[0] + x[1] * x[1]) + (x[2] * x[2] + x[3] * x[3]); }
                    ss += __shfl_xor(ss, 16); ss += __shfl_xor(ss, 32);
                    const float rinv = 1.0f / sqrtf(ss * (1.f / 64.f) + EPS);
                    f32x4 y[2][2];
#pragma unroll
                    for (int bj = 0; bj < 2; ++bj)
#pragma unroll
                        for (int n = 0; n < 2; ++n) y[bj][n] = acc[ai][bj][m][n] * rinv * wv[bj][n];
                    if (smp) {
#pragma unroll
                        for (int n = 0; n < 2; ++n) { const f32x4 cs = *(const f32x4*)(ropeA + (size_t)t * 64 + dim_a + 4 * n), sn = *(const f32x4*)(ropeA + 1024 * 64 + (size_t)t * 64 + dim_a + 4 * n);
                            const f32x4 a = y[0][n], bb = y[1][n]; y[0][n] = a * cs - bb * sn; y[1][n] = bb * cs + a * sn; } }
                    if (!isk) { bf16_t* qp = (bf16_t*)(ws + WS_Q) + row * 1024 + pn * 256 + wc * 64 + dim_a;
#pragma unroll
                        for (int bj = 0; bj < 2; ++bj) { const f32x4 v0 = y[bj][0] * C2A, v1 = y[bj][1] * C2A;
                            u32x4 o; o.x = cvt_pk_bf16(v0[0], v0[1]); o.y = cvt_pk_bf16(v0[2], v0[3]); o.z = cvt_pk_bf16(v1[0], v1[1]); o.w = cvt_pk_bf16(v1[2], v1[3]);
                            *(u32x4*)(qp + 16 * bj) = o; } }
                    else { const int hh = (pn - 4) * 2 + hl;
                        const size_t koff = (smp ? ((size_t)(b * HA + hh) * LKS + PAST + t) * 128 : ((size_t)(b * HA + hh) * SEQP + t) * 128) + j * 64 + dim_a;
                        bf16_t* kp = (bf16_t*)(ws + (smp ? WS_KSA : WS_KP)) + koff;
#pragma unroll
                        for (int bj = 0; bj < 2; ++bj) { const f32x4 v0 = y[bj][0], v1 = y[bj][1];
                            u32x4 o; o.x = cvt_pk_bf16(v0[0], v0[1]); o.y = cvt_pk_bf16(v0[2], v0[3]); o.z = cvt_pk_bf16(v1[0], v1[1]); o.w = cvt_pk_bf16(v1[2], v1[3]);
                            *(u32x4*)(kp + 16 * bj) = o;
                            if (!smp) { float* fp = nak + koff + 16 * bj; *(f32x4*)fp = v0; *(f32x4*)(fp + 4) = v1; } } }
                }
        } else if (pn < 12) {
#pragma unroll
            for (int ai = 0; ai < 2; ++ai)
#pragma unroll
                for (int m = 0; m < 4; ++m) { const int t = tb + ai * 128 + m * 16;
#pragma unroll
                    for (int bj = 0; bj < 2; ++bj) { const int hh = (pn - 8) * 2 + bj, d = 32 * wc + 8 * fq;
                        const size_t voff = (smp ? ((size_t)(b * HA + hh) * LKS + PAST + t) * 128 : ((size_t)(b * HA + hh) * SEQP + t) * 128) + d;
                        const f32x4 v0 = acc[ai][bj][m][0], v1 = acc[ai][bj][m][1];
                        u32x4 o; o.x = cvt_pk_bf16(v0[0], v0[1]); o.y = cvt_pk_bf16(v0[2], v0[3]); o.z = cvt_pk_bf16(v1[0], v1[1]); o.w = cvt_pk_bf16(v1[2], v1[3]);
                        *(u32x4*)((bf16_t*)(ws + (smp ? WS_VSA : WS_VP)) + voff) = o;
                        if (!smp) { *(f32x4*)(nav + voff) = v0; *(f32x4*)(nav + voff + 4) = v1; } } }
        } else if (pn < 16) {
            bf16_t* up = (bf16_t*)(ws + WS_U) + (pn - 12) * 256 + 32 * wc + 8 * fq;
#pragma unroll
            for (int ai = 0; ai < 2; ++ai)
#pragma unroll
                for (int m = 0; m < 4; ++m) { const size_t row = rowb + ai * 128 + m * 16;
#pragma unroll
                    for (int bj = 0; bj < 2; ++bj) { const f32x4 v0 = acc[ai][bj][m][0], v1 = acc[ai][bj][m][1];
                        u32x4 o; o.x = cvt_pk_bf16(v0[0], v0[1]); o.y = cvt_pk_bf16(v0[2], v0[3]); o.z = cvt_pk_bf16(v1[0], v1[1]); o.w = cvt_pk_bf16(v1[2], v1[3]);
                        *(u32x4*)(up + row * 1024 + bj * HALF) = o; } }
        } else {
            bf16_t* sg = (bf16_t*)(ws + WS_SG) + (pn - 16) * 256 + 32 * wc + 8 * fq;
#pragma unroll
            for (int ai = 0; ai < 2; ++ai)
#pragma unroll
                for (int m = 0; m < 4; ++m) { const size_t row = rowb + ai * 128 + m * 16;
#pragma unroll
                    for (int bj = 0; bj < 2; ++bj) { const f32x4 v0 = acc[ai][bj][m][0], v1 = acc[ai][bj][m][1];
                        u32x4 o; o.x = cvt_pk_bf16(siluf(v0[0]), siluf(v0[1])); o.y = cvt_pk_bf16(siluf(v0[2]), siluf(v0[3])); o.z = cvt_pk_bf16(siluf(v1[0]), siluf(v1[1])); o.w = cvt_pk_bf16(siluf(v1[2]), siluf(v1[3]));
                        *(u32x4*)(sg + row * DM + bj * HALF) = o; } }
        }
    }
};
struct EpiProj1 {
    static constexpr bool PERM = true, AFTER_DRAIN = false;
    unsigned char* ws; const float* qw; const float* kw; float* nck; float* ncv; PG8_LAS float* xs; float* slabs;
    __device__ __forceinline__ void operator()(const f32x4 (&acc0)[2][2][4][2], const Unit& u, int wr, int wc, int fr, int fq) const {
        asm volatile("" : "+v"(fr), "+v"(fq));
        if (u.slab >= 0) { slab_store(acc0, slabs, u, wr, wc, fr, fq); return; }
        const int pm = u.pm, pn = u.pn;
        float rstd[2][4]; f32x4 bv[2][2];
        { const int cr = pm < 32 ? 0 : 1 + ((pm - 32) >> 2);
          const float* b2 = (const float*)(ws + WS_B2P) + (size_t)cr * ODD_IN + pn * 256 + 32 * wc + 8 * fq; const float* rss = (const float*)(ws + WS_RSS) + (size_t)pm * 256 + wr * 64 + fr;
#pragma unroll
          for (int bj = 0; bj < 2; ++bj)
#pragma unroll
              for (int n = 0; n < 2; ++n) bv[bj][n] = *(const f32x4*)(b2 + bj * HALF + n * 4);
#pragma unroll
          for (int ai = 0; ai < 2; ++ai)
#pragma unroll
              for (int m = 0; m < 4; ++m) rstd[ai][m] = __builtin_amdgcn_rsqf(rss[ai * 128 + m * 16] * (1.f / DM) + EPS); }
#define VV(ai, bj, m, n) (acc0[ai][bj][m][n] * rstd[ai][m] + bv[bj][n])
        const bool smp = pm >= 32; const int b = smp ? (pm - 32) >> 2 : pm, tb = (smp ? ((pm - 32) & 3) * 256 : 0) + wr * 64 + fr;
        const size_t rowb = (size_t)pm * 256 + wr * 64 + fr;
        if (pn < 10) {
            const bool isk = pn >= 8; const int hl = wc >> 1, w1 = wc & 1, head = (isk ? (pn - 8) : pn) * 2 + hl;
            const float* w = isk ? kw : qw;
            f32x4 wv[2][2];
#pragma unroll
            for (int bj = 0; bj < 2; ++bj)
#pragma unroll
                for (int n = 0; n < 2; ++n) wv[bj][n] = *(const f32x4*)(w + (2 * w1 + bj) * 32 + 8 * fq + 4 * n);
            PG8_LAS float* xo = xs + (wr * 4 + wc) * 128; PG8_LAS float* xp = xs + (wr * 4 + (wc ^ 1)) * 128;
#pragma unroll
            for (int ai = 0; ai < 2; ++ai)
#pragma unroll
                for (int m = 0; m < 4; ++m) { float ss = 0.f;
#pragma unroll
                    for (int bj = 0; bj < 2; ++bj)
#pragma unroll
                        for (int n = 0; n < 2; ++n) { const f32x4 x = VV(ai, bj, m, n); ss += (x[0] * x[0] + x[1] * x[1]) + (x[2] * x[2] + x[3] * x[3]); }
                    ss += __shfl_xor(ss, 16); ss += __shfl_xor(ss, 32);
                    if (fq == 0) xo[ai * 64 + m * 16 + fr] = ss; }
            asm volatile("s_waitcnt lgkmcnt(0)" ::: "memory"); __builtin_amdgcn_s_barrier(); asm volatile("" ::: "memory");
            const float* ropeC = (const float*)(ws + WS_ROPE) + 2 * 1024 * 64;
#pragma unroll
            for (int ai = 0; ai < 2; ++ai)
#pragma unroll
                for (int m = 0; m < 4; ++m) { const int idx = ai * 64 + m * 16 + fr, t = tb + ai * 128 + m * 16; const size_t row = rowb + ai * 128 + m * 16;
                    const float rinv = __builtin_amdgcn_rsqf((xo[idx] + xp[idx]) * (1.f / 128.f) + EPS);
                    float r2 = rstd[ai][m]; asm volatile("" : "+v"(r2));
                    f32x4 y[2][2];
#pragma unroll
                    for (int bj = 0; bj < 2; ++bj)
#pragma unroll
                        for (int n = 0; n < 2; ++n) y[bj][n] = (acc0[ai][bj][m][n] * r2 + bv[bj][n]) * rinv * wv[bj][n];
                    if (smp) {
#pragma unroll
                        for (int n = 0; n < 2; ++n) { const f32x4 cs = *(const f32x4*)(ropeC + (size_t)t * 128 + 64 * w1 + 8 * fq + 4 * n), sn = *(const f32x4*)(ropeC + 1024 * 128 + (size_t)t * 128 + 64 * w1 + 8 * fq + 4 * n);
                            const f32x4 a = y[0][n], bb = y[1][n]; y[0][n] = a * cs - bb * sn; y[1][n] = bb * cs + a * sn; } }
                    if (!isk) { bf16_t* qp = (bf16_t*)(ws + WS_Q) + row * DM + head * 128 + 8 * fq;
#pragma unroll
                        for (int bj = 0; bj < 2; ++bj) { const f32x4 v0 = y[bj][0] * C2C, v1 = y[bj][1] * C2C;
                            u32x4 o; o.x = cvt_pk_bf16(v0[0], v0[1]); o.y = cvt_pk_bf16(v0[2], v0[3]); o.z = cvt_pk_bf16(v1[0], v1[1]); o.w = cvt_pk_bf16(v1[2], v1[3]);
                            *(u32x4*)(qp + (2 * w1 + bj) * 32) = o; } }
                    else { const size_t koff = smp ? ((size_t)(b * KVH + head) * LKS + PAST + t) * 128 : ((size_t)(b * KVH + head) * SEQP + t) * 128;
                        bf16_t* kp = (bf16_t*)(ws + (smp ? WS_KSC : WS_KP)) + koff + 8 * fq;
#pragma unroll
                        for (int bj = 0; bj < 2; ++bj) { const f32x4 v0 = y[bj][0], v1 = y[bj][1];
                            u32x4 o; o.x = cvt_pk_bf16(v0[0], v0[1]); o.y = cvt_pk_bf16(v0[2], v0[3]); o.z = cvt_pk_bf16(v1[0], v1[1]); o.w = cvt_pk_bf16(v1[2], v1[3]);
                            *(u32x4*)(kp + (2 * w1 + bj) * 32) = o;
                            if (!smp) { float* fp = nck + koff + 8 * fq + (2 * w1 + bj) * 32; *(f32x4*)fp = v0; *(f32x4*)(fp + 4) = v1; } } }
                }
        } else if (pn < 12) {
#pragma unroll
            for (int ai = 0; ai < 2; ++ai)
#pragma unroll
                for (int m = 0; m < 4; ++m) { const int t = tb + ai * 128 + m * 16;
#pragma unroll
                    for (int bj = 0; bj < 2; ++bj) { const int kvh = (pn - 10) * 2 + bj, d = 32 * wc + 8 * fq;
                        const size_t voff = (smp ? ((size_t)(b * KVH + kvh) * LKS + PAST + t) * 128 : ((size_t)(b * KVH + kvh) * SEQP + t) * 128) + d;
                        const f32x4 v0 = VV(ai, bj, m, 0), v1 = VV(ai, bj, m, 1);
                        u32x4 o; o.x = cvt_pk_bf16(v0[0], v0[1]); o.y = cvt_pk_bf16(v0[2], v0[3]); o.z = cvt_pk_bf16(v1[0], v1[1]); o.w = cvt_pk_bf16(v1[2], v1[3]);
                        *(u32x4*)((bf16_t*)(ws + (smp ? WS_VSC : WS_VP)) + voff) = o;
                        if (!smp) { *(f32x4*)(ncv + voff) = v0; *(f32x4*)(ncv + voff + 4) = v1; } } }
        } else {
            bf16_t* sg = (bf16_t*)(ws + WS_SG) + (pn - 12) * 256 + 32 * wc + 8 * fq;
#pragma unroll
            for (int ai = 0; ai < 2; ++ai)
#pragma unroll
                for (int m = 0; m < 4; ++m) { const size_t row = rowb + ai * 128 + m * 16;
#pragma unroll
                    for (int bj = 0; bj < 2; ++bj) { const f32x4 v0 = VV(ai, bj, m, 0), v1 = VV(ai, bj, m, 1);
                        u32x4 o; o.x = cvt_pk_bf16(siluf(v0[0]), siluf(v0[1])); o.y = cvt_pk_bf16(siluf(v0[2]), siluf(v0[3])); o.z = cvt_pk_bf16(siluf(v1[0]), siluf(v1[1])); o.w = cvt_pk_bf16(siluf(v1[2]), siluf(v1[3]));
                        *(u32x4*)(sg + row * DM + bj * HALF) = o; } }
        }
    }
};
#undef VV
struct EpiResid0 {
    static constexpr bool PERM = true, AFTER_DRAIN = false;
    const float* xp; const float* xs; const float* gate; const float* cw1; float* out; bf16_t* H1; float* rowss; float* slabs;
    __device__ __forceinline__ void operator()(const f32x4 (&acc)[2][2][4][2], const Unit& u, int wr, int wc, int fr, int fq) const {
        asm volatile("" : "+v"(fr), "+v"(fq));
        if (u.slab >= 0) { slab_store(acc, slabs, u, wr, wc, fr, fq); return; }
        const int row0 = u.pm * BM + wr * 64 + fr, col0 = u.pn * BM + wc * 32 + 8 * fq;
        const int cr = u.pm < 32 ? 0 : 1 + ((u.pm - 32) >> 2);
        f32x4 gv[2][2], cv[2][2];
#pragma unroll
        for (int bj = 0; bj < 2; ++bj)
#pragma unroll
            for (int n = 0; n < 2; ++n) { gv[bj][n] = *(const f32x4*)(gate + (size_t)cr * 6144 + col0 + bj * HALF + n * 4); cv[bj][n] = *(const f32x4*)(cw1 + (size_t)cr * DM + col0 + bj * HALF + n * 4); }
#pragma unroll
        for (int ai = 0; ai < 2; ++ai)
#pragma unroll
            for (int m = 0; m < 4; ++m) { const int r = row0 + ai * HALF + m * 16;
                const float* bp = (r < MP ? xp + (size_t)r * DM : xs + (size_t)(r - MP) * DM) + col0; float* op = out + (size_t)r * DM + col0; bf16_t* hp = H1 + (size_t)r * DM + col0;
                float ss = 0.f;
#pragma unroll
                for (int bj = 0; bj < 2; ++bj) { const f32x4 y0 = *(const f32x4*)(bp + bj * HALF) + gv[bj][0] * acc[ai][bj][m][0], y1 = *(const f32x4*)(bp + bj * HALF + 4) + gv[bj][1] * acc[ai][bj][m][1];
                    *(f32x4*)(op + bj * HALF) = y0; *(f32x4*)(op + bj * HALF + 4) = y1;
                    ss += (y0[0] * y0[0] + y0[1] * y0[1]) + (y0[2] * y0[2] + y0[3] * y0[3]) + (y1[0] * y1[0] + y1[1] * y1[1]) + (y1[2] * y1[2] + y1[3] * y1[3]);
                    const f32x4 h0 = y0 * cv[bj][0], h1 = y1 * cv[bj][1];
                    u32x4 o; o.x = cvt_pk_bf16(h0[0], h0[1]); o.y = cvt_pk_bf16(h0[2], h0[3]); o.z = cvt_pk_bf16(h1[0], h1[1]); o.w = cvt_pk_bf16(h1[2], h1[3]);
                    *(u32x4*)(hp + bj * HALF) = o; }
                ss += __shfl_xor(ss, 16); ss += __shfl_xor(ss, 32);
                if (fq == 0) atomicAdd(rowss + r, ss);
                if (m & 1) asm volatile("" ::: "memory"); }
    }
};
struct EpiResidF {
    static constexpr bool PERM = true, AFTER_DRAIN = false;
    const float* xp; const float* xs; const float* base; const float* gate; float* out; float* slabs;
    __device__ __forceinline__ void operator()(const f32x4 (&acc)[2][2][4][2], const Unit& u, int wr, int wc, int fr, int fq) const {
        asm volatile("" : "+v"(fr), "+v"(fq));
        if (u.slab >= 0) { slab_store(acc, slabs, u, wr, wc, fr, fq); return; }
        const int row0 = u.pm * BM + wr * 64 + fr, col0 = u.pn * BM + wc * 32 + 8 * fq;
        const int cr = u.pm < 32 ? 0 : 1 + ((u.pm - 32) >> 2);
        f32x4 gv[2][2];
#pragma unroll
        for (int bj = 0; bj < 2; ++bj)
#pragma unroll
            for (int n = 0; n < 2; ++n) gv[bj][n] = *(const f32x4*)(gate + (size_t)cr * 6144 + col0 + bj * HALF + n * 4);
#pragma unroll
        for (int ai = 0; ai < 2; ++ai)
#pragma unroll
            for (int m = 0; m < 4; ++m) { const int r = row0 + ai * HALF + m * 16;
                const float* bp = (base ? base + (size_t)r * DM : (r < MP ? xp + (size_t)r * DM : xs + (size_t)(r - MP) * DM)) + col0; float* op = out + (size_t)r * DM + col0;
#pragma unroll
                for (int bj = 0; bj < 2; ++bj)
#pragma unroll
                    for (int n = 0; n < 2; ++n) { const f32x4 b = *(const f32x4*)(bp + bj * HALF + n * 4); *(f32x4*)(op + bj * HALF + n * 4) = b + gv[bj][n] * acc[ai][bj][m][n]; }
                if (m & 1) asm volatile("" ::: "memory"); }
    }
};

template <class Epi, class Sched, bool ALIGN_EPI = false, bool SP2 = false>
__device__ __forceinline__ void gemm_phase(PG8_LAS unsigned char* lds, const Gemm g, const Sched& S, const Epi& E, const int tid) {
    const int wid = __builtin_amdgcn_readfirstlane(tid >> 6), lane = tid & 63, wr = wid >> 2, wc = wid & 3, fr = lane & 15, fq = lane >> 4;
    unsigned voffA[2], voffB[2];
#pragma unroll
    for (int i = 0; i < 2; ++i) { int R, C; stage_rc(tid * 16 + i * 8192, R, C); const int Rb = Epi::PERM ? ((R & ~31) + perm32(R & 31)) : R;
        voffA[i] = (unsigned)(R * g.lda + C) * 2u; voffB[i] = (unsigned)(Rb * g.ldb + C) * 2u; }
    const size_t kstep = (size_t)(BK * 2);
    const size_t hstepA = (size_t)HALF * g.lda * 2, hstepB = (size_t)HALF * g.ldb * 2;
    const size_t tstepA = 2 * hstepA, tstepB = 2 * hstepB;
    const unsigned ldsw = (unsigned)wid * 1024u;
    const int aoff = lds_byte(wr * 64 + fr, fq * 8), boff = lds_byte(wc * 32 + fr, fq * 8);
#define PG8_SA(b, h) (((b) * 2 + (h)) * HTB)
#define PG8_SB(b, h) ((4 + (b) * 2 + (h)) * HTB)
#define PG8_STAGE(bufoff, gbase, voff) do { _Pragma("unroll") for (int _i = 0; _i < 2; ++_i) \
        __builtin_amdgcn_global_load_lds((const unsigned*)((const char*)(gbase) + (voff)[_i]), (PG8_LAS unsigned*)(lds + (bufoff) + ldsw + _i * 8192), 16, 0, 0); } while (0)
#define PG8_LDA(dst, b, h) do { _Pragma("unroll") for (int m = 0; m < 4; ++m) _Pragma("unroll") for (int k = 0; k < 2; ++k) dst[m][k] = *(const PG8_LAS bf16x8*)(lds + PG8_SA(b, h) + aoff + m * 2048 + k * 1024); } while (0)
#define PG8_LDB(dst, b, h) do { _Pragma("unroll") for (int n = 0; n < 2; ++n) _Pragma("unroll") for (int k = 0; k < 2; ++k) dst[n][k] = *(const PG8_LAS bf16x8*)(lds + PG8_SB(b, h) + boff + n * 2048 + k * 1024); } while (0)
#define PG8_MMA(ai, bj, At, Bt) do { __builtin_amdgcn_s_setprio(1); _Pragma("unroll") for (int m = 0; m < 4; ++m) _Pragma("unroll") for (int n = 0; n < 2; ++n) _Pragma("unroll") for (int k = 0; k < 2; ++k) \
        acc[ai][bj][m][n] = __builtin_amdgcn_mfma_f32_16x16x32_bf16(Bt[n][k], At[m][k], acc[ai][bj][m][n], 0, 0, 0); __builtin_amdgcn_s_setprio(0); } while (0)
#define PG8_WAIT_V(n) asm volatile("s_waitcnt vmcnt(" #n ")" ::: "memory")
#define PG8_WAIT_L(n) asm volatile("s_waitcnt lgkmcnt(" #n ")" ::: "memory")
#define PG8_BAR __builtin_amdgcn_s_barrier()
#define PG8_SCHED __builtin_amdgcn_sched_barrier(0)
    Unit cur, nxt; int ui = 0;
    if (!S.next(0, cur)) return;
    f32x4 acc[2][2][4][2];
#pragma unroll
    for (int a = 0; a < 2; ++a)
#pragma unroll
        for (int b = 0; b < 2; ++b)
#pragma unroll
            for (int m = 0; m < 4; ++m)
#pragma unroll
                for (int n = 0; n < 2; ++n) acc[a][b][m][n] = (f32x4){0.f, 0.f, 0.f, 0.f};
    bf16x8 At[4][2], B0[2][2], B1[2][2];
    const char* cA = (const char*)g.A + (size_t)cur.pm * tstepA + (size_t)cur.pn * g.a_pn_off * 2 + (size_t)cur.kt0 * kstep; const char* cB = (const char*)g.Bt + (size_t)cur.pn * tstepB + (size_t)cur.pm * g.b_pm_off * 2 + (size_t)cur.kt0 * kstep;
    S.a_ready(cur);
    if constexpr (SP2) {
        PG8_STAGE(PG8_SB(0, 0), cB, voffB); PG8_STAGE(PG8_SB(0, 1), cB + hstepB, voffB); PG8_STAGE(PG8_SA(0, 0), cA, voffA); PG8_STAGE(PG8_SA(0, 1), cA + hstepA, voffA);
        if (wr == 1) PG8_BAR;
        PG8_WAIT_V(2); PG8_BAR;
        PG8_STAGE(PG8_SB(1, 0), cB + kstep, voffB); PG8_STAGE(PG8_SA(1, 0), cA + kstep, voffA); PG8_STAGE(PG8_SB(1, 1), cB + hstepB + kstep, voffB);
        PG8_WAIT_V(6); PG8_BAR;
    } else {
        PG8_STAGE(PG8_SB(0, 0), cB, voffB); PG8_STAGE(PG8_SA(0, 0), cA, voffA); PG8_STAGE(PG8_SB(0, 1), cB + hstepB, voffB); PG8_STAGE(PG8_SA(0, 1), cA + hstepA, voffA);
        if (wr == 1) PG8_BAR;
        PG8_WAIT_V(4); PG8_BAR;
        PG8_STAGE(PG8_SB(1, 0), cB + kstep, voffB); PG8_STAGE(PG8_SA(1, 0), cA + kstep, voffA); PG8_STAGE(PG8_SB(1, 1), cB + hstepB + kstep, voffB);
        PG8_WAIT_V(6); PG8_BAR;
    }
    for (;;) {
        const bool has_next = S.next(ui + 1, nxt);
        const char* nA = has_next ? (const char*)g.A + (size_t)nxt.pm * tstepA + (size_t)nxt.pn * g.a_pn_off * 2 + (size_t)nxt.kt0 * kstep : cA; const char* nB = has_next ? (const char*)g.Bt + (size_t)nxt.pn * tstepB + (size_t)nxt.pm * g.b_pm_off * 2 + (size_t)nxt.kt0 * kstep : cB;
        const int nt = cur.nkt;
        for (int t = 0; t < nt; t += 2) {
            const bool last = (t == nt - 2);
            const char* a1 = cA + (size_t)(t + 1) * kstep;
            const char* a2 = last ? nA : cA + (size_t)(t + 2) * kstep; const char* b2 = last ? nB : cB + (size_t)(t + 2) * kstep;
            const char* a3 = a2 + kstep; const char* b3 = b2 + kstep;
            if (last && has_next) S.a_ready(nxt);
            if constexpr (SP2) {
            PG8_LDB(B0, 0, 0); PG8_LDB(B1, 0, 1); PG8_SCHED; PG8_LDA(At, 0, 0); PG8_STAGE(PG8_SA(1, 1), a1 + hstepA, voffA);
            PG8_WAIT_V(8); PG8_WAIT_L(0); PG8_BAR; PG8_MMA(0, 0, At, B0); PG8_MMA(0, 1, At, B1); PG8_BAR; PG8_SCHED;
            PG8_LDA(At, 0, 1); PG8_STAGE(PG8_SB(0, 0), b2, voffB); PG8_STAGE(PG8_SB(0, 1), b2 + hstepB, voffB); PG8_STAGE(PG8_SA(0, 0), a2, voffA);
            PG8_WAIT_V(8); PG8_WAIT_L(0); PG8_BAR; PG8_MMA(1, 0, At, B0); PG8_MMA(1, 1, At, B1); PG8_BAR; PG8_SCHED;
            PG8_LDB(B0, 1, 0); PG8_LDB(B1, 1, 1); PG8_SCHED; PG8_LDA(At, 1, 0); PG8_STAGE(PG8_SA(0, 1), a2 + hstepA, voffA);
            PG8_WAIT_V(8); PG8_WAIT_L(0); PG8_BAR; PG8_MMA(0, 0, At, B0); PG8_MMA(0, 1, At, B1); PG8_BAR; PG8_SCHED;
            PG8_LDA(At, 1, 1); PG8_STAGE(PG8_SB(1, 0), b3, voffB); PG8_STAGE(PG8_SB(1, 1), b3 + hstepB, voffB); PG8_STAGE(PG8_SA(1, 0), a3, voffA);
            PG8_WAIT_V(8); PG8_WAIT_L(0); PG8_BAR; PG8_MMA(1, 0, At, B0); PG8_MMA(1, 1, At, B1); PG8_BAR; PG8_SCHED;
            } else {
            PG8_LDB(B0, 0, 0); PG8_SCHED; PG8_LDA(At, 0, 0); PG8_STAGE(PG8_SA(1, 1), a1 + hstepA, voffA);
            PG8_WAIT_L(8); PG8_BAR; PG8_WAIT_L(0); PG8_MMA(0, 0, At, B0); PG8_BAR; PG8_SCHED;
            PG8_LDB(B1, 0, 1); PG8_STAGE(PG8_SB(0, 0), b2, voffB);
            PG8_BAR; PG8_WAIT_L(0); PG8_MMA(0, 1, At, B1); PG8_BAR;
            PG8_LDA(At, 0, 1); PG8_STAGE(PG8_SA(0, 0), a2, voffA);
            PG8_BAR; PG8_WAIT_L(0); PG8_MMA(1, 0, At, B0); PG8_BAR; PG8_SCHED;
            PG8_STAGE(PG8_SB(0, 1), b2 + hstepB, voffB);
            PG8_WAIT_V(6); PG8_BAR; PG8_MMA(1, 1, At, B1); PG8_BAR;
            PG8_LDB(B0, 1, 0); PG8_SCHED; PG8_LDA(At, 1, 0); PG8_STAGE(PG8_SA(0, 1), a2 + hstepA, voffA);
            PG8_WAIT_L(8); PG8_BAR; PG8_WAIT_L(0); PG8_MMA(0, 0, At, B0); PG8_BAR; PG8_SCHED;
            PG8_LDB(B1, 1, 1); PG8_STAGE(PG8_SB(1, 0), b3, voffB);
            PG8_BAR; PG8_WAIT_L(0); PG8_MMA(0, 1, At, B1); PG8_BAR;
            PG8_LDA(At, 1, 1); PG8_STAGE(PG8_SA(1, 0), a3, voffA);
            PG8_BAR; PG8_WAIT_L(0); PG8_MMA(1, 0, At, B0); PG8_BAR; PG8_SCHED;
            PG8_STAGE(PG8_SB(1, 1), b3 + hstepB, voffB);
            PG8_WAIT_V(6); PG8_BAR; PG8_MMA(1, 1, At, B1); PG8_BAR;
            }
        }
        if constexpr (ALIGN_EPI) { if (wr == 0) PG8_BAR; }
        if constexpr (!Epi::AFTER_DRAIN) { E(acc, cur, wr, wc, fr, fq); S.done(cur); }
        if (!has_next) break;
#pragma unroll
        for (int a = 0; a < 2; ++a)
#pragma unroll
            for (int b = 0; b < 2; ++b)
#pragma unroll
                for (int m = 0; m < 4; ++m)
#pragma unroll
                    for (int n = 0; n < 2; ++n) acc[a][b][m][n] = (f32x4){0.f, 0.f, 0.f, 0.f};
        cur = nxt; cA = nA; cB = nB; ++ui;
        if constexpr (ALIGN_EPI) { if (wr == 1) PG8_BAR; }
    }
    PG8_WAIT_V(0);
    if constexpr (!ALIGN_EPI) { if (wr == 0) PG8_BAR; }
    PG8_BAR;
#undef PG8_SA
#undef PG8_SB
#undef PG8_STAGE
#undef PG8_LDA
#undef PG8_LDB
#undef PG8_MMA
#undef PG8_WAIT_V
#undef PG8_WAIT_L
#undef PG8_BAR
#undef PG8_SCHED
}
}

__device__ __forceinline__ void ld8(const bf16_t* p, float (&v)[8]) { const u32x4 r = *(const u32x4*)p; v[0] = bflo(r.x); v[1] = bfhi(r.x); v[2] = bflo(r.y); v[3] = bfhi(r.y); v[4] = bflo(r.z); v[5] = bfhi(r.z); v[6] = bflo(r.w); v[7] = bfhi(r.w); }
__device__ __forceinline__ void pool_apply_slot(const Params& p, int slot, int tid) {
    const bf16_t* __restrict__ Z = (const bf16_t*)(p.ws + WS_U); const bf16_t* __restrict__ SG = (const bf16_t*)(p.ws + WS_SG); bf16_t* __restrict__ Y = (bf16_t*)(p.ws + WS_HY);
    const int chunk = tid & 127, rb = tid >> 7, c = chunk * 8, g = chunk >> 5, h = 1 << g;
    float ps[8];
#pragma unroll
    for (int e = 0; e < 8; ++e) ps[e] = p.pool_scale[c + e];
    float S[8]; bool first = true;
    int m = slot * 80 + rb * 20;
#pragma unroll 1
    for (int i4 = 0; i4 < 5; ++i4) {
        float za[4][8], zr[4][8], own[4][8], gt[4][8]; int cnt[4]; bool init[4];
#pragma unroll
        for (int j = 0; j < 4; ++j) { const int mm = m + j; const bool smp = mm >= MP; const int t = smp ? (mm - MP) & 1023 : mm & 255, L = smp ? SEQS : SEQP;
            const bf16_t* zp = Z + (size_t)mm * 1024 + c;
            const bool add_ok = (t + h <= L), rem_ok = (t - h >= 1);
            ld8(zp + (ptrdiff_t)(add_ok ? (h - 1) : 0) * 1024, za[j]); ld8(zp + (ptrdiff_t)(rem_ok ? (-1 - h) : 0) * 1024, zr[j]); ld8(zp, own[j]); ld8(SG + (size_t)mm * DM + 1024 + c, gt[j]);
            const float fa = add_ok ? 1.f : 0.f, fr = rem_ok ? 1.f : 0.f;
#pragma unroll
            for (int e = 0; e < 8; ++e) { za[j][e] *= fa; zr[j][e] *= fr; }
            cnt[j] = min(t + h, L) - max(t - h, 0); init[j] = (t == 0) || (first && j == 0 && i4 == 0); }
#pragma unroll
        for (int j = 0; j < 4; ++j) { const int mm = m + j;
            if (init[j]) { const bool smp = mm >= MP; const int t = smp ? (mm - MP) & 1023 : mm & 255, L = smp ? SEQS : SEQP; const int lo = max(t - h, 0), hi = min(t + h, L);
#pragma unroll
                for (int e = 0; e < 8; ++e) S[e] = 0.f;
                for (int tt = lo; tt < hi; ++tt) { float w[8]; ld8(Z + (size_t)(mm + tt - t) * 1024 + c, w);
#pragma unroll
                    for (int e = 0; e < 8; ++e) S[e] += w[e]; } }
            else {
#pragma unroll
                for (int e = 0; e < 8; ++e) S[e] += za[j][e] - zr[j][e]; }
            const float inv = 1.0f / (float)cnt[j];
            float o[8];
#pragma unroll
            for (int e = 0; e < 8; ++e) o[e] = (S[e] * inv - own[j][e]) * ps[e] * gt[j][e];
            u32x4 w; w.x = pk2(o[0], o[1]); w.y = pk2(o[2], o[3]); w.z = pk2(o[4], o[5]); w.w = pk2(o[6], o[7]);
            *(u32x4*)(Y + (size_t)mm * DM + 1024 + c) = w; }
        first = false; m += 4;
    }
}
namespace att {
#define GATE(x) (SILU ? siluf(x) : (x))
using bf16x8 = __attribute__((ext_vector_type(8))) short;
using s16x4  = __attribute__((ext_vector_type(4))) short;
using f32x16 = __attribute__((ext_vector_type(16))) float;
constexpr int QBLK = 32, KVBLK = 64, LDK = 128;
constexpr int SHM_V = KVBLK * 128 * 2, SHM_K = KVBLK * 128 * 2;
constexpr int WS_OFF = 2 * SHM_V + 2 * SHM_K;
constexpr int STG_OFF = 72 * 1024;
constexpr float THRL = 8.f * LOG2E;
#define KSWZ(row, colB) ((row) * 256 + ((colB) ^ (((row) & 7) << 4)))
#define SBAR() __builtin_amdgcn_sched_barrier(0)
__device__ __forceinline__ int crow(int r, int hi) { return (r & 3) + 8 * (r >> 2) + 4 * hi; }
__device__ __forceinline__ unsigned cvtpk(float lo, float hi) { unsigned r; asm volatile("v_cvt_pk_bf16_f32 %0, %1, %2" : "=v"(r) : "v"(lo), "v"(hi)); return r; }
__device__ __forceinline__ void partialSM(f32x16& p0, f32x16& p1, float& m_reg, float& mn, float& alpha) {
  float pmax = p0[0]; for (int r = 1; r < 16; ++r) pmax = fmaxf(pmax, p0[r]); for (int r = 0; r < 16; ++r) pmax = fmaxf(pmax, p1[r]);
  { auto rr = __builtin_amdgcn_permlane32_swap(__float_as_uint(pmax), __float_as_uint(pmax), false, false);
    pmax = fmaxf(__uint_as_float(rr[0]), __uint_as_float(rr[1])); }
  if (__builtin_expect(__all(pmax - m_reg <= THRL), 1)) { mn = m_reg; alpha = 1.f; }
  else { mn = fmaxf(m_reg, pmax); alpha = __builtin_amdgcn_exp2f(m_reg - mn); m_reg = mn; }
  for (int r = 0; r < 16; ++r) p0[r] = p0[r] - mn; for (int r = 0; r < 16; ++r) p1[r] = p1[r] - mn;
  for (int r = 0; r < 16; ++r) p0[r] = __builtin_amdgcn_exp2f(p0[r]);
}
__device__ __forceinline__ void finishSM(f32x16& p0, f32x16& p1, float alpha, float& l_reg, bf16x8& pa0, bf16x8& pa1, bf16x8& pa2, bf16x8& pa3) {
  for (int r = 0; r < 16; ++r) p1[r] = __builtin_amdgcn_exp2f(p1[r]);
  float ps = 0; for (int r = 0; r < 16; ++r) ps += p0[r]; for (int r = 0; r < 16; ++r) ps += p1[r];
  { auto rr = __builtin_amdgcn_permlane32_swap(__float_as_uint(ps), __float_as_uint(ps), false, false);
    ps = __uint_as_float(rr[0]) + __uint_as_float(rr[1]); }
  l_reg = l_reg * alpha + ps;
#define PK4(P, BASE, OUT) do { unsigned a0 = cvtpk(P[BASE + 0], P[BASE + 1]), a1 = cvtpk(P[BASE + 2], P[BASE + 3]);   \
    unsigned b0 = cvtpk(P[BASE + 4], P[BASE + 5]), b1 = cvtpk(P[BASE + 6], P[BASE + 7]);                              \
    auto r0 = __builtin_amdgcn_permlane32_swap(a0, b0, false, false); auto r1 = __builtin_amdgcn_permlane32_swap(a1, b1, false, false); \
    u32x4 w = {r0[0], r1[0], r0[1], r1[1]}; OUT = *reinterpret_cast<bf16x8*>(&w); } while (0)
  PK4(p0, 0, pa0); PK4(p0, 8, pa1); PK4(p1, 0, pa2); PK4(p1, 8, pa3);
#undef PK4
}
template <int ND0> __device__ __forceinline__ void qkt(f32x16& p0, f32x16& p1, const char* Ks, const bf16x8* qr, int r32, int hi, int kcol0) {
  p0 = f32x16{}; p1 = f32x16{};
#pragma unroll
  for (int d0 = 0; d0 < ND0; ++d0) { int cb = (kcol0 + d0 * 16 + hi * 8) * 2;
    bf16x8 b0 = *reinterpret_cast<const bf16x8*>(Ks + KSWZ(r32, cb));
    bf16x8 b1 = *reinterpret_cast<const bf16x8*>(Ks + KSWZ(32 + r32, cb));
    p0 = __builtin_amdgcn_mfma_f32_32x32x16_bf16(b0, qr[d0], p0, 0, 0, 0);
    p1 = __builtin_amdgcn_mfma_f32_32x32x16_bf16(b1, qr[d0], p1, 0, 0, 0); }
}
__device__ __forceinline__ int v_st(int k, int c) { const int kk = (k & ~0xC) | ((k & 4) << 1) | ((k & 8) >> 1); return ((kk >> 3) * 4 + (c >> 5)) * 512 + ((kk & 7) * 32 + (c & 31)) * 2; }
__device__ __forceinline__ int v_rd_base(int lane) { return ((lane & 3) << 3) | (((lane >> 2) & 3) << 6) | (((lane >> 4) & 1) << 5) | (((lane >> 5) & 1) << 8); }
constexpr int v_rd_off(int d0, int ks, int half) { return d0 * 512 + ks * 4096 + half * 2048; }
template <int OFF> __device__ __forceinline__ s16x4 tr_read(int vb) {
  s16x4 r; asm volatile("ds_read_b64_tr_b16 %0, %1 offset:%2" : "=&v"(r) : "v"(vb), "i"(OFF) : "memory"); return r;
}
template <int D0> __device__ __forceinline__ void pv_one(f32x16& od, int vb, bf16x8 pa0, bf16x8 pa1, bf16x8 pa2, bf16x8 pa3) {
  const s16x4 l0 = tr_read<v_rd_off(D0, 0, 0)>(vb), h0 = tr_read<v_rd_off(D0, 0, 1)>(vb), l1 = tr_read<v_rd_off(D0, 1, 0)>(vb), h1 = tr_read<v_rd_off(D0, 1, 1)>(vb);
  const s16x4 l2 = tr_read<v_rd_off(D0, 2, 0)>(vb), h2 = tr_read<v_rd_off(D0, 2, 1)>(vb), l3 = tr_read<v_rd_off(D0, 3, 0)>(vb), h3 = tr_read<v_rd_off(D0, 3, 1)>(vb);
  asm volatile("s_waitcnt lgkmcnt(0)" ::: "memory"); SBAR();
#define PK(L, H) (bf16x8){L[0], L[1], L[2], L[3], H[0], H[1], H[2], H[3]}
  od = __builtin_amdgcn_mfma_f32_32x32x16_bf16(pa0, PK(l0, h0), od, 0, 0, 0);
  od = __builtin_amdgcn_mfma_f32_32x32x16_bf16(pa1, PK(l1, h1), od, 0, 0, 0);
  od = __builtin_amdgcn_mfma_f32_32x32x16_bf16(pa2, PK(l2, h2), od, 0, 0, 0);
  od = __builtin_amdgcn_mfma_f32_32x32x16_bf16(pa3, PK(l3, h3), od, 0, 0, 0);
#undef PK
}
__device__ __forceinline__ void pv_d0(f32x16* o, int vb, bf16x8 pa0, bf16x8 pa1, bf16x8 pa2, bf16x8 pa3) {
  pv_one<0>(o[0], vb, pa0, pa1, pa2, pa3); pv_one<1>(o[1], vb, pa0, pa1, pa2, pa3); pv_one<2>(o[2], vb, pa0, pa1, pa2, pa3); pv_one<3>(o[3], vb, pa0, pa1, pa2, pa3);
}
template <int ND0>
__device__ __forceinline__ void attn_core(const bf16_t* Qw, const bf16_t* __restrict__ Kh, const bf16_t* __restrict__ Vh, int seq, int kcol0, char* lds, f32x16 (&o)[4], float& l_reg, const int wid, const int lane) {
  const int tid = wid * 64 + lane, r32 = lane & 31, hi = lane >> 5;
  char* V_lds = lds; char* K_lds = lds + 2 * SHM_V;
  float* ws = (float*)(lds + WS_OFF) + wid * 64; float* al_l = ws + 32;
  float m_reg = -1e30f; l_reg = 0; bf16x8 qr[ND0];
#pragma unroll
  for (int d = 0; d < 4; ++d) o[d] = f32x16{};
#pragma unroll
  for (int d0 = 0; d0 < ND0; ++d0) qr[d0] = *reinterpret_cast<const bf16x8*>(Qw + d0 * 16);
  const int sr = tid >> 4, sc = (tid & 15) * 8, vst0 = v_st(sr, sc), vst1 = v_st(32 + sr, sc);
  const int vb0 = (int)(uintptr_t)V_lds + v_rd_base(lane);
  struct { bf16x8 vs0, vs1, ks0, ks1; } sr_[1];
#define SLOAD(i, k0) do { sr_[i].vs0 = *reinterpret_cast<const bf16x8*>(&Vh[(long)((k0) + sr) * LDK + sc]); sr_[i].vs1 = *reinterpret_cast<const bf16x8*>(&Vh[(long)((k0) + 32 + sr) * LDK + sc]); \
    sr_[i].ks0 = *reinterpret_cast<const bf16x8*>(&Kh[(long)((k0) + sr) * LDK + sc]); sr_[i].ks1 = *reinterpret_cast<const bf16x8*>(&Kh[(long)((k0) + 32 + sr) * LDK + sc]); } while (0)
#define SWRITE(b, i) do { *(bf16x8*)(V_lds + (b) * SHM_V + vst0) = sr_[i].vs0;          \
    *(bf16x8*)(V_lds + (b) * SHM_V + vst1) = sr_[i].vs1; int kc = sc * 2;               \
    *(bf16x8*)(K_lds + (b) * SHM_K + KSWZ(sr, kc)) = sr_[i].ks0;                       \
    *(bf16x8*)(K_lds + (b) * SHM_K + KSWZ(32 + sr, kc)) = sr_[i].ks1; } while (0)
#define SWAIT() asm volatile("s_waitcnt vmcnt(0)" ::: "memory")
#define RESC(a) do { if (__any((a) < 1.f)) { if (hi == 0) al_l[r32] = (a); asm volatile("s_waitcnt lgkmcnt(0)" ::: "memory"); \
    for (int d = 0; d < 4; ++d) for (int r = 0; r < 16; ++r) o[d][r] *= al_l[crow(r, hi)]; } } while (0)
  f32x16 pA0, pA1, pB0, pB1; float mnA, mnB, alA, alB; bf16x8 pa0, pa1, pa2, pa3; const int NT = seq / KVBLK;
  SLOAD(0, 0); asm volatile("s_waitcnt vmcnt(0)" ::: "memory"); SWRITE(0, 0); __syncthreads();
  qkt<ND0>(pA0, pA1, K_lds, qr, r32, hi, kcol0); partialSM(pA0, pA1, m_reg, mnA, alA);
  SLOAD(0, KVBLK);
  SWAIT(); SWRITE(1, 0); __syncthreads();
  for (int j = 1; j + 1 < NT; j += 2) {
    SBAR(); qkt<ND0>(pB0, pB1, K_lds + SHM_K, qr, r32, hi, kcol0);
    finishSM(pA0, pA1, alA, l_reg, pa0, pa1, pa2, pa3); SBAR();
    SLOAD(0, (j + 1) * KVBLK); SBAR();
    pv_d0(o, vb0, pa0, pa1, pa2, pa3); partialSM(pB0, pB1, m_reg, mnB, alB);
    __syncthreads(); SWAIT(); SWRITE(0, 0);
    RESC(alB); __syncthreads();
    SBAR(); qkt<ND0>(pA0, pA1, K_lds, qr, r32, hi, kcol0);
    finishSM(pB0, pB1, alB, l_reg, pa0, pa1, pa2, pa3); SBAR();
    SLOAD(0, (j + 2) * KVBLK); SBAR();
    pv_d0(o, vb0 + SHM_V, pa0, pa1, pa2, pa3); partialSM(pA0, pA1, m_reg, mnA, alA);
    __syncthreads(); SWAIT(); SWRITE(1, 0);
    RESC(alA); __syncthreads();
  }
  SBAR(); qkt<ND0>(pB0, pB1, K_lds + SHM_K, qr, r32, hi, kcol0);
  finishSM(pA0, pA1, alA, l_reg, pa0, pa1, pa2, pa3); SBAR();
  pv_d0(o, vb0, pa0, pa1, pa2, pa3); partialSM(pB0, pB1, m_reg, mnB, alB);
  __syncthreads(); RESC(alB);
  finishSM(pB0, pB1, alB, l_reg, pa0, pa1, pa2, pa3); SBAR();
  pv_d0(o, vb0 + SHM_V, pa0, pa1, pa2, pa3);
#undef SLOAD
#undef SWRITE
#undef SWAIT
#undef RESC
}
__device__ __forceinline__ void row_inv_l(float l_reg, char* lds, int wid, int r32, int hi, float (&rli)[16]) {
  float* li_l = (float*)(lds + WS_OFF) + wid * 64;
  if (hi == 0) li_l[r32] = l_reg; asm volatile("s_waitcnt lgkmcnt(0)" ::: "memory");
#pragma unroll
  for (int r = 0; r < 16; ++r) rli[r] = __builtin_amdgcn_rcpf(li_l[crow(r, hi)]);
}
template <bool SILU> __device__ __forceinline__ void store_rows_gated(const f32x16 (&v)[4], char* stg, bf16_t* Yrow0  , const bf16_t* Grow0, int gpitch, int lane, int r32, int hi) {
  bf16_t* st = (bf16_t*)stg;
#pragma unroll
  for (int r = 0; r < 16; ++r) { const int orow = crow(r, hi);
#pragma unroll
    for (int d0 = 0; d0 < 4; ++d0) st[orow * 128 + d0 * 32 + r32] = (bf16_t)f2bf(v[d0][r]); }
  asm volatile("s_waitcnt lgkmcnt(0)" ::: "memory");
  const bf16_t* gp = Grow0 + (size_t)(lane >> 4) * gpitch + (lane & 15) * 8; bf16_t* yp = Yrow0 + (size_t)(lane >> 4) * DM + (lane & 15) * 8; const bf16_t* sp = st + (lane >> 4) * 128 + (lane & 15) * 8;
  u32x4 g[8];
#pragma unroll
  for (int i = 0; i < 8; ++i) { g[i] = *(const u32x4*)gp; gp += 4 * (size_t)gpitch; asm volatile("" : "+v"(gp)); }
#pragma unroll
  for (int i = 0; i < 8; ++i) {
    const u32x4 x = *(const u32x4*)(sp + i * 4 * 128);
    u32x4 w; w.x = pk2(bflo(x.x) * GATE(bflo(g[i].x)), bfhi(x.x) * GATE(bfhi(g[i].x))); w.y = pk2(bflo(x.y) * GATE(bflo(g[i].y)), bfhi(x.y) * GATE(bfhi(g[i].y)));
    w.z = pk2(bflo(x.z) * GATE(bflo(g[i].z)), bfhi(x.z) * GATE(bfhi(g[i].z))); w.w = pk2(bflo(x.w) * GATE(bflo(g[i].w)), bfhi(x.w) * GATE(bfhi(g[i].w)));
    *(u32x4*)yp = w; yp += 4 * DM; asm volatile("" : "+v"(yp)); }
  asm volatile("s_waitcnt lgkmcnt(0)" ::: "memory");
}
__device__ __forceinline__ void gqa_unit(const Params& p, char* lds, int m0, int hq, const bf16_t* Kh, const bf16_t* Vh, int seq, const int wid) {
  const int lane = fresh_lane(), r32 = lane & 31, hi = lane >> 5;
  const bf16_t* QC = (const bf16_t*)(p.ws + WS_Q); const bf16_t* PR = (const bf16_t*)(p.ws + WS_PR); bf16_t* Y = (bf16_t*)(p.ws + WS_HY);
  f32x16 o[4]; float l_reg;
  attn_core<8>(QC + (size_t)(m0 + wid * QBLK + r32) * DM + hq * 128 + hi * 8, Kh, Vh, seq, 0, lds, o, l_reg, wid, lane);
  float rli[16]; row_inv_l(l_reg, lds, wid, r32, hi, rli);
#pragma unroll
  for (int d0 = 0; d0 < 4; ++d0)
#pragma unroll
    for (int r = 0; r < 16; ++r) o[d0][r] *= rli[r];
  __syncthreads();
  const size_t row0 = (size_t)(m0 + wid * QBLK);
  store_rows_gated<false>(o, lds + wid * 8192, Y + row0 * DM + hq * 128, (const bf16_t*)(p.ws + WS_SG) + row0 * DM + hq * 128, DM, lane, r32, hi);
  __syncthreads();
}
constexpr int RES_WS = 131072 + 1024, RES_EX = 131072 + 4096;
__device__ __forceinline__ void load_kv_resident(const bf16_t* __restrict__ Kh, const bf16_t* __restrict__ Vh, char* lds, int tid) {
  bf16x8 kr[8], vr[8];
#pragma unroll
  for (int i = 0; i < 8; ++i) { const int c = tid + 512 * i; kr[i] = *reinterpret_cast<const bf16x8*>(Kh + (size_t)c * 8); vr[i] = *reinterpret_cast<const bf16x8*>(Vh + (size_t)c * 8); }
#pragma unroll
  for (int i = 0; i < 8; ++i) { const int c = tid + 512 * i, key = c >> 4, col = (c & 15) * 8, t = key >> 6, k = key & 63;
    *(bf16x8*)(lds + 65536 + t * 16384 + v_st(k, col)) = vr[i];
    *(bf16x8*)(lds + t * 16384 + KSWZ(k, col * 2)) = kr[i]; }
}
template <int ND0>
__device__ __forceinline__ void attn_core_res(const bf16_t* Qw, int kcol0, char* lds, f32x16 (&o)[4], float& l_reg, const int wid, const int lane) {
  const int r32 = lane & 31, hi = lane >> 5;
  const char* K_lds = lds; float* al_l = (float*)(lds + RES_WS) + wid * 64 + 32;
  float m_reg = -1e30f; l_reg = 0; bf16x8 qr[ND0];
#pragma unroll
  for (int d = 0; d < 4; ++d) o[d] = f32x16{};
#pragma unroll
  for (int d0 = 0; d0 < ND0; ++d0) qr[d0] = *reinterpret_cast<const bf16x8*>(Qw + d0 * 16);
  const int vb0 = (int)(uintptr_t)(lds + 65536) + v_rd_base(lane);
#define RESC(a) do { if (__any((a) < 1.f)) { if (hi == 0) al_l[r32] = (a); asm volatile("s_waitcnt lgkmcnt(0)" ::: "memory"); \
    for (int d = 0; d < 4; ++d) for (int r = 0; r < 16; ++r) o[d][r] *= al_l[crow(r, hi)]; } } while (0)
  f32x16 pA0, pA1, pB0, pB1; float mnA, mnB, alA, alB; bf16x8 pa0, pa1, pa2, pa3;
  qkt<ND0>(pA0, pA1, K_lds, qr, r32, hi, kcol0); partialSM(pA0, pA1, m_reg, mnA, alA);
  SBAR(); qkt<ND0>(pB0, pB1, K_lds + 16384, qr, r32, hi, kcol0);
  finishSM(pA0, pA1, alA, l_reg, pa0, pa1, pa2, pa3); SBAR();
  pv_d0(o, vb0, pa0, pa1, pa2, pa3); partialSM(pB0, pB1, m_reg, mnB, alB); RESC(alB);
  SBAR(); qkt<ND0>(pA0, pA1, K_lds + 2 * 16384, qr, r32, hi, kcol0);
  finishSM(pB0, pB1, alB, l_reg, pa0, pa1, pa2, pa3); SBAR();
  pv_d0(o, vb0 + 16384, pa0, pa1, pa2, pa3); partialSM(pA0, pA1, m_reg, mnA, alA); RESC(alA);
  SBAR(); qkt<ND0>(pB0, pB1, K_lds + 3 * 16384, qr, r32, hi, kcol0);
  finishSM(pA0, pA1, alA, l_reg, pa0, pa1, pa2, pa3); SBAR();
  pv_d0(o, vb0 + 2 * 16384, pa0, pa1, pa2, pa3); partialSM(pB0, pB1, m_reg, mnB, alB); RESC(alB);
  finishSM(pB0, pB1, alB, l_reg, pa0, pa1, pa2, pa3); SBAR();
  pv_d0(o, vb0 + 3 * 16384, pa0, pa1, pa2, pa3);
#undef RESC
}
__device__ __forceinline__ void row_inv_l_res(float l_reg, char* lds, int wid, int r32, int hi, float (&rli)[16]) {
  float* li_l = (float*)(lds + RES_WS) + wid * 64;
  if (hi == 0) li_l[r32] = l_reg; asm volatile("s_waitcnt lgkmcnt(0)" ::: "memory");
#pragma unroll
  for (int r = 0; r < 16; ++r) rli[r] = __builtin_amdgcn_rcpf(li_l[crow(r, hi)]);
}
template <bool SILU> __device__ __forceinline__ void store_direct_gated(const f32x16 (&v)[4], char* stg  , bf16_t* Y0  , const bf16_t* G0, int gpitch, int lane, int r32, int hi) {
  bf16_t* st = (bf16_t*)stg;
  const bf16_t* gp = G0 + (size_t)(lane >> 4) * gpitch + (lane & 15) * 8; bf16_t* yp = Y0 + (size_t)(lane >> 4) * DM + (lane & 15) * 8; const bf16_t* sp = st + (lane >> 4) * 128 + (lane & 15) * 8;
  u32x4 g[8];
#pragma unroll
  for (int i = 0; i < 8; ++i) { g[i] = *(const u32x4*)gp; gp += 4 * (size_t)gpitch; asm volatile("" : "+v"(gp)); }
#pragma unroll
  for (int j = 0; j < 4; ++j) {
#pragma unroll
    for (int rr = 0; rr < 4; ++rr)
#pragma unroll
      for (int d0 = 0; d0 < 4; ++d0) st[(rr + 4 * hi) * 128 + d0 * 32 + r32] = (bf16_t)f2bf(v[d0][4 * j + rr]);
    asm volatile("s_waitcnt lgkmcnt(0)" ::: "memory");
#pragma unroll
    for (int i = 0; i < 2; ++i) {
      const u32x4 x = *(const u32x4*)(sp + i * 4 * 128); const u32x4 gg = g[2 * j + i];
      u32x4 w; w.x = pk2(bflo(x.x) * GATE(bflo(gg.x)), bfhi(x.x) * GATE(bfhi(gg.x))); w.y = pk2(bflo(x.y) * GATE(bflo(gg.y)), bfhi(x.y) * GATE(bfhi(gg.y)));
      w.z = pk2(bflo(x.z) * GATE(bflo(gg.z)), bfhi(x.z) * GATE(bfhi(gg.z))); w.w = pk2(bflo(x.w) * GATE(bflo(gg.w)), bfhi(x.w) * GATE(bfhi(gg.w)));
      *(u32x4*)yp = w; yp += 4 * DM; asm volatile("" : "+v"(yp)); }
    asm volatile("s_waitcnt lgkmcnt(0)" ::: "memory");
  }
}
__device__ __forceinline__ void gqa_prompt_slot(const Params& p, char* lds, int bk, const int wid) {
  const int lane = fresh_lane(), r32 = lane & 31, hi = lane >> 5;
  const bf16_t* QC = (const bf16_t*)(p.ws + WS_Q); const bf16_t* PR = (const bf16_t*)(p.ws + WS_PR); bf16_t* Y = (bf16_t*)(p.ws + WS_HY);
  load_kv_resident((const bf16_t*)(p.ws + WS_KP) + (size_t)bk * SEQP * 128, (const bf16_t*)(p.ws + WS_VP) + (size_t)bk * SEQP * 128, lds, wid * 64 + lane);
  __syncthreads();
  const int m0 = (bk >> 2) * SEQP;
  for (int g = 0; g < 4; ++g) {
    const int hq = (bk & 3) * 4 + g;
    f32x16 o[4]; float l_reg;
    const size_t row0 = (size_t)(m0 + wid * QBLK);
    attn_core_res<8>(QC + (row0 + r32) * DM + hq * 128 + hi * 8, 0, lds, o, l_reg, wid, lane);
    float rli[16]; row_inv_l_res(l_reg, lds, wid, r32, hi, rli);
#pragma unroll
    for (int d0 = 0; d0 < 4; ++d0)
#pragma unroll
      for (int r = 0; r < 16; ++r) o[d0][r] *= rli[r];
    store_direct_gated<false>(o, lds + RES_EX + wid * 2048, Y + row0 * DM + hq * 128, (const bf16_t*)(p.ws + WS_SG) + row0 * DM + hq * 128, DM, lane, r32, hi);
  }
  __syncthreads();
}
__device__ __forceinline__ void diff_prompt_slot(const Params& p, char* lds, int slot  , float lam, const int wid) {
  const int lane = fresh_lane(), r32 = lane & 31, hi = lane >> 5, rg = wid & 3, mp = wid >> 2;
  const bf16_t* QA = (const bf16_t*)(p.ws + WS_Q); const bf16_t* PR = (const bf16_t*)(p.ws + WS_PR); bf16_t* Y = (bf16_t*)(p.ws + WS_HY);
  for (int hh = 0; hh < 2; ++hh) {
    const int bh = slot * 2 + hh, h = bh & 7, b = bh >> 3;
    load_kv_resident((const bf16_t*)(p.ws + WS_KP) + (size_t)bh * SEQP * 128, (const bf16_t*)(p.ws + WS_VP) + (size_t)bh * SEQP * 128, lds, wid * 64 + lane);
    __syncthreads();
    for (int qb = 0; qb < 2; ++qb) {
      const size_t row0 = (size_t)(b * SEQP + qb * 128 + rg * QBLK);
      f32x16 o[4]; float l_reg;
      attn_core_res<4>(QA + (row0 + r32) * 1024 + h * 128 + mp * 64 + hi * 8, mp * 64, lds, o, l_reg, wid, lane);
      float rli[16]; row_inv_l_res(l_reg, lds, wid, r32, hi, rli);
      float* ex = (float*)(lds + RES_EX) + rg * 1024 + lane;
      float ss[16];
#pragma unroll
      for (int r = 0; r < 16; ++r) ss[r] = 0.f;
#pragma unroll
      for (int d0 = 0; d0 < 4; ++d0) {
        if (mp == 1) {
#pragma unroll
          for (int r = 0; r < 16; ++r) ex[r * 64] = o[d0][r] * (rli[r] * lam); }
        __syncthreads();
        if (mp == 0) {
#pragma unroll
          for (int r = 0; r < 16; ++r) { const float v = o[d0][r] * rli[r] - ex[r * 64]; o[d0][r] = v; ss[r] += v * v; } }
        __syncthreads();
      }
      if (mp == 0) {
#pragma unroll
        for (int r = 0; r < 16; ++r) {
#pragma unroll
          for (int of = 1; of < 32; of <<= 1) ss[r] += __shfl_xor(ss[r], of);
          ss[r] = 0.8f / sqrtf(ss[r] * (1.f / 128.f) + EPS); }
#pragma unroll
        for (int d0 = 0; d0 < 4; ++d0) { const float sw = p.subln_w[d0 * 32 + r32];
#pragma unroll
          for (int r = 0; r < 16; ++r) o[d0][r] *= ss[r] * sw; }
        store_direct_gated<false>(o, lds + RES_EX + 16384 + rg * 2048, Y + row0 * DM + h * 128, (const bf16_t*)(p.ws + WS_SG) + row0 * DM + h * 128, DM, lane, r32, hi);
      }
    }
    __syncthreads();
  }
}
__device__ __forceinline__ void gqa_phase(const Params& p, char* lds, int vcu, int G, const int wid, const int mode) {
  for (int v = vcu; v < 256; v += G) {
    if (v < 128) { if (mode & 1) continue;
      const int qb = v & 3, g = (v >> 2) & 3, bk = v >> 4;
      gqa_unit(p, lds, MP + (bk >> 2) * SEQS + qb * 256, (bk & 3) * 4 + g, (const bf16_t*)(p.ws + WS_KSC) + (size_t)bk * LKS * 128, (const bf16_t*)(p.ws + WS_VSC) + (size_t)bk * LKS * 128, LKS, wid); }
    else { if (mode & 2) continue; gqa_prompt_slot(p, lds, v - 128, wid); }
  }
}
__device__ __forceinline__ void diff_unit(const Params& p, char* lds, int m0, int h, const bf16_t* Kh, const bf16_t* Vh, int seq, float lam, const int wid) {
  const int lane = fresh_lane(), r32 = lane & 31, hi = lane >> 5, rg = wid & 3, mp = wid >> 2;
  const bf16_t* QA = (const bf16_t*)(p.ws + WS_Q); const bf16_t* PR = (const bf16_t*)(p.ws + WS_PR); bf16_t* Y = (bf16_t*)(p.ws + WS_HY);
  f32x16 o[4]; float l_reg;
  attn_core<4>(QA + (size_t)(m0 + rg * QBLK + r32) * 1024 + h * 128 + mp * 64 + hi * 8, Kh, Vh, seq, mp * 64, lds, o, l_reg, wid, lane);
  float rli[16]; row_inv_l(l_reg, lds, wid, r32, hi, rli);
  __syncthreads();
  float* ex = (float*)lds + rg * 4096 + lane;
  if (mp == 1) {
#pragma unroll
    for (int d0 = 0; d0 < 4; ++d0)
#pragma unroll
      for (int r = 0; r < 16; ++r) ex[(d0 * 16 + r) * 64] = o[d0][r] * (rli[r] * lam);
  }
  __syncthreads();
  if (mp == 0) {
    float ss[16];
#pragma unroll
    for (int r = 0; r < 16; ++r) ss[r] = 0.f;
#pragma unroll
    for (int d0 = 0; d0 < 4; ++d0)
#pragma unroll
      for (int r = 0; r < 16; ++r) { const float v = o[d0][r] * rli[r] - ex[(d0 * 16 + r) * 64]; o[d0][r] = v; ss[r] += v * v; }
#pragma unroll
    for (int r = 0; r < 16; ++r) {
#pragma unroll
      for (int of = 1; of < 32; of <<= 1) ss[r] += __shfl_xor(ss[r], of);
      ss[r] = 0.8f / sqrtf(ss[r] * (1.f / 128.f) + EPS); }
#pragma unroll
    for (int d0 = 0; d0 < 4; ++d0) { const float sw = p.subln_w[d0 * 32 + r32];
#pragma unroll
      for (int r = 0; r < 16; ++r) o[d0][r] *= ss[r] * sw; }
    const size_t row0 = (size_t)(m0 + rg * QBLK);
    store_rows_gated<false>(o, lds + STG_OFF + rg * 8192, Y + row0 * DM + h * 128, (const bf16_t*)(p.ws + WS_SG) + row0 * DM + h * 128, DM, lane, r32, hi);
  }
  __syncthreads();
}
__device__ __forceinline__ void diff_phase(const Params& p, char* lds, int vcu, int G, const int wid, const int mode) {
  const int lane = fresh_lane();
  const float lam = expf(wave_sum(p.lam_q1[lane] * p.lam_k1[lane])) - expf(wave_sum(p.lam_q2[lane] * p.lam_k2[lane])) + 0.2f;
  for (int v = vcu; v < 256; v += G) {
    if (v < 128) { if (mode & 1) continue;
      const int qb = v & 7, bh = v >> 3;
      diff_unit(p, lds, MP + (bh >> 3) * SEQS + qb * 128, bh & 7, (const bf16_t*)(p.ws + WS_KSA) + (size_t)bh * LKS * 128, (const bf16_t*)(p.ws + WS_VSA) + (size_t)bh * LKS * 128, LKS, lam, wid);
      if (!(mode & 4)) pool_apply_slot(p, v, wid * 64 + fresh_lane()); }
    else { if (mode & 2) continue; diff_prompt_slot(p, lds, v - 128, lam, wid); }
  }
}
#undef KSWZ
#undef SBAR
}

constexpr int NWAVES = 8;
constexpr int RING_OFF = 0, RING_BYTES = 131072;
constexpr int LDSCTL_OFF = RING_BYTES, MISC_OFF = LDSCTL_OFF + 320;
constexpr int LDS_BYTES = 163840;
constexpr int RES_WS_OFF = RING_BYTES + 1024, RES_EX_OFF = RING_BYTES + 4096;
constexpr int CW_BAR = 4096;
#define GAS __attribute__((address_space(1)))
#define LAS __attribute__((address_space(3)))
typedef GAS unsigned gu32;
#define RLX_AGENT __ATOMIC_RELAXED, __HIP_MEMORY_SCOPE_AGENT
#define XB_TMO      128
#define XB_XCNT(j)  (256  + 64 * (j))
#define XB_XSUB(j)  (1280 + 64 * (j))
#define XB_XGEN(j)  (2304 + 64 * (j))
#define XB_TOP      3328
#define XB_TOPGEN   3392
#define XCD_BAR_WORDS 3456
#define XB_SPIN_CAP (1u << 18)
__device__ __forceinline__ unsigned xb_ld(unsigned* p)              { return __hip_atomic_load(p, __ATOMIC_RELAXED, __HIP_MEMORY_SCOPE_AGENT); }
__device__ __forceinline__ unsigned xb_add(unsigned* p, unsigned v) { return __hip_atomic_fetch_add(p, v, __ATOMIC_RELAXED, __HIP_MEMORY_SCOPE_AGENT); }
__device__ __forceinline__ unsigned xb_xcc_id() { return (unsigned)__builtin_amdgcn_s_getreg((3 << 11) | 20) & 0xFu; }
#define XB_SPIN(cond, bar) do { unsigned _sp = 0; while (cond) { __builtin_amdgcn_s_sleep(1); \
    if ((++_sp & 255u) == 0u) { if (xb_ld(&(bar)[XB_TMO])) break; if (_sp > XB_SPIN_CAP) { atomicAdd(&(bar)[XB_TMO], 1u); break; } } } } while (0)
struct XcdBarrier { unsigned* bar; unsigned x; volatile LAS unsigned* st; };
__device__ __forceinline__ XcdBarrier xcd_barrier_post(unsigned* bar, volatile LAS unsigned* st) {
    XcdBarrier b; b.bar = bar; b.x = xb_xcc_id(); b.st = st;
    if (threadIdx.x == 0) (void)xb_add(&bar[XB_XCNT(b.x)], 1u);
    return b;
}
__device__ __forceinline__ void xcd_barrier_complete(unsigned* bar, unsigned x, unsigned& nloc, unsigned& nx) {
    const unsigned G = gridDim.x * gridDim.y * gridDim.z;
    unsigned sum, cnt, mine, sp = 0u;
    for (;;) {
        sum = 0u; cnt = 0u; mine = 0u;
#pragma unroll
        for (unsigned j = 0; j < 16; ++j) { const unsigned c = xb_ld(&bar[XB_XCNT(j)]); sum += c; cnt += (c > 0u) ? 1u : 0u; mine = (j == x) ? c : mine; }
        if (sum == G) break;
        __builtin_amdgcn_s_sleep(1);
        if ((++sp & 255u) == 0u) { if (xb_ld(&bar[XB_TMO])) break; if (sp > XB_SPIN_CAP) { atomicAdd(&bar[XB_TMO], 1u); break; } }
    }
    nloc = mine > 0u ? mine : 1u; nx = cnt > 0u ? cnt : 1u;
}
__device__ __forceinline__ void xcd_barrier(const XcdBarrier& b) {
    asm volatile("s_waitcnt vmcnt(0)" ::: "memory");
    __syncthreads();
    if (threadIdx.x == 0) {
        unsigned* bar = b.bar;
        __builtin_amdgcn_s_waitcnt(0);
        unsigned nloc = b.st[0], nx = b.st[1];
        if (nloc == 0u) { xcd_barrier_complete(bar, b.x, nloc, nx); b.st[0] = nloc; b.st[1] = nx; }
        const unsigned old = xb_add(&bar[XB_XSUB(b.x)], 1u);
        const unsigned gen = old / nloc;
        if (old + 1u == (gen + 1u) * nloc) {
            __builtin_amdgcn_fence(__ATOMIC_RELEASE, "agent");
            asm volatile("s_waitcnt vmcnt(0)" ::: "memory");
            const unsigned og = xb_add(&bar[XB_TOP], 1u);
            const unsigned tg = og / nx;
            if (og + 1u == (tg + 1u) * nx) xb_add(&bar[XB_TOPGEN], 1u);
            else XB_SPIN(xb_ld(&bar[XB_TOPGEN]) == tg, bar);
            __builtin_amdgcn_fence(__ATOMIC_ACQUIRE, "agent");
            xb_add(&bar[XB_XGEN(b.x)], 1u);
            asm volatile("s_waitcnt vmcnt(0)" ::: "memory");
        } else {
            XB_SPIN(xb_ld(&bar[XB_XGEN(b.x)]) == gen, bar);
            __builtin_amdgcn_fence(__ATOMIC_ACQUIRE, "agent");
            asm volatile("s_waitcnt vmcnt(0)" ::: "memory");
        }
    }
    __syncthreads();
}

constexpr size_t WS_SLAB = WS_PR + 40 * MiB;
constexpr size_t CTL_TAIL = 256 * 1024;
template <int KIND> __device__ __forceinline__ void tail_reduce(const Params& p, const pg8::StaticOrder& S, int slot, int wave, int lane) {
    if (S.split <= 1) return;
    const int c = S.c, xcd = c % 8, q = c / 8, split = S.split, ks = q % split, j = (q / split) * 8 + xcd;
    pg8::Unit u; S.tile(S.nfull + j, u);
    unsigned* cnt = (unsigned*)(p.ws + WS_CTL + CTL_TAIL) + slot * 4096 + 64 * j;
    asm volatile("s_waitcnt vmcnt(0)" ::: "memory");
    __syncthreads();
    if (threadIdx.x == 0) {
        __builtin_amdgcn_fence(__ATOMIC_RELEASE, "agent");
        asm volatile("s_waitcnt vmcnt(0)" ::: "memory");
        __hip_atomic_fetch_add(cnt, 1u, __ATOMIC_RELAXED, __HIP_MEMORY_SCOPE_AGENT);
        unsigned sp = 0;
        while (__hip_atomic_load(cnt, __ATOMIC_RELAXED, __HIP_MEMORY_SCOPE_AGENT) < (unsigned)split) { __builtin_amdgcn_s_sleep(1); if (++sp > (1u << 22)) break; }
        __builtin_amdgcn_fence(__ATOMIC_ACQUIRE, "agent");
        asm volatile("s_waitcnt vmcnt(0)" ::: "memory");
    }
    __syncthreads();
    const int R = 256 / split, rpw = R / 8;
    const float* sb = (const float*)(p.ws + WS_SLAB) + (size_t)(j * split) * 65536 + 4 * lane;
    const int col = u.pn * 256 + 4 * lane;
    for (int i = 0; i < rpw; ++i) {
        const int rl = ks * R + wave * rpw + i, r = u.pm * 256 + rl, cr = cond_row(r);
        f32x4 sum = {0.f, 0.f, 0.f, 0.f};
        for (int sidx = 0; sidx < split; ++sidx) sum += *(const f32x4*)(sb + (size_t)sidx * 65536 + (size_t)rl * 256);
        if (KIND == 0) {
            const f32x4 x = *(const f32x4*)(xrow_ptr(p, r) + col), gt = *(const f32x4*)((const float*)(p.ws + WS_MOD) + 4096 + (size_t)cr * 6144 + col), cw = *(const f32x4*)((const float*)(p.ws + WS_CW1) + (size_t)cr * DM + col);
            const f32x4 y = x + gt * sum;
            *(f32x4*)(p.out + (size_t)r * DM + col) = y;
            const f32x4 h = y * cw; u32x2 o; o.x = pk2(h[0], h[1]); o.y = pk2(h[2], h[3]);
            *(u32x2*)((bf16_t*)(p.ws + WS_H1) + (size_t)r * DM + col) = o;
            const float ss = wave_sum((y[0] * y[0] + y[1] * y[1]) + (y[2] * y[2] + y[3] * y[3]));
            if (lane == 0) atomicAdd((float*)(p.ws + WS_RSS) + r, ss);
        } else if (KIND == 1) {
            const f32x4 gt = *(const f32x4*)((const float*)(p.ws + WS_MOD) + 3 * 6144 + 4096 + (size_t)cr * 6144 + col);
            float* op = p.out + (size_t)r * DM + col; *(f32x4*)op = *(const f32x4*)op + gt * sum;
        } else {
            const float rstd = 1.0f / sqrtf(((const float*)(p.ws + WS_RSS))[r] * (1.f / DM) + EPS);
            const f32x4 v = sum * rstd + *(const f32x4*)((const float*)(p.ws + WS_B2P) + (size_t)cr * ODD_IN + col);
            u32x2 o; o.x = pk2(siluf(v[0]), siluf(v[1])); o.y = pk2(siluf(v[2]), siluf(v[3]));
            *(u32x2*)((bf16_t*)(p.ws + WS_SG) + (size_t)r * DM + (col - 12 * 256)) = o;
        }
    }
}

struct MegaArgs { Params p; int ph_lo, ph_hi, mode, pad; };
constexpr int N_PHASES = 11;
#ifndef DUP_PHASE
#define DUP_PHASE -1
#endif
__device__ __forceinline__ Params load_params() {
#if defined(__HIP_DEVICE_COMPILE__)
    typedef __attribute__((address_space(4))) const unsigned long long* KPtr;
    KPtr a = (KPtr)__builtin_amdgcn_kernarg_segment_ptr();
    asm volatile("" : "+s"(a));
    Params p; unsigned long long* d = (unsigned long long*)&p;
#pragma unroll
    for (int i = 0; i < (int)(sizeof(Params) / 8); ++i) d[i] = a[i];
    return p;
#else
    return Params{};
#endif
}
__global__ void __launch_bounds__(NWAVES * 64, 2) mega_fwd(MegaArgs args) {
    extern __shared__ __attribute__((aligned(16))) unsigned char lds[];
    LAS unsigned char* ldsl = (LAS unsigned char*)lds;
    volatile LAS unsigned* MISC = (volatile LAS unsigned*)(ldsl + MISC_OFF);
    const int wave = __builtin_amdgcn_readfirstlane(threadIdx.x >> 6);
    const int G = gridDim.x, bx = blockIdx.x;
    const int vcu = (G % 8 == 0) ? (bx % 8) * (G / 8) + bx / 8 : bx;
    for (int u = threadIdx.x; u < (LDS_BYTES - LDSCTL_OFF) / 4; u += NWAVES * 64) ((LAS unsigned*)(ldsl + LDSCTL_OFF))[u] = 0u;
    __syncthreads();
    XcdBarrier bar; { const Params p0 = load_params(); bar = xcd_barrier_post((unsigned*)(p0.ws + WS_CTL) + CW_BAR, MISC + 8); }
    const int lo = args.ph_lo, hi = args.ph_hi, mode = args.mode;
    const int gw = vcu * NWAVES + wave, ngw = G * NWAVES;
#define IN(k) (lo <= (k) && (k) < hi)
#define SEAM(k) do { if (IN(k) && (IN((k) + 1) || ((k) == 7 && IN(9)) || ((k) == 5 && IN(7)) || ((k) == 2 && IN(4)))) xcd_barrier(bar); } while (0)
    if (IN(0)) {
        const Params p = load_params();
        float* scr = (float*)lds; const int lane = fresh_lane(), tid = wave * 64 + lane;
        if (!(mode & 8)) mod_items(p, scr, bx, G, tid, NWAVES * 64);
        __syncthreads();
        if (!(mode & 16)) weights_items(p, (float*)(lds + wave * 16384), gw, ngw, lane);
        if (!(mode & 32)) caches_rope_items(p, (long)bx * 512 + tid, (long)G * 512);
    }
    SEAM(0);
    if (IN(1)) {
        const Params p = load_params(); unsigned char* const ws = p.ws;
        if (bx < 32) {
            pg8::Gemm g{(const bf16_t*)(ws + WS_POOLW), (const bf16_t*)(ws + WS_WU), 1024, DM, 256, 256, 1024, 0, 256, 0}; pg8::StaticOrder S; S.init(1024, DM, 256, G, bx, false);
            pg8::EpiBf16 E{(bf16_t*)(ws + WS_WINE) + (size_t)3072 * DM, DM, 0};
            pg8::gemm_phase<pg8::EpiBf16, pg8::StaticOrder, true, true>(ldsl + RING_OFF, g, S, E, wave * 64 + fresh_lane());
        } else { const int ln = fresh_lane(), g2 = (bx - 32) * NWAVES + wave, n2 = (G - 32) * NWAVES; modulate_rows(p, 0, g2, n2, ln); mod1_tables(p, g2, n2, ln); }
    }
    SEAM(1);
    if (IN(2)) {
        const Params p = load_params(); unsigned char* const ws = p.ws;
        pg8::Gemm g{(const bf16_t*)(ws + WS_HY), (const bf16_t*)(ws + WS_WINE), MT, EVEN_IN, DM, DM, DM, 0, 0, 0}; pg8::StaticOrder S; S.init(MT, EVEN_IN, DM, G, bx, false);
        float* nak = p.out + (size_t)MT * DM;
        pg8::EpiProj0 E{ws, p.even_q_norm_w, p.even_k_norm_w, nak, nak + (size_t)NBP * HA * SEQP * 128};
        pg8::gemm_phase<pg8::EpiProj0, pg8::StaticOrder, true, true>(ldsl + RING_OFF, g, S, E, wave * 64 + fresh_lane());
    }
    SEAM(2);
    if (IN(4)) { const Params p = load_params(); att::diff_phase(p, (char*)lds, vcu, G, wave, mode); }
    SEAM(4);
    if (IN(5)) {
        const Params p = load_params(); unsigned char* const ws = p.ws;
        pg8::Gemm g{(const bf16_t*)(ws + WS_HY), (const bf16_t*)(ws + WS_WOUTE), MT, DM, DM, DM, DM, 0, 0, 0}; pg8::StaticOrder S; S.init(MT, DM, DM, G, bx, false);
        pg8::EpiResid0 E{p.x_prompt, p.x_sample, (const float*)(ws + WS_MOD) + 4096, (const float*)(ws + WS_CW1), p.out, (bf16_t*)(ws + WS_H1), (float*)(ws + WS_RSS), (float*)(ws + WS_SLAB)};
        pg8::gemm_phase<pg8::EpiResid0, pg8::StaticOrder, true, true>(ldsl + RING_OFF, g, S, E, wave * 64 + fresh_lane());
        { const Params p2 = load_params(); tail_reduce<0>(p2, S, 0, wave, fresh_lane()); }
    }
    SEAM(5);
    if (IN(7)) {
        const Params p = load_params(); unsigned char* const ws = p.ws;
        pg8::Gemm g{(const bf16_t*)(ws + WS_H1), (const bf16_t*)(ws + WS_WINO), MT, ODD_IN, DM, DM, DM, 0, 0, 0}; pg8::StaticOrder S; S.init(MT, ODD_IN, DM, G, bx, false);
        float* nck = p.out + (size_t)MT * DM + 2 * (size_t)NBP * HA * SEQP * 128;
        pg8::EpiProj1 E{ws, p.gqa_q_norm_w, p.gqa_k_norm_w, nck, nck + (size_t)NBP * KVH * SEQP * 128, (LAS float*)(ldsl + RES_EX_OFF), (float*)(ws + WS_SLAB)};
        pg8::gemm_phase<pg8::EpiProj1, pg8::StaticOrder, true, true>(ldsl + RING_OFF, g, S, E, wave * 64 + fresh_lane());
        { const Params p2 = load_params(); tail_reduce<2>(p2, S, 1, wave, fresh_lane()); }
    }
    SEAM(7);
    if (IN(9)) { const Params p = load_params(); att::gqa_phase(p, (char*)lds, vcu, G, wave, mode); }
    SEAM(9);
    if (IN(10)) {
        const Params p = load_params(); unsigned char* const ws = p.ws;
        pg8::Gemm g{(const bf16_t*)(ws + WS_HY), (const bf16_t*)(ws + WS_WOUTO), MT, DM, DM, DM, DM, 0, 0, 0}; pg8::StaticOrder S; S.init(MT, DM, DM, G, bx, false);
        pg8::EpiResidF E{p.x_prompt, p.x_sample, p.out, (const float*)(ws + WS_MOD) + 3 * 6144 + 4096, p.out, (float*)(ws + WS_SLAB)};
        pg8::gemm_phase<pg8::EpiResidF, pg8::StaticOrder, true, true>(ldsl + RING_OFF, g, S, E, wave * 64 + fresh_lane());
        { const Params p2 = load_params(); tail_reduce<1>(p2, S, 2, wave, fresh_lane()); }
    }
#undef IN
#undef SEAM
}

#ifndef MK_PER_PHASE
#define MK_PER_PHASE 0
#endif
extern "C" void kernel_launch(void* const* d_in, const int* in_sizes, int n_in, void* d_out, int out_size, void* d_ws, size_t ws_size, hipStream_t stream) {
    if (n_in != 26 || ws_size < WS_END || out_size != MT * DM + 2 * NBP * HA * SEQP * 128 + 2 * NBP * KVH * SEQP * 128) {
        fprintf(stderr, "kernel_launch: unexpected shapes n_in %d ws %zu out %d\n", n_in, ws_size, out_size); return; }
    static int ready = 0;
    if (!ready) {
        if (hipFuncSetAttribute((const void*)mega_fwd, hipFuncAttributeMaxDynamicSharedMemorySize, LDS_BYTES) != hipSuccess) { fprintf(stderr, "kernel_launch: hipFuncSetAttribute failed\n"); return; }
        ready = 1;
    }
    MegaArgs a{};
    const float** pin = (const float**)&a.p;
    for (int i = 0; i < 26; ++i) pin[i] = (const float*)d_in[i];
    a.p.out = (float*)d_out; a.p.ws = (unsigned char*)d_ws;
#ifdef EXTRA_PHASE
    (void)hipMemsetAsync((unsigned char*)d_ws + WS_CTL, 0, 2 * MiB, stream);
    a.ph_lo = EXTRA_PHASE; a.ph_hi = EXTRA_PHASE + 1; hipLaunchKernelGGL(mega_fwd, dim3(256), dim3(NWAVES * 64), LDS_BYTES, stream, a);
#endif
    (void)hipMemsetAsync((unsigned char*)d_ws + WS_CTL, 0, 2 * MiB, stream);
#if MK_PER_PHASE
    for (int ph = 0; ph < N_PHASES; ++ph) { a.ph_lo = ph; a.ph_hi = ph + 1; hipLaunchKernelGGL(mega_fwd, dim3(256), dim3(NWAVES * 64), LDS_BYTES, stream, a); }
#else
    a.ph_lo = 0; a.ph_hi = N_PHASES; hipLaunchKernelGGL(mega_fwd, dim3(256), dim3(NWAVES * 64), LDS_BYTES, stream, a);
#endif
#ifdef EXTRA_AFTER
    (void)hipMemsetAsync((unsigned char*)d_ws + WS_CTL, 0, 1 * MiB, stream);
    a.ph_lo = EXTRA_AFTER; a.ph_hi = EXTRA_AFTER + 1; a.mode = EXTRA_MODE; hipLaunchKernelGGL(mega_fwd, dim3(256), dim3(NWAVES * 64), LDS_BYTES, stream, a);
#endif
}
```

```cpp
#include <hip/hip_runtime.h>
#include <cstdio>
#include <cstdint>

typedef unsigned short bf16_t;
typedef float f32x4 __attribute__((ext_vector_type(4)));
typedef unsigned u32x4 __attribute__((ext_vector_type(4)));
typedef unsigned u32x2 __attribute__((ext_vector_type(2)));

constexpr int DM = 2048, NBP = 32, SEQP = 256, NBS = 2, SEQS = 1024, PAST = 256;
constexpr int MP = NBP * SEQP, MS = NBS * SEQS, MT = MP + MS;
constexpr int HA = 8, DKA = 64, DVA = 128, WA = 1024, WB = 1024, GWB = 256;
constexpr int EVEN_IN = 6144, ODD_IN = 5120;
constexpr int HC = 16, KVH = 4, HDC = 128;
constexpr int LKS = PAST + SEQS;
constexpr float EPS = 1e-6f;
constexpr float LOG2E = 1.4426950408889634f;
constexpr float C2A = 0.125f * LOG2E;
constexpr float C2C = 0.08838834764831845f * LOG2E;

constexpr size_t MiB = 1u << 20;
constexpr size_t WS_CTL = 0;
constexpr size_t WS_MOD = 1 * MiB;
constexpr size_t WS_ROPE = 2 * MiB;
constexpr size_t WS_WINE = 4 * MiB;
constexpr size_t WS_WOUTE = 28 * MiB;
constexpr size_t WS_WINO = 36 * MiB;
constexpr size_t WS_WOUTO = 56 * MiB;
constexpr size_t WS_POOLW = 64 * MiB;
constexpr size_t WS_HY = 65 * MiB;
constexpr size_t WS_PR = 105 * MiB;
constexpr size_t WS_Q = 225 * MiB;
constexpr size_t WS_KP = 265 * MiB;
constexpr size_t WS_VP = 281 * MiB;
constexpr size_t WS_KSA = 297 * MiB;
constexpr size_t WS_VSA = 302 * MiB;
constexpr size_t WS_KSC = 307 * MiB;
constexpr size_t WS_VSC = 310 * MiB;
constexpr size_t WS_UA = 313 * MiB;
constexpr size_t WS_SG = WS_PR;
constexpr size_t WS_U = WS_PR + 40 * MiB;
constexpr size_t WS_H1 = 333 * MiB;
constexpr size_t WS_WU = WS_UA;
constexpr size_t WS_END = 373 * MiB;
constexpr size_t WS_CW1 = WS_MOD + 256 * 1024;
constexpr size_t WS_B2P = WS_MOD + 320 * 1024;
constexpr size_t WS_RSS = WS_MOD + 512 * 1024;

struct Params {
    const float* x_prompt; const float* x_sample; const float* cache_a_k; const float* cache_a_v; const float* cache_c_k; const float* cache_c_v;
    const float* c; const float* c_ctx; const float* norm_w; const float* ada_w; const float* ada_b;
    const float* even_w_in; const float* even_q_norm_w; const float* even_k_norm_w; const float* lam_q1; const float* lam_k1; const float* lam_q2; const float* lam_k2;
    const float* subln_w; const float* pool_w; const float* pool_scale; const float* even_w_out;
    const float* gqa_w_in; const float* gqa_q_norm_w; const float* gqa_k_norm_w; const float* gqa_w_out;
    float* out; unsigned char* ws;
};

__device__ __forceinline__ unsigned f2bf(float f) { unsigned u = __builtin_bit_cast(unsigned, f); return (u + 0x7fffu + ((u >> 16) & 1u)) >> 16; }
__device__ __forceinline__ unsigned pk2(float lo, float hi) { return f2bf(lo) | (f2bf(hi) << 16); }
__device__ __forceinline__ float bf2f(unsigned h) { return __builtin_bit_cast(float, h << 16); }
__device__ __forceinline__ float bflo(unsigned w) { return __builtin_bit_cast(float, w << 16); }
__device__ __forceinline__ float bfhi(unsigned w) { return __builtin_bit_cast(float, w & 0xffff0000u); }
__device__ __forceinline__ float siluf(float x) { return x / (1.f + __expf(-x)); }
__device__ __forceinline__ float wave_sum(float v) {
#pragma unroll
    for (int o = 1; o < 64; o <<= 1) v += __shfl_xor(v, o);
    return v;
}
__device__ __forceinline__ float wave_max(float v) {
#pragma unroll
    for (int o = 1; o < 64; o <<= 1) v = fmaxf(v, __shfl_xor(v, o));
    return v;
}
__device__ __forceinline__ int fresh_lane() { int l; asm volatile("v_mbcnt_lo_u32_b32 %0, -1, 0\n\tv_mbcnt_hi_u32_b32 %0, -1, %0" : "=v"(l)); return l; }
__device__ __forceinline__ const float* xrow_ptr(const Params& p, int m) { return m < MP ? p.x_prompt + (size_t)m * DM : p.x_sample + (size_t)(m - MP) * DM; }
__device__ __forceinline__ int cond_row(int m) { return m < MP ? 0 : 1 + ((m - MP) >> 10); }

__device__ __forceinline__ void mod_items(const Params& p, float* sl  , int bid, int nb, int tid, int nthr) {
    float* mod = (float*)(p.ws + WS_MOD);
    for (int it = bid; it < 256; it += nb) {
        const int l = it >> 7, kc = (it >> 2) & 31, nc = it & 3;
        __syncthreads();
        for (int i = tid; i < 192; i += nthr) { const int r = i >> 6, kk = i & 63, k = kc * 64 + kk; const float cv = r == 0 ? p.c_ctx[k] : p.c[(r - 1) * DM + k]; sl[i] = siluf(cv); }
        __syncthreads();
        for (int q = tid; q < 384; q += nthr) {
            const int n = nc * 1536 + q * 4;
            const float* w = p.ada_w + ((size_t)l * DM + kc * 64) * 6144 + n;
            f32x4 a0 = {0.f, 0.f, 0.f, 0.f}, a1 = a0, a2 = a0;
#pragma unroll 16
            for (int kk = 0; kk < 64; ++kk) { const f32x4 wv = *(const f32x4*)(w + (size_t)kk * 6144); a0 += wv * sl[kk]; a1 += wv * sl[64 + kk]; a2 += wv * sl[128 + kk]; }
            if (kc == 0) { const f32x4 b = *(const f32x4*)(p.ada_b + l * 6144 + n); a0 += b; a1 += b; a2 += b; }
            float* m0 = mod + (size_t)(l * 3) * 6144 + n;
#pragma unroll
            for (int e = 0; e < 4; ++e) { atomicAdd(m0 + e, a0[e]); atomicAdd(m0 + 6144 + e, a1[e]); atomicAdd(m0 + 2 * 6144 + e, a2[e]); }
        }
    }
}

__device__ __forceinline__ void transpose_item(const float* W, int K, int N, bf16_t* WT, float* scr, int item, int lane) {
    const int nblk = N / 32, kb = item / nblk, nb = item % nblk, k0 = 64 * kb, n0 = 32 * nb;
#pragma unroll 8
    for (int i = 0; i < 32; ++i) { const int kk = 2 * i + (lane >> 5); scr[kk * 33 + (lane & 31)] = W[(size_t)(k0 + kk) * N + n0 + (lane & 31)]; }
    __builtin_amdgcn_s_waitcnt(0xc07f); asm volatile("" ::: "memory");
    const int c = lane & 7;
#pragma unroll
    for (int j = 0; j < 4; ++j) { const int n = (lane >> 3) + 8 * j; const float* s = scr + (8 * c) * 33 + n;
        u32x4 o; o.x = pk2(s[0 * 33], s[1 * 33]); o.y = pk2(s[2 * 33], s[3 * 33]); o.z = pk2(s[4 * 33], s[5 * 33]); o.w = pk2(s[6 * 33], s[7 * 33]);
        *(u32x4*)(WT + (size_t)(n0 + n) * K + k0 + 8 * c) = o; }
    __builtin_amdgcn_s_waitcnt(0xc07f); asm volatile("" ::: "memory");
}
template <int PERMK> __device__ __forceinline__ int pos_of_col(int n) {
    if (PERMK == 1) { if (n >= 2048) return n; const int c = n & 255, wc = c >> 6, dim = c & 63, q = dim >> 4, ii = dim & 15; return (n & ~255) + 128 * (q & 1) + 32 * wc + (q >> 1) * 16 + ii; }
    if (PERMK == 2) { if (n >= 2560) return n; const int c = n & 255, hl = c >> 7, dim = c & 127, qd = dim >> 5, i = dim & 31; return (n & ~255) + 128 * (qd & 1) + 32 * (2 * hl + (qd >> 1)) + i; }
    return n;
}
template <int PERMK> __device__ __forceinline__ void transpose_item64(const float* W, int K, int N, bf16_t* WT, bf16_t* scr, int item, int lane) {
    const int nblk = N / 64, kb = item / nblk, nb = item % nblk, k0 = 64 * kb, n0 = 64 * nb;
    const int nq = lane & 15, kr = lane >> 4;
    f32x4 v[16];
    const float* src = W + (size_t)(k0 + kr) * N + n0 + 4 * nq;
#pragma unroll
    for (int i = 0; i < 16; ++i) v[i] = *(const f32x4*)(src + (size_t)(4 * i) * N);
#pragma unroll
    for (int i = 0; i < 16; ++i) { const int k = 4 * i + kr;
#pragma unroll
        for (int e = 0; e < 4; ++e) scr[(4 * nq + e) * 72 + k] = (bf16_t)f2bf(v[i][e]); }
    __builtin_amdgcn_s_waitcnt(0xc07f); asm volatile("" ::: "memory");
#pragma unroll
    for (int j = 0; j < 8; ++j) { const int idx = lane + 64 * j, n = idx >> 3, c = idx & 7;
        *(u32x4*)(WT + (size_t)pos_of_col<PERMK>(n0 + n) * K + k0 + 8 * c) = *(const u32x4*)(scr + n * 72 + 8 * c); }
    __builtin_amdgcn_s_waitcnt(0xc07f); asm volatile("" ::: "memory");
}
__device__ __forceinline__ void convert_item64(const float* W, int N, bf16_t* WU, int ldu, int ncol0, int item, int nblk0, int lane) {
    const int nblk = N / 64, kb = item / nblk, nb = item % nblk, k0 = 64 * kb, n0 = 64 * nb;
    const int nq = lane & 15, kr = lane >> 4;
    const float* src = W + (size_t)(k0 + kr) * N + n0 + 4 * nq;
    f32x4 v[16];
#pragma unroll
    for (int i = 0; i < 16; ++i) v[i] = *(const f32x4*)(src + (size_t)(4 * i) * N);
#pragma unroll
    for (int i = 0; i < 16; ++i) { u32x2 o; o.x = pk2(v[i][0], v[i][1]); o.y = pk2(v[i][2], v[i][3]); *(u32x2*)(WU + (size_t)(k0 + 4 * i + kr) * ldu + (n0 - ncol0) + 4 * nq) = o; }
}
__device__ __forceinline__ void weights_items(const Params& p, float* scrf  , int gw, int ngw, int lane) {
    bf16_t* scr = (bf16_t*)scrf;
    constexpr int I_WINE = 32 * (EVEN_IN / 64), I_WOUT = 32 * (DM / 64), I_WINO = 32 * (ODD_IN / 64), I_POOL = 4 * 4;
    constexpr int NITEMS = I_WINE + I_WOUT + I_WINO + I_WOUT + 4 * I_POOL;
    for (int it = gw; it < NITEMS; it += ngw) {
        int r = it;
        if (r < I_WINE) { const int nb = r % (EVEN_IN / 64);
            if (nb >= 48 && nb < 64) convert_item64(p.even_w_in, EVEN_IN, (bf16_t*)(p.ws + WS_WU), 1024, 3072, r, 0, lane);
            else transpose_item64<1>(p.even_w_in, DM, EVEN_IN, (bf16_t*)(p.ws + WS_WINE), scr, r, lane);
            continue; } r -= I_WINE;
        if (r < I_WOUT) { transpose_item64<0>(p.even_w_out, DM, DM, (bf16_t*)(p.ws + WS_WOUTE), scr, r, lane); continue; } r -= I_WOUT;
        if (r < I_WINO) { transpose_item64<2>(p.gqa_w_in, DM, ODD_IN, (bf16_t*)(p.ws + WS_WINO), scr, r, lane); continue; } r -= I_WINO;
        if (r < I_WOUT) { transpose_item64<0>(p.gqa_w_out, DM, DM, (bf16_t*)(p.ws + WS_WOUTO), scr, r, lane); continue; } r -= I_WOUT;
        const int g = r / I_POOL; r -= g * I_POOL;
        transpose_item64<0>(p.pool_w + (size_t)g * 65536, 256, 256, (bf16_t*)(p.ws + WS_POOLW) + (size_t)g * 65536, scr, r, lane);
    }
}
__device__ __forceinline__ void caches_rope_items(const Params& p, long gt, long ngt) {
    constexpr long NA = 2L * 8 * 256 * 128 / 4, NC = 2L * 4 * 256 * 128 / 4;
    for (long i = gt; i < 2 * NA + 2 * NC; i += ngt) {
        long j = i; const float* src; bf16_t* dst;
        if (j < NA) { src = p.cache_a_k; dst = (bf16_t*)(p.ws + WS_KSA); } else if ((j -= NA) < NA) { src = p.cache_a_v; dst = (bf16_t*)(p.ws + WS_VSA); }
        else if ((j -= NA) < NC) { src = p.cache_c_k; dst = (bf16_t*)(p.ws + WS_KSC); } else { j -= NC; src = p.cache_c_v; dst = (bf16_t*)(p.ws + WS_VSC); }
        const long e = j * 4, bh = e / (256 * 128), rem = e % (256 * 128);
        const f32x4 v = *(const f32x4*)(src + e);
        u32x2 o; o.x = pk2(v[0], v[1]); o.y = pk2(v[2], v[3]);
        *(u32x2*)(dst + bh * (LKS * 128) + rem) = o;
    }
    float* ropeA = (float*)(p.ws + WS_ROPE); float* ropeC = ropeA + 2 * 1024 * 64;
    for (long i = gt; i < 1024L * 64 + 1024L * 128; i += ngt) {
        const bool isA = i < 1024L * 64; const long j = isA ? i : i - 1024L * 64; const int dim = isA ? 64 : 128, quarter = dim / 4;
        const int t = (int)(j / dim), d = (int)(j % dim); const int qd = d / quarter, fi = d % quarter;
        const float freq = powf(10000.0f, -(float)fi / (float)quarter);
        const float pos = (qd < 2) ? (float)(t / 64) : (float)(t % 64);
        const float ang = pos * freq;
        float* base = isA ? ropeA : ropeC;
        base[j] = cosf(ang); base[(size_t)1024 * dim + j] = sinf(ang);
    }
}

__device__ __forceinline__ void modulate_rows(const Params& p, int layer, int gw, int ngw, int lane) {
    const float* mod = (const float*)(p.ws + WS_MOD) + (size_t)layer * 3 * 6144;
    const float* nw = p.norm_w + layer * DM;
    bf16_t* H = (bf16_t*)(p.ws + WS_HY);
    for (int m = gw; m < MT; m += ngw) {
        const float* xr = layer == 0 ? xrow_ptr(p, m) : p.out + (size_t)m * DM;
        const float* mr = mod + (size_t)cond_row(m) * 6144;
        f32x4 v[8]; float ss = 0.f;
#pragma unroll
        for (int j = 0; j < 8; ++j) { v[j] = *(const f32x4*)(xr + 4 * lane + 256 * j); ss += (v[j][0] * v[j][0] + v[j][1] * v[j][1]) + (v[j][2] * v[j][2] + v[j][3] * v[j][3]); }
        const float rstd = 1.0f / sqrtf(wave_sum(ss) * (1.f / DM) + EPS);
#pragma unroll
        for (int j = 0; j < 8; ++j) { const int k = 4 * lane + 256 * j;
            const f32x4 w = *(const f32x4*)(nw + k), sh = *(const f32x4*)(mr + k), sc = *(const f32x4*)(mr + 2048 + k);
            const f32x4 h = v[j] * rstd * w * (sc + 1.0f) + sh;
            u32x2 o; o.x = pk2(h[0], h[1]); o.y = pk2(h[2], h[3]);
            *(u32x2*)(H + (size_t)m * DM + k) = o; }
    }
}

__device__ __forceinline__ void mod1_tables(const Params& p, int gw, int ngw, int lane) {
    const float* mod1 = (const float*)(p.ws + WS_MOD) + 3 * 6144;
    float* cw1 = (float*)(p.ws + WS_CW1); float* b2p = (float*)(p.ws + WS_B2P);
    for (int i = gw * 64 + lane; i < 3 * DM; i += ngw * 64) { const int cr = i / DM, k = i % DM; cw1[i] = p.norm_w[DM + k] * (1.f + mod1[cr * 6144 + 2048 + k]); }
    const bf16_t* W = (const bf16_t*)(p.ws + WS_WINO);
    for (int r = gw; r < ODD_IN; r += ngw) {
        float a0 = 0.f, a1 = 0.f, a2 = 0.f;
#pragma unroll
        for (int j = 0; j < 4; ++j) { const int k = 8 * lane + 512 * j; const u32x4 w = *(const u32x4*)(W + (size_t)r * DM + k);
            const float wf[8] = {bflo(w.x), bfhi(w.x), bflo(w.y), bfhi(w.y), bflo(w.z), bfhi(w.z), bflo(w.w), bfhi(w.w)};
#pragma unroll
            for (int e = 0; e < 8; ++e) { a0 += wf[e] * mod1[k + e]; a1 += wf[e] * mod1[6144 + k + e]; a2 += wf[e] * mod1[2 * 6144 + k + e]; } }
        a0 = wave_sum(a0); a1 = wave_sum(a1); a2 = wave_sum(a2);
        if (lane == 0) { b2p[r] = a0; b2p[ODD_IN + r] = a1; b2p[2 * ODD_IN + r] = a2; }
    }
}
template <int DIM>
__device__ __forceinline__ f32x4 norm_rope4(f32x4 v, int lg  , const float* w, bool rope, const float* cosr, const float* sinr) {
    float ss = (v[0] * v[0] + v[1] * v[1]) + (v[2] * v[2] + v[3] * v[3]);
#pragma unroll
    for (int o = 1; o < DIM / 4; o <<= 1) ss += __shfl_xor(ss, o);
    const float r = 1.0f / sqrtf(ss * (1.f / DIM) + EPS);
    const f32x4 wv = *(const f32x4*)(w + 4 * lg);
    f32x4 y = v * r * wv;
    f32x4 pr;
#pragma unroll
    for (int e = 0; e < 4; ++e) pr[e] = __shfl_xor(y[e], DIM / 16);
    if (rope) {
        const f32x4 cs = *(const f32x4*)(cosr + 4 * lg), sn = *(const f32x4*)(sinr + 4 * lg);
        const bool odd = ((lg / (DIM / 16)) & 1) != 0;
        y = odd ? (y * cs + pr * sn) : (y * cs - pr * sn);
    }
    return y;
}

__device__ __forceinline__ void post0_rows(const Params& p, int gw, int ngw, int lane) {
    const bf16_t* PR = (const bf16_t*)(p.ws + WS_PR);
    bf16_t* QA = (bf16_t*)(p.ws + WS_Q); bf16_t* UA = (bf16_t*)(p.ws + WS_UA);
    const float* ropeA = (const float*)(p.ws + WS_ROPE);
    float* new_a_k = p.out + (size_t)MT * DM; float* new_a_v = new_a_k + (size_t)NBP * HA * SEQP * 128;
    for (int m = gw; m < MT; m += ngw) {
        const bool smp = m >= MP; const int b = smp ? (m - MP) >> 10 : m >> 8, t = smp ? (m - MP) & 1023 : m & 255;
        const bf16_t* pr = PR + (size_t)m * EVEN_IN;
        const float* cosr = ropeA + (size_t)t * 64; const float* sinr = ropeA + 1024 * 64 + (size_t)t * 64;
        const int sub = lane >> 4, lg = lane & 15;
#pragma unroll 2
        for (int st = 0; st < 8; ++st) {
            const int grp = st * 4 + sub;
            const u32x2 raw = *(const u32x2*)(pr + grp * 64 + 4 * lg);
            f32x4 v = {bflo(raw.x), bfhi(raw.x), bflo(raw.y), bfhi(raw.y)};
            const bool isk = grp >= 16;
            f32x4 y = norm_rope4<64>(v, lg, isk ? p.even_k_norm_w : p.even_q_norm_w, smp, cosr, sinr);
            if (!isk) { y = y * C2A; u32x2 o; o.x = pk2(y[0], y[1]); o.y = pk2(y[2], y[3]); *(u32x2*)(QA + (size_t)m * 1024 + grp * 64 + 4 * lg) = o; }
            else { const int g2 = grp - 16, h = g2 >> 1, j = g2 & 1;
                u32x2 o; o.x = pk2(y[0], y[1]); o.y = pk2(y[2], y[3]);
                if (smp) *(u32x2*)((bf16_t*)(p.ws + WS_KSA) + ((size_t)(b * HA + h) * LKS + PAST + t) * 128 + j * 64 + 4 * lg) = o;
                else { const size_t off = ((size_t)(b * HA + h) * SEQP + t) * 128 + j * 64 + 4 * lg; *(u32x2*)((bf16_t*)(p.ws + WS_KP) + off) = o; *(f32x4*)(new_a_k + off) = y; } }
        }
#pragma unroll
        for (int i = 0; i < 2; ++i) { const int c = 8 * lane + 512 * i, h = c >> 7, d = c & 127;
            const u32x4 raw = *(const u32x4*)(pr + 2048 + c);
            if (smp) *(u32x4*)((bf16_t*)(p.ws + WS_VSA) + ((size_t)(b * HA + h) * LKS + PAST + t) * 128 + d) = raw;
            else { const size_t off = ((size_t)(b * HA + h) * SEQP + t) * 128 + d; *(u32x4*)((bf16_t*)(p.ws + WS_VP) + off) = raw;
                *(f32x4*)(new_a_v + off) = (f32x4){bflo(raw.x), bfhi(raw.x), bflo(raw.y), bfhi(raw.y)}; *(f32x4*)(new_a_v + off + 4) = (f32x4){bflo(raw.z), bfhi(raw.z), bflo(raw.w), bfhi(raw.w)}; } }
        const int L = smp ? SEQS : SEQP;
#pragma unroll
        for (int i = 0; i < 2; ++i) { const int ch = lane + 64 * i, c = 8 * ch, g = ch >> 5, half = 1 << g;
            const int lo = max(t - half, 0), hi = min(t + half, L);
            float s[8] = {0.f, 0.f, 0.f, 0.f, 0.f, 0.f, 0.f, 0.f};
            for (int tt = lo; tt < hi; ++tt) { const u32x4 raw = *(const u32x4*)(pr + (ptrdiff_t)(tt - t) * EVEN_IN + 3072 + c);
                s[0] += bflo(raw.x); s[1] += bfhi(raw.x); s[2] += bflo(raw.y); s[3] += bfhi(raw.y); s[4] += bflo(raw.z); s[5] += bfhi(raw.z); s[6] += bflo(raw.w); s[7] += bfhi(raw.w); }
            const float inv = 1.0f / (float)(hi - lo);
            const u32x4 own = *(const u32x4*)(pr + 3072 + c);
            u32x4 o; o.x = pk2(s[0] * inv - bflo(own.x), s[1] * inv - bfhi(own.x)); o.y = pk2(s[2] * inv - bflo(own.y), s[3] * inv - bfhi(own.y));
            o.z = pk2(s[4] * inv - bflo(own.z), s[5] * inv - bfhi(own.z)); o.w = pk2(s[6] * inv - bflo(own.w), s[7] * inv - bfhi(own.w));
            *(u32x4*)(UA + (size_t)m * 1024 + c) = o; }
    }
}

__device__ __forceinline__ void pool_rows(const Params& p, int gw, int ngw, int lane) {
    const bf16_t* U = (const bf16_t*)(p.ws + WS_U); bf16_t* UA = (bf16_t*)(p.ws + WS_UA);
    for (int m = gw; m < MT; m += ngw) {
        const bool smp = m >= MP; const int t = smp ? (m - MP) & 1023 : m & 255, L = smp ? SEQS : SEQP;
        const bf16_t* pr = U + (size_t)m * 1024;
#pragma unroll
        for (int i = 0; i < 2; ++i) { const int ch = lane + 64 * i, c = 8 * ch, g = ch >> 5, half = 1 << g;
            const int lo = max(t - half, 0), hi = min(t + half, L);
            float s[8] = {0.f, 0.f, 0.f, 0.f, 0.f, 0.f, 0.f, 0.f};
            for (int tt = lo; tt < hi; ++tt) { const u32x4 raw = *(const u32x4*)(pr + (ptrdiff_t)(tt - t) * 1024 + c);
                s[0] += bflo(raw.x); s[1] += bfhi(raw.x); s[2] += bflo(raw.y); s[3] += bfhi(raw.y); s[4] += bflo(raw.z); s[5] += bfhi(raw.z); s[6] += bflo(raw.w); s[7] += bfhi(raw.w); }
            const float inv = 1.0f / (float)(hi - lo);
            const u32x4 own = *(const u32x4*)(pr + c);
            u32x4 o; o.x = pk2(s[0] * inv - bflo(own.x), s[1] * inv - bfhi(own.x)); o.y = pk2(s[2] * inv - bflo(own.y), s[3] * inv - bfhi(own.y));
            o.z = pk2(s[4] * inv - bflo(own.z), s[5] * inv - bfhi(own.z)); o.w = pk2(s[6] * inv - bflo(own.w), s[7] * inv - bfhi(own.w));
            *(u32x4*)(UA + (size_t)m * 1024 + c) = o; }
    }
}
__device__ __forceinline__ void post1_rows(const Params& p, int gw, int ngw, int lane) {
    const bf16_t* PR = (const bf16_t*)(p.ws + WS_PR);
    bf16_t* QC = (bf16_t*)(p.ws + WS_Q);
    const float* ropeC = (const float*)(p.ws + WS_ROPE) + 2 * 1024 * 64;
    float* new_c_k = p.out + (size_t)MT * DM + 2 * (size_t)NBP * HA * SEQP * 128; float* new_c_v = new_c_k + (size_t)NBP * KVH * SEQP * 128;
    for (int m = gw; m < MT; m += ngw) {
        const bool smp = m >= MP; const int b = smp ? (m - MP) >> 10 : m >> 8, t = smp ? (m - MP) & 1023 : m & 255;
        const bf16_t* pr = PR + (size_t)m * ODD_IN;
        const float* cosr = ropeC + (size_t)t * 128; const float* sinr = ropeC + 1024 * 128 + (size_t)t * 128;
        const int sub = lane >> 5, lg = lane & 31;
#pragma unroll 2
        for (int st = 0; st < 10; ++st) {
            const int grp = st * 2 + sub;
            const u32x2 raw = *(const u32x2*)(pr + grp * 128 + 4 * lg);
            f32x4 v = {bflo(raw.x), bfhi(raw.x), bflo(raw.y), bfhi(raw.y)};
            const bool isk = grp >= 16;
            f32x4 y = norm_rope4<128>(v, lg, isk ? p.gqa_k_norm_w : p.gqa_q_norm_w, smp, cosr, sinr);
            if (!isk) { y = y * C2C; u32x2 o; o.x = pk2(y[0], y[1]); o.y = pk2(y[2], y[3]); *(u32x2*)(QC + (size_t)m * DM + grp * 128 + 4 * lg) = o; }
            else { const int kh = grp - 16;
                u32x2 o; o.x = pk2(y[0], y[1]); o.y = pk2(y[2], y[3]);
                if (smp) *(u32x2*)((bf16_t*)(p.ws + WS_KSC) + ((size_t)(b * KVH + kh) * LKS + PAST + t) * 128 + 4 * lg) = o;
                else { const size_t off = ((size_t)(b * KVH + kh) * SEQP + t) * 128 + 4 * lg; *(u32x2*)((bf16_t*)(p.ws + WS_KP) + off) = o; *(f32x4*)(new_c_k + off) = y; } }
        }
        { const int c = 8 * lane, kh = c >> 7, d = c & 127;
            const u32x4 raw = *(const u32x4*)(pr + 2560 + c);
            if (smp) *(u32x4*)((bf16_t*)(p.ws + WS_VSC) + ((size_t)(b * KVH + kh) * LKS + PAST + t) * 128 + d) = raw;
            else { const size_t off = ((size_t)(b * KVH + kh) * SEQP + t) * 128 + d; *(u32x4*)((bf16_t*)(p.ws + WS_VP) + off) = raw;
                *(f32x4*)(new_c_v + off) = (f32x4){bflo(raw.x), bfhi(raw.x), bflo(raw.y), bfhi(raw.y)}; *(f32x4*)(new_c_v + off + 4) = (f32x4){bflo(raw.z), bfhi(raw.z), bflo(raw.w), bfhi(raw.w)}; } }
    }
}

struct EpiStoreBf16 { bf16_t* C; int ldc; int pad; __device__ void operator()(int r, int c, float v) const { C[(size_t)r * ldc + c] = (bf16_t)f2bf(v); } };
struct EpiPool { bf16_t* Y; const bf16_t* PR; const float* pscale; int g; int pad;
    __device__ void operator()(int r, int c, float v) const { const int cc = g * 256 + c; const float gt = bf2f(PR[(size_t)r * EVEN_IN + 4096 + 1024 + cc]);
        Y[(size_t)r * DM + 1024 + cc] = (bf16_t)f2bf(v * pscale[cc] * siluf(gt)); } };
struct EpiResid { const float* x_prompt; const float* x_sample; const float* base; const float* gate; float* out;
    __device__ void operator()(int r, int c, float v) const { const float bs = base ? base[(size_t)r * DM + c] : (r < MP ? x_prompt[(size_t)r * DM + c] : x_sample[(size_t)(r - MP) * DM + c]);
        out[(size_t)r * DM + c] = bs + gate[(size_t)cond_row(r) * 6144 + c] * v; } };
template <class Epi>
__global__ __launch_bounds__(256) void gemm_naive(const bf16_t* A, int lda, const bf16_t* Bt, int ldb, int M, int N, int K, Epi E) {
    __shared__ float As[16][65], Bs[16][65];
    const int tid = threadIdx.x, tx = tid & 15, ty = tid >> 4;
    const int nbn = N / 64, bm = blockIdx.x / nbn, bn = blockIdx.x % nbn;
    float acc[4][4] = {};
    const int lr = tid >> 2, lc = (tid & 3) * 4;
    for (int k0 = 0; k0 < K; k0 += 16) {
        const u32x2 ra = *(const u32x2*)(A + (size_t)(bm * 64 + lr) * lda + k0 + lc), rb = *(const u32x2*)(Bt + (size_t)(bn * 64 + lr) * ldb + k0 + lc);
        __syncthreads();
        As[lc + 0][lr] = bflo(ra.x); As[lc + 1][lr] = bfhi(ra.x); As[lc + 2][lr] = bflo(ra.y); As[lc + 3][lr] = bfhi(ra.y);
        Bs[lc + 0][lr] = bflo(rb.x); Bs[lc + 1][lr] = bfhi(rb.x); Bs[lc + 2][lr] = bflo(rb.y); Bs[lc + 3][lr] = bfhi(rb.y);
        __syncthreads();
#pragma unroll
        for (int kk = 0; kk < 16; ++kk) { float a[4], b[4];
#pragma unroll
            for (int i = 0; i < 4; ++i) { a[i] = As[kk][ty * 4 + i]; b[i] = Bs[kk][tx * 4 + i]; }
#pragma unroll
            for (int i = 0; i < 4; ++i)
#pragma unroll
                for (int j = 0; j < 4; ++j) acc[i][j] += a[i] * b[j]; }
    }
#pragma unroll
    for (int i = 0; i < 4; ++i)
#pragma unroll
        for (int j = 0; j < 4; ++j) E(bm * 64 + ty * 4 + i, bn * 64 + tx * 4 + j, acc[i][j]);
}

__device__ __forceinline__ void diffattn_tasks(const Params& p, float* s1  , long gw, long ngw, int lane) {
    float* s2 = s1 + LKS; float* qs = s2 + LKS;
    const bf16_t* QA = (const bf16_t*)(p.ws + WS_Q); const bf16_t* PR = (const bf16_t*)(p.ws + WS_PR); bf16_t* Y = (bf16_t*)(p.ws + WS_HY);
    const float lam_init = 0.2f;
    const float lam = expf(wave_sum(p.lam_q1[lane] * p.lam_k1[lane])) - expf(wave_sum(p.lam_q2[lane] * p.lam_k2[lane])) + lam_init;
    for (long task = gw; task < (long)MT * HA; task += ngw) {
        const int m = (int)(task / HA), h = (int)(task % HA);
        const bool smp = m >= MP; const int b = smp ? (m - MP) >> 10 : m >> 8; const int Lk = smp ? LKS : SEQP;
        const bf16_t* Kb = smp ? (const bf16_t*)(p.ws + WS_KSA) + (size_t)(b * HA + h) * LKS * 128 : (const bf16_t*)(p.ws + WS_KP) + (size_t)(b * HA + h) * SEQP * 128;
        const bf16_t* Vb = smp ? (const bf16_t*)(p.ws + WS_VSA) + (size_t)(b * HA + h) * LKS * 128 : (const bf16_t*)(p.ws + WS_VP) + (size_t)(b * HA + h) * SEQP * 128;
        { const unsigned w = *(const unsigned*)(QA + (size_t)m * 1024 + h * 128 + 2 * lane); qs[2 * lane] = bflo(w); qs[2 * lane + 1] = bfhi(w); }
        __builtin_amdgcn_s_waitcnt(0xc07f); asm volatile("" ::: "memory");
        float m1 = -1e30f, m2 = -1e30f;
        for (int j = lane; j < Lk; j += 64) { const bf16_t* kr = Kb + (size_t)j * 128; float a1 = 0.f, a2 = 0.f;
#pragma unroll
            for (int d8 = 0; d8 < 8; ++d8) { const u32x4 w1 = *(const u32x4*)(kr + d8 * 8), w2 = *(const u32x4*)(kr + 64 + d8 * 8); const float* q1 = qs + d8 * 8; const float* q2 = qs + 64 + d8 * 8;
                a1 += q1[0] * bflo(w1.x) + q1[1] * bfhi(w1.x) + q1[2] * bflo(w1.y) + q1[3] * bfhi(w1.y) + q1[4] * bflo(w1.z) + q1[5] * bfhi(w1.z) + q1[6] * bflo(w1.w) + q1[7] * bfhi(w1.w);
                a2 += q2[0] * bflo(w2.x) + q2[1] * bfhi(w2.x) + q2[2] * bflo(w2.y) + q2[3] * bfhi(w2.y) + q2[4] * bflo(w2.z) + q2[5] * bfhi(w2.z) + q2[6] * bflo(w2.w) + q2[7] * bfhi(w2.w); }
            s1[j] = a1; s2[j] = a2; m1 = fmaxf(m1, a1); m2 = fmaxf(m2, a2); }
        m1 = wave_max(m1); m2 = wave_max(m2);
        float l1 = 0.f, l2 = 0.f;
        for (int j = lane; j < Lk; j += 64) { const float e1 = exp2f(s1[j] - m1), e2 = exp2f(s2[j] - m2); s1[j] = e1; s2[j] = e2; l1 += e1; l2 += e2; }
        l1 = wave_sum(l1); l2 = wave_sum(l2);
        const float i1 = 1.f / l1, i2 = lam / l2;
        for (int j = lane; j < Lk; j += 64) s1[j] = s1[j] * i1 - s2[j] * i2;
        __builtin_amdgcn_s_waitcnt(0xc07f); asm volatile("" ::: "memory");
        float o0 = 0.f, o1 = 0.f;
        for (int j = 0; j < Lk; ++j) { const unsigned w = *(const unsigned*)(Vb + (size_t)j * 128 + 2 * lane); const float pj = s1[j]; o0 += pj * bflo(w); o1 += pj * bfhi(w); }
        const float r = 1.0f / sqrtf(wave_sum(o0 * o0 + o1 * o1) * (1.f / 128.f) + EPS);
        const unsigned gw = *(const unsigned*)(PR + (size_t)m * EVEN_IN + 4096 + h * 128 + 2 * lane);
        const float y0 = o0 * r * p.subln_w[2 * lane] * (1.f - lam_init) * siluf(bflo(gw)), y1 = o1 * r * p.subln_w[2 * lane + 1] * (1.f - lam_init) * siluf(bfhi(gw));
        *(unsigned*)(Y + (size_t)m * DM + h * 128 + 2 * lane) = pk2(y0, y1);
        __builtin_amdgcn_s_waitcnt(0xc07f); asm volatile("" ::: "memory");
    }
}
__device__ __forceinline__ void gqa_tasks(const Params& p, float* s1  , long gw, long ngw, int lane) {
    float* qs = s1 + LKS;
    const bf16_t* QC = (const bf16_t*)(p.ws + WS_Q); const bf16_t* PR = (const bf16_t*)(p.ws + WS_PR); bf16_t* Y = (bf16_t*)(p.ws + WS_HY);
    for (long task = gw; task < (long)MT * HC; task += ngw) {
        const int m = (int)(task / HC), hq = (int)(task % HC), kh = hq >> 2;
        const bool smp = m >= MP; const int b = smp ? (m - MP) >> 10 : m >> 8; const int Lk = smp ? LKS : SEQP;
        const bf16_t* Kb = smp ? (const bf16_t*)(p.ws + WS_KSC) + (size_t)(b * KVH + kh) * LKS * 128 : (const bf16_t*)(p.ws + WS_KP) + (size_t)(b * KVH + kh) * SEQP * 128;
        const bf16_t* Vb = smp ? (const bf16_t*)(p.ws + WS_VSC) + (size_t)(b * KVH + kh) * LKS * 128 : (const bf16_t*)(p.ws + WS_VP) + (size_t)(b * KVH + kh) * SEQP * 128;
        { const unsigned w = *(const unsigned*)(QC + (size_t)m * DM + hq * 128 + 2 * lane); qs[2 * lane] = bflo(w); qs[2 * lane + 1] = bfhi(w); }
        __builtin_amdgcn_s_waitcnt(0xc07f); asm volatile("" ::: "memory");
        float m1 = -1e30f;
        for (int j = lane; j < Lk; j += 64) { const bf16_t* kr = Kb + (size_t)j * 128; float a1 = 0.f;
#pragma unroll
            for (int d8 = 0; d8 < 16; ++d8) { const u32x4 w1 = *(const u32x4*)(kr + d8 * 8); const float* q1 = qs + d8 * 8;
                a1 += q1[0] * bflo(w1.x) + q1[1] * bfhi(w1.x) + q1[2] * bflo(w1.y) + q1[3] * bfhi(w1.y) + q1[4] * bflo(w1.z) + q1[5] * bfhi(w1.z) + q1[6] * bflo(w1.w) + q1[7] * bfhi(w1.w); }
            s1[j] = a1; m1 = fmaxf(m1, a1); }
        m1 = wave_max(m1);
        float l1 = 0.f;
        for (int j = lane; j < Lk; j += 64) { const float e1 = exp2f(s1[j] - m1); s1[j] = e1; l1 += e1; }
        l1 = wave_sum(l1);
        __builtin_amdgcn_s_waitcnt(0xc07f); asm volatile("" ::: "memory");
        float o0 = 0.f, o1 = 0.f;
        for (int j = 0; j < Lk; ++j) { const unsigned w = *(const unsigned*)(Vb + (size_t)j * 128 + 2 * lane); const float pj = s1[j]; o0 += pj * bflo(w); o1 += pj * bfhi(w); }
        const float il = 1.f / l1;
        const unsigned gw = *(const unsigned*)(PR + (size_t)m * ODD_IN + 3072 + hq * 128 + 2 * lane);
        *(unsigned*)(Y + (size_t)m * DM + hq * 128 + 2 * lane) = pk2(o0 * il * siluf(bflo(gw)), o1 * il * siluf(bfhi(gw)));
        __builtin_amdgcn_s_waitcnt(0xc07f); asm volatile("" ::: "memory");
    }
}

__global__ __launch_bounds__(256) void diffattn_naive(Params p) { __shared__ float sh[4][2 * LKS + 128]; diffattn_tasks(p, sh[threadIdx.x >> 6], (long)blockIdx.x * 4 + (threadIdx.x >> 6), (long)gridDim.x * 4, threadIdx.x & 63); }
__global__ __launch_bounds__(256) void gqa_naive(Params p) { __shared__ float sh[4][LKS + 128]; gqa_tasks(p, sh[threadIdx.x >> 6], (long)blockIdx.x * 4 + (threadIdx.x >> 6), (long)gridDim.x * 4, threadIdx.x & 63); }
__global__ __launch_bounds__(512) void k_prologue(Params p) {
    __shared__ float scr[8 * 2304];
    const int wid = threadIdx.x >> 6, lane = threadIdx.x & 63;
    mod_items(p, scr, blockIdx.x, gridDim.x, threadIdx.x, blockDim.x);
    __syncthreads();
    weights_items(p, scr + wid * 2304, blockIdx.x * 8 + wid, gridDim.x * 8, lane);
    caches_rope_items(p, (long)blockIdx.x * 512 + threadIdx.x, (long)gridDim.x * 512);
}
__global__ __launch_bounds__(512) void k_modulate(Params p, int layer) { modulate_rows(p, layer, blockIdx.x * 8 + (threadIdx.x >> 6), gridDim.x * 8, threadIdx.x & 63); }
__global__ __launch_bounds__(512) void k_post0(Params p) { post0_rows(p, blockIdx.x * 8 + (threadIdx.x >> 6), gridDim.x * 8, threadIdx.x & 63); }
__global__ __launch_bounds__(512) void k_post1(Params p) { post1_rows(p, blockIdx.x * 8 + (threadIdx.x >> 6), gridDim.x * 8, threadIdx.x & 63); }


namespace pg8 {
#define PG8_LAS __attribute__((address_space(3)))
typedef short bf16x8 __attribute__((ext_vector_type(8)));
constexpr int BM = 256, BK = 64, HALF = 128, HTB = HALF * BK * 2  , STAGE_BYTES = 8 * HTB, NXCD = 8, WGM = 8;
__host__ __device__ __forceinline__ int lds_byte(int r, int c) { const int st = (r >> 4) * 2 + (c >> 5), rr = r & 15, cc = c & 31, ob = rr * 64 + cc * 2; return st * 1024 + (ob ^ (((ob >> 9) & 1) << 5)); }
__host__ __device__ __forceinline__ void stage_rc(int b, int& R, int& C) { const int st = b / 1024, sb = b % 1024, swz = sb ^ (((sb >> 9) & 1) << 5); R = (st >> 1) * 16 + swz / 64; C = (st & 1) * 32 + (swz % 64) / 2; }
__host__ __device__ __forceinline__ int perm32(int rho) { const int n = rho >> 4, i = rho & 15; return 8 * (i >> 2) + 4 * n + (i & 3); }
struct Unit { int pm, pn, kt0, nkt, slab; };
struct Gemm { const bf16_t* A; const bf16_t* Bt; int M, N, K, lda, ldb, a_pn_off, b_pm_off, pad; };
struct StaticOrder {
    int nM, nN, nwg, G, c, KT, nfull, split;
    __host__ __device__ void init(int M, int N, int K, int G_, int c_, bool allow_split) { nM = M / BM; nN = N / BM; nwg = nM * nN; G = G_; c = c_; KT = K / BK;
        const int rem = nwg % G; split = (allow_split && rem && G % rem == 0 && (G % 8) == 0 && ((G / 8) % (G / rem)) == 0 && (KT % (2 * (G / rem))) == 0) ? G / rem : 1; nfull = split > 1 ? nwg - rem : nwg; }
    __host__ __device__ void tile(int wgid, Unit& u) const { const int nig = WGM * nN, gid = wgid / nig, fm = gid * WGM, gsz = (nM - fm) < WGM ? (nM - fm) : WGM; u.pm = fm + ((wgid % nig) % gsz); u.pn = (wgid % nig) / gsz; }
    __host__ __device__ bool next(int i, Unit& u) const {
        const long L = (long)i * G + c;
        if (L < nfull) { int wgid = (int)L; { const int q = nfull / NXCD, r = nfull % NXCD, xcd = wgid % NXCD, off = wgid / NXCD; wgid = (xcd < r ? xcd * (q + 1) : r * (q + 1) + (xcd - r) * q) + off; }
            tile(wgid, u); u.kt0 = 0; u.nkt = KT; u.slab = -1; return true; }
        if (split > 1 && L < nfull + G) { const int xcd = c % 8, q = c / 8, ks = q % split, j = (q / split) * 8 + xcd;
            tile(nfull + j, u); u.nkt = KT / split; u.kt0 = ks * u.nkt; u.slab = j * split + ks; return true; }
        return false;
    }
    __device__ __forceinline__ void a_ready(const Unit&) const {}
    __device__ __forceinline__ void done(const Unit&) const {}
};
struct OutOrder {
    int c, part;
    __device__ bool next(int i, Unit& u) const {
        if (i > 0) return false;
        u.kt0 = 0; u.nkt = DM / BK; u.slab = -1;
        if (part == 0) { const int wgid = (c % 8) * 32 + c / 8, idx = wgid % 64; u.pm = (wgid / 64) * 8 + idx % 8; u.pn = idx / 8; return true; }
        if (c >= 64) return false;
        u.pm = 32 + c / 8; u.pn = c % 8; return true;
    }
    __device__ __forceinline__ void a_ready(const Unit&) const {}
    __device__ __forceinline__ void done(const Unit&) const {}
};
struct StaggerOrder {
    int c; const unsigned* cnt; bool wait;
    __device__ bool next(int i, Unit& u) const {
        const int x = c % 8; u.kt0 = 0; u.nkt = DM / BK; u.slab = -1;
        if (c < 64) { if (i >= 2) return false; u.pm = 32 + x; u.pn = 2 * (c / 8) + i; return true; }
        const int e = (c - 64) / 8; int uidx;
        if (i < 3) uidx = i * 24 + e;
        else { if (i > 3 || e >= 12) return false; if (e >= 8) { u.pm = 32 + x; u.pn = 16 + (e - 8); return true; } uidx = 72 + e; }
        u.pm = 4 * x + (uidx % 4); u.pn = uidx / 4; return true;
    }
    __device__ __forceinline__ void a_ready(const Unit& u) const {
        if (u.pm < 32 || !wait) return;
        if (threadIdx.x < 64) {
            const unsigned* w = cnt + 64 * (u.pm - 32); unsigned sp = 0;
            while ((unsigned)__builtin_amdgcn_readfirstlane(__hip_atomic_load(w, __ATOMIC_RELAXED, __HIP_MEMORY_SCOPE_AGENT)) < 8u) { __builtin_amdgcn_s_sleep(2); if (++sp > (1u << 22)) break; }
            __builtin_amdgcn_fence(__ATOMIC_ACQUIRE, "agent");
            asm volatile("s_waitcnt vmcnt(0)" ::: "memory");
        }
        asm volatile("" ::: "memory"); __builtin_amdgcn_s_barrier(); asm volatile("" ::: "memory");
    }
    __device__ __forceinline__ void done(const Unit&) const {}
};
__device__ __forceinline__ unsigned cvt_pk_bf16(float lo, float hi) { unsigned r; asm volatile("v_cvt_pk_bf16_f32 %0, %1, %2" : "=v"(r) : "v"(lo), "v"(hi)); return r; }
__device__ __forceinline__ void slab_store(const f32x4 (&acc)[2][2][4][2], float* slabs, const Unit& u, int wr, int wc, int fr, int fq) {
    float* sp = slabs + (size_t)u.slab * 65536 + (size_t)(wr * 64 + fr) * 256 + wc * 32 + 8 * fq;
#pragma unroll
    for (int ai = 0; ai < 2; ++ai)
#pragma unroll
        for (int m = 0; m < 4; ++m)
#pragma unroll
            for (int bj = 0; bj < 2; ++bj) { float* q = sp + (size_t)(ai * HALF + m * 16) * 256 + bj * HALF; *(f32x4*)q = acc[ai][bj][m][0]; *(f32x4*)(q + 4) = acc[ai][bj][m][1]; }
}
struct EpiBf16 {
    static constexpr bool PERM = true, AFTER_DRAIN = false;
    bf16_t* O; int ldc; int pad;
    __device__ __forceinline__ void operator()(const f32x4 (&acc)[2][2][4][2], const Unit& u, int wr, int wc, int fr, int fq) const {
        asm volatile("" : "+v"(fr), "+v"(fq));
        const int row0 = u.pm * BM + wr * 64 + fr, col0 = u.pn * BM + wc * 32 + 8 * fq;
#pragma unroll
        for (int ai = 0; ai < 2; ++ai)
#pragma unroll
            for (int m = 0; m < 4; ++m) { bf16_t* rowp = O + (size_t)(row0 + ai * HALF + m * 16) * ldc + col0;
#pragma unroll
                for (int bj = 0; bj < 2; ++bj) { const f32x4 v0 = acc[ai][bj][m][0], v1 = acc[ai][bj][m][1];
                    u32x4 w; w.x = cvt_pk_bf16(v0[0], v0[1]); w.y = cvt_pk_bf16(v0[2], v0[3]); w.z = cvt_pk_bf16(v1[0], v1[1]); w.w = cvt_pk_bf16(v1[2], v1[3]);
                    *(u32x4*)(rowp + bj * HALF) = w; } }
    }
};
struct EpiPoolF {
    static constexpr bool PERM = true, AFTER_DRAIN = false;
    bf16_t* Y; const bf16_t* SG; const float* pscale;
    __device__ __forceinline__ void operator()(const f32x4 (&acc)[2][2][4][2], const Unit& u, int wr, int wc, int fr, int fq) const {
        asm volatile("" : "+v"(fr), "+v"(fq));
        const int row0 = u.pm * BM + wr * 64 + fr, col0 = u.pn * BM + wc * 32 + 8 * fq;
        f32x4 ps[2][2];
#pragma unroll
        for (int bj = 0; bj < 2; ++bj) { ps[bj][0] = *(const f32x4*)(pscale + col0 + bj * HALF); ps[bj][1] = *(const f32x4*)(pscale + col0 + bj * HALF + 4); }
#pragma unroll
        for (int ai = 0; ai < 2; ++ai)
#pragma unroll
            for (int m = 0; m < 4; ++m) { const size_t r = (size_t)(row0 + ai * HALF + m * 16);
#pragma unroll
                for (int bj = 0; bj < 2; ++bj) { const int c = col0 + bj * HALF;
                    const u32x4 g = *(const u32x4*)(SG + r * DM + 1024 + c);
                    const f32x4 v0 = acc[ai][bj][m][0] * ps[bj][0], v1 = acc[ai][bj][m][1] * ps[bj][1];
                    u32x4 w; w.x = cvt_pk_bf16(v0[0] * bflo(g.x), v0[1] * bfhi(g.x)); w.y = cvt_pk_bf16(v0[2] * bflo(g.y), v0[3] * bfhi(g.y));
                    w.z = cvt_pk_bf16(v1[0] * bflo(g.z), v1[1] * bfhi(g.z)); w.w = cvt_pk_bf16(v1[2] * bflo(g.w), v1[3] * bfhi(g.w));
                    *(u32x4*)(Y + r * DM + 1024 + c) = w; } }
    }
};
struct EpiProj0 {
    static constexpr bool PERM = true, AFTER_DRAIN = false;
    unsigned char* ws; const float* qw; const float* kw; float* nak; float* nav;
    __device__ __forceinline__ void operator()(const f32x4 (&acc)[2][2][4][2], const Unit& u, int wr, int wc, int fr, int fq) const {
        asm volatile("" : "+v"(fr), "+v"(fq));
        const int pm = u.pm, pn = u.pn;
        const bool smp = pm >= 32; const int b = smp ? (pm - 32) >> 2 : pm, tb = (smp ? ((pm - 32) & 3) * 256 : 0) + wr * 64 + fr;
        const size_t rowb = (size_t)pm * 256 + wr * 64 + fr;
        if (pn < 8) {
            const bool isk = pn >= 4; const int hl = wc >> 1, j = wc & 1, h = (pn & 3) * 2 + hl, dim_a = 8 * fq + 16 * (fq >> 1);
            const float* w = isk ? kw : qw;
            f32x4 wv[2][2];
#pragma unroll
            for (int bj = 0; bj < 2; ++bj)
#pragma unroll
                for (int n = 0; n < 2; ++n) wv[bj][n] = *(const f32x4*)(w + dim_a + 16 * bj + 4 * n);
            const float* ropeA = (const float*)(ws + WS_ROPE);
#pragma unroll
            for (int ai = 0; ai < 2; ++ai)
#pragma unroll
                for (int m = 0; m < 4; ++m) { const int t = tb + ai * 128 + m * 16; const size_t row = rowb + ai * 128 + m * 16;
                    float ss = 0.f;
#pragma unroll
                    for (int bj = 0; bj < 2; ++bj)
#pragma unroll
                        for (int n = 0; n < 2; ++n) { const f32x4 x = acc[ai][bj][m][n]; ss += (x[0] * x[0] + x[1] * x[1]) + (x[2] * x[2] + x[3] * x[3]); }
                    ss += __shfl_xor(ss, 16); ss += __shfl_xor(ss, 32);
                    const float rinv = 1.0f / sqrtf(ss * (1.f / 64.f) + EPS);
                    f32x4 y[2][2];
#pragma unroll
                    for (int bj = 0; bj < 2; ++bj)
#pragma unroll
                        for (int n = 0; n < 2; ++n) y[bj][n] = acc[ai][bj][m][n] * rinv * wv[bj][n];
                    if (smp) {
#pragma unroll
                        for (int n = 0; n < 2; ++n) { const f32x4 cs = *(const f32x4*)(ropeA + (size_t)t * 64 + dim_a + 4 * n), sn = *(const f32x4*)(ropeA + 1024 * 64 + (size_t)t * 64 + dim_a + 4 * n);
                            const f32x4 a = y[0][n], bb = y[1][n]; y[0][n] = a * cs - bb * sn; y[1][n] = bb * cs + a * sn; } }
                    if (!isk) { bf16_t* qp = (bf16_t*)(ws + WS_Q) + row * 1024 + pn * 256 + wc * 64 + dim_a;
#pragma unroll
                        for (int bj = 0; bj < 2; ++bj) { const f32x4 v0 = y[bj][0] * C2A, v1 = y[bj][1] * C2A;
                            u32x4 o; o.x = cvt_pk_bf16(v0[0], v0[1]); o.y = cvt_pk_bf16(v0[2], v0[3]); o.z = cvt_pk_bf16(v1[0], v1[1]); o.w = cvt_pk_bf16(v1[2], v1[3]);
                            *(u32x4*)(qp + 16 * bj) = o; } }
                    else { const int hh = (pn - 4) * 2 + hl;
                        const size_t koff = (smp ? ((size_t)(b * HA + hh) * LKS + PAST + t) * 128 : ((size_t)(b * HA + hh) * SEQP + t) * 128) + j * 64 + dim_a;
                        bf16_t* kp = (bf16_t*)(ws + (smp ? WS_KSA : WS_KP)) + koff;
#pragma unroll
                        for (int bj = 0; bj < 2; ++bj) { const f32x4 v0 = y[bj][0], v1 = y[bj][1];
                            u32x4 o; o.x = cvt_pk_bf16(v0[0], v0[1]); o.y = cvt_pk_bf16(v0[2], v0[3]); o.z = cvt_pk_bf16(v1[0], v1[1]); o.w = cvt_pk_bf16(v1[2], v1[3]);
                            *(u32x4*)(kp + 16 * bj) = o;
                            if (!smp) { float* fp = nak + koff + 16 * bj; *(f32x4*)fp = v0; *(f32x4*)(fp + 4) = v1; } } }
                }
        } else if (pn < 12) {
#pragma unroll
            for (int ai = 0; ai < 2; ++ai)
#pragma unroll
                for (int m = 0; m < 4; ++m) { const int t = tb + ai * 128 + m * 16;
#pragma unroll
                    for (int bj = 0; bj < 2; ++bj) { const int hh = (pn - 8) * 2 + bj, d = 32 * wc + 8 * fq;
                        const size_t voff = (smp ? ((size_t)(b * HA + hh) * LKS + PAST + t) * 128 : ((size_t)(b * HA + hh) * SEQP + t) * 128) + d;
                        const f32x4 v0 = acc[ai][bj][m][0], v1 = acc[ai][bj][m][1];
                        u32x4 o; o.x = cvt_pk_bf16(v0[0], v0[1]); o.y = cvt_pk_bf16(v0[2], v0[3]); o.z = cvt_pk_bf16(v1[0], v1[1]); o.w = cvt_pk_bf16(v1[2], v1[3]);
                        *(u32x4*)((bf16_t*)(ws + (smp ? WS_VSA : WS_VP)) + voff) = o;
                        if (!smp) { *(f32x4*)(nav + voff) = v0; *(f32x4*)(nav + voff + 4) = v1; } } }
        } else if (pn < 16) {
            bf16_t* up = (bf16_t*)(ws + WS_U) + (pn - 12) * 256 + 32 * wc + 8 * fq;
#pragma unroll
            for (int ai = 0; ai < 2; ++ai)
#pragma unroll
                for (int m = 0; m < 4; ++m) { const size_t row = rowb + ai * 128 + m * 16;
#pragma unroll
                    for (int bj = 0; bj < 2; ++bj) { const f32x4 v0 = acc[ai][bj][m][0], v1 = acc[ai][bj][m][1];
                        u32x4 o; o.x = cvt_pk_bf16(v0[0], v0[1]); o.y = cvt_pk_bf16(v0[2], v0[3]); o.z = cvt_pk_bf16(v1[0], v1[1]); o.w = cvt_pk_bf16(v1[2], v1[3]);
                        *(u32x4*)(up + row * 1024 + bj * HALF) = o; } }
        } else {
            bf16_t* sg = (bf16_t*)(ws + WS_SG) + (pn - 16) * 256 + 32 * wc + 8 * fq;
#pragma unroll
            for (int ai = 0; ai < 2; ++ai)
#pragma unroll
                for (int m = 0; m < 4; ++m) { const size_t row = rowb + ai * 128 + m * 16;
#pragma unroll
                    for (int bj = 0; bj < 2; ++bj) { const f32x4 v0 = acc[ai][bj][m][0], v1 = acc[ai][bj][m][1];
                        u32x4 o; o.x = cvt_pk_bf16(siluf(v0[0]), siluf(v0[1])); o.y = cvt_pk_bf16(siluf(v0[2]), siluf(v0[3])); o.z = cvt_pk_bf16(siluf(v1[0]), siluf(v1[1])); o.w = cvt_pk_bf16(siluf(v1[2]), siluf(v1[3]));
                        *(u32x4*)(sg + row * DM + bj * HALF) = o; } }
        }
    }
};
struct EpiProj1 {
    static constexpr bool PERM = true, AFTER_DRAIN = false;
    unsigned char* ws; const float* qw; const float* kw; float* nck; float* ncv; PG8_LAS float* xs; float* slabs;
    __device__ __forceinline__ void operator()(const f32x4 (&acc0)[2][2][4][2], const Unit& u, int wr, int wc, int fr, int fq) const {
        asm volatile("" : "+v"(fr), "+v"(fq));
        if (u.slab >= 0) { slab_store(acc0, slabs, u, wr, wc, fr, fq); return; }
        const int pm = u.pm, pn = u.pn;
        float rstd[2][4]; f32x4 bv[2][2];
        { const int cr = pm < 32 ? 0 : 1 + ((pm - 32) >> 2);
          const float* b2 = (const float*)(ws + WS_B2P) + (size_t)cr * ODD_IN + pn * 256 + 32 * wc + 8 * fq; const float* rss = (const float*)(ws + WS_RSS) + (size_t)pm * 256 + wr * 64 + fr;
#pragma unroll
          for (int bj = 0; bj < 2; ++bj)
#pragma unroll
              for (int n = 0; n < 2; ++n) bv[bj][n] = *(const f32x4*)(b2 + bj * HALF + n * 4);
#pragma unroll
          for (int ai = 0; ai < 2; ++ai)
#pragma unroll
              for (int m = 0; m < 4; ++m) rstd[ai][m] = __builtin_amdgcn_rsqf(rss[ai * 128 + m * 16] * (1.f / DM) + EPS); }
#define VV(ai, bj, m, n) (acc0[ai][bj][m][n] * rstd[ai][m] + bv[bj][n])
        const bool smp = pm >= 32; const int b = smp ? (pm - 32) >> 2 : pm, tb = (smp ? ((pm - 32) & 3) * 256 : 0) + wr * 64 + fr;
        const size_t rowb = (size_t)pm * 256 + wr * 64 + fr;
        if (pn < 10) {
            const bool isk = pn >= 8; const int hl = wc >> 1, w1 = wc & 1, head = (isk ? (pn - 8) : pn) * 2 + hl;
            const float* w = isk ? kw : qw;
            f32x4 wv[2][2];
#pragma unroll
            for (int bj = 0; bj < 2; ++bj)
#pragma unroll
                for (int n = 0; n < 2; ++n) wv[bj][n] = *(const f32x4*)(w + (2 * w1 + bj) * 32 + 8 * fq + 4 * n);
            PG8_LAS float* xo = xs + (wr * 4 + wc) * 128; PG8_LAS float* xp = xs + (wr * 4 + (wc ^ 1)) * 128;
#pragma unroll
            for (int ai = 0; ai < 2; ++ai)
#pragma unroll
                for (int m = 0; m < 4; ++m) { float ss = 0.f;
#pragma unroll
                    for (int bj = 0; bj < 2; ++bj)
#pragma unroll
                        for (int n = 0; n < 2; ++n) { const f32x4 x = VV(ai, bj, m, n); ss += (x[0] * x[0] + x[1] * x[1]) + (x[2] * x[2] + x[3] * x[3]); }
                    ss += __shfl_xor(ss, 16); ss += __shfl_xor(ss, 32);
                    if (fq == 0) xo[ai * 64 + m * 16 + fr] = ss; }
            asm volatile("s_waitcnt lgkmcnt(0)" ::: "memory"); __builtin_amdgcn_s_barrier(); asm volatile("" ::: "memory");
            const float* ropeC = (const float*)(ws + WS_ROPE) + 2 * 1024 * 64;
#pragma unroll
            for (int ai = 0; ai < 2; ++ai)
#pragma unroll
                for (int m = 0; m < 4; ++m) { const int idx = ai * 64 + m * 16 + fr, t = tb + ai * 128 + m * 16; const size_t row = rowb + ai * 128 + m * 16;
                    const float rinv = __builtin_amdgcn_rsqf((xo[idx] + xp[idx]) * (1.f / 128.f) + EPS);
                    float r2 = rstd[ai][m]; asm volatile("" : "+v"(r2));
                    f32x4 y[2][2];
#pragma unroll
                    for (int bj = 0; bj < 2; ++bj)
#pragma unroll
                        for (int n = 0; n < 2; ++n) y[bj][n] = (acc0[ai][bj][m][n] * r2 + bv[bj][n]) * rinv * wv[bj][n];
                    if (smp) {
#pragma unroll
                        for (int n = 0; n < 2; ++n) { const f32x4 cs = *(const f32x4*)(ropeC + (size_t)t * 128 + 64 * w1 + 8 * fq + 4 * n), sn = *(const f32x4*)(ropeC + 1024 * 128 + (size_t)t * 128 + 64 * w1 + 8 * fq + 4 * n);
                            const f32x4 a = y[0][n], bb = y[1][n]; y[0][n] = a * cs - bb * sn; y[1][n] = bb * cs + a * sn; } }
                    if (!isk) { bf16_t* qp = (bf16_t*)(ws + WS_Q) + row * DM + head * 128 + 8 * fq;
#pragma unroll
                        for (int bj = 0; bj < 2; ++bj) { const f32x4 v0 = y[bj][0] * C2C, v1 = y[bj][1] * C2C;
                            u32x4 o; o.x = cvt_pk_bf16(v0[0], v0[1]); o.y = cvt_pk_bf16(v0[2], v0[3]); o.z = cvt_pk_bf16(v1[0], v1[1]); o.w = cvt_pk_bf16(v1[2], v1[3]);
                            *(u32x4*)(qp + (2 * w1 + bj) * 32) = o; } }
                    else { const size_t koff = smp ? ((size_t)(b * KVH + head) * LKS + PAST + t) * 128 : ((size_t)(b * KVH + head) * SEQP + t) * 128;
                        bf16_t* kp = (bf16_t*)(ws + (smp ? WS_KSC : WS_KP)) + koff + 8 * fq;
#pragma unroll
                        for (int bj = 0; bj < 2; ++bj) { const f32x4 v0 = y[bj][0], v1 = y[bj][1];
                            u32x4 o; o.x = cvt_pk_bf16(v0[0], v0[1]); o.y = cvt_pk_bf16(v0[2], v0[3]); o.z = cvt_pk_bf16(v1[0], v1[1]); o.w = cvt_pk_bf16(v1[2], v1[3]);
                            *(u32x4*)(kp + (2 * w1 + bj) * 32) = o;
                            if (!smp) { float* fp = nck + koff + 8 * fq + (2 * w1 + bj) * 32; *(f32x4*)fp = v0; *(f32x4*)(fp + 4) = v1; } } }
                }
        } else if (pn < 12) {
#pragma unroll
            for (int ai = 0; ai < 2; ++ai)
#pragma unroll
                for (int m = 0; m < 4; ++m) { const int t = tb + ai * 128 + m * 16;
#pragma unroll
                    for (int bj = 0; bj < 2; ++bj) { const int kvh = (pn - 10) * 2 + bj, d = 32 * wc + 8 * fq;
                        const size_t voff = (smp ? ((size_t)(b * KVH + kvh) * LKS + PAST + t) * 128 : ((size_t)(b * KVH + kvh) * SEQP + t) * 128) + d;
                        const f32x4 v0 = VV(ai, bj, m, 0), v1 = VV(ai, bj, m, 1);
                        u32x4 o; o.x = cvt_pk_bf16(v0[0], v0[1]); o.y = cvt_pk_bf16(v0[2], v0[3]); o.z = cvt_pk_bf16(v1[0], v1[1]); o.w = cvt_pk_bf16(v1[2], v1[3]);
                        *(u32x4*)((bf16_t*)(ws + (smp ? WS_VSC : WS_VP)) + voff) = o;
                        if (!smp) { *(f32x4*)(ncv + voff) = v0; *(f32x4*)(ncv + voff + 4) = v1; } } }
        } else {
            bf16_t* sg = (bf16_t*)(ws + WS_SG) + (pn - 12) * 256 + 32 * wc + 8 * fq;
#pragma unroll
            for (int ai = 0; ai < 2; ++ai)
#pragma unroll
                for (int m = 0; m < 4; ++m) { const size_t row = rowb + ai * 128 + m * 16;
#pragma unroll
                    for (int bj = 0; bj < 2; ++bj) { const f32x4 v0 = VV(ai, bj, m, 0), v1 = VV(ai, bj, m, 1);
                        u32x4 o; o.x = cvt_pk_bf16(siluf(v0[0]), siluf(v0[1])); o.y = cvt_pk_bf16(siluf(v0[2]), siluf(v0[3])); o.z = cvt_pk_bf16(siluf(v1[0]), siluf(v1[1])); o.w = cvt_pk_bf16(siluf(v1[2]), siluf(v1[3]));
                        *(u32x4*)(sg + row * DM + bj * HALF) = o; } }
        }
    }
};
#undef VV
struct EpiResid0 {
    static constexpr bool PERM = true, AFTER_DRAIN = false;
    const float* xp; const float* xs; const float* gate; const float* cw1; float* out; bf16_t* H1; float* rowss; float* slabs;
    __device__ __forceinline__ void operator()(const f32x4 (&acc)[2][2][4][2], const Unit& u, int wr, int wc, int fr, int fq) const {
        asm volatile("" : "+v"(fr), "+v"(fq));
        if (u.slab >= 0) { slab_store(acc, slabs, u, wr, wc, fr, fq); return; }
        const int row0 = u.pm * BM + wr * 64 + fr, col0 = u.pn * BM + wc * 32 + 8 * fq;
        const int cr = u.pm < 32 ? 0 : 1 + ((u.pm - 32) >> 2);
        f32x4 gv[2][2], cv[2][2];
#pragma unroll
        for (int bj = 0; bj < 2; ++bj)
#pragma unroll
            for (int n = 0; n < 2; ++n) { gv[bj][n] = *(const f32x4*)(gate + (size_t)cr * 6144 + col0 + bj * HALF + n * 4); cv[bj][n] = *(const f32x4*)(cw1 + (size_t)cr * DM + col0 + bj * HALF + n * 4); }
#pragma unroll
        for (int ai = 0; ai < 2; ++ai)
#pragma unroll
            for (int m = 0; m < 4; ++m) { const int r = row0 + ai * HALF + m * 16;
                const float* bp = (r < MP ? xp + (size_t)r * DM : xs + (size_t)(r - MP) * DM) + col0; float* op = out + (size_t)r * DM + col0; bf16_t* hp = H1 + (size_t)r * DM + col0;
                float ss = 0.f;
#pragma unroll
                for (int bj = 0; bj < 2; ++bj) { const f32x4 y0 = *(const f32x4*)(bp + bj * HALF) + gv[bj][0] * acc[ai][bj][m][0], y1 = *(const f32x4*)(bp + bj * HALF + 4) + gv[bj][1] * acc[ai][bj][m][1];
                    *(f32x4*)(op + bj * HALF) = y0; *(f32x4*)(op + bj * HALF + 4) = y1;
                    ss += (y0[0] * y0[0] + y0[1] * y0[1]) + (y0[2] * y0[2] + y0[3] * y0[3]) + (y1[0] * y1[0] + y1[1] * y1[1]) + (y1[2] * y1[2] + y1[3] * y1[3]);
                    const f32x4 h0 = y0 * cv[bj][0], h1 = y1 * cv[bj][1];
                    u32x4 o; o.x = cvt_pk_bf16(h0[0], h0[1]); o.y = cvt_pk_bf16(h0[2], h0[3]); o.z = cvt_pk_bf16(h1[0], h1[1]); o.w = cvt_pk_bf16(h1[2], h1[3]);
                    *(u32x4*)(hp + bj * HALF) = o; }
                ss += __shfl_xor(ss, 16); ss += __shfl_xor(ss, 32);
                if (fq == 0) atomicAdd(rowss + r, ss);
                if (m & 1) asm volatile("" ::: "memory"); }
    }
};
struct EpiResidF {
    static constexpr bool PERM = true, AFTER_DRAIN = false;
    const float* xp; const float* xs; const float* base; const float* gate; float* out; float* slabs;
    __device__ __forceinline__ void operator()(const f32x4 (&acc)[2][2][4][2], const Unit& u, int wr, int wc, int fr, int fq) const {
        asm volatile("" : "+v"(fr), "+v"(fq));
        if (u.slab >= 0) { slab_store(acc, slabs, u, wr, wc, fr, fq); return; }
        const int row0 = u.pm * BM + wr * 64 + fr, col0 = u.pn * BM + wc * 32 + 8 * fq;
        const int cr = u.pm < 32 ? 0 : 1 + ((u.pm - 32) >> 2);
        f32x4 gv[2][2];
#pragma unroll
        for (int bj = 0; bj < 2; ++bj)
#pragma unroll
            for (int n = 0; n < 2; ++n) gv[bj][n] = *(const f32x4*)(gate + (size_t)cr * 6144 + col0 + bj * HALF + n * 4);
#pragma unroll
        for (int ai = 0; ai < 2; ++ai)
#pragma unroll
            for (int m = 0; m < 4; ++m) { const int r = row0 + ai * HALF + m * 16;
                const float* bp = (base ? base + (size_t)r * DM : (r < MP ? xp + (size_t)r * DM : xs + (size_t)(r - MP) * DM)) + col0; float* op = out + (size_t)r * DM + col0;
#pragma unroll
                for (int bj = 0; bj < 2; ++bj)
#pragma unroll
                    for (int n = 0; n < 2; ++n) { const f32x4 b = *(const f32x4*)(bp + bj * HALF + n * 4); *(f32x4*)(op + bj * HALF + n * 4) = b + gv[bj][n] * acc[ai][bj][m][n]; }
                if (m & 1) asm volatile("" ::: "memory"); }
    }
};

template <class Epi, class Sched, bool ALIGN_EPI = false, bool SP2 = false>
__device__ __forceinline__ void gemm_phase(PG8_LAS unsigned char* lds, const Gemm g, const Sched& S, const Epi& E, const int tid) {
    const int wid = __builtin_amdgcn_readfirstlane(tid >> 6), lane = tid & 63, wr = wid >> 2, wc = wid & 3, fr = lane & 15, fq = lane >> 4;
    unsigned voffA[2], voffB[2];
#pragma unroll
    for (int i = 0; i < 2; ++i) { int R, C; stage_rc(tid * 16 + i * 8192, R, C); const int Rb = Epi::PERM ? ((R & ~31) + perm32(R & 31)) : R;
        voffA[i] = (unsigned)(R * g.lda + C) * 2u; voffB[i] = (unsigned)(Rb * g.ldb + C) * 2u; }
    const size_t kstep = (size_t)(BK * 2);
    const size_t hstepA = (size_t)HALF * g.lda * 2, hstepB = (size_t)HALF * g.ldb * 2;
    const size_t tstepA = 2 * hstepA, tstepB = 2 * hstepB;
    const unsigned ldsw = (unsigned)wid * 1024u;
    const int aoff = lds_byte(wr * 64 + fr, fq * 8), boff = lds_byte(wc * 32 + fr, fq * 8);
#define PG8_SA(b, h) (((b) * 2 + (h)) * HTB)
#define PG8_SB(b, h) ((4 + (b) * 2 + (h)) * HTB)
#define PG8_STAGE(bufoff, gbase, voff) do { _Pragma("unroll") for (int _i = 0; _i < 2; ++_i) \
        __builtin_amdgcn_global_load_lds((const unsigned*)((const char*)(gbase) + (voff)[_i]), (PG8_LAS unsigned*)(lds + (bufoff) + ldsw + _i * 8192), 16, 0, 0); } while (0)
#define PG8_LDA(dst, b, h) do { _Pragma("unroll") for (int m = 0; m < 4; ++m) _Pragma("unroll") for (int k = 0; k < 2; ++k) dst[m][k] = *(const PG8_LAS bf16x8*)(lds + PG8_SA(b, h) + aoff + m * 2048 + k * 1024); } while (0)
#define PG8_LDB(dst, b, h) do { _Pragma("unroll") for (int n = 0; n < 2; ++n) _Pragma("unroll") for (int k = 0; k < 2; ++k) dst[n][k] = *(const PG8_LAS bf16x8*)(lds + PG8_SB(b, h) + boff + n * 2048 + k * 1024); } while (0)
#define PG8_MMA(ai, bj, At, Bt) do { __builtin_amdgcn_s_setprio(1); _Pragma("unroll") for (int m = 0; m < 4; ++m) _Pragma("unroll") for (int n = 0; n < 2; ++n) _Pragma("unroll") for (int k = 0; k < 2; ++k) \
        acc[ai][bj][m][n] = __builtin_amdgcn_mfma_f32_16x16x32_bf16(Bt[n][k], At[m][k], acc[ai][bj][m][n], 0, 0, 0); __builtin_amdgcn_s_setprio(0); } while (0)
#define PG8_WAIT_V(n) asm volatile("s_waitcnt vmcnt(" #n ")" ::: "memory")
#define PG8_WAIT_L(n) asm volatile("s_waitcnt lgkmcnt(" #n ")" ::: "memory")
#define PG8_BAR __builtin_amdgcn_s_barrier()
#define PG8_SCHED __builtin_amdgcn_sched_barrier(0)
    Unit cur, nxt; int ui = 0;
    if (!S.next(0, cur)) return;
    f32x4 acc[2][2][4][2];
#pragma unroll
    for (int a = 0; a < 2; ++a)
#pragma unroll
        for (int b = 0; b < 2; ++b)
#pragma unroll
            for (int m = 0; m < 4; ++m)
#pragma unroll
                for (int n = 0; n < 2; ++n) acc[a][b][m][n] = (f32x4){0.f, 0.f, 0.f, 0.f};
    bf16x8 At[4][2], B0[2][2], B1[2][2];
    const char* cA = (const char*)g.A + (size_t)cur.pm * tstepA + (size_t)cur.pn * g.a_pn_off * 2 + (size_t)cur.kt0 * kstep; const char* cB = (const char*)g.Bt + (size_t)cur.pn * tstepB + (size_t)cur.pm * g.b_pm_off * 2 + (size_t)cur.kt0 * kstep;
    S.a_ready(cur);
    if constexpr (SP2) {
        PG8_STAGE(PG8_SB(0, 0), cB, voffB); PG8_STAGE(PG8_SB(0, 1), cB + hstepB, voffB); PG8_STAGE(PG8_SA(0, 0), cA, voffA); PG8_STAGE(PG8_SA(0, 1), cA + hstepA, voffA);
        if (wr == 1) PG8_BAR;
        PG8_WAIT_V(2); PG8_BAR;
        PG8_STAGE(PG8_SB(1, 0), cB + kstep, voffB); PG8_STAGE(PG8_SA(1, 0), cA + kstep, voffA); PG8_STAGE(PG8_SB(1, 1), cB + hstepB + kstep, voffB);
        PG8_WAIT_V(6); PG8_BAR;
    } else {
        PG8_STAGE(PG8_SB(0, 0), cB, voffB); PG8_STAGE(PG8_SA(0, 0), cA, voffA); PG8_STAGE(PG8_SB(0, 1), cB + hstepB, voffB); PG8_STAGE(PG8_SA(0, 1), cA + hstepA, voffA);
        if (wr == 1) PG8_BAR;
        PG8_WAIT_V(4); PG8_BAR;
        PG8_STAGE(PG8_SB(1, 0), cB + kstep, voffB); PG8_STAGE(PG8_SA(1, 0), cA + kstep, voffA); PG8_STAGE(PG8_SB(1, 1), cB + hstepB + kstep, voffB);
        PG8_WAIT_V(6); PG8_BAR;
    }
    for (;;) {
        const bool has_next = S.next(ui + 1, nxt);
        const char* nA = has_next ? (const char*)g.A + (size_t)nxt.pm * tstepA + (size_t)nxt.pn * g.a_pn_off * 2 + (size_t)nxt.kt0 * kstep : cA; const char* nB = has_next ? (const char*)g.Bt + (size_t)nxt.pn * tstepB + (size_t)nxt.pm * g.b_pm_off * 2 + (size_t)nxt.kt0 * kstep : cB;
        const int nt = cur.nkt;
        for (int t = 0; t < nt; t += 2) {
            const bool last = (t == nt - 2);
            const char* a1 = cA + (size_t)(t + 1) * kstep;
            const char* a2 = last ? nA : cA + (size_t)(t + 2) * kstep; const char* b2 = last ? nB : cB + (size_t)(t + 2) * kstep;
            const char* a3 = a2 + kstep; const char* b3 = b2 + kstep;
            if (last && has_next) S.a_ready(nxt);
            if constexpr (SP2) {
            PG8_LDB(B0, 0, 0); PG8_LDB(B1, 0, 1); PG8_SCHED; PG8_LDA(At, 0, 0); PG8_STAGE(PG8_SA(1, 1), a1 + hstepA, voffA);
            PG8_WAIT_V(8); PG8_WAIT_L(0); PG8_BAR; PG8_MMA(0, 0, At, B0); PG8_MMA(0, 1, At, B1); PG8_BAR; PG8_SCHED;
            PG8_LDA(At, 0, 1); PG8_STAGE(PG8_SB(0, 0), b2, voffB); PG8_STAGE(PG8_SB(0, 1), b2 + hstepB, voffB); PG8_STAGE(PG8_SA(0, 0), a2, voffA);
            PG8_WAIT_V(8); PG8_WAIT_L(0); PG8_BAR; PG8_MMA(1, 0, At, B0); PG8_MMA(1, 1, At, B1); PG8_BAR; PG8_SCHED;
            PG8_LDB(B0, 1, 0); PG8_LDB(B1, 1, 1); PG8_SCHED; PG8_LDA(At, 1, 0); PG8_STAGE(PG8_SA(0, 1), a2 + hstepA, voffA);
            PG8_WAIT_V(8); PG8_WAIT_L(0); PG8_BAR; PG8_MMA(0, 0, At, B0); PG8_MMA(0, 1, At, B1); PG8_BAR; PG8_SCHED;
            PG8_LDA(At, 1, 1); PG8_STAGE(PG8_SB(1, 0), b3, voffB); PG8_STAGE(PG8_SB(1, 1), b3 + hstepB, voffB); PG8_STAGE(PG8_SA(1, 0), a3, voffA);
            PG8_WAIT_V(8); PG8_WAIT_L(0); PG8_BAR; PG8_MMA(1, 0, At, B0); PG8_MMA(1, 1, At, B1); PG8_BAR; PG8_SCHED;
            } else {
            PG8_LDB(B0, 0, 0); PG8_SCHED; PG8_LDA(At, 0, 0); PG8_STAGE(PG8_SA(1, 1), a1 + hstepA, voffA);
            PG8_WAIT_L(8); PG8_BAR; PG8_WAIT_L(0); PG8_MMA(0, 0, At, B0); PG8_BAR; PG8_SCHED;
            PG8_LDB(B1, 0, 1); PG8_STAGE(PG8_SB(0, 0), b2, voffB);
            PG8_BAR; PG8_WAIT_L(0); PG8_MMA(0, 1, At, B1); PG8_BAR;
            PG8_LDA(At, 0, 1); PG8_STAGE(PG8_SA(0, 0), a2, voffA);
            PG8_BAR; PG8_WAIT_L(0); PG8_MMA(1, 0, At, B0); PG8_BAR; PG8_SCHED;
            PG8_STAGE(PG8_SB(0, 1), b2 + hstepB, voffB);
            PG8_WAIT_V(6); PG8_BAR; PG8_MMA(1, 1, At, B1); PG8_BAR;
            PG8_LDB(B0, 1, 0); PG8_SCHED; PG8_LDA(At, 1, 0); PG8_STAGE(PG8_SA(0, 1), a2 + hstepA, voffA);
            PG8_WAIT_L(8); PG8_BAR; PG8_WAIT_L(0); PG8_MMA(0, 0, At, B0); PG8_BAR; PG8_SCHED;
            PG8_LDB(B1, 1, 1); PG8_STAGE(PG8_SB(1, 0), b3, voffB);
            PG8_BAR; PG8_WAIT_L(0); PG8_MMA(0, 1, At, B1); PG8_BAR;
            PG8_LDA(At, 1, 1); PG8_STAGE(PG8_SA(1, 0), a3, voffA);
            PG8_BAR; PG8_WAIT_L(0); PG8_MMA(1, 0, At, B0); PG8_BAR; PG8_SCHED;
            PG8_STAGE(PG8_SB(1, 1), b3 + hstepB, voffB);
            PG8_WAIT_V(6); PG8_BAR; PG8_MMA(1, 1, At, B1); PG8_BAR;
            }
        }
        if constexpr (ALIGN_EPI) { if (wr == 0) PG8_BAR; }
        if constexpr (!Epi::AFTER_DRAIN) { E(acc, cur, wr, wc, fr, fq); S.done(cur); }
        if (!has_next) break;
#pragma unroll
        for (int a = 0; a < 2; ++a)
#pragma unroll
            for (int b = 0; b < 2; ++b)
#pragma unroll
                for (int m = 0; m < 4; ++m)
#pragma unroll
                    for (int n = 0; n < 2; ++n) acc[a][b][m][n] = (f32x4){0.f, 0.f, 0.f, 0.f};
        cur = nxt; cA = nA; cB = nB; ++ui;
        if constexpr (ALIGN_EPI) { if (wr == 1) PG8_BAR; }
    }
    PG8_WAIT_V(0);
    if constexpr (!ALIGN_EPI) { if (wr == 0) PG8_BAR; }
    PG8_BAR;
#undef PG8_SA
#undef PG8_SB
#undef PG8_STAGE
#undef PG8_LDA
#undef PG8_LDB
#undef PG8_MMA
#undef PG8_WAIT_V
#undef PG8_WAIT_L
#undef PG8_BAR
#undef PG8_SCHED
}
}

__device__ __forceinline__ void ld8(const bf16_t* p, float (&v)[8]) { const u32x4 r = *(const u32x4*)p; v[0] = bflo(r.x); v[1] = bfhi(r.x); v[2] = bflo(r.y); v[3] = bfhi(r.y); v[4] = bflo(r.z); v[5] = bfhi(r.z); v[6] = bflo(r.w); v[7] = bfhi(r.w); }
__device__ __forceinline__ void pool_apply_slot(const Params& p, int slot, int tid) {
    const bf16_t* __restrict__ Z = (const bf16_t*)(p.ws + WS_U); const bf16_t* __restrict__ SG = (const bf16_t*)(p.ws + WS_SG); bf16_t* __restrict__ Y = (bf16_t*)(p.ws + WS_HY);
    const int chunk = tid & 127, rb = tid >> 7, c = chunk * 8, g = chunk >> 5, h = 1 << g;
    float ps[8];
#pragma unroll
    for (int e = 0; e < 8; ++e) ps[e] = p.pool_scale[c + e];
    float S[8]; bool first = true;
    int m = slot * 80 + rb * 20;
#pragma unroll 1
    for (int i4 = 0; i4 < 5; ++i4) {
        float za[4][8], zr[4][8], own[4][8], gt[4][8]; int cnt[4]; bool init[4];
#pragma unroll
        for (int j = 0; j < 4; ++j) { const int mm = m + j; const bool smp = mm >= MP; const int t = smp ? (mm - MP) & 1023 : mm & 255, L = smp ? SEQS : SEQP;
            const bf16_t* zp = Z + (size_t)mm * 1024 + c;
            const bool add_ok = (t + h <= L), rem_ok = (t - h >= 1);
            ld8(zp + (ptrdiff_t)(add_ok ? (h - 1) : 0) * 1024, za[j]); ld8(zp + (ptrdiff_t)(rem_ok ? (-1 - h) : 0) * 1024, zr[j]); ld8(zp, own[j]); ld8(SG + (size_t)mm * DM + 1024 + c, gt[j]);
            const float fa = add_ok ? 1.f : 0.f, fr = rem_ok ? 1.f : 0.f;
#pragma unroll
            for (int e = 0; e < 8; ++e) { za[j][e] *= fa; zr[j][e] *= fr; }
            cnt[j] = min(t + h, L) - max(t - h, 0); init[j] = (t == 0) || (first && j == 0 && i4 == 0); }
#pragma unroll
        for (int j = 0; j < 4; ++j) { const int mm = m + j;
            if (init[j]) { const bool smp = mm >= MP; const int t = smp ? (mm - MP) & 1023 : mm & 255, L = smp ? SEQS : SEQP; const int lo = max(t - h, 0), hi = min(t + h, L);
#pragma unroll
                for (int e = 0; e < 8; ++e) S[e] = 0.f;
                for (int tt = lo; tt < hi; ++tt) { float w[8]; ld8(Z + (size_t)(mm + tt - t) * 1024 + c, w);
#pragma unroll
                    for (int e = 0; e < 8; ++e) S[e] += w[e]; } }
            else {
#pragma unroll
                for (int e = 0; e < 8; ++e) S[e] += za[j][e] - zr[j][e]; }
            const float inv = 1.0f / (float)cnt[j];
            float o[8];
#pragma unroll
            for (int e = 0; e < 8; ++e) o[e] = (S[e] * inv - own[j][e]) * ps[e] * gt[j][e];
            u32x4 w; w.x = pk2(o[0], o[1]); w.y = pk2(o[2], o[3]); w.z = pk2(o[4], o[5]); w.w = pk2(o[6], o[7]);
            *(u32x4*)(Y + (size_t)mm * DM + 1024 + c) = w; }
        first = false; m += 4;
    }
}
namespace att {
#define GATE(x) (SILU ? siluf(x) : (x))
using bf16x8 = __attribute__((ext_vector_type(8))) short;
using s16x4  = __attribute__((ext_vector_type(4))) short;
using f32x16 = __attribute__((ext_vector_type(16))) float;
constexpr int QBLK = 32, KVBLK = 64, LDK = 128;
constexpr int SHM_V = KVBLK * 128 * 2, SHM_K = KVBLK * 128 * 2;
constexpr int WS_OFF = 2 * SHM_V + 2 * SHM_K;
constexpr int STG_OFF = 72 * 1024;
constexpr float THRL = 8.f * LOG2E;
#define KSWZ(row, colB) ((row) * 256 + ((colB) ^ (((row) & 7) << 4)))
#define SBAR() __builtin_amdgcn_sched_barrier(0)
__device__ __forceinline__ int crow(int r, int hi) { return (r & 3) + 8 * (r >> 2) + 4 * hi; }
__device__ __forceinline__ unsigned cvtpk(float lo, float hi) { unsigned r; asm volatile("v_cvt_pk_bf16_f32 %0, %1, %2" : "=v"(r) : "v"(lo), "v"(hi)); return r; }
constexpr float SOFT_OFF = 0.f;
__device__ __forceinline__ void partialSM(f32x16& p0, f32x16& p1, float& m_reg, float& mn, float& alpha) {
  float pmax = p0[0]; for (int r = 1; r < 16; ++r) pmax = fmaxf(pmax, p0[r]); for (int r = 0; r < 16; ++r) pmax = fmaxf(pmax, p1[r]);
  { auto rr = __builtin_amdgcn_permlane32_swap(__float_as_uint(pmax), __float_as_uint(pmax), false, false);
    pmax = fmaxf(__uint_as_float(rr[0]), __uint_as_float(rr[1])); }
  if (__builtin_expect(__all(pmax - m_reg <= THRL), 1)) { mn = m_reg; alpha = 1.f; }
  else { mn = fmaxf(m_reg, pmax); alpha = __builtin_amdgcn_exp2f(m_reg - mn); m_reg = mn; }
  for (int r = 0; r < 16; ++r) p0[r] = p0[r] - mn; for (int r = 0; r < 16; ++r) p1[r] = p1[r] - mn;
  for (int r = 0; r < 16; ++r) p0[r] = __builtin_amdgcn_exp2f(p0[r]);
}
__device__ __forceinline__ void finishSM(f32x16& p0, f32x16& p1, float alpha, float& l_reg, bf16x8& pa0, bf16x8& pa1, bf16x8& pa2, bf16x8& pa3) {
  for (int r = 0; r < 16; ++r) p1[r] = __builtin_amdgcn_exp2f(p1[r]);
  float ps = 0; for (int r = 0; r < 16; ++r) ps += p0[r]; for (int r = 0; r < 16; ++r) ps += p1[r];
  { auto rr = __builtin_amdgcn_permlane32_swap(__float_as_uint(ps), __float_as_uint(ps), false, false);
    ps = __uint_as_float(rr[0]) + __uint_as_float(rr[1]); }
  l_reg = l_reg * alpha + ps;
#define PK4(P, BASE, OUT) do { unsigned a0 = cvtpk(P[BASE + 0], P[BASE + 1]), a1 = cvtpk(P[BASE + 2], P[BASE + 3]);   \
    unsigned b0 = cvtpk(P[BASE + 4], P[BASE + 5]), b1 = cvtpk(P[BASE + 6], P[BASE + 7]);                              \
    auto r0 = __builtin_amdgcn_permlane32_swap(a0, b0, false, false); auto r1 = __builtin_amdgcn_permlane32_swap(a1, b1, false, false); \
    u32x4 w = {r0[0], r1[0], r0[1], r1[1]}; OUT = *reinterpret_cast<bf16x8*>(&w); } while (0)
  PK4(p0, 0, pa0); PK4(p0, 8, pa1); PK4(p1, 0, pa2); PK4(p1, 8, pa3);
#undef PK4
}
template <int ND0> __device__ __forceinline__ void qkt(f32x16& p0, f32x16& p1, const char* Ks, const bf16x8* qr, int r32, int hi, int kcol0, const f32x16& cinit) {
#pragma unroll
  for (int d0 = 0; d0 < ND0; ++d0) { int cb = (kcol0 + d0 * 16 + hi * 8) * 2;
    bf16x8 b0 = *reinterpret_cast<const bf16x8*>(Ks + KSWZ(r32, cb));
    bf16x8 b1 = *reinterpret_cast<const bf16x8*>(Ks + KSWZ(32 + r32, cb));
    if (d0 == 0) { p0 = __builtin_amdgcn_mfma_f32_32x32x16_bf16(b0, qr[d0], cinit, 0, 0, 0); p1 = __builtin_amdgcn_mfma_f32_32x32x16_bf16(b1, qr[d0], cinit, 0, 0, 0); }
    else { p0 = __builtin_amdgcn_mfma_f32_32x32x16_bf16(b0, qr[d0], p0, 0, 0, 0); p1 = __builtin_amdgcn_mfma_f32_32x32x16_bf16(b1, qr[d0], p1, 0, 0, 0); } }
}
__device__ __forceinline__ int v_st(int k, int c) { const int kk = (k & ~0xC) | ((k & 4) << 1) | ((k & 8) >> 1); return ((kk >> 3) * 4 + (c >> 5)) * 512 + ((kk & 7) * 32 + (c & 31)) * 2; }
__device__ __forceinline__ int v_rd_base(int lane) { return ((lane & 3) << 3) | (((lane >> 2) & 3) << 6) | (((lane >> 4) & 1) << 5) | (((lane >> 5) & 1) << 8); }
constexpr int v_rd_off(int d0, int ks, int half) { return d0 * 512 + ks * 4096 + half * 2048; }
template <int OFF> __device__ __forceinline__ s16x4 tr_read(int vb) {
  s16x4 r; asm volatile("ds_read_b64_tr_b16 %0, %1 offset:%2" : "=&v"(r) : "v"(vb), "i"(OFF) : "memory"); return r;
}
template <int D0> __device__ __forceinline__ void pv_one(f32x16& od, int vb, bf16x8 pa0, bf16x8 pa1, bf16x8 pa2, bf16x8 pa3) {
  const s16x4 l0 = tr_read<v_rd_off(D0, 0, 0)>(vb), h0 = tr_read<v_rd_off(D0, 0, 1)>(vb), l1 = tr_read<v_rd_off(D0, 1, 0)>(vb), h1 = tr_read<v_rd_off(D0, 1, 1)>(vb);
  const s16x4 l2 = tr_read<v_rd_off(D0, 2, 0)>(vb), h2 = tr_read<v_rd_off(D0, 2, 1)>(vb), l3 = tr_read<v_rd_off(D0, 3, 0)>(vb), h3 = tr_read<v_rd_off(D0, 3, 1)>(vb);
  asm volatile("s_waitcnt lgkmcnt(0)" ::: "memory"); SBAR();
#define PK(L, H) (bf16x8){L[0], L[1], L[2], L[3], H[0], H[1], H[2], H[3]}
  od = __builtin_amdgcn_mfma_f32_32x32x16_bf16(pa0, PK(l0, h0), od, 0, 0, 0);
  od = __builtin_amdgcn_mfma_f32_32x32x16_bf16(pa1, PK(l1, h1), od, 0, 0, 0);
  od = __builtin_amdgcn_mfma_f32_32x32x16_bf16(pa2, PK(l2, h2), od, 0, 0, 0);
  od = __builtin_amdgcn_mfma_f32_32x32x16_bf16(pa3, PK(l3, h3), od, 0, 0, 0);
#undef PK
}
__device__ __forceinline__ void pv_d0(f32x16* o, int vb, bf16x8 pa0, bf16x8 pa1, bf16x8 pa2, bf16x8 pa3) {
  pv_one<0>(o[0], vb, pa0, pa1, pa2, pa3); pv_one<1>(o[1], vb, pa0, pa1, pa2, pa3); pv_one<2>(o[2], vb, pa0, pa1, pa2, pa3); pv_one<3>(o[3], vb, pa0, pa1, pa2, pa3);
}
template <int ND0>
__device__ __forceinline__ void attn_core(const bf16_t* Qw, const bf16_t* __restrict__ Kh, const bf16_t* __restrict__ Vh, int seq, int kcol0, char* lds, f32x16 (&o)[4], float& l_reg, const int wid, const int lane) {
  const int tid = wid * 64 + lane, r32 = lane & 31, hi = lane >> 5;
  char* V_lds = lds; char* K_lds = lds + 2 * SHM_V;
  float* ws = (float*)(lds + WS_OFF) + wid * 64; float* al_l = ws + 32;
  float m_reg = -1e30f; l_reg = 0; bf16x8 qr[ND0];
  f32x16 cinit; for (int r = 0; r < 16; ++r) cinit[r] = -SOFT_OFF;
#pragma unroll
  for (int d = 0; d < 4; ++d) o[d] = f32x16{};
#pragma unroll
  for (int d0 = 0; d0 < ND0; ++d0) qr[d0] = *reinterpret_cast<const bf16x8*>(Qw + d0 * 16);
  const int sr = tid >> 4, sc = (tid & 15) * 8, vst0 = v_st(sr, sc), vst1 = v_st(32 + sr, sc);
  const int vb0 = (int)(uintptr_t)V_lds + v_rd_base(lane);
  struct { bf16x8 vs0, vs1, ks0, ks1; } sr_[1];
#define SLOAD(i, k0) do { sr_[i].vs0 = *reinterpret_cast<const bf16x8*>(&Vh[(long)((k0) + sr) * LDK + sc]); sr_[i].vs1 = *reinterpret_cast<const bf16x8*>(&Vh[(long)((k0) + 32 + sr) * LDK + sc]); \
    sr_[i].ks0 = *reinterpret_cast<const bf16x8*>(&Kh[(long)((k0) + sr) * LDK + sc]); sr_[i].ks1 = *reinterpret_cast<const bf16x8*>(&Kh[(long)((k0) + 32 + sr) * LDK + sc]); } while (0)
#define SWRITE(b, i) do { *(bf16x8*)(V_lds + (b) * SHM_V + vst0) = sr_[i].vs0;          \
    *(bf16x8*)(V_lds + (b) * SHM_V + vst1) = sr_[i].vs1; int kc = sc * 2;               \
    *(bf16x8*)(K_lds + (b) * SHM_K + KSWZ(sr, kc)) = sr_[i].ks0;                       \
    *(bf16x8*)(K_lds + (b) * SHM_K + KSWZ(32 + sr, kc)) = sr_[i].ks1; } while (0)
#define SWAIT() asm volatile("s_waitcnt vmcnt(0)" ::: "memory")
#define RESC(a) do { if (__any((a) < 1.f)) { if (hi == 0) al_l[r32] = (a); asm volatile("s_waitcnt lgkmcnt(0)" ::: "memory"); \
    for (int d = 0; d < 4; ++d) for (int r = 0; r < 16; ++r) o[d][r] *= al_l[crow(r, hi)]; } } while (0)
  f32x16 pA0, pA1, pB0, pB1; float mnA, mnB, alA, alB; bf16x8 pa0, pa1, pa2, pa3; const int NT = seq / KVBLK;
  SLOAD(0, 0); asm volatile("s_waitcnt vmcnt(0)" ::: "memory"); SWRITE(0, 0); __syncthreads();
  qkt<ND0>(pA0, pA1, K_lds, qr, r32, hi, kcol0, cinit); partialSM(pA0, pA1, m_reg, mnA, alA);
  SLOAD(0, KVBLK);
  SWAIT(); SWRITE(1, 0); __syncthreads();
  for (int j = 1; j + 1 < NT; j += 2) {
    SBAR(); qkt<ND0>(pB0, pB1, K_lds + SHM_K, qr, r32, hi, kcol0, cinit);
    finishSM(pA0, pA1, alA, l_reg, pa0, pa1, pa2, pa3); SBAR();
    SLOAD(0, (j + 1) * KVBLK); SBAR();
    pv_d0(o, vb0, pa0, pa1, pa2, pa3); partialSM(pB0, pB1, m_reg, mnB, alB);
    __syncthreads(); SWAIT(); SWRITE(0, 0);
    RESC(alB); __syncthreads();
    SBAR(); qkt<ND0>(pA0, pA1, K_lds, qr, r32, hi, kcol0, cinit);
    finishSM(pB0, pB1, alB, l_reg, pa0, pa1, pa2, pa3); SBAR();
    SLOAD(0, (j + 2) * KVBLK); SBAR();
    pv_d0(o, vb0 + SHM_V, pa0, pa1, pa2, pa3); partialSM(pA0, pA1, m_reg, mnA, alA);
    __syncthreads(); SWAIT(); SWRITE(1, 0);
    RESC(alA); __syncthreads();
  }
  SBAR(); qkt<ND0>(pB0, pB1, K_lds + SHM_K, qr, r32, hi, kcol0, cinit);
  finishSM(pA0, pA1, alA, l_reg, pa0, pa1, pa2, pa3); SBAR();
  pv_d0(o, vb0, pa0, pa1, pa2, pa3); partialSM(pB0, pB1, m_reg, mnB, alB);
  __syncthreads(); RESC(alB);
  finishSM(pB0, pB1, alB, l_reg, pa0, pa1, pa2, pa3); SBAR();
  pv_d0(o, vb0 + SHM_V, pa0, pa1, pa2, pa3);
#undef SLOAD
#undef SWRITE
#undef SWAIT
#undef RESC
}
__device__ __forceinline__ void row_inv_l(float l_reg, char* lds, int wid, int r32, int hi, float (&rli)[16]) {
  float* li_l = (float*)(lds + WS_OFF) + wid * 64;
  if (hi == 0) li_l[r32] = l_reg; asm volatile("s_waitcnt lgkmcnt(0)" ::: "memory");
#pragma unroll
  for (int r = 0; r < 16; ++r) rli[r] = __builtin_amdgcn_rcpf(li_l[crow(r, hi)]);
}
template <bool SILU> __device__ __forceinline__ void store_rows_gated(const f32x16 (&v)[4], char* stg, bf16_t* Yrow0  , const bf16_t* Grow0, int gpitch, int lane, int r32, int hi) {
  bf16_t* st = (bf16_t*)stg;
#pragma unroll
  for (int r = 0; r < 16; ++r) { const int orow = crow(r, hi);
#pragma unroll
    for (int d0 = 0; d0 < 4; ++d0) st[orow * 128 + d0 * 32 + r32] = (bf16_t)f2bf(v[d0][r]); }
  asm volatile("s_waitcnt lgkmcnt(0)" ::: "memory");
  const bf16_t* gp = Grow0 + (size_t)(lane >> 4) * gpitch + (lane & 15) * 8; bf16_t* yp = Yrow0 + (size_t)(lane >> 4) * DM + (lane & 15) * 8; const bf16_t* sp = st + (lane >> 4) * 128 + (lane & 15) * 8;
  u32x4 g[8];
#pragma unroll
  for (int i = 0; i < 8; ++i) { g[i] = *(const u32x4*)gp; gp += 4 * (size_t)gpitch; asm volatile("" : "+v"(gp)); }
#pragma unroll
  for (int i = 0; i < 8; ++i) {
    const u32x4 x = *(const u32x4*)(sp + i * 4 * 128);
    u32x4 w; w.x = pk2(bflo(x.x) * GATE(bflo(g[i].x)), bfhi(x.x) * GATE(bfhi(g[i].x))); w.y = pk2(bflo(x.y) * GATE(bflo(g[i].y)), bfhi(x.y) * GATE(bfhi(g[i].y)));
    w.z = pk2(bflo(x.z) * GATE(bflo(g[i].z)), bfhi(x.z) * GATE(bfhi(g[i].z))); w.w = pk2(bflo(x.w) * GATE(bflo(g[i].w)), bfhi(x.w) * GATE(bfhi(g[i].w)));
    *(u32x4*)yp = w; yp += 4 * DM; asm volatile("" : "+v"(yp)); }
  asm volatile("s_waitcnt lgkmcnt(0)" ::: "memory");
}
__device__ __forceinline__ void gqa_unit(const Params& p, char* lds, int m0, int hq, const bf16_t* Kh, const bf16_t* Vh, int seq, const int wid) {
  const int lane = fresh_lane(), r32 = lane & 31, hi = lane >> 5;
  const bf16_t* QC = (const bf16_t*)(p.ws + WS_Q); const bf16_t* PR = (const bf16_t*)(p.ws + WS_PR); bf16_t* Y = (bf16_t*)(p.ws + WS_HY);
  f32x16 o[4]; float l_reg;
  attn_core<8>(QC + (size_t)(m0 + wid * QBLK + r32) * DM + hq * 128 + hi * 8, Kh, Vh, seq, 0, lds, o, l_reg, wid, lane);
  float rli[16]; row_inv_l(l_reg, lds, wid, r32, hi, rli);
#pragma unroll
  for (int d0 = 0; d0 < 4; ++d0)
#pragma unroll
    for (int r = 0; r < 16; ++r) o[d0][r] *= rli[r];
  __syncthreads();
  const size_t row0 = (size_t)(m0 + wid * QBLK);
  store_rows_gated<false>(o, lds + wid * 8192, Y + row0 * DM + hq * 128, (const bf16_t*)(p.ws + WS_SG) + row0 * DM + hq * 128, DM, lane, r32, hi);
  __syncthreads();
}
constexpr int RES_WS = 131072 + 1024, RES_EX = 131072 + 4096;
__device__ __forceinline__ void load_kv_resident(const bf16_t* __restrict__ Kh, const bf16_t* __restrict__ Vh, char* lds, int tid) {
  bf16x8 kr[8], vr[8];
#pragma unroll
  for (int i = 0; i < 8; ++i) { const int c = tid + 512 * i; kr[i] = *reinterpret_cast<const bf16x8*>(Kh + (size_t)c * 8); vr[i] = *reinterpret_cast<const bf16x8*>(Vh + (size_t)c * 8); }
#pragma unroll
  for (int i = 0; i < 8; ++i) { const int c = tid + 512 * i, key = c >> 4, col = (c & 15) * 8, t = key >> 6, k = key & 63;
    *(bf16x8*)(lds + 65536 + t * 16384 + v_st(k, col)) = vr[i];
    *(bf16x8*)(lds + t * 16384 + KSWZ(k, col * 2)) = kr[i]; }
}
template <int ND0>
__device__ __forceinline__ void attn_core_res(const bf16_t* Qw, int kcol0, char* lds, f32x16 (&o)[4], float& l_reg, const int wid, const int lane) {
  const int r32 = lane & 31, hi = lane >> 5;
  const char* K_lds = lds; float* al_l = (float*)(lds + RES_WS) + wid * 64 + 32;
  float m_reg = -1e30f; l_reg = 0; bf16x8 qr[ND0];
  f32x16 cinit; for (int r = 0; r < 16; ++r) cinit[r] = -SOFT_OFF;
#pragma unroll
  for (int d = 0; d < 4; ++d) o[d] = f32x16{};
#pragma unroll
  for (int d0 = 0; d0 < ND0; ++d0) qr[d0] = *reinterpret_cast<const bf16x8*>(Qw + d0 * 16);
  const int vb0 = (int)(uintptr_t)(lds + 65536) + v_rd_base(lane);
#define RESC(a) do { if (__any((a) < 1.f)) { if (hi == 0) al_l[r32] = (a); asm volatile("s_waitcnt lgkmcnt(0)" ::: "memory"); \
    for (int d = 0; d < 4; ++d) for (int r = 0; r < 16; ++r) o[d][r] *= al_l[crow(r, hi)]; } } while (0)
  f32x16 pA0, pA1, pB0, pB1; float mnA, mnB, alA, alB; bf16x8 pa0, pa1, pa2, pa3;
  qkt<ND0>(pA0, pA1, K_lds, qr, r32, hi, kcol0, cinit); partialSM(pA0, pA1, m_reg, mnA, alA);
  SBAR(); qkt<ND0>(pB0, pB1, K_lds + 16384, qr, r32, hi, kcol0, cinit);
  finishSM(pA0, pA1, alA, l_reg, pa0, pa1, pa2, pa3); SBAR();
  pv_d0(o, vb0, pa0, pa1, pa2, pa3); partialSM(pB0, pB1, m_reg, mnB, alB); RESC(alB);
  SBAR(); qkt<ND0>(pA0, pA1, K_lds + 2 * 16384, qr, r32, hi, kcol0, cinit);
  finishSM(pB0, pB1, alB, l_reg, pa0, pa1, pa2, pa3); SBAR();
  pv_d0(o, vb0 + 16384, pa0, pa1, pa2, pa3); partialSM(pA0, pA1, m_reg, mnA, alA); RESC(alA);
  SBAR(); qkt<ND0>(pB0, pB1, K_lds + 3 * 16384, qr, r32, hi, kcol0, cinit);
  finishSM(pA0, pA1, alA, l_reg, pa0, pa1, pa2, pa3); SBAR();
  pv_d0(o, vb0 + 2 * 16384, pa0, pa1, pa2, pa3); partialSM(pB0, pB1, m_reg, mnB, alB); RESC(alB);
  finishSM(pB0, pB1, alB, l_reg, pa0, pa1, pa2, pa3); SBAR();
  pv_d0(o, vb0 + 3 * 16384, pa0, pa1, pa2, pa3);
#undef RESC
}
__device__ __forceinline__ void row_inv_l_res(float l_reg, char* lds, int wid, int r32, int hi, float (&rli)[16]) {
  float* li_l = (float*)(lds + RES_WS) + wid * 64;
  if (hi == 0) li_l[r32] = l_reg; asm volatile("s_waitcnt lgkmcnt(0)" ::: "memory");
#pragma unroll
  for (int r = 0; r < 16; ++r) rli[r] = __builtin_amdgcn_rcpf(li_l[crow(r, hi)]);
}
template <bool SILU> __device__ __forceinline__ void store_direct_gated(const f32x16 (&v)[4], char* stg  , bf16_t* Y0  , const bf16_t* G0, int gpitch, int lane, int r32, int hi) {
  bf16_t* st = (bf16_t*)stg;
  const bf16_t* gp = G0 + (size_t)(lane >> 4) * gpitch + (lane & 15) * 8; bf16_t* yp = Y0 + (size_t)(lane >> 4) * DM + (lane & 15) * 8; const bf16_t* sp = st + (lane >> 4) * 128 + (lane & 15) * 8;
  u32x4 g[8];
#pragma unroll
  for (int i = 0; i < 8; ++i) { g[i] = *(const u32x4*)gp; gp += 4 * (size_t)gpitch; asm volatile("" : "+v"(gp)); }
#pragma unroll
  for (int j = 0; j < 4; ++j) {
#pragma unroll
    for (int rr = 0; rr < 4; ++rr)
#pragma unroll
      for (int d0 = 0; d0 < 4; ++d0) st[(rr + 4 * hi) * 128 + d0 * 32 + r32] = (bf16_t)f2bf(v[d0][4 * j + rr]);
    asm volatile("s_waitcnt lgkmcnt(0)" ::: "memory");
#pragma unroll
    for (int i = 0; i < 2; ++i) {
      const u32x4 x = *(const u32x4*)(sp + i * 4 * 128); const u32x4 gg = g[2 * j + i];
      u32x4 w; w.x = pk2(bflo(x.x) * GATE(bflo(gg.x)), bfhi(x.x) * GATE(bfhi(gg.x))); w.y = pk2(bflo(x.y) * GATE(bflo(gg.y)), bfhi(x.y) * GATE(bfhi(gg.y)));
      w.z = pk2(bflo(x.z) * GATE(bflo(gg.z)), bfhi(x.z) * GATE(bfhi(gg.z))); w.w = pk2(bflo(x.w) * GATE(bflo(gg.w)), bfhi(x.w) * GATE(bfhi(gg.w)));
      *(u32x4*)yp = w; yp += 4 * DM; asm volatile("" : "+v"(yp)); }
    asm volatile("s_waitcnt lgkmcnt(0)" ::: "memory");
  }
}
__device__ __forceinline__ void gqa_prompt_slot(const Params& p, char* lds, int bk, const int wid) {
  const int lane = fresh_lane(), r32 = lane & 31, hi = lane >> 5;
  const bf16_t* QC = (const bf16_t*)(p.ws + WS_Q); const bf16_t* PR = (const bf16_t*)(p.ws + WS_PR); bf16_t* Y = (bf16_t*)(p.ws + WS_HY);
  load_kv_resident((const bf16_t*)(p.ws + WS_KP) + (size_t)bk * SEQP * 128, (const bf16_t*)(p.ws + WS_VP) + (size_t)bk * SEQP * 128, lds, wid * 64 + lane);
  __syncthreads();
  const int m0 = (bk >> 2) * SEQP;
  for (int g = 0; g < 4; ++g) {
    const int lane = fresh_lane(), r32 = lane & 31, hi = lane >> 5;
    const int hq = (bk & 3) * 4 + g;
    f32x16 o[4]; float l_reg;
    const size_t row0 = (size_t)(m0 + wid * QBLK);
    attn_core_res<8>(QC + (row0 + r32) * DM + hq * 128 + hi * 8, 0, lds, o, l_reg, wid, lane);
    float rli[16]; row_inv_l_res(l_reg, lds, wid, r32, hi, rli);
#pragma unroll
    for (int d0 = 0; d0 < 4; ++d0)
#pragma unroll
      for (int r = 0; r < 16; ++r) o[d0][r] *= rli[r];
    store_direct_gated<false>(o, lds + RES_EX + wid * 2048, Y + row0 * DM + hq * 128, (const bf16_t*)(p.ws + WS_SG) + row0 * DM + hq * 128, DM, lane, r32, hi);
  }
  __syncthreads();
}
__device__ __forceinline__ void diff_prompt_slot(const Params& p, char* lds, int slot  , float lam, const int wid) {
  const int lane = fresh_lane(), r32 = lane & 31, hi = lane >> 5, rg = wid & 3, mp = wid >> 2;
  const bf16_t* QA = (const bf16_t*)(p.ws + WS_Q); const bf16_t* PR = (const bf16_t*)(p.ws + WS_PR); bf16_t* Y = (bf16_t*)(p.ws + WS_HY);
  for (int hh = 0; hh < 2; ++hh) {
    const int bh = slot * 2 + hh, h = bh & 7, b = bh >> 3;
    load_kv_resident((const bf16_t*)(p.ws + WS_KP) + (size_t)bh * SEQP * 128, (const bf16_t*)(p.ws + WS_VP) + (size_t)bh * SEQP * 128, lds, wid * 64 + lane);
    __syncthreads();
    for (int qb = 0; qb < 2; ++qb) {
      const int lane = fresh_lane(), r32 = lane & 31, hi = lane >> 5;
      const size_t row0 = (size_t)(b * SEQP + qb * 128 + rg * QBLK);
      f32x16 o[4]; float l_reg;
      attn_core_res<4>(QA + (row0 + r32) * 1024 + h * 128 + mp * 64 + hi * 8, mp * 64, lds, o, l_reg, wid, lane);
      float rli[16]; row_inv_l_res(l_reg, lds, wid, r32, hi, rli);
      float* ex = (float*)(lds + RES_EX) + rg * 1024 + lane;
      float ss[16];
#pragma unroll
      for (int r = 0; r < 16; ++r) ss[r] = 0.f;
#pragma unroll
      for (int d0 = 0; d0 < 4; ++d0) {
        if (mp == 1) {
#pragma unroll
          for (int r = 0; r < 16; ++r) ex[r * 64] = o[d0][r] * (rli[r] * lam); }
        __syncthreads();
        if (mp == 0) {
#pragma unroll
          for (int r = 0; r < 16; ++r) { const float v = o[d0][r] * rli[r] - ex[r * 64]; o[d0][r] = v; ss[r] += v * v; } }
        __syncthreads();
      }
      if (mp == 0) {
#pragma unroll
        for (int r = 0; r < 16; ++r) {
#pragma unroll
          for (int of = 1; of < 32; of <<= 1) ss[r] += __shfl_xor(ss[r], of);
          ss[r] = 0.8f / sqrtf(ss[r] * (1.f / 128.f) + EPS); }
#pragma unroll
        for (int d0 = 0; d0 < 4; ++d0) { const float sw = p.subln_w[d0 * 32 + r32];
#pragma unroll
          for (int r = 0; r < 16; ++r) o[d0][r] *= ss[r] * sw; }
        store_direct_gated<false>(o, lds + RES_EX + 16384 + rg * 2048, Y + row0 * DM + h * 128, (const bf16_t*)(p.ws + WS_SG) + row0 * DM + h * 128, DM, lane, r32, hi);
      }
    }
    __syncthreads();
  }
}
__device__ __forceinline__ void gqa_phase(const Params& p, char* lds, int vcu, int G, const int wid, const int mode) {
  for (int v = vcu; v < 256; v += G) {
    if (v < 128) { if (mode & 1) continue;
      const int qb = v & 3, g = (v >> 2) & 3, bk = v >> 4;
      gqa_unit(p, lds, MP + (bk >> 2) * SEQS + qb * 256, (bk & 3) * 4 + g, (const bf16_t*)(p.ws + WS_KSC) + (size_t)bk * LKS * 128, (const bf16_t*)(p.ws + WS_VSC) + (size_t)bk * LKS * 128, LKS, wid); }
    else { if (mode & 2) continue; gqa_prompt_slot(p, lds, v - 128, wid); }
  }
}
__device__ __forceinline__ void diff_unit(const Params& p, char* lds, int m0, int h, const bf16_t* Kh, const bf16_t* Vh, int seq, float lam, const int wid) {
  const int lane = fresh_lane(), r32 = lane & 31, hi = lane >> 5, rg = wid & 3, mp = wid >> 2;
  const bf16_t* QA = (const bf16_t*)(p.ws + WS_Q); const bf16_t* PR = (const bf16_t*)(p.ws + WS_PR); bf16_t* Y = (bf16_t*)(p.ws + WS_HY);
  f32x16 o[4]; float l_reg;
  attn_core<4>(QA + (size_t)(m0 + rg * QBLK + r32) * 1024 + h * 128 + mp * 64 + hi * 8, Kh, Vh, seq, mp * 64, lds, o, l_reg, wid, lane);
  float rli[16]; row_inv_l(l_reg, lds, wid, r32, hi, rli);
  __syncthreads();
  float* ex = (float*)lds + rg * 4096 + lane;
  if (mp == 1) {
#pragma unroll
    for (int d0 = 0; d0 < 4; ++d0)
#pragma unroll
      for (int r = 0; r < 16; ++r) ex[(d0 * 16 + r) * 64] = o[d0][r] * (rli[r] * lam);
  }
  __syncthreads();
  if (mp == 0) {
    float ss[16];
#pragma unroll
    for (int r = 0; r < 16; ++r) ss[r] = 0.f;
#pragma unroll
    for (int d0 = 0; d0 < 4; ++d0)
#pragma unroll
      for (int r = 0; r < 16; ++r) { const float v = o[d0][r] * rli[r] - ex[(d0 * 16 + r) * 64]; o[d0][r] = v; ss[r] += v * v; }
#pragma unroll
    for (int r = 0; r < 16; ++r) {
#pragma unroll
      for (int of = 1; of < 32; of <<= 1) ss[r] += __shfl_xor(ss[r], of);
      ss[r] = 0.8f / sqrtf(ss[r] * (1.f / 128.f) + EPS); }
#pragma unroll
    for (int d0 = 0; d0 < 4; ++d0) { const float sw = p.subln_w[d0 * 32 + r32];
#pragma unroll
      for (int r = 0; r < 16; ++r) o[d0][r] *= ss[r] * sw; }
    const size_t row0 = (size_t)(m0 + rg * QBLK);
    store_rows_gated<false>(o, lds + STG_OFF + rg * 8192, Y + row0 * DM + h * 128, (const bf16_t*)(p.ws + WS_SG) + row0 * DM + h * 128, DM, lane, r32, hi);
  }
  __syncthreads();
}
__device__ __forceinline__ void diff_phase(const Params& p, char* lds, int vcu, int G, const int wid, const int mode) {
  const int lane = fresh_lane();
  const float lam = expf(wave_sum(p.lam_q1[lane] * p.lam_k1[lane])) - expf(wave_sum(p.lam_q2[lane] * p.lam_k2[lane])) + 0.2f;
  for (int v = vcu; v < 256; v += G) {
    if (v < 128) { if (mode & 1) continue;
      const int qb = v & 7, bh = v >> 3;
      diff_unit(p, lds, MP + (bh >> 3) * SEQS + qb * 128, bh & 7, (const bf16_t*)(p.ws + WS_KSA) + (size_t)bh * LKS * 128, (const bf16_t*)(p.ws + WS_VSA) + (size_t)bh * LKS * 128, LKS, lam, wid);
      if (!(mode & 4)) pool_apply_slot(p, v, wid * 64 + fresh_lane()); }
    else { if (mode & 2) continue; diff_prompt_slot(p, lds, v - 128, lam, wid); }
  }
}
#undef KSWZ
#undef SBAR
}

constexpr int NWAVES = 8;
constexpr int RING_OFF = 0, RING_BYTES = 131072;
constexpr int LDSCTL_OFF = RING_BYTES, MISC_OFF = LDSCTL_OFF + 320;
constexpr int LDS_BYTES = 163840;
constexpr int RES_WS_OFF = RING_BYTES + 1024, RES_EX_OFF = RING_BYTES + 4096;
constexpr int CW_BAR = 4096;
#define GAS __attribute__((address_space(1)))
#define LAS __attribute__((address_space(3)))
typedef GAS unsigned gu32;
#define RLX_AGENT __ATOMIC_RELAXED, __HIP_MEMORY_SCOPE_AGENT
#define XB_TMO      128
#define XB_XCNT(j)  (256  + 64 * (j))
#define XB_XSUB(j)  (1280 + 64 * (j))
#define XB_XGEN(j)  (2304 + 64 * (j))
#define XB_TOP      3328
#define XB_TOPGEN   3392
#define XCD_BAR_WORDS 3456
#define XB_SPIN_CAP (1u << 18)
__device__ __forceinline__ unsigned xb_ld(unsigned* p)              { return __hip_atomic_load(p, __ATOMIC_RELAXED, __HIP_MEMORY_SCOPE_AGENT); }
__device__ __forceinline__ unsigned xb_add(unsigned* p, unsigned v) { return __hip_atomic_fetch_add(p, v, __ATOMIC_RELAXED, __HIP_MEMORY_SCOPE_AGENT); }
__device__ __forceinline__ unsigned xb_xcc_id() { return (unsigned)__builtin_amdgcn_s_getreg((3 << 11) | 20) & 0xFu; }
#define XB_SPIN(cond, bar) do { unsigned _sp = 0; while (cond) { __builtin_amdgcn_s_sleep(1); \
    if ((++_sp & 255u) == 0u) { if (xb_ld(&(bar)[XB_TMO])) break; if (_sp > XB_SPIN_CAP) { atomicAdd(&(bar)[XB_TMO], 1u); break; } } } } while (0)
struct XcdBarrier { unsigned* bar; unsigned x; volatile LAS unsigned* st; };
__device__ __forceinline__ XcdBarrier xcd_barrier_post(unsigned* bar, volatile LAS unsigned* st) {
    XcdBarrier b; b.bar = bar; b.x = xb_xcc_id(); b.st = st;
    if (threadIdx.x == 0) (void)xb_add(&bar[XB_XCNT(b.x)], 1u);
    return b;
}
__device__ __forceinline__ void xcd_barrier_complete(unsigned* bar, unsigned x, unsigned& nloc, unsigned& nx) {
    const unsigned G = gridDim.x * gridDim.y * gridDim.z;
    unsigned sum, cnt, mine, sp = 0u;
    for (;;) {
        sum = 0u; cnt = 0u; mine = 0u;
#pragma unroll
        for (unsigned j = 0; j < 16; ++j) { const unsigned c = xb_ld(&bar[XB_XCNT(j)]); sum += c; cnt += (c > 0u) ? 1u : 0u; mine = (j == x) ? c : mine; }
        if (sum == G) break;
        __builtin_amdgcn_s_sleep(1);
        if ((++sp & 255u) == 0u) { if (xb_ld(&bar[XB_TMO])) break; if (sp > XB_SPIN_CAP) { atomicAdd(&bar[XB_TMO], 1u); break; } }
    }
    nloc = mine > 0u ? mine : 1u; nx = cnt > 0u ? cnt : 1u;
}
__device__ __forceinline__ void xcd_barrier(const XcdBarrier& b) {
    asm volatile("s_waitcnt vmcnt(0)" ::: "memory");
    __syncthreads();
    if (threadIdx.x == 0) {
        unsigned* bar = b.bar;
        __builtin_amdgcn_s_waitcnt(0);
        unsigned nloc = b.st[0], nx = b.st[1];
        if (nloc == 0u) { xcd_barrier_complete(bar, b.x, nloc, nx); b.st[0] = nloc; b.st[1] = nx; }
        const unsigned old = xb_add(&bar[XB_XSUB(b.x)], 1u);
        const unsigned gen = old / nloc;
        if (old + 1u == (gen + 1u) * nloc) {
            __builtin_amdgcn_fence(__ATOMIC_RELEASE, "agent");
            asm volatile("s_waitcnt vmcnt(0)" ::: "memory");
            const unsigned og = xb_add(&bar[XB_TOP], 1u);
            const unsigned tg = og / nx;
            if (og + 1u == (tg + 1u) * nx) xb_add(&bar[XB_TOPGEN], 1u);
            else XB_SPIN(xb_ld(&bar[XB_TOPGEN]) == tg, bar);
            __builtin_amdgcn_fence(__ATOMIC_ACQUIRE, "agent");
            xb_add(&bar[XB_XGEN(b.x)], 1u);
            asm volatile("s_waitcnt vmcnt(0)" ::: "memory");
        } else {
            XB_SPIN(xb_ld(&bar[XB_XGEN(b.x)]) == gen, bar);
            __builtin_amdgcn_fence(__ATOMIC_ACQUIRE, "agent");
            asm volatile("s_waitcnt vmcnt(0)" ::: "memory");
        }
    }
    __syncthreads();
}

constexpr size_t WS_SLAB = WS_PR + 40 * MiB;
constexpr size_t CTL_TAIL = 256 * 1024;
template <int KIND> __device__ __forceinline__ void tail_reduce(const Params& p, const pg8::StaticOrder& S, int slot, int wave, int lane) {
    if (S.split <= 1) return;
    const int c = S.c, xcd = c % 8, q = c / 8, split = S.split, ks = q % split, j = (q / split) * 8 + xcd;
    pg8::Unit u; S.tile(S.nfull + j, u);
    unsigned* cnt = (unsigned*)(p.ws + WS_CTL + CTL_TAIL) + slot * 4096 + 64 * j;
    asm volatile("s_waitcnt vmcnt(0)" ::: "memory");
    __syncthreads();
    if (threadIdx.x == 0) {
        __builtin_amdgcn_fence(__ATOMIC_RELEASE, "agent");
        asm volatile("s_waitcnt vmcnt(0)" ::: "memory");
        __hip_atomic_fetch_add(cnt, 1u, __ATOMIC_RELAXED, __HIP_MEMORY_SCOPE_AGENT);
        unsigned sp = 0;
        while (__hip_atomic_load(cnt, __ATOMIC_RELAXED, __HIP_MEMORY_SCOPE_AGENT) < (unsigned)split) { __builtin_amdgcn_s_sleep(1); if (++sp > (1u << 22)) break; }
        __builtin_amdgcn_fence(__ATOMIC_ACQUIRE, "agent");
        asm volatile("s_waitcnt vmcnt(0)" ::: "memory");
    }
    __syncthreads();
    const int R = 256 / split, rpw = R / 8;
    const float* sb = (const float*)(p.ws + WS_SLAB) + (size_t)(j * split) * 65536 + 4 * lane;
    const int col = u.pn * 256 + 4 * lane;
    for (int i = 0; i < rpw; ++i) {
        const int rl = ks * R + wave * rpw + i, r = u.pm * 256 + rl, cr = cond_row(r);
        f32x4 sum = {0.f, 0.f, 0.f, 0.f};
        for (int sidx = 0; sidx < split; ++sidx) sum += *(const f32x4*)(sb + (size_t)sidx * 65536 + (size_t)rl * 256);
        if (KIND == 0) {
            const f32x4 x = *(const f32x4*)(xrow_ptr(p, r) + col), gt = *(const f32x4*)((const float*)(p.ws + WS_MOD) + 4096 + (size_t)cr * 6144 + col), cw = *(const f32x4*)((const float*)(p.ws + WS_CW1) + (size_t)cr * DM + col);
            const f32x4 y = x + gt * sum;
            *(f32x4*)(p.out + (size_t)r * DM + col) = y;
            const f32x4 h = y * cw; u32x2 o; o.x = pk2(h[0], h[1]); o.y = pk2(h[2], h[3]);
            *(u32x2*)((bf16_t*)(p.ws + WS_H1) + (size_t)r * DM + col) = o;
            const float ss = wave_sum((y[0] * y[0] + y[1] * y[1]) + (y[2] * y[2] + y[3] * y[3]));
            if (lane == 0) atomicAdd((float*)(p.ws + WS_RSS) + r, ss);
        } else if (KIND == 1) {
            const f32x4 gt = *(const f32x4*)((const float*)(p.ws + WS_MOD) + 3 * 6144 + 4096 + (size_t)cr * 6144 + col);
            float* op = p.out + (size_t)r * DM + col; *(f32x4*)op = *(const f32x4*)op + gt * sum;
        } else {
            const float rstd = 1.0f / sqrtf(((const float*)(p.ws + WS_RSS))[r] * (1.f / DM) + EPS);
            const f32x4 v = sum * rstd + *(const f32x4*)((const float*)(p.ws + WS_B2P) + (size_t)cr * ODD_IN + col);
            u32x2 o; o.x = pk2(siluf(v[0]), siluf(v[1])); o.y = pk2(siluf(v[2]), siluf(v[3]));
            *(u32x2*)((bf16_t*)(p.ws + WS_SG) + (size_t)r * DM + (col - 12 * 256)) = o;
        }
    }
}

struct MegaArgs { Params p; int ph_lo, ph_hi, mode, pad; };
constexpr int N_PHASES = 11;
#ifndef DUP_PHASE
#define DUP_PHASE -1
#endif
__device__ __forceinline__ Params load_params() {
#if defined(__HIP_DEVICE_COMPILE__)
    typedef __attribute__((address_space(4))) const unsigned long long* KPtr;
    KPtr a = (KPtr)__builtin_amdgcn_kernarg_segment_ptr();
    asm volatile("" : "+s"(a));
    Params p; unsigned long long* d = (unsigned long long*)&p;
#pragma unroll
    for (int i = 0; i < (int)(sizeof(Params) / 8); ++i) d[i] = a[i];
    return p;
#else
    return Params{};
#endif
}
__global__ void __launch_bounds__(NWAVES * 64, 2) mega_fwd(MegaArgs args) {
    extern __shared__ __attribute__((aligned(16))) unsigned char lds[];
    LAS unsigned char* ldsl = (LAS unsigned char*)lds;
    volatile LAS unsigned* MISC = (volatile LAS unsigned*)(ldsl + MISC_OFF);
    const int wave = __builtin_amdgcn_readfirstlane(threadIdx.x >> 6);
    const int G = gridDim.x, bx = blockIdx.x;
    const int vcu = (G % 8 == 0) ? (bx % 8) * (G / 8) + bx / 8 : bx;
    for (int u = threadIdx.x; u < (LDS_BYTES - LDSCTL_OFF) / 4; u += NWAVES * 64) ((LAS unsigned*)(ldsl + LDSCTL_OFF))[u] = 0u;
    __syncthreads();
    XcdBarrier bar; { const Params p0 = load_params(); bar = xcd_barrier_post((unsigned*)(p0.ws + WS_CTL) + CW_BAR, MISC + 8); }
    const int lo = args.ph_lo, hi = args.ph_hi, mode = args.mode;
    const int gw = vcu * NWAVES + wave, ngw = G * NWAVES;
#define IN(k) (lo <= (k) && (k) < hi)
#define SEAM(k) do { if (IN(k) && (IN((k) + 1) || ((k) == 7 && IN(9)) || ((k) == 5 && IN(7)) || ((k) == 2 && IN(4)))) xcd_barrier(bar); } while (0)
    if (IN(0)) {
        const Params p = load_params();
        float* scr = (float*)lds; const int lane = fresh_lane(), tid = wave * 64 + lane;
        if (!(mode & 8)) mod_items(p, scr, bx, G, tid, NWAVES * 64);
        __syncthreads();
        if (!(mode & 16)) weights_items(p, (float*)(lds + wave * 16384), gw, ngw, lane);
        if (!(mode & 32)) caches_rope_items(p, (long)bx * 512 + tid, (long)G * 512);
    }
    SEAM(0);
    if (IN(1)) {
        const Params p = load_params(); unsigned char* const ws = p.ws;
        if (bx < 32) {
            pg8::Gemm g{(const bf16_t*)(ws + WS_POOLW), (const bf16_t*)(ws + WS_WU), 1024, DM, 256, 256, 1024, 0, 256, 0}; pg8::StaticOrder S; S.init(1024, DM, 256, G, bx, false);
            pg8::EpiBf16 E{(bf16_t*)(ws + WS_WINE) + (size_t)3072 * DM, DM, 0};
            pg8::gemm_phase<pg8::EpiBf16, pg8::StaticOrder, true, true>(ldsl + RING_OFF, g, S, E, wave * 64 + fresh_lane());
        } else { const int ln = fresh_lane(), g2 = (bx - 32) * NWAVES + wave, n2 = (G - 32) * NWAVES; modulate_rows(p, 0, g2, n2, ln); mod1_tables(p, g2, n2, ln); }
    }
    SEAM(1);
    if (IN(2)) {
        const Params p = load_params(); unsigned char* const ws = p.ws;
        pg8::Gemm g{(const bf16_t*)(ws + WS_HY), (const bf16_t*)(ws + WS_WINE), MT, EVEN_IN, DM, DM, DM, 0, 0, 0}; pg8::StaticOrder S; S.init(MT, EVEN_IN, DM, G, bx, false);
        float* nak = p.out + (size_t)MT * DM;
        pg8::EpiProj0 E{ws, p.even_q_norm_w, p.even_k_norm_w, nak, nak + (size_t)NBP * HA * SEQP * 128};
        pg8::gemm_phase<pg8::EpiProj0, pg8::StaticOrder, true, true>(ldsl + RING_OFF, g, S, E, wave * 64 + fresh_lane());
    }
    SEAM(2);
    if (IN(4)) { const Params p = load_params(); att::diff_phase(p, (char*)lds, vcu, G, wave, mode); }
    SEAM(4);
    constexpr size_t CTL_PANEL = 320 * 1024;
    const bool stagger = (G == 256) && IN(5) && IN(7);
    if (IN(5)) {
        for (int part = 0; part < (stagger ? 2 : 1); ++part) {
            const Params p = load_params(); unsigned char* const ws = p.ws;
            pg8::Gemm g{(const bf16_t*)(ws + WS_HY), (const bf16_t*)(ws + WS_WOUTE), MT, DM, DM, DM, DM, 0, 0, 0};
            pg8::EpiResid0 E{p.x_prompt, p.x_sample, (const float*)(ws + WS_MOD) + 4096, (const float*)(ws + WS_CW1), p.out, (bf16_t*)(ws + WS_H1), (float*)(ws + WS_RSS), (float*)(ws + WS_SLAB)};
            if (stagger) {
                if (part == 1 && bx >= 64) break;
                pg8::OutOrder S{bx, part};
                pg8::gemm_phase<pg8::EpiResid0, pg8::OutOrder, true, true>(ldsl + RING_OFF, g, S, E, wave * 64 + fresh_lane());
                if (part == 0) xcd_barrier(bar);
                else {
                    asm volatile("s_waitcnt vmcnt(0)" ::: "memory"); __syncthreads();
                    if (threadIdx.x == 0) { __builtin_amdgcn_fence(__ATOMIC_RELEASE, "agent"); asm volatile("s_waitcnt vmcnt(0)" ::: "memory");
                        __hip_atomic_fetch_add((unsigned*)(ws + WS_CTL + CTL_PANEL) + 64 * (bx / 8), 1u, __ATOMIC_RELAXED, __HIP_MEMORY_SCOPE_AGENT); }
                }
            } else {
                pg8::StaticOrder S; S.init(MT, DM, DM, G, bx, false);
                pg8::gemm_phase<pg8::EpiResid0, pg8::StaticOrder, true, true>(ldsl + RING_OFF, g, S, E, wave * 64 + fresh_lane());
            }
        }
    }
    if (!stagger) SEAM(5);
    if (IN(7)) {
        const Params p = load_params(); unsigned char* const ws = p.ws;
        pg8::Gemm g{(const bf16_t*)(ws + WS_H1), (const bf16_t*)(ws + WS_WINO), MT, ODD_IN, DM, DM, DM, 0, 0, 0};
        float* nck = p.out + (size_t)MT * DM + 2 * (size_t)NBP * HA * SEQP * 128;
        pg8::EpiProj1 E{ws, p.gqa_q_norm_w, p.gqa_k_norm_w, nck, nck + (size_t)NBP * KVH * SEQP * 128, (LAS float*)(ldsl + RES_EX_OFF), (float*)(ws + WS_SLAB)};
        if (stagger) { pg8::StaggerOrder S{bx, (const unsigned*)(ws + WS_CTL + CTL_PANEL), true};
            pg8::gemm_phase<pg8::EpiProj1, pg8::StaggerOrder, true, true>(ldsl + RING_OFF, g, S, E, wave * 64 + fresh_lane()); }
        else { pg8::StaticOrder S; S.init(MT, ODD_IN, DM, G, bx, false);
            pg8::gemm_phase<pg8::EpiProj1, pg8::StaticOrder, true, true>(ldsl + RING_OFF, g, S, E, wave * 64 + fresh_lane()); }
    }
    SEAM(7);
    if (IN(9)) { const Params p = load_params(); att::gqa_phase(p, (char*)lds, vcu, G, wave, mode); }
    SEAM(9);
    if (IN(10)) {
        const Params p = load_params(); unsigned char* const ws = p.ws;
        pg8::Gemm g{(const bf16_t*)(ws + WS_HY), (const bf16_t*)(ws + WS_WOUTO), MT, DM, DM, DM, DM, 0, 0, 0}; pg8::StaticOrder S; S.init(MT, DM, DM, G, bx, false);
        pg8::EpiResidF E{p.x_prompt, p.x_sample, p.out, (const float*)(ws + WS_MOD) + 3 * 6144 + 4096, p.out, (float*)(ws + WS_SLAB)};
        pg8::gemm_phase<pg8::EpiResidF, pg8::StaticOrder, true, true>(ldsl + RING_OFF, g, S, E, wave * 64 + fresh_lane());
        { const Params p2 = load_params(); tail_reduce<1>(p2, S, 2, wave, fresh_lane()); }
    }
#undef IN
#undef SEAM
}

#ifndef MK_PER_PHASE
#define MK_PER_PHASE 0
#endif
extern "C" void kernel_launch(void* const* d_in, const int* in_sizes, int n_in, void* d_out, int out_size, void* d_ws, size_t ws_size, hipStream_t stream) {
    if (n_in != 26 || ws_size < WS_END || out_size != MT * DM + 2 * NBP * HA * SEQP * 128 + 2 * NBP * KVH * SEQP * 128) {
        fprintf(stderr, "kernel_launch: unexpected shapes n_in %d ws %zu out %d\n", n_in, ws_size, out_size); return; }
    static int ready = 0;
    if (!ready) {
        if (hipFuncSetAttribute((const void*)mega_fwd, hipFuncAttributeMaxDynamicSharedMemorySize, LDS_BYTES) != hipSuccess) { fprintf(stderr, "kernel_launch: hipFuncSetAttribute failed\n"); return; }
        ready = 1;
    }
    MegaArgs a{};
    const float** pin = (const float**)&a.p;
    for (int i = 0; i < 26; ++i) pin[i] = (const float*)d_in[i];
    a.p.out = (float*)d_out; a.p.ws = (unsigned char*)d_ws;
#ifdef EXTRA_PHASE
    (void)hipMemsetAsync((unsigned char*)d_ws + WS_CTL, 0, 2 * MiB, stream);
    a.ph_lo = EXTRA_PHASE; a.ph_hi = EXTRA_PHASE + 1; hipLaunchKernelGGL(mega_fwd, dim3(256), dim3(NWAVES * 64), LDS_BYTES, stream, a);
#endif
    (void)hipMemsetAsync((unsigned char*)d_ws + WS_CTL, 0, 2 * MiB, stream);
#if MK_PER_PHASE
    for (int ph = 0; ph < N_PHASES; ++ph) { a.ph_lo = ph; a.ph_hi = ph + 1; hipLaunchKernelGGL(mega_fwd, dim3(256), dim3(NWAVES * 64), LDS_BYTES, stream, a); }
#else
    a.ph_lo = 0; a.ph_hi = N_PHASES; hipLaunchKernelGGL(mega_fwd, dim3(256), dim3(NWAVES * 64), LDS_BYTES, stream, a);
#endif
#ifdef EXTRA_AFTER
    (void)hipMemsetAsync((unsigned char*)d_ws + WS_CTL, 0, 1 * MiB, stream);
    a.ph_lo = EXTRA_AFTER; a.ph_hi = EXTRA_AFTER + 1; a.mode = EXTRA_MODE; hipLaunchKernelGGL(mega_fwd, dim3(256), dim3(NWAVES * 64), LDS_BYTES, stream, a);
#endif
}
```

```cpp
#include <hip/hip_runtime.h>
#include <cstdio>
#include <cstdint>

typedef unsigned short bf16_t;
typedef float f32x4 __attribute__((ext_vector_type(4)));
typedef unsigned u32x4 __attribute__((ext_vector_type(4)));
typedef unsigned u32x2 __attribute__((ext_vector_type(2)));

constexpr int DM = 2048, NBP = 32, SEQP = 256, NBS = 2, SEQS = 1024, PAST = 256;
constexpr int MP = NBP * SEQP, MS = NBS * SEQS, MT = MP + MS;
constexpr int HA = 8, DKA = 64, DVA = 128, WA = 1024, WB = 1024, GWB = 256;
constexpr int EVEN_IN = 6144, ODD_IN = 5120;
constexpr int HC = 16, KVH = 4, HDC = 128;
constexpr int LKS = PAST + SEQS;
constexpr float EPS = 1e-6f;
constexpr float LOG2E = 1.4426950408889634f;
constexpr float C2A = 0.125f * LOG2E;
constexpr float C2C = 0.08838834764831845f * LOG2E;

constexpr size_t MiB = 1u << 20;
constexpr size_t WS_CTL = 0;
constexpr size_t WS_MOD = 1 * MiB;
constexpr size_t WS_ROPE = 2 * MiB;
constexpr size_t WS_WINE = 4 * MiB;
constexpr size_t WS_WOUTE = 28 * MiB;
constexpr size_t WS_WINO = 36 * MiB;
constexpr size_t WS_WOUTO = 56 * MiB;
constexpr size_t WS_POOLW = 64 * MiB;
constexpr size_t WS_HY = 65 * MiB;
constexpr size_t WS_PR = 105 * MiB;
constexpr size_t WS_Q = 225 * MiB;
constexpr size_t WS_KP = 265 * MiB;
constexpr size_t WS_VP = 281 * MiB;
constexpr size_t WS_KSA = 297 * MiB;
constexpr size_t WS_VSA = 302 * MiB;
constexpr size_t WS_KSC = 307 * MiB;
constexpr size_t WS_VSC = 310 * MiB;
constexpr size_t WS_UA = 313 * MiB;
constexpr size_t WS_SG = WS_PR;
constexpr size_t WS_U = WS_PR + 40 * MiB;
constexpr size_t WS_H1 = 333 * MiB;
constexpr size_t WS_WU = WS_UA;
constexpr size_t WS_END = 373 * MiB;
constexpr size_t WS_CW1 = WS_MOD + 256 * 1024;
constexpr size_t WS_B2P = WS_MOD + 320 * 1024;
constexpr size_t WS_RSS = WS_MOD + 512 * 1024;

struct Params {
    const float* x_prompt; const float* x_sample; const float* cache_a_k; const float* cache_a_v; const float* cache_c_k; const float* cache_c_v;
    const float* c; const float* c_ctx; const float* norm_w; const float* ada_w; const float* ada_b;
    const float* even_w_in; const float* even_q_norm_w; const float* even_k_norm_w; const float* lam_q1; const float* lam_k1; const float* lam_q2; const float* lam_k2;
    const float* subln_w; const float* pool_w; const float* pool_scale; const float* even_w_out;
    const float* gqa_w_in; const float* gqa_q_norm_w; const float* gqa_k_norm_w; const float* gqa_w_out;
    float* out; unsigned char* ws;
};

__device__ __forceinline__ unsigned f2bf(float f) { unsigned u = __builtin_bit_cast(unsigned, f); return (u + 0x7fffu + ((u >> 16) & 1u)) >> 16; }
__device__ __forceinline__ unsigned pk2(float lo, float hi) { return f2bf(lo) | (f2bf(hi) << 16); }
__device__ __forceinline__ float bf2f(unsigned h) { return __builtin_bit_cast(float, h << 16); }
__device__ __forceinline__ float bflo(unsigned w) { return __builtin_bit_cast(float, w << 16); }
__device__ __forceinline__ float bfhi(unsigned w) { return __builtin_bit_cast(float, w & 0xffff0000u); }
__device__ __forceinline__ float siluf(float x) { return x / (1.f + __expf(-x)); }
__device__ __forceinline__ float wave_sum(float v) {
#pragma unroll
    for (int o = 1; o < 64; o <<= 1) v += __shfl_xor(v, o);
    return v;
}
__device__ __forceinline__ float wave_max(float v) {
#pragma unroll
    for (int o = 1; o < 64; o <<= 1) v = fmaxf(v, __shfl_xor(v, o));
    return v;
}
__device__ __forceinline__ int fresh_lane() { int l; asm volatile("v_mbcnt_lo_u32_b32 %0, -1, 0\n\tv_mbcnt_hi_u32_b32 %0, -1, %0" : "=v"(l)); return l; }
__device__ __forceinline__ const float* xrow_ptr(const Params& p, int m) { return m < MP ? p.x_prompt + (size_t)m * DM : p.x_sample + (size_t)(m - MP) * DM; }
__device__ __forceinline__ int cond_row(int m) { return m < MP ? 0 : 1 + ((m - MP) >> 10); }

__device__ __forceinline__ void mod_items(const Params& p, float* sl  , int bid, int nb, int tid, int nthr) {
    float* mod = (float*)(p.ws + WS_MOD);
    for (int it = bid; it < 256; it += nb) {
        const int l = it >> 7, kc = (it >> 2) & 31, nc = it & 3;
        __syncthreads();
        for (int i = tid; i < 192; i += nthr) { const int r = i >> 6, kk = i & 63, k = kc * 64 + kk; const float cv = r == 0 ? p.c_ctx[k] : p.c[(r - 1) * DM + k]; sl[i] = siluf(cv); }
        __syncthreads();
        for (int q = tid; q < 384; q += nthr) {
            const int n = nc * 1536 + q * 4;
            const float* w = p.ada_w + ((size_t)l * DM + kc * 64) * 6144 + n;
            f32x4 a0 = {0.f, 0.f, 0.f, 0.f}, a1 = a0, a2 = a0;
#pragma unroll 16
            for (int kk = 0; kk < 64; ++kk) { const f32x4 wv = *(const f32x4*)(w + (size_t)kk * 6144); a0 += wv * sl[kk]; a1 += wv * sl[64 + kk]; a2 += wv * sl[128 + kk]; }
            if (kc == 0) { const f32x4 b = *(const f32x4*)(p.ada_b + l * 6144 + n); a0 += b; a1 += b; a2 += b; }
            float* m0 = mod + (size_t)(l * 3) * 6144 + n;
#pragma unroll
            for (int e = 0; e < 4; ++e) { atomicAdd(m0 + e, a0[e]); atomicAdd(m0 + 6144 + e, a1[e]); atomicAdd(m0 + 2 * 6144 + e, a2[e]); }
        }
    }
}

__device__ __forceinline__ void transpose_item(const float* W, int K, int N, bf16_t* WT, float* scr, int item, int lane) {
    const int nblk = N / 32, kb = item / nblk, nb = item % nblk, k0 = 64 * kb, n0 = 32 * nb;
#pragma unroll 8
    for (int i = 0; i < 32; ++i) { const int kk = 2 * i + (lane >> 5); scr[kk * 33 + (lane & 31)] = W[(size_t)(k0 + kk) * N + n0 + (lane & 31)]; }
    __builtin_amdgcn_s_waitcnt(0xc07f); asm volatile("" ::: "memory");
    const int c = lane & 7;
#pragma unroll
    for (int j = 0; j < 4; ++j) { const int n = (lane >> 3) + 8 * j; const float* s = scr + (8 * c) * 33 + n;
        u32x4 o; o.x = pk2(s[0 * 33], s[1 * 33]); o.y = pk2(s[2 * 33], s[3 * 33]); o.z = pk2(s[4 * 33], s[5 * 33]); o.w = pk2(s[6 * 33], s[7 * 33]);
        *(u32x4*)(WT + (size_t)(n0 + n) * K + k0 + 8 * c) = o; }
    __builtin_amdgcn_s_waitcnt(0xc07f); asm volatile("" ::: "memory");
}
template <int PERMK> __device__ __forceinline__ int pos_of_col(int n) {
    if (PERMK == 1) { if (n >= 2048) return n; const int c = n & 255, wc = c >> 6, dim = c & 63, q = dim >> 4, ii = dim & 15; return (n & ~255) + 128 * (q & 1) + 32 * wc + (q >> 1) * 16 + ii; }
    if (PERMK == 2) { if (n >= 2560) return n; const int c = n & 255, hl = c >> 7, dim = c & 127, qd = dim >> 5, i = dim & 31; return (n & ~255) + 128 * (qd & 1) + 32 * (2 * hl + (qd >> 1)) + i; }
    return n;
}
template <int PERMK> __device__ __forceinline__ void transpose_item64(const float* W, int K, int N, bf16_t* WT, bf16_t* scr, int item, int lane) {
    const int nblk = N / 64, kb = item / nblk, nb = item % nblk, k0 = 64 * kb, n0 = 64 * nb;
    const int nq = lane & 15, kr = lane >> 4;
    f32x4 v[16];
    const float* src = W + (size_t)(k0 + kr) * N + n0 + 4 * nq;
#pragma unroll
    for (int i = 0; i < 16; ++i) v[i] = *(const f32x4*)(src + (size_t)(4 * i) * N);
#pragma unroll
    for (int i = 0; i < 16; ++i) { const int k = 4 * i + kr;
#pragma unroll
        for (int e = 0; e < 4; ++e) scr[(4 * nq + e) * 72 + k] = (bf16_t)f2bf(v[i][e]); }
    __builtin_amdgcn_s_waitcnt(0xc07f); asm volatile("" ::: "memory");
#pragma unroll
    for (int j = 0; j < 8; ++j) { const int idx = lane + 64 * j, n = idx >> 3, c = idx & 7;
        *(u32x4*)(WT + (size_t)pos_of_col<PERMK>(n0 + n) * K + k0 + 8 * c) = *(const u32x4*)(scr + n * 72 + 8 * c); }
    __builtin_amdgcn_s_waitcnt(0xc07f); asm volatile("" ::: "memory");
}
__device__ __forceinline__ void convert_item64(const float* W, int N, bf16_t* WU, int ldu, int ncol0, int item, int nblk0, int lane) {
    const int nblk = N / 64, kb = item / nblk, nb = item % nblk, k0 = 64 * kb, n0 = 64 * nb;
    const int nq = lane & 15, kr = lane >> 4;
    const float* src = W + (size_t)(k0 + kr) * N + n0 + 4 * nq;
    f32x4 v[16];
#pragma unroll
    for (int i = 0; i < 16; ++i) v[i] = *(const f32x4*)(src + (size_t)(4 * i) * N);
#pragma unroll
    for (int i = 0; i < 16; ++i) { u32x2 o; o.x = pk2(v[i][0], v[i][1]); o.y = pk2(v[i][2], v[i][3]); *(u32x2*)(WU + (size_t)(k0 + 4 * i + kr) * ldu + (n0 - ncol0) + 4 * nq) = o; }
}
__device__ __forceinline__ void weights_items(const Params& p, float* scrf  , int gw, int ngw, int lane) {
    bf16_t* scr = (bf16_t*)scrf;
    constexpr int I_WINE = 32 * (EVEN_IN / 64), I_WOUT = 32 * (DM / 64), I_WINO = 32 * (ODD_IN / 64), I_POOL = 4 * 4;
    constexpr int NITEMS = I_WINE + I_WOUT + I_WINO + I_WOUT + 4 * I_POOL;
    for (int it = gw; it < NITEMS; it += ngw) {
        int r = it;
        if (r < I_WINE) { const int nb = r % (EVEN_IN / 64);
            if (nb >= 48 && nb < 64) convert_item64(p.even_w_in, EVEN_IN, (bf16_t*)(p.ws + WS_WU), 1024, 3072, r, 0, lane);
            else transpose_item64<1>(p.even_w_in, DM, EVEN_IN, (bf16_t*)(p.ws + WS_WINE), scr, r, lane);
            continue; } r -= I_WINE;
        if (r < I_WOUT) { transpose_item64<0>(p.even_w_out, DM, DM, (bf16_t*)(p.ws + WS_WOUTE), scr, r, lane); continue; } r -= I_WOUT;
        if (r < I_WINO) { transpose_item64<2>(p.gqa_w_in, DM, ODD_IN, (bf16_t*)(p.ws + WS_WINO), scr, r, lane); continue; } r -= I_WINO;
        if (r < I_WOUT) { transpose_item64<0>(p.gqa_w_out, DM, DM, (bf16_t*)(p.ws + WS_WOUTO), scr, r, lane); continue; } r -= I_WOUT;
        const int g = r / I_POOL; r -= g * I_POOL;
        transpose_item64<0>(p.pool_w + (size_t)g * 65536, 256, 256, (bf16_t*)(p.ws + WS_POOLW) + (size_t)g * 65536, scr, r, lane);
    }
}
__device__ __forceinline__ void caches_rope_items(const Params& p, long gt, long ngt) {
    constexpr long NA = 2L * 8 * 256 * 128 / 4, NC = 2L * 4 * 256 * 128 / 4;
    for (long i = gt; i < 2 * NA + 2 * NC; i += ngt) {
        long j = i; const float* src; bf16_t* dst;
        if (j < NA) { src = p.cache_a_k; dst = (bf16_t*)(p.ws + WS_KSA); } else if ((j -= NA) < NA) { src = p.cache_a_v; dst = (bf16_t*)(p.ws + WS_VSA); }
        else if ((j -= NA) < NC) { src = p.cache_c_k; dst = (bf16_t*)(p.ws + WS_KSC); } else { j -= NC; src = p.cache_c_v; dst = (bf16_t*)(p.ws + WS_VSC); }
        const long e = j * 4, bh = e / (256 * 128), rem = e % (256 * 128);
        const f32x4 v = *(const f32x4*)(src + e);
        u32x2 o; o.x = pk2(v[0], v[1]); o.y = pk2(v[2], v[3]);
        *(u32x2*)(dst + bh * (LKS * 128) + rem) = o;
    }
    float* ropeA = (float*)(p.ws + WS_ROPE); float* ropeC = ropeA + 2 * 1024 * 64;
    for (long i = gt; i < 1024L * 64 + 1024L * 128; i += ngt) {
        const bool isA = i < 1024L * 64; const long j = isA ? i : i - 1024L * 64; const int dim = isA ? 64 : 128, quarter = dim / 4;
        const int t = (int)(j / dim), d = (int)(j % dim); const int qd = d / quarter, fi = d % quarter;
        const float freq = powf(10000.0f, -(float)fi / (float)quarter);
        const float pos = (qd < 2) ? (float)(t / 64) : (float)(t % 64);
        const float ang = pos * freq;
        float* base = isA ? ropeA : ropeC;
        base[j] = cosf(ang); base[(size_t)1024 * dim + j] = sinf(ang);
    }
}

__device__ __forceinline__ void modulate_rows(const Params& p, int layer, int gw, int ngw, int lane) {
    const float* mod = (const float*)(p.ws + WS_MOD) + (size_t)layer * 3 * 6144;
    const float* nw = p.norm_w + layer * DM;
    bf16_t* H = (bf16_t*)(p.ws + WS_HY);
    for (int m = gw; m < MT; m += ngw) {
        const float* xr = layer == 0 ? xrow_ptr(p, m) : p.out + (size_t)m * DM;
        const float* mr = mod + (size_t)cond_row(m) * 6144;
        f32x4 v[8]; float ss = 0.f;
#pragma unroll
        for (int j = 0; j < 8; ++j) { v[j] = *(const f32x4*)(xr + 4 * lane + 256 * j); ss += (v[j][0] * v[j][0] + v[j][1] * v[j][1]) + (v[j][2] * v[j][2] + v[j][3] * v[j][3]); }
        const float rstd = 1.0f / sqrtf(wave_sum(ss) * (1.f / DM) + EPS);
#pragma unroll
        for (int j = 0; j < 8; ++j) { const int k = 4 * lane + 256 * j;
            const f32x4 w = *(const f32x4*)(nw + k), sh = *(const f32x4*)(mr + k), sc = *(const f32x4*)(mr + 2048 + k);
            const f32x4 h = v[j] * rstd * w * (sc + 1.0f) + sh;
            u32x2 o; o.x = pk2(h[0], h[1]); o.y = pk2(h[2], h[3]);
            *(u32x2*)(H + (size_t)m * DM + k) = o; }
    }
}

__device__ __forceinline__ void mod1_tables(const Params& p, int gw, int ngw, int lane) {
    const float* mod1 = (const float*)(p.ws + WS_MOD) + 3 * 6144;
    float* cw1 = (float*)(p.ws + WS_CW1); float* b2p = (float*)(p.ws + WS_B2P);
    for (int i = gw * 64 + lane; i < 3 * DM; i += ngw * 64) { const int cr = i / DM, k = i % DM; cw1[i] = p.norm_w[DM + k] * (1.f + mod1[cr * 6144 + 2048 + k]); }
    const bf16_t* W = (const bf16_t*)(p.ws + WS_WINO);
    for (int r = gw; r < ODD_IN; r += ngw) {
        float a0 = 0.f, a1 = 0.f, a2 = 0.f;
#pragma unroll
        for (int j = 0; j < 4; ++j) { const int k = 8 * lane + 512 * j; const u32x4 w = *(const u32x4*)(W + (size_t)r * DM + k);
            const float wf[8] = {bflo(w.x), bfhi(w.x), bflo(w.y), bfhi(w.y), bflo(w.z), bfhi(w.z), bflo(w.w), bfhi(w.w)};
#pragma unroll
            for (int e = 0; e < 8; ++e) { a0 += wf[e] * mod1[k + e]; a1 += wf[e] * mod1[6144 + k + e]; a2 += wf[e] * mod1[2 * 6144 + k + e]; } }
        a0 = wave_sum(a0); a1 = wave_sum(a1); a2 = wave_sum(a2);
        if (lane == 0) { b2p[r] = a0; b2p[ODD_IN + r] = a1; b2p[2 * ODD_IN + r] = a2; }
    }
}
template <int DIM>
__device__ __forceinline__ f32x4 norm_rope4(f32x4 v, int lg  , const float* w, bool rope, const float* cosr, const float* sinr) {
    float ss = (v[0] * v[0] + v[1] * v[1]) + (v[2] * v[2] + v[3] * v[3]);
#pragma unroll
    for (int o = 1; o < DIM / 4; o <<= 1) ss += __shfl_xor(ss, o);
    const float r = 1.0f / sqrtf(ss * (1.f / DIM) + EPS);
    const f32x4 wv = *(const f32x4*)(w + 4 * lg);
    f32x4 y = v * r * wv;
    f32x4 pr;
#pragma unroll
    for (int e = 0; e < 4; ++e) pr[e] = __shfl_xor(y[e], DIM / 16);
    if (rope) {
        const f32x4 cs = *(const f32x4*)(cosr + 4 * lg), sn = *(const f32x4*)(sinr + 4 * lg);
        const bool odd = ((lg / (DIM / 16)) & 1) != 0;
        y = odd ? (y * cs + pr * sn) : (y * cs - pr * sn);
    }
    return y;
}

__device__ __forceinline__ void post0_rows(const Params& p, int gw, int ngw, int lane) {
    const bf16_t* PR = (const bf16_t*)(p.ws + WS_PR);
    bf16_t* QA = (bf16_t*)(p.ws + WS_Q); bf16_t* UA = (bf16_t*)(p.ws + WS_UA);
    const float* ropeA = (const float*)(p.ws + WS_ROPE);
    float* new_a_k = p.out + (size_t)MT * DM; float* new_a_v = new_a_k + (size_t)NBP * HA * SEQP * 128;
    for (int m = gw; m < MT; m += ngw) {
        const bool smp = m >= MP; const int b = smp ? (m - MP) >> 10 : m >> 8, t = smp ? (m - MP) & 1023 : m & 255;
        const bf16_t* pr = PR + (size_t)m * EVEN_IN;
        const float* cosr = ropeA + (size_t)t * 64; const float* sinr = ropeA + 1024 * 64 + (size_t)t * 64;
        const int sub = lane >> 4, lg = lane & 15;
#pragma unroll 2
        for (int st = 0; st < 8; ++st) {
            const int grp = st * 4 + sub;
            const u32x2 raw = *(const u32x2*)(pr + grp * 64 + 4 * lg);
            f32x4 v = {bflo(raw.x), bfhi(raw.x), bflo(raw.y), bfhi(raw.y)};
            const bool isk = grp >= 16;
            f32x4 y = norm_rope4<64>(v, lg, isk ? p.even_k_norm_w : p.even_q_norm_w, smp, cosr, sinr);
            if (!isk) { y = y * C2A; u32x2 o; o.x = pk2(y[0], y[1]); o.y = pk2(y[2], y[3]); *(u32x2*)(QA + (size_t)m * 1024 + grp * 64 + 4 * lg) = o; }
            else { const int g2 = grp - 16, h = g2 >> 1, j = g2 & 1;
                u32x2 o; o.x = pk2(y[0], y[1]); o.y = pk2(y[2], y[3]);
                if (smp) *(u32x2*)((bf16_t*)(p.ws + WS_KSA) + ((size_t)(b * HA + h) * LKS + PAST + t) * 128 + j * 64 + 4 * lg) = o;
                else { const size_t off = ((size_t)(b * HA + h) * SEQP + t) * 128 + j * 64 + 4 * lg; *(u32x2*)((bf16_t*)(p.ws + WS_KP) + off) = o; *(f32x4*)(new_a_k + off) = y; } }
        }
#pragma unroll
        for (int i = 0; i < 2; ++i) { const int c = 8 * lane + 512 * i, h = c >> 7, d = c & 127;
            const u32x4 raw = *(const u32x4*)(pr + 2048 + c);
            if (smp) *(u32x4*)((bf16_t*)(p.ws + WS_VSA) + ((size_t)(b * HA + h) * LKS + PAST + t) * 128 + d) = raw;
            else { const size_t off = ((size_t)(b * HA + h) * SEQP + t) * 128 + d; *(u32x4*)((bf16_t*)(p.ws + WS_VP) + off) = raw;
                *(f32x4*)(new_a_v + off) = (f32x4){bflo(raw.x), bfhi(raw.x), bflo(raw.y), bfhi(raw.y)}; *(f32x4*)(new_a_v + off + 4) = (f32x4){bflo(raw.z), bfhi(raw.z), bflo(raw.w), bfhi(raw.w)}; } }
        const int L = smp ? SEQS : SEQP;
#pragma unroll
        for (int i = 0; i < 2; ++i) { const int ch = lane + 64 * i, c = 8 * ch, g = ch >> 5, half = 1 << g;
            const int lo = max(t - half, 0), hi = min(t + half, L);
            float s[8] = {0.f, 0.f, 0.f, 0.f, 0.f, 0.f, 0.f, 0.f};
            for (int tt = lo; tt < hi; ++tt) { const u32x4 raw = *(const u32x4*)(pr + (ptrdiff_t)(tt - t) * EVEN_IN + 3072 + c);
                s[0] += bflo(raw.x); s[1] += bfhi(raw.x); s[2] += bflo(raw.y); s[3] += bfhi(raw.y); s[4] += bflo(raw.z); s[5] += bfhi(raw.z); s[6] += bflo(raw.w); s[7] += bfhi(raw.w); }
            const float inv = 1.0f / (float)(hi - lo);
            const u32x4 own = *(const u32x4*)(pr + 3072 + c);
            u32x4 o; o.x = pk2(s[0] * inv - bflo(own.x), s[1] * inv - bfhi(own.x)); o.y = pk2(s[2] * inv - bflo(own.y), s[3] * inv - bfhi(own.y));
            o.z = pk2(s[4] * inv - bflo(own.z), s[5] * inv - bfhi(own.z)); o.w = pk2(s[6] * inv - bflo(own.w), s[7] * inv - bfhi(own.w));
            *(u32x4*)(UA + (size_t)m * 1024 + c) = o; }
    }
}

__device__ __forceinline__ void pool_rows(const Params& p, int gw, int ngw, int lane) {
    const bf16_t* U = (const bf16_t*)(p.ws + WS_U); bf16_t* UA = (bf16_t*)(p.ws + WS_UA);
    for (int m = gw; m < MT; m += ngw) {
        const bool smp = m >= MP; const int t = smp ? (m - MP) & 1023 : m & 255, L = smp ? SEQS : SEQP;
        const bf16_t* pr = U + (size_t)m * 1024;
#pragma unroll
        for (int i = 0; i < 2; ++i) { const int ch = lane + 64 * i, c = 8 * ch, g = ch >> 5, half = 1 << g;
            const int lo = max(t - half, 0), hi = min(t + half, L);
            float s[8] = {0.f, 0.f, 0.f, 0.f, 0.f, 0.f, 0.f, 0.f};
            for (int tt = lo; tt < hi; ++tt) { const u32x4 raw = *(const u32x4*)(pr + (ptrdiff_t)(tt - t) * 1024 + c);
                s[0] += bflo(raw.x); s[1] += bfhi(raw.x); s[2] += bflo(raw.y); s[3] += bfhi(raw.y); s[4] += bflo(raw.z); s[5] += bfhi(raw.z); s[6] += bflo(raw.w); s[7] += bfhi(raw.w); }
            const float inv = 1.0f / (float)(hi - lo);
            const u32x4 own = *(const u32x4*)(pr + c);
            u32x4 o; o.x = pk2(s[0] * inv - bflo(own.x), s[1] * inv - bfhi(own.x)); o.y = pk2(s[2] * inv - bflo(own.y), s[3] * inv - bfhi(own.y));
            o.z = pk2(s[4] * inv - bflo(own.z), s[5] * inv - bfhi(own.z)); o.w = pk2(s[6] * inv - bflo(own.w), s[7] * inv - bfhi(own.w));
            *(u32x4*)(UA + (size_t)m * 1024 + c) = o; }
    }
}
__device__ __forceinline__ void post1_rows(const Params& p, int gw, int ngw, int lane) {
    const bf16_t* PR = (const bf16_t*)(p.ws + WS_PR);
    bf16_t* QC = (bf16_t*)(p.ws + WS_Q);
    const float* ropeC = (const float*)(p.ws + WS_ROPE) + 2 * 1024 * 64;
    float* new_c_k = p.out + (size_t)MT * DM + 2 * (size_t)NBP * HA * SEQP * 128; float* new_c_v = new_c_k + (size_t)NBP * KVH * SEQP * 128;
    for (int m = gw; m < MT; m += ngw) {
        const bool smp = m >= MP; const int b = smp ? (m - MP) >> 10 : m >> 8, t = smp ? (m - MP) & 1023 : m & 255;
        const bf16_t* pr = PR + (size_t)m * ODD_IN;
        const float* cosr = ropeC + (size_t)t * 128; const float* sinr = ropeC + 1024 * 128 + (size_t)t * 128;
        const int sub = lane >> 5, lg = lane & 31;
#pragma unroll 2
        for (int st = 0; st < 10; ++st) {
            const int grp = st * 2 + sub;
            const u32x2 raw = *(const u32x2*)(pr + grp * 128 + 4 * lg);
            f32x4 v = {bflo(raw.x), bfhi(raw.x), bflo(raw.y), bfhi(raw.y)};
            const bool isk = grp >= 16;
            f32x4 y = norm_rope4<128>(v, lg, isk ? p.gqa_k_norm_w : p.gqa_q_norm_w, smp, cosr, sinr);
            if (!isk) { y = y * C2C; u32x2 o; o.x = pk2(y[0], y[1]); o.y = pk2(y[2], y[3]); *(u32x2*)(QC + (size_t)m * DM + grp * 128 + 4 * lg) = o; }
            else { const int kh = grp - 16;
                u32x2 o; o.x = pk2(y[0], y[1]); o.y = pk2(y[2], y[3]);
                if (smp) *(u32x2*)((bf16_t*)(p.ws + WS_KSC) + ((size_t)(b * KVH + kh) * LKS + PAST + t) * 128 + 4 * lg) = o;
                else { const size_t off = ((size_t)(b * KVH + kh) * SEQP + t) * 128 + 4 * lg; *(u32x2*)((bf16_t*)(p.ws + WS_KP) + off) = o; *(f32x4*)(new_c_k + off) = y; } }
        }
        { const int c = 8 * lane, kh = c >> 7, d = c & 127;
            const u32x4 raw = *(const u32x4*)(pr + 2560 + c);
            if (smp) *(u32x4*)((bf16_t*)(p.ws + WS_VSC) + ((size_t)(b * KVH + kh) * LKS + PAST + t) * 128 + d) = raw;
            else { const size_t off = ((size_t)(b * KVH + kh) * SEQP + t) * 128 + d; *(u32x4*)((bf16_t*)(p.ws + WS_VP) + off) = raw;
                *(f32x4*)(new_c_v + off) = (f32x4){bflo(raw.x), bfhi(raw.x), bflo(raw.y), bfhi(raw.y)}; *(f32x4*)(new_c_v + off + 4) = (f32x4){bflo(raw.z), bfhi(raw.z), bflo(raw.w), bfhi(raw.w)}; } }
    }
}

struct EpiStoreBf16 { bf16_t* C; int ldc; int pad; __device__ void operator()(int r, int c, float v) const { C[(size_t)r * ldc + c] = (bf16_t)f2bf(v); } };
struct EpiPool { bf16_t* Y; const bf16_t* PR; const float* pscale; int g; int pad;
    __device__ void operator()(int r, int c, float v) const { const int cc = g * 256 + c; const float gt = bf2f(PR[(size_t)r * EVEN_IN + 4096 + 1024 + cc]);
        Y[(size_t)r * DM + 1024 + cc] = (bf16_t)f2bf(v * pscale[cc] * siluf(gt)); } };
struct EpiResid { const float* x_prompt; const float* x_sample; const float* base; const float* gate; float* out;
    __device__ void operator()(int r, int c, float v) const { const float bs = base ? base[(size_t)r * DM + c] : (r < MP ? x_prompt[(size_t)r * DM + c] : x_sample[(size_t)(r - MP) * DM + c]);
        out[(size_t)r * DM + c] = bs + gate[(size_t)cond_row(r) * 6144 + c] * v; } };
template <class Epi>
__global__ __launch_bounds__(256) void gemm_naive(const bf16_t* A, int lda, const bf16_t* Bt, int ldb, int M, int N, int K, Epi E) {
    __shared__ float As[16][65], Bs[16][65];
    const int tid = threadIdx.x, tx = tid & 15, ty = tid >> 4;
    const int nbn = N / 64, bm = blockIdx.x / nbn, bn = blockIdx.x % nbn;
    float acc[4][4] = {};
    const int lr = tid >> 2, lc = (tid & 3) * 4;
    for (int k0 = 0; k0 < K; k0 += 16) {
        const u32x2 ra = *(const u32x2*)(A + (size_t)(bm * 64 + lr) * lda + k0 + lc), rb = *(const u32x2*)(Bt + (size_t)(bn * 64 + lr) * ldb + k0 + lc);
        __syncthreads();
        As[lc + 0][lr] = bflo(ra.x); As[lc + 1][lr] = bfhi(ra.x); As[lc + 2][lr] = bflo(ra.y); As[lc + 3][lr] = bfhi(ra.y);
        Bs[lc + 0][lr] = bflo(rb.x); Bs[lc + 1][lr] = bfhi(rb.x); Bs[lc + 2][lr] = bflo(rb.y); Bs[lc + 3][lr] = bfhi(rb.y);
        __syncthreads();
#pragma unroll
        for (int kk = 0; kk < 16; ++kk) { float a[4], b[4];
#pragma unroll
            for (int i = 0; i < 4; ++i) { a[i] = As[kk][ty * 4 + i]; b[i] = Bs[kk][tx * 4 + i]; }
#pragma unroll
            for (int i = 0; i < 4; ++i)
#pragma unroll
                for (int j = 0; j < 4; ++j) acc[i][j] += a[i] * b[j]; }
    }
#pragma unroll
    for (int i = 0; i < 4; ++i)
#pragma unroll
        for (int j = 0; j < 4; ++j) E(bm * 64 + ty * 4 + i, bn * 64 + tx * 4 + j, acc[i][j]);
}

__device__ __forceinline__ void diffattn_tasks(const Params& p, float* s1  , long gw, long ngw, int lane) {
    float* s2 = s1 + LKS; float* qs = s2 + LKS;
    const bf16_t* QA = (const bf16_t*)(p.ws + WS_Q); const bf16_t* PR = (const bf16_t*)(p.ws + WS_PR); bf16_t* Y = (bf16_t*)(p.ws + WS_HY);
    const float lam_init = 0.2f;
    const float lam = expf(wave_sum(p.lam_q1[lane] * p.lam_k1[lane])) - expf(wave_sum(p.lam_q2[lane] * p.lam_k2[lane])) + lam_init;
    for (long task = gw; task < (long)MT * HA; task += ngw) {
        const int m = (int)(task / HA), h = (int)(task % HA);
        const bool smp = m >= MP; const int b = smp ? (m - MP) >> 10 : m >> 8; const int Lk = smp ? LKS : SEQP;
        const bf16_t* Kb = smp ? (const bf16_t*)(p.ws + WS_KSA) + (size_t)(b * HA + h) * LKS * 128 : (const bf16_t*)(p.ws + WS_KP) + (size_t)(b * HA + h) * SEQP * 128;
        const bf16_t* Vb = smp ? (const bf16_t*)(p.ws + WS_VSA) + (size_t)(b * HA + h) * LKS * 128 : (const bf16_t*)(p.ws + WS_VP) + (size_t)(b * HA + h) * SEQP * 128;
        { const unsigned w = *(const unsigned*)(QA + (size_t)m * 1024 + h * 128 + 2 * lane); qs[2 * lane] = bflo(w); qs[2 * lane + 1] = bfhi(w); }
        __builtin_amdgcn_s_waitcnt(0xc07f); asm volatile("" ::: "memory");
        float m1 = -1e30f, m2 = -1e30f;
        for (int j = lane; j < Lk; j += 64) { const bf16_t* kr = Kb + (size_t)j * 128; float a1 = 0.f, a2 = 0.f;
#pragma unroll
            for (int d8 = 0; d8 < 8; ++d8) { const u32x4 w1 = *(const u32x4*)(kr + d8 * 8), w2 = *(const u32x4*)(kr + 64 + d8 * 8); const float* q1 = qs + d8 * 8; const float* q2 = qs + 64 + d8 * 8;
                a1 += q1[0] * bflo(w1.x) + q1[1] * bfhi(w1.x) + q1[2] * bflo(w1.y) + q1[3] * bfhi(w1.y) + q1[4] * bflo(w1.z) + q1[5] * bfhi(w1.z) + q1[6] * bflo(w1.w) + q1[7] * bfhi(w1.w);
                a2 += q2[0] * bflo(w2.x) + q2[1] * bfhi(w2.x) + q2[2] * bflo(w2.y) + q2[3] * bfhi(w2.y) + q2[4] * bflo(w2.z) + q2[5] * bfhi(w2.z) + q2[6] * bflo(w2.w) + q2[7] * bfhi(w2.w); }
            s1[j] = a1; s2[j] = a2; m1 = fmaxf(m1, a1); m2 = fmaxf(m2, a2); }
        m1 = wave_max(m1); m2 = wave_max(m2);
        float l1 = 0.f, l2 = 0.f;
        for (int j = lane; j < Lk; j += 64) { const float e1 = exp2f(s1[j] - m1), e2 = exp2f(s2[j] - m2); s1[j] = e1; s2[j] = e2; l1 += e1; l2 += e2; }
        l1 = wave_sum(l1); l2 = wave_sum(l2);
        const float i1 = 1.f / l1, i2 = lam / l2;
        for (int j = lane; j < Lk; j += 64) s1[j] = s1[j] * i1 - s2[j] * i2;
        __builtin_amdgcn_s_waitcnt(0xc07f); asm volatile("" ::: "memory");
        float o0 = 0.f, o1 = 0.f;
        for (int j = 0; j < Lk; ++j) { const unsigned w = *(const unsigned*)(Vb + (size_t)j * 128 + 2 * lane); const float pj = s1[j]; o0 += pj * bflo(w); o1 += pj * bfhi(w); }
        const float r = 1.0f / sqrtf(wave_sum(o0 * o0 + o1 * o1) * (1.f / 128.f) + EPS);
        const unsigned gw = *(const unsigned*)(PR + (size_t)m * EVEN_IN + 4096 + h * 128 + 2 * lane);
        const float y0 = o0 * r * p.subln_w[2 * lane] * (1.f - lam_init) * siluf(bflo(gw)), y1 = o1 * r * p.subln_w[2 * lane + 1] * (1.f - lam_init) * siluf(bfhi(gw));
        *(unsigned*)(Y + (size_t)m * DM + h * 128 + 2 * lane) = pk2(y0, y1);
        __builtin_amdgcn_s_waitcnt(0xc07f); asm volatile("" ::: "memory");
    }
}
__device__ __forceinline__ void gqa_tasks(const Params& p, float* s1  , long gw, long ngw, int lane) {
    float* qs = s1 + LKS;
    const bf16_t* QC = (const bf16_t*)(p.ws + WS_Q); const bf16_t* PR = (const bf16_t*)(p.ws + WS_PR); bf16_t* Y = (bf16_t*)(p.ws + WS_HY);
    for (long task = gw; task < (long)MT * HC; task += ngw) {
        const int m = (int)(task / HC), hq = (int)(task % HC), kh = hq >> 2;
        const bool smp = m >= MP; const int b = smp ? (m - MP) >> 10 : m >> 8; const int Lk = smp ? LKS : SEQP;
        const bf16_t* Kb = smp ? (const bf16_t*)(p.ws + WS_KSC) + (size_t)(b * KVH + kh) * LKS * 128 : (const bf16_t*)(p.ws + WS_KP) + (size_t)(b * KVH + kh) * SEQP * 128;
        const bf16_t* Vb = smp ? (const bf16_t*)(p.ws + WS_VSC) + (size_t)(b * KVH + kh) * LKS * 128 : (const bf16_t*)(p.ws + WS_VP) + (size_t)(b * KVH + kh) * SEQP * 128;
        { const unsigned w = *(const unsigned*)(QC + (size_t)m * DM + hq * 128 + 2 * lane); qs[2 * lane] = bflo(w); qs[2 * lane + 1] = bfhi(w); }
        __builtin_amdgcn_s_waitcnt(0xc07f); asm volatile("" ::: "memory");
        float m1 = -1e30f;
        for (int j = lane; j < Lk; j += 64) { const bf16_t* kr = Kb + (size_t)j * 128; float a1 = 0.f;
#pragma unroll
            for (int d8 = 0; d8 < 16; ++d8) { const u32x4 w1 = *(const u32x4*)(kr + d8 * 8); const float* q1 = qs + d8 * 8;
                a1 += q1[0] * bflo(w1.x) + q1[1] * bfhi(w1.x) + q1[2] * bflo(w1.y) + q1[3] * bfhi(w1.y) + q1[4] * bflo(w1.z) + q1[5] * bfhi(w1.z) + q1[6] * bflo(w1.w) + q1[7] * bfhi(w1.w); }
            s1[j] = a1; m1 = fmaxf(m1, a1); }
        m1 = wave_max(m1);
        float l1 = 0.f;
        for (int j = lane; j < Lk; j += 64) { const float e1 = exp2f(s1[j] - m1); s1[j] = e1; l1 += e1; }
        l1 = wave_sum(l1);
        __builtin_amdgcn_s_waitcnt(0xc07f); asm volatile("" ::: "memory");
        float o0 = 0.f, o1 = 0.f;
        for (int j = 0; j < Lk; ++j) { const unsigned w = *(const unsigned*)(Vb + (size_t)j * 128 + 2 * lane); const float pj = s1[j]; o0 += pj * bflo(w); o1 += pj * bfhi(w); }
        const float il = 1.f / l1;
        const unsigned gw = *(const unsigned*)(PR + (size_t)m * ODD_IN + 3072 + hq * 128 + 2 * lane);
        *(unsigned*)(Y + (size_t)m * DM + hq * 128 + 2 * lane) = pk2(o0 * il * siluf(bflo(gw)), o1 * il * siluf(bfhi(gw)));
        __builtin_amdgcn_s_waitcnt(0xc07f); asm volatile("" ::: "memory");
    }
}

__global__ __launch_bounds__(256) void diffattn_naive(Params p) { __shared__ float sh[4][2 * LKS + 128]; diffattn_tasks(p, sh[threadIdx.x >> 6], (long)blockIdx.x * 4 + (threadIdx.x >> 6), (long)gridDim.x * 4, threadIdx.x & 63); }
__global__ __launch_bounds__(256) void gqa_naive(Params p) { __shared__ float sh[4][LKS + 128]; gqa_tasks(p, sh[threadIdx.x >> 6], (long)blockIdx.x * 4 + (threadIdx.x >> 6), (long)gridDim.x * 4, threadIdx.x & 63); }
__global__ __launch_bounds__(512) void k_prologue(Params p) {
    __shared__ float scr[8 * 2304];
    const int wid = threadIdx.x >> 6, lane = threadIdx.x & 63;
    mod_items(p, scr, blockIdx.x, gridDim.x, threadIdx.x, blockDim.x);
    __syncthreads();
    weights_items(p, scr + wid * 2304, blockIdx.x * 8 + wid, gridDim.x * 8, lane);
    caches_rope_items(p, (long)blockIdx.x * 512 + threadIdx.x, (long)gridDim.x * 512);
}
__global__ __launch_bounds__(512) void k_modulate(Params p, int layer) { modulate_rows(p, layer, blockIdx.x * 8 + (threadIdx.x >> 6), gridDim.x * 8, threadIdx.x & 63); }
__global__ __launch_bounds__(512) void k_post0(Params p) { post0_rows(p, blockIdx.x * 8 + (threadIdx.x >> 6), gridDim.x * 8, threadIdx.x & 63); }
__global__ __launch_bounds__(512) void k_post1(Params p) { post1_rows(p, blockIdx.x * 8 + (threadIdx.x >> 6), gridDim.x * 8, threadIdx.x & 63); }


namespace pg8 {
#define PG8_LAS __attribute__((address_space(3)))
typedef short bf16x8 __attribute__((ext_vector_type(8)));
constexpr int BM = 256, BK = 64, HALF = 128, HTB = HALF * BK * 2  , STAGE_BYTES = 8 * HTB, NXCD = 8, WGM = 8;
__host__ __device__ __forceinline__ int lds_byte(int r, int c) { const int st = (r >> 4) * 2 + (c >> 5), rr = r & 15, cc = c & 31, ob = rr * 64 + cc * 2; return st * 1024 + (ob ^ (((ob >> 9) & 1) << 5)); }
__host__ __device__ __forceinline__ void stage_rc(int b, int& R, int& C) { const int st = b / 1024, sb = b % 1024, swz = sb ^ (((sb >> 9) & 1) << 5); R = (st >> 1) * 16 + swz / 64; C = (st & 1) * 32 + (swz % 64) / 2; }
__host__ __device__ __forceinline__ int perm32(int rho) { const int n = rho >> 4, i = rho & 15; return 8 * (i >> 2) + 4 * n + (i & 3); }
struct Unit { int pm, pn, kt0, nkt, slab, half, hm; };
struct Gemm { const bf16_t* A; const bf16_t* Bt; int M, N, K, lda, ldb, a_pn_off, b_pm_off, pad; };
struct StaticOrder {
    int nM, nN, nwg, G, c, KT, nfull, split;
    __host__ __device__ void init(int M, int N, int K, int G_, int c_, bool allow_split) { nM = M / BM; nN = N / BM; nwg = nM * nN; G = G_; c = c_; KT = K / BK;
        const int rem = nwg % G; split = (allow_split && rem && G % rem == 0 && (G % 8) == 0 && ((G / 8) % (G / rem)) == 0 && (KT % (2 * (G / rem))) == 0) ? G / rem : 1; nfull = split > 1 ? nwg - rem : nwg; }
    __host__ __device__ void tile(int wgid, Unit& u) const { const int nig = WGM * nN, gid = wgid / nig, fm = gid * WGM, gsz = (nM - fm) < WGM ? (nM - fm) : WGM; u.pm = fm + ((wgid % nig) % gsz); u.pn = (wgid % nig) / gsz; }
    __host__ __device__ bool next(int i, Unit& u) const {
        const long L = (long)i * G + c;
        if (L < nfull) { int wgid = (int)L; { const int q = nfull / NXCD, r = nfull % NXCD, xcd = wgid % NXCD, off = wgid / NXCD; wgid = (xcd < r ? xcd * (q + 1) : r * (q + 1) + (xcd - r) * q) + off; }
            tile(wgid, u); u.kt0 = 0; u.nkt = KT; u.slab = -1; u.half = 0; u.hm = 0; return true; }
        if (split > 1 && L < nfull + G) { const int xcd = c % 8, q = c / 8, ks = q % split, j = (q / split) * 8 + xcd;
            tile(nfull + j, u); u.nkt = KT / split; u.kt0 = ks * u.nkt; u.slab = j * split + ks; u.half = 0; u.hm = 0; return true; }
        return false;
    }
    __device__ __forceinline__ void a_ready(const Unit&) const {}
    __device__ __forceinline__ void done(const Unit&) const {}
};
struct OutOrder {
    int c, part;
    __device__ bool next(int i, Unit& u) const {
        if (i > 0) return false;
        u.kt0 = 0; u.nkt = DM / BK; u.slab = -1; u.half = 0; u.hm = 0;
        if (part == 0) { const int wgid = (c % 8) * 32 + c / 8, idx = wgid % 64; u.pm = (wgid / 64) * 8 + idx % 8; u.pn = idx / 8; return true; }
        if (c >= 64) return false;
        u.pm = 32 + c / 8; u.pn = c % 8; return true;
    }
    __device__ __forceinline__ void a_ready(const Unit&) const {}
    __device__ __forceinline__ void done(const Unit&) const {}
};
struct LastOrder {
    int c;
    __device__ bool next(int i, Unit& u) const {
        u.kt0 = 0; u.nkt = DM / BK; u.slab = -1; u.half = 0; u.hm = 0;
        if (i == 0) { const int wgid = (c % 8) * 32 + c / 8, idx = wgid % 64; u.pm = (wgid / 64) * 8 + idx % 8; u.pn = idx / 8; return true; }
        if (i > 1 || c >= 128) return false;
        const int q = c / 8; u.half = 1; u.hm = q & 1; u.pm = 32 + (q >> 1); u.pn = c % 8; return true;
    }
    __device__ __forceinline__ void a_ready(const Unit&) const {}
    __device__ __forceinline__ void done(const Unit&) const {}
};
struct StaggerOrder {
    int c; const unsigned* cnt; bool wait;
    __device__ bool next(int i, Unit& u) const {
        const int x = c % 8; u.kt0 = 0; u.nkt = DM / BK; u.slab = -1; u.half = 0; u.hm = 0;
        if (c < 64) { if (i >= 2) return false; u.pm = 32 + x; u.pn = 2 * (c / 8) + i; return true; }
        const int e = (c - 64) / 8; int uidx;
        if (i < 3) uidx = i * 24 + e;
        else { if (i > 3) return false; const int h4 = e >> 1; u.half = 1; u.hm = e & 1;
            if (h4 >= 8) { u.pm = 32 + x; u.pn = 16 + (h4 - 8); return true; } uidx = 72 + h4; }
        u.pm = 4 * x + (uidx % 4); u.pn = uidx / 4; return true;
    }
    __device__ __forceinline__ void a_ready(const Unit& u) const {
        if (u.pm < 32 || !wait) return;
        if (threadIdx.x < 64) {
            const unsigned* w = cnt + 64 * (u.pm - 32); unsigned sp = 0;
            while ((unsigned)__builtin_amdgcn_readfirstlane(__hip_atomic_load(w, __ATOMIC_RELAXED, __HIP_MEMORY_SCOPE_AGENT)) < 8u) { __builtin_amdgcn_s_sleep(2); if (++sp > (1u << 22)) break; }
            __builtin_amdgcn_fence(__ATOMIC_ACQUIRE, "agent");
            asm volatile("s_waitcnt vmcnt(0)" ::: "memory");
        }
        asm volatile("" ::: "memory"); __builtin_amdgcn_s_barrier(); asm volatile("" ::: "memory");
    }
    __device__ __forceinline__ void done(const Unit&) const {}
};
__device__ __forceinline__ unsigned cvt_pk_bf16(float lo, float hi) { unsigned r; asm volatile("v_cvt_pk_bf16_f32 %0, %1, %2" : "=v"(r) : "v"(lo), "v"(hi)); return r; }
__device__ __forceinline__ void slab_store(const f32x4 (&acc)[2][2][4][2], float* slabs, const Unit& u, int wr, int wc, int fr, int fq) {
    float* sp = slabs + (size_t)u.slab * 65536 + (size_t)(wr * 64 + fr) * 256 + wc * 32 + 8 * fq;
#pragma unroll
    for (int ai = 0; ai < 2; ++ai)
#pragma unroll
        for (int m = 0; m < 4; ++m)
#pragma unroll
            for (int bj = 0; bj < 2; ++bj) { float* q = sp + (size_t)(ai * HALF + m * 16) * 256 + bj * HALF; *(f32x4*)q = acc[ai][bj][m][0]; *(f32x4*)(q + 4) = acc[ai][bj][m][1]; }
}
struct EpiBf16 {
    static constexpr bool PERM = true, AFTER_DRAIN = false;
    bf16_t* O; int ldc; int pad;
    __device__ __forceinline__ void operator()(const f32x4 (&acc)[2][2][4][2], const Unit& u, int wr, int wc, int fr, int fq) const {
        asm volatile("" : "+v"(fr), "+v"(fq));
        const int row0 = u.pm * BM + wr * 64 + fr, col0 = u.pn * BM + wc * 32 + 8 * fq;
#pragma unroll
        for (int ai = 0; ai < 2; ++ai)
#pragma unroll
            for (int m = 0; m < 4; ++m) { bf16_t* rowp = O + (size_t)(row0 + ai * HALF + m * 16) * ldc + col0;
#pragma unroll
                for (int bj = 0; bj < 2; ++bj) { const f32x4 v0 = acc[ai][bj][m][0], v1 = acc[ai][bj][m][1];
                    u32x4 w; w.x = cvt_pk_bf16(v0[0], v0[1]); w.y = cvt_pk_bf16(v0[2], v0[3]); w.z = cvt_pk_bf16(v1[0], v1[1]); w.w = cvt_pk_bf16(v1[2], v1[3]);
                    *(u32x4*)(rowp + bj * HALF) = w; } }
    }
};
struct EpiPoolF {
    static constexpr bool PERM = true, AFTER_DRAIN = false;
    bf16_t* Y; const bf16_t* SG; const float* pscale;
    __device__ __forceinline__ void operator()(const f32x4 (&acc)[2][2][4][2], const Unit& u, int wr, int wc, int fr, int fq) const {
        asm volatile("" : "+v"(fr), "+v"(fq));
        const int row0 = u.pm * BM + wr * 64 + fr, col0 = u.pn * BM + wc * 32 + 8 * fq;
        f32x4 ps[2][2];
#pragma unroll
        for (int bj = 0; bj < 2; ++bj) { ps[bj][0] = *(const f32x4*)(pscale + col0 + bj * HALF); ps[bj][1] = *(const f32x4*)(pscale + col0 + bj * HALF + 4); }
#pragma unroll
        for (int ai = 0; ai < 2; ++ai)
#pragma unroll
            for (int m = 0; m < 4; ++m) { const size_t r = (size_t)(row0 + ai * HALF + m * 16);
#pragma unroll
                for (int bj = 0; bj < 2; ++bj) { const int c = col0 + bj * HALF;
                    const u32x4 g = *(const u32x4*)(SG + r * DM + 1024 + c);
                    const f32x4 v0 = acc[ai][bj][m][0] * ps[bj][0], v1 = acc[ai][bj][m][1] * ps[bj][1];
                    u32x4 w; w.x = cvt_pk_bf16(v0[0] * bflo(g.x), v0[1] * bfhi(g.x)); w.y = cvt_pk_bf16(v0[2] * bflo(g.y), v0[3] * bfhi(g.y));
                    w.z = cvt_pk_bf16(v1[0] * bflo(g.z), v1[1] * bfhi(g.z)); w.w = cvt_pk_bf16(v1[2] * bflo(g.w), v1[3] * bfhi(g.w));
                    *(u32x4*)(Y + r * DM + 1024 + c) = w; } }
    }
};
struct EpiProj0 {
    static constexpr bool PERM = true, AFTER_DRAIN = false;
    unsigned char* ws; const float* qw; const float* kw; float* nak; float* nav;
    __device__ __forceinline__ void operator()(const f32x4 (&acc)[2][2][4][2], const Unit& u, int wr, int wc, int fr, int fq) const {
        asm volatile("" : "+v"(fr), "+v"(fq));
        const int pm = u.pm, pn = u.pn;
        const bool smp = pm >= 32; const int b = smp ? (pm - 32) >> 2 : pm, tb = (smp ? ((pm - 32) & 3) * 256 : 0) + wr * 64 + fr;
        const size_t rowb = (size_t)pm * 256 + wr * 64 + fr;
        if (pn < 8) {
            const bool isk = pn >= 4; const int hl = wc >> 1, j = wc & 1, h = (pn & 3) * 2 + hl, dim_a = 8 * fq + 16 * (fq >> 1);
            const float* w = isk ? kw : qw;
            f32x4 wv[2][2];
#pragma unroll
            for (int bj = 0; bj < 2; ++bj)
#pragma unroll
                for (int n = 0; n < 2; ++n) wv[bj][n] = *(const f32x4*)(w + dim_a + 16 * bj + 4 * n);
            const float* ropeA = (const float*)(ws + WS_ROPE);
#pragma unroll
            for (int ai = 0; ai < 2; ++ai)
#pragma unroll
                for (int m = 0; m < 4; ++m) { const int t = tb + ai * 128 + m * 16; const size_t row = rowb + ai * 128 + m * 16;
                    float ss = 0.f;
#pragma unroll
                    for (int bj = 0; bj < 2; ++bj)
#pragma unroll
                        for (int n = 0; n < 2; ++n) { const f32x4 x = acc[ai][bj][m][n]; ss += (x[0] * x[0] + x[1] * x[1]) + (x[2] * x[2] + x[3] * x[3]); }
                    ss += __shfl_xor(ss, 16); ss += __shfl_xor(ss, 32);
                    const float rinv = 1.0f / sqrtf(ss * (1.f / 64.f) + EPS);
                    f32x4 y[2][2];
#pragma unroll
                    for (int bj = 0; bj < 2; ++bj)
#pragma unroll
                        for (int n = 0; n < 2; ++n) y[bj][n] = acc[ai][bj][m][n] * rinv * wv[bj][n];
                    if (smp) {
#pragma unroll
                        for (int n = 0; n < 2; ++n) { const f32x4 cs = *(const f32x4*)(ropeA + (size_t)t * 64 + dim_a + 4 * n), sn = *(const f32x4*)(ropeA + 1024 * 64 + (size_t)t * 64 + dim_a + 4 * n);
                            const f32x4 a = y[0][n], bb = y[1][n]; y[0][n] = a * cs - bb * sn; y[1][n] = bb * cs + a * sn; } }
                    if (!isk) { bf16_t* qp = (bf16_t*)(ws + WS_Q) + row * 1024 + pn * 256 + wc * 64 + dim_a;
#pragma unroll
                        for (int bj = 0; bj < 2; ++bj) { const f32x4 v0 = y[bj][0] * C2A, v1 = y[bj][1] * C2A;
                            u32x4 o; o.x = cvt_pk_bf16(v0[0], v0[1]); o.y = cvt_pk_bf16(v0[2], v0[3]); o.z = cvt_pk_bf16(v1[0], v1[1]); o.w = cvt_pk_bf16(v1[2], v1[3]);
                            *(u32x4*)(qp + 16 * bj) = o; } }
                    else { const int hh = (pn - 4) * 2 + hl;
                        const size_t koff = (smp ? ((size_t)(b * HA + hh) * LKS + PAST + t) * 128 : ((size_t)(b * HA + hh) * SEQP + t) * 128) + j * 64 + dim_a;
                        bf16_t* kp = (bf16_t*)(ws + (smp ? WS_KSA : WS_KP)) + koff;
#pragma unroll
                        for (int bj = 0; bj < 2; ++bj) { const f32x4 v0 = y[bj][0], v1 = y[bj][1];
                            u32x4 o; o.x = cvt_pk_bf16(v0[0], v0[1]); o.y = cvt_pk_bf16(v0[2], v0[3]); o.z = cvt_pk_bf16(v1[0], v1[1]); o.w = cvt_pk_bf16(v1[2], v1[3]);
                            *(u32x4*)(kp + 16 * bj) = o;
                            if (!smp) { float* fp = nak + koff + 16 * bj; *(f32x4*)fp = v0; *(f32x4*)(fp + 4) = v1; } } }
                }
        } else if (pn < 12) {
#pragma unroll
            for (int ai = 0; ai < 2; ++ai)
#pragma unroll
                for (int m = 0; m < 4; ++m) { const int t = tb + ai * 128 + m * 16;
#pragma unroll
                    for (int bj = 0; bj < 2; ++bj) { const int hh = (pn - 8) * 2 + bj, d = 32 * wc + 8 * fq;
                        const size_t voff = (smp ? ((size_t)(b * HA + hh) * LKS + PAST + t) * 128 : ((size_t)(b * HA + hh) * SEQP + t) * 128) + d;
                        const f32x4 v0 = acc[ai][bj][m][0], v1 = acc[ai][bj][m][1];
                        u32x4 o; o.x = cvt_pk_bf16(v0[0], v0[1]); o.y = cvt_pk_bf16(v0[2], v0[3]); o.z = cvt_pk_bf16(v1[0], v1[1]); o.w = cvt_pk_bf16(v1[2], v1[3]);
                        *(u32x4*)((bf16_t*)(ws + (smp ? WS_VSA : WS_VP)) + voff) = o;
                        if (!smp) { *(f32x4*)(nav + voff) = v0; *(f32x4*)(nav + voff + 4) = v1; } } }
        } else if (pn < 16) {
            bf16_t* up = (bf16_t*)(ws + WS_U) + (pn - 12) * 256 + 32 * wc + 8 * fq;
#pragma unroll
            for (int ai = 0; ai < 2; ++ai)
#pragma unroll
                for (int m = 0; m < 4; ++m) { const size_t row = rowb + ai * 128 + m * 16;
#pragma unroll
                    for (int bj = 0; bj < 2; ++bj) { const f32x4 v0 = acc[ai][bj][m][0], v1 = acc[ai][bj][m][1];
                        u32x4 o; o.x = cvt_pk_bf16(v0[0], v0[1]); o.y = cvt_pk_bf16(v0[2], v0[3]); o.z = cvt_pk_bf16(v1[0], v1[1]); o.w = cvt_pk_bf16(v1[2], v1[3]);
                        *(u32x4*)(up + row * 1024 + bj * HALF) = o; } }
        } else {
            bf16_t* sg = (bf16_t*)(ws + WS_SG) + (pn - 16) * 256 + 32 * wc + 8 * fq;
#pragma unroll
            for (int ai = 0; ai < 2; ++ai)
#pragma unroll
                for (int m = 0; m < 4; ++m) { const size_t row = rowb + ai * 128 + m * 16;
#pragma unroll
                    for (int bj = 0; bj < 2; ++bj) { const f32x4 v0 = acc[ai][bj][m][0], v1 = acc[ai][bj][m][1];
                        u32x4 o; o.x = cvt_pk_bf16(siluf(v0[0]), siluf(v0[1])); o.y = cvt_pk_bf16(siluf(v0[2]), siluf(v0[3])); o.z = cvt_pk_bf16(siluf(v1[0]), siluf(v1[1])); o.w = cvt_pk_bf16(siluf(v1[2]), siluf(v1[3]));
                        *(u32x4*)(sg + row * DM + bj * HALF) = o; } }
        }
    }
};
struct EpiProj1 {
    static constexpr bool PERM = true, AFTER_DRAIN = false;
    unsigned char* ws; const float* qw; const float* kw; float* nck; float* ncv; PG8_LAS float* xs; float* slabs;
    __device__ __forceinline__ void operator()(const f32x4 (&acc0)[2][2][4][2], const Unit& u, int wr, int wc, int fr, int fq) const {
        asm volatile("" : "+v"(fr), "+v"(fq));
        if (u.slab >= 0) { slab_store(acc0, slabs, u, wr, wc, fr, fq); return; }
        const int pm = u.pm, pn = u.pn;
        float rstd[2][4]; f32x4 bv[2][2];
        { const int cr = pm < 32 ? 0 : 1 + ((pm - 32) >> 2);
          const float* b2 = (const float*)(ws + WS_B2P) + (size_t)cr * ODD_IN + pn * 256 + 32 * wc + 8 * fq; const float* rss = (const float*)(ws + WS_RSS) + (size_t)pm * 256 + (u.half ? u.hm * 128 : 0) + wr * 64 + fr;
#pragma unroll
          for (int bj = 0; bj < 2; ++bj)
#pragma unroll
              for (int n = 0; n < 2; ++n) bv[bj][n] = *(const f32x4*)(b2 + bj * HALF + n * 4);
#pragma unroll
          for (int ai = 0; ai < 2; ++ai)
#pragma unroll
              for (int m = 0; m < 4; ++m) rstd[ai][m] = __builtin_amdgcn_rsqf(rss[ai * 128 + m * 16] * (1.f / DM) + EPS); }
#define VV(ai, bj, m, n) (acc0[ai][bj][m][n] * rstd[ai][m] + bv[bj][n])
        const int hoff = u.half ? u.hm * 128 : 0, nai = u.half ? 1 : 2;
        const bool smp = pm >= 32; const int b = smp ? (pm - 32) >> 2 : pm, tb = (smp ? ((pm - 32) & 3) * 256 : 0) + hoff + wr * 64 + fr;
        const size_t rowb = (size_t)pm * 256 + hoff + wr * 64 + fr;
        if (pn < 10) {
            const bool isk = pn >= 8; const int hl = wc >> 1, w1 = wc & 1, head = (isk ? (pn - 8) : pn) * 2 + hl;
            const float* w = isk ? kw : qw;
            f32x4 wv[2][2];
#pragma unroll
            for (int bj = 0; bj < 2; ++bj)
#pragma unroll
                for (int n = 0; n < 2; ++n) wv[bj][n] = *(const f32x4*)(w + (2 * w1 + bj) * 32 + 8 * fq + 4 * n);
            PG8_LAS float* xo = xs + (wr * 4 + wc) * 128; PG8_LAS float* xp = xs + (wr * 4 + (wc ^ 1)) * 128;
#pragma unroll
            for (int ai = 0; ai < 2; ++ai)
#pragma unroll
                for (int m = 0; m < 4; ++m) { if (ai >= nai) continue; float ss = 0.f;
#pragma unroll
                    for (int bj = 0; bj < 2; ++bj)
#pragma unroll
                        for (int n = 0; n < 2; ++n) { const f32x4 x = VV(ai, bj, m, n); ss += (x[0] * x[0] + x[1] * x[1]) + (x[2] * x[2] + x[3] * x[3]); }
                    ss += __shfl_xor(ss, 16); ss += __shfl_xor(ss, 32);
                    if (fq == 0) xo[ai * 64 + m * 16 + fr] = ss; }
            asm volatile("s_waitcnt lgkmcnt(0)" ::: "memory"); __builtin_amdgcn_s_barrier(); asm volatile("" ::: "memory");
            const float* ropeC = (const float*)(ws + WS_ROPE) + 2 * 1024 * 64;
#pragma unroll
            for (int ai = 0; ai < 2; ++ai)
#pragma unroll
                for (int m = 0; m < 4; ++m) { if (ai >= nai) continue; const int idx = ai * 64 + m * 16 + fr, t = tb + ai * 128 + m * 16; const size_t row = rowb + ai * 128 + m * 16;
                    const float rinv = __builtin_amdgcn_rsqf((xo[idx] + xp[idx]) * (1.f / 128.f) + EPS);
                    float r2 = rstd[ai][m]; asm volatile("" : "+v"(r2));
                    f32x4 y[2][2];
#pragma unroll
                    for (int bj = 0; bj < 2; ++bj)
#pragma unroll
                        for (int n = 0; n < 2; ++n) y[bj][n] = (acc0[ai][bj][m][n] * r2 + bv[bj][n]) * rinv * wv[bj][n];
                    if (smp) {
#pragma unroll
                        for (int n = 0; n < 2; ++n) { const f32x4 cs = *(const f32x4*)(ropeC + (size_t)t * 128 + 64 * w1 + 8 * fq + 4 * n), sn = *(const f32x4*)(ropeC + 1024 * 128 + (size_t)t * 128 + 64 * w1 + 8 * fq + 4 * n);
                            const f32x4 a = y[0][n], bb = y[1][n]; y[0][n] = a * cs - bb * sn; y[1][n] = bb * cs + a * sn; } }
                    if (!isk) { bf16_t* qp = (bf16_t*)(ws + WS_Q) + row * DM + head * 128 + 8 * fq;
#pragma unroll
                        for (int bj = 0; bj < 2; ++bj) { const f32x4 v0 = y[bj][0] * C2C, v1 = y[bj][1] * C2C;
                            u32x4 o; o.x = cvt_pk_bf16(v0[0], v0[1]); o.y = cvt_pk_bf16(v0[2], v0[3]); o.z = cvt_pk_bf16(v1[0], v1[1]); o.w = cvt_pk_bf16(v1[2], v1[3]);
                            *(u32x4*)(qp + (2 * w1 + bj) * 32) = o; } }
                    else { const size_t koff = smp ? ((size_t)(b * KVH + head) * LKS + PAST + t) * 128 : ((size_t)(b * KVH + head) * SEQP + t) * 128;
                        bf16_t* kp = (bf16_t*)(ws + (smp ? WS_KSC : WS_KP)) + koff + 8 * fq;
#pragma unroll
                        for (int bj = 0; bj < 2; ++bj) { const f32x4 v0 = y[bj][0], v1 = y[bj][1];
                            u32x4 o; o.x = cvt_pk_bf16(v0[0], v0[1]); o.y = cvt_pk_bf16(v0[2], v0[3]); o.z = cvt_pk_bf16(v1[0], v1[1]); o.w = cvt_pk_bf16(v1[2], v1[3]);
                            *(u32x4*)(kp + (2 * w1 + bj) * 32) = o;
                            if (!smp) { float* fp = nck + koff + 8 * fq + (2 * w1 + bj) * 32; *(f32x4*)fp = v0; *(f32x4*)(fp + 4) = v1; } } }
                }
        } else if (pn < 12) {
#pragma unroll
            for (int ai = 0; ai < 2; ++ai)
#pragma unroll
                for (int m = 0; m < 4; ++m) { if (ai >= nai) continue; const int t = tb + ai * 128 + m * 16;
#pragma unroll
                    for (int bj = 0; bj < 2; ++bj) { const int kvh = (pn - 10) * 2 + bj, d = 32 * wc + 8 * fq;
                        const size_t voff = (smp ? ((size_t)(b * KVH + kvh) * LKS + PAST + t) * 128 : ((size_t)(b * KVH + kvh) * SEQP + t) * 128) + d;
                        const f32x4 v0 = VV(ai, bj, m, 0), v1 = VV(ai, bj, m, 1);
                        u32x4 o; o.x = cvt_pk_bf16(v0[0], v0[1]); o.y = cvt_pk_bf16(v0[2], v0[3]); o.z = cvt_pk_bf16(v1[0], v1[1]); o.w = cvt_pk_bf16(v1[2], v1[3]);
                        *(u32x4*)((bf16_t*)(ws + (smp ? WS_VSC : WS_VP)) + voff) = o;
                        if (!smp) { *(f32x4*)(ncv + voff) = v0; *(f32x4*)(ncv + voff + 4) = v1; } } }
        } else {
            bf16_t* sg = (bf16_t*)(ws + WS_SG) + (pn - 12) * 256 + 32 * wc + 8 * fq;
#pragma unroll
            for (int ai = 0; ai < 2; ++ai)
#pragma unroll
                for (int m = 0; m < 4; ++m) { if (ai >= nai) continue; const size_t row = rowb + ai * 128 + m * 16;
#pragma unroll
                    for (int bj = 0; bj < 2; ++bj) { const f32x4 v0 = VV(ai, bj, m, 0), v1 = VV(ai, bj, m, 1);
                        u32x4 o; o.x = cvt_pk_bf16(siluf(v0[0]), siluf(v0[1])); o.y = cvt_pk_bf16(siluf(v0[2]), siluf(v0[3])); o.z = cvt_pk_bf16(siluf(v1[0]), siluf(v1[1])); o.w = cvt_pk_bf16(siluf(v1[2]), siluf(v1[3]));
                        *(u32x4*)(sg + row * DM + bj * HALF) = o; } }
        }
    }
};
#undef VV
struct EpiResid0 {
    static constexpr bool PERM = true, AFTER_DRAIN = false;
    const float* xp; const float* xs; const float* gate; const float* cw1; float* out; bf16_t* H1; float* rowss; float* slabs;
    __device__ __forceinline__ void operator()(const f32x4 (&acc)[2][2][4][2], const Unit& u, int wr, int wc, int fr, int fq) const {
        asm volatile("" : "+v"(fr), "+v"(fq));
        if (u.slab >= 0) { slab_store(acc, slabs, u, wr, wc, fr, fq); return; }
        const int row0 = u.pm * BM + wr * 64 + fr, col0 = u.pn * BM + wc * 32 + 8 * fq;
        const int cr = u.pm < 32 ? 0 : 1 + ((u.pm - 32) >> 2);
        f32x4 gv[2][2], cv[2][2];
#pragma unroll
        for (int bj = 0; bj < 2; ++bj)
#pragma unroll
            for (int n = 0; n < 2; ++n) { gv[bj][n] = *(const f32x4*)(gate + (size_t)cr * 6144 + col0 + bj * HALF + n * 4); cv[bj][n] = *(const f32x4*)(cw1 + (size_t)cr * DM + col0 + bj * HALF + n * 4); }
#pragma unroll
        for (int ai = 0; ai < 2; ++ai)
#pragma unroll
            for (int m = 0; m < 4; ++m) { const int r = row0 + ai * HALF + m * 16;
                const float* bp = (r < MP ? xp + (size_t)r * DM : xs + (size_t)(r - MP) * DM) + col0; float* op = out + (size_t)r * DM + col0; bf16_t* hp = H1 + (size_t)r * DM + col0;
                float ss = 0.f;
#pragma unroll
                for (int bj = 0; bj < 2; ++bj) { const f32x4 y0 = *(const f32x4*)(bp + bj * HALF) + gv[bj][0] * acc[ai][bj][m][0], y1 = *(const f32x4*)(bp + bj * HALF + 4) + gv[bj][1] * acc[ai][bj][m][1];
                    *(f32x4*)(op + bj * HALF) = y0; *(f32x4*)(op + bj * HALF + 4) = y1;
                    ss += (y0[0] * y0[0] + y0[1] * y0[1]) + (y0[2] * y0[2] + y0[3] * y0[3]) + (y1[0] * y1[0] + y1[1] * y1[1]) + (y1[2] * y1[2] + y1[3] * y1[3]);
                    const f32x4 h0 = y0 * cv[bj][0], h1 = y1 * cv[bj][1];
                    u32x4 o; o.x = cvt_pk_bf16(h0[0], h0[1]); o.y = cvt_pk_bf16(h0[2], h0[3]); o.z = cvt_pk_bf16(h1[0], h1[1]); o.w = cvt_pk_bf16(h1[2], h1[3]);
                    *(u32x4*)(hp + bj * HALF) = o; }
                ss += __shfl_xor(ss, 16); ss += __shfl_xor(ss, 32);
                if (fq == 0) atomicAdd(rowss + r, ss);
                if (m & 1) asm volatile("" ::: "memory"); }
    }
};
struct EpiResidF {
    static constexpr bool PERM = true, AFTER_DRAIN = false;
    const float* xp; const float* xs; const float* base; const float* gate; float* out; float* slabs;
    __device__ __forceinline__ void operator()(const f32x4 (&acc)[2][2][4][2], const Unit& u, int wr, int wc, int fr, int fq) const {
        asm volatile("" : "+v"(fr), "+v"(fq));
        if (u.slab >= 0) { slab_store(acc, slabs, u, wr, wc, fr, fq); return; }
        const int row0 = u.pm * BM + (u.half ? u.hm * HALF : 0) + wr * 64 + fr, col0 = u.pn * BM + wc * 32 + 8 * fq;
        const int cr = u.pm < 32 ? 0 : 1 + ((u.pm - 32) >> 2);
        f32x4 gv[2][2];
#pragma unroll
        for (int bj = 0; bj < 2; ++bj)
#pragma unroll
            for (int n = 0; n < 2; ++n) gv[bj][n] = *(const f32x4*)(gate + (size_t)cr * 6144 + col0 + bj * HALF + n * 4);
#pragma unroll
        for (int ai = 0; ai < 2; ++ai)
#pragma unroll
            for (int m = 0; m < 4; ++m) { if (ai == 1 && u.half) continue; const int r = row0 + ai * HALF + m * 16;
                const float* bp = (base ? base + (size_t)r * DM : (r < MP ? xp + (size_t)r * DM : xs + (size_t)(r - MP) * DM)) + col0; float* op = out + (size_t)r * DM + col0;
#pragma unroll
                for (int bj = 0; bj < 2; ++bj)
#pragma unroll
                    for (int n = 0; n < 2; ++n) { const f32x4 b = *(const f32x4*)(bp + bj * HALF + n * 4); *(f32x4*)(op + bj * HALF + n * 4) = b + gv[bj][n] * acc[ai][bj][m][n]; }
                if (m & 1) asm volatile("" ::: "memory"); }
    }
};

template <class Epi, class Sched, bool ALIGN_EPI = false, bool SP2 = false>
__device__ __forceinline__ void gemm_phase(PG8_LAS unsigned char* lds, const Gemm g, const Sched& S, const Epi& E, const int tid) {
    const int wid = __builtin_amdgcn_readfirstlane(tid >> 6), lane = tid & 63, wr = wid >> 2, wc = wid & 3, fr = lane & 15, fq = lane >> 4;
    unsigned voffA[2], voffB[2];
#pragma unroll
    for (int i = 0; i < 2; ++i) { int R, C; stage_rc(tid * 16 + i * 8192, R, C); const int Rb = Epi::PERM ? ((R & ~31) + perm32(R & 31)) : R;
        voffA[i] = (unsigned)(R * g.lda + C) * 2u; voffB[i] = (unsigned)(Rb * g.ldb + C) * 2u; }
    const size_t kstep = (size_t)(BK * 2);
    const size_t hstepA = (size_t)HALF * g.lda * 2, hstepB = (size_t)HALF * g.ldb * 2;
    const size_t tstepA = 2 * hstepA, tstepB = 2 * hstepB;
    const unsigned ldsw = (unsigned)wid * 1024u;
    const int aoff = lds_byte(wr * 64 + fr, fq * 8), boff = lds_byte(wc * 32 + fr, fq * 8);
#define PG8_SA(b, h) (((b) * 2 + (h)) * HTB)
#define PG8_SB(b, h) ((4 + (b) * 2 + (h)) * HTB)
#define PG8_STAGE(bufoff, gbase, voff) do { _Pragma("unroll") for (int _i = 0; _i < 2; ++_i) \
        __builtin_amdgcn_global_load_lds((const unsigned*)((const char*)(gbase) + (voff)[_i]), (PG8_LAS unsigned*)(lds + (bufoff) + ldsw + _i * 8192), 16, 0, 0); } while (0)
#define PG8_LDA(dst, b, h) do { _Pragma("unroll") for (int m = 0; m < 4; ++m) _Pragma("unroll") for (int k = 0; k < 2; ++k) dst[m][k] = *(const PG8_LAS bf16x8*)(lds + PG8_SA(b, h) + aoff + m * 2048 + k * 1024); } while (0)
#define PG8_LDB(dst, b, h) do { _Pragma("unroll") for (int n = 0; n < 2; ++n) _Pragma("unroll") for (int k = 0; k < 2; ++k) dst[n][k] = *(const PG8_LAS bf16x8*)(lds + PG8_SB(b, h) + boff + n * 2048 + k * 1024); } while (0)
#define PG8_MMA(ai, bj, At, Bt) do { __builtin_amdgcn_s_setprio(1); _Pragma("unroll") for (int m = 0; m < 4; ++m) _Pragma("unroll") for (int n = 0; n < 2; ++n) _Pragma("unroll") for (int k = 0; k < 2; ++k) \
        acc[ai][bj][m][n] = __builtin_amdgcn_mfma_f32_16x16x32_bf16(Bt[n][k], At[m][k], acc[ai][bj][m][n], 0, 0, 0); __builtin_amdgcn_s_setprio(0); } while (0)
#define PG8_WAIT_V(n) asm volatile("s_waitcnt vmcnt(" #n ")" ::: "memory")
#define PG8_WAIT_L(n) asm volatile("s_waitcnt lgkmcnt(" #n ")" ::: "memory")
#define PG8_BAR __builtin_amdgcn_s_barrier()
#define PG8_SCHED __builtin_amdgcn_sched_barrier(0)
    Unit cur, nxt; int ui = 0;
    if (!S.next(0, cur)) return;
    f32x4 acc[2][2][4][2];
#pragma unroll
    for (int a = 0; a < 2; ++a)
#pragma unroll
        for (int b = 0; b < 2; ++b)
#pragma unroll
            for (int m = 0; m < 4; ++m)
#pragma unroll
                for (int n = 0; n < 2; ++n) acc[a][b][m][n] = (f32x4){0.f, 0.f, 0.f, 0.f};
    bf16x8 At[4][2], B0[2][2], B1[2][2];
    const char* cA = (const char*)g.A + (size_t)cur.pm * tstepA + (size_t)cur.pn * g.a_pn_off * 2 + (size_t)cur.kt0 * kstep + (cur.half ? (size_t)cur.hm * hstepA : 0); const char* cB = (const char*)g.Bt + (size_t)cur.pn * tstepB + (size_t)cur.pm * g.b_pm_off * 2 + (size_t)cur.kt0 * kstep;
    S.a_ready(cur);
    if constexpr (SP2) {
        PG8_STAGE(PG8_SB(0, 0), cB, voffB); PG8_STAGE(PG8_SB(0, 1), cB + hstepB, voffB); PG8_STAGE(PG8_SA(0, 0), cA, voffA); PG8_STAGE(PG8_SA(0, 1), cA + (cur.half ? 0 : hstepA), voffA);
        if (wr == 1) PG8_BAR;
        PG8_WAIT_V(2); PG8_BAR;
        PG8_STAGE(PG8_SB(1, 0), cB + kstep, voffB); PG8_STAGE(PG8_SA(1, 0), cA + kstep, voffA); PG8_STAGE(PG8_SB(1, 1), cB + hstepB + kstep, voffB);
        PG8_WAIT_V(6); PG8_BAR;
    } else {
        PG8_STAGE(PG8_SB(0, 0), cB, voffB); PG8_STAGE(PG8_SA(0, 0), cA, voffA); PG8_STAGE(PG8_SB(0, 1), cB + hstepB, voffB); PG8_STAGE(PG8_SA(0, 1), cA + hstepA, voffA);
        if (wr == 1) PG8_BAR;
        PG8_WAIT_V(4); PG8_BAR;
        PG8_STAGE(PG8_SB(1, 0), cB + kstep, voffB); PG8_STAGE(PG8_SA(1, 0), cA + kstep, voffA); PG8_STAGE(PG8_SB(1, 1), cB + hstepB + kstep, voffB);
        PG8_WAIT_V(6); PG8_BAR;
    }
    for (;;) {
        const bool has_next = S.next(ui + 1, nxt);
        const char* nA = has_next ? (const char*)g.A + (size_t)nxt.pm * tstepA + (size_t)nxt.pn * g.a_pn_off * 2 + (size_t)nxt.kt0 * kstep + (nxt.half ? (size_t)nxt.hm * hstepA : 0) : cA; const char* nB = has_next ? (const char*)g.Bt + (size_t)nxt.pn * tstepB + (size_t)nxt.pm * g.b_pm_off * 2 + (size_t)nxt.kt0 * kstep : cB;
        const size_t curH = cur.half ? 0 : hstepA, nxtH = has_next ? (nxt.half ? 0 : hstepA) : curH;
        const int nt = cur.nkt;
        for (int t = 0; t < nt; t += 2) {
            const bool last = (t == nt - 2);
            const char* a1 = cA + (size_t)(t + 1) * kstep;
            const char* a2 = last ? nA : cA + (size_t)(t + 2) * kstep; const char* b2 = last ? nB : cB + (size_t)(t + 2) * kstep;
            const char* a3 = a2 + kstep; const char* b3 = b2 + kstep;
            if (last && has_next) S.a_ready(nxt);
            if constexpr (SP2) {
            PG8_LDB(B0, 0, 0); PG8_LDB(B1, 0, 1); PG8_SCHED; PG8_LDA(At, 0, 0); PG8_STAGE(PG8_SA(1, 1), a1 + curH, voffA);
            PG8_WAIT_V(8); PG8_WAIT_L(0); PG8_BAR; PG8_MMA(0, 0, At, B0); PG8_MMA(0, 1, At, B1); PG8_BAR; PG8_SCHED;
            PG8_LDA(At, 0, 1); PG8_STAGE(PG8_SB(0, 0), b2, voffB); PG8_STAGE(PG8_SB(0, 1), b2 + hstepB, voffB); PG8_STAGE(PG8_SA(0, 0), a2, voffA);
            PG8_WAIT_V(8); PG8_WAIT_L(0); PG8_BAR; if (!cur.half) { PG8_MMA(1, 0, At, B0); PG8_MMA(1, 1, At, B1); } PG8_BAR; PG8_SCHED;
            PG8_LDB(B0, 1, 0); PG8_LDB(B1, 1, 1); PG8_SCHED; PG8_LDA(At, 1, 0); PG8_STAGE(PG8_SA(0, 1), a2 + (last ? nxtH : curH), voffA);
            PG8_WAIT_V(8); PG8_WAIT_L(0); PG8_BAR; PG8_MMA(0, 0, At, B0); PG8_MMA(0, 1, At, B1); PG8_BAR; PG8_SCHED;
            PG8_LDA(At, 1, 1); PG8_STAGE(PG8_SB(1, 0), b3, voffB); PG8_STAGE(PG8_SB(1, 1), b3 + hstepB, voffB); PG8_STAGE(PG8_SA(1, 0), a3, voffA);
            PG8_WAIT_V(8); PG8_WAIT_L(0); PG8_BAR; if (!cur.half) { PG8_MMA(1, 0, At, B0); PG8_MMA(1, 1, At, B1); } PG8_BAR; PG8_SCHED;
            } else {
            PG8_LDB(B0, 0, 0); PG8_SCHED; PG8_LDA(At, 0, 0); PG8_STAGE(PG8_SA(1, 1), a1 + hstepA, voffA);
            PG8_WAIT_L(8); PG8_BAR; PG8_WAIT_L(0); PG8_MMA(0, 0, At, B0); PG8_BAR; PG8_SCHED;
            PG8_LDB(B1, 0, 1); PG8_STAGE(PG8_SB(0, 0), b2, voffB);
            PG8_BAR; PG8_WAIT_L(0); PG8_MMA(0, 1, At, B1); PG8_BAR;
            PG8_LDA(At, 0, 1); PG8_STAGE(PG8_SA(0, 0), a2, voffA);
            PG8_BAR; PG8_WAIT_L(0); PG8_MMA(1, 0, At, B0); PG8_BAR; PG8_SCHED;
            PG8_STAGE(PG8_SB(0, 1), b2 + hstepB, voffB);
            PG8_WAIT_V(6); PG8_BAR; PG8_MMA(1, 1, At, B1); PG8_BAR;
            PG8_LDB(B0, 1, 0); PG8_SCHED; PG8_LDA(At, 1, 0); PG8_STAGE(PG8_SA(0, 1), a2 + hstepA, voffA);
            PG8_WAIT_L(8); PG8_BAR; PG8_WAIT_L(0); PG8_MMA(0, 0, At, B0); PG8_BAR; PG8_SCHED;
            PG8_LDB(B1, 1, 1); PG8_STAGE(PG8_SB(1, 0), b3, voffB);
            PG8_BAR; PG8_WAIT_L(0); PG8_MMA(0, 1, At, B1); PG8_BAR;
            PG8_LDA(At, 1, 1); PG8_STAGE(PG8_SA(1, 0), a3, voffA);
            PG8_BAR; PG8_WAIT_L(0); PG8_MMA(1, 0, At, B0); PG8_BAR; PG8_SCHED;
            PG8_STAGE(PG8_SB(1, 1), b3 + hstepB, voffB);
            PG8_WAIT_V(6); PG8_BAR; PG8_MMA(1, 1, At, B1); PG8_BAR;
            }
        }
        if constexpr (ALIGN_EPI) { if (wr == 0) PG8_BAR; }
        if constexpr (!Epi::AFTER_DRAIN) { E(acc, cur, wr, wc, fr, fq); S.done(cur); }
        if (!has_next) break;
#pragma unroll
        for (int a = 0; a < 2; ++a)
#pragma unroll
            for (int b = 0; b < 2; ++b)
#pragma unroll
                for (int m = 0; m < 4; ++m)
#pragma unroll
                    for (int n = 0; n < 2; ++n) acc[a][b][m][n] = (f32x4){0.f, 0.f, 0.f, 0.f};
        cur = nxt; cA = nA; cB = nB; ++ui;
        if constexpr (ALIGN_EPI) { if (wr == 1) PG8_BAR; }
    }
    PG8_WAIT_V(0);
    if constexpr (!ALIGN_EPI) { if (wr == 0) PG8_BAR; }
    PG8_BAR;
#undef PG8_SA
#undef PG8_SB
#undef PG8_STAGE
#undef PG8_LDA
#undef PG8_LDB
#undef PG8_MMA
#undef PG8_WAIT_V
#undef PG8_WAIT_L
#undef PG8_BAR
#undef PG8_SCHED
}
}

__device__ __forceinline__ void ld8(const bf16_t* p, float (&v)[8]) { const u32x4 r = *(const u32x4*)p; v[0] = bflo(r.x); v[1] = bfhi(r.x); v[2] = bflo(r.y); v[3] = bfhi(r.y); v[4] = bflo(r.z); v[5] = bfhi(r.z); v[6] = bflo(r.w); v[7] = bfhi(r.w); }
__device__ __forceinline__ void pool_apply_slot(const Params& p, int slot, int tid) {
    const bf16_t* __restrict__ Z = (const bf16_t*)(p.ws + WS_U); const bf16_t* __restrict__ SG = (const bf16_t*)(p.ws + WS_SG); bf16_t* __restrict__ Y = (bf16_t*)(p.ws + WS_HY);
    const int chunk = tid & 127, rb = tid >> 7, c = chunk * 8, g = chunk >> 5, h = 1 << g;
    float ps[8];
#pragma unroll
    for (int e = 0; e < 8; ++e) ps[e] = p.pool_scale[c + e];
    float S[8]; bool first = true;
    int m = slot * 80 + rb * 20;
#pragma unroll 1
    for (int i4 = 0; i4 < 5; ++i4) {
        float za[4][8], zr[4][8], own[4][8], gt[4][8]; int cnt[4]; bool init[4];
#pragma unroll
        for (int j = 0; j < 4; ++j) { const int mm = m + j; const bool smp = mm >= MP; const int t = smp ? (mm - MP) & 1023 : mm & 255, L = smp ? SEQS : SEQP;
            const bf16_t* zp = Z + (size_t)mm * 1024 + c;
            const bool add_ok = (t + h <= L), rem_ok = (t - h >= 1);
            ld8(zp + (ptrdiff_t)(add_ok ? (h - 1) : 0) * 1024, za[j]); ld8(zp + (ptrdiff_t)(rem_ok ? (-1 - h) : 0) * 1024, zr[j]); ld8(zp, own[j]); ld8(SG + (size_t)mm * DM + 1024 + c, gt[j]);
            const float fa = add_ok ? 1.f : 0.f, fr = rem_ok ? 1.f : 0.f;
#pragma unroll
            for (int e = 0; e < 8; ++e) { za[j][e] *= fa; zr[j][e] *= fr; }
            cnt[j] = min(t + h, L) - max(t - h, 0); init[j] = (t == 0) || (first && j == 0 && i4 == 0); }
#pragma unroll
        for (int j = 0; j < 4; ++j) { const int mm = m + j;
            if (init[j]) { const bool smp = mm >= MP; const int t = smp ? (mm - MP) & 1023 : mm & 255, L = smp ? SEQS : SEQP; const int lo = max(t - h, 0), hi = min(t + h, L);
#pragma unroll
                for (int e = 0; e < 8; ++e) S[e] = 0.f;
                for (int tt = lo; tt < hi; ++tt) { float w[8]; ld8(Z + (size_t)(mm + tt - t) * 1024 + c, w);
#pragma unroll
                    for (int e = 0; e < 8; ++e) S[e] += w[e]; } }
            else {
#pragma unroll
                for (int e = 0; e < 8; ++e) S[e] += za[j][e] - zr[j][e]; }
            const float inv = 1.0f / (float)cnt[j];
            float o[8];
#pragma unroll
            for (int e = 0; e < 8; ++e) o[e] = (S[e] * inv - own[j][e]) * ps[e] * gt[j][e];
            u32x4 w; w.x = pk2(o[0], o[1]); w.y = pk2(o[2], o[3]); w.z = pk2(o[4], o[5]); w.w = pk2(o[6], o[7]);
            *(u32x4*)(Y + (size_t)mm * DM + 1024 + c) = w; }
        first = false; m += 4;
    }
}
namespace att {
#define GATE(x) (SILU ? siluf(x) : (x))
using bf16x8 = __attribute__((ext_vector_type(8))) short;
using s16x4  = __attribute__((ext_vector_type(4))) short;
using f32x16 = __attribute__((ext_vector_type(16))) float;
constexpr int QBLK = 32, KVBLK = 64, LDK = 128;
constexpr int SHM_V = KVBLK * 128 * 2, SHM_K = KVBLK * 128 * 2;
constexpr int WS_OFF = 2 * SHM_V + 2 * SHM_K;
constexpr int STG_OFF = 72 * 1024;
constexpr float THRL = 8.f * LOG2E;
#define KSWZ(row, colB) ((row) * 256 + ((colB) ^ (((row) & 7) << 4)))
#define SBAR() __builtin_amdgcn_sched_barrier(0)
__device__ __forceinline__ int crow(int r, int hi) { return (r & 3) + 8 * (r >> 2) + 4 * hi; }
__device__ __forceinline__ unsigned cvtpk(float lo, float hi) { unsigned r; asm volatile("v_cvt_pk_bf16_f32 %0, %1, %2" : "=v"(r) : "v"(lo), "v"(hi)); return r; }
constexpr float SOFT_OFF = 0.f;
__device__ __forceinline__ void partialSM(f32x16& p0, f32x16& p1, float& m_reg, float& mn, float& alpha) {
  float pmax = p0[0]; for (int r = 1; r < 16; ++r) pmax = fmaxf(pmax, p0[r]); for (int r = 0; r < 16; ++r) pmax = fmaxf(pmax, p1[r]);
  { auto rr = __builtin_amdgcn_permlane32_swap(__float_as_uint(pmax), __float_as_uint(pmax), false, false);
    pmax = fmaxf(__uint_as_float(rr[0]), __uint_as_float(rr[1])); }
  if (__builtin_expect(__all(pmax - m_reg <= THRL), 1)) { mn = m_reg; alpha = 1.f; }
  else { mn = fmaxf(m_reg, pmax); alpha = __builtin_amdgcn_exp2f(m_reg - mn); m_reg = mn; }
  for (int r = 0; r < 16; ++r) p0[r] = p0[r] - mn; for (int r = 0; r < 16; ++r) p1[r] = p1[r] - mn;
  for (int r = 0; r < 16; ++r) p0[r] = __builtin_amdgcn_exp2f(p0[r]);
}
__device__ __forceinline__ void finishSM(f32x16& p0, f32x16& p1, float alpha, float& l_reg, bf16x8& pa0, bf16x8& pa1, bf16x8& pa2, bf16x8& pa3) {
  for (int r = 0; r < 16; ++r) p1[r] = __builtin_amdgcn_exp2f(p1[r]);
  float ps = 0; for (int r = 0; r < 16; ++r) ps += p0[r]; for (int r = 0; r < 16; ++r) ps += p1[r];
  { auto rr = __builtin_amdgcn_permlane32_swap(__float_as_uint(ps), __float_as_uint(ps), false, false);
    ps = __uint_as_float(rr[0]) + __uint_as_float(rr[1]); }
  l_reg = l_reg * alpha + ps;
#define PK4(P, BASE, OUT) do { unsigned a0 = cvtpk(P[BASE + 0], P[BASE + 1]), a1 = cvtpk(P[BASE + 2], P[BASE + 3]);   \
    unsigned b0 = cvtpk(P[BASE + 4], P[BASE + 5]), b1 = cvtpk(P[BASE + 6], P[BASE + 7]);                              \
    auto r0 = __builtin_amdgcn_permlane32_swap(a0, b0, false, false); auto r1 = __builtin_amdgcn_permlane32_swap(a1, b1, false, false); \
    u32x4 w = {r0[0], r1[0], r0[1], r1[1]}; OUT = *reinterpret_cast<bf16x8*>(&w); } while (0)
  PK4(p0, 0, pa0); PK4(p0, 8, pa1); PK4(p1, 0, pa2); PK4(p1, 8, pa3);
#undef PK4
}
template <int ND0> __device__ __forceinline__ void qkt(f32x16& p0, f32x16& p1, const char* Ks, const bf16x8* qr, int r32, int hi, int kcol0, const f32x16& cinit) {
#pragma unroll
  for (int d0 = 0; d0 < ND0; ++d0) { int cb = (kcol0 + d0 * 16 + hi * 8) * 2;
    bf16x8 b0 = *reinterpret_cast<const bf16x8*>(Ks + KSWZ(r32, cb));
    bf16x8 b1 = *reinterpret_cast<const bf16x8*>(Ks + KSWZ(32 + r32, cb));
    if (d0 == 0) { p0 = __builtin_amdgcn_mfma_f32_32x32x16_bf16(b0, qr[d0], cinit, 0, 0, 0); p1 = __builtin_amdgcn_mfma_f32_32x32x16_bf16(b1, qr[d0], cinit, 0, 0, 0); }
    else { p0 = __builtin_amdgcn_mfma_f32_32x32x16_bf16(b0, qr[d0], p0, 0, 0, 0); p1 = __builtin_amdgcn_mfma_f32_32x32x16_bf16(b1, qr[d0], p1, 0, 0, 0); } }
}
__device__ __forceinline__ int v_st(int k, int c) { const int kk = (k & ~0xC) | ((k & 4) << 1) | ((k & 8) >> 1); return ((kk >> 3) * 4 + (c >> 5)) * 512 + ((kk & 7) * 32 + (c & 31)) * 2; }
__device__ __forceinline__ int v_rd_base(int lane) { return ((lane & 3) << 3) | (((lane >> 2) & 3) << 6) | (((lane >> 4) & 1) << 5) | (((lane >> 5) & 1) << 8); }
constexpr int v_rd_off(int d0, int ks, int half) { return d0 * 512 + ks * 4096 + half * 2048; }
template <int OFF> __device__ __forceinline__ s16x4 tr_read(int vb) {
  s16x4 r; asm volatile("ds_read_b64_tr_b16 %0, %1 offset:%2" : "=&v"(r) : "v"(vb), "i"(OFF) : "memory"); return r;
}
template <int D0> __device__ __forceinline__ void pv_one(f32x16& od, int vb, bf16x8 pa0, bf16x8 pa1, bf16x8 pa2, bf16x8 pa3) {
  const s16x4 l0 = tr_read<v_rd_off(D0, 0, 0)>(vb), h0 = tr_read<v_rd_off(D0, 0, 1)>(vb), l1 = tr_read<v_rd_off(D0, 1, 0)>(vb), h1 = tr_read<v_rd_off(D0, 1, 1)>(vb);
  const s16x4 l2 = tr_read<v_rd_off(D0, 2, 0)>(vb), h2 = tr_read<v_rd_off(D0, 2, 1)>(vb), l3 = tr_read<v_rd_off(D0, 3, 0)>(vb), h3 = tr_read<v_rd_off(D0, 3, 1)>(vb);
  asm volatile("s_waitcnt lgkmcnt(0)" ::: "memory"); SBAR();
#define PK(L, H) (bf16x8){L[0], L[1], L[2], L[3], H[0], H[1], H[2], H[3]}
  od = __builtin_amdgcn_mfma_f32_32x32x16_bf16(pa0, PK(l0, h0), od, 0, 0, 0);
  od = __builtin_amdgcn_mfma_f32_32x32x16_bf16(pa1, PK(l1, h1), od, 0, 0, 0);
  od = __builtin_amdgcn_mfma_f32_32x32x16_bf16(pa2, PK(l2, h2), od, 0, 0, 0);
  od = __builtin_amdgcn_mfma_f32_32x32x16_bf16(pa3, PK(l3, h3), od, 0, 0, 0);
#undef PK
}
__device__ __forceinline__ void pv_d0(f32x16* o, int vb, bf16x8 pa0, bf16x8 pa1, bf16x8 pa2, bf16x8 pa3) {
  pv_one<0>(o[0], vb, pa0, pa1, pa2, pa3); pv_one<1>(o[1], vb, pa0, pa1, pa2, pa3); pv_one<2>(o[2], vb, pa0, pa1, pa2, pa3); pv_one<3>(o[3], vb, pa0, pa1, pa2, pa3);
}
template <int ND0>
__device__ __forceinline__ void attn_core(const bf16_t* Qw, const bf16_t* __restrict__ Kh, const bf16_t* __restrict__ Vh, int seq, int kcol0, char* lds, f32x16 (&o)[4], float& l_reg, const int wid, const int lane) {
  const int tid = wid * 64 + lane, r32 = lane & 31, hi = lane >> 5;
  char* V_lds = lds; char* K_lds = lds + 2 * SHM_V;
  float* ws = (float*)(lds + WS_OFF) + wid * 64; float* al_l = ws + 32;
  float m_reg = -1e30f; l_reg = 0; bf16x8 qr[ND0];
  f32x16 cinit; for (int r = 0; r < 16; ++r) cinit[r] = -SOFT_OFF;
#pragma unroll
  for (int d = 0; d < 4; ++d) o[d] = f32x16{};
#pragma unroll
  for (int d0 = 0; d0 < ND0; ++d0) qr[d0] = *reinterpret_cast<const bf16x8*>(Qw + d0 * 16);
  const int sr = tid >> 4, sc = (tid & 15) * 8, vst0 = v_st(sr, sc), vst1 = v_st(32 + sr, sc);
  const int vb0 = (int)(uintptr_t)V_lds + v_rd_base(lane);
  struct { bf16x8 vs0, vs1, ks0, ks1; } sr_[1];
#define SLOAD(i, k0) do { sr_[i].vs0 = *reinterpret_cast<const bf16x8*>(&Vh[(long)((k0) + sr) * LDK + sc]); sr_[i].vs1 = *reinterpret_cast<const bf16x8*>(&Vh[(long)((k0) + 32 + sr) * LDK + sc]); \
    sr_[i].ks0 = *reinterpret_cast<const bf16x8*>(&Kh[(long)((k0) + sr) * LDK + sc]); sr_[i].ks1 = *reinterpret_cast<const bf16x8*>(&Kh[(long)((k0) + 32 + sr) * LDK + sc]); } while (0)
#define SWRITE(b, i) do { *(bf16x8*)(V_lds + (b) * SHM_V + vst0) = sr_[i].vs0;          \
    *(bf16x8*)(V_lds + (b) * SHM_V + vst1) = sr_[i].vs1; int kc = sc * 2;               \
    *(bf16x8*)(K_lds + (b) * SHM_K + KSWZ(sr, kc)) = sr_[i].ks0;                       \
    *(bf16x8*)(K_lds + (b) * SHM_K + KSWZ(32 + sr, kc)) = sr_[i].ks1; } while (0)
#define SWAIT() asm volatile("s_waitcnt vmcnt(0)" ::: "memory")
#define RESC(a) do { if (__any((a) < 1.f)) { if (hi == 0) al_l[r32] = (a); asm volatile("s_waitcnt lgkmcnt(0)" ::: "memory"); \
    for (int d = 0; d < 4; ++d) for (int r = 0; r < 16; ++r) o[d][r] *= al_l[crow(r, hi)]; } } while (0)
  f32x16 pA0, pA1, pB0, pB1; float mnA, mnB, alA, alB; bf16x8 pa0, pa1, pa2, pa3; const int NT = seq / KVBLK;
  SLOAD(0, 0); asm volatile("s_waitcnt vmcnt(0)" ::: "memory"); SWRITE(0, 0); __syncthreads();
  qkt<ND0>(pA0, pA1, K_lds, qr, r32, hi, kcol0, cinit); partialSM(pA0, pA1, m_reg, mnA, alA);
  SLOAD(0, KVBLK);
  SWAIT(); SWRITE(1, 0); __syncthreads();
  for (int j = 1; j + 1 < NT; j += 2) {
    SBAR(); qkt<ND0>(pB0, pB1, K_lds + SHM_K, qr, r32, hi, kcol0, cinit);
    finishSM(pA0, pA1, alA, l_reg, pa0, pa1, pa2, pa3); SBAR();
    SLOAD(0, (j + 1) * KVBLK); SBAR();
    pv_d0(o, vb0, pa0, pa1, pa2, pa3); partialSM(pB0, pB1, m_reg, mnB, alB);
    __syncthreads(); SWAIT(); SWRITE(0, 0);
    RESC(alB); __syncthreads();
    SBAR(); qkt<ND0>(pA0, pA1, K_lds, qr, r32, hi, kcol0, cinit);
    finishSM(pB0, pB1, alB, l_reg, pa0, pa1, pa2, pa3); SBAR();
    SLOAD(0, (j + 2) * KVBLK); SBAR();
    pv_d0(o, vb0 + SHM_V, pa0, pa1, pa2, pa3); partialSM(pA0, pA1, m_reg, mnA, alA);
    __syncthreads(); SWAIT(); SWRITE(1, 0);
    RESC(alA); __syncthreads();
  }
  SBAR(); qkt<ND0>(pB0, pB1, K_lds + SHM_K, qr, r32, hi, kcol0, cinit);
  finishSM(pA0, pA1, alA, l_reg, pa0, pa1, pa2, pa3); SBAR();
  pv_d0(o, vb0, pa0, pa1, pa2, pa3); partialSM(pB0, pB1, m_reg, mnB, alB);
  __syncthreads(); RESC(alB);
  finishSM(pB0, pB1, alB, l_reg, pa0, pa1, pa2, pa3); SBAR();
  pv_d0(o, vb0 + SHM_V, pa0, pa1, pa2, pa3);
#undef SLOAD
#undef SWRITE
#undef SWAIT
#undef RESC
}
__device__ __forceinline__ void row_inv_l(float l_reg, char* lds, int wid, int r32, int hi, float (&rli)[16]) {
  float* li_l = (float*)(lds + WS_OFF) + wid * 64;
  if (hi == 0) li_l[r32] = l_reg; asm volatile("s_waitcnt lgkmcnt(0)" ::: "memory");
#pragma unroll
  for (int r = 0; r < 16; ++r) rli[r] = __builtin_amdgcn_rcpf(li_l[crow(r, hi)]);
}
template <bool SILU> __device__ __forceinline__ void store_rows_gated(const f32x16 (&v)[4], char* stg, bf16_t* Yrow0  , const bf16_t* Grow0, int gpitch, int lane, int r32, int hi) {
  bf16_t* st = (bf16_t*)stg;
#pragma unroll
  for (int r = 0; r < 16; ++r) { const int orow = crow(r, hi);
#pragma unroll
    for (int d0 = 0; d0 < 4; ++d0) st[orow * 128 + d0 * 32 + r32] = (bf16_t)f2bf(v[d0][r]); }
  asm volatile("s_waitcnt lgkmcnt(0)" ::: "memory");
  const bf16_t* gp = Grow0 + (size_t)(lane >> 4) * gpitch + (lane & 15) * 8; bf16_t* yp = Yrow0 + (size_t)(lane >> 4) * DM + (lane & 15) * 8; const bf16_t* sp = st + (lane >> 4) * 128 + (lane & 15) * 8;
  u32x4 g[8];
#pragma unroll
  for (int i = 0; i < 8; ++i) { g[i] = *(const u32x4*)gp; gp += 4 * (size_t)gpitch; asm volatile("" : "+v"(gp)); }
#pragma unroll
  for (int i = 0; i < 8; ++i) {
    const u32x4 x = *(const u32x4*)(sp + i * 4 * 128);
    u32x4 w; w.x = pk2(bflo(x.x) * GATE(bflo(g[i].x)), bfhi(x.x) * GATE(bfhi(g[i].x))); w.y = pk2(bflo(x.y) * GATE(bflo(g[i].y)), bfhi(x.y) * GATE(bfhi(g[i].y)));
    w.z = pk2(bflo(x.z) * GATE(bflo(g[i].z)), bfhi(x.z) * GATE(bfhi(g[i].z))); w.w = pk2(bflo(x.w) * GATE(bflo(g[i].w)), bfhi(x.w) * GATE(bfhi(g[i].w)));
    *(u32x4*)yp = w; yp += 4 * DM; asm volatile("" : "+v"(yp)); }
  asm volatile("s_waitcnt lgkmcnt(0)" ::: "memory");
}
__device__ __forceinline__ void gqa_unit(const Params& p, char* lds, int m0, int hq, const bf16_t* Kh, const bf16_t* Vh, int seq, const int wid) {
  const int lane = fresh_lane(), r32 = lane & 31, hi = lane >> 5;
  const bf16_t* QC = (const bf16_t*)(p.ws + WS_Q); const bf16_t* PR = (const bf16_t*)(p.ws + WS_PR); bf16_t* Y = (bf16_t*)(p.ws + WS_HY);
  f32x16 o[4]; float l_reg;
  attn_core<8>(QC + (size_t)(m0 + wid * QBLK + r32) * DM + hq * 128 + hi * 8, Kh, Vh, seq, 0, lds, o, l_reg, wid, lane);
  float rli[16]; row_inv_l(l_reg, lds, wid, r32, hi, rli);
#pragma unroll
  for (int d0 = 0; d0 < 4; ++d0)
#pragma unroll
    for (int r = 0; r < 16; ++r) o[d0][r] *= rli[r];
  __syncthreads();
  const size_t row0 = (size_t)(m0 + wid * QBLK);
  store_rows_gated<false>(o, lds + wid * 8192, Y + row0 * DM + hq * 128, (const bf16_t*)(p.ws + WS_SG) + row0 * DM + hq * 128, DM, lane, r32, hi);
  __syncthreads();
}
constexpr int RES_WS = 131072 + 1024, RES_EX = 131072 + 4096;
__device__ __forceinline__ void load_kv_resident(const bf16_t* __restrict__ Kh, const bf16_t* __restrict__ Vh, char* lds, int tid) {
  bf16x8 kr[8], vr[8];
#pragma unroll
  for (int i = 0; i < 8; ++i) { const int c = tid + 512 * i; kr[i] = *reinterpret_cast<const bf16x8*>(Kh + (size_t)c * 8); vr[i] = *reinterpret_cast<const bf16x8*>(Vh + (size_t)c * 8); }
#pragma unroll
  for (int i = 0; i < 8; ++i) { const int c = tid + 512 * i, key = c >> 4, col = (c & 15) * 8, t = key >> 6, k = key & 63;
    *(bf16x8*)(lds + 65536 + t * 16384 + v_st(k, col)) = vr[i];
    *(bf16x8*)(lds + t * 16384 + KSWZ(k, col * 2)) = kr[i]; }
}
template <int ND0>
__device__ __forceinline__ void attn_core_res(const bf16_t* Qw, int kcol0, char* lds, f32x16 (&o)[4], float& l_reg, const int wid, const int lane) {
  const int r32 = lane & 31, hi = lane >> 5;
  const char* K_lds = lds; float* al_l = (float*)(lds + RES_WS) + wid * 64 + 32;
  float m_reg = -1e30f; l_reg = 0; bf16x8 qr[ND0];
  f32x16 cinit; for (int r = 0; r < 16; ++r) cinit[r] = -SOFT_OFF;
#pragma unroll
  for (int d = 0; d < 4; ++d) o[d] = f32x16{};
#pragma unroll
  for (int d0 = 0; d0 < ND0; ++d0) qr[d0] = *reinterpret_cast<const bf16x8*>(Qw + d0 * 16);
  const int vb0 = (int)(uintptr_t)(lds + 65536) + v_rd_base(lane);
#define RESC(a) do { if (__any((a) < 1.f)) { if (hi == 0) al_l[r32] = (a); asm volatile("s_waitcnt lgkmcnt(0)" ::: "memory"); \
    for (int d = 0; d < 4; ++d) for (int r = 0; r < 16; ++r) o[d][r] *= al_l[crow(r, hi)]; } } while (0)
  f32x16 pA0, pA1, pB0, pB1; float mnA, mnB, alA, alB; bf16x8 pa0, pa1, pa2, pa3;
  qkt<ND0>(pA0, pA1, K_lds, qr, r32, hi, kcol0, cinit); partialSM(pA0, pA1, m_reg, mnA, alA);
  SBAR(); qkt<ND0>(pB0, pB1, K_lds + 16384, qr, r32, hi, kcol0, cinit);
  finishSM(pA0, pA1, alA, l_reg, pa0, pa1, pa2, pa3); SBAR();
  pv_d0(o, vb0, pa0, pa1, pa2, pa3); partialSM(pB0, pB1, m_reg, mnB, alB); RESC(alB);
  SBAR(); qkt<ND0>(pA0, pA1, K_lds + 2 * 16384, qr, r32, hi, kcol0, cinit);
  finishSM(pB0, pB1, alB, l_reg, pa0, pa1, pa2, pa3); SBAR();
  pv_d0(o, vb0 + 16384, pa0, pa1, pa2, pa3); partialSM(pA0, pA1, m_reg, mnA, alA); RESC(alA);
  SBAR(); qkt<ND0>(pB0, pB1, K_lds + 3 * 16384, qr, r32, hi, kcol0, cinit);
  finishSM(pA0, pA1, alA, l_reg, pa0, pa1, pa2, pa3); SBAR();
  pv_d0(o, vb0 + 2 * 16384, pa0, pa1, pa2, pa3); partialSM(pB0, pB1, m_reg, mnB, alB); RESC(alB);
  finishSM(pB0, pB1, alB, l_reg, pa0, pa1, pa2, pa3); SBAR();
  pv_d0(o, vb0 + 3 * 16384, pa0, pa1, pa2, pa3);
#undef RESC
}
__device__ __forceinline__ void row_inv_l_res(float l_reg, char* lds, int wid, int r32, int hi, float (&rli)[16]) {
  float* li_l = (float*)(lds + RES_WS) + wid * 64;
  if (hi == 0) li_l[r32] = l_reg; asm volatile("s_waitcnt lgkmcnt(0)" ::: "memory");
#pragma unroll
  for (int r = 0; r < 16; ++r) rli[r] = __builtin_amdgcn_rcpf(li_l[crow(r, hi)]);
}
template <bool SILU> __device__ __forceinline__ void store_direct_gated(const f32x16 (&v)[4], char* stg  , bf16_t* Y0  , const bf16_t* G0, int gpitch, int lane, int r32, int hi) {
  bf16_t* st = (bf16_t*)stg;
  const bf16_t* gp = G0 + (size_t)(lane >> 4) * gpitch + (lane & 15) * 8; bf16_t* yp = Y0 + (size_t)(lane >> 4) * DM + (lane & 15) * 8; const bf16_t* sp = st + (lane >> 4) * 128 + (lane & 15) * 8;
  u32x4 g[8];
#pragma unroll
  for (int i = 0; i < 8; ++i) { g[i] = *(const u32x4*)gp; gp += 4 * (size_t)gpitch; asm volatile("" : "+v"(gp)); }
#pragma unroll
  for (int j = 0; j < 4; ++j) {
#pragma unroll
    for (int rr = 0; rr < 4; ++rr)
#pragma unroll
      for (int d0 = 0; d0 < 4; ++d0) st[(rr + 4 * hi) * 128 + d0 * 32 + r32] = (bf16_t)f2bf(v[d0][4 * j + rr]);
    asm volatile("s_waitcnt lgkmcnt(0)" ::: "memory");
#pragma unroll
    for (int i = 0; i < 2; ++i) {
      const u32x4 x = *(const u32x4*)(sp + i * 4 * 128); const u32x4 gg = g[2 * j + i];
      u32x4 w; w.x = pk2(bflo(x.x) * GATE(bflo(gg.x)), bfhi(x.x) * GATE(bfhi(gg.x))); w.y = pk2(bflo(x.y) * GATE(bflo(gg.y)), bfhi(x.y) * GATE(bfhi(gg.y)));
      w.z = pk2(bflo(x.z) * GATE(bflo(gg.z)), bfhi(x.z) * GATE(bfhi(gg.z))); w.w = pk2(bflo(x.w) * GATE(bflo(gg.w)), bfhi(x.w) * GATE(bfhi(gg.w)));
      *(u32x4*)yp = w; yp += 4 * DM; asm volatile("" : "+v"(yp)); }
    asm volatile("s_waitcnt lgkmcnt(0)" ::: "memory");
  }
}
__device__ __forceinline__ void gqa_prompt_slot(const Params& p, char* lds, int bk, const int wid) {
  const int lane = fresh_lane(), r32 = lane & 31, hi = lane >> 5;
  const bf16_t* QC = (const bf16_t*)(p.ws + WS_Q); const bf16_t* PR = (const bf16_t*)(p.ws + WS_PR); bf16_t* Y = (bf16_t*)(p.ws + WS_HY);
  load_kv_resident((const bf16_t*)(p.ws + WS_KP) + (size_t)bk * SEQP * 128, (const bf16_t*)(p.ws + WS_VP) + (size_t)bk * SEQP * 128, lds, wid * 64 + lane);
  __syncthreads();
  const int m0 = (bk >> 2) * SEQP;
  for (int g = 0; g < 4; ++g) {
    const int lane = fresh_lane(), r32 = lane & 31, hi = lane >> 5;
    const int hq = (bk & 3) * 4 + g;
    f32x16 o[4]; float l_reg;
    const size_t row0 = (size_t)(m0 + wid * QBLK);
    attn_core_res<8>(QC + (row0 + r32) * DM + hq * 128 + hi * 8, 0, lds, o, l_reg, wid, lane);
    float rli[16]; row_inv_l_res(l_reg, lds, wid, r32, hi, rli);
#pragma unroll
    for (int d0 = 0; d0 < 4; ++d0)
#pragma unroll
      for (int r = 0; r < 16; ++r) o[d0][r] *= rli[r];
    store_direct_gated<false>(o, lds + RES_EX + wid * 2048, Y + row0 * DM + hq * 128, (const bf16_t*)(p.ws + WS_SG) + row0 * DM + hq * 128, DM, lane, r32, hi);
  }
  __syncthreads();
}
__device__ __forceinline__ void diff_prompt_slot(const Params& p, char* lds, int slot  , float lam, const int wid) {
  const int lane = fresh_lane(), r32 = lane & 31, hi = lane >> 5, rg = wid & 3, mp = wid >> 2;
  const bf16_t* QA = (const bf16_t*)(p.ws + WS_Q); const bf16_t* PR = (const bf16_t*)(p.ws + WS_PR); bf16_t* Y = (bf16_t*)(p.ws + WS_HY);
  for (int hh = 0; hh < 2; ++hh) {
    const int bh = slot * 2 + hh, h = bh & 7, b = bh >> 3;
    load_kv_resident((const bf16_t*)(p.ws + WS_KP) + (size_t)bh * SEQP * 128, (const bf16_t*)(p.ws + WS_VP) + (size_t)bh * SEQP * 128, lds, wid * 64 + lane);
    __syncthreads();
    for (int qb = 0; qb < 2; ++qb) {
      const int lane = fresh_lane(), r32 = lane & 31, hi = lane >> 5;
      const size_t row0 = (size_t)(b * SEQP + qb * 128 + rg * QBLK);
      f32x16 o[4]; float l_reg;
      attn_core_res<4>(QA + (row0 + r32) * 1024 + h * 128 + mp * 64 + hi * 8, mp * 64, lds, o, l_reg, wid, lane);
      float rli[16]; row_inv_l_res(l_reg, lds, wid, r32, hi, rli);
      float* ex = (float*)(lds + RES_EX) + rg * 1024 + lane;
      float ss[16];
#pragma unroll
      for (int r = 0; r < 16; ++r) ss[r] = 0.f;
#pragma unroll
      for (int d0 = 0; d0 < 4; ++d0) {
        if (mp == 1) {
#pragma unroll
          for (int r = 0; r < 16; ++r) ex[r * 64] = o[d0][r] * (rli[r] * lam); }
        __syncthreads();
        if (mp == 0) {
#pragma unroll
          for (int r = 0; r < 16; ++r) { const float v = o[d0][r] * rli[r] - ex[r * 64]; o[d0][r] = v; ss[r] += v * v; } }
        __syncthreads();
      }
      if (mp == 0) {
#pragma unroll
        for (int r = 0; r < 16; ++r) {
#pragma unroll
          for (int of = 1; of < 32; of <<= 1) ss[r] += __shfl_xor(ss[r], of);
          ss[r] = 0.8f / sqrtf(ss[r] * (1.f / 128.f) + EPS); }
#pragma unroll
        for (int d0 = 0; d0 < 4; ++d0) { const float sw = p.subln_w[d0 * 32 + r32];
#pragma unroll
          for (int r = 0; r < 16; ++r) o[d0][r] *= ss[r] * sw; }
        store_direct_gated<false>(o, lds + RES_EX + 16384 + rg * 2048, Y + row0 * DM + h * 128, (const bf16_t*)(p.ws + WS_SG) + row0 * DM + h * 128, DM, lane, r32, hi);
      }
    }
    __syncthreads();
  }
}
__device__ __forceinline__ void gqa_phase(const Params& p, char* lds, int vcu, int G, const int wid, const int mode) {
  for (int v = vcu; v < 256; v += G) {
    if (v < 128) { if (mode & 1) continue;
      const int qb = v & 3, g = (v >> 2) & 3, bk = v >> 4;
      gqa_unit(p, lds, MP + (bk >> 2) * SEQS + qb * 256, (bk & 3) * 4 + g, (const bf16_t*)(p.ws + WS_KSC) + (size_t)bk * LKS * 128, (const bf16_t*)(p.ws + WS_VSC) + (size_t)bk * LKS * 128, LKS, wid); }
    else { if (mode & 2) continue; gqa_prompt_slot(p, lds, v - 128, wid); }
  }
}
__device__ __forceinline__ void diff_unit(const Params& p, char* lds, int m0, int h, const bf16_t* Kh, const bf16_t* Vh, int seq, float lam, const int wid) {
  const int lane = fresh_lane(), r32 = lane & 31, hi = lane >> 5, rg = wid & 3, mp = wid >> 2;
  const bf16_t* QA = (const bf16_t*)(p.ws + WS_Q); const bf16_t* PR = (const bf16_t*)(p.ws + WS_PR); bf16_t* Y = (bf16_t*)(p.ws + WS_HY);
  f32x16 o[4]; float l_reg;
  attn_core<4>(QA + (size_t)(m0 + rg * QBLK + r32) * 1024 + h * 128 + mp * 64 + hi * 8, Kh, Vh, seq, mp * 64, lds, o, l_reg, wid, lane);
  float rli[16]; row_inv_l(l_reg, lds, wid, r32, hi, rli);
  __syncthreads();
  float* ex = (float*)lds + rg * 4096 + lane;
  if (mp == 1) {
#pragma unroll
    for (int d0 = 0; d0 < 4; ++d0)
#pragma unroll
      for (int r = 0; r < 16; ++r) ex[(d0 * 16 + r) * 64] = o[d0][r] * (rli[r] * lam);
  }
  __syncthreads();
  if (mp == 0) {
    float ss[16];
#pragma unroll
    for (int r = 0; r < 16; ++r) ss[r] = 0.f;
#pragma unroll
    for (int d0 = 0; d0 < 4; ++d0)
#pragma unroll
      for (int r = 0; r < 16; ++r) { const float v = o[d0][r] * rli[r] - ex[(d0 * 16 + r) * 64]; o[d0][r] = v; ss[r] += v * v; }
#pragma unroll
    for (int r = 0; r < 16; ++r) {
#pragma unroll
      for (int of = 1; of < 32; of <<= 1) ss[r] += __shfl_xor(ss[r], of);
      ss[r] = 0.8f / sqrtf(ss[r] * (1.f / 128.f) + EPS); }
#pragma unroll
    for (int d0 = 0; d0 < 4; ++d0) { const float sw = p.subln_w[d0 * 32 + r32];
#pragma unroll
      for (int r = 0; r < 16; ++r) o[d0][r] *= ss[r] * sw; }
    const size_t row0 = (size_t)(m0 + rg * QBLK);
    store_rows_gated<false>(o, lds + STG_OFF + rg * 8192, Y + row0 * DM + h * 128, (const bf16_t*)(p.ws + WS_SG) + row0 * DM + h * 128, DM, lane, r32, hi);
  }
  __syncthreads();
}
__device__ __forceinline__ void diff_phase(const Params& p, char* lds, int vcu, int G, const int wid, const int mode) {
  const int lane = fresh_lane();
  const float lam = expf(wave_sum(p.lam_q1[lane] * p.lam_k1[lane])) - expf(wave_sum(p.lam_q2[lane] * p.lam_k2[lane])) + 0.2f;
  for (int v = vcu; v < 256; v += G) {
    if (v < 128) { if (mode & 1) continue;
      const int qb = v & 7, bh = v >> 3;
      diff_unit(p, lds, MP + (bh >> 3) * SEQS + qb * 128, bh & 7, (const bf16_t*)(p.ws + WS_KSA) + (size_t)bh * LKS * 128, (const bf16_t*)(p.ws + WS_VSA) + (size_t)bh * LKS * 128, LKS, lam, wid);
      if (!(mode & 4)) pool_apply_slot(p, v, wid * 64 + fresh_lane()); }
    else { if (mode & 2) continue; diff_prompt_slot(p, lds, v - 128, lam, wid); }
  }
}
#undef KSWZ
#undef SBAR
}

constexpr int NWAVES = 8;
constexpr int RING_OFF = 0, RING_BYTES = 131072;
constexpr int LDSCTL_OFF = RING_BYTES, MISC_OFF = LDSCTL_OFF + 320;
constexpr int LDS_BYTES = 163840;
constexpr int RES_WS_OFF = RING_BYTES + 1024, RES_EX_OFF = RING_BYTES + 4096;
constexpr int CW_BAR = 4096;
#define GAS __attribute__((address_space(1)))
#define LAS __attribute__((address_space(3)))
typedef GAS unsigned gu32;
#define RLX_AGENT __ATOMIC_RELAXED, __HIP_MEMORY_SCOPE_AGENT
#define XB_TMO      128
#define XB_XCNT(j)  (256  + 64 * (j))
#define XB_XSUB(j)  (1280 + 64 * (j))
#define XB_XGEN(j)  (2304 + 64 * (j))
#define XB_TOP      3328
#define XB_TOPGEN   3392
#define XCD_BAR_WORDS 3456
#define XB_SPIN_CAP (1u << 18)
__device__ __forceinline__ unsigned xb_ld(unsigned* p)              { return __hip_atomic_load(p, __ATOMIC_RELAXED, __HIP_MEMORY_SCOPE_AGENT); }
__device__ __forceinline__ unsigned xb_add(unsigned* p, unsigned v) { return __hip_atomic_fetch_add(p, v, __ATOMIC_RELAXED, __HIP_MEMORY_SCOPE_AGENT); }
__device__ __forceinline__ unsigned xb_xcc_id() { return (unsigned)__builtin_amdgcn_s_getreg((3 << 11) | 20) & 0xFu; }
#define XB_SPIN(cond, bar) do { unsigned _sp = 0; while (cond) { __builtin_amdgcn_s_sleep(1); \
    if ((++_sp & 255u) == 0u) { if (xb_ld(&(bar)[XB_TMO])) break; if (_sp > XB_SPIN_CAP) { atomicAdd(&(bar)[XB_TMO], 1u); break; } } } } while (0)
struct XcdBarrier { unsigned* bar; unsigned x; volatile LAS unsigned* st; };
__device__ __forceinline__ XcdBarrier xcd_barrier_post(unsigned* bar, volatile LAS unsigned* st) {
    XcdBarrier b; b.bar = bar; b.x = xb_xcc_id(); b.st = st;
    if (threadIdx.x == 0) (void)xb_add(&bar[XB_XCNT(b.x)], 1u);
    return b;
}
__device__ __forceinline__ void xcd_barrier_complete(unsigned* bar, unsigned x, unsigned& nloc, unsigned& nx) {
    const unsigned G = gridDim.x * gridDim.y * gridDim.z;
    unsigned sum, cnt, mine, sp = 0u;
    for (;;) {
        sum = 0u; cnt = 0u; mine = 0u;
#pragma unroll
        for (unsigned j = 0; j < 16; ++j) { const unsigned c = xb_ld(&bar[XB_XCNT(j)]); sum += c; cnt += (c > 0u) ? 1u : 0u; mine = (j == x) ? c : mine; }
        if (sum == G) break;
        __builtin_amdgcn_s_sleep(1);
        if ((++sp & 255u) == 0u) { if (xb_ld(&bar[XB_TMO])) break; if (sp > XB_SPIN_CAP) { atomicAdd(&bar[XB_TMO], 1u); break; } }
    }
    nloc = mine > 0u ? mine : 1u; nx = cnt > 0u ? cnt : 1u;
}
__device__ __forceinline__ void xcd_barrier(const XcdBarrier& b) {
    asm volatile("s_waitcnt vmcnt(0)" ::: "memory");
    __syncthreads();
    if (threadIdx.x == 0) {
        unsigned* bar = b.bar;
        __builtin_amdgcn_s_waitcnt(0);
        unsigned nloc = b.st[0], nx = b.st[1];
        if (nloc == 0u) { xcd_barrier_complete(bar, b.x, nloc, nx); b.st[0] = nloc; b.st[1] = nx; }
        const unsigned old = xb_add(&bar[XB_XSUB(b.x)], 1u);
        const unsigned gen = old / nloc;
        if (old + 1u == (gen + 1u) * nloc) {
            __builtin_amdgcn_fence(__ATOMIC_RELEASE, "agent");
            asm volatile("s_waitcnt vmcnt(0)" ::: "memory");
            const unsigned og = xb_add(&bar[XB_TOP], 1u);
            const unsigned tg = og / nx;
            if (og + 1u == (tg + 1u) * nx) xb_add(&bar[XB_TOPGEN], 1u);
            else XB_SPIN(xb_ld(&bar[XB_TOPGEN]) == tg, bar);
            __builtin_amdgcn_fence(__ATOMIC_ACQUIRE, "agent");
            xb_add(&bar[XB_XGEN(b.x)], 1u);
            asm volatile("s_waitcnt vmcnt(0)" ::: "memory");
        } else {
            XB_SPIN(xb_ld(&bar[XB_XGEN(b.x)]) == gen, bar);
            __builtin_amdgcn_fence(__ATOMIC_ACQUIRE, "agent");
            asm volatile("s_waitcnt vmcnt(0)" ::: "memory");
        }
    }
    __syncthreads();
}

constexpr size_t WS_SLAB = WS_PR + 40 * MiB;
constexpr size_t CTL_TAIL = 256 * 1024;
template <int KIND> __device__ __forceinline__ void tail_reduce(const Params& p, const pg8::StaticOrder& S, int slot, int wave, int lane) {
    if (S.split <= 1) return;
    const int c = S.c, xcd = c % 8, q = c / 8, split = S.split, ks = q % split, j = (q / split) * 8 + xcd;
    pg8::Unit u; S.tile(S.nfull + j, u);
    unsigned* cnt = (unsigned*)(p.ws + WS_CTL + CTL_TAIL) + slot * 4096 + 64 * j;
    asm volatile("s_waitcnt vmcnt(0)" ::: "memory");
    __syncthreads();
    if (threadIdx.x == 0) {
        __builtin_amdgcn_fence(__ATOMIC_RELEASE, "agent");
        asm volatile("s_waitcnt vmcnt(0)" ::: "memory");
        __hip_atomic_fetch_add(cnt, 1u, __ATOMIC_RELAXED, __HIP_MEMORY_SCOPE_AGENT);
        unsigned sp = 0;
        while (__hip_atomic_load(cnt, __ATOMIC_RELAXED, __HIP_MEMORY_SCOPE_AGENT) < (unsigned)split) { __builtin_amdgcn_s_sleep(1); if (++sp > (1u << 22)) break; }
        __builtin_amdgcn_fence(__ATOMIC_ACQUIRE, "agent");
        asm volatile("s_waitcnt vmcnt(0)" ::: "memory");
    }
    __syncthreads();
    const int R = 256 / split, rpw = R / 8;
    const float* sb = (const float*)(p.ws + WS_SLAB) + (size_t)(j * split) * 65536 + 4 * lane;
    const int col = u.pn * 256 + 4 * lane;
    for (int i = 0; i < rpw; ++i) {
        const int rl = ks * R + wave * rpw + i, r = u.pm * 256 + rl, cr = cond_row(r);
        f32x4 sum = {0.f, 0.f, 0.f, 0.f};
        for (int sidx = 0; sidx < split; ++sidx) sum += *(const f32x4*)(sb + (size_t)sidx * 65536 + (size_t)rl * 256);
        if (KIND == 0) {
            const f32x4 x = *(const f32x4*)(xrow_ptr(p, r) + col), gt = *(const f32x4*)((const float*)(p.ws + WS_MOD) + 4096 + (size_t)cr * 6144 + col), cw = *(const f32x4*)((const float*)(p.ws + WS_CW1) + (size_t)cr * DM + col);
            const f32x4 y = x + gt * sum;
            *(f32x4*)(p.out + (size_t)r * DM + col) = y;
            const f32x4 h = y * cw; u32x2 o; o.x = pk2(h[0], h[1]); o.y = pk2(h[2], h[3]);
            *(u32x2*)((bf16_t*)(p.ws + WS_H1) + (size_t)r * DM + col) = o;
            const float ss = wave_sum((y[0] * y[0] + y[1] * y[1]) + (y[2] * y[2] + y[3] * y[3]));
            if (lane == 0) atomicAdd((float*)(p.ws + WS_RSS) + r, ss);
        } else if (KIND == 1) {
            const f32x4 gt = *(const f32x4*)((const float*)(p.ws + WS_MOD) + 3 * 6144 + 4096 + (size_t)cr * 6144 + col);
            float* op = p.out + (size_t)r * DM + col; *(f32x4*)op = *(const f32x4*)op + gt * sum;
        } else {
            const float rstd = 1.0f / sqrtf(((const float*)(p.ws + WS_RSS))[r] * (1.f / DM) + EPS);
            const f32x4 v = sum * rstd + *(const f32x4*)((const float*)(p.ws + WS_B2P) + (size_t)cr * ODD_IN + col);
            u32x2 o; o.x = pk2(siluf(v[0]), siluf(v[1])); o.y = pk2(siluf(v[2]), siluf(v[3]));
            *(u32x2*)((bf16_t*)(p.ws + WS_SG) + (size_t)r * DM + (col - 12 * 256)) = o;
        }
    }
}

struct MegaArgs { Params p; int ph_lo, ph_hi, mode, pad; };
constexpr int N_PHASES = 11;
#ifndef DUP_PHASE
#define DUP_PHASE -1
#endif
__device__ __forceinline__ Params load_params() {
#if defined(__HIP_DEVICE_COMPILE__)
    typedef __attribute__((address_space(4))) const unsigned long long* KPtr;
    KPtr a = (KPtr)__builtin_amdgcn_kernarg_segment_ptr();
    asm volatile("" : "+s"(a));
    Params p; unsigned long long* d = (unsigned long long*)&p;
#pragma unroll
    for (int i = 0; i < (int)(sizeof(Params) / 8); ++i) d[i] = a[i];
    return p;
#else
    return Params{};
#endif
}
__global__ void __launch_bounds__(NWAVES * 64, 2) mega_fwd(MegaArgs args) {
    extern __shared__ __attribute__((aligned(16))) unsigned char lds[];
    LAS unsigned char* ldsl = (LAS unsigned char*)lds;
    volatile LAS unsigned* MISC = (volatile LAS unsigned*)(ldsl + MISC_OFF);
    const int wave = __builtin_amdgcn_readfirstlane(threadIdx.x >> 6);
    const int G = gridDim.x, bx = blockIdx.x;
    const int vcu = (G % 8 == 0) ? (bx % 8) * (G / 8) + bx / 8 : bx;
    for (int u = threadIdx.x; u < (LDS_BYTES - LDSCTL_OFF) / 4; u += NWAVES * 64) ((LAS unsigned*)(ldsl + LDSCTL_OFF))[u] = 0u;
    __syncthreads();
    XcdBarrier bar; { const Params p0 = load_params(); bar = xcd_barrier_post((unsigned*)(p0.ws + WS_CTL) + CW_BAR, MISC + 8); }
    const int lo = args.ph_lo, hi = args.ph_hi, mode = args.mode;
    const int gw = vcu * NWAVES + wave, ngw = G * NWAVES;
#define IN(k) (lo <= (k) && (k) < hi)
#define SEAM(k) do { if (IN(k) && (IN((k) + 1) || ((k) == 7 && IN(9)) || ((k) == 5 && IN(7)) || ((k) == 2 && IN(4)))) xcd_barrier(bar); } while (0)
    if (IN(0)) {
        const Params p = load_params();
        float* scr = (float*)lds; const int lane = fresh_lane(), tid = wave * 64 + lane;
        if (!(mode & 8)) mod_items(p, scr, bx, G, tid, NWAVES * 64);
        __syncthreads();
        if (!(mode & 16)) weights_items(p, (float*)(lds + wave * 16384), gw, ngw, lane);
        if (!(mode & 32)) caches_rope_items(p, (long)bx * 512 + tid, (long)G * 512);
    }
    SEAM(0);
    if (IN(1)) {
        const Params p = load_params(); unsigned char* const ws = p.ws;
        if (bx < 32) {
            pg8::Gemm g{(const bf16_t*)(ws + WS_POOLW), (const bf16_t*)(ws + WS_WU), 1024, DM, 256, 256, 1024, 0, 256, 0}; pg8::StaticOrder S; S.init(1024, DM, 256, G, bx, false);
            pg8::EpiBf16 E{(bf16_t*)(ws + WS_WINE) + (size_t)3072 * DM, DM, 0};
            pg8::gemm_phase<pg8::EpiBf16, pg8::StaticOrder, true, true>(ldsl + RING_OFF, g, S, E, wave * 64 + fresh_lane());
        } else { const int ln = fresh_lane(), g2 = (bx - 32) * NWAVES + wave, n2 = (G - 32) * NWAVES; modulate_rows(p, 0, g2, n2, ln); mod1_tables(p, g2, n2, ln); }
    }
    SEAM(1);
    if (IN(2)) {
        const Params p = load_params(); unsigned char* const ws = p.ws;
        pg8::Gemm g{(const bf16_t*)(ws + WS_HY), (const bf16_t*)(ws + WS_WINE), MT, EVEN_IN, DM, DM, DM, 0, 0, 0}; pg8::StaticOrder S; S.init(MT, EVEN_IN, DM, G, bx, false);
        float* nak = p.out + (size_t)MT * DM;
        pg8::EpiProj0 E{ws, p.even_q_norm_w, p.even_k_norm_w, nak, nak + (size_t)NBP * HA * SEQP * 128};
        pg8::gemm_phase<pg8::EpiProj0, pg8::StaticOrder, true, true>(ldsl + RING_OFF, g, S, E, wave * 64 + fresh_lane());
    }
    SEAM(2);
    if (IN(4)) { const Params p = load_params(); att::diff_phase(p, (char*)lds, vcu, G, wave, mode); }
    SEAM(4);
    constexpr size_t CTL_PANEL = 320 * 1024;
    const bool stagger = (G == 256) && IN(5) && IN(7);
    if (IN(5)) {
        for (int part = 0; part < (stagger ? 2 : 1); ++part) {
            const Params p = load_params(); unsigned char* const ws = p.ws;
            pg8::Gemm g{(const bf16_t*)(ws + WS_HY), (const bf16_t*)(ws + WS_WOUTE), MT, DM, DM, DM, DM, 0, 0, 0};
            pg8::EpiResid0 E{p.x_prompt, p.x_sample, (const float*)(ws + WS_MOD) + 4096, (const float*)(ws + WS_CW1), p.out, (bf16_t*)(ws + WS_H1), (float*)(ws + WS_RSS), (float*)(ws + WS_SLAB)};
            if (stagger) {
                if (part == 1 && bx >= 64) break;
                pg8::OutOrder S{bx, part};
                pg8::gemm_phase<pg8::EpiResid0, pg8::OutOrder, true, true>(ldsl + RING_OFF, g, S, E, wave * 64 + fresh_lane());
                if (part == 0) xcd_barrier(bar);
                else {
                    asm volatile("s_waitcnt vmcnt(0)" ::: "memory"); __syncthreads();
                    if (threadIdx.x == 0) { __builtin_amdgcn_fence(__ATOMIC_RELEASE, "agent"); asm volatile("s_waitcnt vmcnt(0)" ::: "memory");
                        __hip_atomic_fetch_add((unsigned*)(ws + WS_CTL + CTL_PANEL) + 64 * (bx / 8), 1u, __ATOMIC_RELAXED, __HIP_MEMORY_SCOPE_AGENT); }
                }
            } else {
                pg8::StaticOrder S; S.init(MT, DM, DM, G, bx, false);
                pg8::gemm_phase<pg8::EpiResid0, pg8::StaticOrder, true, true>(ldsl + RING_OFF, g, S, E, wave * 64 + fresh_lane());
            }
        }
    }
    if (!stagger) SEAM(5);
    if (IN(7)) {
        const Params p = load_params(); unsigned char* const ws = p.ws;
        pg8::Gemm g{(const bf16_t*)(ws + WS_H1), (const bf16_t*)(ws + WS_WINO), MT, ODD_IN, DM, DM, DM, 0, 0, 0};
        float* nck = p.out + (size_t)MT * DM + 2 * (size_t)NBP * HA * SEQP * 128;
        pg8::EpiProj1 E{ws, p.gqa_q_norm_w, p.gqa_k_norm_w, nck, nck + (size_t)NBP * KVH * SEQP * 128, (LAS float*)(ldsl + RES_EX_OFF), (float*)(ws + WS_SLAB)};
        if (stagger) { pg8::StaggerOrder S{bx, (const unsigned*)(ws + WS_CTL + CTL_PANEL), true};
            pg8::gemm_phase<pg8::EpiProj1, pg8::StaggerOrder, true, true>(ldsl + RING_OFF, g, S, E, wave * 64 + fresh_lane()); }
        else { pg8::StaticOrder S; S.init(MT, ODD_IN, DM, G, bx, false);
            pg8::gemm_phase<pg8::EpiProj1, pg8::StaticOrder, true, true>(ldsl + RING_OFF, g, S, E, wave * 64 + fresh_lane()); }
    }
    SEAM(7);
    if (IN(9)) { const Params p = load_params(); att::gqa_phase(p, (char*)lds, vcu, G, wave, mode); }
    SEAM(9);
    if (IN(10)) {
        const Params p = load_params(); unsigned char* const ws = p.ws;
        pg8::Gemm g{(const bf16_t*)(ws + WS_HY), (const bf16_t*)(ws + WS_WOUTO), MT, DM, DM, DM, DM, 0, 0, 0};
        pg8::EpiResidF E{p.x_prompt, p.x_sample, p.out, (const float*)(ws + WS_MOD) + 3 * 6144 + 4096, p.out, (float*)(ws + WS_SLAB)};
        if (G == 256) { pg8::LastOrder S{bx}; pg8::gemm_phase<pg8::EpiResidF, pg8::LastOrder, true, true>(ldsl + RING_OFF, g, S, E, wave * 64 + fresh_lane()); }
        else { pg8::StaticOrder S; S.init(MT, DM, DM, G, bx, false); pg8::gemm_phase<pg8::EpiResidF, pg8::StaticOrder, true, true>(ldsl + RING_OFF, g, S, E, wave * 64 + fresh_lane()); }
    }
#undef IN
#undef SEAM
}

#ifndef MK_PER_PHASE
#define MK_PER_PHASE 0
#endif
extern "C" void kernel_launch(void* const* d_in, const int* in_sizes, int n_in, void* d_out, int out_size, void* d_ws, size_t ws_size, hipStream_t stream) {
    if (n_in != 26 || ws_size < WS_END || out_size != MT * DM + 2 * NBP * HA * SEQP * 128 + 2 * NBP * KVH * SEQP * 128) {
        fprintf(stderr, "kernel_launch: unexpected shapes n_in %d ws %zu out %d\n", n_in, ws_size, out_size); return; }
    static int ready = 0;
    if (!ready) {
        if (hipFuncSetAttribute((const void*)mega_fwd, hipFuncAttributeMaxDynamicSharedMemorySize, LDS_BYTES) != hipSuccess) { fprintf(stderr, "kernel_launch: hipFuncSetAttribute failed\n"); return; }
        ready = 1;
    }
    MegaArgs a{};
    const float** pin = (const float**)&a.p;
    for (int i = 0; i < 26; ++i) pin[i] = (const float*)d_in[i];
    a.p.out = (float*)d_out; a.p.ws = (unsigned char*)d_ws;
#ifdef EXTRA_PHASE
    (void)hipMemsetAsync((unsigned char*)d_ws + WS_CTL, 0, 2 * MiB, stream);
    a.ph_lo = EXTRA_PHASE; a.ph_hi = EXTRA_PHASE + 1; hipLaunchKernelGGL(mega_fwd, dim3(256), dim3(NWAVES * 64), LDS_BYTES, stream, a);
#endif
    (void)hipMemsetAsync((unsigned char*)d_ws + WS_CTL, 0, 2 * MiB, stream);
#if MK_PER_PHASE
    for (int ph = 0; ph < N_PHASES; ++ph) { a.ph_lo = ph; a.ph_hi = ph + 1; hipLaunchKernelGGL(mega_fwd, dim3(256), dim3(NWAVES * 64), LDS_BYTES, stream, a); }
#else
    a.ph_lo = 0; a.ph_hi = N_PHASES; hipLaunchKernelGGL(mega_fwd, dim3(256), dim3(NWAVES * 64), LDS_BYTES, stream, a);
#endif
#ifdef EXTRA_AFTER
    (void)hipMemsetAsync((unsigned char*)d_ws + WS_CTL, 0, 1 * MiB, stream);
    a.ph_lo = EXTRA_AFTER; a.ph_hi = EXTRA_AFTER + 1; a.mode = EXTRA_MODE; hipLaunchKernelGGL(mega_fwd, dim3(256), dim3(NWAVES * 64), LDS_BYTES, stream, a);
#endif
}
```

```cpp
#include <hip/hip_runtime.h>
#include <cstdio>
#include <cstdint>

typedef unsigned short bf16_t;
typedef float f32x4 __attribute__((ext_vector_type(4)));
typedef unsigned u32x4 __attribute__((ext_vector_type(4)));
typedef unsigned u32x2 __attribute__((ext_vector_type(2)));

constexpr int DM = 2048, NBP = 32, SEQP = 256, NBS = 2, SEQS = 1024, PAST = 256;
constexpr int MP = NBP * SEQP, MS = NBS * SEQS, MT = MP + MS;
constexpr int HA = 8, DKA = 64, DVA = 128, WA = 1024, WB = 1024, GWB = 256;
constexpr int EVEN_IN = 6144, ODD_IN = 5120;
constexpr int HC = 16, KVH = 4, HDC = 128;
constexpr int LKS = PAST + SEQS;
constexpr float EPS = 1e-6f;
constexpr float LOG2E = 1.4426950408889634f;
constexpr float C2A = 0.125f * LOG2E;
constexpr float C2C = 0.08838834764831845f * LOG2E;

constexpr size_t MiB = 1u << 20;
constexpr size_t WS_CTL = 0;
constexpr size_t WS_MOD = 1 * MiB;
constexpr size_t WS_ROPE = 2 * MiB;
constexpr size_t WS_WINE = 4 * MiB;
constexpr size_t WS_WOUTE = 28 * MiB;
constexpr size_t WS_WINO = 36 * MiB;
constexpr size_t WS_WOUTO = 56 * MiB;
constexpr size_t WS_POOLW = 64 * MiB;
constexpr size_t WS_HY = 65 * MiB;
constexpr size_t WS_PR = 105 * MiB;
constexpr size_t WS_Q = 225 * MiB;
constexpr size_t WS_KP = 265 * MiB;
constexpr size_t WS_VP = 281 * MiB;
constexpr size_t WS_KSA = 297 * MiB;
constexpr size_t WS_VSA = 302 * MiB;
constexpr size_t WS_KSC = 307 * MiB;
constexpr size_t WS_VSC = 310 * MiB;
constexpr size_t WS_UA = 313 * MiB;
constexpr size_t WS_SG = WS_PR;
constexpr size_t WS_U = WS_PR + 40 * MiB;
constexpr size_t WS_H1 = 333 * MiB;
constexpr size_t WS_WU = WS_UA;
constexpr size_t WS_END = 373 * MiB;
constexpr size_t WS_CW1 = WS_MOD + 256 * 1024;
constexpr size_t WS_B2P = WS_MOD + 320 * 1024;
constexpr size_t WS_RSS = WS_MOD + 512 * 1024;

struct Params {
    const float* x_prompt; const float* x_sample; const float* cache_a_k; const float* cache_a_v; const float* cache_c_k; const float* cache_c_v;
    const float* c; const float* c_ctx; const float* norm_w; const float* ada_w; const float* ada_b;
    const float* even_w_in; const float* even_q_norm_w; const float* even_k_norm_w; const float* lam_q1; const float* lam_k1; const float* lam_q2; const float* lam_k2;
    const float* subln_w; const float* pool_w; const float* pool_scale; const float* even_w_out;
    const float* gqa_w_in; const float* gqa_q_norm_w; const float* gqa_k_norm_w; const float* gqa_w_out;
    float* out; unsigned char* ws;
};

__device__ __forceinline__ unsigned f2bf(float f) { unsigned u = __builtin_bit_cast(unsigned, f); return (u + 0x7fffu + ((u >> 16) & 1u)) >> 16; }
__device__ __forceinline__ unsigned pk2(float lo, float hi) { return f2bf(lo) | (f2bf(hi) << 16); }
__device__ __forceinline__ float bf2f(unsigned h) { return __builtin_bit_cast(float, h << 16); }
__device__ __forceinline__ float bflo(unsigned w) { return __builtin_bit_cast(float, w << 16); }
__device__ __forceinline__ float bfhi(unsigned w) { return __builtin_bit_cast(float, w & 0xffff0000u); }
__device__ __forceinline__ float siluf(float x) { return x / (1.f + __expf(-x)); }
__device__ __forceinline__ float wave_sum(float v) {
#pragma unroll
    for (int o = 1; o < 64; o <<= 1) v += __shfl_xor(v, o);
    return v;
}
__device__ __forceinline__ float wave_max(float v) {
#pragma unroll
    for (int o = 1; o < 64; o <<= 1) v = fmaxf(v, __shfl_xor(v, o));
    return v;
}
__device__ __forceinline__ int fresh_lane() { int l; asm volatile("v_mbcnt_lo_u32_b32 %0, -1, 0\n\tv_mbcnt_hi_u32_b32 %0, -1, %0" : "=v"(l)); return l; }
__device__ __forceinline__ const float* xrow_ptr(const Params& p, int m) { return m < MP ? p.x_prompt + (size_t)m * DM : p.x_sample + (size_t)(m - MP) * DM; }
__device__ __forceinline__ int cond_row(int m) { return m < MP ? 0 : 1 + ((m - MP) >> 10); }

__device__ __forceinline__ void mod_items(const Params& p, float* sl  , int bid, int nb, int tid, int nthr) {
    float* mod = (float*)(p.ws + WS_MOD);
    for (int it = bid; it < 256; it += nb) {
        const int l = it >> 7, kc = (it >> 2) & 31, nc = it & 3;
        __syncthreads();
        for (int i = tid; i < 192; i += nthr) { const int r = i >> 6, kk = i & 63, k = kc * 64 + kk; const float cv = r == 0 ? p.c_ctx[k] : p.c[(r - 1) * DM + k]; sl[i] = siluf(cv); }
        __syncthreads();
        for (int q = tid; q < 384; q += nthr) {
            const int n = nc * 1536 + q * 4;
            const float* w = p.ada_w + ((size_t)l * DM + kc * 64) * 6144 + n;
            f32x4 a0 = {0.f, 0.f, 0.f, 0.f}, a1 = a0, a2 = a0;
#pragma unroll 1
            for (int k0 = 0; k0 < 64; k0 += 32) { f32x4 wv[32];
#pragma unroll
                for (int kk = 0; kk < 32; ++kk) wv[kk] = __builtin_nontemporal_load((const f32x4*)(w + (size_t)(k0 + kk) * 6144));
#pragma unroll
                for (int kk = 0; kk < 32; ++kk) { a0 += wv[kk] * sl[k0 + kk]; a1 += wv[kk] * sl[64 + k0 + kk]; a2 += wv[kk] * sl[128 + k0 + kk]; } }
            if (kc == 0) { const f32x4 b = *(const f32x4*)(p.ada_b + l * 6144 + n); a0 += b; a1 += b; a2 += b; }
            float* m0 = mod + (size_t)(l * 3) * 6144 + n;
#pragma unroll
            for (int e = 0; e < 4; ++e) { atomicAdd(m0 + e, a0[e]); atomicAdd(m0 + 6144 + e, a1[e]); atomicAdd(m0 + 2 * 6144 + e, a2[e]); }
        }
    }
}

__device__ __forceinline__ void transpose_item(const float* W, int K, int N, bf16_t* WT, float* scr, int item, int lane) {
    const int nblk = N / 32, kb = item / nblk, nb = item % nblk, k0 = 64 * kb, n0 = 32 * nb;
#pragma unroll 8
    for (int i = 0; i < 32; ++i) { const int kk = 2 * i + (lane >> 5); scr[kk * 33 + (lane & 31)] = W[(size_t)(k0 + kk) * N + n0 + (lane & 31)]; }
    __builtin_amdgcn_s_waitcnt(0xc07f); asm volatile("" ::: "memory");
    const int c = lane & 7;
#pragma unroll
    for (int j = 0; j < 4; ++j) { const int n = (lane >> 3) + 8 * j; const float* s = scr + (8 * c) * 33 + n;
        u32x4 o; o.x = pk2(s[0 * 33], s[1 * 33]); o.y = pk2(s[2 * 33], s[3 * 33]); o.z = pk2(s[4 * 33], s[5 * 33]); o.w = pk2(s[6 * 33], s[7 * 33]);
        *(u32x4*)(WT + (size_t)(n0 + n) * K + k0 + 8 * c) = o; }
    __builtin_amdgcn_s_waitcnt(0xc07f); asm volatile("" ::: "memory");
}
template <int PERMK> __device__ __forceinline__ int pos_of_col(int n) {
    if (PERMK == 1) { if (n >= 2048) return n; const int c = n & 255, wc = c >> 6, dim = c & 63, q = dim >> 4, ii = dim & 15; return (n & ~255) + 128 * (q & 1) + 32 * wc + (q >> 1) * 16 + ii; }
    if (PERMK == 2) { if (n >= 2560) return n; const int c = n & 255, hl = c >> 7, dim = c & 127, qd = dim >> 5, i = dim & 31; return (n & ~255) + 128 * (qd & 1) + 32 * (2 * hl + (qd >> 1)) + i; }
    return n;
}
template <int PERMK> __device__ __forceinline__ void transpose_item64(const float* W, int K, int N, bf16_t* WT, bf16_t* scr, int item, int lane) {
    const int nblk = N / 64, kb = item / nblk, nb = item % nblk, k0 = 64 * kb, n0 = 64 * nb;
    const int nq = lane & 15, kr = lane >> 4;
    f32x4 v[16];
    const float* src = W + (size_t)(k0 + kr) * N + n0 + 4 * nq;
#pragma unroll
    for (int i = 0; i < 16; ++i) v[i] = *(const f32x4*)(src + (size_t)(4 * i) * N);
#pragma unroll
    for (int i = 0; i < 16; ++i) { const int k = 4 * i + kr;
#pragma unroll
        for (int e = 0; e < 4; ++e) scr[(4 * nq + e) * 72 + k] = (bf16_t)f2bf(v[i][e]); }
    __builtin_amdgcn_s_waitcnt(0xc07f); asm volatile("" ::: "memory");
#pragma unroll
    for (int j = 0; j < 8; ++j) { const int idx = lane + 64 * j, n = idx >> 3, c = idx & 7;
        *(u32x4*)(WT + (size_t)pos_of_col<PERMK>(n0 + n) * K + k0 + 8 * c) = *(const u32x4*)(scr + n * 72 + 8 * c); }
    __builtin_amdgcn_s_waitcnt(0xc07f); asm volatile("" ::: "memory");
}
__device__ __forceinline__ void convert_item64(const float* W, int N, bf16_t* WU, int ldu, int ncol0, int item, int nblk0, int lane) {
    const int nblk = N / 64, kb = item / nblk, nb = item % nblk, k0 = 64 * kb, n0 = 64 * nb;
    const int nq = lane & 15, kr = lane >> 4;
    const float* src = W + (size_t)(k0 + kr) * N + n0 + 4 * nq;
    f32x4 v[16];
#pragma unroll
    for (int i = 0; i < 16; ++i) v[i] = *(const f32x4*)(src + (size_t)(4 * i) * N);
#pragma unroll
    for (int i = 0; i < 16; ++i) { u32x2 o; o.x = pk2(v[i][0], v[i][1]); o.y = pk2(v[i][2], v[i][3]); *(u32x2*)(WU + (size_t)(k0 + 4 * i + kr) * ldu + (n0 - ncol0) + 4 * nq) = o; }
}
__device__ __forceinline__ void weights_items(const Params& p, float* scrf  , int gw, int ngw, int lane) {
    bf16_t* scr = (bf16_t*)scrf;
    constexpr int I_WINE = 32 * (EVEN_IN / 64), I_WOUT = 32 * (DM / 64), I_WINO = 32 * (ODD_IN / 64), I_POOL = 4 * 4;
    constexpr int NITEMS = I_WINE + I_WOUT + I_WINO + I_WOUT + 4 * I_POOL;
    for (int it = gw; it < NITEMS; it += ngw) {
        int r = it;
        if (r < I_WINE) { const int nb = r % (EVEN_IN / 64);
            if (nb >= 48 && nb < 64) convert_item64(p.even_w_in, EVEN_IN, (bf16_t*)(p.ws + WS_WU), 1024, 3072, r, 0, lane);
            else transpose_item64<1>(p.even_w_in, DM, EVEN_IN, (bf16_t*)(p.ws + WS_WINE), scr, r, lane);
            continue; } r -= I_WINE;
        if (r < I_WOUT) { transpose_item64<0>(p.even_w_out, DM, DM, (bf16_t*)(p.ws + WS_WOUTE), scr, r, lane); continue; } r -= I_WOUT;
        if (r < I_WINO) { transpose_item64<2>(p.gqa_w_in, DM, ODD_IN, (bf16_t*)(p.ws + WS_WINO), scr, r, lane); continue; } r -= I_WINO;
        if (r < I_WOUT) { transpose_item64<0>(p.gqa_w_out, DM, DM, (bf16_t*)(p.ws + WS_WOUTO), scr, r, lane); continue; } r -= I_WOUT;
        const int g = r / I_POOL; r -= g * I_POOL;
        transpose_item64<0>(p.pool_w + (size_t)g * 65536, 256, 256, (bf16_t*)(p.ws + WS_POOLW) + (size_t)g * 65536, scr, r, lane);
    }
}
__device__ __forceinline__ void caches_rope_items(const Params& p, long gt, long ngt) {
    constexpr long NA = 2L * 8 * 256 * 128 / 4, NC = 2L * 4 * 256 * 128 / 4;
    for (long i = gt; i < 2 * NA + 2 * NC; i += ngt) {
        long j = i; const float* src; bf16_t* dst;
        if (j < NA) { src = p.cache_a_k; dst = (bf16_t*)(p.ws + WS_KSA); } else if ((j -= NA) < NA) { src = p.cache_a_v; dst = (bf16_t*)(p.ws + WS_VSA); }
        else if ((j -= NA) < NC) { src = p.cache_c_k; dst = (bf16_t*)(p.ws + WS_KSC); } else { j -= NC; src = p.cache_c_v; dst = (bf16_t*)(p.ws + WS_VSC); }
        const long e = j * 4, bh = e / (256 * 128), rem = e % (256 * 128);
        const f32x4 v = *(const f32x4*)(src + e);
        u32x2 o; o.x = pk2(v[0], v[1]); o.y = pk2(v[2], v[3]);
        *(u32x2*)(dst + bh * (LKS * 128) + rem) = o;
    }
    float* ropeA = (float*)(p.ws + WS_ROPE); float* ropeC = ropeA + 2 * 1024 * 64;
    for (long i = gt; i < 1024L * 64 + 1024L * 128; i += ngt) {
        const bool isA = i < 1024L * 64; const long j = isA ? i : i - 1024L * 64; const int dim = isA ? 64 : 128, quarter = dim / 4;
        const int t = (int)(j / dim), d = (int)(j % dim); const int qd = d / quarter, fi = d % quarter;
        const float freq = powf(10000.0f, -(float)fi / (float)quarter);
        const float pos = (qd < 2) ? (float)(t / 64) : (float)(t % 64);
        const float ang = pos * freq;
        float* base = isA ? ropeA : ropeC;
        base[j] = cosf(ang); base[(size_t)1024 * dim + j] = sinf(ang);
    }
}

__device__ __forceinline__ void modulate_rows(const Params& p, int layer, int gw, int ngw, int lane) {
    const float* mod = (const float*)(p.ws + WS_MOD) + (size_t)layer * 3 * 6144;
    const float* nw = p.norm_w + layer * DM;
    bf16_t* H = (bf16_t*)(p.ws + WS_HY);
    f32x4 cw[8], sh[8]; int cur_cr = -1;
    for (int m = gw; m < MT; m += ngw) {
        const float* xr = layer == 0 ? xrow_ptr(p, m) : p.out + (size_t)m * DM;
        f32x4 v[8]; float ss = 0.f;
#pragma unroll
        for (int j = 0; j < 8; ++j) { v[j] = __builtin_nontemporal_load((const f32x4*)(xr + 4 * lane + 256 * j)); ss += (v[j][0] * v[j][0] + v[j][1] * v[j][1]) + (v[j][2] * v[j][2] + v[j][3] * v[j][3]); }
        const int cr = cond_row(m);
        if (cr != cur_cr) { cur_cr = cr; const float* mr = mod + (size_t)cr * 6144;
#pragma unroll
            for (int j = 0; j < 8; ++j) { const int k = 4 * lane + 256 * j; cw[j] = *(const f32x4*)(nw + k) * (*(const f32x4*)(mr + 2048 + k) + 1.0f); sh[j] = *(const f32x4*)(mr + k); } }
        const float rstd = 1.0f / sqrtf(wave_sum(ss) * (1.f / DM) + EPS);
#pragma unroll
        for (int j = 0; j < 8; ++j) { const int k = 4 * lane + 256 * j;
            const f32x4 h = v[j] * rstd * cw[j] + sh[j];
            u32x2 o; o.x = pk2(h[0], h[1]); o.y = pk2(h[2], h[3]);
            *(u32x2*)(H + (size_t)m * DM + k) = o; }
    }
}

__device__ __forceinline__ void mod1_tables(const Params& p, int gw, int ngw, int lane) {
    const float* mod1 = (const float*)(p.ws + WS_MOD) + 3 * 6144;
    float* cw1 = (float*)(p.ws + WS_CW1); float* b2p = (float*)(p.ws + WS_B2P);
    for (int i = gw * 64 + lane; i < 3 * DM; i += ngw * 64) { const int cr = i / DM, k = i % DM; cw1[i] = p.norm_w[DM + k] * (1.f + mod1[cr * 6144 + 2048 + k]); }
    const bf16_t* W = (const bf16_t*)(p.ws + WS_WINO);
    for (int r = gw; r < ODD_IN; r += ngw) {
        float a0 = 0.f, a1 = 0.f, a2 = 0.f;
#pragma unroll
        for (int j = 0; j < 4; ++j) { const int k = 8 * lane + 512 * j; const u32x4 w = *(const u32x4*)(W + (size_t)r * DM + k);
            const float wf[8] = {bflo(w.x), bfhi(w.x), bflo(w.y), bfhi(w.y), bflo(w.z), bfhi(w.z), bflo(w.w), bfhi(w.w)};
#pragma unroll
            for (int e = 0; e < 8; ++e) { a0 += wf[e] * mod1[k + e]; a1 += wf[e] * mod1[6144 + k + e]; a2 += wf[e] * mod1[2 * 6144 + k + e]; } }
        a0 = wave_sum(a0); a1 = wave_sum(a1); a2 = wave_sum(a2);
        if (lane == 0) { b2p[r] = a0; b2p[ODD_IN + r] = a1; b2p[2 * ODD_IN + r] = a2; }
    }
}
template <int DIM>
__device__ __forceinline__ f32x4 norm_rope4(f32x4 v, int lg  , const float* w, bool rope, const float* cosr, const float* sinr) {
    float ss = (v[0] * v[0] + v[1] * v[1]) + (v[2] * v[2] + v[3] * v[3]);
#pragma unroll
    for (int o = 1; o < DIM / 4; o <<= 1) ss += __shfl_xor(ss, o);
    const float r = 1.0f / sqrtf(ss * (1.f / DIM) + EPS);
    const f32x4 wv = *(const f32x4*)(w + 4 * lg);
    f32x4 y = v * r * wv;
    f32x4 pr;
#pragma unroll
    for (int e = 0; e < 4; ++e) pr[e] = __shfl_xor(y[e], DIM / 16);
    if (rope) {
        const f32x4 cs = *(const f32x4*)(cosr + 4 * lg), sn = *(const f32x4*)(sinr + 4 * lg);
        const bool odd = ((lg / (DIM / 16)) & 1) != 0;
        y = odd ? (y * cs + pr * sn) : (y * cs - pr * sn);
    }
    return y;
}

__device__ __forceinline__ void post0_rows(const Params& p, int gw, int ngw, int lane) {
    const bf16_t* PR = (const bf16_t*)(p.ws + WS_PR);
    bf16_t* QA = (bf16_t*)(p.ws + WS_Q); bf16_t* UA = (bf16_t*)(p.ws + WS_UA);
    const float* ropeA = (const float*)(p.ws + WS_ROPE);
    float* new_a_k = p.out + (size_t)MT * DM; float* new_a_v = new_a_k + (size_t)NBP * HA * SEQP * 128;
    for (int m = gw; m < MT; m += ngw) {
        const bool smp = m >= MP; const int b = smp ? (m - MP) >> 10 : m >> 8, t = smp ? (m - MP) & 1023 : m & 255;
        const bf16_t* pr = PR + (size_t)m * EVEN_IN;
        const float* cosr = ropeA + (size_t)t * 64; const float* sinr = ropeA + 1024 * 64 + (size_t)t * 64;
        const int sub = lane >> 4, lg = lane & 15;
#pragma unroll 2
        for (int st = 0; st < 8; ++st) {
            const int grp = st * 4 + sub;
            const u32x2 raw = *(const u32x2*)(pr + grp * 64 + 4 * lg);
            f32x4 v = {bflo(raw.x), bfhi(raw.x), bflo(raw.y), bfhi(raw.y)};
            const bool isk = grp >= 16;
            f32x4 y = norm_rope4<64>(v, lg, isk ? p.even_k_norm_w : p.even_q_norm_w, smp, cosr, sinr);
            if (!isk) { y = y * C2A; u32x2 o; o.x = pk2(y[0], y[1]); o.y = pk2(y[2], y[3]); *(u32x2*)(QA + (size_t)m * 1024 + grp * 64 + 4 * lg) = o; }
            else { const int g2 = grp - 16, h = g2 >> 1, j = g2 & 1;
                u32x2 o; o.x = pk2(y[0], y[1]); o.y = pk2(y[2], y[3]);
                if (smp) *(u32x2*)((bf16_t*)(p.ws + WS_KSA) + ((size_t)(b * HA + h) * LKS + PAST + t) * 128 + j * 64 + 4 * lg) = o;
                else { const size_t off = ((size_t)(b * HA + h) * SEQP + t) * 128 + j * 64 + 4 * lg; *(u32x2*)((bf16_t*)(p.ws + WS_KP) + off) = o; *(f32x4*)(new_a_k + off) = y; } }
        }
#pragma unroll
        for (int i = 0; i < 2; ++i) { const int c = 8 * lane + 512 * i, h = c >> 7, d = c & 127;
            const u32x4 raw = *(const u32x4*)(pr + 2048 + c);
            if (smp) *(u32x4*)((bf16_t*)(p.ws + WS_VSA) + ((size_t)(b * HA + h) * LKS + PAST + t) * 128 + d) = raw;
            else { const size_t off = ((size_t)(b * HA + h) * SEQP + t) * 128 + d; *(u32x4*)((bf16_t*)(p.ws + WS_VP) + off) = raw;
                *(f32x4*)(new_a_v + off) = (f32x4){bflo(raw.x), bfhi(raw.x), bflo(raw.y), bfhi(raw.y)}; *(f32x4*)(new_a_v + off + 4) = (f32x4){bflo(raw.z), bfhi(raw.z), bflo(raw.w), bfhi(raw.w)}; } }
        const int L = smp ? SEQS : SEQP;
#pragma unroll
        for (int i = 0; i < 2; ++i) { const int ch = lane + 64 * i, c = 8 * ch, g = ch >> 5, half = 1 << g;
            const int lo = max(t - half, 0), hi = min(t + half, L);
            float s[8] = {0.f, 0.f, 0.f, 0.f, 0.f, 0.f, 0.f, 0.f};
            for (int tt = lo; tt < hi; ++tt) { const u32x4 raw = *(const u32x4*)(pr + (ptrdiff_t)(tt - t) * EVEN_IN + 3072 + c);
                s[0] += bflo(raw.x); s[1] += bfhi(raw.x); s[2] += bflo(raw.y); s[3] += bfhi(raw.y); s[4] += bflo(raw.z); s[5] += bfhi(raw.z); s[6] += bflo(raw.w); s[7] += bfhi(raw.w); }
            const float inv = 1.0f / (float)(hi - lo);
            const u32x4 own = *(const u32x4*)(pr + 3072 + c);
            u32x4 o; o.x = pk2(s[0] * inv - bflo(own.x), s[1] * inv - bfhi(own.x)); o.y = pk2(s[2] * inv - bflo(own.y), s[3] * inv - bfhi(own.y));
            o.z = pk2(s[4] * inv - bflo(own.z), s[5] * inv - bfhi(own.z)); o.w = pk2(s[6] * inv - bflo(own.w), s[7] * inv - bfhi(own.w));
            *(u32x4*)(UA + (size_t)m * 1024 + c) = o; }
    }
}

__device__ __forceinline__ void pool_rows(const Params& p, int gw, int ngw, int lane) {
    const bf16_t* U = (const bf16_t*)(p.ws + WS_U); bf16_t* UA = (bf16_t*)(p.ws + WS_UA);
    for (int m = gw; m < MT; m += ngw) {
        const bool smp = m >= MP; const int t = smp ? (m - MP) & 1023 : m & 255, L = smp ? SEQS : SEQP;
        const bf16_t* pr = U + (size_t)m * 1024;
#pragma unroll
        for (int i = 0; i < 2; ++i) { const int ch = lane + 64 * i, c = 8 * ch, g = ch >> 5, half = 1 << g;
            const int lo = max(t - half, 0), hi = min(t + half, L);
            float s[8] = {0.f, 0.f, 0.f, 0.f, 0.f, 0.f, 0.f, 0.f};
            for (int tt = lo; tt < hi; ++tt) { const u32x4 raw = *(const u32x4*)(pr + (ptrdiff_t)(tt - t) * 1024 + c);
                s[0] += bflo(raw.x); s[1] += bfhi(raw.x); s[2] += bflo(raw.y); s[3] += bfhi(raw.y); s[4] += bflo(raw.z); s[5] += bfhi(raw.z); s[6] += bflo(raw.w); s[7] += bfhi(raw.w); }
            const float inv = 1.0f / (float)(hi - lo);
            const u32x4 own = *(const u32x4*)(pr + c);
            u32x4 o; o.x = pk2(s[0] * inv - bflo(own.x), s[1] * inv - bfhi(own.x)); o.y = pk2(s[2] * inv - bflo(own.y), s[3] * inv - bfhi(own.y));
            o.z = pk2(s[4] * inv - bflo(own.z), s[5] * inv - bfhi(own.z)); o.w = pk2(s[6] * inv - bflo(own.w), s[7] * inv - bfhi(own.w));
            *(u32x4*)(UA + (size_t)m * 1024 + c) = o; }
    }
}
__device__ __forceinline__ void post1_rows(const Params& p, int gw, int ngw, int lane) {
    const bf16_t* PR = (const bf16_t*)(p.ws + WS_PR);
    bf16_t* QC = (bf16_t*)(p.ws + WS_Q);
    const float* ropeC = (const float*)(p.ws + WS_ROPE) + 2 * 1024 * 64;
    float* new_c_k = p.out + (size_t)MT * DM + 2 * (size_t)NBP * HA * SEQP * 128; float* new_c_v = new_c_k + (size_t)NBP * KVH * SEQP * 128;
    for (int m = gw; m < MT; m += ngw) {
        const bool smp = m >= MP; const int b = smp ? (m - MP) >> 10 : m >> 8, t = smp ? (m - MP) & 1023 : m & 255;
        const bf16_t* pr = PR + (size_t)m * ODD_IN;
        const float* cosr = ropeC + (size_t)t * 128; const float* sinr = ropeC + 1024 * 128 + (size_t)t * 128;
        const int sub = lane >> 5, lg = lane & 31;
#pragma unroll 2
        for (int st = 0; st < 10; ++st) {
            const int grp = st * 2 + sub;
            const u32x2 raw = *(const u32x2*)(pr + grp * 128 + 4 * lg);
            f32x4 v = {bflo(raw.x), bfhi(raw.x), bflo(raw.y), bfhi(raw.y)};
            const bool isk = grp >= 16;
            f32x4 y = norm_rope4<128>(v, lg, isk ? p.gqa_k_norm_w : p.gqa_q_norm_w, smp, cosr, sinr);
            if (!isk) { y = y * C2C; u32x2 o; o.x = pk2(y[0], y[1]); o.y = pk2(y[2], y[3]); *(u32x2*)(QC + (size_t)m * DM + grp * 128 + 4 * lg) = o; }
            else { const int kh = grp - 16;
                u32x2 o; o.x = pk2(y[0], y[1]); o.y = pk2(y[2], y[3]);
                if (smp) *(u32x2*)((bf16_t*)(p.ws + WS_KSC) + ((size_t)(b * KVH + kh) * LKS + PAST + t) * 128 + 4 * lg) = o;
                else { const size_t off = ((size_t)(b * KVH + kh) * SEQP + t) * 128 + 4 * lg; *(u32x2*)((bf16_t*)(p.ws + WS_KP) + off) = o; *(f32x4*)(new_c_k + off) = y; } }
        }
        { const int c = 8 * lane, kh = c >> 7, d = c & 127;
            const u32x4 raw = *(const u32x4*)(pr + 2560 + c);
            if (smp) *(u32x4*)((bf16_t*)(p.ws + WS_VSC) + ((size_t)(b * KVH + kh) * LKS + PAST + t) * 128 + d) = raw;
            else { const size_t off = ((size_t)(b * KVH + kh) * SEQP + t) * 128 + d; *(u32x4*)((bf16_t*)(p.ws + WS_VP) + off) = raw;
                *(f32x4*)(new_c_v + off) = (f32x4){bflo(raw.x), bfhi(raw.x), bflo(raw.y), bfhi(raw.y)}; *(f32x4*)(new_c_v + off + 4) = (f32x4){bflo(raw.z), bfhi(raw.z), bflo(raw.w), bfhi(raw.w)}; } }
    }
}

struct EpiStoreBf16 { bf16_t* C; int ldc; int pad; __device__ void operator()(int r, int c, float v) const { C[(size_t)r * ldc + c] = (bf16_t)f2bf(v); } };
struct EpiPool { bf16_t* Y; const bf16_t* PR; const float* pscale; int g; int pad;
    __device__ void operator()(int r, int c, float v) const { const int cc = g * 256 + c; const float gt = bf2f(PR[(size_t)r * EVEN_IN + 4096 + 1024 + cc]);
        Y[(size_t)r * DM + 1024 + cc] = (bf16_t)f2bf(v * pscale[cc] * siluf(gt)); } };
struct EpiResid { const float* x_prompt; const float* x_sample; const float* base; const float* gate; float* out;
    __device__ void operator()(int r, int c, float v) const { const float bs = base ? base[(size_t)r * DM + c] : (r < MP ? x_prompt[(size_t)r * DM + c] : x_sample[(size_t)(r - MP) * DM + c]);
        out[(size_t)r * DM + c] = bs + gate[(size_t)cond_row(r) * 6144 + c] * v; } };
template <class Epi>
__global__ __launch_bounds__(256) void gemm_naive(const bf16_t* A, int lda, const bf16_t* Bt, int ldb, int M, int N, int K, Epi E) {
    __shared__ float As[16][65], Bs[16][65];
    const int tid = threadIdx.x, tx = tid & 15, ty = tid >> 4;
    const int nbn = N / 64, bm = blockIdx.x / nbn, bn = blockIdx.x % nbn;
    float acc[4][4] = {};
    const int lr = tid >> 2, lc = (tid & 3) * 4;
    for (int k0 = 0; k0 < K; k0 += 16) {
        const u32x2 ra = *(const u32x2*)(A + (size_t)(bm * 64 + lr) * lda + k0 + lc), rb = *(const u32x2*)(Bt + (size_t)(bn * 64 + lr) * ldb + k0 + lc);
        __syncthreads();
        As[lc + 0][lr] = bflo(ra.x); As[lc + 1][lr] = bfhi(ra.x); As[lc + 2][lr] = bflo(ra.y); As[lc + 3][lr] = bfhi(ra.y);
        Bs[lc + 0][lr] = bflo(rb.x); Bs[lc + 1][lr] = bfhi(rb.x); Bs[lc + 2][lr] = bflo(rb.y); Bs[lc + 3][lr] = bfhi(rb.y);
        __syncthreads();
#pragma unroll
        for (int kk = 0; kk < 16; ++kk) { float a[4], b[4];
#pragma unroll
            for (int i = 0; i < 4; ++i) { a[i] = As[kk][ty * 4 + i]; b[i] = Bs[kk][tx * 4 + i]; }
#pragma unroll
            for (int i = 0; i < 4; ++i)
#pragma unroll
                for (int j = 0; j < 4; ++j) acc[i][j] += a[i] * b[j]; }
    }
#pragma unroll
    for (int i = 0; i < 4; ++i)
#pragma unroll
        for (int j = 0; j < 4; ++j) E(bm * 64 + ty * 4 + i, bn * 64 + tx * 4 + j, acc[i][j]);
}

__device__ __forceinline__ void diffattn_tasks(const Params& p, float* s1  , long gw, long ngw, int lane) {
    float* s2 = s1 + LKS; float* qs = s2 + LKS;
    const bf16_t* QA = (const bf16_t*)(p.ws + WS_Q); const bf16_t* PR = (const bf16_t*)(p.ws + WS_PR); bf16_t* Y = (bf16_t*)(p.ws + WS_HY);
    const float lam_init = 0.2f;
    const float lam = expf(wave_sum(p.lam_q1[lane] * p.lam_k1[lane])) - expf(wave_sum(p.lam_q2[lane] * p.lam_k2[lane])) + lam_init;
    for (long task = gw; task < (long)MT * HA; task += ngw) {
        const int m = (int)(task / HA), h = (int)(task % HA);
        const bool smp = m >= MP; const int b = smp ? (m - MP) >> 10 : m >> 8; const int Lk = smp ? LKS : SEQP;
        const bf16_t* Kb = smp ? (const bf16_t*)(p.ws + WS_KSA) + (size_t)(b * HA + h) * LKS * 128 : (const bf16_t*)(p.ws + WS_KP) + (size_t)(b * HA + h) * SEQP * 128;
        const bf16_t* Vb = smp ? (const bf16_t*)(p.ws + WS_VSA) + (size_t)(b * HA + h) * LKS * 128 : (const bf16_t*)(p.ws + WS_VP) + (size_t)(b * HA + h) * SEQP * 128;
        { const unsigned w = *(const unsigned*)(QA + (size_t)m * 1024 + h * 128 + 2 * lane); qs[2 * lane] = bflo(w); qs[2 * lane + 1] = bfhi(w); }
        __builtin_amdgcn_s_waitcnt(0xc07f); asm volatile("" ::: "memory");
        float m1 = -1e30f, m2 = -1e30f;
        for (int j = lane; j < Lk; j += 64) { const bf16_t* kr = Kb + (size_t)j * 128; float a1 = 0.f, a2 = 0.f;
#pragma unroll
            for (int d8 = 0; d8 < 8; ++d8) { const u32x4 w1 = *(const u32x4*)(kr + d8 * 8), w2 = *(const u32x4*)(kr + 64 + d8 * 8); const float* q1 = qs + d8 * 8; const float* q2 = qs + 64 + d8 * 8;
                a1 += q1[0] * bflo(w1.x) + q1[1] * bfhi(w1.x) + q1[2] * bflo(w1.y) + q1[3] * bfhi(w1.y) + q1[4] * bflo(w1.z) + q1[5] * bfhi(w1.z) + q1[6] * bflo(w1.w) + q1[7] * bfhi(w1.w);
                a2 += q2[0] * bflo(w2.x) + q2[1] * bfhi(w2.x) + q2[2] * bflo(w2.y) + q2[3] * bfhi(w2.y) + q2[4] * bflo(w2.z) + q2[5] * bfhi(w2.z) + q2[6] * bflo(w2.w) + q2[7] * bfhi(w2.w); }
            s1[j] = a1; s2[j] = a2; m1 = fmaxf(m1, a1); m2 = fmaxf(m2, a2); }
        m1 = wave_max(m1); m2 = wave_max(m2);
        float l1 = 0.f, l2 = 0.f;
        for (int j = lane; j < Lk; j += 64) { const float e1 = exp2f(s1[j] - m1), e2 = exp2f(s2[j] - m2); s1[j] = e1; s2[j] = e2; l1 += e1; l2 += e2; }
        l1 = wave_sum(l1); l2 = wave_sum(l2);
        const float i1 = 1.f / l1, i2 = lam / l2;
        for (int j = lane; j < Lk; j += 64) s1[j] = s1[j] * i1 - s2[j] * i2;
        __builtin_amdgcn_s_waitcnt(0xc07f); asm volatile("" ::: "memory");
        float o0 = 0.f, o1 = 0.f;
        for (int j = 0; j < Lk; ++j) { const unsigned w = *(const unsigned*)(Vb + (size_t)j * 128 + 2 * lane); const float pj = s1[j]; o0 += pj * bflo(w); o1 += pj * bfhi(w); }
        const float r = 1.0f / sqrtf(wave_sum(o0 * o0 + o1 * o1) * (1.f / 128.f) + EPS);
        const unsigned gw = *(const unsigned*)(PR + (size_t)m * EVEN_IN + 4096 + h * 128 + 2 * lane);
        const float y0 = o0 * r * p.subln_w[2 * lane] * (1.f - lam_init) * siluf(bflo(gw)), y1 = o1 * r * p.subln_w[2 * lane + 1] * (1.f - lam_init) * siluf(bfhi(gw));
        *(unsigned*)(Y + (size_t)m * DM + h * 128 + 2 * lane) = pk2(y0, y1);
        __builtin_amdgcn_s_waitcnt(0xc07f); asm volatile("" ::: "memory");
    }
}
__device__ __forceinline__ void gqa_tasks(const Params& p, float* s1  , long gw, long ngw, int lane) {
    float* qs = s1 + LKS;
    const bf16_t* QC = (const bf16_t*)(p.ws + WS_Q); const bf16_t* PR = (const bf16_t*)(p.ws + WS_PR); bf16_t* Y = (bf16_t*)(p.ws + WS_HY);
    for (long task = gw; task < (long)MT * HC; task += ngw) {
        const int m = (int)(task / HC), hq = (int)(task % HC), kh = hq >> 2;
        const bool smp = m >= MP; const int b = smp ? (m - MP) >> 10 : m >> 8; const int Lk = smp ? LKS : SEQP;
        const bf16_t* Kb = smp ? (const bf16_t*)(p.ws + WS_KSC) + (size_t)(b * KVH + kh) * LKS * 128 : (const bf16_t*)(p.ws + WS_KP) + (size_t)(b * KVH + kh) * SEQP * 128;
        const bf16_t* Vb = smp ? (const bf16_t*)(p.ws + WS_VSC) + (size_t)(b * KVH + kh) * LKS * 128 : (const bf16_t*)(p.ws + WS_VP) + (size_t)(b * KVH + kh) * SEQP * 128;
        { const unsigned w = *(const unsigned*)(QC + (size_t)m * DM + hq * 128 + 2 * lane); qs[2 * lane] = bflo(w); qs[2 * lane + 1] = bfhi(w); }
        __builtin_amdgcn_s_waitcnt(0xc07f); asm volatile("" ::: "memory");
        float m1 = -1e30f;
        for (int j = lane; j < Lk; j += 64) { const bf16_t* kr = Kb + (size_t)j * 128; float a1 = 0.f;
#pragma unroll
            for (int d8 = 0; d8 < 16; ++d8) { const u32x4 w1 = *(const u32x4*)(kr + d8 * 8); const float* q1 = qs + d8 * 8;
                a1 += q1[0] * bflo(w1.x) + q1[1] * bfhi(w1.x) + q1[2] * bflo(w1.y) + q1[3] * bfhi(w1.y) + q1[4] * bflo(w1.z) + q1[5] * bfhi(w1.z) + q1[6] * bflo(w1.w) + q1[7] * bfhi(w1.w); }
            s1[j] = a1; m1 = fmaxf(m1, a1); }
        m1 = wave_max(m1);
        float l1 = 0.f;
        for (int j = lane; j < Lk; j += 64) { const float e1 = exp2f(s1[j] - m1); s1[j] = e1; l1 += e1; }
        l1 = wave_sum(l1);
        __builtin_amdgcn_s_waitcnt(0xc07f); asm volatile("" ::: "memory");
        float o0 = 0.f, o1 = 0.f;
        for (int j = 0; j < Lk; ++j) { const unsigned w = *(const unsigned*)(Vb + (size_t)j * 128 + 2 * lane); const float pj = s1[j]; o0 += pj * bflo(w); o1 += pj * bfhi(w); }
        const float il = 1.f / l1;
        const unsigned gw = *(const unsigned*)(PR + (size_t)m * ODD_IN + 3072 + hq * 128 + 2 * lane);
        *(unsigned*)(Y + (size_t)m * DM + hq * 128 + 2 * lane) = pk2(o0 * il * siluf(bflo(gw)), o1 * il * siluf(bfhi(gw)));
        __builtin_amdgcn_s_waitcnt(0xc07f); asm volatile("" ::: "memory");
    }
}

__global__ __launch_bounds__(256) void diffattn_naive(Params p) { __shared__ float sh[4][2 * LKS + 128]; diffattn_tasks(p, sh[threadIdx.x >> 6], (long)blockIdx.x * 4 + (threadIdx.x >> 6), (long)gridDim.x * 4, threadIdx.x & 63); }
__global__ __launch_bounds__(256) void gqa_naive(Params p) { __shared__ float sh[4][LKS + 128]; gqa_tasks(p, sh[threadIdx.x >> 6], (long)blockIdx.x * 4 + (threadIdx.x >> 6), (long)gridDim.x * 4, threadIdx.x & 63); }
__global__ __launch_bounds__(512) void k_prologue(Params p) {
    __shared__ float scr[8 * 2304];
    const int wid = threadIdx.x >> 6, lane = threadIdx.x & 63;
    mod_items(p, scr, blockIdx.x, gridDim.x, threadIdx.x, blockDim.x);
    __syncthreads();
    weights_items(p, scr + wid * 2304, blockIdx.x * 8 + wid, gridDim.x * 8, lane);
    caches_rope_items(p, (long)blockIdx.x * 512 + threadIdx.x, (long)gridDim.x * 512);
}
__global__ __launch_bounds__(512) void k_modulate(Params p, int layer) { modulate_rows(p, layer, blockIdx.x * 8 + (threadIdx.x >> 6), gridDim.x * 8, threadIdx.x & 63); }
__global__ __launch_bounds__(512) void k_post0(Params p) { post0_rows(p, blockIdx.x * 8 + (threadIdx.x >> 6), gridDim.x * 8, threadIdx.x & 63); }
__global__ __launch_bounds__(512) void k_post1(Params p) { post1_rows(p, blockIdx.x * 8 + (threadIdx.x >> 6), gridDim.x * 8, threadIdx.x & 63); }


namespace pg8 {
#define PG8_LAS __attribute__((address_space(3)))
typedef short bf16x8 __attribute__((ext_vector_type(8)));
constexpr int BM = 256, BK = 64, HALF = 128, HTB = HALF * BK * 2  , STAGE_BYTES = 8 * HTB, NXCD = 8, WGM = 8;
__host__ __device__ __forceinline__ int lds_byte(int r, int c) { const int st = (r >> 4) * 2 + (c >> 5), rr = r & 15, cc = c & 31, ob = rr * 64 + cc * 2; return st * 1024 + (ob ^ (((ob >> 9) & 1) << 5)); }
__host__ __device__ __forceinline__ void stage_rc(int b, int& R, int& C) { const int st = b / 1024, sb = b % 1024, swz = sb ^ (((sb >> 9) & 1) << 5); R = (st >> 1) * 16 + swz / 64; C = (st & 1) * 32 + (swz % 64) / 2; }
__host__ __device__ __forceinline__ int perm32(int rho) { const int n = rho >> 4, i = rho & 15; return 8 * (i >> 2) + 4 * n + (i & 3); }
struct Unit { int pm, pn, kt0, nkt, slab, half, hm; };
struct Gemm { const bf16_t* A; const bf16_t* Bt; int M, N, K, lda, ldb, a_pn_off, b_pm_off, pad; };
struct StaticOrder {
    int nM, nN, nwg, G, c, KT, nfull, split;
    __host__ __device__ void init(int M, int N, int K, int G_, int c_, bool allow_split) { nM = M / BM; nN = N / BM; nwg = nM * nN; G = G_; c = c_; KT = K / BK;
        const int rem = nwg % G; split = (allow_split && rem && G % rem == 0 && (G % 8) == 0 && ((G / 8) % (G / rem)) == 0 && (KT % (2 * (G / rem))) == 0) ? G / rem : 1; nfull = split > 1 ? nwg - rem : nwg; }
    __host__ __device__ void tile(int wgid, Unit& u) const { const int nig = WGM * nN, gid = wgid / nig, fm = gid * WGM, gsz = (nM - fm) < WGM ? (nM - fm) : WGM; u.pm = fm + ((wgid % nig) % gsz); u.pn = (wgid % nig) / gsz; }
    __host__ __device__ bool next(int i, Unit& u) const {
        const long L = (long)i * G + c;
        if (L < nfull) { int wgid = (int)L; { const int q = nfull / NXCD, r = nfull % NXCD, xcd = wgid % NXCD, off = wgid / NXCD; wgid = (xcd < r ? xcd * (q + 1) : r * (q + 1) + (xcd - r) * q) + off; }
            tile(wgid, u); u.kt0 = 0; u.nkt = KT; u.slab = -1; u.half = 0; u.hm = 0; return true; }
        if (split > 1 && L < nfull + G) { const int xcd = c % 8, q = c / 8, ks = q % split, j = (q / split) * 8 + xcd;
            tile(nfull + j, u); u.nkt = KT / split; u.kt0 = ks * u.nkt; u.slab = j * split + ks; u.half = 0; u.hm = 0; return true; }
        return false;
    }
    __device__ __forceinline__ void a_ready(const Unit&) const {}
    __device__ __forceinline__ void done(const Unit&) const {}
};
struct OutOrder {
    int c, part;
    __device__ bool next(int i, Unit& u) const {
        if (i > 0) return false;
        u.kt0 = 0; u.nkt = DM / BK; u.slab = -1; u.half = 0; u.hm = 0;
        if (part == 0) { const int wgid = (c % 8) * 32 + c / 8, idx = wgid % 64; u.pm = (wgid / 64) * 8 + idx % 8; u.pn = idx / 8; return true; }
        if (c >= 64) return false;
        u.pm = 32 + c / 8; u.pn = c % 8; return true;
    }
    __device__ __forceinline__ void a_ready(const Unit&) const {}
    __device__ __forceinline__ void done(const Unit&) const {}
};
struct LastOrder {
    int c;
    __device__ bool next(int i, Unit& u) const {
        u.kt0 = 0; u.nkt = DM / BK; u.slab = -1; u.half = 0; u.hm = 0;
        if (i == 0) { const int wgid = (c % 8) * 32 + c / 8, idx = wgid % 64; u.pm = (wgid / 64) * 8 + idx % 8; u.pn = idx / 8; return true; }
        if (i > 1 || c >= 128) return false;
        const int q = c / 8; u.half = 1; u.hm = q & 1; u.pm = 32 + (q >> 1); u.pn = c % 8; return true;
    }
    __device__ __forceinline__ void a_ready(const Unit&) const {}
    __device__ __forceinline__ void done(const Unit&) const {}
};
struct StaggerOrder {
    int c; const unsigned* cnt; bool wait;
    __device__ bool next(int i, Unit& u) const {
        const int x = c % 8; u.kt0 = 0; u.nkt = DM / BK; u.slab = -1; u.half = 0; u.hm = 0;
        if (c < 64) { if (i >= 2) return false; u.pm = 32 + x; u.pn = 2 * (c / 8) + i; return true; }
        const int e = (c - 64) / 8; int uidx;
        if (i < 3) uidx = i * 24 + e;
        else { if (i > 3) return false; const int h4 = e >> 1; u.half = 1; u.hm = e & 1;
            if (h4 >= 8) { u.pm = 32 + x; u.pn = 16 + (h4 - 8); return true; } uidx = 72 + h4; }
        u.pm = 4 * x + (uidx % 4); u.pn = uidx / 4; return true;
    }
    __device__ __forceinline__ void a_ready(const Unit& u) const {
        if (u.pm < 32 || !wait) return;
        if (threadIdx.x < 64) {
            const unsigned* w = cnt + 64 * (u.pm - 32); unsigned sp = 0;
            while ((unsigned)__builtin_amdgcn_readfirstlane(__hip_atomic_load(w, __ATOMIC_RELAXED, __HIP_MEMORY_SCOPE_AGENT)) < 8u) { __builtin_amdgcn_s_sleep(2); if (++sp > (1u << 22)) break; }
            __builtin_amdgcn_fence(__ATOMIC_ACQUIRE, "agent");
            asm volatile("s_waitcnt vmcnt(0)" ::: "memory");
        }
        asm volatile("" ::: "memory"); __builtin_amdgcn_s_barrier(); asm volatile("" ::: "memory");
    }
    __device__ __forceinline__ void done(const Unit&) const {}
};
__device__ __forceinline__ unsigned cvt_pk_bf16(float lo, float hi) { unsigned r; asm volatile("v_cvt_pk_bf16_f32 %0, %1, %2" : "=v"(r) : "v"(lo), "v"(hi)); return r; }
__device__ __forceinline__ void slab_store(const f32x4 (&acc)[2][2][4][2], float* slabs, const Unit& u, int wr, int wc, int fr, int fq) {
    float* sp = slabs + (size_t)u.slab * 65536 + (size_t)(wr * 64 + fr) * 256 + wc * 32 + 8 * fq;
#pragma unroll
    for (int ai = 0; ai < 2; ++ai)
#pragma unroll
        for (int m = 0; m < 4; ++m)
#pragma unroll
            for (int bj = 0; bj < 2; ++bj) { float* q = sp + (size_t)(ai * HALF + m * 16) * 256 + bj * HALF; *(f32x4*)q = acc[ai][bj][m][0]; *(f32x4*)(q + 4) = acc[ai][bj][m][1]; }
}
struct EpiBf16 {
    static constexpr bool PERM = true, AFTER_DRAIN = false;
    bf16_t* O; int ldc; int pad;
    __device__ __forceinline__ void operator()(const f32x4 (&acc)[2][2][4][2], const Unit& u, int wr, int wc, int fr, int fq) const {
        asm volatile("" : "+v"(fr), "+v"(fq));
        const int row0 = u.pm * BM + wr * 64 + fr, col0 = u.pn * BM + wc * 32 + 8 * fq;
#pragma unroll
        for (int ai = 0; ai < 2; ++ai)
#pragma unroll
            for (int m = 0; m < 4; ++m) { bf16_t* rowp = O + (size_t)(row0 + ai * HALF + m * 16) * ldc + col0;
#pragma unroll
                for (int bj = 0; bj < 2; ++bj) { const f32x4 v0 = acc[ai][bj][m][0], v1 = acc[ai][bj][m][1];
                    u32x4 w; w.x = cvt_pk_bf16(v0[0], v0[1]); w.y = cvt_pk_bf16(v0[2], v0[3]); w.z = cvt_pk_bf16(v1[0], v1[1]); w.w = cvt_pk_bf16(v1[2], v1[3]);
                    *(u32x4*)(rowp + bj * HALF) = w; } }
    }
};
struct EpiPoolF {
    static constexpr bool PERM = true, AFTER_DRAIN = false;
    bf16_t* Y; const bf16_t* SG; const float* pscale;
    __device__ __forceinline__ void operator()(const f32x4 (&acc)[2][2][4][2], const Unit& u, int wr, int wc, int fr, int fq) const {
        asm volatile("" : "+v"(fr), "+v"(fq));
        const int row0 = u.pm * BM + wr * 64 + fr, col0 = u.pn * BM + wc * 32 + 8 * fq;
        f32x4 ps[2][2];
#pragma unroll
        for (int bj = 0; bj < 2; ++bj) { ps[bj][0] = *(const f32x4*)(pscale + col0 + bj * HALF); ps[bj][1] = *(const f32x4*)(pscale + col0 + bj * HALF + 4); }
#pragma unroll
        for (int ai = 0; ai < 2; ++ai)
#pragma unroll
            for (int m = 0; m < 4; ++m) { const size_t r = (size_t)(row0 + ai * HALF + m * 16);
#pragma unroll
                for (int bj = 0; bj < 2; ++bj) { const int c = col0 + bj * HALF;
                    const u32x4 g = *(const u32x4*)(SG + r * DM + 1024 + c);
                    const f32x4 v0 = acc[ai][bj][m][0] * ps[bj][0], v1 = acc[ai][bj][m][1] * ps[bj][1];
                    u32x4 w; w.x = cvt_pk_bf16(v0[0] * bflo(g.x), v0[1] * bfhi(g.x)); w.y = cvt_pk_bf16(v0[2] * bflo(g.y), v0[3] * bfhi(g.y));
                    w.z = cvt_pk_bf16(v1[0] * bflo(g.z), v1[1] * bfhi(g.z)); w.w = cvt_pk_bf16(v1[2] * bflo(g.w), v1[3] * bfhi(g.w));
                    *(u32x4*)(Y + r * DM + 1024 + c) = w; } }
    }
};
struct EpiProj0 {
    static constexpr bool PERM = true, AFTER_DRAIN = false;
    unsigned char* ws; const float* qw; const float* kw; float* nak; float* nav;
    __device__ __forceinline__ void operator()(const f32x4 (&acc)[2][2][4][2], const Unit& u, int wr, int wc, int fr, int fq) const {
        asm volatile("" : "+v"(fr), "+v"(fq));
        const int pm = u.pm, pn = u.pn;
        const bool smp = pm >= 32; const int b = smp ? (pm - 32) >> 2 : pm, tb = (smp ? ((pm - 32) & 3) * 256 : 0) + wr * 64 + fr;
        const size_t rowb = (size_t)pm * 256 + wr * 64 + fr;
        if (pn < 8) {
            const bool isk = pn >= 4; const int hl = wc >> 1, j = wc & 1, h = (pn & 3) * 2 + hl, dim_a = 8 * fq + 16 * (fq >> 1);
            const float* w = isk ? kw : qw;
            f32x4 wv[2][2];
#pragma unroll
            for (int bj = 0; bj < 2; ++bj)
#pragma unroll
                for (int n = 0; n < 2; ++n) wv[bj][n] = *(const f32x4*)(w + dim_a + 16 * bj + 4 * n);
            const float* ropeA = (const float*)(ws + WS_ROPE);
#pragma unroll
            for (int ai = 0; ai < 2; ++ai)
#pragma unroll
                for (int m = 0; m < 4; ++m) { const int t = tb + ai * 128 + m * 16; const size_t row = rowb + ai * 128 + m * 16;
                    float ss = 0.f;
#pragma unroll
                    for (int bj = 0; bj < 2; ++bj)
#pragma unroll
                        for (int n = 0; n < 2; ++n) { const f32x4 x = acc[ai][bj][m][n]; ss += (x[0] * x[0] + x[1] * x[1]) + (x[2] * x[2] + x[3] * x[3]); }
                    ss += __shfl_xor(ss, 16); ss += __shfl_xor(ss, 32);
                    const float rinv = 1.0f / sqrtf(ss * (1.f / 64.f) + EPS);
                    f32x4 y[2][2];
#pragma unroll
                    for (int bj = 0; bj < 2; ++bj)
#pragma unroll
                        for (int n = 0; n < 2; ++n) y[bj][n] = acc[ai][bj][m][n] * rinv * wv[bj][n];
                    if (smp) {
#pragma unroll
                        for (int n = 0; n < 2; ++n) { const f32x4 cs = *(const f32x4*)(ropeA + (size_t)t * 64 + dim_a + 4 * n), sn = *(const f32x4*)(ropeA + 1024 * 64 + (size_t)t * 64 + dim_a + 4 * n);
                            const f32x4 a = y[0][n], bb = y[1][n]; y[0][n] = a * cs - bb * sn; y[1][n] = bb * cs + a * sn; } }
                    if (!isk) { bf16_t* qp = (bf16_t*)(ws + WS_Q) + row * 1024 + pn * 256 + wc * 64 + dim_a;
#pragma unroll
                        for (int bj = 0; bj < 2; ++bj) { const f32x4 v0 = y[bj][0] * C2A, v1 = y[bj][1] * C2A;
                            u32x4 o; o.x = cvt_pk_bf16(v0[0], v0[1]); o.y = cvt_pk_bf16(v0[2], v0[3]); o.z = cvt_pk_bf16(v1[0], v1[1]); o.w = cvt_pk_bf16(v1[2], v1[3]);
                            *(u32x4*)(qp + 16 * bj) = o; } }
                    else { const int hh = (pn - 4) * 2 + hl;
                        const size_t koff = (smp ? ((size_t)(b * HA + hh) * LKS + PAST + t) * 128 : ((size_t)(b * HA + hh) * SEQP + t) * 128) + j * 64 + dim_a;
                        bf16_t* kp = (bf16_t*)(ws + (smp ? WS_KSA : WS_KP)) + koff;
#pragma unroll
                        for (int bj = 0; bj < 2; ++bj) { const f32x4 v0 = y[bj][0], v1 = y[bj][1];
                            u32x4 o; o.x = cvt_pk_bf16(v0[0], v0[1]); o.y = cvt_pk_bf16(v0[2], v0[3]); o.z = cvt_pk_bf16(v1[0], v1[1]); o.w = cvt_pk_bf16(v1[2], v1[3]);
                            *(u32x4*)(kp + 16 * bj) = o;
                            if (!smp) { float* fp = nak + koff + 16 * bj; *(f32x4*)fp = v0; *(f32x4*)(fp + 4) = v1; } } }
                }
        } else if (pn < 12) {
#pragma unroll
            for (int ai = 0; ai < 2; ++ai)
#pragma unroll
                for (int m = 0; m < 4; ++m) { const int t = tb + ai * 128 + m * 16;
#pragma unroll
                    for (int bj = 0; bj < 2; ++bj) { const int hh = (pn - 8) * 2 + bj, d = 32 * wc + 8 * fq;
                        const size_t voff = (smp ? ((size_t)(b * HA + hh) * LKS + PAST + t) * 128 : ((size_t)(b * HA + hh) * SEQP + t) * 128) + d;
                        const f32x4 v0 = acc[ai][bj][m][0], v1 = acc[ai][bj][m][1];
                        u32x4 o; o.x = cvt_pk_bf16(v0[0], v0[1]); o.y = cvt_pk_bf16(v0[2], v0[3]); o.z = cvt_pk_bf16(v1[0], v1[1]); o.w = cvt_pk_bf16(v1[2], v1[3]);
                        *(u32x4*)((bf16_t*)(ws + (smp ? WS_VSA : WS_VP)) + voff) = o;
                        if (!smp) { *(f32x4*)(nav + voff) = v0; *(f32x4*)(nav + voff + 4) = v1; } } }
        } else if (pn < 16) {
            bf16_t* up = (bf16_t*)(ws + WS_U) + (pn - 12) * 256 + 32 * wc + 8 * fq;
#pragma unroll
            for (int ai = 0; ai < 2; ++ai)
#pragma unroll
                for (int m = 0; m < 4; ++m) { const size_t row = rowb + ai * 128 + m * 16;
#pragma unroll
                    for (int bj = 0; bj < 2; ++bj) { const f32x4 v0 = acc[ai][bj][m][0], v1 = acc[ai][bj][m][1];
                        u32x4 o; o.x = cvt_pk_bf16(v0[0], v0[1]); o.y = cvt_pk_bf16(v0[2], v0[3]); o.z = cvt_pk_bf16(v1[0], v1[1]); o.w = cvt_pk_bf16(v1[2], v1[3]);
                        *(u32x4*)(up + row * 1024 + bj * HALF) = o; } }
        } else {
            bf16_t* sg = (bf16_t*)(ws + WS_SG) + (pn - 16) * 256 + 32 * wc + 8 * fq;
#pragma unroll
            for (int ai = 0; ai < 2; ++ai)
#pragma unroll
                for (int m = 0; m < 4; ++m) { const size_t row = rowb + ai * 128 + m * 16;
#pragma unroll
                    for (int bj = 0; bj < 2; ++bj) { const f32x4 v0 = acc[ai][bj][m][0], v1 = acc[ai][bj][m][1];
                        u32x4 o; o.x = cvt_pk_bf16(siluf(v0[0]), siluf(v0[1])); o.y = cvt_pk_bf16(siluf(v0[2]), siluf(v0[3])); o.z = cvt_pk_bf16(siluf(v1[0]), siluf(v1[1])); o.w = cvt_pk_bf16(siluf(v1[2]), siluf(v1[3]));
                        *(u32x4*)(sg + row * DM + bj * HALF) = o; } }
        }
    }
};
struct EpiProj1 {
    static constexpr bool PERM = true, AFTER_DRAIN = false;
    unsigned char* ws; const float* qw; const float* kw; float* nck; float* ncv; PG8_LAS float* xs; float* slabs;
    __device__ __forceinline__ void operator()(const f32x4 (&acc0)[2][2][4][2], const Unit& u, int wr, int wc, int fr, int fq) const {
        asm volatile("" : "+v"(fr), "+v"(fq));
        if (u.slab >= 0) { slab_store(acc0, slabs, u, wr, wc, fr, fq); return; }
        const int pm = u.pm, pn = u.pn;
        float rstd[2][4]; f32x4 bv[2][2];
        { const int cr = pm < 32 ? 0 : 1 + ((pm - 32) >> 2);
          const float* b2 = (const float*)(ws + WS_B2P) + (size_t)cr * ODD_IN + pn * 256 + 32 * wc + 8 * fq; const float* rss = (const float*)(ws + WS_RSS) + (size_t)pm * 256 + (u.half ? u.hm * 128 : 0) + wr * 64 + fr;
#pragma unroll
          for (int bj = 0; bj < 2; ++bj)
#pragma unroll
              for (int n = 0; n < 2; ++n) bv[bj][n] = *(const f32x4*)(b2 + bj * HALF + n * 4);
#pragma unroll
          for (int ai = 0; ai < 2; ++ai)
#pragma unroll
              for (int m = 0; m < 4; ++m) rstd[ai][m] = __builtin_amdgcn_rsqf(rss[ai * 128 + m * 16] * (1.f / DM) + EPS); }
#define VV(ai, bj, m, n) (acc0[ai][bj][m][n] * rstd[ai][m] + bv[bj][n])
        const int hoff = u.half ? u.hm * 128 : 0, nai = u.half ? 1 : 2;
        const bool smp = pm >= 32; const int b = smp ? (pm - 32) >> 2 : pm, tb = (smp ? ((pm - 32) & 3) * 256 : 0) + hoff + wr * 64 + fr;
        const size_t rowb = (size_t)pm * 256 + hoff + wr * 64 + fr;
        if (pn < 10) {
            const bool isk = pn >= 8; const int hl = wc >> 1, w1 = wc & 1, head = (isk ? (pn - 8) : pn) * 2 + hl;
            const float* w = isk ? kw : qw;
            f32x4 wv[2][2];
#pragma unroll
            for (int bj = 0; bj < 2; ++bj)
#pragma unroll
                for (int n = 0; n < 2; ++n) wv[bj][n] = *(const f32x4*)(w + (2 * w1 + bj) * 32 + 8 * fq + 4 * n);
            PG8_LAS float* xo = xs + (wr * 4 + wc) * 128; PG8_LAS float* xp = xs + (wr * 4 + (wc ^ 1)) * 128;
#pragma unroll
            for (int ai = 0; ai < 2; ++ai)
#pragma unroll
                for (int m = 0; m < 4; ++m) { if (ai >= nai) continue; float ss = 0.f;
#pragma unroll
                    for (int bj = 0; bj < 2; ++bj)
#pragma unroll
                        for (int n = 0; n < 2; ++n) { const f32x4 x = VV(ai, bj, m, n); ss += (x[0] * x[0] + x[1] * x[1]) + (x[2] * x[2] + x[3] * x[3]); }
                    ss += __shfl_xor(ss, 16); ss += __shfl_xor(ss, 32);
                    if (fq == 0) xo[ai * 64 + m * 16 + fr] = ss; }
            asm volatile("s_waitcnt lgkmcnt(0)" ::: "memory"); __builtin_amdgcn_s_barrier(); asm volatile("" ::: "memory");
            const float* ropeC = (const float*)(ws + WS_ROPE) + 2 * 1024 * 64;
#pragma unroll
            for (int ai = 0; ai < 2; ++ai)
#pragma unroll
                for (int m = 0; m < 4; ++m) { if (ai >= nai) continue; const int idx = ai * 64 + m * 16 + fr, t = tb + ai * 128 + m * 16; const size_t row = rowb + ai * 128 + m * 16;
                    const float rinv = __builtin_amdgcn_rsqf((xo[idx] + xp[idx]) * (1.f / 128.f) + EPS);
                    float r2 = rstd[ai][m]; asm volatile("" : "+v"(r2));
                    f32x4 y[2][2];
#pragma unroll
                    for (int bj = 0; bj < 2; ++bj)
#pragma unroll
                        for (int n = 0; n < 2; ++n) y[bj][n] = (acc0[ai][bj][m][n] * r2 + bv[bj][n]) * rinv * wv[bj][n];
                    if (smp) {
#pragma unroll
                        for (int n = 0; n < 2; ++n) { const f32x4 cs = *(const f32x4*)(ropeC + (size_t)t * 128 + 64 * w1 + 8 * fq + 4 * n), sn = *(const f32x4*)(ropeC + 1024 * 128 + (size_t)t * 128 + 64 * w1 + 8 * fq + 4 * n);
                            const f32x4 a = y[0][n], bb = y[1][n]; y[0][n] = a * cs - bb * sn; y[1][n] = bb * cs + a * sn; } }
                    if (!isk) { bf16_t* qp = (bf16_t*)(ws + WS_Q) + row * DM + head * 128 + 8 * fq;
#pragma unroll
                        for (int bj = 0; bj < 2; ++bj) { const f32x4 v0 = y[bj][0] * C2C, v1 = y[bj][1] * C2C;
                            u32x4 o; o.x = cvt_pk_bf16(v0[0], v0[1]); o.y = cvt_pk_bf16(v0[2], v0[3]); o.z = cvt_pk_bf16(v1[0], v1[1]); o.w = cvt_pk_bf16(v1[2], v1[3]);
                            *(u32x4*)(qp + (2 * w1 + bj) * 32) = o; } }
                    else { const size_t koff = smp ? ((size_t)(b * KVH + head) * LKS + PAST + t) * 128 : ((size_t)(b * KVH + head) * SEQP + t) * 128;
                        bf16_t* kp = (bf16_t*)(ws + (smp ? WS_KSC : WS_KP)) + koff + 8 * fq;
#pragma unroll
                        for (int bj = 0; bj < 2; ++bj) { const f32x4 v0 = y[bj][0], v1 = y[bj][1];
                            u32x4 o; o.x = cvt_pk_bf16(v0[0], v0[1]); o.y = cvt_pk_bf16(v0[2], v0[3]); o.z = cvt_pk_bf16(v1[0], v1[1]); o.w = cvt_pk_bf16(v1[2], v1[3]);
                            *(u32x4*)(kp + (2 * w1 + bj) * 32) = o;
                            if (!smp) { float* fp = nck + koff + 8 * fq + (2 * w1 + bj) * 32; *(f32x4*)fp = v0; *(f32x4*)(fp + 4) = v1; } } }
                }
        } else if (pn < 12) {
#pragma unroll
            for (int ai = 0; ai < 2; ++ai)
#pragma unroll
                for (int m = 0; m < 4; ++m) { if (ai >= nai) continue; const int t = tb + ai * 128 + m * 16;
#pragma unroll
                    for (int bj = 0; bj < 2; ++bj) { const int kvh = (pn - 10) * 2 + bj, d = 32 * wc + 8 * fq;
                        const size_t voff = (smp ? ((size_t)(b * KVH + kvh) * LKS + PAST + t) * 128 : ((size_t)(b * KVH + kvh) * SEQP + t) * 128) + d;
                        const f32x4 v0 = VV(ai, bj, m, 0), v1 = VV(ai, bj, m, 1);
                        u32x4 o; o.x = cvt_pk_bf16(v0[0], v0[1]); o.y = cvt_pk_bf16(v0[2], v0[3]); o.z = cvt_pk_bf16(v1[0], v1[1]); o.w = cvt_pk_bf16(v1[2], v1[3]);
                        *(u32x4*)((bf16_t*)(ws + (smp ? WS_VSC : WS_VP)) + voff) = o;
                        if (!smp) { *(f32x4*)(ncv + voff) = v0; *(f32x4*)(ncv + voff + 4) = v1; } } }
        } else {
            bf16_t* sg = (bf16_t*)(ws + WS_SG) + (pn - 12) * 256 + 32 * wc + 8 * fq;
#pragma unroll
            for (int ai = 0; ai < 2; ++ai)
#pragma unroll
                for (int m = 0; m < 4; ++m) { if (ai >= nai) continue; const size_t row = rowb + ai * 128 + m * 16;
#pragma unroll
                    for (int bj = 0; bj < 2; ++bj) { const f32x4 v0 = VV(ai, bj, m, 0), v1 = VV(ai, bj, m, 1);
                        u32x4 o; o.x = cvt_pk_bf16(siluf(v0[0]), siluf(v0[1])); o.y = cvt_pk_bf16(siluf(v0[2]), siluf(v0[3])); o.z = cvt_pk_bf16(siluf(v1[0]), siluf(v1[1])); o.w = cvt_pk_bf16(siluf(v1[2]), siluf(v1[3]));
                        *(u32x4*)(sg + row * DM + bj * HALF) = o; } }
        }
    }
};
#undef VV
struct EpiResid0 {
    static constexpr bool PERM = true, AFTER_DRAIN = false;
    const float* xp; const float* xs; const float* gate; const float* cw1; float* out; bf16_t* H1; float* rowss; float* slabs;
    __device__ __forceinline__ void operator()(const f32x4 (&acc)[2][2][4][2], const Unit& u, int wr, int wc, int fr, int fq) const {
        asm volatile("" : "+v"(fr), "+v"(fq));
        if (u.slab >= 0) { slab_store(acc, slabs, u, wr, wc, fr, fq); return; }
        const int row0 = u.pm * BM + wr * 64 + fr, col0 = u.pn * BM + wc * 32 + 8 * fq;
        const int cr = u.pm < 32 ? 0 : 1 + ((u.pm - 32) >> 2);
        const float* xb = u.pm < 32 ? xp : xs - (size_t)MP * DM;
        f32x4 gv[2][2], cv[2][2];
#pragma unroll
        for (int bj = 0; bj < 2; ++bj)
#pragma unroll
            for (int n = 0; n < 2; ++n) { gv[bj][n] = *(const f32x4*)(gate + (size_t)cr * 6144 + col0 + bj * HALF + n * 4); cv[bj][n] = *(const f32x4*)(cw1 + (size_t)cr * DM + col0 + bj * HALF + n * 4); }
#pragma unroll
        for (int ai = 0; ai < 2; ++ai)
#pragma unroll
            for (int mp = 0; mp < 4; mp += 2) {
                f32x4 bs[2][2][2];
#pragma unroll
                for (int mm = 0; mm < 2; ++mm) { const float* bp = xb + (size_t)(row0 + ai * HALF + (mp + mm) * 16) * DM + col0;
#pragma unroll
                    for (int bj = 0; bj < 2; ++bj)
#pragma unroll
                        for (int n = 0; n < 2; ++n) bs[mm][bj][n] = *(const f32x4*)(bp + bj * HALF + n * 4); }
#pragma unroll
                for (int mm = 0; mm < 2; ++mm) { const int m = mp + mm, r = row0 + ai * HALF + m * 16;
                    float* op = out + (size_t)r * DM + col0; bf16_t* hp = H1 + (size_t)r * DM + col0;
                    float ss = 0.f;
#pragma unroll
                    for (int bj = 0; bj < 2; ++bj) { const f32x4 y0 = bs[mm][bj][0] + gv[bj][0] * acc[ai][bj][m][0], y1 = bs[mm][bj][1] + gv[bj][1] * acc[ai][bj][m][1];
                        *(f32x4*)(op + bj * HALF) = y0; *(f32x4*)(op + bj * HALF + 4) = y1;
                        ss += (y0[0] * y0[0] + y0[1] * y0[1]) + (y0[2] * y0[2] + y0[3] * y0[3]) + (y1[0] * y1[0] + y1[1] * y1[1]) + (y1[2] * y1[2] + y1[3] * y1[3]);
                        const f32x4 h0 = y0 * cv[bj][0], h1 = y1 * cv[bj][1];
                        u32x4 o; o.x = cvt_pk_bf16(h0[0], h0[1]); o.y = cvt_pk_bf16(h0[2], h0[3]); o.z = cvt_pk_bf16(h1[0], h1[1]); o.w = cvt_pk_bf16(h1[2], h1[3]);
                        *(u32x4*)(hp + bj * HALF) = o; }
                    ss += __shfl_xor(ss, 16); ss += __shfl_xor(ss, 32);
                    if (fq == 0) atomicAdd(rowss + r, ss); }
                asm volatile("" ::: "memory"); }
    }
};
struct EpiResidF {
    static constexpr bool PERM = true, AFTER_DRAIN = false;
    const float* xp; const float* xs; const float* base; const float* gate; float* out; float* slabs;
    __device__ __forceinline__ void operator()(const f32x4 (&acc)[2][2][4][2], const Unit& u, int wr, int wc, int fr, int fq) const {
        asm volatile("" : "+v"(fr), "+v"(fq));
        if (u.slab >= 0) { slab_store(acc, slabs, u, wr, wc, fr, fq); return; }
        const int row0 = u.pm * BM + (u.half ? u.hm * HALF : 0) + wr * 64 + fr, col0 = u.pn * BM + wc * 32 + 8 * fq;
        const int cr = u.pm < 32 ? 0 : 1 + ((u.pm - 32) >> 2);
        const float* xb = base ? base : (u.pm < 32 ? xp : xs - (size_t)MP * DM);
        f32x4 gv[2][2];
#pragma unroll
        for (int bj = 0; bj < 2; ++bj)
#pragma unroll
            for (int n = 0; n < 2; ++n) gv[bj][n] = *(const f32x4*)(gate + (size_t)cr * 6144 + col0 + bj * HALF + n * 4);
#pragma unroll
        for (int ai = 0; ai < 2; ++ai)
#pragma unroll
            for (int mp = 0; mp < 4; mp += 2) { if (ai == 1 && u.half) continue;
                f32x4 bs[2][2][2];
#pragma unroll
                for (int mm = 0; mm < 2; ++mm) { const float* bp = xb + (size_t)(row0 + ai * HALF + (mp + mm) * 16) * DM + col0;
#pragma unroll
                    for (int bj = 0; bj < 2; ++bj)
#pragma unroll
                        for (int n = 0; n < 2; ++n) bs[mm][bj][n] = *(const f32x4*)(bp + bj * HALF + n * 4); }
#pragma unroll
                for (int mm = 0; mm < 2; ++mm) { float* op = out + (size_t)(row0 + ai * HALF + (mp + mm) * 16) * DM + col0;
#pragma unroll
                    for (int bj = 0; bj < 2; ++bj)
#pragma unroll
                        for (int n = 0; n < 2; ++n) *(f32x4*)(op + bj * HALF + n * 4) = bs[mm][bj][n] + gv[bj][n] * acc[ai][bj][mp + mm][n]; }
                asm volatile("" ::: "memory"); }
    }
};

template <class Epi, class Sched, bool ALIGN_EPI = false, bool SP2 = false>
__device__ __forceinline__ void gemm_phase(PG8_LAS unsigned char* lds, const Gemm g, const Sched& S, const Epi& E, const int tid) {
    const int wid = __builtin_amdgcn_readfirstlane(tid >> 6), lane = tid & 63, wr = wid >> 2, wc = wid & 3, fr = lane & 15, fq = lane >> 4;
    unsigned voffA[2], voffB[2];
#pragma unroll
    for (int i = 0; i < 2; ++i) { int R, C; stage_rc(tid * 16 + i * 8192, R, C); const int Rb = Epi::PERM ? ((R & ~31) + perm32(R & 31)) : R;
        voffA[i] = (unsigned)(R * g.lda + C) * 2u; voffB[i] = (unsigned)(Rb * g.ldb + C) * 2u; }
    const size_t kstep = (size_t)(BK * 2);
    const size_t hstepA = (size_t)HALF * g.lda * 2, hstepB = (size_t)HALF * g.ldb * 2;
    const size_t tstepA = 2 * hstepA, tstepB = 2 * hstepB;
    const unsigned ldsw = (unsigned)wid * 1024u;
    const int aoff = lds_byte(wr * 64 + fr, fq * 8), boff = lds_byte(wc * 32 + fr, fq * 8);
#define PG8_SA(b, h) (((b) * 2 + (h)) * HTB)
#define PG8_SB(b, h) ((4 + (b) * 2 + (h)) * HTB)
#define PG8_STAGE(bufoff, gbase, voff) do { _Pragma("unroll") for (int _i = 0; _i < 2; ++_i) \
        __builtin_amdgcn_global_load_lds((const unsigned*)((const char*)(gbase) + (voff)[_i]), (PG8_LAS unsigned*)(lds + (bufoff) + ldsw + _i * 8192), 16, 0, 0); } while (0)
#define PG8_LDA(dst, b, h) do { _Pragma("unroll") for (int m = 0; m < 4; ++m) _Pragma("unroll") for (int k = 0; k < 2; ++k) dst[m][k] = *(const PG8_LAS bf16x8*)(lds + PG8_SA(b, h) + aoff + m * 2048 + k * 1024); } while (0)
#define PG8_LDB(dst, b, h) do { _Pragma("unroll") for (int n = 0; n < 2; ++n) _Pragma("unroll") for (int k = 0; k < 2; ++k) dst[n][k] = *(const PG8_LAS bf16x8*)(lds + PG8_SB(b, h) + boff + n * 2048 + k * 1024); } while (0)
#define PG8_MMA(ai, bj, At, Bt) do { __builtin_amdgcn_s_setprio(1); _Pragma("unroll") for (int m = 0; m < 4; ++m) _Pragma("unroll") for (int n = 0; n < 2; ++n) _Pragma("unroll") for (int k = 0; k < 2; ++k) \
        acc[ai][bj][m][n] = __builtin_amdgcn_mfma_f32_16x16x32_bf16(Bt[n][k], At[m][k], acc[ai][bj][m][n], 0, 0, 0); __builtin_amdgcn_s_setprio(0); } while (0)
#define PG8_WAIT_V(n) asm volatile("s_waitcnt vmcnt(" #n ")" ::: "memory")
#define PG8_WAIT_L(n) asm volatile("s_waitcnt lgkmcnt(" #n ")" ::: "memory")
#define PG8_BAR __builtin_amdgcn_s_barrier()
#define PG8_SCHED __builtin_amdgcn_sched_barrier(0)
    Unit cur, nxt; int ui = 0;
    if (!S.next(0, cur)) return;
    f32x4 acc[2][2][4][2];
#pragma unroll
    for (int a = 0; a < 2; ++a)
#pragma unroll
        for (int b = 0; b < 2; ++b)
#pragma unroll
            for (int m = 0; m < 4; ++m)
#pragma unroll
                for (int n = 0; n < 2; ++n) acc[a][b][m][n] = (f32x4){0.f, 0.f, 0.f, 0.f};
    bf16x8 At[4][2], B0[2][2], B1[2][2];
    const char* cA = (const char*)g.A + (size_t)cur.pm * tstepA + (size_t)cur.pn * g.a_pn_off * 2 + (size_t)cur.kt0 * kstep + (cur.half ? (size_t)cur.hm * hstepA : 0); const char* cB = (const char*)g.Bt + (size_t)cur.pn * tstepB + (size_t)cur.pm * g.b_pm_off * 2 + (size_t)cur.kt0 * kstep;
    S.a_ready(cur);
    if constexpr (SP2) {
        PG8_STAGE(PG8_SB(0, 0), cB, voffB); PG8_STAGE(PG8_SB(0, 1), cB + hstepB, voffB); PG8_STAGE(PG8_SA(0, 0), cA, voffA); PG8_STAGE(PG8_SA(0, 1), cA + (cur.half ? 0 : hstepA), voffA);
        if (wr == 1) PG8_BAR;
        PG8_WAIT_V(2); PG8_BAR;
        PG8_STAGE(PG8_SB(1, 0), cB + kstep, voffB); PG8_STAGE(PG8_SA(1, 0), cA + kstep, voffA); PG8_STAGE(PG8_SB(1, 1), cB + hstepB + kstep, voffB);
        PG8_WAIT_V(6); PG8_BAR;
    } else {
        PG8_STAGE(PG8_SB(0, 0), cB, voffB); PG8_STAGE(PG8_SA(0, 0), cA, voffA); PG8_STAGE(PG8_SB(0, 1), cB + hstepB, voffB); PG8_STAGE(PG8_SA(0, 1), cA + hstepA, voffA);
        if (wr == 1) PG8_BAR;
        PG8_WAIT_V(4); PG8_BAR;
        PG8_STAGE(PG8_SB(1, 0), cB + kstep, voffB); PG8_STAGE(PG8_SA(1, 0), cA + kstep, voffA); PG8_STAGE(PG8_SB(1, 1), cB + hstepB + kstep, voffB);
        PG8_WAIT_V(6); PG8_BAR;
    }
    for (;;) {
        const bool has_next = S.next(ui + 1, nxt);
        const char* nA = has_next ? (const char*)g.A + (size_t)nxt.pm * tstepA + (size_t)nxt.pn * g.a_pn_off * 2 + (size_t)nxt.kt0 * kstep + (nxt.half ? (size_t)nxt.hm * hstepA : 0) : cA; const char* nB = has_next ? (const char*)g.Bt + (size_t)nxt.pn * tstepB + (size_t)nxt.pm * g.b_pm_off * 2 + (size_t)nxt.kt0 * kstep : cB;
        const size_t curH = cur.half ? 0 : hstepA, nxtH = has_next ? (nxt.half ? 0 : hstepA) : curH;
        const int nt = cur.nkt;
        for (int t = 0; t < nt; t += 2) {
            const bool last = (t == nt - 2);
            const char* a1 = cA + (size_t)(t + 1) * kstep;
            const char* a2 = last ? nA : cA + (size_t)(t + 2) * kstep; const char* b2 = last ? nB : cB + (size_t)(t + 2) * kstep;
            const char* a3 = a2 + kstep; const char* b3 = b2 + kstep;
            if (last && has_next) S.a_ready(nxt);
            if constexpr (SP2) {
            PG8_LDB(B0, 0, 0); PG8_LDB(B1, 0, 1); PG8_SCHED; PG8_LDA(At, 0, 0); PG8_STAGE(PG8_SA(1, 1), a1 + curH, voffA);
            PG8_WAIT_V(8); PG8_WAIT_L(0); PG8_BAR; PG8_MMA(0, 0, At, B0); PG8_MMA(0, 1, At, B1); PG8_BAR; PG8_SCHED;
            PG8_LDA(At, 0, 1); PG8_STAGE(PG8_SB(0, 0), b2, voffB); PG8_STAGE(PG8_SB(0, 1), b2 + hstepB, voffB); PG8_STAGE(PG8_SA(0, 0), a2, voffA);
            PG8_WAIT_V(8); PG8_WAIT_L(0); PG8_BAR; if (!cur.half) { PG8_MMA(1, 0, At, B0); PG8_MMA(1, 1, At, B1); } PG8_BAR; PG8_SCHED;
            PG8_LDB(B0, 1, 0); PG8_LDB(B1, 1, 1); PG8_SCHED; PG8_LDA(At, 1, 0); PG8_STAGE(PG8_SA(0, 1), a2 + (last ? nxtH : curH), voffA);
            PG8_WAIT_V(8); PG8_WAIT_L(0); PG8_BAR; PG8_MMA(0, 0, At, B0); PG8_MMA(0, 1, At, B1); PG8_BAR; PG8_SCHED;
            PG8_LDA(At, 1, 1); PG8_STAGE(PG8_SB(1, 0), b3, voffB); PG8_STAGE(PG8_SB(1, 1), b3 + hstepB, voffB); PG8_STAGE(PG8_SA(1, 0), a3, voffA);
            PG8_WAIT_V(8); PG8_WAIT_L(0); PG8_BAR; if (!cur.half) { PG8_MMA(1, 0, At, B0); PG8_MMA(1, 1, At, B1); } PG8_BAR; PG8_SCHED;
            } else {
            PG8_LDB(B0, 0, 0); PG8_SCHED; PG8_LDA(At, 0, 0); PG8_STAGE(PG8_SA(1, 1), a1 + hstepA, voffA);
            PG8_WAIT_L(8); PG8_BAR; PG8_WAIT_L(0); PG8_MMA(0, 0, At, B0); PG8_BAR; PG8_SCHED;
            PG8_LDB(B1, 0, 1); PG8_STAGE(PG8_SB(0, 0), b2, voffB);
            PG8_BAR; PG8_WAIT_L(0); PG8_MMA(0, 1, At, B1); PG8_BAR;
            PG8_LDA(At, 0, 1); PG8_STAGE(PG8_SA(0, 0), a2, voffA);
            PG8_BAR; PG8_WAIT_L(0); PG8_MMA(1, 0, At, B0); PG8_BAR; PG8_SCHED;
            PG8_STAGE(PG8_SB(0, 1), b2 + hstepB, voffB);
            PG8_WAIT_V(6); PG8_BAR; PG8_MMA(1, 1, At, B1); PG8_BAR;
            PG8_LDB(B0, 1, 0); PG8_SCHED; PG8_LDA(At, 1, 0); PG8_STAGE(PG8_SA(0, 1), a2 + hstepA, voffA);
            PG8_WAIT_L(8); PG8_BAR; PG8_WAIT_L(0); PG8_MMA(0, 0, At, B0); PG8_BAR; PG8_SCHED;
            PG8_LDB(B1, 1, 1); PG8_STAGE(PG8_SB(1, 0), b3, voffB);
            PG8_BAR; PG8_WAIT_L(0); PG8_MMA(0, 1, At, B1); PG8_BAR;
            PG8_LDA(At, 1, 1); PG8_STAGE(PG8_SA(1, 0), a3, voffA);
            PG8_BAR; PG8_WAIT_L(0); PG8_MMA(1, 0, At, B0); PG8_BAR; PG8_SCHED;
            PG8_STAGE(PG8_SB(1, 1), b3 + hstepB, voffB);
            PG8_WAIT_V(6); PG8_BAR; PG8_MMA(1, 1, At, B1); PG8_BAR;
            }
        }
        if constexpr (ALIGN_EPI) { if (wr == 0) PG8_BAR; }
        if constexpr (!Epi::AFTER_DRAIN) { E(acc, cur, wr, wc, fr, fq); S.done(cur); }
        if (!has_next) break;
#pragma unroll
        for (int a = 0; a < 2; ++a)
#pragma unroll
            for (int b = 0; b < 2; ++b)
#pragma unroll
                for (int m = 0; m < 4; ++m)
#pragma unroll
                    for (int n = 0; n < 2; ++n) acc[a][b][m][n] = (f32x4){0.f, 0.f, 0.f, 0.f};
        cur = nxt; cA = nA; cB = nB; ++ui;
        if constexpr (ALIGN_EPI) { if (wr == 1) PG8_BAR; }
    }
    PG8_WAIT_V(0);
    if constexpr (!ALIGN_EPI) { if (wr == 0) PG8_BAR; }
    PG8_BAR;
#undef PG8_SA
#undef PG8_SB
#undef PG8_STAGE
#undef PG8_LDA
#undef PG8_LDB
#undef PG8_MMA
#undef PG8_WAIT_V
#undef PG8_WAIT_L
#undef PG8_BAR
#undef PG8_SCHED
}
}

__device__ __forceinline__ void ld8(const bf16_t* p, float (&v)[8]) { const u32x4 r = *(const u32x4*)p; v[0] = bflo(r.x); v[1] = bfhi(r.x); v[2] = bflo(r.y); v[3] = bfhi(r.y); v[4] = bflo(r.z); v[5] = bfhi(r.z); v[6] = bflo(r.w); v[7] = bfhi(r.w); }
__device__ __forceinline__ void pool_apply_slot(const Params& p, int slot, int tid) {
    const bf16_t* __restrict__ Z = (const bf16_t*)(p.ws + WS_U); const bf16_t* __restrict__ SG = (const bf16_t*)(p.ws + WS_SG); bf16_t* __restrict__ Y = (bf16_t*)(p.ws + WS_HY);
    const int chunk = tid & 127, rb = tid >> 7, c = chunk * 8, g = chunk >> 5, h = 1 << g;
    float ps[8];
#pragma unroll
    for (int e = 0; e < 8; ++e) ps[e] = p.pool_scale[c + e];
    float S[8]; bool first = true;
    int m = slot * 80 + rb * 20;
#pragma unroll 1
    for (int i4 = 0; i4 < 5; ++i4) {
        float za[4][8], zr[4][8], own[4][8], gt[4][8]; int cnt[4]; bool init[4];
#pragma unroll
        for (int j = 0; j < 4; ++j) { const int mm = m + j; const bool smp = mm >= MP; const int t = smp ? (mm - MP) & 1023 : mm & 255, L = smp ? SEQS : SEQP;
            const bf16_t* zp = Z + (size_t)mm * 1024 + c;
            const bool add_ok = (t + h <= L), rem_ok = (t - h >= 1);
            ld8(zp + (ptrdiff_t)(add_ok ? (h - 1) : 0) * 1024, za[j]); ld8(zp + (ptrdiff_t)(rem_ok ? (-1 - h) : 0) * 1024, zr[j]); ld8(zp, own[j]); ld8(SG + (size_t)mm * DM + 1024 + c, gt[j]);
            const float fa = add_ok ? 1.f : 0.f, fr = rem_ok ? 1.f : 0.f;
#pragma unroll
            for (int e = 0; e < 8; ++e) { za[j][e] *= fa; zr[j][e] *= fr; }
            cnt[j] = min(t + h, L) - max(t - h, 0); init[j] = (t == 0) || (first && j == 0 && i4 == 0); }
#pragma unroll
        for (int j = 0; j < 4; ++j) { const int mm = m + j;
            if (init[j]) { const bool smp = mm >= MP; const int t = smp ? (mm - MP) & 1023 : mm & 255, L = smp ? SEQS : SEQP; const int lo = max(t - h, 0), hi = min(t + h, L);
#pragma unroll
                for (int e = 0; e < 8; ++e) S[e] = 0.f;
                for (int tt = lo; tt < hi; ++tt) { float w[8]; ld8(Z + (size_t)(mm + tt - t) * 1024 + c, w);
#pragma unroll
                    for (int e = 0; e < 8; ++e) S[e] += w[e]; } }
            else {
#pragma unroll
                for (int e = 0; e < 8; ++e) S[e] += za[j][e] - zr[j][e]; }
            const float inv = 1.0f / (float)cnt[j];
            float o[8];
#pragma unroll
            for (int e = 0; e < 8; ++e) o[e] = (S[e] * inv - own[j][e]) * ps[e] * gt[j][e];
            u32x4 w; w.x = pk2(o[0], o[1]); w.y = pk2(o[2], o[3]); w.z = pk2(o[4], o[5]); w.w = pk2(o[6], o[7]);
            *(u32x4*)(Y + (size_t)mm * DM + 1024 + c) = w; }
        first = false; m += 4;
    }
}
namespace att {
#define GATE(x) (SILU ? siluf(x) : (x))
using bf16x8 = __attribute__((ext_vector_type(8))) short;
using s16x4  = __attribute__((ext_vector_type(4))) short;
using f32x16 = __attribute__((ext_vector_type(16))) float;
constexpr int QBLK = 32, KVBLK = 64, LDK = 128;
constexpr int SHM_V = KVBLK * 128 * 2, SHM_K = KVBLK * 128 * 2;
constexpr int WS_OFF = 2 * SHM_V + 2 * SHM_K;
constexpr int STG_OFF = 72 * 1024;
constexpr float THRL = 8.f * LOG2E;
#define KSWZ(row, colB) ((row) * 256 + ((colB) ^ (((row) & 7) << 4)))
#define SBAR() __builtin_amdgcn_sched_barrier(0)
__device__ __forceinline__ int crow(int r, int hi) { return (r & 3) + 8 * (r >> 2) + 4 * hi; }
__device__ __forceinline__ unsigned cvtpk(float lo, float hi) { unsigned r; asm volatile("v_cvt_pk_bf16_f32 %0, %1, %2" : "=v"(r) : "v"(lo), "v"(hi)); return r; }
constexpr float SOFT_OFF = 0.f;
__device__ __forceinline__ void partialSM(f32x16& p0, f32x16& p1, float& m_reg, float& mn, float& alpha) {
  float pmax = p0[0]; for (int r = 1; r < 16; ++r) pmax = fmaxf(pmax, p0[r]); for (int r = 0; r < 16; ++r) pmax = fmaxf(pmax, p1[r]);
  { auto rr = __builtin_amdgcn_permlane32_swap(__float_as_uint(pmax), __float_as_uint(pmax), false, false);
    pmax = fmaxf(__uint_as_float(rr[0]), __uint_as_float(rr[1])); }
  if (__builtin_expect(__all(pmax - m_reg <= THRL), 1)) { mn = m_reg; alpha = 1.f; }
  else { mn = fmaxf(m_reg, pmax); alpha = __builtin_amdgcn_exp2f(m_reg - mn); m_reg = mn; }
  for (int r = 0; r < 16; ++r) p0[r] = p0[r] - mn; for (int r = 0; r < 16; ++r) p1[r] = p1[r] - mn;
  for (int r = 0; r < 16; ++r) p0[r] = __builtin_amdgcn_exp2f(p0[r]);
}
__device__ __forceinline__ void finishSM(f32x16& p0, f32x16& p1, float alpha, float& l_reg, bf16x8& pa0, bf16x8& pa1, bf16x8& pa2, bf16x8& pa3) {
  for (int r = 0; r < 16; ++r) p1[r] = __builtin_amdgcn_exp2f(p1[r]);
  float ps = 0; for (int r = 0; r < 16; ++r) ps += p0[r]; for (int r = 0; r < 16; ++r) ps += p1[r];
  { auto rr = __builtin_amdgcn_permlane32_swap(__float_as_uint(ps), __float_as_uint(ps), false, false);
    ps = __uint_as_float(rr[0]) + __uint_as_float(rr[1]); }
  l_reg = l_reg * alpha + ps;
#define PK4(P, BASE, OUT) do { unsigned a0 = cvtpk(P[BASE + 0], P[BASE + 1]), a1 = cvtpk(P[BASE + 2], P[BASE + 3]);   \
    unsigned b0 = cvtpk(P[BASE + 4], P[BASE + 5]), b1 = cvtpk(P[BASE + 6], P[BASE + 7]);                              \
    auto r0 = __builtin_amdgcn_permlane32_swap(a0, b0, false, false); auto r1 = __builtin_amdgcn_permlane32_swap(a1, b1, false, false); \
    u32x4 w = {r0[0], r1[0], r0[1], r1[1]}; OUT = *reinterpret_cast<bf16x8*>(&w); } while (0)
  PK4(p0, 0, pa0); PK4(p0, 8, pa1); PK4(p1, 0, pa2); PK4(p1, 8, pa3);
#undef PK4
}
template <int ND0> __device__ __forceinline__ void qkt(f32x16& p0, f32x16& p1, const char* Ks, const bf16x8* qr, int r32, int hi, int kcol0, const f32x16& cinit) {
#pragma unroll
  for (int d0 = 0; d0 < ND0; ++d0) { int cb = (kcol0 + d0 * 16 + hi * 8) * 2;
    bf16x8 b0 = *reinterpret_cast<const bf16x8*>(Ks + KSWZ(r32, cb));
    bf16x8 b1 = *reinterpret_cast<const bf16x8*>(Ks + KSWZ(32 + r32, cb));
    if (d0 == 0) { p0 = __builtin_amdgcn_mfma_f32_32x32x16_bf16(b0, qr[d0], cinit, 0, 0, 0); p1 = __builtin_amdgcn_mfma_f32_32x32x16_bf16(b1, qr[d0], cinit, 0, 0, 0); }
    else { p0 = __builtin_amdgcn_mfma_f32_32x32x16_bf16(b0, qr[d0], p0, 0, 0, 0); p1 = __builtin_amdgcn_mfma_f32_32x32x16_bf16(b1, qr[d0], p1, 0, 0, 0); } }
}
__device__ __forceinline__ int v_st(int k, int c) { const int kk = (k & ~0xC) | ((k & 4) << 1) | ((k & 8) >> 1); return ((kk >> 3) * 4 + (c >> 5)) * 512 + ((kk & 7) * 32 + (c & 31)) * 2; }
__device__ __forceinline__ int v_rd_base(int lane) { return ((lane & 3) << 3) | (((lane >> 2) & 3) << 6) | (((lane >> 4) & 1) << 5) | (((lane >> 5) & 1) << 8); }
constexpr int v_rd_off(int d0, int ks, int half) { return d0 * 512 + ks * 4096 + half * 2048; }
template <int OFF> __device__ __forceinline__ s16x4 tr_read(int vb) {
  s16x4 r; asm volatile("ds_read_b64_tr_b16 %0, %1 offset:%2" : "=&v"(r) : "v"(vb), "i"(OFF) : "memory"); return r;
}
template <int D0> __device__ __forceinline__ void pv_one(f32x16& od, int vb, bf16x8 pa0, bf16x8 pa1, bf16x8 pa2, bf16x8 pa3) {
  const s16x4 l0 = tr_read<v_rd_off(D0, 0, 0)>(vb), h0 = tr_read<v_rd_off(D0, 0, 1)>(vb), l1 = tr_read<v_rd_off(D0, 1, 0)>(vb), h1 = tr_read<v_rd_off(D0, 1, 1)>(vb);
  const s16x4 l2 = tr_read<v_rd_off(D0, 2, 0)>(vb), h2 = tr_read<v_rd_off(D0, 2, 1)>(vb), l3 = tr_read<v_rd_off(D0, 3, 0)>(vb), h3 = tr_read<v_rd_off(D0, 3, 1)>(vb);
  asm volatile("s_waitcnt lgkmcnt(0)" ::: "memory"); SBAR();
#define PK(L, H) (bf16x8){L[0], L[1], L[2], L[3], H[0], H[1], H[2], H[3]}
  od = __builtin_amdgcn_mfma_f32_32x32x16_bf16(pa0, PK(l0, h0), od, 0, 0, 0);
  od = __builtin_amdgcn_mfma_f32_32x32x16_bf16(pa1, PK(l1, h1), od, 0, 0, 0);
  od = __builtin_amdgcn_mfma_f32_32x32x16_bf16(pa2, PK(l2, h2), od, 0, 0, 0);
  od = __builtin_amdgcn_mfma_f32_32x32x16_bf16(pa3, PK(l3, h3), od, 0, 0, 0);
#undef PK
}
__device__ __forceinline__ void pv_d0(f32x16* o, int vb, bf16x8 pa0, bf16x8 pa1, bf16x8 pa2, bf16x8 pa3) {
  pv_one<0>(o[0], vb, pa0, pa1, pa2, pa3); pv_one<1>(o[1], vb, pa0, pa1, pa2, pa3); pv_one<2>(o[2], vb, pa0, pa1, pa2, pa3); pv_one<3>(o[3], vb, pa0, pa1, pa2, pa3);
}
template <int ND0>
__device__ __forceinline__ void attn_core(const bf16_t* Qw, const bf16_t* __restrict__ Kh, const bf16_t* __restrict__ Vh, int seq, int kcol0, char* lds, f32x16 (&o)[4], float& l_reg, const int wid, const int lane) {
  const int tid = wid * 64 + lane, r32 = lane & 31, hi = lane >> 5;
  char* V_lds = lds; char* K_lds = lds + 2 * SHM_V;
  float* ws = (float*)(lds + WS_OFF) + wid * 64; float* al_l = ws + 32;
  float m_reg = -1e30f; l_reg = 0; bf16x8 qr[ND0];
  f32x16 cinit; for (int r = 0; r < 16; ++r) cinit[r] = -SOFT_OFF;
#pragma unroll
  for (int d = 0; d < 4; ++d) o[d] = f32x16{};
#pragma unroll
  for (int d0 = 0; d0 < ND0; ++d0) qr[d0] = *reinterpret_cast<const bf16x8*>(Qw + d0 * 16);
  const int sr = tid >> 4, sc = (tid & 15) * 8, vst0 = v_st(sr, sc), vst1 = v_st(32 + sr, sc);
  const int vb0 = (int)(uintptr_t)V_lds + v_rd_base(lane);
  struct { bf16x8 vs0, vs1, ks0, ks1; } sr_[1];
#define SLOAD(i, k0) do { sr_[i].vs0 = *reinterpret_cast<const bf16x8*>(&Vh[(long)((k0) + sr) * LDK + sc]); sr_[i].vs1 = *reinterpret_cast<const bf16x8*>(&Vh[(long)((k0) + 32 + sr) * LDK + sc]); \
    sr_[i].ks0 = *reinterpret_cast<const bf16x8*>(&Kh[(long)((k0) + sr) * LDK + sc]); sr_[i].ks1 = *reinterpret_cast<const bf16x8*>(&Kh[(long)((k0) + 32 + sr) * LDK + sc]); } while (0)
#define SWRITE(b, i) do { *(bf16x8*)(V_lds + (b) * SHM_V + vst0) = sr_[i].vs0;          \
    *(bf16x8*)(V_lds + (b) * SHM_V + vst1) = sr_[i].vs1; int kc = sc * 2;               \
    *(bf16x8*)(K_lds + (b) * SHM_K + KSWZ(sr, kc)) = sr_[i].ks0;                       \
    *(bf16x8*)(K_lds + (b) * SHM_K + KSWZ(32 + sr, kc)) = sr_[i].ks1; } while (0)
#define SWAIT() asm volatile("s_waitcnt vmcnt(0)" ::: "memory")
#define RESC(a) do { if (__any((a) < 1.f)) { if (hi == 0) al_l[r32] = (a); asm volatile("s_waitcnt lgkmcnt(0)" ::: "memory"); \
    for (int d = 0; d < 4; ++d) for (int r = 0; r < 16; ++r) o[d][r] *= al_l[crow(r, hi)]; } } while (0)
  f32x16 pA0, pA1, pB0, pB1; float mnA, mnB, alA, alB; bf16x8 pa0, pa1, pa2, pa3; const int NT = seq / KVBLK;
  SLOAD(0, 0); asm volatile("s_waitcnt vmcnt(0)" ::: "memory"); SWRITE(0, 0); __syncthreads();
  qkt<ND0>(pA0, pA1, K_lds, qr, r32, hi, kcol0, cinit); partialSM(pA0, pA1, m_reg, mnA, alA);
  SLOAD(0, KVBLK);
  SWAIT(); SWRITE(1, 0); __syncthreads();
  for (int j = 1; j + 1 < NT; j += 2) {
    SBAR(); qkt<ND0>(pB0, pB1, K_lds + SHM_K, qr, r32, hi, kcol0, cinit);
    finishSM(pA0, pA1, alA, l_reg, pa0, pa1, pa2, pa3); SBAR();
    SLOAD(0, (j + 1) * KVBLK); SBAR();
    pv_d0(o, vb0, pa0, pa1, pa2, pa3); partialSM(pB0, pB1, m_reg, mnB, alB);
    __syncthreads(); SWAIT(); SWRITE(0, 0);
    RESC(alB); __syncthreads();
    SBAR(); qkt<ND0>(pA0, pA1, K_lds, qr, r32, hi, kcol0, cinit);
    finishSM(pB0, pB1, alB, l_reg, pa0, pa1, pa2, pa3); SBAR();
    SLOAD(0, (j + 2) * KVBLK); SBAR();
    pv_d0(o, vb0 + SHM_V, pa0, pa1, pa2, pa3); partialSM(pA0, pA1, m_reg, mnA, alA);
    __syncthreads(); SWAIT(); SWRITE(1, 0);
    RESC(alA); __syncthreads();
  }
  SBAR(); qkt<ND0>(pB0, pB1, K_lds + SHM_K, qr, r32, hi, kcol0, cinit);
  finishSM(pA0, pA1, alA, l_reg, pa0, pa1, pa2, pa3); SBAR();
  pv_d0(o, vb0, pa0, pa1, pa2, pa3); partialSM(pB0, pB1, m_reg, mnB, alB);
  __syncthreads(); RESC(alB);
  finishSM(pB0, pB1, alB, l_reg, pa0, pa1, pa2, pa3); SBAR();
  pv_d0(o, vb0 + SHM_V, pa0, pa1, pa2, pa3);
#undef SLOAD
#undef SWRITE
#undef SWAIT
#undef RESC
}
__device__ __forceinline__ void row_inv_l(float l_reg, char* lds, int wid, int r32, int hi, float (&rli)[16]) {
  float* li_l = (float*)(lds + WS_OFF) + wid * 64;
  if (hi == 0) li_l[r32] = l_reg; asm volatile("s_waitcnt lgkmcnt(0)" ::: "memory");
#pragma unroll
  for (int r = 0; r < 16; ++r) rli[r] = __builtin_amdgcn_rcpf(li_l[crow(r, hi)]);
}
template <bool SILU> __device__ __forceinline__ void store_rows_gated(const f32x16 (&v)[4], char* stg, bf16_t* Yrow0  , const bf16_t* Grow0, int gpitch, int lane, int r32, int hi) {
  bf16_t* st = (bf16_t*)stg;
#pragma unroll
  for (int r = 0; r < 16; ++r) { const int orow = crow(r, hi);
#pragma unroll
    for (int d0 = 0; d0 < 4; ++d0) st[orow * 128 + d0 * 32 + r32] = (bf16_t)f2bf(v[d0][r]); }
  asm volatile("s_waitcnt lgkmcnt(0)" ::: "memory");
  const bf16_t* gp = Grow0 + (size_t)(lane >> 4) * gpitch + (lane & 15) * 8; bf16_t* yp = Yrow0 + (size_t)(lane >> 4) * DM + (lane & 15) * 8; const bf16_t* sp = st + (lane >> 4) * 128 + (lane & 15) * 8;
  u32x4 g[8];
#pragma unroll
  for (int i = 0; i < 8; ++i) { g[i] = *(const u32x4*)gp; gp += 4 * (size_t)gpitch; asm volatile("" : "+v"(gp)); }
#pragma unroll
  for (int i = 0; i < 8; ++i) {
    const u32x4 x = *(const u32x4*)(sp + i * 4 * 128);
    u32x4 w; w.x = pk2(bflo(x.x) * GATE(bflo(g[i].x)), bfhi(x.x) * GATE(bfhi(g[i].x))); w.y = pk2(bflo(x.y) * GATE(bflo(g[i].y)), bfhi(x.y) * GATE(bfhi(g[i].y)));
    w.z = pk2(bflo(x.z) * GATE(bflo(g[i].z)), bfhi(x.z) * GATE(bfhi(g[i].z))); w.w = pk2(bflo(x.w) * GATE(bflo(g[i].w)), bfhi(x.w) * GATE(bfhi(g[i].w)));
    *(u32x4*)yp = w; yp += 4 * DM; asm volatile("" : "+v"(yp)); }
  asm volatile("s_waitcnt lgkmcnt(0)" ::: "memory");
}
__device__ __forceinline__ void gqa_unit(const Params& p, char* lds, int m0, int hq, const bf16_t* Kh, const bf16_t* Vh, int seq, const int wid) {
  const int lane = fresh_lane(), r32 = lane & 31, hi = lane >> 5;
  const bf16_t* QC = (const bf16_t*)(p.ws + WS_Q); const bf16_t* PR = (const bf16_t*)(p.ws + WS_PR); bf16_t* Y = (bf16_t*)(p.ws + WS_HY);
  f32x16 o[4]; float l_reg;
  attn_core<8>(QC + (size_t)(m0 + wid * QBLK + r32) * DM + hq * 128 + hi * 8, Kh, Vh, seq, 0, lds, o, l_reg, wid, lane);
  float rli[16]; row_inv_l(l_reg, lds, wid, r32, hi, rli);
#pragma unroll
  for (int d0 = 0; d0 < 4; ++d0)
#pragma unroll
    for (int r = 0; r < 16; ++r) o[d0][r] *= rli[r];
  __syncthreads();
  const size_t row0 = (size_t)(m0 + wid * QBLK);
  store_rows_gated<false>(o, lds + wid * 8192, Y + row0 * DM + hq * 128, (const bf16_t*)(p.ws + WS_SG) + row0 * DM + hq * 128, DM, lane, r32, hi);
  __syncthreads();
}
constexpr int RES_WS = 131072 + 1024, RES_EX = 131072 + 4096;
__device__ __forceinline__ void load_kv_resident(const bf16_t* __restrict__ Kh, const bf16_t* __restrict__ Vh, char* lds, int tid) {
  bf16x8 kr[8], vr[8];
#pragma unroll
  for (int i = 0; i < 8; ++i) { const int c = tid + 512 * i; kr[i] = *reinterpret_cast<const bf16x8*>(Kh + (size_t)c * 8); vr[i] = *reinterpret_cast<const bf16x8*>(Vh + (size_t)c * 8); }
#pragma unroll
  for (int i = 0; i < 8; ++i) { const int c = tid + 512 * i, key = c >> 4, col = (c & 15) * 8, t = key >> 6, k = key & 63;
    *(bf16x8*)(lds + 65536 + t * 16384 + v_st(k, col)) = vr[i];
    *(bf16x8*)(lds + t * 16384 + KSWZ(k, col * 2)) = kr[i]; }
}
template <int ND0>
__device__ __forceinline__ void attn_core_res(const bf16_t* Qw, int kcol0, char* lds, f32x16 (&o)[4], float& l_reg, const int wid, const int lane) {
  const int r32 = lane & 31, hi = lane >> 5;
  const char* K_lds = lds; float* al_l = (float*)(lds + RES_WS) + wid * 64 + 32;
  float m_reg = -1e30f; l_reg = 0; bf16x8 qr[ND0];
  f32x16 cinit; for (int r = 0; r < 16; ++r) cinit[r] = -SOFT_OFF;
#pragma unroll
  for (int d = 0; d < 4; ++d) o[d] = f32x16{};
#pragma unroll
  for (int d0 = 0; d0 < ND0; ++d0) qr[d0] = *reinterpret_cast<const bf16x8*>(Qw + d0 * 16);
  const int vb0 = (int)(uintptr_t)(lds + 65536) + v_rd_base(lane);
#define RESC(a) do { if (__any((a) < 1.f)) { if (hi == 0) al_l[r32] = (a); asm volatile("s_waitcnt lgkmcnt(0)" ::: "memory"); \
    for (int d = 0; d < 4; ++d) for (int r = 0; r < 16; ++r) o[d][r] *= al_l[crow(r, hi)]; } } while (0)
  f32x16 pA0, pA1, pB0, pB1; float mnA, mnB, alA, alB; bf16x8 pa0, pa1, pa2, pa3;
  qkt<ND0>(pA0, pA1, K_lds, qr, r32, hi, kcol0, cinit); partialSM(pA0, pA1, m_reg, mnA, alA);
  SBAR(); qkt<ND0>(pB0, pB1, K_lds + 16384, qr, r32, hi, kcol0, cinit);
  finishSM(pA0, pA1, alA, l_reg, pa0, pa1, pa2, pa3); SBAR();
  pv_d0(o, vb0, pa0, pa1, pa2, pa3); partialSM(pB0, pB1, m_reg, mnB, alB); RESC(alB);
  SBAR(); qkt<ND0>(pA0, pA1, K_lds + 2 * 16384, qr, r32, hi, kcol0, cinit);
  finishSM(pB0, pB1, alB, l_reg, pa0, pa1, pa2, pa3); SBAR();
  pv_d0(o, vb0 + 16384, pa0, pa1, pa2, pa3); partialSM(pA0, pA1, m_reg, mnA, alA); RESC(alA);
  SBAR(); qkt<ND0>(pB0, pB1, K_lds + 3 * 16384, qr, r32, hi, kcol0, cinit);
  finishSM(pA0, pA1, alA, l_reg, pa0, pa1, pa2, pa3); SBAR();
  pv_d0(o, vb0 + 2 * 16384, pa0, pa1, pa2, pa3); partialSM(pB0, pB1, m_reg, mnB, alB); RESC(alB);
  finishSM(pB0, pB1, alB, l_reg, pa0, pa1, pa2, pa3); SBAR();
  pv_d0(o, vb0 + 3 * 16384, pa0, pa1, pa2, pa3);
#undef RESC
}
__device__ __forceinline__ void row_inv_l_res(float l_reg, char* lds, int wid, int r32, int hi, float (&rli)[16]) {
  float* li_l = (float*)(lds + RES_WS) + wid * 64;
  if (hi == 0) li_l[r32] = l_reg; asm volatile("s_waitcnt lgkmcnt(0)" ::: "memory");
#pragma unroll
  for (int r = 0; r < 16; ++r) rli[r] = __builtin_amdgcn_rcpf(li_l[crow(r, hi)]);
}
template <bool SILU> __device__ __forceinline__ void store_direct_gated(const f32x16 (&v)[4], char* stg  , bf16_t* Y0  , const bf16_t* G0, int gpitch, int lane, int r32, int hi) {
  bf16_t* st = (bf16_t*)stg;
  const bf16_t* gp = G0 + (size_t)(lane >> 4) * gpitch + (lane & 15) * 8; bf16_t* yp = Y0 + (size_t)(lane >> 4) * DM + (lane & 15) * 8; const bf16_t* sp = st + (lane >> 4) * 128 + (lane & 15) * 8;
  u32x4 g[8];
#pragma unroll
  for (int i = 0; i < 8; ++i) { g[i] = *(const u32x4*)gp; gp += 4 * (size_t)gpitch; asm volatile("" : "+v"(gp)); }
#pragma unroll
  for (int j = 0; j < 4; ++j) {
#pragma unroll
    for (int rr = 0; rr < 4; ++rr)
#pragma unroll
      for (int d0 = 0; d0 < 4; ++d0) st[(rr + 4 * hi) * 128 + d0 * 32 + r32] = (bf16_t)f2bf(v[d0][4 * j + rr]);
    asm volatile("s_waitcnt lgkmcnt(0)" ::: "memory");
#pragma unroll
    for (int i = 0; i < 2; ++i) {
      const u32x4 x = *(const u32x4*)(sp + i * 4 * 128); const u32x4 gg = g[2 * j + i];
      u32x4 w; w.x = pk2(bflo(x.x) * GATE(bflo(gg.x)), bfhi(x.x) * GATE(bfhi(gg.x))); w.y = pk2(bflo(x.y) * GATE(bflo(gg.y)), bfhi(x.y) * GATE(bfhi(gg.y)));
      w.z = pk2(bflo(x.z) * GATE(bflo(gg.z)), bfhi(x.z) * GATE(bfhi(gg.z))); w.w = pk2(bflo(x.w) * GATE(bflo(gg.w)), bfhi(x.w) * GATE(bfhi(gg.w)));
      *(u32x4*)yp = w; yp += 4 * DM; asm volatile("" : "+v"(yp)); }
    asm volatile("s_waitcnt lgkmcnt(0)" ::: "memory");
  }
}
__device__ __forceinline__ void gqa_prompt_slot(const Params& p, char* lds, int bk, const int wid) {
  const int lane = fresh_lane(), r32 = lane & 31, hi = lane >> 5;
  const bf16_t* QC = (const bf16_t*)(p.ws + WS_Q); const bf16_t* PR = (const bf16_t*)(p.ws + WS_PR); bf16_t* Y = (bf16_t*)(p.ws + WS_HY);
  load_kv_resident((const bf16_t*)(p.ws + WS_KP) + (size_t)bk * SEQP * 128, (const bf16_t*)(p.ws + WS_VP) + (size_t)bk * SEQP * 128, lds, wid * 64 + lane);
  __syncthreads();
  const int m0 = (bk >> 2) * SEQP;
  for (int g = 0; g < 4; ++g) {
    const int lane = fresh_lane(), r32 = lane & 31, hi = lane >> 5;
    const int hq = (bk & 3) * 4 + g;
    f32x16 o[4]; float l_reg;
    const size_t row0 = (size_t)(m0 + wid * QBLK);
    attn_core_res<8>(QC + (row0 + r32) * DM + hq * 128 + hi * 8, 0, lds, o, l_reg, wid, lane);
    float rli[16]; row_inv_l_res(l_reg, lds, wid, r32, hi, rli);
#pragma unroll
    for (int d0 = 0; d0 < 4; ++d0)
#pragma unroll
      for (int r = 0; r < 16; ++r) o[d0][r] *= rli[r];
    store_direct_gated<false>(o, lds + RES_EX + wid * 2048, Y + row0 * DM + hq * 128, (const bf16_t*)(p.ws + WS_SG) + row0 * DM + hq * 128, DM, lane, r32, hi);
  }
  __syncthreads();
}
__device__ __forceinline__ void diff_prompt_slot(const Params& p, char* lds, int slot  , float lam, const int wid) {
  const int lane = fresh_lane(), r32 = lane & 31, hi = lane >> 5, rg = wid & 3, mp = wid >> 2;
  const bf16_t* QA = (const bf16_t*)(p.ws + WS_Q); const bf16_t* PR = (const bf16_t*)(p.ws + WS_PR); bf16_t* Y = (bf16_t*)(p.ws + WS_HY);
  for (int hh = 0; hh < 2; ++hh) {
    const int bh = slot * 2 + hh, h = bh & 7, b = bh >> 3;
    load_kv_resident((const bf16_t*)(p.ws + WS_KP) + (size_t)bh * SEQP * 128, (const bf16_t*)(p.ws + WS_VP) + (size_t)bh * SEQP * 128, lds, wid * 64 + lane);
    __syncthreads();
    for (int qb = 0; qb < 2; ++qb) {
      const int lane = fresh_lane(), r32 = lane & 31, hi = lane >> 5;
      const size_t row0 = (size_t)(b * SEQP + qb * 128 + rg * QBLK);
      f32x16 o[4]; float l_reg;
      attn_core_res<4>(QA + (row0 + r32) * 1024 + h * 128 + mp * 64 + hi * 8, mp * 64, lds, o, l_reg, wid, lane);
      float rli[16]; row_inv_l_res(l_reg, lds, wid, r32, hi, rli);
      float* ex = (float*)(lds + RES_EX) + rg * 1024 + lane;
      float ss[16];
#pragma unroll
      for (int r = 0; r < 16; ++r) ss[r] = 0.f;
#pragma unroll
      for (int d0 = 0; d0 < 4; ++d0) {
        if (mp == 1) {
#pragma unroll
          for (int r = 0; r < 16; ++r) ex[r * 64] = o[d0][r] * (rli[r] * lam); }
        __syncthreads();
        if (mp == 0) {
#pragma unroll
          for (int r = 0; r < 16; ++r) { const float v = o[d0][r] * rli[r] - ex[r * 64]; o[d0][r] = v; ss[r] += v * v; } }
        __syncthreads();
      }
      if (mp == 0) {
#pragma unroll
        for (int r = 0; r < 16; ++r) {
#pragma unroll
          for (int of = 1; of < 32; of <<= 1) ss[r] += __shfl_xor(ss[r], of);
          ss[r] = 0.8f / sqrtf(ss[r] * (1.f / 128.f) + EPS); }
#pragma unroll
        for (int d0 = 0; d0 < 4; ++d0) { const float sw = p.subln_w[d0 * 32 + r32];
#pragma unroll
          for (int r = 0; r < 16; ++r) o[d0][r] *= ss[r] * sw; }
        store_direct_gated<false>(o, lds + RES_EX + 16384 + rg * 2048, Y + row0 * DM + h * 128, (const bf16_t*)(p.ws + WS_SG) + row0 * DM + h * 128, DM, lane, r32, hi);
      }
    }
    __syncthreads();
  }
}
__device__ __forceinline__ void gqa_phase(const Params& p, char* lds, int vcu, int G, const int wid, const int mode) {
  for (int v = vcu; v < 256; v += G) {
    if (v < 128) { if (mode & 1) continue;
      const int qb = v & 3, g = (v >> 2) & 3, bk = v >> 4;
      gqa_unit(p, lds, MP + (bk >> 2) * SEQS + qb * 256, (bk & 3) * 4 + g, (const bf16_t*)(p.ws + WS_KSC) + (size_t)bk * LKS * 128, (const bf16_t*)(p.ws + WS_VSC) + (size_t)bk * LKS * 128, LKS, wid); }
    else { if (mode & 2) continue; gqa_prompt_slot(p, lds, v - 128, wid); }
  }
}
__device__ __forceinline__ void diff_unit(const Params& p, char* lds, int m0, int h, const bf16_t* Kh, const bf16_t* Vh, int seq, float lam, const int wid) {
  const int lane = fresh_lane(), r32 = lane & 31, hi = lane >> 5, rg = wid & 3, mp = wid >> 2;
  const bf16_t* QA = (const bf16_t*)(p.ws + WS_Q); const bf16_t* PR = (const bf16_t*)(p.ws + WS_PR); bf16_t* Y = (bf16_t*)(p.ws + WS_HY);
  f32x16 o[4]; float l_reg;
  attn_core<4>(QA + (size_t)(m0 + rg * QBLK + r32) * 1024 + h * 128 + mp * 64 + hi * 8, Kh, Vh, seq, mp * 64, lds, o, l_reg, wid, lane);
  float rli[16]; row_inv_l(l_reg, lds, wid, r32, hi, rli);
  __syncthreads();
  float* ex = (float*)lds + rg * 4096 + lane;
  if (mp == 1) {
#pragma unroll
    for (int d0 = 0; d0 < 4; ++d0)
#pragma unroll
      for (int r = 0; r < 16; ++r) ex[(d0 * 16 + r) * 64] = o[d0][r] * (rli[r] * lam);
  }
  __syncthreads();
  if (mp == 0) {
    float ss[16];
#pragma unroll
    for (int r = 0; r < 16; ++r) ss[r] = 0.f;
#pragma unroll
    for (int d0 = 0; d0 < 4; ++d0)
#pragma unroll
      for (int r = 0; r < 16; ++r) { const float v = o[d0][r] * rli[r] - ex[(d0 * 16 + r) * 64]; o[d0][r] = v; ss[r] += v * v; }
#pragma unroll
    for (int r = 0; r < 16; ++r) {
#pragma unroll
      for (int of = 1; of < 32; of <<= 1) ss[r] += __shfl_xor(ss[r], of);
      ss[r] = 0.8f / sqrtf(ss[r] * (1.f / 128.f) + EPS); }
#pragma unroll
    for (int d0 = 0; d0 < 4; ++d0) { const float sw = p.subln_w[d0 * 32 + r32];
#pragma unroll
      for (int r = 0; r < 16; ++r) o[d0][r] *= ss[r] * sw; }
    const size_t row0 = (size_t)(m0 + rg * QBLK);
    store_rows_gated<false>(o, lds + STG_OFF + rg * 8192, Y + row0 * DM + h * 128, (const bf16_t*)(p.ws + WS_SG) + row0 * DM + h * 128, DM, lane, r32, hi);
  }
  __syncthreads();
}
__device__ __forceinline__ void diff_phase(const Params& p, char* lds, int vcu, int G, const int wid, const int mode) {
  const int lane = fresh_lane();
  const float lam = expf(wave_sum(p.lam_q1[lane] * p.lam_k1[lane])) - expf(wave_sum(p.lam_q2[lane] * p.lam_k2[lane])) + 0.2f;
  for (int v = vcu; v < 256; v += G) {
    if (v < 128) { if (mode & 1) continue;
      const int qb = v & 7, bh = v >> 3;
      diff_unit(p, lds, MP + (bh >> 3) * SEQS + qb * 128, bh & 7, (const bf16_t*)(p.ws + WS_KSA) + (size_t)bh * LKS * 128, (const bf16_t*)(p.ws + WS_VSA) + (size_t)bh * LKS * 128, LKS, lam, wid);
      if (!(mode & 4)) pool_apply_slot(p, v, wid * 64 + fresh_lane()); }
    else { if (mode & 2) continue; diff_prompt_slot(p, lds, v - 128, lam, wid); }
  }
}
#undef KSWZ
#undef SBAR
}

constexpr int NWAVES = 8;
constexpr int RING_OFF = 0, RING_BYTES = 131072;
constexpr int LDSCTL_OFF = RING_BYTES, MISC_OFF = LDSCTL_OFF + 320;
constexpr int LDS_BYTES = 163840;
constexpr int RES_WS_OFF = RING_BYTES + 1024, RES_EX_OFF = RING_BYTES + 4096;
constexpr int CW_BAR = 4096;
#define GAS __attribute__((address_space(1)))
#define LAS __attribute__((address_space(3)))
typedef GAS unsigned gu32;
#define RLX_AGENT __ATOMIC_RELAXED, __HIP_MEMORY_SCOPE_AGENT
#define XB_TMO      128
#define XB_XCNT(j)  (256  + 64 * (j))
#define XB_XSUB(j)  (1280 + 64 * (j))
#define XB_XGEN(j)  (2304 + 64 * (j))
#define XB_TOP      3328
#define XB_TOPGEN   3392
#define XCD_BAR_WORDS 3456
#define XB_SPIN_CAP (1u << 18)
__device__ __forceinline__ unsigned xb_ld(unsigned* p)              { return __hip_atomic_load(p, __ATOMIC_RELAXED, __HIP_MEMORY_SCOPE_AGENT); }
__device__ __forceinline__ unsigned xb_add(unsigned* p, unsigned v) { return __hip_atomic_fetch_add(p, v, __ATOMIC_RELAXED, __HIP_MEMORY_SCOPE_AGENT); }
__device__ __forceinline__ unsigned xb_xcc_id() { return (unsigned)__builtin_amdgcn_s_getreg((3 << 11) | 20) & 0xFu; }
#define XB_SPIN(cond, bar) do { unsigned _sp = 0; while (cond) { __builtin_amdgcn_s_sleep(1); \
    if ((++_sp & 255u) == 0u) { if (xb_ld(&(bar)[XB_TMO])) break; if (_sp > XB_SPIN_CAP) { atomicAdd(&(bar)[XB_TMO], 1u); break; } } } } while (0)
struct XcdBarrier { unsigned* bar; unsigned x; volatile LAS unsigned* st; };
__device__ __forceinline__ XcdBarrier xcd_barrier_post(unsigned* bar, volatile LAS unsigned* st) {
    XcdBarrier b; b.bar = bar; b.x = xb_xcc_id(); b.st = st;
    if (threadIdx.x == 0) (void)xb_add(&bar[XB_XCNT(b.x)], 1u);
    return b;
}
__device__ __forceinline__ void xcd_barrier_complete(unsigned* bar, unsigned x, unsigned& nloc, unsigned& nx) {
    const unsigned G = gridDim.x * gridDim.y * gridDim.z;
    unsigned sum, cnt, mine, sp = 0u;
    for (;;) {
        sum = 0u; cnt = 0u; mine = 0u;
#pragma unroll
        for (unsigned j = 0; j < 16; ++j) { const unsigned c = xb_ld(&bar[XB_XCNT(j)]); sum += c; cnt += (c > 0u) ? 1u : 0u; mine = (j == x) ? c : mine; }
        if (sum == G) break;
        __builtin_amdgcn_s_sleep(1);
        if ((++sp & 255u) == 0u) { if (xb_ld(&bar[XB_TMO])) break; if (sp > XB_SPIN_CAP) { atomicAdd(&bar[XB_TMO], 1u); break; } }
    }
    nloc = mine > 0u ? mine : 1u; nx = cnt > 0u ? cnt : 1u;
}
__device__ __forceinline__ void xcd_barrier(const XcdBarrier& b) {
    asm volatile("s_waitcnt vmcnt(0)" ::: "memory");
    __syncthreads();
    if (threadIdx.x == 0) {
        unsigned* bar = b.bar;
        __builtin_amdgcn_s_waitcnt(0);
        unsigned nloc = b.st[0], nx = b.st[1];
        if (nloc == 0u) { xcd_barrier_complete(bar, b.x, nloc, nx); b.st[0] = nloc; b.st[1] = nx; }
        const unsigned old = xb_add(&bar[XB_XSUB(b.x)], 1u);
        const unsigned gen = old / nloc;
        if (old + 1u == (gen + 1u) * nloc) {
            __builtin_amdgcn_fence(__ATOMIC_RELEASE, "agent");
            asm volatile("s_waitcnt vmcnt(0)" ::: "memory");
            const unsigned og = xb_add(&bar[XB_TOP], 1u);
            const unsigned tg = og / nx;
            if (og + 1u == (tg + 1u) * nx) xb_add(&bar[XB_TOPGEN], 1u);
            else XB_SPIN(xb_ld(&bar[XB_TOPGEN]) == tg, bar);
            __builtin_amdgcn_fence(__ATOMIC_ACQUIRE, "agent");
            xb_add(&bar[XB_XGEN(b.x)], 1u);
            asm volatile("s_waitcnt vmcnt(0)" ::: "memory");
        } else {
            XB_SPIN(xb_ld(&bar[XB_XGEN(b.x)]) == gen, bar);
            __builtin_amdgcn_fence(__ATOMIC_ACQUIRE, "agent");
            asm volatile("s_waitcnt vmcnt(0)" ::: "memory");
        }
    }
    __syncthreads();
}

constexpr size_t WS_SLAB = WS_PR + 40 * MiB;
constexpr size_t CTL_TAIL = 256 * 1024;
template <int KIND> __device__ __forceinline__ void tail_reduce(const Params& p, const pg8::StaticOrder& S, int slot, int wave, int lane) {
    if (S.split <= 1) return;
    const int c = S.c, xcd = c % 8, q = c / 8, split = S.split, ks = q % split, j = (q / split) * 8 + xcd;
    pg8::Unit u; S.tile(S.nfull + j, u);
    unsigned* cnt = (unsigned*)(p.ws + WS_CTL + CTL_TAIL) + slot * 4096 + 64 * j;
    asm volatile("s_waitcnt vmcnt(0)" ::: "memory");
    __syncthreads();
    if (threadIdx.x == 0) {
        __builtin_amdgcn_fence(__ATOMIC_RELEASE, "agent");
        asm volatile("s_waitcnt vmcnt(0)" ::: "memory");
        __hip_atomic_fetch_add(cnt, 1u, __ATOMIC_RELAXED, __HIP_MEMORY_SCOPE_AGENT);
        unsigned sp = 0;
        while (__hip_atomic_load(cnt, __ATOMIC_RELAXED, __HIP_MEMORY_SCOPE_AGENT) < (unsigned)split) { __builtin_amdgcn_s_sleep(1); if (++sp > (1u << 22)) break; }
        __builtin_amdgcn_fence(__ATOMIC_ACQUIRE, "agent");
        asm volatile("s_waitcnt vmcnt(0)" ::: "memory");
    }
    __syncthreads();
    const int R = 256 / split, rpw = R / 8;
    const float* sb = (const float*)(p.ws + WS_SLAB) + (size_t)(j * split) * 65536 + 4 * lane;
    const int col = u.pn * 256 + 4 * lane;
    for (int i = 0; i < rpw; ++i) {
        const int rl = ks * R + wave * rpw + i, r = u.pm * 256 + rl, cr = cond_row(r);
        f32x4 sum = {0.f, 0.f, 0.f, 0.f};
        for (int sidx = 0; sidx < split; ++sidx) sum += *(const f32x4*)(sb + (size_t)sidx * 65536 + (size_t)rl * 256);
        if (KIND == 0) {
            const f32x4 x = *(const f32x4*)(xrow_ptr(p, r) + col), gt = *(const f32x4*)((const float*)(p.ws + WS_MOD) + 4096 + (size_t)cr * 6144 + col), cw = *(const f32x4*)((const float*)(p.ws + WS_CW1) + (size_t)cr * DM + col);
            const f32x4 y = x + gt * sum;
            *(f32x4*)(p.out + (size_t)r * DM + col) = y;
            const f32x4 h = y * cw; u32x2 o; o.x = pk2(h[0], h[1]); o.y = pk2(h[2], h[3]);
            *(u32x2*)((bf16_t*)(p.ws + WS_H1) + (size_t)r * DM + col) = o;
            const float ss = wave_sum((y[0] * y[0] + y[1] * y[1]) + (y[2] * y[2] + y[3] * y[3]));
            if (lane == 0) atomicAdd((float*)(p.ws + WS_RSS) + r, ss);
        } else if (KIND == 1) {
            const f32x4 gt = *(const f32x4*)((const float*)(p.ws + WS_MOD) + 3 * 6144 + 4096 + (size_t)cr * 6144 + col);
            float* op = p.out + (size_t)r * DM + col; *(f32x4*)op = *(const f32x4*)op + gt * sum;
        } else {
            const float rstd = 1.0f / sqrtf(((const float*)(p.ws + WS_RSS))[r] * (1.f / DM) + EPS);
            const f32x4 v = sum * rstd + *(const f32x4*)((const float*)(p.ws + WS_B2P) + (size_t)cr * ODD_IN + col);
            u32x2 o; o.x = pk2(siluf(v[0]), siluf(v[1])); o.y = pk2(siluf(v[2]), siluf(v[3]));
            *(u32x2*)((bf16_t*)(p.ws + WS_SG) + (size_t)r * DM + (col - 12 * 256)) = o;
        }
    }
}

struct MegaArgs { Params p; int ph_lo, ph_hi, mode, pad; };
constexpr int N_PHASES = 11;
#ifndef DUP_PHASE
#define DUP_PHASE -1
#endif
__device__ __forceinline__ Params load_params() {
#if defined(__HIP_DEVICE_COMPILE__)
    typedef __attribute__((address_space(4))) const unsigned long long* KPtr;
    KPtr a = (KPtr)__builtin_amdgcn_kernarg_segment_ptr();
    asm volatile("" : "+s"(a));
#define GPF(i) ((const float*)(__attribute__((address_space(1))) const float*)(a[i]))
    Params p;
    p.x_prompt = GPF(0); p.x_sample = GPF(1); p.cache_a_k = GPF(2); p.cache_a_v = GPF(3); p.cache_c_k = GPF(4); p.cache_c_v = GPF(5);
    p.c = GPF(6); p.c_ctx = GPF(7); p.norm_w = GPF(8); p.ada_w = GPF(9); p.ada_b = GPF(10);
    p.even_w_in = GPF(11); p.even_q_norm_w = GPF(12); p.even_k_norm_w = GPF(13); p.lam_q1 = GPF(14); p.lam_k1 = GPF(15); p.lam_q2 = GPF(16); p.lam_k2 = GPF(17);
    p.subln_w = GPF(18); p.pool_w = GPF(19); p.pool_scale = GPF(20); p.even_w_out = GPF(21);
    p.gqa_w_in = GPF(22); p.gqa_q_norm_w = GPF(23); p.gqa_k_norm_w = GPF(24); p.gqa_w_out = GPF(25);
    p.out = (float*)(__attribute__((address_space(1))) float*)(a[26]); p.ws = (unsigned char*)(__attribute__((address_space(1))) unsigned char*)(a[27]);
#undef GPF
    return p;
#else
    return Params{};
#endif
}
__global__ void __launch_bounds__(NWAVES * 64, 2) mega_fwd(MegaArgs args) {
    extern __shared__ __attribute__((aligned(16))) unsigned char lds[];
    LAS unsigned char* ldsl = (LAS unsigned char*)lds;
    volatile LAS unsigned* MISC = (volatile LAS unsigned*)(ldsl + MISC_OFF);
    const int wave = __builtin_amdgcn_readfirstlane(threadIdx.x >> 6);
    const int G = gridDim.x, bx = blockIdx.x;
    const int vcu = (G % 8 == 0) ? (bx % 8) * (G / 8) + bx / 8 : bx;
    for (int u = threadIdx.x; u < (LDS_BYTES - LDSCTL_OFF) / 4; u += NWAVES * 64) ((LAS unsigned*)(ldsl + LDSCTL_OFF))[u] = 0u;
    __syncthreads();
    XcdBarrier bar; { const Params p0 = load_params(); bar = xcd_barrier_post((unsigned*)(p0.ws + WS_CTL) + CW_BAR, MISC + 8); }
    const int lo = args.ph_lo, hi = args.ph_hi, mode = args.mode;
    const int gw = vcu * NWAVES + wave, ngw = G * NWAVES;
#define IN(k) (lo <= (k) && (k) < hi)
#define SEAM(k) do { if (IN(k) && (IN((k) + 1) || ((k) == 7 && IN(9)) || ((k) == 5 && IN(7)) || ((k) == 2 && IN(4)))) xcd_barrier(bar); } while (0)
    if (IN(0)) {
        const Params p = load_params();
        float* scr = (float*)lds; const int lane = fresh_lane(), tid = wave * 64 + lane;
        if (!(mode & 8)) mod_items(p, scr, bx, G, tid, NWAVES * 64);
        __syncthreads();
        if (!(mode & 16)) weights_items(p, (float*)(lds + wave * 16384), gw, ngw, lane);
        if (!(mode & 32)) caches_rope_items(p, (long)bx * 512 + tid, (long)G * 512);
    }
    SEAM(0);
    if (IN(1)) {
        const Params p = load_params(); unsigned char* const ws = p.ws;
        if (bx < 32) {
            pg8::Gemm g{(const bf16_t*)(ws + WS_POOLW), (const bf16_t*)(ws + WS_WU), 1024, DM, 256, 256, 1024, 0, 256, 0}; pg8::StaticOrder S; S.init(1024, DM, 256, G, bx, false);
            pg8::EpiBf16 E{(bf16_t*)(ws + WS_WINE) + (size_t)3072 * DM, DM, 0};
            pg8::gemm_phase<pg8::EpiBf16, pg8::StaticOrder, true, true>(ldsl + RING_OFF, g, S, E, wave * 64 + fresh_lane());
        } else { const int ln = fresh_lane(), g2 = (bx - 32) * NWAVES + wave, n2 = (G - 32) * NWAVES; modulate_rows(p, 0, g2, n2, ln); mod1_tables(p, g2, n2, ln); }
    }
    SEAM(1);
    if (IN(2)) {
        const Params p = load_params(); unsigned char* const ws = p.ws;
        pg8::Gemm g{(const bf16_t*)(ws + WS_HY), (const bf16_t*)(ws + WS_WINE), MT, EVEN_IN, DM, DM, DM, 0, 0, 0}; pg8::StaticOrder S; S.init(MT, EVEN_IN, DM, G, bx, false);
        float* nak = p.out + (size_t)MT * DM;
        pg8::EpiProj0 E{ws, p.even_q_norm_w, p.even_k_norm_w, nak, nak + (size_t)NBP * HA * SEQP * 128};
        pg8::gemm_phase<pg8::EpiProj0, pg8::StaticOrder, true, true>(ldsl + RING_OFF, g, S, E, wave * 64 + fresh_lane());
    }
    SEAM(2);
    if (IN(4)) { const Params p = load_params(); att::diff_phase(p, (char*)lds, vcu, G, wave, mode); }
    SEAM(4);
    constexpr size_t CTL_PANEL = 320 * 1024;
    const bool stagger = (G == 256) && IN(5) && IN(7);
    if (IN(5)) {
        for (int part = 0; part < (stagger ? 2 : 1); ++part) {
            const Params p = load_params(); unsigned char* const ws = p.ws;
            pg8::Gemm g{(const bf16_t*)(ws + WS_HY), (const bf16_t*)(ws + WS_WOUTE), MT, DM, DM, DM, DM, 0, 0, 0};
            pg8::EpiResid0 E{p.x_prompt, p.x_sample, (const float*)(ws + WS_MOD) + 4096, (const float*)(ws + WS_CW1), p.out, (bf16_t*)(ws + WS_H1), (float*)(ws + WS_RSS), (float*)(ws + WS_SLAB)};
            if (stagger) {
                if (part == 1 && bx >= 64) break;
                pg8::OutOrder S{bx, part};
                pg8::gemm_phase<pg8::EpiResid0, pg8::OutOrder, true, true>(ldsl + RING_OFF, g, S, E, wave * 64 + fresh_lane());
                if (part == 0) xcd_barrier(bar);
                else {
                    asm volatile("s_waitcnt vmcnt(0)" ::: "memory"); __syncthreads();
                    if (threadIdx.x == 0) { __builtin_amdgcn_fence(__ATOMIC_RELEASE, "agent"); asm volatile("s_waitcnt vmcnt(0)" ::: "memory");
                        __hip_atomic_fetch_add((unsigned*)(ws + WS_CTL + CTL_PANEL) + 64 * (bx / 8), 1u, __ATOMIC_RELAXED, __HIP_MEMORY_SCOPE_AGENT); }
                }
            } else {
                pg8::StaticOrder S; S.init(MT, DM, DM, G, bx, false);
                pg8::gemm_phase<pg8::EpiResid0, pg8::StaticOrder, true, true>(ldsl + RING_OFF, g, S, E, wave * 64 + fresh_lane());
            }
        }
    }
    if (!stagger) SEAM(5);
    if (IN(7)) {
        const Params p = load_params(); unsigned char* const ws = p.ws;
        pg8::Gemm g{(const bf16_t*)(ws + WS_H1), (const bf16_t*)(ws + WS_WINO), MT, ODD_IN, DM, DM, DM, 0, 0, 0};
        float* nck = p.out + (size_t)MT * DM + 2 * (size_t)NBP * HA * SEQP * 128;
        pg8::EpiProj1 E{ws, p.gqa_q_norm_w, p.gqa_k_norm_w, nck, nck + (size_t)NBP * KVH * SEQP * 128, (LAS float*)(ldsl + RES_EX_OFF), (float*)(ws + WS_SLAB)};
        if (stagger) { pg8::StaggerOrder S{bx, (const unsigned*)(ws + WS_CTL + CTL_PANEL), true};
            pg8::gemm_phase<pg8::EpiProj1, pg8::StaggerOrder, true, true>(ldsl + RING_OFF, g, S, E, wave * 64 + fresh_lane()); }
        else { pg8::StaticOrder S; S.init(MT, ODD_IN, DM, G, bx, false);
            pg8::gemm_phase<pg8::EpiProj1, pg8::StaticOrder, true, true>(ldsl + RING_OFF, g, S, E, wave * 64 + fresh_lane()); }
    }
    SEAM(7);
    if (IN(9)) { const Params p = load_params(); att::gqa_phase(p, (char*)lds, vcu, G, wave, mode); }
    SEAM(9);
    if (IN(10)) {
        const Params p = load_params(); unsigned char* const ws = p.ws;
        pg8::Gemm g{(const bf16_t*)(ws + WS_HY), (const bf16_t*)(ws + WS_WOUTO), MT, DM, DM, DM, DM, 0, 0, 0};
        pg8::EpiResidF E{p.x_prompt, p.x_sample, p.out, (const float*)(ws + WS_MOD) + 3 * 6144 + 4096, p.out, (float*)(ws + WS_SLAB)};
        if (G == 256) { pg8::LastOrder S{bx}; pg8::gemm_phase<pg8::EpiResidF, pg8::LastOrder, true, true>(ldsl + RING_OFF, g, S, E, wave * 64 + fresh_lane()); }
        else { pg8::StaticOrder S; S.init(MT, DM, DM, G, bx, false); pg8::gemm_phase<pg8::EpiResidF, pg8::StaticOrder, true, true>(ldsl + RING_OFF, g, S, E, wave * 64 + fresh_lane()); }
    }
#undef IN
#undef SEAM
}

#ifndef MK_PER_PHASE
#define MK_PER_PHASE 0
#endif
extern "C" void kernel_launch(void* const* d_in, const int* in_sizes, int n_in, void* d_out, int out_size, void* d_ws, size_t ws_size, hipStream_t stream) {
    if (n_in != 26 || ws_size < WS_END || out_size != MT * DM + 2 * NBP * HA * SEQP * 128 + 2 * NBP * KVH * SEQP * 128) {
        fprintf(stderr, "kernel_launch: unexpected shapes n_in %d ws %zu out %d\n", n_in, ws_size, out_size); return; }
    static int ready = 0;
    if (!ready) {
        if (hipFuncSetAttribute((const void*)mega_fwd, hipFuncAttributeMaxDynamicSharedMemorySize, LDS_BYTES) != hipSuccess) { fprintf(stderr, "kernel_launch: hipFuncSetAttribute failed\n"); return; }
        ready = 1;
    }
    MegaArgs a{};
    const float** pin = (const float**)&a.p;
    for (int i = 0; i < 26; ++i) pin[i] = (const float*)d_in[i];
    a.p.out = (float*)d_out; a.p.ws = (unsigned char*)d_ws;
#ifdef EXTRA_PHASE
    (void)hipMemsetAsync((unsigned char*)d_ws + WS_CTL, 0, 2 * MiB, stream);
    a.ph_lo = EXTRA_PHASE; a.ph_hi = EXTRA_PHASE + 1; hipLaunchKernelGGL(mega_fwd, dim3(256), dim3(NWAVES * 64), LDS_BYTES, stream, a);
#endif
    (void)hipMemsetAsync((unsigned char*)d_ws + WS_CTL, 0, 2 * MiB, stream);
#if MK_PER_PHASE
    for (int ph = 0; ph < N_PHASES; ++ph) { a.ph_lo = ph; a.ph_hi = ph + 1; hipLaunchKernelGGL(mega_fwd, dim3(256), dim3(NWAVES * 64), LDS_BYTES, stream, a); }
#else
    a.ph_lo = 0; a.ph_hi = N_PHASES; hipLaunchKernelGGL(mega_fwd, dim3(256), dim3(NWAVES * 64), LDS_BYTES, stream, a);
#endif
#ifdef EXTRA_AFTER
    (void)hipMemsetAsync((unsigned char*)d_ws + WS_CTL, 0, 1 * MiB, stream);
    a.ph_lo = EXTRA_AFTER; a.ph_hi = EXTRA_AFTER + 1; a.mode = EXTRA_MODE; hipLaunchKernelGGL(mega_fwd, dim3(256), dim3(NWAVES * 64), LDS_BYTES, stream, a);
#endif
}
```

```cpp
#include <hip/hip_runtime.h>
#include <cstdio>
#include <cstdint>

typedef unsigned short bf16_t;
typedef float f32x4 __attribute__((ext_vector_type(4)));
typedef unsigned u32x4 __attribute__((ext_vector_type(4)));
typedef unsigned u32x2 __attribute__((ext_vector_type(2)));

constexpr int DM = 2048, NBP = 32, SEQP = 256, NBS = 2, SEQS = 1024, PAST = 256;
constexpr int MP = NBP * SEQP, MS = NBS * SEQS, MT = MP + MS;
constexpr int HA = 8, DKA = 64, DVA = 128, WA = 1024, WB = 1024, GWB = 256;
constexpr int EVEN_IN = 6144, ODD_IN = 5120;
constexpr int HC = 16, KVH = 4, HDC = 128;
constexpr int LKS = PAST + SEQS;
constexpr float EPS = 1e-6f;
constexpr float LOG2E = 1.4426950408889634f;
constexpr float C2A = 0.125f * LOG2E;
constexpr float C2C = 0.08838834764831845f * LOG2E;

constexpr size_t MiB = 1u << 20;
constexpr size_t WS_CTL = 0;
constexpr size_t WS_MOD = 1 * MiB;
constexpr size_t WS_ROPE = 2 * MiB;
constexpr size_t WS_WINE = 4 * MiB;
constexpr size_t WS_WOUTE = 28 * MiB;
constexpr size_t WS_WINO = 36 * MiB;
constexpr size_t WS_WOUTO = 56 * MiB;
constexpr size_t WS_POOLW = 64 * MiB;
constexpr size_t WS_HY = 65 * MiB;
constexpr size_t WS_PR = 105 * MiB;
constexpr size_t WS_Q = 225 * MiB;
constexpr size_t WS_KP = 265 * MiB;
constexpr size_t WS_VP = 281 * MiB;
constexpr size_t WS_KSA = 297 * MiB;
constexpr size_t WS_VSA = 302 * MiB;
constexpr size_t WS_KSC = 307 * MiB;
constexpr size_t WS_VSC = 310 * MiB;
constexpr size_t WS_UA = 313 * MiB;
constexpr size_t WS_SG = WS_PR;
constexpr size_t WS_U = WS_PR + 40 * MiB;
constexpr size_t WS_H1 = 333 * MiB;
constexpr size_t WS_WU = WS_UA;
constexpr size_t WS_END = 373 * MiB;
constexpr size_t WS_CW1 = WS_MOD + 256 * 1024;
constexpr size_t WS_B2P = WS_MOD + 320 * 1024;
constexpr size_t WS_RSS = WS_MOD + 512 * 1024;

struct Params {
    const float* x_prompt; const float* x_sample; const float* cache_a_k; const float* cache_a_v; const float* cache_c_k; const float* cache_c_v;
    const float* c; const float* c_ctx; const float* norm_w; const float* ada_w; const float* ada_b;
    const float* even_w_in; const float* even_q_norm_w; const float* even_k_norm_w; const float* lam_q1; const float* lam_k1; const float* lam_q2; const float* lam_k2;
    const float* subln_w; const float* pool_w; const float* pool_scale; const float* even_w_out;
    const float* gqa_w_in; const float* gqa_q_norm_w; const float* gqa_k_norm_w; const float* gqa_w_out;
    float* out; unsigned char* ws;
};

__device__ __forceinline__ unsigned f2bf(float f) { unsigned u = __builtin_bit_cast(unsigned, f); return (u + 0x7fffu + ((u >> 16) & 1u)) >> 16; }
__device__ __forceinline__ unsigned pk2(float lo, float hi) { return f2bf(lo) | (f2bf(hi) << 16); }
__device__ __forceinline__ float bf2f(unsigned h) { return __builtin_bit_cast(float, h << 16); }
__device__ __forceinline__ float bflo(unsigned w) { return __builtin_bit_cast(float, w << 16); }
__device__ __forceinline__ float bfhi(unsigned w) { return __builtin_bit_cast(float, w & 0xffff0000u); }
__device__ __forceinline__ float siluf(float x) { return x / (1.f + __expf(-x)); }
__device__ __forceinline__ float silu_fast(float x) { return x * __builtin_amdgcn_rcpf(1.f + __builtin_amdgcn_exp2f(-LOG2E * x)); }
__device__ __forceinline__ float wave_sum(float v) {
#pragma unroll
    for (int o = 1; o < 64; o <<= 1) v += __shfl_xor(v, o);
    return v;
}
__device__ __forceinline__ float wave_max(float v) {
#pragma unroll
    for (int o = 1; o < 64; o <<= 1) v = fmaxf(v, __shfl_xor(v, o));
    return v;
}
__device__ __forceinline__ int fresh_lane() { int l; asm volatile("v_mbcnt_lo_u32_b32 %0, -1, 0\n\tv_mbcnt_hi_u32_b32 %0, -1, %0" : "=v"(l)); return l; }
__device__ __forceinline__ const float* xrow_ptr(const Params& p, int m) { return m < MP ? p.x_prompt + (size_t)m * DM : p.x_sample + (size_t)(m - MP) * DM; }
__device__ __forceinline__ int cond_row(int m) { return m < MP ? 0 : 1 + ((m - MP) >> 10); }

__device__ __forceinline__ void mod_items(const Params& p, float* sl  , int bid, int nb, int tid, int nthr, int l) {
    float* mod = (float*)(p.ws + WS_MOD);
    float* red = sl + 768;
    const int w = tid >> 6, lane = tid & 63;
    for (int it = bid; it < 192; it += nb) {
        const int kc = it / 24, nc = it % 24;
        __syncthreads();
        for (int i = tid; i < 768; i += nthr) { const int r = i >> 8, kk = i & 255, k = kc * 256 + kk; const float cv = r == 0 ? p.c_ctx[k] : p.c[(r - 1) * DM + k]; sl[i] = siluf(cv); }
        __syncthreads();
        const int n = nc * 256 + lane * 4;
        const float* wp = p.ada_w + ((size_t)l * DM + kc * 256 + w * 32) * 6144 + n;
        f32x4 a0 = {0.f, 0.f, 0.f, 0.f}, a1 = a0, a2 = a0;
#pragma unroll 1
        for (int k0 = 0; k0 < 32; k0 += 16) { f32x4 wv[16];
#pragma unroll
            for (int kk = 0; kk < 16; ++kk) wv[kk] = __builtin_nontemporal_load((const f32x4*)(wp + (size_t)(k0 + kk) * 6144));
#pragma unroll
            for (int kk = 0; kk < 16; ++kk) { const int kr = w * 32 + k0 + kk; a0 += wv[kk] * sl[kr]; a1 += wv[kk] * sl[256 + kr]; a2 += wv[kk] * sl[512 + kr]; } }
        *(f32x4*)(red + ((w * 3 + 0) * 64 + lane) * 4) = a0; *(f32x4*)(red + ((w * 3 + 1) * 64 + lane) * 4) = a1; *(f32x4*)(red + ((w * 3 + 2) * 64 + lane) * 4) = a2;
        __syncthreads();
        if (tid < 192) { const int r = tid >> 6;
            f32x4 sum = (kc == 0) ? *(const f32x4*)(p.ada_b + l * 6144 + n) : (f32x4){0.f, 0.f, 0.f, 0.f};
#pragma unroll
            for (int ww = 0; ww < 8; ++ww) sum += *(const f32x4*)(red + ((ww * 3 + r) * 64 + lane) * 4);
            float* m0 = mod + (size_t)(l * 3 + r) * 6144 + n;
#pragma unroll
            for (int e = 0; e < 4; ++e) atomicAdd(m0 + e, sum[e]); }
    }
}

template <int PERMK> __device__ __forceinline__ int pos_of_col(int n) {
    if (PERMK == 1) { if (n >= 2048) return n; const int c = n & 255, wc = c >> 6, dim = c & 63, q = dim >> 4, ii = dim & 15; return (n & ~255) + 128 * (q & 1) + 32 * wc + (q >> 1) * 16 + ii; }
    if (PERMK == 2) { if (n >= 2560) return n; const int c = n & 255, hl = c >> 7, dim = c & 127, qd = dim >> 5, i = dim & 31; return (n & ~255) + 128 * (qd & 1) + 32 * (2 * hl + (qd >> 1)) + i; }
    return n;
}
template <int PERMK> __device__ __forceinline__ void transpose_item64(const float* W, int K, int N, bf16_t* WT, bf16_t* scr, int item, int lane) {
    const int nblk = N / 64, kb = item / nblk, nb = item % nblk, k0 = 64 * kb, n0 = 64 * nb;
    const int nq = lane & 15, kr = lane >> 4;
    f32x4 v[16];
    const float* src = W + (size_t)(k0 + kr) * N + n0 + 4 * nq;
#pragma unroll
    for (int i = 0; i < 16; ++i) v[i] = __builtin_nontemporal_load((const f32x4*)(src + (size_t)(4 * i) * N));
#pragma unroll
    for (int i = 0; i < 16; ++i) { const int k = 4 * i + kr;
#pragma unroll
        for (int e = 0; e < 4; ++e) scr[(4 * nq + e) * 72 + k] = (bf16_t)f2bf(v[i][e]); }
    __builtin_amdgcn_s_waitcnt(0xc07f); asm volatile("" ::: "memory");
#pragma unroll
    for (int j = 0; j < 8; ++j) { const int idx = lane + 64 * j, n = idx >> 3, c = idx & 7;
        *(u32x4*)(WT + (size_t)pos_of_col<PERMK>(n0 + n) * K + k0 + 8 * c) = *(const u32x4*)(scr + n * 72 + 8 * c); }
    __builtin_amdgcn_s_waitcnt(0xc07f); asm volatile("" ::: "memory");
}
__device__ __forceinline__ void convert_item64(const float* W, int N, bf16_t* WU, int ldu, int ncol0, int item, int nblk0, int lane) {
    const int nblk = N / 64, kb = item / nblk, nb = item % nblk, k0 = 64 * kb, n0 = 64 * nb;
    const int nq = lane & 15, kr = lane >> 4;
    const float* src = W + (size_t)(k0 + kr) * N + n0 + 4 * nq;
    f32x4 v[16];
#pragma unroll
    for (int i = 0; i < 16; ++i) v[i] = __builtin_nontemporal_load((const f32x4*)(src + (size_t)(4 * i) * N));
#pragma unroll
    for (int i = 0; i < 16; ++i) { u32x2 o; o.x = pk2(v[i][0], v[i][1]); o.y = pk2(v[i][2], v[i][3]); *(u32x2*)(WU + (size_t)(k0 + 4 * i + kr) * ldu + (n0 - ncol0) + 4 * nq) = o; }
}
__device__ __forceinline__ void weights_items(const Params& p, float* scrf  , int gw, int ngw, int lane, int part) {
    bf16_t* scr = (bf16_t*)scrf;
    constexpr int I_WU = 32 * 16, I_POOL = 4 * 4, I_WINE = 32 * 80, I_WOUT = 32 * (DM / 64), I_WINO = 32 * (ODD_IN / 64);
    if (part == 0) {
        for (int it = gw; it < I_WU + 4 * I_POOL; it += ngw) {
            if (it < I_WU) { convert_item64(p.even_w_in, EVEN_IN, (bf16_t*)(p.ws + WS_WU), 1024, 3072, (it >> 4) * 96 + 48 + (it & 15), 0, lane); continue; }
            const int r = it - I_WU, g = r / I_POOL;
            transpose_item64<0>(p.pool_w + (size_t)g * 65536, 256, 256, (bf16_t*)(p.ws + WS_POOLW) + (size_t)g * 65536, scr, r - g * I_POOL, lane);
        }
        return;
    }
    for (int it = gw; it < I_WINE + I_WOUT + I_WINO + I_WOUT; it += ngw) {
        int r = it;
        if (r < I_WINE) { const int kb = r / 80, j = r % 80; transpose_item64<1>(p.even_w_in, DM, EVEN_IN, (bf16_t*)(p.ws + WS_WINE), scr, kb * 96 + (j < 48 ? j : j + 16), lane); continue; } r -= I_WINE;
        if (r < I_WOUT) { transpose_item64<0>(p.even_w_out, DM, DM, (bf16_t*)(p.ws + WS_WOUTE), scr, r, lane); continue; } r -= I_WOUT;
        if (r < I_WINO) { transpose_item64<2>(p.gqa_w_in, DM, ODD_IN, (bf16_t*)(p.ws + WS_WINO), scr, r, lane); continue; } r -= I_WINO;
        transpose_item64<0>(p.gqa_w_out, DM, DM, (bf16_t*)(p.ws + WS_WOUTO), scr, r, lane);
    }
}
__device__ __forceinline__ void caches_rope_items(const Params& p, long gt, long ngt) {
    constexpr long NA = 2L * 8 * 256 * 128 / 4, NC = 2L * 4 * 256 * 128 / 4;
    for (long i = gt; i < 2 * NA + 2 * NC; i += ngt) {
        long j = i; const float* src; bf16_t* dst;
        if (j < NA) { src = p.cache_a_k; dst = (bf16_t*)(p.ws + WS_KSA); } else if ((j -= NA) < NA) { src = p.cache_a_v; dst = (bf16_t*)(p.ws + WS_VSA); }
        else if ((j -= NA) < NC) { src = p.cache_c_k; dst = (bf16_t*)(p.ws + WS_KSC); } else { j -= NC; src = p.cache_c_v; dst = (bf16_t*)(p.ws + WS_VSC); }
        const long e = j * 4, bh = e / (256 * 128), rem = e % (256 * 128);
        const f32x4 v = __builtin_nontemporal_load((const f32x4*)(src + e));
        u32x2 o; o.x = pk2(v[0], v[1]); o.y = pk2(v[2], v[3]);
        *(u32x2*)(dst + bh * (LKS * 128) + rem) = o;
    }
    float* ropeA = (float*)(p.ws + WS_ROPE); float* ropeC = ropeA + 2 * 1024 * 64;
    for (long i = gt; i < 1024L * 64 + 1024L * 128; i += ngt) {
        const bool isA = i < 1024L * 64; const long j = isA ? i : i - 1024L * 64; const int dim = isA ? 64 : 128, quarter = dim / 4;
        const int t = (int)(j / dim), d = (int)(j % dim); const int qd = d / quarter, fi = d % quarter;
        const float freq = powf(10000.0f, -(float)fi / (float)quarter);
        const float pos = (qd < 2) ? (float)(t / 64) : (float)(t % 64);
        const float ang = pos * freq;
        float* base = isA ? ropeA : ropeC;
        base[j] = cosf(ang); base[(size_t)1024 * dim + j] = sinf(ang);
    }
}

__device__ __forceinline__ void modulate_rows(const Params& p, int layer, int gw, int ngw, int lane) {
    const float* mod = (const float*)(p.ws + WS_MOD) + (size_t)layer * 3 * 6144;
    const float* nw = p.norm_w + layer * DM;
    bf16_t* H = (bf16_t*)(p.ws + WS_HY);
    f32x4 cw[8], sh[8]; int cur_cr = -1;
    f32x4 v[8], vn[8];
    if (gw < MT) { const float* xr = layer == 0 ? xrow_ptr(p, gw) : p.out + (size_t)gw * DM;
#pragma unroll
        for (int j = 0; j < 8; ++j) v[j] = __builtin_nontemporal_load((const f32x4*)(xr + 4 * lane + 256 * j)); }
    for (int m = gw; m < MT; m += ngw) {
        const int mn = m + ngw;
        if (mn < MT) { const float* xr = layer == 0 ? xrow_ptr(p, mn) : p.out + (size_t)mn * DM;
#pragma unroll
            for (int j = 0; j < 8; ++j) vn[j] = __builtin_nontemporal_load((const f32x4*)(xr + 4 * lane + 256 * j)); }
        float ss = 0.f;
#pragma unroll
        for (int j = 0; j < 8; ++j) ss += (v[j][0] * v[j][0] + v[j][1] * v[j][1]) + (v[j][2] * v[j][2] + v[j][3] * v[j][3]);
        const int cr = cond_row(m);
        if (cr != cur_cr) { cur_cr = cr; const float* mr = mod + (size_t)cr * 6144;
#pragma unroll
            for (int j = 0; j < 8; ++j) { const int k = 4 * lane + 256 * j; cw[j] = *(const f32x4*)(nw + k) * (*(const f32x4*)(mr + 2048 + k) + 1.0f); sh[j] = *(const f32x4*)(mr + k); } }
        const float rstd = 1.0f / sqrtf(wave_sum(ss) * (1.f / DM) + EPS);
#pragma unroll
        for (int j = 0; j < 8; ++j) { const int k = 4 * lane + 256 * j;
            const f32x4 h = v[j] * rstd * cw[j] + sh[j];
            u32x2 o; o.x = pk2(h[0], h[1]); o.y = pk2(h[2], h[3]);
            *(u32x2*)(H + (size_t)m * DM + k) = o; }
#pragma unroll
        for (int j = 0; j < 8; ++j) v[j] = vn[j];
    }
}

__device__ __forceinline__ void mod1_tables(const Params& p, int gw, int ngw, int lane) {
    const float* mod1 = (const float*)(p.ws + WS_MOD) + 3 * 6144;
    float* cw1 = (float*)(p.ws + WS_CW1); float* b2p = (float*)(p.ws + WS_B2P);
    for (int i = gw * 64 + lane; i < 3 * DM; i += ngw * 64) { const int cr = i / DM, k = i % DM; cw1[i] = p.norm_w[DM + k] * (1.f + mod1[cr * 6144 + 2048 + k]); }
    const bf16_t* W = (const bf16_t*)(p.ws + WS_WINO);
    for (int r = gw; r < ODD_IN; r += ngw) {
        float a0 = 0.f, a1 = 0.f, a2 = 0.f;
#pragma unroll
        for (int j = 0; j < 4; ++j) { const int k = 8 * lane + 512 * j; const u32x4 w = *(const u32x4*)(W + (size_t)r * DM + k);
            const float wf[8] = {bflo(w.x), bfhi(w.x), bflo(w.y), bfhi(w.y), bflo(w.z), bfhi(w.z), bflo(w.w), bfhi(w.w)};
#pragma unroll
            for (int e = 0; e < 8; ++e) { a0 += wf[e] * mod1[k + e]; a1 += wf[e] * mod1[6144 + k + e]; a2 += wf[e] * mod1[2 * 6144 + k + e]; } }
        a0 = wave_sum(a0); a1 = wave_sum(a1); a2 = wave_sum(a2);
        if (lane == 0) { b2p[r] = a0; b2p[ODD_IN + r] = a1; b2p[2 * ODD_IN + r] = a2; }
    }
}
namespace pg8 {
#define PG8_LAS __attribute__((address_space(3)))
typedef short bf16x8 __attribute__((ext_vector_type(8)));
constexpr int BM = 256, BK = 64, HALF = 128, HTB = HALF * BK * 2  , STAGE_BYTES = 8 * HTB, NXCD = 8, WGM = 8;
__host__ __device__ __forceinline__ int lds_byte(int r, int c) { const int st = (r >> 4) * 2 + (c >> 5), rr = r & 15, cc = c & 31, ob = rr * 64 + cc * 2; return st * 1024 + (ob ^ (((ob >> 9) & 1) << 5)); }
__host__ __device__ __forceinline__ void stage_rc(int b, int& R, int& C) { const int st = b / 1024, sb = b % 1024, swz = sb ^ (((sb >> 9) & 1) << 5); R = (st >> 1) * 16 + swz / 64; C = (st & 1) * 32 + (swz % 64) / 2; }
__host__ __device__ __forceinline__ int perm32(int rho) { const int n = rho >> 4, i = rho & 15; return 8 * (i >> 2) + 4 * n + (i & 3); }
struct Unit { int pm, pn, kt0, nkt, slab, half, hm; };
struct Gemm { const bf16_t* A; const bf16_t* Bt; int M, N, K, lda, ldb, a_pn_off, b_pm_off, pad; };
struct StaticOrder {
    int nM, nN, nwg, G, c, KT, nfull, split;
    __host__ __device__ void init(int M, int N, int K, int G_, int c_, bool allow_split) { nM = M / BM; nN = N / BM; nwg = nM * nN; G = G_; c = c_; KT = K / BK;
        const int rem = nwg % G; split = (allow_split && rem && G % rem == 0 && (G % 8) == 0 && ((G / 8) % (G / rem)) == 0 && (KT % (2 * (G / rem))) == 0) ? G / rem : 1; nfull = split > 1 ? nwg - rem : nwg; }
    __host__ __device__ void tile(int wgid, Unit& u) const { const int nig = WGM * nN, gid = wgid / nig, fm = gid * WGM, gsz = (nM - fm) < WGM ? (nM - fm) : WGM; u.pm = fm + ((wgid % nig) % gsz); u.pn = (wgid % nig) / gsz; }
    __host__ __device__ bool next(int i, Unit& u) const {
        const long L = (long)i * G + c;
        if (L < nfull) { int wgid = (int)L; { const int q = nfull / NXCD, r = nfull % NXCD, xcd = wgid % NXCD, off = wgid / NXCD; wgid = (xcd < r ? xcd * (q + 1) : r * (q + 1) + (xcd - r) * q) + off; }
            tile(wgid, u); u.kt0 = 0; u.nkt = KT; u.slab = -1; u.half = 0; u.hm = 0; return true; }
        if (split > 1 && L < nfull + G) { const int xcd = c % 8, q = c / 8, ks = q % split, j = (q / split) * 8 + xcd;
            tile(nfull + j, u); u.nkt = KT / split; u.kt0 = ks * u.nkt; u.slab = j * split + ks; u.half = 0; u.hm = 0; return true; }
        return false;
    }
    __device__ __forceinline__ void a_ready(const Unit&) const {}
    __device__ __forceinline__ void done(const Unit&) const {}
};
struct OutOrder {
    int c, part;
    __device__ bool next(int i, Unit& u) const {
        if (i > 0) return false;
        u.kt0 = 0; u.nkt = DM / BK; u.slab = -1; u.half = 0; u.hm = 0;
        if (part == 0) { const int wgid = (c % 8) * 32 + c / 8, idx = wgid % 64; u.pm = (wgid / 64) * 8 + idx % 8; u.pn = idx / 8; return true; }
        if (c >= 64) return false;
        u.pm = 32 + c / 8; u.pn = c % 8; return true;
    }
    __device__ __forceinline__ void a_ready(const Unit&) const {}
    __device__ __forceinline__ void done(const Unit&) const {}
};
struct LastOrder {
    int c;
    __device__ bool next(int i, Unit& u) const {
        u.kt0 = 0; u.nkt = DM / BK; u.slab = -1; u.half = 0; u.hm = 0;
        if (i == 0) { const int wgid = (c % 8) * 32 + c / 8, idx = wgid % 64; u.pm = (wgid / 64) * 8 + idx % 8; u.pn = idx / 8; return true; }
        if (i > 1 || c >= 128) return false;
        const int q = c / 8; u.half = 1; u.hm = q & 1; u.pm = 32 + (q >> 1); u.pn = c % 8; return true;
    }
    __device__ __forceinline__ void a_ready(const Unit&) const {}
    __device__ __forceinline__ void done(const Unit&) const {}
};
struct StaggerOrder {
    int c; const unsigned* cnt; bool wait; int wid;
    __device__ bool next(int i, Unit& u) const {
        const int x = c % 8; u.kt0 = 0; u.nkt = DM / BK; u.slab = -1; u.half = 0; u.hm = 0;
        if (c < 64) { if (i >= 2) return false; u.pm = 32 + x; u.pn = 2 * (c / 8) + i; return true; }
        const int e = (c - 64) / 8; int uidx;
        if (i < 3) uidx = i * 24 + e;
        else { if (i > 3) return false; const int h4 = e >> 1; u.half = 1; u.hm = e & 1;
            if (h4 >= 8) { u.pm = 32 + x; u.pn = 16 + (h4 - 8); return true; } uidx = 72 + h4; }
        u.pm = 4 * x + (uidx % 4); u.pn = uidx / 4; return true;
    }
    __device__ __forceinline__ void a_ready(const Unit& u) const {
        if (u.pm < 32 || !wait) return;
        if (wid == 0) {
            const unsigned* w = cnt + 64 * (u.pm - 32); unsigned sp = 0;
            while ((unsigned)__builtin_amdgcn_readfirstlane(__hip_atomic_load(w, __ATOMIC_RELAXED, __HIP_MEMORY_SCOPE_AGENT)) < 8u) { __builtin_amdgcn_s_sleep(2); if (++sp > (1u << 22)) break; }
            __builtin_amdgcn_fence(__ATOMIC_ACQUIRE, "agent");
            asm volatile("s_waitcnt vmcnt(0)" ::: "memory");
        }
        asm volatile("" ::: "memory"); __builtin_amdgcn_s_barrier(); asm volatile("" ::: "memory");
    }
    __device__ __forceinline__ void done(const Unit&) const {}
};
__device__ __forceinline__ unsigned cvt_pk_bf16(float lo, float hi) { unsigned r; asm volatile("v_cvt_pk_bf16_f32 %0, %1, %2" : "=v"(r) : "v"(lo), "v"(hi)); return r; }
__device__ __forceinline__ void slab_store(const f32x4 (&acc)[2][2][4][2], float* slabs, const Unit& u, int wr, int wc, int fr, int fq) {
    float* sp = slabs + (size_t)u.slab * 65536 + (size_t)(wr * 64 + fr) * 256 + wc * 32 + 8 * fq;
#pragma unroll
    for (int ai = 0; ai < 2; ++ai)
#pragma unroll
        for (int m = 0; m < 4; ++m)
#pragma unroll
            for (int bj = 0; bj < 2; ++bj) { float* q = sp + (size_t)(ai * HALF + m * 16) * 256 + bj * HALF; *(f32x4*)q = acc[ai][bj][m][0]; *(f32x4*)(q + 4) = acc[ai][bj][m][1]; }
}
struct EpiBf16 {
    static constexpr bool PERM = true, AFTER_DRAIN = false;
    bf16_t* O; int ldc; int pad;
    __device__ __forceinline__ void operator()(const f32x4 (&acc)[2][2][4][2], const Unit& u, int wr, int wc, int fr, int fq) const {
        asm volatile("" : "+v"(fr), "+v"(fq));
        const int row0 = u.pm * BM + wr * 64 + fr, col0 = u.pn * BM + wc * 32 + 8 * fq;
#pragma unroll
        for (int ai = 0; ai < 2; ++ai)
#pragma unroll
            for (int m = 0; m < 4; ++m) { bf16_t* rowp = O + (size_t)(row0 + ai * HALF + m * 16) * ldc + col0;
#pragma unroll
                for (int bj = 0; bj < 2; ++bj) { const f32x4 v0 = acc[ai][bj][m][0], v1 = acc[ai][bj][m][1];
                    u32x4 w; w.x = cvt_pk_bf16(v0[0], v0[1]); w.y = cvt_pk_bf16(v0[2], v0[3]); w.z = cvt_pk_bf16(v1[0], v1[1]); w.w = cvt_pk_bf16(v1[2], v1[3]);
                    *(u32x4*)(rowp + bj * HALF) = w; } }
    }
};
struct EpiPoolF {
    static constexpr bool PERM = true, AFTER_DRAIN = false;
    bf16_t* Y; const bf16_t* SG; const float* pscale;
    __device__ __forceinline__ void operator()(const f32x4 (&acc)[2][2][4][2], const Unit& u, int wr, int wc, int fr, int fq) const {
        asm volatile("" : "+v"(fr), "+v"(fq));
        const int row0 = u.pm * BM + wr * 64 + fr, col0 = u.pn * BM + wc * 32 + 8 * fq;
        f32x4 ps[2][2];
#pragma unroll
        for (int bj = 0; bj < 2; ++bj) { ps[bj][0] = *(const f32x4*)(pscale + col0 + bj * HALF); ps[bj][1] = *(const f32x4*)(pscale + col0 + bj * HALF + 4); }
#pragma unroll
        for (int ai = 0; ai < 2; ++ai)
#pragma unroll
            for (int m = 0; m < 4; ++m) { const size_t r = (size_t)(row0 + ai * HALF + m * 16);
#pragma unroll
                for (int bj = 0; bj < 2; ++bj) { const int c = col0 + bj * HALF;
                    const u32x4 g = *(const u32x4*)(SG + r * DM + 1024 + c);
                    const f32x4 v0 = acc[ai][bj][m][0] * ps[bj][0], v1 = acc[ai][bj][m][1] * ps[bj][1];
                    u32x4 w; w.x = cvt_pk_bf16(v0[0] * bflo(g.x), v0[1] * bfhi(g.x)); w.y = cvt_pk_bf16(v0[2] * bflo(g.y), v0[3] * bfhi(g.y));
                    w.z = cvt_pk_bf16(v1[0] * bflo(g.z), v1[1] * bfhi(g.z)); w.w = cvt_pk_bf16(v1[2] * bflo(g.w), v1[3] * bfhi(g.w));
                    *(u32x4*)(Y + r * DM + 1024 + c) = w; } }
    }
};
struct EpiProj0 {
    static constexpr bool PERM = true, AFTER_DRAIN = false;
    unsigned char* ws; const float* qw; const float* kw; float* nak; float* nav;
    __device__ __forceinline__ void operator()(const f32x4 (&acc)[2][2][4][2], const Unit& u, int wr, int wc, int fr, int fq) const {
        asm volatile("" : "+v"(fr), "+v"(fq));
        const int pm = u.pm, pn = u.pn;
        const bool smp = pm >= 32; const int b = smp ? (pm - 32) >> 2 : pm, tb = (smp ? ((pm - 32) & 3) * 256 : 0) + wr * 64 + fr;
        const size_t rowb = (size_t)pm * 256 + wr * 64 + fr;
        if (pn < 8) {
            const bool isk = pn >= 4; const int hl = wc >> 1, j = wc & 1, h = (pn & 3) * 2 + hl, dim_a = 8 * fq + 16 * (fq >> 1);
            const float* w = isk ? kw : qw;
            f32x4 wv[2][2];
#pragma unroll
            for (int bj = 0; bj < 2; ++bj)
#pragma unroll
                for (int n = 0; n < 2; ++n) wv[bj][n] = *(const f32x4*)(w + dim_a + 16 * bj + 4 * n);
            const float* ropeA = (const float*)(ws + WS_ROPE);
#pragma unroll
            for (int ai = 0; ai < 2; ++ai)
#pragma unroll
                for (int m = 0; m < 4; ++m) { const int t = tb + ai * 128 + m * 16; const size_t row = rowb + ai * 128 + m * 16;
                    float ss = 0.f;
#pragma unroll
                    for (int bj = 0; bj < 2; ++bj)
#pragma unroll
                        for (int n = 0; n < 2; ++n) { const f32x4 x = acc[ai][bj][m][n]; ss += (x[0] * x[0] + x[1] * x[1]) + (x[2] * x[2] + x[3] * x[3]); }
                    ss += __shfl_xor(ss, 16); ss += __shfl_xor(ss, 32);
                    const float rinv = __builtin_amdgcn_rsqf(ss * (1.f / 64.f) + EPS);
                    f32x4 y[2][2];
#pragma unroll
                    for (int bj = 0; bj < 2; ++bj)
#pragma unroll
                        for (int n = 0; n < 2; ++n) y[bj][n] = acc[ai][bj][m][n] * rinv * wv[bj][n];
                    if (smp) {
#pragma unroll
                        for (int n = 0; n < 2; ++n) { const f32x4 cs = *(const f32x4*)(ropeA + (size_t)t * 64 + dim_a + 4 * n), sn = *(const f32x4*)(ropeA + 1024 * 64 + (size_t)t * 64 + dim_a + 4 * n);
                            const f32x4 a = y[0][n], bb = y[1][n]; y[0][n] = a * cs - bb * sn; y[1][n] = bb * cs + a * sn; } }
                    if (!isk) { bf16_t* qp = (bf16_t*)(ws + WS_Q) + row * 1024 + pn * 256 + wc * 64 + dim_a;
#pragma unroll
                        for (int bj = 0; bj < 2; ++bj) { const f32x4 v0 = y[bj][0] * C2A, v1 = y[bj][1] * C2A;
                            u32x4 o; o.x = cvt_pk_bf16(v0[0], v0[1]); o.y = cvt_pk_bf16(v0[2], v0[3]); o.z = cvt_pk_bf16(v1[0], v1[1]); o.w = cvt_pk_bf16(v1[2], v1[3]);
                            *(u32x4*)(qp + 16 * bj) = o; } }
                    else { const int hh = (pn - 4) * 2 + hl;
                        const size_t koff = (smp ? ((size_t)(b * HA + hh) * LKS + PAST + t) * 128 : ((size_t)(b * HA + hh) * SEQP + t) * 128) + j * 64 + dim_a;
                        bf16_t* kp = (bf16_t*)(ws + (smp ? WS_KSA : WS_KP)) + koff;
#pragma unroll
                        for (int bj = 0; bj < 2; ++bj) { const f32x4 v0 = y[bj][0], v1 = y[bj][1];
                            u32x4 o; o.x = cvt_pk_bf16(v0[0], v0[1]); o.y = cvt_pk_bf16(v0[2], v0[3]); o.z = cvt_pk_bf16(v1[0], v1[1]); o.w = cvt_pk_bf16(v1[2], v1[3]);
                            *(u32x4*)(kp + 16 * bj) = o;
                            if (!smp) { float* fp = nak + koff + 16 * bj; __builtin_nontemporal_store(v0, (f32x4*)fp); __builtin_nontemporal_store(v1, (f32x4*)(fp + 4)); } } }
                }
        } else if (pn < 12) {
#pragma unroll
            for (int ai = 0; ai < 2; ++ai)
#pragma unroll
                for (int m = 0; m < 4; ++m) { const int t = tb + ai * 128 + m * 16;
#pragma unroll
                    for (int bj = 0; bj < 2; ++bj) { const int hh = (pn - 8) * 2 + bj, d = 32 * wc + 8 * fq;
                        const size_t voff = (smp ? ((size_t)(b * HA + hh) * LKS + PAST + t) * 128 : ((size_t)(b * HA + hh) * SEQP + t) * 128) + d;
                        const f32x4 v0 = acc[ai][bj][m][0], v1 = acc[ai][bj][m][1];
                        u32x4 o; o.x = cvt_pk_bf16(v0[0], v0[1]); o.y = cvt_pk_bf16(v0[2], v0[3]); o.z = cvt_pk_bf16(v1[0], v1[1]); o.w = cvt_pk_bf16(v1[2], v1[3]);
                        *(u32x4*)((bf16_t*)(ws + (smp ? WS_VSA : WS_VP)) + voff) = o;
                        if (!smp) { __builtin_nontemporal_store(v0, (f32x4*)(nav + voff)); __builtin_nontemporal_store(v1, (f32x4*)(nav + voff + 4)); } } }
        } else if (pn < 16) {
            bf16_t* up = (bf16_t*)(ws + WS_U) + (pn - 12) * 256 + 32 * wc + 8 * fq;
#pragma unroll
            for (int ai = 0; ai < 2; ++ai)
#pragma unroll
                for (int m = 0; m < 4; ++m) { const size_t row = rowb + ai * 128 + m * 16;
#pragma unroll
                    for (int bj = 0; bj < 2; ++bj) { const f32x4 v0 = acc[ai][bj][m][0], v1 = acc[ai][bj][m][1];
                        u32x4 o; o.x = cvt_pk_bf16(v0[0], v0[1]); o.y = cvt_pk_bf16(v0[2], v0[3]); o.z = cvt_pk_bf16(v1[0], v1[1]); o.w = cvt_pk_bf16(v1[2], v1[3]);
                        *(u32x4*)(up + row * 1024 + bj * HALF) = o; } }
        } else {
            bf16_t* sg = (bf16_t*)(ws + WS_SG) + (pn - 16) * 256 + 32 * wc + 8 * fq;
#pragma unroll
            for (int ai = 0; ai < 2; ++ai)
#pragma unroll
                for (int m = 0; m < 4; ++m) { const size_t row = rowb + ai * 128 + m * 16;
#pragma unroll
                    for (int bj = 0; bj < 2; ++bj) { const f32x4 v0 = acc[ai][bj][m][0], v1 = acc[ai][bj][m][1];
                        u32x4 o; o.x = cvt_pk_bf16(silu_fast(v0[0]), silu_fast(v0[1])); o.y = cvt_pk_bf16(silu_fast(v0[2]), silu_fast(v0[3])); o.z = cvt_pk_bf16(silu_fast(v1[0]), silu_fast(v1[1])); o.w = cvt_pk_bf16(silu_fast(v1[2]), silu_fast(v1[3]));
                        *(u32x4*)(sg + row * DM + bj * HALF) = o; } }
        }
    }
};
struct EpiProj1 {
    static constexpr bool PERM = true, AFTER_DRAIN = false;
    unsigned char* ws; const float* qw; const float* kw; float* nck; float* ncv; PG8_LAS float* xs; float* slabs;
    __device__ __forceinline__ void operator()(const f32x4 (&acc0)[2][2][4][2], const Unit& u, int wr, int wc, int fr, int fq) const {
        asm volatile("" : "+v"(fr), "+v"(fq));
        if (u.slab >= 0) { slab_store(acc0, slabs, u, wr, wc, fr, fq); return; }
        const int pm = u.pm, pn = u.pn;
        float rstd[2][4]; f32x4 bv[2][2];
        { const int cr = pm < 32 ? 0 : 1 + ((pm - 32) >> 2);
          const float* b2 = (const float*)(ws + WS_B2P) + (size_t)cr * ODD_IN + pn * 256 + 32 * wc + 8 * fq; const float* rss = (const float*)(ws + WS_RSS) + (size_t)pm * 256 + (u.half ? u.hm * 128 : 0) + wr * 64 + fr;
#pragma unroll
          for (int bj = 0; bj < 2; ++bj)
#pragma unroll
              for (int n = 0; n < 2; ++n) bv[bj][n] = *(const f32x4*)(b2 + bj * HALF + n * 4);
#pragma unroll
          for (int ai = 0; ai < 2; ++ai)
#pragma unroll
              for (int m = 0; m < 4; ++m) rstd[ai][m] = __builtin_amdgcn_rsqf(rss[ai * 128 + m * 16] * (1.f / DM) + EPS); }
#define VV(ai, bj, m, n) (acc0[ai][bj][m][n] * rstd[ai][m] + bv[bj][n])
        const int hoff = u.half ? u.hm * 128 : 0, nai = u.half ? 1 : 2;
        const bool smp = pm >= 32; const int b = smp ? (pm - 32) >> 2 : pm, tb = (smp ? ((pm - 32) & 3) * 256 : 0) + hoff + wr * 64 + fr;
        const size_t rowb = (size_t)pm * 256 + hoff + wr * 64 + fr;
        if (pn < 10) {
            const bool isk = pn >= 8; const int hl = wc >> 1, w1 = wc & 1, head = (isk ? (pn - 8) : pn) * 2 + hl;
            const float* w = isk ? kw : qw;
            f32x4 wv[2][2];
#pragma unroll
            for (int bj = 0; bj < 2; ++bj)
#pragma unroll
                for (int n = 0; n < 2; ++n) wv[bj][n] = *(const f32x4*)(w + (2 * w1 + bj) * 32 + 8 * fq + 4 * n);
            PG8_LAS float* xo = xs + (wr * 4 + wc) * 128; PG8_LAS float* xp = xs + (wr * 4 + (wc ^ 1)) * 128;
#pragma unroll
            for (int ai = 0; ai < 2; ++ai)
#pragma unroll
                for (int m = 0; m < 4; ++m) { if (ai >= nai) continue; float ss = 0.f;
#pragma unroll
                    for (int bj = 0; bj < 2; ++bj)
#pragma unroll
                        for (int n = 0; n < 2; ++n) { const f32x4 x = VV(ai, bj, m, n); ss += (x[0] * x[0] + x[1] * x[1]) + (x[2] * x[2] + x[3] * x[3]); }
                    ss += __shfl_xor(ss, 16); ss += __shfl_xor(ss, 32);
                    if (fq == 0) xo[ai * 64 + m * 16 + fr] = ss; }
            asm volatile("s_waitcnt lgkmcnt(0)" ::: "memory"); __builtin_amdgcn_s_barrier(); asm volatile("" ::: "memory");
            const float* ropeC = (const float*)(ws + WS_ROPE) + 2 * 1024 * 64;
#pragma unroll
            for (int ai = 0; ai < 2; ++ai)
#pragma unroll
                for (int m = 0; m < 4; ++m) { if (ai >= nai) continue; const int idx = ai * 64 + m * 16 + fr, t = tb + ai * 128 + m * 16; const size_t row = rowb + ai * 128 + m * 16;
                    const float rinv = __builtin_amdgcn_rsqf((xo[idx] + xp[idx]) * (1.f / 128.f) + EPS);
                    float r2 = rstd[ai][m]; asm volatile("" : "+v"(r2));
                    f32x4 y[2][2];
#pragma unroll
                    for (int bj = 0; bj < 2; ++bj)
#pragma unroll
                        for (int n = 0; n < 2; ++n) y[bj][n] = (acc0[ai][bj][m][n] * r2 + bv[bj][n]) * rinv * wv[bj][n];
                    if (smp) {
#pragma unroll
                        for (int n = 0; n < 2; ++n) { const f32x4 cs = *(const f32x4*)(ropeC + (size_t)t * 128 + 64 * w1 + 8 * fq + 4 * n), sn = *(const f32x4*)(ropeC + 1024 * 128 + (size_t)t * 128 + 64 * w1 + 8 * fq + 4 * n);
                            const f32x4 a = y[0][n], bb = y[1][n]; y[0][n] = a * cs - bb * sn; y[1][n] = bb * cs + a * sn; } }
                    if (!isk) { bf16_t* qp = (bf16_t*)(ws + WS_Q) + row * DM + head * 128 + 8 * fq;
#pragma unroll
                        for (int bj = 0; bj < 2; ++bj) { const f32x4 v0 = y[bj][0] * C2C, v1 = y[bj][1] * C2C;
                            u32x4 o; o.x = cvt_pk_bf16(v0[0], v0[1]); o.y = cvt_pk_bf16(v0[2], v0[3]); o.z = cvt_pk_bf16(v1[0], v1[1]); o.w = cvt_pk_bf16(v1[2], v1[3]);
                            *(u32x4*)(qp + (2 * w1 + bj) * 32) = o; } }
                    else { const size_t koff = smp ? ((size_t)(b * KVH + head) * LKS + PAST + t) * 128 : ((size_t)(b * KVH + head) * SEQP + t) * 128;
                        bf16_t* kp = (bf16_t*)(ws + (smp ? WS_KSC : WS_KP)) + koff + 8 * fq;
#pragma unroll
                        for (int bj = 0; bj < 2; ++bj) { const f32x4 v0 = y[bj][0], v1 = y[bj][1];
                            u32x4 o; o.x = cvt_pk_bf16(v0[0], v0[1]); o.y = cvt_pk_bf16(v0[2], v0[3]); o.z = cvt_pk_bf16(v1[0], v1[1]); o.w = cvt_pk_bf16(v1[2], v1[3]);
                            *(u32x4*)(kp + (2 * w1 + bj) * 32) = o;
                            if (!smp) { float* fp = nck + koff + 8 * fq + (2 * w1 + bj) * 32; __builtin_nontemporal_store(v0, (f32x4*)fp); __builtin_nontemporal_store(v1, (f32x4*)(fp + 4)); } } }
                }
        } else if (pn < 12) {
#pragma unroll
            for (int ai = 0; ai < 2; ++ai)
#pragma unroll
                for (int m = 0; m < 4; ++m) { if (ai >= nai) continue; const int t = tb + ai * 128 + m * 16;
#pragma unroll
                    for (int bj = 0; bj < 2; ++bj) { const int kvh = (pn - 10) * 2 + bj, d = 32 * wc + 8 * fq;
                        const size_t voff = (smp ? ((size_t)(b * KVH + kvh) * LKS + PAST + t) * 128 : ((size_t)(b * KVH + kvh) * SEQP + t) * 128) + d;
                        const f32x4 v0 = VV(ai, bj, m, 0), v1 = VV(ai, bj, m, 1);
                        u32x4 o; o.x = cvt_pk_bf16(v0[0], v0[1]); o.y = cvt_pk_bf16(v0[2], v0[3]); o.z = cvt_pk_bf16(v1[0], v1[1]); o.w = cvt_pk_bf16(v1[2], v1[3]);
                        *(u32x4*)((bf16_t*)(ws + (smp ? WS_VSC : WS_VP)) + voff) = o;
                        if (!smp) { __builtin_nontemporal_store(v0, (f32x4*)(ncv + voff)); __builtin_nontemporal_store(v1, (f32x4*)(ncv + voff + 4)); } } }
        } else {
            bf16_t* sg = (bf16_t*)(ws + WS_SG) + (pn - 12) * 256 + 32 * wc + 8 * fq;
#pragma unroll
            for (int ai = 0; ai < 2; ++ai)
#pragma unroll
                for (int m = 0; m < 4; ++m) { if (ai >= nai) continue; const size_t row = rowb + ai * 128 + m * 16;
#pragma unroll
                    for (int bj = 0; bj < 2; ++bj) { const f32x4 v0 = VV(ai, bj, m, 0), v1 = VV(ai, bj, m, 1);
                        u32x4 o; o.x = cvt_pk_bf16(silu_fast(v0[0]), silu_fast(v0[1])); o.y = cvt_pk_bf16(silu_fast(v0[2]), silu_fast(v0[3])); o.z = cvt_pk_bf16(silu_fast(v1[0]), silu_fast(v1[1])); o.w = cvt_pk_bf16(silu_fast(v1[2]), silu_fast(v1[3]));
                        *(u32x4*)(sg + row * DM + bj * HALF) = o; } }
        }
    }
};
#undef VV
struct EpiResid0 {
    static constexpr bool PERM = true, AFTER_DRAIN = false;
    const float* xp; const float* xs; const float* gate; const float* cw1; float* out; bf16_t* H1; float* rowss; float* slabs;
    __device__ __forceinline__ void operator()(const f32x4 (&acc)[2][2][4][2], const Unit& u, int wr, int wc, int fr, int fq) const {
        asm volatile("" : "+v"(fr), "+v"(fq));
        if (u.slab >= 0) { slab_store(acc, slabs, u, wr, wc, fr, fq); return; }
        const int row0 = u.pm * BM + wr * 64 + fr, col0 = u.pn * BM + wc * 32 + 8 * fq;
        const int cr = u.pm < 32 ? 0 : 1 + ((u.pm - 32) >> 2);
        const float* xb = u.pm < 32 ? xp : xs - (size_t)MP * DM;
        f32x4 gv[2][2], cv[2][2];
#pragma unroll
        for (int bj = 0; bj < 2; ++bj)
#pragma unroll
            for (int n = 0; n < 2; ++n) { gv[bj][n] = *(const f32x4*)(gate + (size_t)cr * 6144 + col0 + bj * HALF + n * 4); cv[bj][n] = *(const f32x4*)(cw1 + (size_t)cr * DM + col0 + bj * HALF + n * 4); }
        f32x4 cb[2][2], nb[2][2];
#define LDG(dst, g) do { const float* bp_ = xb + (size_t)(row0 + ((g) >> 2) * HALF + ((g) & 3) * 16) * DM + col0; \
        _Pragma("unroll") for (int bj = 0; bj < 2; ++bj) _Pragma("unroll") for (int n = 0; n < 2; ++n) dst[bj][n] = __builtin_nontemporal_load((const f32x4*)(bp_ + bj * HALF + n * 4)); } while (0)
        LDG(cb, 0);
#pragma unroll
        for (int g = 0; g < 8; ++g) {
            if (g + 1 < 8) LDG(nb, g + 1);
            const int ai = g >> 2, m = g & 3, r = row0 + ai * HALF + m * 16;
            float* op = out + (size_t)r * DM + col0; bf16_t* hp = H1 + (size_t)r * DM + col0;
            float ss = 0.f;
#pragma unroll
            for (int bj = 0; bj < 2; ++bj) { const f32x4 y0 = cb[bj][0] + gv[bj][0] * acc[ai][bj][m][0], y1 = cb[bj][1] + gv[bj][1] * acc[ai][bj][m][1];
                *(f32x4*)(op + bj * HALF) = y0; *(f32x4*)(op + bj * HALF + 4) = y1;
                ss += (y0[0] * y0[0] + y0[1] * y0[1]) + (y0[2] * y0[2] + y0[3] * y0[3]) + (y1[0] * y1[0] + y1[1] * y1[1]) + (y1[2] * y1[2] + y1[3] * y1[3]);
                const f32x4 h0 = y0 * cv[bj][0], h1 = y1 * cv[bj][1];
                u32x4 o; o.x = cvt_pk_bf16(h0[0], h0[1]); o.y = cvt_pk_bf16(h0[2], h0[3]); o.z = cvt_pk_bf16(h1[0], h1[1]); o.w = cvt_pk_bf16(h1[2], h1[3]);
                *(u32x4*)(hp + bj * HALF) = o; }
            ss += __shfl_xor(ss, 16); ss += __shfl_xor(ss, 32);
            if (fq == 0) atomicAdd(rowss + r, ss);
#pragma unroll
            for (int bj = 0; bj < 2; ++bj)
#pragma unroll
                for (int n = 0; n < 2; ++n) cb[bj][n] = nb[bj][n];
            asm volatile("" ::: "memory"); }
#undef LDG
    }
};
struct EpiResidF {
    static constexpr bool PERM = true, AFTER_DRAIN = false;
    const float* xp; const float* xs; const float* base; const float* gate; float* out; float* slabs;
    __device__ __forceinline__ void operator()(const f32x4 (&acc)[2][2][4][2], const Unit& u, int wr, int wc, int fr, int fq) const {
        asm volatile("" : "+v"(fr), "+v"(fq));
        if (u.slab >= 0) { slab_store(acc, slabs, u, wr, wc, fr, fq); return; }
        const int row0 = u.pm * BM + (u.half ? u.hm * HALF : 0) + wr * 64 + fr, col0 = u.pn * BM + wc * 32 + 8 * fq;
        const int cr = u.pm < 32 ? 0 : 1 + ((u.pm - 32) >> 2);
        const float* xb = base ? base : (u.pm < 32 ? xp : xs - (size_t)MP * DM);
        f32x4 gv[2][2];
#pragma unroll
        for (int bj = 0; bj < 2; ++bj)
#pragma unroll
            for (int n = 0; n < 2; ++n) gv[bj][n] = *(const f32x4*)(gate + (size_t)cr * 6144 + col0 + bj * HALF + n * 4);
        const int ng = u.half ? 4 : 8;
        f32x4 cb[2][2], nb[2][2];
#define LDG(dst, g) do { const float* bp_ = xb + (size_t)(row0 + ((g) >> 2) * HALF + ((g) & 3) * 16) * DM + col0; \
        _Pragma("unroll") for (int bj = 0; bj < 2; ++bj) _Pragma("unroll") for (int n = 0; n < 2; ++n) dst[bj][n] = __builtin_nontemporal_load((const f32x4*)(bp_ + bj * HALF + n * 4)); } while (0)
        LDG(cb, 0);
#pragma unroll
        for (int g = 0; g < 8; ++g) { if (g >= ng) continue;
            if (g + 1 < ng) LDG(nb, g + 1);
            float* op = out + (size_t)(row0 + (g >> 2) * HALF + (g & 3) * 16) * DM + col0;
#pragma unroll
            for (int bj = 0; bj < 2; ++bj)
#pragma unroll
                for (int n = 0; n < 2; ++n) __builtin_nontemporal_store(cb[bj][n] + gv[bj][n] * acc[g >> 2][bj][g & 3][n], (f32x4*)(op + bj * HALF + n * 4));
#pragma unroll
            for (int bj = 0; bj < 2; ++bj)
#pragma unroll
                for (int n = 0; n < 2; ++n) cb[bj][n] = nb[bj][n];
            asm volatile("" ::: "memory"); }
#undef LDG
    }
};

template <class Epi, class Sched, bool ALIGN_EPI = false, bool SP2 = false>
__device__ __forceinline__ void gemm_phase(PG8_LAS unsigned char* lds, const Gemm g, const Sched& S, const Epi& E, const int tid) {
    const int wid = __builtin_amdgcn_readfirstlane(tid >> 6), lane = tid & 63, wr = wid >> 2, wc = wid & 3, fr = lane & 15, fq = lane >> 4;
    unsigned voffA[2], voffB[2];
#pragma unroll
    for (int i = 0; i < 2; ++i) { int R, C; stage_rc(tid * 16 + i * 8192, R, C); const int Rb = Epi::PERM ? ((R & ~31) + perm32(R & 31)) : R;
        voffA[i] = (unsigned)(R * g.lda + C) * 2u; voffB[i] = (unsigned)(Rb * g.ldb + C) * 2u; }
    const size_t kstep = (size_t)(BK * 2);
    const size_t hstepA = (size_t)HALF * g.lda * 2, hstepB = (size_t)HALF * g.ldb * 2;
    const size_t tstepA = 2 * hstepA, tstepB = 2 * hstepB;
    const unsigned ldsw = (unsigned)wid * 1024u;
    const int aoff = lds_byte(wr * 64 + fr, fq * 8), boff = lds_byte(wc * 32 + fr, fq * 8);
#define PG8_SA(b, h) (((b) * 2 + (h)) * HTB)
#define PG8_SB(b, h) ((4 + (b) * 2 + (h)) * HTB)
#define PG8_STAGE(bufoff, gbase, voff) do { _Pragma("unroll") for (int _i = 0; _i < 2; ++_i) \
        __builtin_amdgcn_global_load_lds((const unsigned*)((const char*)(gbase) + (voff)[_i]), (PG8_LAS unsigned*)(lds + (bufoff) + ldsw + _i * 8192), 16, 0, 0); } while (0)
#define PG8_LDA(dst, b, h) do { _Pragma("unroll") for (int m = 0; m < 4; ++m) _Pragma("unroll") for (int k = 0; k < 2; ++k) dst[m][k] = *(const PG8_LAS bf16x8*)(lds + PG8_SA(b, h) + aoff + m * 2048 + k * 1024); } while (0)
#define PG8_LDB(dst, b, h) do { _Pragma("unroll") for (int n = 0; n < 2; ++n) _Pragma("unroll") for (int k = 0; k < 2; ++k) dst[n][k] = *(const PG8_LAS bf16x8*)(lds + PG8_SB(b, h) + boff + n * 2048 + k * 1024); } while (0)
#define PG8_MMA(ai, bj, At, Bt) do { __builtin_amdgcn_s_setprio(1); _Pragma("unroll") for (int m = 0; m < 4; ++m) _Pragma("unroll") for (int n = 0; n < 2; ++n) _Pragma("unroll") for (int k = 0; k < 2; ++k) \
        acc[ai][bj][m][n] = __builtin_amdgcn_mfma_f32_16x16x32_bf16(Bt[n][k], At[m][k], acc[ai][bj][m][n], 0, 0, 0); __builtin_amdgcn_s_setprio(0); } while (0)
#define PG8_WAIT_V(n) asm volatile("s_waitcnt vmcnt(" #n ")" ::: "memory")
#define PG8_WAIT_L(n) asm volatile("s_waitcnt lgkmcnt(" #n ")" ::: "memory")
#define PG8_BAR __builtin_amdgcn_s_barrier()
#define PG8_SCHED __builtin_amdgcn_sched_barrier(0)
    Unit cur, nxt; int ui = 0;
    if (!S.next(0, cur)) return;
    f32x4 acc[2][2][4][2];
#pragma unroll
    for (int a = 0; a < 2; ++a)
#pragma unroll
        for (int b = 0; b < 2; ++b)
#pragma unroll
            for (int m = 0; m < 4; ++m)
#pragma unroll
                for (int n = 0; n < 2; ++n) acc[a][b][m][n] = (f32x4){0.f, 0.f, 0.f, 0.f};
    bf16x8 At[4][2], B0[2][2], B1[2][2];
    const char* cA = (const char*)g.A + (size_t)cur.pm * tstepA + (size_t)cur.pn * g.a_pn_off * 2 + (size_t)cur.kt0 * kstep + (cur.half ? (size_t)cur.hm * hstepA : 0); const char* cB = (const char*)g.Bt + (size_t)cur.pn * tstepB + (size_t)cur.pm * g.b_pm_off * 2 + (size_t)cur.kt0 * kstep;
    S.a_ready(cur);
    if constexpr (SP2) {
        PG8_STAGE(PG8_SB(0, 0), cB, voffB); PG8_STAGE(PG8_SB(0, 1), cB + hstepB, voffB); PG8_STAGE(PG8_SA(0, 0), cA, voffA); PG8_STAGE(PG8_SA(0, 1), cA + (cur.half ? 0 : hstepA), voffA);
        if (wr == 1) PG8_BAR;
        PG8_WAIT_V(2); PG8_BAR;
        PG8_STAGE(PG8_SB(1, 0), cB + kstep, voffB); PG8_STAGE(PG8_SA(1, 0), cA + kstep, voffA); PG8_STAGE(PG8_SB(1, 1), cB + hstepB + kstep, voffB);
        PG8_WAIT_V(6); PG8_BAR;
    } else {
        PG8_STAGE(PG8_SB(0, 0), cB, voffB); PG8_STAGE(PG8_SA(0, 0), cA, voffA); PG8_STAGE(PG8_SB(0, 1), cB + hstepB, voffB); PG8_STAGE(PG8_SA(0, 1), cA + hstepA, voffA);
        if (wr == 1) PG8_BAR;
        PG8_WAIT_V(4); PG8_BAR;
        PG8_STAGE(PG8_SB(1, 0), cB + kstep, voffB); PG8_STAGE(PG8_SA(1, 0), cA + kstep, voffA); PG8_STAGE(PG8_SB(1, 1), cB + hstepB + kstep, voffB);
        PG8_WAIT_V(6); PG8_BAR;
    }
    for (;;) {
        const bool has_next = S.next(ui + 1, nxt);
        const char* nA = has_next ? (const char*)g.A + (size_t)nxt.pm * tstepA + (size_t)nxt.pn * g.a_pn_off * 2 + (size_t)nxt.kt0 * kstep + (nxt.half ? (size_t)nxt.hm * hstepA : 0) : cA; const char* nB = has_next ? (const char*)g.Bt + (size_t)nxt.pn * tstepB + (size_t)nxt.pm * g.b_pm_off * 2 + (size_t)nxt.kt0 * kstep : cB;
        const size_t curH = cur.half ? 0 : hstepA, nxtH = has_next ? (nxt.half ? 0 : hstepA) : curH;
        const int nt = cur.nkt;
        for (int t = 0; t < nt; t += 2) {
            const bool last = (t == nt - 2);
            const char* a1 = cA + (size_t)(t + 1) * kstep;
            const char* a2 = last ? nA : cA + (size_t)(t + 2) * kstep; const char* b2 = last ? nB : cB + (size_t)(t + 2) * kstep;
            const char* a3 = a2 + kstep; const char* b3 = b2 + kstep;
            if (last && has_next) S.a_ready(nxt);
            if constexpr (SP2) {
            PG8_LDB(B0, 0, 0); PG8_LDB(B1, 0, 1); PG8_SCHED; PG8_LDA(At, 0, 0); PG8_STAGE(PG8_SA(1, 1), a1 + curH, voffA);
            PG8_WAIT_V(8); PG8_WAIT_L(0); PG8_BAR; PG8_MMA(0, 0, At, B0); PG8_MMA(0, 1, At, B1); PG8_BAR; PG8_SCHED;
            PG8_LDA(At, 0, 1); PG8_STAGE(PG8_SB(0, 0), b2, voffB); PG8_STAGE(PG8_SB(0, 1), b2 + hstepB, voffB); PG8_STAGE(PG8_SA(0, 0), a2, voffA);
            PG8_WAIT_V(8); PG8_WAIT_L(0); PG8_BAR; if (!cur.half) { PG8_MMA(1, 0, At, B0); PG8_MMA(1, 1, At, B1); } PG8_BAR; PG8_SCHED;
            PG8_LDB(B0, 1, 0); PG8_LDB(B1, 1, 1); PG8_SCHED; PG8_LDA(At, 1, 0); PG8_STAGE(PG8_SA(0, 1), a2 + (last ? nxtH : curH), voffA);
            PG8_WAIT_V(8); PG8_WAIT_L(0); PG8_BAR; PG8_MMA(0, 0, At, B0); PG8_MMA(0, 1, At, B1); PG8_BAR; PG8_SCHED;
            PG8_LDA(At, 1, 1); PG8_STAGE(PG8_SB(1, 0), b3, voffB); PG8_STAGE(PG8_SB(1, 1), b3 + hstepB, voffB); PG8_STAGE(PG8_SA(1, 0), a3, voffA);
            PG8_WAIT_V(8); PG8_WAIT_L(0); PG8_BAR; if (!cur.half) { PG8_MMA(1, 0, At, B0); PG8_MMA(1, 1, At, B1); } PG8_BAR; PG8_SCHED;
            } else {
            PG8_LDB(B0, 0, 0); PG8_SCHED; PG8_LDA(At, 0, 0); PG8_STAGE(PG8_SA(1, 1), a1 + hstepA, voffA);
            PG8_WAIT_L(8); PG8_BAR; PG8_WAIT_L(0); PG8_MMA(0, 0, At, B0); PG8_BAR; PG8_SCHED;
            PG8_LDB(B1, 0, 1); PG8_STAGE(PG8_SB(0, 0), b2, voffB);
            PG8_BAR; PG8_WAIT_L(0); PG8_MMA(0, 1, At, B1); PG8_BAR;
            PG8_LDA(At, 0, 1); PG8_STAGE(PG8_SA(0, 0), a2, voffA);
            PG8_BAR; PG8_WAIT_L(0); PG8_MMA(1, 0, At, B0); PG8_BAR; PG8_SCHED;
            PG8_STAGE(PG8_SB(0, 1), b2 + hstepB, voffB);
            PG8_WAIT_V(6); PG8_BAR; PG8_MMA(1, 1, At, B1); PG8_BAR;
            PG8_LDB(B0, 1, 0); PG8_SCHED; PG8_LDA(At, 1, 0); PG8_STAGE(PG8_SA(0, 1), a2 + hstepA, voffA);
            PG8_WAIT_L(8); PG8_BAR; PG8_WAIT_L(0); PG8_MMA(0, 0, At, B0); PG8_BAR; PG8_SCHED;
            PG8_LDB(B1, 1, 1); PG8_STAGE(PG8_SB(1, 0), b3, voffB);
            PG8_BAR; PG8_WAIT_L(0); PG8_MMA(0, 1, At, B1); PG8_BAR;
            PG8_LDA(At, 1, 1); PG8_STAGE(PG8_SA(1, 0), a3, voffA);
            PG8_BAR; PG8_WAIT_L(0); PG8_MMA(1, 0, At, B0); PG8_BAR; PG8_SCHED;
            PG8_STAGE(PG8_SB(1, 1), b3 + hstepB, voffB);
            PG8_WAIT_V(6); PG8_BAR; PG8_MMA(1, 1, At, B1); PG8_BAR;
            }
        }
        if constexpr (ALIGN_EPI) { if (wr == 0) PG8_BAR; }
        if constexpr (!Epi::AFTER_DRAIN) { E(acc, cur, wr, wc, fr, fq); S.done(cur); }
        if (!has_next) break;
#pragma unroll
        for (int a = 0; a < 2; ++a)
#pragma unroll
            for (int b = 0; b < 2; ++b)
#pragma unroll
                for (int m = 0; m < 4; ++m)
#pragma unroll
                    for (int n = 0; n < 2; ++n) acc[a][b][m][n] = (f32x4){0.f, 0.f, 0.f, 0.f};
        cur = nxt; cA = nA; cB = nB; ++ui;
        if constexpr (ALIGN_EPI) { if (wr == 1) PG8_BAR; }
    }
    PG8_WAIT_V(0);
    if constexpr (!ALIGN_EPI) { if (wr == 0) PG8_BAR; }
    PG8_BAR;
#undef PG8_SA
#undef PG8_SB
#undef PG8_STAGE
#undef PG8_LDA
#undef PG8_LDB
#undef PG8_MMA
#undef PG8_WAIT_V
#undef PG8_WAIT_L
#undef PG8_BAR
#undef PG8_SCHED
}
}

__device__ __forceinline__ void ld8(const bf16_t* p, float (&v)[8]) { const u32x4 r = *(const u32x4*)p; v[0] = bflo(r.x); v[1] = bfhi(r.x); v[2] = bflo(r.y); v[3] = bfhi(r.y); v[4] = bflo(r.z); v[5] = bfhi(r.z); v[6] = bflo(r.w); v[7] = bfhi(r.w); }
__device__ __forceinline__ void pool_apply_slot(const Params& p, int row_base, int run_len  , int tid) {
    const bf16_t* __restrict__ Z = (const bf16_t*)(p.ws + WS_U); const bf16_t* __restrict__ SG = (const bf16_t*)(p.ws + WS_SG); bf16_t* __restrict__ Y = (bf16_t*)(p.ws + WS_HY);
    const int chunk = tid & 127, rb = tid >> 7, c = chunk * 8, g = chunk >> 5, h = 1 << g;
    float ps[8];
#pragma unroll
    for (int e = 0; e < 8; ++e) ps[e] = p.pool_scale[c + e];
    float S[8]; bool first = true;
    int m = row_base + rb * run_len;
#pragma unroll 1
    for (int i4 = 0; i4 < run_len / 4; ++i4) {
        float za[4][8], zr[4][8], own[4][8], gt[4][8]; int cnt[4]; bool init[4];
#pragma unroll
        for (int j = 0; j < 4; ++j) { const int mm = m + j; const bool smp = mm >= MP; const int t = smp ? (mm - MP) & 1023 : mm & 255, L = smp ? SEQS : SEQP;
            const bf16_t* zp = Z + (size_t)mm * 1024 + c;
            const bool add_ok = (t + h <= L), rem_ok = (t - h >= 1);
            ld8(zp + (ptrdiff_t)(add_ok ? (h - 1) : 0) * 1024, za[j]); ld8(zp + (ptrdiff_t)(rem_ok ? (-1 - h) : 0) * 1024, zr[j]); ld8(zp, own[j]); ld8(SG + (size_t)mm * DM + 1024 + c, gt[j]);
            const float fa = add_ok ? 1.f : 0.f, fr = rem_ok ? 1.f : 0.f;
#pragma unroll
            for (int e = 0; e < 8; ++e) { za[j][e] *= fa; zr[j][e] *= fr; }
            cnt[j] = min(t + h, L) - max(t - h, 0); init[j] = (t == 0) || (first && j == 0 && i4 == 0); }
#pragma unroll
        for (int j = 0; j < 4; ++j) { const int mm = m + j;
            if (init[j]) { const bool smp = mm >= MP; const int t = smp ? (mm - MP) & 1023 : mm & 255, L = smp ? SEQS : SEQP; const int lo = max(t - h, 0), hi = min(t + h, L);
#pragma unroll
                for (int e = 0; e < 8; ++e) S[e] = 0.f;
                for (int tt = lo; tt < hi; ++tt) { float w[8]; ld8(Z + (size_t)(mm + tt - t) * 1024 + c, w);
#pragma unroll
                    for (int e = 0; e < 8; ++e) S[e] += w[e]; } }
            else {
#pragma unroll
                for (int e = 0; e < 8; ++e) S[e] += za[j][e] - zr[j][e]; }
            const float inv = 1.0f / (float)cnt[j];
            float o[8];
#pragma unroll
            for (int e = 0; e < 8; ++e) o[e] = (S[e] * inv - own[j][e]) * ps[e] * gt[j][e];
            u32x4 w; w.x = pk2(o[0], o[1]); w.y = pk2(o[2], o[3]); w.z = pk2(o[4], o[5]); w.w = pk2(o[6], o[7]);
            *(u32x4*)(Y + (size_t)mm * DM + 1024 + c) = w; }
        first = false; m += 4;
    }
}
namespace att {
#define GATE(x) (SILU ? siluf(x) : (x))
using bf16x8 = __attribute__((ext_vector_type(8))) short;
using s16x4  = __attribute__((ext_vector_type(4))) short;
using f32x16 = __attribute__((ext_vector_type(16))) float;
constexpr int QBLK = 32, KVBLK = 64, LDK = 128;
constexpr int SHM_V = KVBLK * 128 * 2, SHM_K = KVBLK * 128 * 2;
constexpr int WS_OFF = 2 * SHM_V + 2 * SHM_K;
constexpr int STG_OFF = 72 * 1024;
constexpr float THRL = 8.f * LOG2E;
#define KSWZ(row, colB) ((row) * 256 + ((colB) ^ (((row) & 7) << 4)))
#define SBAR() __builtin_amdgcn_sched_barrier(0)
__device__ __forceinline__ int crow(int r, int hi) { return (r & 3) + 8 * (r >> 2) + 4 * hi; }
__device__ __forceinline__ unsigned cvtpk(float lo, float hi) { unsigned r; asm volatile("v_cvt_pk_bf16_f32 %0, %1, %2" : "=v"(r) : "v"(lo), "v"(hi)); return r; }
constexpr float SOFT_OFF = 0.f;
__device__ __forceinline__ void partialSM(f32x16& p0, f32x16& p1, float& m_reg, float& mn, float& alpha) {
  float pmax = p0[0]; for (int r = 1; r < 16; ++r) pmax = fmaxf(pmax, p0[r]); for (int r = 0; r < 16; ++r) pmax = fmaxf(pmax, p1[r]);
  { auto rr = __builtin_amdgcn_permlane32_swap(__float_as_uint(pmax), __float_as_uint(pmax), false, false);
    pmax = fmaxf(__uint_as_float(rr[0]), __uint_as_float(rr[1])); }
  if (__builtin_expect(__all(pmax - m_reg <= THRL), 1)) { mn = m_reg; alpha = 1.f; }
  else { mn = fmaxf(m_reg, pmax); alpha = __builtin_amdgcn_exp2f(m_reg - mn); m_reg = mn; }
  for (int r = 0; r < 16; ++r) p0[r] = p0[r] - mn; for (int r = 0; r < 16; ++r) p1[r] = p1[r] - mn;
  for (int r = 0; r < 16; ++r) p0[r] = __builtin_amdgcn_exp2f(p0[r]);
}
__device__ __forceinline__ void finishSM(f32x16& p0, f32x16& p1, float alpha, float& l_reg, bf16x8& pa0, bf16x8& pa1, bf16x8& pa2, bf16x8& pa3) {
  for (int r = 0; r < 16; ++r) p1[r] = __builtin_amdgcn_exp2f(p1[r]);
  float ps = 0; for (int r = 0; r < 16; ++r) ps += p0[r]; for (int r = 0; r < 16; ++r) ps += p1[r];
  { auto rr = __builtin_amdgcn_permlane32_swap(__float_as_uint(ps), __float_as_uint(ps), false, false);
    ps = __uint_as_float(rr[0]) + __uint_as_float(rr[1]); }
  l_reg = l_reg * alpha + ps;
#define PK4(P, BASE, OUT) do { unsigned a0 = cvtpk(P[BASE + 0], P[BASE + 1]), a1 = cvtpk(P[BASE + 2], P[BASE + 3]);   \
    unsigned b0 = cvtpk(P[BASE + 4], P[BASE + 5]), b1 = cvtpk(P[BASE + 6], P[BASE + 7]);                              \
    auto r0 = __builtin_amdgcn_permlane32_swap(a0, b0, false, false); auto r1 = __builtin_amdgcn_permlane32_swap(a1, b1, false, false); \
    u32x4 w = {r0[0], r1[0], r0[1], r1[1]}; OUT = *reinterpret_cast<bf16x8*>(&w); } while (0)
  PK4(p0, 0, pa0); PK4(p0, 8, pa1); PK4(p1, 0, pa2); PK4(p1, 8, pa3);
#undef PK4
}
template <int ND0> __device__ __forceinline__ void qkt(f32x16& p0, f32x16& p1, const char* Ks, const bf16x8* qr, int r32, int hi, int kcol0, const f32x16& cinit) {
#pragma unroll
  for (int d0 = 0; d0 < ND0; ++d0) { int cb = (kcol0 + d0 * 16 + hi * 8) * 2;
    bf16x8 b0 = *reinterpret_cast<const bf16x8*>(Ks + KSWZ(r32, cb));
    bf16x8 b1 = *reinterpret_cast<const bf16x8*>(Ks + KSWZ(32 + r32, cb));
    if (d0 == 0) { p0 = __builtin_amdgcn_mfma_f32_32x32x16_bf16(b0, qr[d0], cinit, 0, 0, 0); p1 = __builtin_amdgcn_mfma_f32_32x32x16_bf16(b1, qr[d0], cinit, 0, 0, 0); }
    else { p0 = __builtin_amdgcn_mfma_f32_32x32x16_bf16(b0, qr[d0], p0, 0, 0, 0); p1 = __builtin_amdgcn_mfma_f32_32x32x16_bf16(b1, qr[d0], p1, 0, 0, 0); } }
}
__device__ __forceinline__ int v_st(int k, int c) { const int kk = (k & ~0xC) | ((k & 4) << 1) | ((k & 8) >> 1); return ((kk >> 3) * 4 + (c >> 5)) * 512 + ((kk & 7) * 32 + (c & 31)) * 2; }
__device__ __forceinline__ int v_rd_base(int lane) { return ((lane & 3) << 3) | (((lane >> 2) & 3) << 6) | (((lane >> 4) & 1) << 5) | (((lane >> 5) & 1) << 8); }
constexpr int v_rd_off(int d0, int ks, int half) { return d0 * 512 + ks * 4096 + half * 2048; }
template <int OFF> __device__ __forceinline__ s16x4 tr_read(int vb) {
  s16x4 r; asm volatile("ds_read_b64_tr_b16 %0, %1 offset:%2" : "=&v"(r) : "v"(vb), "i"(OFF) : "memory"); return r;
}
template <int D0> __device__ __forceinline__ void pv_one(f32x16& od, int vb, bf16x8 pa0, bf16x8 pa1, bf16x8 pa2, bf16x8 pa3) {
  const s16x4 l0 = tr_read<v_rd_off(D0, 0, 0)>(vb), h0 = tr_read<v_rd_off(D0, 0, 1)>(vb), l1 = tr_read<v_rd_off(D0, 1, 0)>(vb), h1 = tr_read<v_rd_off(D0, 1, 1)>(vb);
  const s16x4 l2 = tr_read<v_rd_off(D0, 2, 0)>(vb), h2 = tr_read<v_rd_off(D0, 2, 1)>(vb), l3 = tr_read<v_rd_off(D0, 3, 0)>(vb), h3 = tr_read<v_rd_off(D0, 3, 1)>(vb);
  asm volatile("s_waitcnt lgkmcnt(0)" ::: "memory"); SBAR();
#define PK(L, H) (bf16x8){L[0], L[1], L[2], L[3], H[0], H[1], H[2], H[3]}
  od = __builtin_amdgcn_mfma_f32_32x32x16_bf16(pa0, PK(l0, h0), od, 0, 0, 0);
  od = __builtin_amdgcn_mfma_f32_32x32x16_bf16(pa1, PK(l1, h1), od, 0, 0, 0);
  od = __builtin_amdgcn_mfma_f32_32x32x16_bf16(pa2, PK(l2, h2), od, 0, 0, 0);
  od = __builtin_amdgcn_mfma_f32_32x32x16_bf16(pa3, PK(l3, h3), od, 0, 0, 0);
#undef PK
}
__device__ __forceinline__ void pv_d0(f32x16* o, int vb, bf16x8 pa0, bf16x8 pa1, bf16x8 pa2, bf16x8 pa3) {
  pv_one<0>(o[0], vb, pa0, pa1, pa2, pa3); pv_one<1>(o[1], vb, pa0, pa1, pa2, pa3); pv_one<2>(o[2], vb, pa0, pa1, pa2, pa3); pv_one<3>(o[3], vb, pa0, pa1, pa2, pa3);
}
template <int ND0>
__device__ __forceinline__ void attn_core(const bf16_t* Qw, const bf16_t* __restrict__ Kh, const bf16_t* __restrict__ Vh, int seq, int kcol0, char* lds, f32x16 (&o)[4], float& l_reg, const int wid, const int lane) {
  const int tid = wid * 64 + lane, r32 = lane & 31, hi = lane >> 5;
  char* V_lds = lds; char* K_lds = lds + 2 * SHM_V;
  float* ws = (float*)(lds + WS_OFF) + wid * 64; float* al_l = ws + 32;
  float m_reg = -1e30f; l_reg = 0; bf16x8 qr[ND0];
  f32x16 cinit; for (int r = 0; r < 16; ++r) cinit[r] = -SOFT_OFF;
#pragma unroll
  for (int d = 0; d < 4; ++d) o[d] = f32x16{};
#pragma unroll
  for (int d0 = 0; d0 < ND0; ++d0) qr[d0] = __builtin_nontemporal_load(reinterpret_cast<const bf16x8*>(Qw + d0 * 16));
  const int sr = tid >> 4, sc = (tid & 15) * 8, vst0 = v_st(sr, sc), vst1 = v_st(32 + sr, sc);
  const int vb0 = (int)(uintptr_t)V_lds + v_rd_base(lane);
  struct { bf16x8 vs0, vs1, ks0, ks1; } sr_[1];
#define SLOAD(i, k0) do { sr_[i].vs0 = *reinterpret_cast<const bf16x8*>(&Vh[(long)((k0) + sr) * LDK + sc]); sr_[i].vs1 = *reinterpret_cast<const bf16x8*>(&Vh[(long)((k0) + 32 + sr) * LDK + sc]); \
    sr_[i].ks0 = *reinterpret_cast<const bf16x8*>(&Kh[(long)((k0) + sr) * LDK + sc]); sr_[i].ks1 = *reinterpret_cast<const bf16x8*>(&Kh[(long)((k0) + 32 + sr) * LDK + sc]); } while (0)
#define SWRITE(b, i) do { *(bf16x8*)(V_lds + (b) * SHM_V + vst0) = sr_[i].vs0;          \
    *(bf16x8*)(V_lds + (b) * SHM_V + vst1) = sr_[i].vs1; int kc = sc * 2;               \
    *(bf16x8*)(K_lds + (b) * SHM_K + KSWZ(sr, kc)) = sr_[i].ks0;                       \
    *(bf16x8*)(K_lds + (b) * SHM_K + KSWZ(32 + sr, kc)) = sr_[i].ks1; } while (0)
#define SWAIT() asm volatile("s_waitcnt vmcnt(0)" ::: "memory")
#define RESC(a) do { if (__any((a) < 1.f)) { if (hi == 0) al_l[r32] = (a); asm volatile("s_waitcnt lgkmcnt(0)" ::: "memory"); \
    for (int d = 0; d < 4; ++d) for (int r = 0; r < 16; ++r) o[d][r] *= al_l[crow(r, hi)]; } } while (0)
  f32x16 pA0, pA1, pB0, pB1; float mnA, mnB, alA, alB; bf16x8 pa0, pa1, pa2, pa3; const int NT = seq / KVBLK;
  SLOAD(0, 0); asm volatile("s_waitcnt vmcnt(0)" ::: "memory"); SWRITE(0, 0); __syncthreads();
  qkt<ND0>(pA0, pA1, K_lds, qr, r32, hi, kcol0, cinit); partialSM(pA0, pA1, m_reg, mnA, alA);
  SLOAD(0, KVBLK);
  SWAIT(); SWRITE(1, 0); __syncthreads();
  for (int j = 1; j + 1 < NT; j += 2) {
    SBAR(); qkt<ND0>(pB0, pB1, K_lds + SHM_K, qr, r32, hi, kcol0, cinit);
    finishSM(pA0, pA1, alA, l_reg, pa0, pa1, pa2, pa3); SBAR();
    SLOAD(0, (j + 1) * KVBLK); SBAR();
    pv_d0(o, vb0, pa0, pa1, pa2, pa3); partialSM(pB0, pB1, m_reg, mnB, alB);
    __syncthreads(); SWAIT(); SWRITE(0, 0);
    RESC(alB); __syncthreads();
    SBAR(); qkt<ND0>(pA0, pA1, K_lds, qr, r32, hi, kcol0, cinit);
    finishSM(pB0, pB1, alB, l_reg, pa0, pa1, pa2, pa3); SBAR();
    SLOAD(0, (j + 2) * KVBLK); SBAR();
    pv_d0(o, vb0 + SHM_V, pa0, pa1, pa2, pa3); partialSM(pA0, pA1, m_reg, mnA, alA);
    __syncthreads(); SWAIT(); SWRITE(1, 0);
    RESC(alA); __syncthreads();
  }
  SBAR(); qkt<ND0>(pB0, pB1, K_lds + SHM_K, qr, r32, hi, kcol0, cinit);
  finishSM(pA0, pA1, alA, l_reg, pa0, pa1, pa2, pa3); SBAR();
  pv_d0(o, vb0, pa0, pa1, pa2, pa3); partialSM(pB0, pB1, m_reg, mnB, alB);
  __syncthreads(); RESC(alB);
  finishSM(pB0, pB1, alB, l_reg, pa0, pa1, pa2, pa3); SBAR();
  pv_d0(o, vb0 + SHM_V, pa0, pa1, pa2, pa3);
#undef SLOAD
#undef SWRITE
#undef SWAIT
#undef RESC
}
__device__ __forceinline__ void row_inv_l(float l_reg, char* lds, int wid, int r32, int hi, float (&rli)[16]) {
  float* li_l = (float*)(lds + WS_OFF) + wid * 64;
  if (hi == 0) li_l[r32] = l_reg; asm volatile("s_waitcnt lgkmcnt(0)" ::: "memory");
#pragma unroll
  for (int r = 0; r < 16; ++r) rli[r] = __builtin_amdgcn_rcpf(li_l[crow(r, hi)]);
}
template <bool SILU> __device__ __forceinline__ void store_rows_gated(const f32x16 (&v)[4], char* stg, bf16_t* Yrow0  , const bf16_t* Grow0, int gpitch, int lane, int r32, int hi) {
  bf16_t* st = (bf16_t*)stg;
#pragma unroll
  for (int r = 0; r < 16; ++r) { const int orow = crow(r, hi);
#pragma unroll
    for (int d0 = 0; d0 < 4; ++d0) st[orow * 128 + d0 * 32 + r32] = (bf16_t)f2bf(v[d0][r]); }
  asm volatile("s_waitcnt lgkmcnt(0)" ::: "memory");
  const bf16_t* gp = Grow0 + (size_t)(lane >> 4) * gpitch + (lane & 15) * 8; bf16_t* yp = Yrow0 + (size_t)(lane >> 4) * DM + (lane & 15) * 8; const bf16_t* sp = st + (lane >> 4) * 128 + (lane & 15) * 8;
  u32x4 g[8];
#pragma unroll
  for (int i = 0; i < 8; ++i) { g[i] = __builtin_nontemporal_load((const u32x4*)gp); gp += 4 * (size_t)gpitch; asm volatile("" : "+v"(gp)); }
#pragma unroll
  for (int i = 0; i < 8; ++i) {
    const u32x4 x = *(const u32x4*)(sp + i * 4 * 128);
    u32x4 w; w.x = pk2(bflo(x.x) * GATE(bflo(g[i].x)), bfhi(x.x) * GATE(bfhi(g[i].x))); w.y = pk2(bflo(x.y) * GATE(bflo(g[i].y)), bfhi(x.y) * GATE(bfhi(g[i].y)));
    w.z = pk2(bflo(x.z) * GATE(bflo(g[i].z)), bfhi(x.z) * GATE(bfhi(g[i].z))); w.w = pk2(bflo(x.w) * GATE(bflo(g[i].w)), bfhi(x.w) * GATE(bfhi(g[i].w)));
    *(u32x4*)yp = w; yp += 4 * DM; asm volatile("" : "+v"(yp)); }
  asm volatile("s_waitcnt lgkmcnt(0)" ::: "memory");
}
__device__ __forceinline__ void gqa_unit(const Params& p, char* lds, int m0, int hq, const bf16_t* Kh, const bf16_t* Vh, int seq, const int wid) {
  const int lane = fresh_lane(), r32 = lane & 31, hi = lane >> 5;
  const bf16_t* QC = (const bf16_t*)(p.ws + WS_Q); const bf16_t* PR = (const bf16_t*)(p.ws + WS_PR); bf16_t* Y = (bf16_t*)(p.ws + WS_HY);
  f32x16 o[4]; float l_reg;
  attn_core<8>(QC + (size_t)(m0 + wid * QBLK + r32) * DM + hq * 128 + hi * 8, Kh, Vh, seq, 0, lds, o, l_reg, wid, lane);
  float rli[16]; row_inv_l(l_reg, lds, wid, r32, hi, rli);
#pragma unroll
  for (int d0 = 0; d0 < 4; ++d0)
#pragma unroll
    for (int r = 0; r < 16; ++r) o[d0][r] *= rli[r];
  __syncthreads();
  const size_t row0 = (size_t)(m0 + wid * QBLK);
  store_rows_gated<false>(o, lds + wid * 8192, Y + row0 * DM + hq * 128, (const bf16_t*)(p.ws + WS_SG) + row0 * DM + hq * 128, DM, lane, r32, hi);
  __syncthreads();
}
constexpr int RES_WS = 131072 + 1024, RES_EX = 131072 + 4096;
__device__ __forceinline__ void load_kv_resident(const bf16_t* __restrict__ Kh, const bf16_t* __restrict__ Vh, char* lds, int tid) {
  bf16x8 kr[8], vr[8];
#pragma unroll
  for (int i = 0; i < 8; ++i) { const int c = tid + 512 * i; kr[i] = __builtin_nontemporal_load(reinterpret_cast<const bf16x8*>(Kh + (size_t)c * 8)); vr[i] = __builtin_nontemporal_load(reinterpret_cast<const bf16x8*>(Vh + (size_t)c * 8)); }
#pragma unroll
  for (int i = 0; i < 8; ++i) { const int c = tid + 512 * i, key = c >> 4, col = (c & 15) * 8, t = key >> 6, k = key & 63;
    *(bf16x8*)(lds + 65536 + t * 16384 + v_st(k, col)) = vr[i];
    *(bf16x8*)(lds + t * 16384 + KSWZ(k, col * 2)) = kr[i]; }
}
template <int ND0>
__device__ __forceinline__ void attn_core_res(const bf16_t* Qw, int kcol0, char* lds, f32x16 (&o)[4], float& l_reg, const int wid, const int lane) {
  const int r32 = lane & 31, hi = lane >> 5;
  const char* K_lds = lds; float* al_l = (float*)(lds + RES_WS) + wid * 64 + 32;
  float m_reg = -1e30f; l_reg = 0; bf16x8 qr[ND0];
  f32x16 cinit; for (int r = 0; r < 16; ++r) cinit[r] = -SOFT_OFF;
#pragma unroll
  for (int d = 0; d < 4; ++d) o[d] = f32x16{};
#pragma unroll
  for (int d0 = 0; d0 < ND0; ++d0) qr[d0] = __builtin_nontemporal_load(reinterpret_cast<const bf16x8*>(Qw + d0 * 16));
  const int vb0 = (int)(uintptr_t)(lds + 65536) + v_rd_base(lane);
#define RESC(a) do { if (__any((a) < 1.f)) { if (hi == 0) al_l[r32] = (a); asm volatile("s_waitcnt lgkmcnt(0)" ::: "memory"); \
    for (int d = 0; d < 4; ++d) for (int r = 0; r < 16; ++r) o[d][r] *= al_l[crow(r, hi)]; } } while (0)
  f32x16 pA0, pA1, pB0, pB1; float mnA, mnB, alA, alB; bf16x8 pa0, pa1, pa2, pa3;
  qkt<ND0>(pA0, pA1, K_lds, qr, r32, hi, kcol0, cinit); partialSM(pA0, pA1, m_reg, mnA, alA);
  SBAR(); qkt<ND0>(pB0, pB1, K_lds + 16384, qr, r32, hi, kcol0, cinit);
  finishSM(pA0, pA1, alA, l_reg, pa0, pa1, pa2, pa3); SBAR();
  pv_d0(o, vb0, pa0, pa1, pa2, pa3); partialSM(pB0, pB1, m_reg, mnB, alB); RESC(alB);
  SBAR(); qkt<ND0>(pA0, pA1, K_lds + 2 * 16384, qr, r32, hi, kcol0, cinit);
  finishSM(pB0, pB1, alB, l_reg, pa0, pa1, pa2, pa3); SBAR();
  pv_d0(o, vb0 + 16384, pa0, pa1, pa2, pa3); partialSM(pA0, pA1, m_reg, mnA, alA); RESC(alA);
  SBAR(); qkt<ND0>(pB0, pB1, K_lds + 3 * 16384, qr, r32, hi, kcol0, cinit);
  finishSM(pA0, pA1, alA, l_reg, pa0, pa1, pa2, pa3); SBAR();
  pv_d0(o, vb0 + 2 * 16384, pa0, pa1, pa2, pa3); partialSM(pB0, pB1, m_reg, mnB, alB); RESC(alB);
  finishSM(pB0, pB1, alB, l_reg, pa0, pa1, pa2, pa3); SBAR();
  pv_d0(o, vb0 + 3 * 16384, pa0, pa1, pa2, pa3);
#undef RESC
}
__device__ __forceinline__ void row_inv_l_res(float l_reg, char* lds, int wid, int r32, int hi, float (&rli)[16]) {
  float* li_l = (float*)(lds + RES_WS) + wid * 64;
  if (hi == 0) li_l[r32] = l_reg; asm volatile("s_waitcnt lgkmcnt(0)" ::: "memory");
#pragma unroll
  for (int r = 0; r < 16; ++r) rli[r] = __builtin_amdgcn_rcpf(li_l[crow(r, hi)]);
}
template <bool SILU> __device__ __forceinline__ void store_direct_gated(const f32x16 (&v)[4], char* stg  , bf16_t* Y0  , const bf16_t* G0, int gpitch, int lane, int r32, int hi) {
  bf16_t* st = (bf16_t*)stg;
  const bf16_t* gp = G0 + (size_t)(lane >> 4) * gpitch + (lane & 15) * 8; bf16_t* yp = Y0 + (size_t)(lane >> 4) * DM + (lane & 15) * 8; const bf16_t* sp = st + (lane >> 4) * 128 + (lane & 15) * 8;
  u32x4 g[8];
#pragma unroll
  for (int i = 0; i < 8; ++i) { g[i] = __builtin_nontemporal_load((const u32x4*)gp); gp += 4 * (size_t)gpitch; asm volatile("" : "+v"(gp)); }
#pragma unroll
  for (int j = 0; j < 4; ++j) {
#pragma unroll
    for (int rr = 0; rr < 4; ++rr)
#pragma unroll
      for (int d0 = 0; d0 < 4; ++d0) st[(rr + 4 * hi) * 128 + d0 * 32 + r32] = (bf16_t)f2bf(v[d0][4 * j + rr]);
    asm volatile("s_waitcnt lgkmcnt(0)" ::: "memory");
#pragma unroll
    for (int i = 0; i < 2; ++i) {
      const u32x4 x = *(const u32x4*)(sp + i * 4 * 128); const u32x4 gg = g[2 * j + i];
      u32x4 w; w.x = pk2(bflo(x.x) * GATE(bflo(gg.x)), bfhi(x.x) * GATE(bfhi(gg.x))); w.y = pk2(bflo(x.y) * GATE(bflo(gg.y)), bfhi(x.y) * GATE(bfhi(gg.y)));
      w.z = pk2(bflo(x.z) * GATE(bflo(gg.z)), bfhi(x.z) * GATE(bfhi(gg.z))); w.w = pk2(bflo(x.w) * GATE(bflo(gg.w)), bfhi(x.w) * GATE(bfhi(gg.w)));
      *(u32x4*)yp = w; yp += 4 * DM; asm volatile("" : "+v"(yp)); }
    asm volatile("s_waitcnt lgkmcnt(0)" ::: "memory");
  }
}
__device__ __forceinline__ void gqa_prompt_slot(const Params& p, char* lds, int bk, const int wid) {
  const int lane = fresh_lane(), r32 = lane & 31, hi = lane >> 5;
  const bf16_t* QC = (const bf16_t*)(p.ws + WS_Q); const bf16_t* PR = (const bf16_t*)(p.ws + WS_PR); bf16_t* Y = (bf16_t*)(p.ws + WS_HY);
  load_kv_resident((const bf16_t*)(p.ws + WS_KP) + (size_t)bk * SEQP * 128, (const bf16_t*)(p.ws + WS_VP) + (size_t)bk * SEQP * 128, lds, wid * 64 + lane);
  __syncthreads();
  const int m0 = (bk >> 2) * SEQP;
  for (int g = 0; g < 4; ++g) {
    const int lane = fresh_lane(), r32 = lane & 31, hi = lane >> 5;
    const int hq = (bk & 3) * 4 + g;
    f32x16 o[4]; float l_reg;
    const size_t row0 = (size_t)(m0 + wid * QBLK);
    attn_core_res<8>(QC + (row0 + r32) * DM + hq * 128 + hi * 8, 0, lds, o, l_reg, wid, lane);
    float rli[16]; row_inv_l_res(l_reg, lds, wid, r32, hi, rli);
#pragma unroll
    for (int d0 = 0; d0 < 4; ++d0)
#pragma unroll
      for (int r = 0; r < 16; ++r) o[d0][r] *= rli[r];
    store_direct_gated<false>(o, lds + RES_EX + wid * 2048, Y + row0 * DM + hq * 128, (const bf16_t*)(p.ws + WS_SG) + row0 * DM + hq * 128, DM, lane, r32, hi);
  }
  __syncthreads();
}
__device__ __forceinline__ void diff_prompt_slot(const Params& p, char* lds, int slot  , float lam, const int wid) {
  const bf16_t* QA = (const bf16_t*)(p.ws + WS_Q); bf16_t* Y = (bf16_t*)(p.ws + WS_HY);
  for (int hh = 0; hh < 2; ++hh) {
    const int lane = fresh_lane(), r32 = lane & 31, hi = lane >> 5;
    const int bh = slot * 2 + hh, h = bh & 7, b = bh >> 3;
    load_kv_resident((const bf16_t*)(p.ws + WS_KP) + (size_t)bh * SEQP * 128, (const bf16_t*)(p.ws + WS_VP) + (size_t)bh * SEQP * 128, lds, wid * 64 + lane);
    __syncthreads();
    const size_t row0 = (size_t)(b * SEQP + wid * QBLK);
    const bf16_t* Qw = QA + (row0 + r32) * 1024 + h * 128 + hi * 8;
    bf16x8 q1[4], q2[4];
#pragma unroll
    for (int d0 = 0; d0 < 4; ++d0) { q1[d0] = __builtin_nontemporal_load(reinterpret_cast<const bf16x8*>(Qw + d0 * 16)); q2[d0] = __builtin_nontemporal_load(reinterpret_cast<const bf16x8*>(Qw + 64 + d0 * 16)); }
    f32x16 o1[4], o2[4];
#pragma unroll
    for (int d = 0; d < 4; ++d) { o1[d] = f32x16{}; o2[d] = f32x16{}; }
    float m1 = -1e30f, m2 = -1e30f, l1 = 0.f, l2 = 0.f;
    float* al_l = (float*)(lds + RES_WS) + wid * 64 + 32;
    const int vb0 = (int)(uintptr_t)(lds + 65536) + v_rd_base(lane);
    f32x16 cz; for (int r = 0; r < 16; ++r) cz[r] = 0.f;
#define RESC2(o, a) do { if (__any((a) < 1.f)) { if (hi == 0) al_l[r32] = (a); asm volatile("s_waitcnt lgkmcnt(0)" ::: "memory"); \
    for (int d = 0; d < 4; ++d) for (int r = 0; r < 16; ++r) o[d][r] *= al_l[crow(r, hi)]; asm volatile("s_waitcnt lgkmcnt(0)" ::: "memory"); } } while (0)
#pragma unroll 1
    for (int t = 0; t < 4; ++t) {
      f32x16 p0, p1; float mn, al; bf16x8 pa0, pa1, pa2, pa3;
      qkt<4>(p0, p1, lds + t * 16384, q1, r32, hi, 0, cz); partialSM(p0, p1, m1, mn, al); finishSM(p0, p1, al, l1, pa0, pa1, pa2, pa3); RESC2(o1, al); SBAR();
      pv_d0(o1, vb0 + t * 16384, pa0, pa1, pa2, pa3); SBAR();
      qkt<4>(p0, p1, lds + t * 16384, q2, r32, hi, 64, cz); partialSM(p0, p1, m2, mn, al); finishSM(p0, p1, al, l2, pa0, pa1, pa2, pa3); RESC2(o2, al); SBAR();
      pv_d0(o2, vb0 + t * 16384, pa0, pa1, pa2, pa3); SBAR();
    }
#undef RESC2
    float ra[16], rb[16];
    row_inv_l_res(l1, lds, wid, r32, hi, ra);
    asm volatile("s_waitcnt lgkmcnt(0)" ::: "memory");
    row_inv_l_res(l2, lds, wid, r32, hi, rb);
    float ss[16];
#pragma unroll
    for (int r = 0; r < 16; ++r) { ss[r] = 0.f; rb[r] *= lam; }
#pragma unroll
    for (int d0 = 0; d0 < 4; ++d0)
#pragma unroll
      for (int r = 0; r < 16; ++r) { const float v = o1[d0][r] * ra[r] - o2[d0][r] * rb[r]; o1[d0][r] = v; ss[r] += v * v; }
#pragma unroll
    for (int r = 0; r < 16; ++r) {
#pragma unroll
      for (int of = 1; of < 32; of <<= 1) ss[r] += __shfl_xor(ss[r], of);
      ss[r] = 0.8f * __builtin_amdgcn_rsqf(ss[r] * (1.f / 128.f) + EPS); }
#pragma unroll
    for (int d0 = 0; d0 < 4; ++d0) { const float sw = p.subln_w[d0 * 32 + r32];
#pragma unroll
      for (int r = 0; r < 16; ++r) o1[d0][r] *= ss[r] * sw; }
    store_direct_gated<false>(o1, lds + RES_EX + wid * 2048, Y + row0 * DM + h * 128, (const bf16_t*)(p.ws + WS_SG) + row0 * DM + h * 128, DM, lane, r32, hi);
    __syncthreads();
  }
}
__device__ __forceinline__ void gqa_phase(const Params& p, char* lds, int vcu, int G, const int wid, const int mode) {
  for (int v = vcu; v < 256; v += G) {
    if (v < 128) { if (mode & 1) continue;
      const int qb = v & 3, g = (v >> 2) & 3, bk = v >> 4;
      gqa_unit(p, lds, MP + (bk >> 2) * SEQS + qb * 256, (bk & 3) * 4 + g, (const bf16_t*)(p.ws + WS_KSC) + (size_t)bk * LKS * 128, (const bf16_t*)(p.ws + WS_VSC) + (size_t)bk * LKS * 128, LKS, wid); }
    else { if (mode & 2) continue; gqa_prompt_slot(p, lds, v - 128, wid); }
  }
}
__device__ __forceinline__ void diff_unit(const Params& p, char* lds, int m0, int h, const bf16_t* Kh, const bf16_t* Vh, int seq, float lam, const int wid) {
  const int lane = fresh_lane(), r32 = lane & 31, hi = lane >> 5, rg = wid & 3, mp = wid >> 2;
  const bf16_t* QA = (const bf16_t*)(p.ws + WS_Q); const bf16_t* PR = (const bf16_t*)(p.ws + WS_PR); bf16_t* Y = (bf16_t*)(p.ws + WS_HY);
  f32x16 o[4]; float l_reg;
  attn_core<4>(QA + (size_t)(m0 + rg * QBLK + r32) * 1024 + h * 128 + mp * 64 + hi * 8, Kh, Vh, seq, mp * 64, lds, o, l_reg, wid, lane);
  float rli[16]; row_inv_l(l_reg, lds, wid, r32, hi, rli);
  __syncthreads();
  float* ex = (float*)lds + rg * 4096 + lane;
  if (mp == 1) {
#pragma unroll
    for (int d0 = 0; d0 < 4; ++d0)
#pragma unroll
      for (int r = 0; r < 16; ++r) ex[(d0 * 16 + r) * 64] = o[d0][r] * (rli[r] * lam);
  }
  __syncthreads();
  if (mp == 0) {
    float ss[16];
#pragma unroll
    for (int r = 0; r < 16; ++r) ss[r] = 0.f;
#pragma unroll
    for (int d0 = 0; d0 < 4; ++d0)
#pragma unroll
      for (int r = 0; r < 16; ++r) { const float v = o[d0][r] * rli[r] - ex[(d0 * 16 + r) * 64]; o[d0][r] = v; ss[r] += v * v; }
#pragma unroll
    for (int r = 0; r < 16; ++r) {
#pragma unroll
      for (int of = 1; of < 32; of <<= 1) ss[r] += __shfl_xor(ss[r], of);
      ss[r] = 0.8f / sqrtf(ss[r] * (1.f / 128.f) + EPS); }
#pragma unroll
    for (int d0 = 0; d0 < 4; ++d0) { const float sw = p.subln_w[d0 * 32 + r32];
#pragma unroll
      for (int r = 0; r < 16; ++r) o[d0][r] *= ss[r] * sw; }
    const size_t row0 = (size_t)(m0 + rg * QBLK);
    store_rows_gated<false>(o, lds + STG_OFF + rg * 8192, Y + row0 * DM + h * 128, (const bf16_t*)(p.ws + WS_SG) + row0 * DM + h * 128, DM, lane, r32, hi);
  }
  __syncthreads();
}
__device__ __forceinline__ void diff_phase(const Params& p, char* lds, int vcu, int G, const int wid, const int mode) {
  const int lane = fresh_lane();
  const float lam = expf(wave_sum(p.lam_q1[lane] * p.lam_k1[lane])) - expf(wave_sum(p.lam_q2[lane] * p.lam_k2[lane])) + 0.2f;
  for (int v = vcu; v < 256; v += G) {
    if (v < 128) { if (mode & 1) continue;
      const int qb = v & 7, bh = v >> 3;
      diff_unit(p, lds, MP + (bh >> 3) * SEQS + qb * 128, bh & 7, (const bf16_t*)(p.ws + WS_KSA) + (size_t)bh * LKS * 128, (const bf16_t*)(p.ws + WS_VSA) + (size_t)bh * LKS * 128, LKS, lam, wid);
      if (!(mode & 4)) pool_apply_slot(p, v * 80, 12, wid * 64 + fresh_lane()); }
    else { if (mode & 2) continue; diff_prompt_slot(p, lds, v - 128, lam, wid); if (!(mode & 4)) pool_apply_slot(p, (v - 128) * 80 + 48, 8, wid * 64 + fresh_lane()); }
  }
}
#undef KSWZ
#undef SBAR
}

constexpr int NWAVES = 8;
constexpr int RING_OFF = 0, RING_BYTES = 131072;
constexpr int LDSCTL_OFF = RING_BYTES, MISC_OFF = LDSCTL_OFF + 320;
constexpr int LDS_BYTES = 163840;
constexpr int RES_WS_OFF = RING_BYTES + 1024, RES_EX_OFF = RING_BYTES + 4096;
constexpr int CW_BAR = 4096;
#define GAS __attribute__((address_space(1)))
#define LAS __attribute__((address_space(3)))
typedef GAS unsigned gu32;
#define RLX_AGENT __ATOMIC_RELAXED, __HIP_MEMORY_SCOPE_AGENT
#define XB_TMO      128
#define XB_XCNT(j)  (256  + 64 * (j))
#define XB_XSUB(j)  (1280 + 64 * (j))
#define XB_XGEN(j)  (2304 + 64 * (j))
#define XB_TOP      3328
#define XB_TOPGEN   3392
#define XCD_BAR_WORDS 3456
#define XB_SPIN_CAP (1u << 18)
__device__ __forceinline__ unsigned xb_ld(unsigned* p)              { return __hip_atomic_load(p, __ATOMIC_RELAXED, __HIP_MEMORY_SCOPE_AGENT); }
__device__ __forceinline__ unsigned xb_add(unsigned* p, unsigned v) { return __hip_atomic_fetch_add(p, v, __ATOMIC_RELAXED, __HIP_MEMORY_SCOPE_AGENT); }
__device__ __forceinline__ unsigned xb_xcc_id() { return (unsigned)__builtin_amdgcn_s_getreg((3 << 11) | 20) & 0xFu; }
#define XB_SPIN(cond, bar) do { unsigned _sp = 0; while (cond) { __builtin_amdgcn_s_sleep(1); \
    if ((++_sp & 255u) == 0u) { if (xb_ld(&(bar)[XB_TMO])) break; if (_sp > XB_SPIN_CAP) { atomicAdd(&(bar)[XB_TMO], 1u); break; } } } } while (0)
struct XcdBarrier { unsigned* bar; unsigned x; volatile LAS unsigned* st; };
__device__ __forceinline__ XcdBarrier xcd_barrier_post(unsigned* bar, volatile LAS unsigned* st) {
    XcdBarrier b; b.bar = bar; b.x = xb_xcc_id(); b.st = st;
    if (threadIdx.x == 0) (void)xb_add(&bar[XB_XCNT(b.x)], 1u);
    return b;
}
__device__ __forceinline__ void xcd_barrier_complete(unsigned* bar, unsigned x, unsigned& nloc, unsigned& nx) {
    const unsigned G = gridDim.x * gridDim.y * gridDim.z;
    unsigned sum, cnt, mine, sp = 0u;
    for (;;) {
        sum = 0u; cnt = 0u; mine = 0u;
#pragma unroll
        for (unsigned j = 0; j < 16; ++j) { const unsigned c = xb_ld(&bar[XB_XCNT(j)]); sum += c; cnt += (c > 0u) ? 1u : 0u; mine = (j == x) ? c : mine; }
        if (sum == G) break;
        __builtin_amdgcn_s_sleep(1);
        if ((++sp & 255u) == 0u) { if (xb_ld(&bar[XB_TMO])) break; if (sp > XB_SPIN_CAP) { atomicAdd(&bar[XB_TMO], 1u); break; } }
    }
    nloc = mine > 0u ? mine : 1u; nx = cnt > 0u ? cnt : 1u;
}
__device__ __forceinline__ void xcd_barrier(const XcdBarrier& b, const int wave) {
    asm volatile("s_waitcnt vmcnt(0)" ::: "memory");
    __syncthreads();
    if (wave == 0 && fresh_lane() == 0) {
        unsigned* bar = b.bar;
        __builtin_amdgcn_s_waitcnt(0);
        unsigned nloc = b.st[0], nx = b.st[1];
        if (nloc == 0u) { xcd_barrier_complete(bar, b.x, nloc, nx); b.st[0] = nloc; b.st[1] = nx; }
        const unsigned old = xb_add(&bar[XB_XSUB(b.x)], 1u);
        const unsigned gen = old / nloc;
        if (old + 1u == (gen + 1u) * nloc) {
            __builtin_amdgcn_fence(__ATOMIC_RELEASE, "agent");
            asm volatile("s_waitcnt vmcnt(0)" ::: "memory");
            const unsigned og = xb_add(&bar[XB_TOP], 1u);
            const unsigned tg = og / nx;
            if (og + 1u == (tg + 1u) * nx) xb_add(&bar[XB_TOPGEN], 1u);
            else XB_SPIN(xb_ld(&bar[XB_TOPGEN]) == tg, bar);
            __builtin_amdgcn_fence(__ATOMIC_ACQUIRE, "agent");
            xb_add(&bar[XB_XGEN(b.x)], 1u);
            asm volatile("s_waitcnt vmcnt(0)" ::: "memory");
        } else {
            XB_SPIN(xb_ld(&bar[XB_XGEN(b.x)]) == gen, bar);
            __builtin_amdgcn_fence(__ATOMIC_ACQUIRE, "agent");
            asm volatile("s_waitcnt vmcnt(0)" ::: "memory");
        }
    }
    __syncthreads();
}

constexpr size_t WS_SLAB = WS_PR + 40 * MiB;
constexpr size_t CTL_TAIL = 256 * 1024;
template <int KIND> __device__ __forceinline__ void tail_reduce(const Params& p, const pg8::StaticOrder& S, int slot, int wave, int lane) {
    if (S.split <= 1) return;
    const int c = S.c, xcd = c % 8, q = c / 8, split = S.split, ks = q % split, j = (q / split) * 8 + xcd;
    pg8::Unit u; S.tile(S.nfull + j, u);
    unsigned* cnt = (unsigned*)(p.ws + WS_CTL + CTL_TAIL) + slot * 4096 + 64 * j;
    asm volatile("s_waitcnt vmcnt(0)" ::: "memory");
    __syncthreads();
    if (threadIdx.x == 0) {
        __builtin_amdgcn_fence(__ATOMIC_RELEASE, "agent");
        asm volatile("s_waitcnt vmcnt(0)" ::: "memory");
        __hip_atomic_fetch_add(cnt, 1u, __ATOMIC_RELAXED, __HIP_MEMORY_SCOPE_AGENT);
        unsigned sp = 0;
        while (__hip_atomic_load(cnt, __ATOMIC_RELAXED, __HIP_MEMORY_SCOPE_AGENT) < (unsigned)split) { __builtin_amdgcn_s_sleep(1); if (++sp > (1u << 22)) break; }
        __builtin_amdgcn_fence(__ATOMIC_ACQUIRE, "agent");
        asm volatile("s_waitcnt vmcnt(0)" ::: "memory");
    }
    __syncthreads();
    const int R = 256 / split, rpw = R / 8;
    const float* sb = (const float*)(p.ws + WS_SLAB) + (size_t)(j * split) * 65536 + 4 * lane;
    const int col = u.pn * 256 + 4 * lane;
    for (int i = 0; i < rpw; ++i) {
        const int rl = ks * R + wave * rpw + i, r = u.pm * 256 + rl, cr = cond_row(r);
        f32x4 sum = {0.f, 0.f, 0.f, 0.f};
        for (int sidx = 0; sidx < split; ++sidx) sum += *(const f32x4*)(sb + (size_t)sidx * 65536 + (size_t)rl * 256);
        if (KIND == 0) {
            const f32x4 x = *(const f32x4*)(xrow_ptr(p, r) + col), gt = *(const f32x4*)((const float*)(p.ws + WS_MOD) + 4096 + (size_t)cr * 6144 + col), cw = *(const f32x4*)((const float*)(p.ws + WS_CW1) + (size_t)cr * DM + col);
            const f32x4 y = x + gt * sum;
            *(f32x4*)(p.out + (size_t)r * DM + col) = y;
            const f32x4 h = y * cw; u32x2 o; o.x = pk2(h[0], h[1]); o.y = pk2(h[2], h[3]);
            *(u32x2*)((bf16_t*)(p.ws + WS_H1) + (size_t)r * DM + col) = o;
            const float ss = wave_sum((y[0] * y[0] + y[1] * y[1]) + (y[2] * y[2] + y[3] * y[3]));
            if (lane == 0) atomicAdd((float*)(p.ws + WS_RSS) + r, ss);
        } else if (KIND == 1) {
            const f32x4 gt = *(const f32x4*)((const float*)(p.ws + WS_MOD) + 3 * 6144 + 4096 + (size_t)cr * 6144 + col);
            float* op = p.out + (size_t)r * DM + col; *(f32x4*)op = *(const f32x4*)op + gt * sum;
        } else {
            const float rstd = 1.0f / sqrtf(((const float*)(p.ws + WS_RSS))[r] * (1.f / DM) + EPS);
            const f32x4 v = sum * rstd + *(const f32x4*)((const float*)(p.ws + WS_B2P) + (size_t)cr * ODD_IN + col);
            u32x2 o; o.x = pk2(siluf(v[0]), siluf(v[1])); o.y = pk2(siluf(v[2]), siluf(v[3]));
            *(u32x2*)((bf16_t*)(p.ws + WS_SG) + (size_t)r * DM + (col - 12 * 256)) = o;
        }
    }
}

struct MegaArgs { Params p; int ph_lo, ph_hi, mode, pad; };
constexpr int N_PHASES = 11;
#ifndef DUP_PHASE
#define DUP_PHASE -1
#endif
__device__ __forceinline__ Params load_params() {
#if defined(__HIP_DEVICE_COMPILE__)
    typedef __attribute__((address_space(4))) const unsigned long long* KPtr;
    KPtr a = (KPtr)__builtin_amdgcn_kernarg_segment_ptr();
    asm volatile("" : "+s"(a));
#define GPF(i) ((const float*)(__attribute__((address_space(1))) const float*)(a[i]))
    Params p;
    p.x_prompt = GPF(0); p.x_sample = GPF(1); p.cache_a_k = GPF(2); p.cache_a_v = GPF(3); p.cache_c_k = GPF(4); p.cache_c_v = GPF(5);
    p.c = GPF(6); p.c_ctx = GPF(7); p.norm_w = GPF(8); p.ada_w = GPF(9); p.ada_b = GPF(10);
    p.even_w_in = GPF(11); p.even_q_norm_w = GPF(12); p.even_k_norm_w = GPF(13); p.lam_q1 = GPF(14); p.lam_k1 = GPF(15); p.lam_q2 = GPF(16); p.lam_k2 = GPF(17);
    p.subln_w = GPF(18); p.pool_w = GPF(19); p.pool_scale = GPF(20); p.even_w_out = GPF(21);
    p.gqa_w_in = GPF(22); p.gqa_q_norm_w = GPF(23); p.gqa_k_norm_w = GPF(24); p.gqa_w_out = GPF(25);
    p.out = (float*)(__attribute__((address_space(1))) float*)(a[26]); p.ws = (unsigned char*)(__attribute__((address_space(1))) unsigned char*)(a[27]);
#undef GPF
    return p;
#else
    return Params{};
#endif
}
__global__ void __launch_bounds__(NWAVES * 64, 2) mega_fwd(MegaArgs args) {
    extern __shared__ __attribute__((aligned(16))) unsigned char lds[];
    LAS unsigned char* ldsl = (LAS unsigned char*)lds;
    volatile LAS unsigned* MISC = (volatile LAS unsigned*)(ldsl + MISC_OFF);
    const int wave = __builtin_amdgcn_readfirstlane(threadIdx.x >> 6);
    const int G = gridDim.x, bx = blockIdx.x;
    const int vcu = (G % 8 == 0) ? (bx % 8) * (G / 8) + bx / 8 : bx;
    for (int u = threadIdx.x; u < (LDS_BYTES - LDSCTL_OFF) / 4; u += NWAVES * 64) ((LAS unsigned*)(ldsl + LDSCTL_OFF))[u] = 0u;
    __syncthreads();
    XcdBarrier bar; { const Params p0 = load_params(); bar = xcd_barrier_post((unsigned*)(p0.ws + WS_CTL) + CW_BAR, MISC + 8); }
    const int lo = args.ph_lo, hi = args.ph_hi, mode = args.mode;
    const int gw = vcu * NWAVES + wave, ngw = G * NWAVES;
#define IN(k) (lo <= (k) && (k) < hi)
#define SEAM(k) do { if (IN(k) && (IN((k) + 1) || ((k) == 7 && IN(9)) || ((k) == 5 && IN(7)) || ((k) == 2 && IN(4)))) xcd_barrier(bar, wave); } while (0)
    if (IN(0)) {
        const Params p = load_params();
        float* scr = (float*)lds; const int lane = fresh_lane(), tid = wave * 64 + lane;
        if (!(mode & 8)) mod_items(p, scr, bx, G, tid, NWAVES * 64, 0);
        __syncthreads();
        if (!(mode & 16)) weights_items(p, (float*)(lds + wave * 16384), gw, ngw, lane, 0);
    }
    SEAM(0);
    if (IN(1)) {
        const Params p = load_params(); unsigned char* const ws = p.ws;
        if (bx < 32) {
            pg8::Gemm g{(const bf16_t*)(ws + WS_POOLW), (const bf16_t*)(ws + WS_WU), 1024, DM, 256, 256, 1024, 0, 256, 0}; pg8::StaticOrder S; S.init(1024, DM, 256, G, bx, false);
            pg8::EpiBf16 E{(bf16_t*)(ws + WS_WINE) + (size_t)3072 * DM, DM, 0};
            pg8::gemm_phase<pg8::EpiBf16, pg8::StaticOrder, true, true>(ldsl + RING_OFF, g, S, E, wave * 64 + fresh_lane());
            if (G == 256) { const int ln = fresh_lane(), wv = bx * NWAVES + wave, vid = 224 * NWAVES + (wv >> 1), nv = 224 * NWAVES + 128, st = vid + (wv & 1) * nv;
                modulate_rows(p, 0, st, 2 * nv, ln);
                weights_items(p, (float*)(lds + wave * 16384), st, 2 * nv, ln, 1); }
        } else { const int ln = fresh_lane(), rk = bx - 32, nr = G - 32, g2 = rk * NWAVES + wave, n2 = (G == 256) ? 224 * NWAVES + 128 : nr * NWAVES;
            modulate_rows(p, 0, g2, n2, ln);
            weights_items(p, (float*)(lds + wave * 16384), g2, n2, ln, 1);
            __syncthreads();
            mod_items(p, (float*)lds, rk, nr, wave * 64 + ln, NWAVES * 64, 1);
            caches_rope_items(p, (long)rk * 512 + wave * 64 + ln, (long)nr * 512); }
    }
    SEAM(1);
    if (IN(2)) {
        const Params p = load_params(); unsigned char* const ws = p.ws;
        pg8::Gemm g{(const bf16_t*)(ws + WS_HY), (const bf16_t*)(ws + WS_WINE), MT, EVEN_IN, DM, DM, DM, 0, 0, 0}; pg8::StaticOrder S; S.init(MT, EVEN_IN, DM, G, bx, false);
        float* nak = p.out + (size_t)MT * DM;
        pg8::EpiProj0 E{ws, p.even_q_norm_w, p.even_k_norm_w, nak, nak + (size_t)NBP * HA * SEQP * 128};
        pg8::gemm_phase<pg8::EpiProj0, pg8::StaticOrder, true, true>(ldsl + RING_OFF, g, S, E, wave * 64 + fresh_lane());
        if (G == 256) { if (bx >= 192) { const Params p2 = load_params(); mod1_tables(p2, (bx - 192) * NWAVES + wave, 64 * NWAVES, fresh_lane()); } }
        else { const Params p2 = load_params(); mod1_tables(p2, gw, ngw, fresh_lane()); }
    }
    SEAM(2);
    if (IN(4)) { const Params p = load_params(); att::diff_phase(p, (char*)lds, vcu, G, wave, mode); }
    SEAM(4);
    constexpr size_t CTL_PANEL = 320 * 1024;
    const bool stagger = (G == 256) && IN(5) && IN(7);
    if (IN(5)) {
        for (int part = 0; part < (stagger ? 2 : 1); ++part) {
            const Params p = load_params(); unsigned char* const ws = p.ws;
            pg8::Gemm g{(const bf16_t*)(ws + WS_HY), (const bf16_t*)(ws + WS_WOUTE), MT, DM, DM, DM, DM, 0, 0, 0};
            pg8::EpiResid0 E{p.x_prompt, p.x_sample, (const float*)(ws + WS_MOD) + 4096, (const float*)(ws + WS_CW1), p.out, (bf16_t*)(ws + WS_H1), (float*)(ws + WS_RSS), (float*)(ws + WS_SLAB)};
            if (stagger) {
                if (part == 1 && bx >= 64) break;
                pg8::OutOrder S{bx, part};
                pg8::gemm_phase<pg8::EpiResid0, pg8::OutOrder, true, true>(ldsl + RING_OFF, g, S, E, wave * 64 + fresh_lane());
                if (part == 0) xcd_barrier(bar, wave);
                else {
                    asm volatile("s_waitcnt vmcnt(0)" ::: "memory"); __syncthreads();
                    if (wave == 0 && fresh_lane() == 0) { __builtin_amdgcn_fence(__ATOMIC_RELEASE, "agent"); asm volatile("s_waitcnt vmcnt(0)" ::: "memory");
                        __hip_atomic_fetch_add((unsigned*)(ws + WS_CTL + CTL_PANEL) + 64 * (bx / 8), 1u, __ATOMIC_RELAXED, __HIP_MEMORY_SCOPE_AGENT); }
                }
            } else {
                pg8::StaticOrder S; S.init(MT, DM, DM, G, bx, false);
                pg8::gemm_phase<pg8::EpiResid0, pg8::StaticOrder, true, true>(ldsl + RING_OFF, g, S, E, wave * 64 + fresh_lane());
            }
        }
    }
    if (!stagger) SEAM(5);
    if (IN(7)) {
        const Params p = load_params(); unsigned char* const ws = p.ws;
        pg8::Gemm g{(const bf16_t*)(ws + WS_H1), (const bf16_t*)(ws + WS_WINO), MT, ODD_IN, DM, DM, DM, 0, 0, 0};
        float* nck = p.out + (size_t)MT * DM + 2 * (size_t)NBP * HA * SEQP * 128;
        pg8::EpiProj1 E{ws, p.gqa_q_norm_w, p.gqa_k_norm_w, nck, nck + (size_t)NBP * KVH * SEQP * 128, (LAS float*)(ldsl + RES_EX_OFF), (float*)(ws + WS_SLAB)};
        if (stagger) { pg8::StaggerOrder S{bx, (const unsigned*)(ws + WS_CTL + CTL_PANEL), true, wave};
            pg8::gemm_phase<pg8::EpiProj1, pg8::StaggerOrder, true, true>(ldsl + RING_OFF, g, S, E, wave * 64 + fresh_lane()); }
        else { pg8::StaticOrder S; S.init(MT, ODD_IN, DM, G, bx, false);
            pg8::gemm_phase<pg8::EpiProj1, pg8::StaticOrder, true, true>(ldsl + RING_OFF, g, S, E, wave * 64 + fresh_lane()); }
    }
    SEAM(7);
    if (IN(9)) { const Params p = load_params(); att::gqa_phase(p, (char*)lds, vcu, G, wave, mode); }
    SEAM(9);
    if (IN(10)) {
        const Params p = load_params(); unsigned char* const ws = p.ws;
        pg8::Gemm g{(const bf16_t*)(ws + WS_HY), (const bf16_t*)(ws + WS_WOUTO), MT, DM, DM, DM, DM, 0, 0, 0};
        pg8::EpiResidF E{p.x_prompt, p.x_sample, p.out, (const float*)(ws + WS_MOD) + 3 * 6144 + 4096, p.out, (float*)(ws + WS_SLAB)};
        if (G == 256) { pg8::LastOrder S{bx}; pg8::gemm_phase<pg8::EpiResidF, pg8::LastOrder, true, true>(ldsl + RING_OFF, g, S, E, wave * 64 + fresh_lane()); }
        else { pg8::StaticOrder S; S.init(MT, DM, DM, G, bx, false); pg8::gemm_phase<pg8::EpiResidF, pg8::StaticOrder, true, true>(ldsl + RING_OFF, g, S, E, wave * 64 + fresh_lane()); }
    }
#undef IN
#undef SEAM
}

#ifndef MK_PER_PHASE
#define MK_PER_PHASE 0
#endif
extern "C" void kernel_launch(void* const* d_in, const int* in_sizes, int n_in, void* d_out, int out_size, void* d_ws, size_t ws_size, hipStream_t stream) {
    if (n_in != 26 || ws_size < WS_END || out_size != MT * DM + 2 * NBP * HA * SEQP * 128 + 2 * NBP * KVH * SEQP * 128) {
        fprintf(stderr, "kernel_launch: unexpected shapes n_in %d ws %zu out %d\n", n_in, ws_size, out_size); return; }
    static int ready = 0;
    if (!ready) {
        if (hipFuncSetAttribute((const void*)mega_fwd, hipFuncAttributeMaxDynamicSharedMemorySize, LDS_BYTES) != hipSuccess) { fprintf(stderr, "kernel_launch: hipFuncSetAttribute failed\n"); return; }
        ready = 1;
    }
    MegaArgs a{};
    const float** pin = (const float**)&a.p;
    for (int i = 0; i < 26; ++i) pin[i] = (const float*)d_in[i];
    a.p.out = (float*)d_out; a.p.ws = (unsigned char*)d_ws;
#ifdef EXTRA_PHASE
    (void)hipMemsetAsync((unsigned char*)d_ws + WS_CTL, 0, 2 * MiB, stream);
    a.ph_lo = EXTRA_PHASE; a.ph_hi = EXTRA_PHASE + 1; hipLaunchKernelGGL(mega_fwd, dim3(256), dim3(NWAVES * 64), LDS_BYTES, stream, a);
#endif
    (void)hipMemsetAsync((unsigned char*)d_ws + WS_CTL, 0, 2 * MiB, stream);
#if MK_PER_PHASE
    for (int ph = 0; ph < N_PHASES; ++ph) { a.ph_lo = ph; a.ph_hi = ph + 1; hipLaunchKernelGGL(mega_fwd, dim3(256), dim3(NWAVES * 64), LDS_BYTES, stream, a); }
#else
    a.ph_lo = 0; a.ph_hi = N_PHASES; hipLaunchKernelGGL(mega_fwd, dim3(256), dim3(NWAVES * 64), LDS_BYTES, stream, a);
#endif
#ifdef EXTRA_AFTER
    (void)hipMemsetAsync((unsigned char*)d_ws + WS_CTL, 0, 1 * MiB, stream);
    a.ph_lo = EXTRA_AFTER; a.ph_hi = EXTRA_AFTER + 1; a.mode = EXTRA_MODE; hipLaunchKernelGGL(mega_fwd, dim3(256), dim3(NWAVES * 64), LDS_BYTES, stream, a);
#endif
}
```

```cpp
#include <hip/hip_runtime.h>
#include <cstdio>
#include <cstdint>

typedef unsigned short bf16_t;
typedef float f32x4 __attribute__((ext_vector_type(4)));
typedef unsigned u32x4 __attribute__((ext_vector_type(4)));
typedef unsigned u32x2 __attribute__((ext_vector_type(2)));

constexpr int DM = 2048, NBP = 32, SEQP = 256, NBS = 2, SEQS = 1024, PAST = 256;
constexpr int MP = NBP * SEQP, MS = NBS * SEQS, MT = MP + MS;
constexpr int HA = 8, DKA = 64, DVA = 128, WA = 1024, WB = 1024, GWB = 256;
constexpr int EVEN_IN = 6144, ODD_IN = 5120;
constexpr int HC = 16, KVH = 4, HDC = 128;
constexpr int LKS = PAST + SEQS;
constexpr float EPS = 1e-6f;
constexpr float LOG2E = 1.4426950408889634f;
constexpr float C2A = 0.125f * LOG2E;
constexpr float C2C = 0.08838834764831845f * LOG2E;

constexpr size_t MiB = 1u << 20;
constexpr size_t WS_CTL = 0;
constexpr size_t WS_MOD = 1 * MiB;
constexpr size_t WS_ROPE = 2 * MiB;
constexpr size_t WS_WINE = 4 * MiB;
constexpr size_t WS_WOUTE = 28 * MiB;
constexpr size_t WS_WINO = 36 * MiB;
constexpr size_t WS_WOUTO = 56 * MiB;
constexpr size_t WS_POOLW = 64 * MiB;
constexpr size_t WS_HY = 65 * MiB;
constexpr size_t WS_PR = 105 * MiB;
constexpr size_t WS_Q = 225 * MiB;
constexpr size_t WS_KP = 265 * MiB;
constexpr size_t WS_VP = 281 * MiB;
constexpr size_t WS_KSA = 297 * MiB;
constexpr size_t WS_VSA = 302 * MiB;
constexpr size_t WS_KSC = 307 * MiB;
constexpr size_t WS_VSC = 310 * MiB;
constexpr size_t WS_UA = 313 * MiB;
constexpr size_t WS_SG = WS_PR;
constexpr size_t WS_U = WS_PR + 40 * MiB;
constexpr size_t WS_Y1B = 145 * MiB;
constexpr size_t WS_H1 = 333 * MiB;
constexpr size_t WS_WU = WS_UA;
constexpr size_t WS_END = 373 * MiB;
constexpr size_t WS_CW1 = WS_MOD + 256 * 1024;
constexpr size_t WS_B2P = WS_MOD + 320 * 1024;
constexpr size_t WS_RSS = WS_MOD + 512 * 1024;

struct Params {
    const float* x_prompt; const float* x_sample; const float* cache_a_k; const float* cache_a_v; const float* cache_c_k; const float* cache_c_v;
    const float* c; const float* c_ctx; const float* norm_w; const float* ada_w; const float* ada_b;
    const float* even_w_in; const float* even_q_norm_w; const float* even_k_norm_w; const float* lam_q1; const float* lam_k1; const float* lam_q2; const float* lam_k2;
    const float* subln_w; const float* pool_w; const float* pool_scale; const float* even_w_out;
    const float* gqa_w_in; const float* gqa_q_norm_w; const float* gqa_k_norm_w; const float* gqa_w_out;
    float* out; unsigned char* ws;
};

__device__ __forceinline__ unsigned pk2(float lo, float hi) { unsigned r; asm("v_cvt_pk_bf16_f32 %0, %1, %2" : "=v"(r) : "v"(lo), "v"(hi)); return r; }
__device__ __forceinline__ unsigned f2bf(float f) { return pk2(f, f) & 0xffffu; }
__device__ __forceinline__ float bf2f(unsigned h) { return __builtin_bit_cast(float, h << 16); }
__device__ __forceinline__ float bflo(unsigned w) { return __builtin_bit_cast(float, w << 16); }
__device__ __forceinline__ float bfhi(unsigned w) { return __builtin_bit_cast(float, w & 0xffff0000u); }
__device__ __forceinline__ float siluf(float x) { return x / (1.f + __expf(-x)); }
__device__ __forceinline__ float silu_fast(float x) { return x * __builtin_amdgcn_rcpf(1.f + __builtin_amdgcn_exp2f(-LOG2E * x)); }
__device__ __forceinline__ float wave_sum(float v) {
#pragma unroll
    for (int o = 1; o < 64; o <<= 1) v += __shfl_xor(v, o);
    return v;
}
__device__ __forceinline__ float wave_max(float v) {
#pragma unroll
    for (int o = 1; o < 64; o <<= 1) v = fmaxf(v, __shfl_xor(v, o));
    return v;
}
__device__ __forceinline__ int fresh_lane() { int l; asm volatile("v_mbcnt_lo_u32_b32 %0, -1, 0\n\tv_mbcnt_hi_u32_b32 %0, -1, %0" : "=v"(l)); return l; }
__device__ __forceinline__ const float* xrow_ptr(const Params& p, int m) { return m < MP ? p.x_prompt + (size_t)m * DM : p.x_sample + (size_t)(m - MP) * DM; }
__device__ __forceinline__ int cond_row(int m) { return m < MP ? 0 : 1 + ((m - MP) >> 10); }

__device__ __forceinline__ void mod_items(const Params& p, float* sl  , int bid, int nb, int tid, int nthr, int l) {
    float* mod = (float*)(p.ws + WS_MOD);
    float* red = sl + 768;
    const int w = tid >> 6, lane = tid & 63;
    for (int it = bid; it < 192; it += nb) {
        const int kc = it / 24, nc = it % 24;
        __syncthreads();
        for (int i = tid; i < 768; i += nthr) { const int r = i >> 8, kk = i & 255, k = kc * 256 + kk; const float cv = r == 0 ? p.c_ctx[k] : p.c[(r - 1) * DM + k]; sl[i] = siluf(cv); }
        __syncthreads();
        const int n = nc * 256 + lane * 4;
        const float* wp = p.ada_w + ((size_t)l * DM + kc * 256 + w * 32) * 6144 + n;
        f32x4 a0 = {0.f, 0.f, 0.f, 0.f}, a1 = a0, a2 = a0;
#pragma unroll 1
        for (int k0 = 0; k0 < 32; k0 += 16) { f32x4 wv[16];
#pragma unroll
            for (int kk = 0; kk < 16; ++kk) wv[kk] = __builtin_nontemporal_load((const f32x4*)(wp + (size_t)(k0 + kk) * 6144));
#pragma unroll
            for (int kk = 0; kk < 16; ++kk) { const int kr = w * 32 + k0 + kk; a0 += wv[kk] * sl[kr]; a1 += wv[kk] * sl[256 + kr]; a2 += wv[kk] * sl[512 + kr]; } }
        *(f32x4*)(red + ((w * 3 + 0) * 64 + lane) * 4) = a0; *(f32x4*)(red + ((w * 3 + 1) * 64 + lane) * 4) = a1; *(f32x4*)(red + ((w * 3 + 2) * 64 + lane) * 4) = a2;
        __syncthreads();
        if (tid < 192) { const int r = tid >> 6;
            f32x4 sum = (kc == 0) ? *(const f32x4*)(p.ada_b + l * 6144 + n) : (f32x4){0.f, 0.f, 0.f, 0.f};
#pragma unroll
            for (int ww = 0; ww < 8; ++ww) sum += *(const f32x4*)(red + ((ww * 3 + r) * 64 + lane) * 4);
            float* m0 = mod + (size_t)(l * 3 + r) * 6144 + n;
#pragma unroll
            for (int e = 0; e < 4; ++e) atomicAdd(m0 + e, sum[e]); }
    }
}

template <int PERMK> __device__ __forceinline__ int pos_of_col(int n) {
    if (PERMK == 1) { if (n >= 2048) return n; const int c = n & 255, wc = c >> 6, dim = c & 63, q = dim >> 4, ii = dim & 15; return (n & ~255) + 128 * (q & 1) + 32 * wc + (q >> 1) * 16 + ii; }
    if (PERMK == 2) { if (n >= 2560) return n; const int c = n & 255, hl = c >> 7, dim = c & 127, qd = dim >> 5, i = dim & 31; return (n & ~255) + 128 * (qd & 1) + 32 * (2 * hl + (qd >> 1)) + i; }
    return n;
}
template <int PERMK> __device__ __forceinline__ void transpose_item64(const float* W, int K, int N, bf16_t* WT, bf16_t* scr, int item, int lane) {
    const int nblk = N / 64, kb = item / nblk, nb = item % nblk, k0 = 64 * kb, n0 = 64 * nb;
    const int nq = lane & 15, kr = lane >> 4;
    f32x4 v[16];
    const float* src = W + (size_t)(k0 + kr) * N + n0 + 4 * nq;
#pragma unroll
    for (int i = 0; i < 16; ++i) v[i] = __builtin_nontemporal_load((const f32x4*)(src + (size_t)(4 * i) * N));
#pragma unroll
    for (int i = 0; i < 16; ++i) { const int k = 4 * i + kr;
#pragma unroll
        for (int e = 0; e < 4; ++e) scr[(4 * nq + e) * 72 + k] = (bf16_t)f2bf(v[i][e]); }
    __builtin_amdgcn_s_waitcnt(0xc07f); asm volatile("" ::: "memory");
#pragma unroll
    for (int j = 0; j < 8; ++j) { const int idx = lane + 64 * j, n = idx >> 3, c = idx & 7;
        *(u32x4*)(WT + (size_t)pos_of_col<PERMK>(n0 + n) * K + k0 + 8 * c) = *(const u32x4*)(scr + n * 72 + 8 * c); }
    __builtin_amdgcn_s_waitcnt(0xc07f); asm volatile("" ::: "memory");
}
__device__ __forceinline__ void convert_item64(const float* W, int N, bf16_t* WU, int ldu, int ncol0, int item, int nblk0, int lane) {
    const int nblk = N / 64, kb = item / nblk, nb = item % nblk, k0 = 64 * kb, n0 = 64 * nb;
    const int nq = lane & 15, kr = lane >> 4;
    const float* src = W + (size_t)(k0 + kr) * N + n0 + 4 * nq;
    f32x4 v[16];
#pragma unroll
    for (int i = 0; i < 16; ++i) v[i] = __builtin_nontemporal_load((const f32x4*)(src + (size_t)(4 * i) * N));
#pragma unroll
    for (int i = 0; i < 16; ++i) { u32x2 o; o.x = pk2(v[i][0], v[i][1]); o.y = pk2(v[i][2], v[i][3]); *(u32x2*)(WU + (size_t)(k0 + 4 * i + kr) * ldu + (n0 - ncol0) + 4 * nq) = o; }
}
__device__ __forceinline__ void weights_items(const Params& p, float* scrf  , int gw, int ngw, int lane, int part) {
    bf16_t* scr = (bf16_t*)scrf;
    constexpr int I_WU = 32 * 16, I_POOL = 4 * 4, I_WINE = 32 * 80, I_WOUT = 32 * (DM / 64), I_WINO = 32 * (ODD_IN / 64);
    if (part == 0) {
        for (int it = gw; it < I_WU + 4 * I_POOL; it += ngw) {
            if (it < I_WU) { convert_item64(p.even_w_in, EVEN_IN, (bf16_t*)(p.ws + WS_WU), 1024, 3072, (it >> 4) * 96 + 48 + (it & 15), 0, lane); continue; }
            const int r = it - I_WU, g = r / I_POOL;
            transpose_item64<0>(p.pool_w + (size_t)g * 65536, 256, 256, (bf16_t*)(p.ws + WS_POOLW) + (size_t)g * 65536, scr, r - g * I_POOL, lane);
        }
        return;
    }
    for (int it = gw; it < I_WINE + I_WOUT + I_WINO + I_WOUT; it += ngw) {
        int r = it;
        if (r < I_WINE) { const int kb = r / 80, j = r % 80; transpose_item64<1>(p.even_w_in, DM, EVEN_IN, (bf16_t*)(p.ws + WS_WINE), scr, kb * 96 + (j < 48 ? j : j + 16), lane); continue; } r -= I_WINE;
        if (r < I_WOUT) { transpose_item64<0>(p.even_w_out, DM, DM, (bf16_t*)(p.ws + WS_WOUTE), scr, r, lane); continue; } r -= I_WOUT;
        if (r < I_WINO) { transpose_item64<2>(p.gqa_w_in, DM, ODD_IN, (bf16_t*)(p.ws + WS_WINO), scr, r, lane); continue; } r -= I_WINO;
        transpose_item64<0>(p.gqa_w_out, DM, DM, (bf16_t*)(p.ws + WS_WOUTO), scr, r, lane);
    }
}
__device__ __forceinline__ void caches_rope_items(const Params& p, long gt, long ngt) {
    constexpr long NA = 2L * 8 * 256 * 128 / 4, NC = 2L * 4 * 256 * 128 / 4;
    for (long i = gt; i < 2 * NA + 2 * NC; i += ngt) {
        long j = i; const float* src; bf16_t* dst;
        if (j < NA) { src = p.cache_a_k; dst = (bf16_t*)(p.ws + WS_KSA); } else if ((j -= NA) < NA) { src = p.cache_a_v; dst = (bf16_t*)(p.ws + WS_VSA); }
        else if ((j -= NA) < NC) { src = p.cache_c_k; dst = (bf16_t*)(p.ws + WS_KSC); } else { j -= NC; src = p.cache_c_v; dst = (bf16_t*)(p.ws + WS_VSC); }
        const long e = j * 4, bh = e / (256 * 128), rem = e % (256 * 128);
        const f32x4 v = __builtin_nontemporal_load((const f32x4*)(src + e));
        u32x2 o; o.x = pk2(v[0], v[1]); o.y = pk2(v[2], v[3]);
        *(u32x2*)(dst + bh * (LKS * 128) + rem) = o;
    }
    float* ropeA = (float*)(p.ws + WS_ROPE); float* ropeC = ropeA + 2 * 1024 * 64;
    for (long i = gt; i < 1024L * 64 + 1024L * 128; i += ngt) {
        const bool isA = i < 1024L * 64; const long j = isA ? i : i - 1024L * 64; const int dim = isA ? 64 : 128, quarter = dim / 4;
        const int t = (int)(j / dim), d = (int)(j % dim); const int qd = d / quarter, fi = d % quarter;
        const float freq = powf(10000.0f, -(float)fi / (float)quarter);
        const float pos = (qd < 2) ? (float)(t / 64) : (float)(t % 64);
        const float ang = pos * freq;
        float* base = isA ? ropeA : ropeC;
        base[j] = cosf(ang); base[(size_t)1024 * dim + j] = sinf(ang);
    }
}

__device__ __forceinline__ void modulate_rows(const Params& p, int layer, int gw, int ngw, int lane) {
    const float* mod = (const float*)(p.ws + WS_MOD) + (size_t)layer * 3 * 6144;
    const float* nw = p.norm_w + layer * DM;
    bf16_t* H = (bf16_t*)(p.ws + WS_HY);
    f32x4 cw[8], sh[8]; int cur_cr = -1;
    f32x4 v[8], vn[8];
    if (gw < MT) { const float* xr = layer == 0 ? xrow_ptr(p, gw) : p.out + (size_t)gw * DM;
#pragma unroll
        for (int j = 0; j < 8; ++j) v[j] = __builtin_nontemporal_load((const f32x4*)(xr + 4 * lane + 256 * j)); }
    for (int m = gw; m < MT; m += ngw) {
        const int mn = m + ngw;
        if (mn < MT) { const float* xr = layer == 0 ? xrow_ptr(p, mn) : p.out + (size_t)mn * DM;
#pragma unroll
            for (int j = 0; j < 8; ++j) vn[j] = __builtin_nontemporal_load((const f32x4*)(xr + 4 * lane + 256 * j)); }
        float ss = 0.f;
#pragma unroll
        for (int j = 0; j < 8; ++j) ss += (v[j][0] * v[j][0] + v[j][1] * v[j][1]) + (v[j][2] * v[j][2] + v[j][3] * v[j][3]);
        const int cr = cond_row(m);
        if (cr != cur_cr) { cur_cr = cr; const float* mr = mod + (size_t)cr * 6144;
#pragma unroll
            for (int j = 0; j < 8; ++j) { const int k = 4 * lane + 256 * j; cw[j] = *(const f32x4*)(nw + k) * (*(const f32x4*)(mr + 2048 + k) + 1.0f); sh[j] = *(const f32x4*)(mr + k); } }
        const float rstd = 1.0f / sqrtf(wave_sum(ss) * (1.f / DM) + EPS);
#pragma unroll
        for (int j = 0; j < 8; ++j) { const int k = 4 * lane + 256 * j;
            const f32x4 h = v[j] * rstd * cw[j] + sh[j];
            u32x2 o; o.x = pk2(h[0], h[1]); o.y = pk2(h[2], h[3]);
            *(u32x2*)(H + (size_t)m * DM + k) = o; }
#pragma unroll
        for (int j = 0; j < 8; ++j) v[j] = vn[j];
    }
}

__device__ __forceinline__ void mod1_tables(const Params& p, int gw, int ngw, int lane) {
    const float* mod1 = (const float*)(p.ws + WS_MOD) + 3 * 6144;
    float* cw1 = (float*)(p.ws + WS_CW1); float* b2p = (float*)(p.ws + WS_B2P);
    for (int i = gw * 64 + lane; i < 3 * DM; i += ngw * 64) { const int cr = i / DM, k = i % DM; cw1[i] = p.norm_w[DM + k] * (1.f + mod1[cr * 6144 + 2048 + k]); }
    const bf16_t* W = (const bf16_t*)(p.ws + WS_WINO);
    for (int r = gw; r < ODD_IN; r += ngw) {
        float a0 = 0.f, a1 = 0.f, a2 = 0.f;
#pragma unroll
        for (int j = 0; j < 4; ++j) { const int k = 8 * lane + 512 * j; const u32x4 w = *(const u32x4*)(W + (size_t)r * DM + k);
            const float wf[8] = {bflo(w.x), bfhi(w.x), bflo(w.y), bfhi(w.y), bflo(w.z), bfhi(w.z), bflo(w.w), bfhi(w.w)};
#pragma unroll
            for (int e = 0; e < 8; ++e) { a0 += wf[e] * mod1[k + e]; a1 += wf[e] * mod1[6144 + k + e]; a2 += wf[e] * mod1[2 * 6144 + k + e]; } }
        a0 = wave_sum(a0); a1 = wave_sum(a1); a2 = wave_sum(a2);
        if (lane == 0) { b2p[r] = a0; b2p[ODD_IN + r] = a1; b2p[2 * ODD_IN + r] = a2; }
    }
}
namespace pg8 {
#define PG8_LAS __attribute__((address_space(3)))
typedef short bf16x8 __attribute__((ext_vector_type(8)));
constexpr int BM = 256, BK = 64, HALF = 128, HTB = HALF * BK * 2  , STAGE_BYTES = 8 * HTB, NXCD = 8, WGM = 8;
__host__ __device__ __forceinline__ int lds_byte(int r, int c) { const int st = (r >> 4) * 2 + (c >> 5), rr = r & 15, cc = c & 31, ob = rr * 64 + cc * 2; return st * 1024 + (ob ^ (((ob >> 9) & 1) << 5)); }
__host__ __device__ __forceinline__ void stage_rc(int b, int& R, int& C) { const int st = b / 1024, sb = b % 1024, swz = sb ^ (((sb >> 9) & 1) << 5); R = (st >> 1) * 16 + swz / 64; C = (st & 1) * 32 + (swz % 64) / 2; }
__host__ __device__ __forceinline__ int perm32(int rho) { const int n = rho >> 4, i = rho & 15; return 8 * (i >> 2) + 4 * n + (i & 3); }
struct Unit { int pm, pn, kt0, nkt, slab, half, hm, qn; };
struct Gemm { const bf16_t* A; const bf16_t* Bt; int M, N, K, lda, ldb, a_pn_off, b_pm_off, pad; };
struct StaticOrder {
    int nM, nN, nwg, G, c, KT, nfull, split;
    __host__ __device__ void init(int M, int N, int K, int G_, int c_, bool allow_split) { nM = M / BM; nN = N / BM; nwg = nM * nN; G = G_; c = c_; KT = K / BK;
        const int rem = nwg % G; split = (allow_split && rem && G % rem == 0 && (G % 8) == 0 && ((G / 8) % (G / rem)) == 0 && (KT % (2 * (G / rem))) == 0) ? G / rem : 1; nfull = split > 1 ? nwg - rem : nwg; }
    __host__ __device__ void tile(int wgid, Unit& u) const { const int nig = WGM * nN, gid = wgid / nig, fm = gid * WGM, gsz = (nM - fm) < WGM ? (nM - fm) : WGM; u.pm = fm + ((wgid % nig) % gsz); u.pn = (wgid % nig) / gsz; }
    __host__ __device__ bool next(int i, Unit& u) const {
        const long L = (long)i * G + c;
        if (L < nfull) { int wgid = (int)L; { const int q = nfull / NXCD, r = nfull % NXCD, xcd = wgid % NXCD, off = wgid / NXCD; wgid = (xcd < r ? xcd * (q + 1) : r * (q + 1) + (xcd - r) * q) + off; }
            tile(wgid, u); u.kt0 = 0; u.nkt = KT; u.slab = -1; u.half = 0; u.hm = 0; u.qn = -1; return true; }
        if (split > 1 && L < nfull + G) { const int xcd = c % 8, q = c / 8, ks = q % split, j = (q / split) * 8 + xcd;
            tile(nfull + j, u); u.nkt = KT / split; u.kt0 = ks * u.nkt; u.slab = j * split + ks; u.half = 0; u.hm = 0; u.qn = -1; return true; }
        return false;
    }
    __device__ __forceinline__ void a_ready(const Unit&) const {}
    __device__ __forceinline__ void done(const Unit&) const {}
};
struct OutOrder {
    int c, part;
    __device__ bool next(int i, Unit& u) const {
        if (i > 0) return false;
        u.kt0 = 0; u.nkt = DM / BK; u.slab = -1; u.half = 0; u.hm = 0; u.qn = -1;
        if (part == 0) { const int wgid = (c % 8) * 32 + c / 8, idx = wgid % 64; u.pm = (wgid / 64) * 8 + idx % 8; u.pn = idx / 8; return true; }
        if (c >= 64) return false;
        u.pm = 32 + c / 8; u.pn = c % 8; return true;
    }
    __device__ __forceinline__ void a_ready(const Unit&) const {}
    __device__ __forceinline__ void done(const Unit&) const {}
};
struct LastOrder {
    int c;
    __device__ bool next(int i, Unit& u) const {
        u.kt0 = 0; u.nkt = DM / BK; u.slab = -1; u.half = 0; u.hm = 0; u.qn = -1;
        if (i == 0) { const int wgid = (c % 8) * 32 + c / 8, idx = wgid % 64; u.pm = (wgid / 64) * 8 + idx % 8; u.pn = idx / 8; return true; }
        if (i > 1) return false;
        const int wgid = (c % 8) * 32 + c / 8, t = wgid >> 2; u.half = 1; u.hm = wgid & 1; u.qn = (wgid >> 1) & 1; u.pm = 32 + (t >> 3); u.pn = t & 7; return true;
    }
    __device__ __forceinline__ void a_ready(const Unit&) const {}
    __device__ __forceinline__ void done(const Unit&) const {}
};
struct StaggerOrder {
    int c; const unsigned* cnt; bool wait; int wid;
    __device__ bool next(int i, Unit& u) const {
        const int x = c % 8; u.kt0 = 0; u.nkt = DM / BK; u.slab = -1; u.half = 0; u.hm = 0; u.qn = -1;
        if (c < 64) { if (i >= 2) return false; u.pm = 32 + x; u.pn = 2 * (c / 8) + i; return true; }
        const int e = (c - 64) / 8; int uidx;
        if (i < 3) uidx = i * 24 + e;
        else { if (i > 3) return false; const int h4 = e >> 1; u.half = 1; u.hm = e & 1;
            if (h4 >= 8) { u.pm = 32 + x; u.pn = 16 + (h4 - 8); return true; } uidx = 72 + h4; }
        u.pm = 4 * x + (uidx % 4); u.pn = uidx / 4; return true;
    }
    __device__ __forceinline__ void a_ready(const Unit& u) const {
        if (u.pm < 32 || !wait) return;
        if (wid == 0) {
            const unsigned* w = cnt + 64 * (u.pm - 32); unsigned sp = 0;
            while ((unsigned)__builtin_amdgcn_readfirstlane(__hip_atomic_load(w, __ATOMIC_RELAXED, __HIP_MEMORY_SCOPE_AGENT)) < 8u) { __builtin_amdgcn_s_sleep(2); if (++sp > (1u << 22)) break; }
            __builtin_amdgcn_fence(__ATOMIC_ACQUIRE, "agent");
            asm volatile("s_waitcnt vmcnt(0)" ::: "memory");
        }
        asm volatile("" ::: "memory"); __builtin_amdgcn_s_barrier(); asm volatile("" ::: "memory");
    }
    __device__ __forceinline__ void done(const Unit&) const {}
};
__device__ __forceinline__ unsigned cvt_pk_bf16(float lo, float hi) { unsigned r; asm volatile("v_cvt_pk_bf16_f32 %0, %1, %2" : "=v"(r) : "v"(lo), "v"(hi)); return r; }
__device__ __forceinline__ void slab_store(const f32x4 (&acc)[2][2][4][2], float* slabs, const Unit& u, int wr, int wc, int fr, int fq) {
    float* sp = slabs + (size_t)u.slab * 65536 + (size_t)(wr * 64 + fr) * 256 + wc * 32 + 8 * fq;
#pragma unroll
    for (int ai = 0; ai < 2; ++ai)
#pragma unroll
        for (int m = 0; m < 4; ++m)
#pragma unroll
            for (int bj = 0; bj < 2; ++bj) { float* q = sp + (size_t)(ai * HALF + m * 16) * 256 + bj * HALF; *(f32x4*)q = acc[ai][bj][m][0]; *(f32x4*)(q + 4) = acc[ai][bj][m][1]; }
}
struct EpiBf16 {
    static constexpr bool PERM = true, AFTER_DRAIN = false;
    bf16_t* O; int ldc; int pad;
    __device__ __forceinline__ void operator()(const f32x4 (&acc)[2][2][4][2], const Unit& u, int wr, int wc, int fr, int fq) const {
        asm volatile("" : "+v"(fr), "+v"(fq));
        const int row0 = u.pm * BM + wr * 64 + fr, col0 = u.pn * BM + wc * 32 + 8 * fq;
#pragma unroll
        for (int ai = 0; ai < 2; ++ai)
#pragma unroll
            for (int m = 0; m < 4; ++m) { bf16_t* rowp = O + (size_t)(row0 + ai * HALF + m * 16) * ldc + col0;
#pragma unroll
                for (int bj = 0; bj < 2; ++bj) { const f32x4 v0 = acc[ai][bj][m][0], v1 = acc[ai][bj][m][1];
                    u32x4 w; w.x = cvt_pk_bf16(v0[0], v0[1]); w.y = cvt_pk_bf16(v0[2], v0[3]); w.z = cvt_pk_bf16(v1[0], v1[1]); w.w = cvt_pk_bf16(v1[2], v1[3]);
                    *(u32x4*)(rowp + bj * HALF) = w; } }
    }
};
struct EpiPoolF {
    static constexpr bool PERM = true, AFTER_DRAIN = false;
    bf16_t* Y; const bf16_t* SG; const float* pscale;
    __device__ __forceinline__ void operator()(const f32x4 (&acc)[2][2][4][2], const Unit& u, int wr, int wc, int fr, int fq) const {
        asm volatile("" : "+v"(fr), "+v"(fq));
        const int row0 = u.pm * BM + wr * 64 + fr, col0 = u.pn * BM + wc * 32 + 8 * fq;
        f32x4 ps[2][2];
#pragma unroll
        for (int bj = 0; bj < 2; ++bj) { ps[bj][0] = *(const f32x4*)(pscale + col0 + bj * HALF); ps[bj][1] = *(const f32x4*)(pscale + col0 + bj * HALF + 4); }
#pragma unroll
        for (int ai = 0; ai < 2; ++ai)
#pragma unroll
            for (int m = 0; m < 4; ++m) { const size_t r = (size_t)(row0 + ai * HALF + m * 16);
#pragma unroll
                for (int bj = 0; bj < 2; ++bj) { const int c = col0 + bj * HALF;
                    const u32x4 g = *(const u32x4*)(SG + r * DM + 1024 + c);
                    const f32x4 v0 = acc[ai][bj][m][0] * ps[bj][0], v1 = acc[ai][bj][m][1] * ps[bj][1];
                    u32x4 w; w.x = cvt_pk_bf16(v0[0] * bflo(g.x), v0[1] * bfhi(g.x)); w.y = cvt_pk_bf16(v0[2] * bflo(g.y), v0[3] * bfhi(g.y));
                    w.z = cvt_pk_bf16(v1[0] * bflo(g.z), v1[1] * bfhi(g.z)); w.w = cvt_pk_bf16(v1[2] * bflo(g.w), v1[3] * bfhi(g.w));
                    *(u32x4*)(Y + r * DM + 1024 + c) = w; } }
    }
};
struct EpiProj0 {
    static constexpr bool PERM = true, AFTER_DRAIN = false;
    unsigned char* ws; const float* qw; const float* kw; float* nak; float* nav;
    __device__ __forceinline__ void operator()(const f32x4 (&acc)[2][2][4][2], const Unit& u, int wr, int wc, int fr, int fq) const {
        asm volatile("" : "+v"(fr), "+v"(fq));
        const int pm = u.pm, pn = u.pn;
        const bool smp = pm >= 32; const int b = smp ? (pm - 32) >> 2 : pm, tb = (smp ? ((pm - 32) & 3) * 256 : 0) + wr * 64 + fr;
        const size_t rowb = (size_t)pm * 256 + wr * 64 + fr;
        if (pn < 8) {
            const bool isk = pn >= 4; const int hl = wc >> 1, j = wc & 1, h = (pn & 3) * 2 + hl, dim_a = 8 * fq + 16 * (fq >> 1);
            const float* w = isk ? kw : qw;
            f32x4 wv[2][2];
#pragma unroll
            for (int bj = 0; bj < 2; ++bj)
#pragma unroll
                for (int n = 0; n < 2; ++n) wv[bj][n] = *(const f32x4*)(w + dim_a + 16 * bj + 4 * n);
            const float* ropeA = (const float*)(ws + WS_ROPE);
#pragma unroll
            for (int ai = 0; ai < 2; ++ai)
#pragma unroll
                for (int m = 0; m < 4; ++m) { const int t = tb + ai * 128 + m * 16; const size_t row = rowb + ai * 128 + m * 16;
                    float ss = 0.f;
#pragma unroll
                    for (int bj = 0; bj < 2; ++bj)
#pragma unroll
                        for (int n = 0; n < 2; ++n) { const f32x4 x = acc[ai][bj][m][n]; ss += (x[0] * x[0] + x[1] * x[1]) + (x[2] * x[2] + x[3] * x[3]); }
                    ss += __shfl_xor(ss, 16); ss += __shfl_xor(ss, 32);
                    const float rinv = __builtin_amdgcn_rsqf(ss * (1.f / 64.f) + EPS);
                    f32x4 y[2][2];
#pragma unroll
                    for (int bj = 0; bj < 2; ++bj)
#pragma unroll
                        for (int n = 0; n < 2; ++n) y[bj][n] = acc[ai][bj][m][n] * rinv * wv[bj][n];
                    if (smp) {
#pragma unroll
                        for (int n = 0; n < 2; ++n) { const f32x4 cs = *(const f32x4*)(ropeA + (size_t)t * 64 + dim_a + 4 * n), sn = *(const f32x4*)(ropeA + 1024 * 64 + (size_t)t * 64 + dim_a + 4 * n);
                            const f32x4 a = y[0][n], bb = y[1][n]; y[0][n] = a * cs - bb * sn; y[1][n] = bb * cs + a * sn; } }
                    if (!isk) { bf16_t* qp = (bf16_t*)(ws + WS_Q) + row * 1024 + pn * 256 + wc * 64 + dim_a;
#pragma unroll
                        for (int bj = 0; bj < 2; ++bj) { const f32x4 v0 = y[bj][0] * C2A, v1 = y[bj][1] * C2A;
                            u32x4 o; o.x = cvt_pk_bf16(v0[0], v0[1]); o.y = cvt_pk_bf16(v0[2], v0[3]); o.z = cvt_pk_bf16(v1[0], v1[1]); o.w = cvt_pk_bf16(v1[2], v1[3]);
                            *(u32x4*)(qp + 16 * bj) = o; } }
                    else { const int hh = (pn - 4) * 2 + hl;
                        const size_t koff = (smp ? ((size_t)(b * HA + hh) * LKS + PAST + t) * 128 : ((size_t)(b * HA + hh) * SEQP + t) * 128) + j * 64 + dim_a;
                        bf16_t* kp = (bf16_t*)(ws + (smp ? WS_KSA : WS_KP)) + koff;
#pragma unroll
                        for (int bj = 0; bj < 2; ++bj) { const f32x4 v0 = y[bj][0], v1 = y[bj][1];
                            u32x4 o; o.x = cvt_pk_bf16(v0[0], v0[1]); o.y = cvt_pk_bf16(v0[2], v0[3]); o.z = cvt_pk_bf16(v1[0], v1[1]); o.w = cvt_pk_bf16(v1[2], v1[3]);
                            *(u32x4*)(kp + 16 * bj) = o;
                            if (!smp) { float* fp = nak + koff + 16 * bj; __builtin_nontemporal_store(v0, (f32x4*)fp); __builtin_nontemporal_store(v1, (f32x4*)(fp + 4)); } } }
                }
        } else if (pn < 12) {
#pragma unroll
            for (int ai = 0; ai < 2; ++ai)
#pragma unroll
                for (int m = 0; m < 4; ++m) { const int t = tb + ai * 128 + m * 16;
#pragma unroll
                    for (int bj = 0; bj < 2; ++bj) { const int hh = (pn - 8) * 2 + bj, d = 32 * wc + 8 * fq;
                        const size_t voff = (smp ? ((size_t)(b * HA + hh) * LKS + PAST + t) * 128 : ((size_t)(b * HA + hh) * SEQP + t) * 128) + d;
                        const f32x4 v0 = acc[ai][bj][m][0], v1 = acc[ai][bj][m][1];
                        u32x4 o; o.x = cvt_pk_bf16(v0[0], v0[1]); o.y = cvt_pk_bf16(v0[2], v0[3]); o.z = cvt_pk_bf16(v1[0], v1[1]); o.w = cvt_pk_bf16(v1[2], v1[3]);
                        *(u32x4*)((bf16_t*)(ws + (smp ? WS_VSA : WS_VP)) + voff) = o;
                        if (!smp) { __builtin_nontemporal_store(v0, (f32x4*)(nav + voff)); __builtin_nontemporal_store(v1, (f32x4*)(nav + voff + 4)); } } }
        } else if (pn < 16) {
            bf16_t* up = (bf16_t*)(ws + WS_U) + (pn - 12) * 256 + 32 * wc + 8 * fq;
#pragma unroll
            for (int ai = 0; ai < 2; ++ai)
#pragma unroll
                for (int m = 0; m < 4; ++m) { const size_t row = rowb + ai * 128 + m * 16;
#pragma unroll
                    for (int bj = 0; bj < 2; ++bj) { const f32x4 v0 = acc[ai][bj][m][0], v1 = acc[ai][bj][m][1];
                        u32x4 o; o.x = cvt_pk_bf16(v0[0], v0[1]); o.y = cvt_pk_bf16(v0[2], v0[3]); o.z = cvt_pk_bf16(v1[0], v1[1]); o.w = cvt_pk_bf16(v1[2], v1[3]);
                        *(u32x4*)(up + row * 1024 + bj * HALF) = o; } }
        } else {
            bf16_t* sg = (bf16_t*)(ws + WS_SG) + (pn - 16) * 256 + 32 * wc + 8 * fq;
#pragma unroll
            for (int ai = 0; ai < 2; ++ai)
#pragma unroll
                for (int m = 0; m < 4; ++m) { const size_t row = rowb + ai * 128 + m * 16;
#pragma unroll
                    for (int bj = 0; bj < 2; ++bj) { const f32x4 v0 = acc[ai][bj][m][0], v1 = acc[ai][bj][m][1];
                        u32x4 o; o.x = cvt_pk_bf16(silu_fast(v0[0]), silu_fast(v0[1])); o.y = cvt_pk_bf16(silu_fast(v0[2]), silu_fast(v0[3])); o.z = cvt_pk_bf16(silu_fast(v1[0]), silu_fast(v1[1])); o.w = cvt_pk_bf16(silu_fast(v1[2]), silu_fast(v1[3]));
                        *(u32x4*)(sg + row * DM + bj * HALF) = o; } }
        }
    }
};
struct EpiProj1 {
    static constexpr bool PERM = true, AFTER_DRAIN = false;
    unsigned char* ws; const float* qw; const float* kw; float* nck; float* ncv; PG8_LAS float* xs; float* slabs;
    __device__ __forceinline__ void operator()(const f32x4 (&acc0)[2][2][4][2], const Unit& u, int wr, int wc, int fr, int fq) const {
        asm volatile("" : "+v"(fr), "+v"(fq));
        if (u.slab >= 0) { slab_store(acc0, slabs, u, wr, wc, fr, fq); return; }
        const int pm = u.pm, pn = u.pn;
        float rstd[2][4]; f32x4 bv[2][2];
        { const int cr = pm < 32 ? 0 : 1 + ((pm - 32) >> 2);
          const float* b2 = (const float*)(ws + WS_B2P) + (size_t)cr * ODD_IN + pn * 256 + 32 * wc + 8 * fq; const float* rss = (const float*)(ws + WS_RSS) + (size_t)pm * 256 + (u.half ? u.hm * 128 : 0) + wr * 64 + fr;
#pragma unroll
          for (int bj = 0; bj < 2; ++bj)
#pragma unroll
              for (int n = 0; n < 2; ++n) bv[bj][n] = *(const f32x4*)(b2 + bj * HALF + n * 4);
#pragma unroll
          for (int ai = 0; ai < 2; ++ai)
#pragma unroll
              for (int m = 0; m < 4; ++m) rstd[ai][m] = __builtin_amdgcn_rsqf(rss[ai * 128 + m * 16] * (1.f / DM) + EPS); }
#define VV(ai, bj, m, n) (acc0[ai][bj][m][n] * rstd[ai][m] + bv[bj][n])
        const int hoff = u.half ? u.hm * 128 : 0, nai = u.half ? 1 : 2;
        const bool smp = pm >= 32; const int b = smp ? (pm - 32) >> 2 : pm, tb = (smp ? ((pm - 32) & 3) * 256 : 0) + hoff + wr * 64 + fr;
        const size_t rowb = (size_t)pm * 256 + hoff + wr * 64 + fr;
        if (pn < 10) {
            const bool isk = pn >= 8; const int hl = wc >> 1, w1 = wc & 1, head = (isk ? (pn - 8) : pn) * 2 + hl;
            const float* w = isk ? kw : qw;
            f32x4 wv[2][2];
#pragma unroll
            for (int bj = 0; bj < 2; ++bj)
#pragma unroll
                for (int n = 0; n < 2; ++n) wv[bj][n] = *(const f32x4*)(w + (2 * w1 + bj) * 32 + 8 * fq + 4 * n);
            PG8_LAS float* xo = xs + (wr * 4 + wc) * 128; PG8_LAS float* xp = xs + (wr * 4 + (wc ^ 1)) * 128;
#pragma unroll
            for (int ai = 0; ai < 2; ++ai)
#pragma unroll
                for (int m = 0; m < 4; ++m) { if (ai >= nai) continue; float ss = 0.f;
#pragma unroll
                    for (int bj = 0; bj < 2; ++bj)
#pragma unroll
                        for (int n = 0; n < 2; ++n) { const f32x4 x = VV(ai, bj, m, n); ss += (x[0] * x[0] + x[1] * x[1]) + (x[2] * x[2] + x[3] * x[3]); }
                    ss += __shfl_xor(ss, 16); ss += __shfl_xor(ss, 32);
                    if (fq == 0) xo[ai * 64 + m * 16 + fr] = ss; }
            asm volatile("s_waitcnt lgkmcnt(0)" ::: "memory"); __builtin_amdgcn_s_barrier(); asm volatile("" ::: "memory");
            const float* ropeC = (const float*)(ws + WS_ROPE) + 2 * 1024 * 64;
#pragma unroll
            for (int ai = 0; ai < 2; ++ai)
#pragma unroll
                for (int m = 0; m < 4; ++m) { if (ai >= nai) continue; const int idx = ai * 64 + m * 16 + fr, t = tb + ai * 128 + m * 16; const size_t row = rowb + ai * 128 + m * 16;
                    const float rinv = __builtin_amdgcn_rsqf((xo[idx] + xp[idx]) * (1.f / 128.f) + EPS);
                    float r2 = rstd[ai][m]; asm volatile("" : "+v"(r2));
                    f32x4 y[2][2];
#pragma unroll
                    for (int bj = 0; bj < 2; ++bj)
#pragma unroll
                        for (int n = 0; n < 2; ++n) y[bj][n] = (acc0[ai][bj][m][n] * r2 + bv[bj][n]) * rinv * wv[bj][n];
                    if (smp) {
#pragma unroll
                        for (int n = 0; n < 2; ++n) { const f32x4 cs = *(const f32x4*)(ropeC + (size_t)t * 128 + 64 * w1 + 8 * fq + 4 * n), sn = *(const f32x4*)(ropeC + 1024 * 128 + (size_t)t * 128 + 64 * w1 + 8 * fq + 4 * n);
                            const f32x4 a = y[0][n], bb = y[1][n]; y[0][n] = a * cs - bb * sn; y[1][n] = bb * cs + a * sn; } }
                    if (!isk) { bf16_t* qp = (bf16_t*)(ws + WS_Q) + row * DM + head * 128 + 8 * fq;
#pragma unroll
                        for (int bj = 0; bj < 2; ++bj) { const f32x4 v0 = y[bj][0] * C2C, v1 = y[bj][1] * C2C;
                            u32x4 o; o.x = cvt_pk_bf16(v0[0], v0[1]); o.y = cvt_pk_bf16(v0[2], v0[3]); o.z = cvt_pk_bf16(v1[0], v1[1]); o.w = cvt_pk_bf16(v1[2], v1[3]);
                            *(u32x4*)(qp + (2 * w1 + bj) * 32) = o; } }
                    else { const size_t koff = smp ? ((size_t)(b * KVH + head) * LKS + PAST + t) * 128 : ((size_t)(b * KVH + head) * SEQP + t) * 128;
                        bf16_t* kp = (bf16_t*)(ws + (smp ? WS_KSC : WS_KP)) + koff + 8 * fq;
#pragma unroll
                        for (int bj = 0; bj < 2; ++bj) { const f32x4 v0 = y[bj][0], v1 = y[bj][1];
                            u32x4 o; o.x = cvt_pk_bf16(v0[0], v0[1]); o.y = cvt_pk_bf16(v0[2], v0[3]); o.z = cvt_pk_bf16(v1[0], v1[1]); o.w = cvt_pk_bf16(v1[2], v1[3]);
                            *(u32x4*)(kp + (2 * w1 + bj) * 32) = o;
                            if (!smp) { float* fp = nck + koff + 8 * fq + (2 * w1 + bj) * 32; __builtin_nontemporal_store(v0, (f32x4*)fp); __builtin_nontemporal_store(v1, (f32x4*)(fp + 4)); } } }
                }
        } else if (pn < 12) {
#pragma unroll
            for (int ai = 0; ai < 2; ++ai)
#pragma unroll
                for (int m = 0; m < 4; ++m) { if (ai >= nai) continue; const int t = tb + ai * 128 + m * 16;
#pragma unroll
                    for (int bj = 0; bj < 2; ++bj) { const int kvh = (pn - 10) * 2 + bj, d = 32 * wc + 8 * fq;
                        const size_t voff = (smp ? ((size_t)(b * KVH + kvh) * LKS + PAST + t) * 128 : ((size_t)(b * KVH + kvh) * SEQP + t) * 128) + d;
                        const f32x4 v0 = VV(ai, bj, m, 0), v1 = VV(ai, bj, m, 1);
                        u32x4 o; o.x = cvt_pk_bf16(v0[0], v0[1]); o.y = cvt_pk_bf16(v0[2], v0[3]); o.z = cvt_pk_bf16(v1[0], v1[1]); o.w = cvt_pk_bf16(v1[2], v1[3]);
                        *(u32x4*)((bf16_t*)(ws + (smp ? WS_VSC : WS_VP)) + voff) = o;
                        if (!smp) { __builtin_nontemporal_store(v0, (f32x4*)(ncv + voff)); __builtin_nontemporal_store(v1, (f32x4*)(ncv + voff + 4)); } } }
        } else {
            bf16_t* sg = (bf16_t*)(ws + WS_SG) + (pn - 12) * 256 + 32 * wc + 8 * fq;
#pragma unroll
            for (int ai = 0; ai < 2; ++ai)
#pragma unroll
                for (int m = 0; m < 4; ++m) { if (ai >= nai) continue; const size_t row = rowb + ai * 128 + m * 16;
#pragma unroll
                    for (int bj = 0; bj < 2; ++bj) { const f32x4 v0 = VV(ai, bj, m, 0), v1 = VV(ai, bj, m, 1);
                        u32x4 o; o.x = cvt_pk_bf16(silu_fast(v0[0]), silu_fast(v0[1])); o.y = cvt_pk_bf16(silu_fast(v0[2]), silu_fast(v0[3])); o.z = cvt_pk_bf16(silu_fast(v1[0]), silu_fast(v1[1])); o.w = cvt_pk_bf16(silu_fast(v1[2]), silu_fast(v1[3]));
                        *(u32x4*)(sg + row * DM + bj * HALF) = o; } }
        }
    }
};
#undef VV
struct EpiResid0 {
    static constexpr bool PERM = true, AFTER_DRAIN = false;
    const float* xp; const float* xs; const float* gate; const float* cw1; bf16_t* Y1; bf16_t* H1; float* rowss; float* slabs;
    __device__ __forceinline__ void operator()(const f32x4 (&acc)[2][2][4][2], const Unit& u, int wr, int wc, int fr, int fq) const {
        asm volatile("" : "+v"(fr), "+v"(fq));
        if (u.slab >= 0) { slab_store(acc, slabs, u, wr, wc, fr, fq); return; }
        const int row0 = u.pm * BM + wr * 64 + fr, col0 = u.pn * BM + wc * 32 + 8 * fq;
        const int cr = u.pm < 32 ? 0 : 1 + ((u.pm - 32) >> 2);
        const float* xb = u.pm < 32 ? xp : xs - (size_t)MP * DM;
        f32x4 gv[2][2], cv[2][2];
#pragma unroll
        for (int bj = 0; bj < 2; ++bj)
#pragma unroll
            for (int n = 0; n < 2; ++n) { gv[bj][n] = *(const f32x4*)(gate + (size_t)cr * 6144 + col0 + bj * HALF + n * 4); cv[bj][n] = *(const f32x4*)(cw1 + (size_t)cr * DM + col0 + bj * HALF + n * 4); }
        f32x4 cb[2][2], nb[2][2];
#define LDG(dst, g) do { const float* bp_ = xb + (size_t)(row0 + ((g) >> 2) * HALF + ((g) & 3) * 16) * DM + col0; \
        _Pragma("unroll") for (int bj = 0; bj < 2; ++bj) _Pragma("unroll") for (int n = 0; n < 2; ++n) dst[bj][n] = __builtin_nontemporal_load((const f32x4*)(bp_ + bj * HALF + n * 4)); } while (0)
        LDG(cb, 0);
#pragma unroll
        for (int g = 0; g < 8; ++g) {
            if (g + 1 < 8) LDG(nb, g + 1);
            const int ai = g >> 2, m = g & 3, r = row0 + ai * HALF + m * 16;
            bf16_t* op = Y1 + (size_t)r * DM + col0; bf16_t* hp = H1 + (size_t)r * DM + col0;
            float ss = 0.f;
#pragma unroll
            for (int bj = 0; bj < 2; ++bj) { const f32x4 y0 = cb[bj][0] + gv[bj][0] * acc[ai][bj][m][0], y1 = cb[bj][1] + gv[bj][1] * acc[ai][bj][m][1];
                { u32x4 yo; yo.x = cvt_pk_bf16(y0[0], y0[1]); yo.y = cvt_pk_bf16(y0[2], y0[3]); yo.z = cvt_pk_bf16(y1[0], y1[1]); yo.w = cvt_pk_bf16(y1[2], y1[3]); *(u32x4*)(op + bj * HALF) = yo; }
                ss += (y0[0] * y0[0] + y0[1] * y0[1]) + (y0[2] * y0[2] + y0[3] * y0[3]) + (y1[0] * y1[0] + y1[1] * y1[1]) + (y1[2] * y1[2] + y1[3] * y1[3]);
                const f32x4 h0 = y0 * cv[bj][0], h1 = y1 * cv[bj][1];
                u32x4 o; o.x = cvt_pk_bf16(h0[0], h0[1]); o.y = cvt_pk_bf16(h0[2], h0[3]); o.z = cvt_pk_bf16(h1[0], h1[1]); o.w = cvt_pk_bf16(h1[2], h1[3]);
                *(u32x4*)(hp + bj * HALF) = o; }
            ss += __shfl_xor(ss, 16); ss += __shfl_xor(ss, 32);
            if (fq == 0) atomicAdd(rowss + r, ss);
#pragma unroll
            for (int bj = 0; bj < 2; ++bj)
#pragma unroll
                for (int n = 0; n < 2; ++n) cb[bj][n] = nb[bj][n];
            asm volatile("" ::: "memory"); }
#undef LDG
    }
};
struct EpiResidF {
    static constexpr bool PERM = true, AFTER_DRAIN = false;
    const bf16_t* yb; const float* gate; float* out; float* slabs;
    __device__ __forceinline__ void operator()(const f32x4 (&acc)[2][2][4][2], const Unit& u, int wr, int wc, int fr, int fq) const {
        asm volatile("" : "+v"(fr), "+v"(fq));
        if (u.slab >= 0) { slab_store(acc, slabs, u, wr, wc, fr, fq); return; }
        const int row0 = u.pm * BM + (u.half ? u.hm * HALF : 0) + wr * 64 + fr, col0 = u.pn * BM + (u.qn > 0 ? HALF : 0) + wc * 32 + 8 * fq;
        const int cr = u.pm < 32 ? 0 : 1 + ((u.pm - 32) >> 2); const int nbj = u.qn >= 0 ? 1 : 2;
        f32x4 gv[2][2];
#pragma unroll
        for (int bj = 0; bj < 2; ++bj)
#pragma unroll
            for (int n = 0; n < 2; ++n) gv[bj][n] = (bj < nbj) ? *(const f32x4*)(gate + (size_t)cr * 6144 + col0 + bj * HALF + n * 4) : (f32x4){0.f, 0.f, 0.f, 0.f};
        const int ng = u.half ? 4 : 8;
        u32x4 cb[2], nb[2];
#define LDG(dst, g) do { const bf16_t* bp_ = yb + (size_t)(row0 + ((g) >> 2) * HALF + ((g) & 3) * 16) * DM + col0; \
        _Pragma("unroll") for (int bj = 0; bj < 2; ++bj) if (bj < nbj) dst[bj] = __builtin_nontemporal_load((const u32x4*)(bp_ + bj * HALF)); } while (0)
        LDG(cb, 0);
#pragma unroll
        for (int g = 0; g < 8; ++g) { if (g >= ng) continue;
            if (g + 1 < ng) LDG(nb, g + 1);
            float* op = out + (size_t)(row0 + (g >> 2) * HALF + (g & 3) * 16) * DM + col0;
#pragma unroll
            for (int bj = 0; bj < 2; ++bj) { if (bj >= nbj) continue; const u32x4 c = cb[bj];
                const f32x4 b0 = (f32x4){bflo(c.x), bfhi(c.x), bflo(c.y), bfhi(c.y)}, b1 = (f32x4){bflo(c.z), bfhi(c.z), bflo(c.w), bfhi(c.w)};
                __builtin_nontemporal_store(b0 + gv[bj][0] * acc[g >> 2][bj][g & 3][0], (f32x4*)(op + bj * HALF));
                __builtin_nontemporal_store(b1 + gv[bj][1] * acc[g >> 2][bj][g & 3][1], (f32x4*)(op + bj * HALF + 4)); }
#pragma unroll
            for (int bj = 0; bj < 2; ++bj) cb[bj] = nb[bj];
            asm volatile("" ::: "memory"); }
#undef LDG
    }
};

template <class Epi, class Sched, bool ALIGN_EPI = false, bool SP2 = false>
__device__ __forceinline__ void gemm_phase(PG8_LAS unsigned char* lds, const Gemm g, const Sched& S, const Epi& E, const int tid) {
    const int wid = __builtin_amdgcn_readfirstlane(tid >> 6), lane = tid & 63, wr = wid >> 2, wc = wid & 3, fr = lane & 15, fq = lane >> 4;
    unsigned voffA[2], voffB[2];
#pragma unroll
    for (int i = 0; i < 2; ++i) { int R, C; stage_rc(tid * 16 + i * 8192, R, C); const int Rb = Epi::PERM ? ((R & ~31) + perm32(R & 31)) : R;
        voffA[i] = (unsigned)(R * g.lda + C) * 2u; voffB[i] = (unsigned)(Rb * g.ldb + C) * 2u; }
    const size_t kstep = (size_t)(BK * 2);
    const size_t hstepA = (size_t)HALF * g.lda * 2, hstepB = (size_t)HALF * g.ldb * 2;
    const size_t tstepA = 2 * hstepA, tstepB = 2 * hstepB;
    const unsigned ldsw = (unsigned)wid * 1024u;
    const int aoff = lds_byte(wr * 64 + fr, fq * 8), boff = lds_byte(wc * 32 + fr, fq * 8);
#define PG8_SA(b, h) (((b) * 2 + (h)) * HTB)
#define PG8_SB(b, h) ((4 + (b) * 2 + (h)) * HTB)
#define PG8_STAGE(bufoff, gbase, voff) do { _Pragma("unroll") for (int _i = 0; _i < 2; ++_i) \
        __builtin_amdgcn_global_load_lds((const unsigned*)((const char*)(gbase) + (voff)[_i]), (PG8_LAS unsigned*)(lds + (bufoff) + ldsw + _i * 8192), 16, 0, 0); } while (0)
#define PG8_LDA(dst, b, h) do { _Pragma("unroll") for (int m = 0; m < 4; ++m) _Pragma("unroll") for (int k = 0; k < 2; ++k) dst[m][k] = *(const PG8_LAS bf16x8*)(lds + PG8_SA(b, h) + aoff + m * 2048 + k * 1024); } while (0)
#define PG8_LDB(dst, b, h) do { _Pragma("unroll") for (int n = 0; n < 2; ++n) _Pragma("unroll") for (int k = 0; k < 2; ++k) dst[n][k] = *(const PG8_LAS bf16x8*)(lds + PG8_SB(b, h) + boff + n * 2048 + k * 1024); } while (0)
#define PG8_MMA(ai, bj, At, Bt) do { __builtin_amdgcn_s_setprio(1); _Pragma("unroll") for (int m = 0; m < 4; ++m) _Pragma("unroll") for (int n = 0; n < 2; ++n) _Pragma("unroll") for (int k = 0; k < 2; ++k) \
        acc[ai][bj][m][n] = __builtin_amdgcn_mfma_f32_16x16x32_bf16(Bt[n][k], At[m][k], acc[ai][bj][m][n], 0, 0, 0); __builtin_amdgcn_s_setprio(0); } while (0)
#define PG8_WAIT_V(n) asm volatile("s_waitcnt vmcnt(" #n ")" ::: "memory")
#define PG8_WAIT_L(n) asm volatile("s_waitcnt lgkmcnt(" #n ")" ::: "memory")
#define PG8_BAR __builtin_amdgcn_s_barrier()
#define PG8_SCHED __builtin_amdgcn_sched_barrier(0)
    Unit cur, nxt; int ui = 0;
    if (!S.next(0, cur)) return;
    f32x4 acc[2][2][4][2];
#pragma unroll
    for (int a = 0; a < 2; ++a)
#pragma unroll
        for (int b = 0; b < 2; ++b)
#pragma unroll
            for (int m = 0; m < 4; ++m)
#pragma unroll
                for (int n = 0; n < 2; ++n) acc[a][b][m][n] = (f32x4){0.f, 0.f, 0.f, 0.f};
    bf16x8 At[4][2], B0[2][2], B1[2][2];
    const char* cA = (const char*)g.A + (size_t)cur.pm * tstepA + (size_t)cur.pn * g.a_pn_off * 2 + (size_t)cur.kt0 * kstep + (cur.half ? (size_t)cur.hm * hstepA : 0); const char* cB = (const char*)g.Bt + (size_t)cur.pn * tstepB + (size_t)cur.pm * g.b_pm_off * 2 + (size_t)cur.kt0 * kstep + (cur.qn > 0 ? hstepB : 0);
    S.a_ready(cur);
    if constexpr (SP2) {
        const size_t pHB = cur.qn >= 0 ? 0 : hstepB;
        PG8_STAGE(PG8_SB(0, 0), cB, voffB); PG8_STAGE(PG8_SB(0, 1), cB + pHB, voffB); PG8_STAGE(PG8_SA(0, 0), cA, voffA); PG8_STAGE(PG8_SA(0, 1), cA + (cur.half ? 0 : hstepA), voffA);
        if (wr == 1) PG8_BAR;
        PG8_WAIT_V(2); PG8_BAR;
        PG8_STAGE(PG8_SB(1, 0), cB + kstep, voffB); PG8_STAGE(PG8_SA(1, 0), cA + kstep, voffA); PG8_STAGE(PG8_SB(1, 1), cB + pHB + kstep, voffB);
        PG8_WAIT_V(6); PG8_BAR;
    } else {
        PG8_STAGE(PG8_SB(0, 0), cB, voffB); PG8_STAGE(PG8_SA(0, 0), cA, voffA); PG8_STAGE(PG8_SB(0, 1), cB + hstepB, voffB); PG8_STAGE(PG8_SA(0, 1), cA + hstepA, voffA);
        if (wr == 1) PG8_BAR;
        PG8_WAIT_V(4); PG8_BAR;
        PG8_STAGE(PG8_SB(1, 0), cB + kstep, voffB); PG8_STAGE(PG8_SA(1, 0), cA + kstep, voffA); PG8_STAGE(PG8_SB(1, 1), cB + hstepB + kstep, voffB);
        PG8_WAIT_V(6); PG8_BAR;
    }
    for (;;) {
        const bool has_next = S.next(ui + 1, nxt);
        const char* nA = has_next ? (const char*)g.A + (size_t)nxt.pm * tstepA + (size_t)nxt.pn * g.a_pn_off * 2 + (size_t)nxt.kt0 * kstep + (nxt.half ? (size_t)nxt.hm * hstepA : 0) : cA; const char* nB = has_next ? (const char*)g.Bt + (size_t)nxt.pn * tstepB + (size_t)nxt.pm * g.b_pm_off * 2 + (size_t)nxt.kt0 * kstep + (nxt.qn > 0 ? hstepB : 0) : cB;
        const size_t curH = cur.half ? 0 : hstepA, nxtH = has_next ? (nxt.half ? 0 : hstepA) : curH;
        const size_t curHB = cur.qn >= 0 ? 0 : hstepB, nxtHB = has_next ? (nxt.qn >= 0 ? 0 : hstepB) : curHB;
        const int nt = cur.nkt;
        for (int t = 0; t < nt; t += 2) {
            const bool last = (t == nt - 2);
            const char* a1 = cA + (size_t)(t + 1) * kstep;
            const char* a2 = last ? nA : cA + (size_t)(t + 2) * kstep; const char* b2 = last ? nB : cB + (size_t)(t + 2) * kstep;
            const char* a3 = a2 + kstep; const char* b3 = b2 + kstep;
            if (last && has_next) S.a_ready(nxt);
            if constexpr (SP2) {
            PG8_LDB(B0, 0, 0); PG8_LDB(B1, 0, 1); PG8_SCHED; PG8_LDA(At, 0, 0); PG8_STAGE(PG8_SA(1, 1), a1 + curH, voffA);
            PG8_WAIT_V(8); PG8_WAIT_L(0); PG8_BAR; PG8_MMA(0, 0, At, B0); if (cur.qn < 0) PG8_MMA(0, 1, At, B1); PG8_BAR; PG8_SCHED;
            PG8_LDA(At, 0, 1); PG8_STAGE(PG8_SB(0, 0), b2, voffB); PG8_STAGE(PG8_SB(0, 1), b2 + (last ? nxtHB : curHB), voffB); PG8_STAGE(PG8_SA(0, 0), a2, voffA);
            PG8_WAIT_V(8); PG8_WAIT_L(0); PG8_BAR; if (!cur.half) { PG8_MMA(1, 0, At, B0); PG8_MMA(1, 1, At, B1); } PG8_BAR; PG8_SCHED;
            PG8_LDB(B0, 1, 0); PG8_LDB(B1, 1, 1); PG8_SCHED; PG8_LDA(At, 1, 0); PG8_STAGE(PG8_SA(0, 1), a2 + (last ? nxtH : curH), voffA);
            PG8_WAIT_V(8); PG8_WAIT_L(0); PG8_BAR; PG8_MMA(0, 0, At, B0); if (cur.qn < 0) PG8_MMA(0, 1, At, B1); PG8_BAR; PG8_SCHED;
            PG8_LDA(At, 1, 1); PG8_STAGE(PG8_SB(1, 0), b3, voffB); PG8_STAGE(PG8_SB(1, 1), b3 + (last ? nxtHB : curHB), voffB); PG8_STAGE(PG8_SA(1, 0), a3, voffA);
            PG8_WAIT_V(8); PG8_WAIT_L(0); PG8_BAR; if (!cur.half) { PG8_MMA(1, 0, At, B0); PG8_MMA(1, 1, At, B1); } PG8_BAR; PG8_SCHED;
            } else {
            PG8_LDB(B0, 0, 0); PG8_SCHED; PG8_LDA(At, 0, 0); PG8_STAGE(PG8_SA(1, 1), a1 + hstepA, voffA);
            PG8_WAIT_L(8); PG8_BAR; PG8_WAIT_L(0); PG8_MMA(0, 0, At, B0); PG8_BAR; PG8_SCHED;
            PG8_LDB(B1, 0, 1); PG8_STAGE(PG8_SB(0, 0), b2, voffB);
            PG8_BAR; PG8_WAIT_L(0); PG8_MMA(0, 1, At, B1); PG8_BAR;
            PG8_LDA(At, 0, 1); PG8_STAGE(PG8_SA(0, 0), a2, voffA);
            PG8_BAR; PG8_WAIT_L(0); PG8_MMA(1, 0, At, B0); PG8_BAR; PG8_SCHED;
            PG8_STAGE(PG8_SB(0, 1), b2 + hstepB, voffB);
            PG8_WAIT_V(6); PG8_BAR; PG8_MMA(1, 1, At, B1); PG8_BAR;
            PG8_LDB(B0, 1, 0); PG8_SCHED; PG8_LDA(At, 1, 0); PG8_STAGE(PG8_SA(0, 1), a2 + hstepA, voffA);
            PG8_WAIT_L(8); PG8_BAR; PG8_WAIT_L(0); PG8_MMA(0, 0, At, B0); PG8_BAR; PG8_SCHED;
            PG8_LDB(B1, 1, 1); PG8_STAGE(PG8_SB(1, 0), b3, voffB);
            PG8_BAR; PG8_WAIT_L(0); PG8_MMA(0, 1, At, B1); PG8_BAR;
            PG8_LDA(At, 1, 1); PG8_STAGE(PG8_SA(1, 0), a3, voffA);
            PG8_BAR; PG8_WAIT_L(0); PG8_MMA(1, 0, At, B0); PG8_BAR; PG8_SCHED;
            PG8_STAGE(PG8_SB(1, 1), b3 + hstepB, voffB);
            PG8_WAIT_V(6); PG8_BAR; PG8_MMA(1, 1, At, B1); PG8_BAR;
            }
        }
        if constexpr (ALIGN_EPI) { if (wr == 0) PG8_BAR; }
        if constexpr (!Epi::AFTER_DRAIN) { E(acc, cur, wr, wc, fr, fq); S.done(cur); }
        if (!has_next) break;
#pragma unroll
        for (int a = 0; a < 2; ++a)
#pragma unroll
            for (int b = 0; b < 2; ++b)
#pragma unroll
                for (int m = 0; m < 4; ++m)
#pragma unroll
                    for (int n = 0; n < 2; ++n) acc[a][b][m][n] = (f32x4){0.f, 0.f, 0.f, 0.f};
        cur = nxt; cA = nA; cB = nB; ++ui;
        if constexpr (ALIGN_EPI) { if (wr == 1) PG8_BAR; }
    }
    PG8_WAIT_V(0);
    if constexpr (!ALIGN_EPI) { if (wr == 0) PG8_BAR; }
    PG8_BAR;
#undef PG8_SA
#undef PG8_SB
#undef PG8_STAGE
#undef PG8_LDA
#undef PG8_LDB
#undef PG8_MMA
#undef PG8_WAIT_V
#undef PG8_WAIT_L
#undef PG8_BAR
#undef PG8_SCHED
}
}

__device__ __forceinline__ void ld8(const bf16_t* p, float (&v)[8]) { const u32x4 r = *(const u32x4*)p; v[0] = bflo(r.x); v[1] = bfhi(r.x); v[2] = bflo(r.y); v[3] = bfhi(r.y); v[4] = bflo(r.z); v[5] = bfhi(r.z); v[6] = bflo(r.w); v[7] = bfhi(r.w); }
__device__ __forceinline__ void pool_apply_slot(const Params& p, int row_base, int run_len  , int tid) {
    const bf16_t* __restrict__ Z = (const bf16_t*)(p.ws + WS_U); const bf16_t* __restrict__ SG = (const bf16_t*)(p.ws + WS_SG); bf16_t* __restrict__ Y = (bf16_t*)(p.ws + WS_HY);
    const int chunk = tid & 127, rb = tid >> 7, c = chunk * 8, g = chunk >> 5, h = 1 << g;
    float ps[8];
#pragma unroll
    for (int e = 0; e < 8; ++e) ps[e] = p.pool_scale[c + e];
    float S[8]; bool first = true;
    int m = row_base + rb * run_len;
#pragma unroll 1
    for (int i4 = 0; i4 < run_len / 4; ++i4) {
        float za[4][8], zr[4][8], own[4][8], gt[4][8]; int cnt[4]; bool init[4];
#pragma unroll
        for (int j = 0; j < 4; ++j) { const int mm = m + j; const bool smp = mm >= MP; const int t = smp ? (mm - MP) & 1023 : mm & 255, L = smp ? SEQS : SEQP;
            const bf16_t* zp = Z + (size_t)mm * 1024 + c;
            const bool add_ok = (t + h <= L), rem_ok = (t - h >= 1);
            ld8(zp + (ptrdiff_t)(add_ok ? (h - 1) : 0) * 1024, za[j]); ld8(zp + (ptrdiff_t)(rem_ok ? (-1 - h) : 0) * 1024, zr[j]); ld8(zp, own[j]); ld8(SG + (size_t)mm * DM + 1024 + c, gt[j]);
            const float fa = add_ok ? 1.f : 0.f, fr = rem_ok ? 1.f : 0.f;
#pragma unroll
            for (int e = 0; e < 8; ++e) { za[j][e] *= fa; zr[j][e] *= fr; }
            cnt[j] = min(t + h, L) - max(t - h, 0); init[j] = (t == 0) || (first && j == 0 && i4 == 0); }
#pragma unroll
        for (int j = 0; j < 4; ++j) { const int mm = m + j;
            if (init[j]) { const bool smp = mm >= MP; const int t = smp ? (mm - MP) & 1023 : mm & 255, L = smp ? SEQS : SEQP; const int lo = max(t - h, 0), hi = min(t + h, L);
#pragma unroll
                for (int e = 0; e < 8; ++e) S[e] = 0.f;
                for (int tt = lo; tt < hi; ++tt) { float w[8]; ld8(Z + (size_t)(mm + tt - t) * 1024 + c, w);
#pragma unroll
                    for (int e = 0; e < 8; ++e) S[e] += w[e]; } }
            else {
#pragma unroll
                for (int e = 0; e < 8; ++e) S[e] += za[j][e] - zr[j][e]; }
            const float inv = 1.0f / (float)cnt[j];
            float o[8];
#pragma unroll
            for (int e = 0; e < 8; ++e) o[e] = (S[e] * inv - own[j][e]) * ps[e] * gt[j][e];
            u32x4 w; w.x = pk2(o[0], o[1]); w.y = pk2(o[2], o[3]); w.z = pk2(o[4], o[5]); w.w = pk2(o[6], o[7]);
            *(u32x4*)(Y + (size_t)mm * DM + 1024 + c) = w; }
        first = false; m += 4;
    }
}
namespace att {
#define GATE(x) (SILU ? siluf(x) : (x))
using bf16x8 = __attribute__((ext_vector_type(8))) short;
using s16x4  = __attribute__((ext_vector_type(4))) short;
using f32x16 = __attribute__((ext_vector_type(16))) float;
constexpr int QBLK = 32, KVBLK = 64, LDK = 128;
constexpr int SHM_V = KVBLK * 128 * 2, SHM_K = KVBLK * 128 * 2;
constexpr int WS_OFF = 2 * SHM_V + 2 * SHM_K;
constexpr int STG_OFF = 72 * 1024;
constexpr float THRL = 8.f * LOG2E;
#define KSWZ(row, colB) ((row) * 256 + ((colB) ^ (((row) & 7) << 4)))
#define SBAR() __builtin_amdgcn_sched_barrier(0)
__device__ __forceinline__ int crow(int r, int hi) { return (r & 3) + 8 * (r >> 2) + 4 * hi; }
__device__ __forceinline__ unsigned cvtpk(float lo, float hi) { unsigned r; asm volatile("v_cvt_pk_bf16_f32 %0, %1, %2" : "=v"(r) : "v"(lo), "v"(hi)); return r; }
constexpr float SOFT_OFF = 0.f;
__device__ __forceinline__ void partialSM(f32x16& p0, f32x16& p1, float& m_reg, float& mn, float& alpha) {
  alpha = 1.f;
  for (int r = 0; r < 16; ++r) p0[r] = __builtin_amdgcn_exp2f(p0[r]);
}
__device__ __forceinline__ void finishSM(f32x16& p0, f32x16& p1, float alpha, float& l_reg, bf16x8& pa0, bf16x8& pa1, bf16x8& pa2, bf16x8& pa3) {
  for (int r = 0; r < 16; ++r) p1[r] = __builtin_amdgcn_exp2f(p1[r]);
  float ps = 0; for (int r = 0; r < 16; ++r) ps += p0[r]; for (int r = 0; r < 16; ++r) ps += p1[r];
  { auto rr = __builtin_amdgcn_permlane32_swap(__float_as_uint(ps), __float_as_uint(ps), false, false);
    ps = __uint_as_float(rr[0]) + __uint_as_float(rr[1]); }
  l_reg = l_reg * alpha + ps;
#define PK4(P, BASE, OUT) do { unsigned a0 = cvtpk(P[BASE + 0], P[BASE + 1]), a1 = cvtpk(P[BASE + 2], P[BASE + 3]);   \
    unsigned b0 = cvtpk(P[BASE + 4], P[BASE + 5]), b1 = cvtpk(P[BASE + 6], P[BASE + 7]);                              \
    auto r0 = __builtin_amdgcn_permlane32_swap(a0, b0, false, false); auto r1 = __builtin_amdgcn_permlane32_swap(a1, b1, false, false); \
    u32x4 w = {r0[0], r1[0], r0[1], r1[1]}; OUT = *reinterpret_cast<bf16x8*>(&w); } while (0)
  PK4(p0, 0, pa0); PK4(p0, 8, pa1); PK4(p1, 0, pa2); PK4(p1, 8, pa3);
#undef PK4
}
template <int ND0> __device__ __forceinline__ void qkt(f32x16& p0, f32x16& p1, const char* Ks, const bf16x8* qr, int r32, int hi, int kcol0, const f32x16& cinit) {
#pragma unroll
  for (int d0 = 0; d0 < ND0; ++d0) { int cb = (kcol0 + d0 * 16 + hi * 8) * 2;
    bf16x8 b0 = *reinterpret_cast<const bf16x8*>(Ks + KSWZ(r32, cb));
    bf16x8 b1 = *reinterpret_cast<const bf16x8*>(Ks + KSWZ(32 + r32, cb));
    if (d0 == 0) { p0 = __builtin_amdgcn_mfma_f32_32x32x16_bf16(b0, qr[d0], cinit, 0, 0, 0); p1 = __builtin_amdgcn_mfma_f32_32x32x16_bf16(b1, qr[d0], cinit, 0, 0, 0); }
    else { p0 = __builtin_amdgcn_mfma_f32_32x32x16_bf16(b0, qr[d0], p0, 0, 0, 0); p1 = __builtin_amdgcn_mfma_f32_32x32x16_bf16(b1, qr[d0], p1, 0, 0, 0); } }
}
__device__ __forceinline__ int v_st(int k, int c) { const int kk = (k & ~0xC) | ((k & 4) << 1) | ((k & 8) >> 1); return ((kk >> 3) * 4 + (c >> 5)) * 512 + ((kk & 7) * 32 + (c & 31)) * 2; }
__device__ __forceinline__ int v_rd_base(int lane) { return ((lane & 3) << 3) | (((lane >> 2) & 3) << 6) | (((lane >> 4) & 1) << 5) | (((lane >> 5) & 1) << 8); }
constexpr int v_rd_off(int d0, int ks, int half) { return d0 * 512 + ks * 4096 + half * 2048; }
template <int OFF> __device__ __forceinline__ s16x4 tr_read(int vb) {
  s16x4 r; asm volatile("ds_read_b64_tr_b16 %0, %1 offset:%2" : "=&v"(r) : "v"(vb), "i"(OFF) : "memory"); return r;
}
template <int D0> __device__ __forceinline__ void pv_one(f32x16& od, int vb, bf16x8 pa0, bf16x8 pa1, bf16x8 pa2, bf16x8 pa3) {
  const s16x4 l0 = tr_read<v_rd_off(D0, 0, 0)>(vb), h0 = tr_read<v_rd_off(D0, 0, 1)>(vb), l1 = tr_read<v_rd_off(D0, 1, 0)>(vb), h1 = tr_read<v_rd_off(D0, 1, 1)>(vb);
  const s16x4 l2 = tr_read<v_rd_off(D0, 2, 0)>(vb), h2 = tr_read<v_rd_off(D0, 2, 1)>(vb), l3 = tr_read<v_rd_off(D0, 3, 0)>(vb), h3 = tr_read<v_rd_off(D0, 3, 1)>(vb);
  asm volatile("s_waitcnt lgkmcnt(0)" ::: "memory"); SBAR();
#define PK(L, H) (bf16x8){L[0], L[1], L[2], L[3], H[0], H[1], H[2], H[3]}
  od = __builtin_amdgcn_mfma_f32_32x32x16_bf16(pa0, PK(l0, h0), od, 0, 0, 0);
  od = __builtin_amdgcn_mfma_f32_32x32x16_bf16(pa1, PK(l1, h1), od, 0, 0, 0);
  od = __builtin_amdgcn_mfma_f32_32x32x16_bf16(pa2, PK(l2, h2), od, 0, 0, 0);
  od = __builtin_amdgcn_mfma_f32_32x32x16_bf16(pa3, PK(l3, h3), od, 0, 0, 0);
#undef PK
}
__device__ __forceinline__ void pv_d0(f32x16* o, int vb, bf16x8 pa0, bf16x8 pa1, bf16x8 pa2, bf16x8 pa3) {
  pv_one<0>(o[0], vb, pa0, pa1, pa2, pa3); pv_one<1>(o[1], vb, pa0, pa1, pa2, pa3); pv_one<2>(o[2], vb, pa0, pa1, pa2, pa3); pv_one<3>(o[3], vb, pa0, pa1, pa2, pa3);
}
template <int ND0>
__device__ __forceinline__ void attn_core(const bf16_t* Qw, const bf16_t* __restrict__ Kh, const bf16_t* __restrict__ Vh, int seq, int kcol0, char* lds, f32x16 (&o)[4], float& l_reg, const int wid, const int lane) {
  const int tid = wid * 64 + lane, r32 = lane & 31, hi = lane >> 5;
  char* V_lds = lds; char* K_lds = lds + 2 * SHM_V;
  float* ws = (float*)(lds + WS_OFF) + wid * 64; float* al_l = ws + 32;
  float m_reg = -1e30f; l_reg = 0; bf16x8 qr[ND0];
  f32x16 cinit; for (int r = 0; r < 16; ++r) cinit[r] = -SOFT_OFF;
#pragma unroll
  for (int d = 0; d < 4; ++d) o[d] = f32x16{};
#pragma unroll
  for (int d0 = 0; d0 < ND0; ++d0) qr[d0] = __builtin_nontemporal_load(reinterpret_cast<const bf16x8*>(Qw + d0 * 16));
  const int sr = tid >> 4, sc = (tid & 15) * 8, vst0 = v_st(sr, sc), vst1 = v_st(32 + sr, sc);
  const int vb0 = (int)(uintptr_t)V_lds + v_rd_base(lane);
  struct { bf16x8 vs0, vs1, ks0, ks1; } sr_[1];
#define SLOAD(i, k0) do { sr_[i].vs0 = *reinterpret_cast<const bf16x8*>(&Vh[(long)((k0) + sr) * LDK + sc]); sr_[i].vs1 = *reinterpret_cast<const bf16x8*>(&Vh[(long)((k0) + 32 + sr) * LDK + sc]); \
    sr_[i].ks0 = *reinterpret_cast<const bf16x8*>(&Kh[(long)((k0) + sr) * LDK + sc]); sr_[i].ks1 = *reinterpret_cast<const bf16x8*>(&Kh[(long)((k0) + 32 + sr) * LDK + sc]); } while (0)
#define SWRITE(b, i) do { *(bf16x8*)(V_lds + (b) * SHM_V + vst0) = sr_[i].vs0;          \
    *(bf16x8*)(V_lds + (b) * SHM_V + vst1) = sr_[i].vs1; int kc = sc * 2;               \
    *(bf16x8*)(K_lds + (b) * SHM_K + KSWZ(sr, kc)) = sr_[i].ks0;                       \
    *(bf16x8*)(K_lds + (b) * SHM_K + KSWZ(32 + sr, kc)) = sr_[i].ks1; } while (0)
#define SWAIT() asm volatile("s_waitcnt vmcnt(0)" ::: "memory")
#define RESC(a) do { if (__any((a) < 1.f)) { if (hi == 0) al_l[r32] = (a); asm volatile("s_waitcnt lgkmcnt(0)" ::: "memory"); \
    for (int d = 0; d < 4; ++d) for (int r = 0; r < 16; ++r) o[d][r] *= al_l[crow(r, hi)]; } } while (0)
  f32x16 pA0, pA1, pB0, pB1; float mnA, mnB, alA, alB; bf16x8 pa0, pa1, pa2, pa3; const int NT = seq / KVBLK;
  SLOAD(0, 0); asm volatile("s_waitcnt vmcnt(0)" ::: "memory"); SWRITE(0, 0); __syncthreads();
  qkt<ND0>(pA0, pA1, K_lds, qr, r32, hi, kcol0, cinit); partialSM(pA0, pA1, m_reg, mnA, alA);
  SLOAD(0, KVBLK);
  SWAIT(); SWRITE(1, 0); __syncthreads();
  for (int j = 1; j + 1 < NT; j += 2) {
    SBAR(); qkt<ND0>(pB0, pB1, K_lds + SHM_K, qr, r32, hi, kcol0, cinit);
    finishSM(pA0, pA1, alA, l_reg, pa0, pa1, pa2, pa3); SBAR();
    SLOAD(0, (j + 1) * KVBLK); SBAR();
    pv_d0(o, vb0, pa0, pa1, pa2, pa3); partialSM(pB0, pB1, m_reg, mnB, alB);
    __syncthreads(); SWAIT(); SWRITE(0, 0);
    RESC(alB); __syncthreads();
    SBAR(); qkt<ND0>(pA0, pA1, K_lds, qr, r32, hi, kcol0, cinit);
    finishSM(pB0, pB1, alB, l_reg, pa0, pa1, pa2, pa3); SBAR();
    SLOAD(0, (j + 2) * KVBLK); SBAR();
    pv_d0(o, vb0 + SHM_V, pa0, pa1, pa2, pa3); partialSM(pA0, pA1, m_reg, mnA, alA);
    __syncthreads(); SWAIT(); SWRITE(1, 0);
    RESC(alA); __syncthreads();
  }
  SBAR(); qkt<ND0>(pB0, pB1, K_lds + SHM_K, qr, r32, hi, kcol0, cinit);
  finishSM(pA0, pA1, alA, l_reg, pa0, pa1, pa2, pa3); SBAR();
  pv_d0(o, vb0, pa0, pa1, pa2, pa3); partialSM(pB0, pB1, m_reg, mnB, alB);
  __syncthreads(); RESC(alB);
  finishSM(pB0, pB1, alB, l_reg, pa0, pa1, pa2, pa3); SBAR();
  pv_d0(o, vb0 + SHM_V, pa0, pa1, pa2, pa3);
#undef SLOAD
#undef SWRITE
#undef SWAIT
#undef RESC
}
__device__ __forceinline__ void row_inv_l(float l_reg, char* lds, int wid, int r32, int hi, float (&rli)[16]) {
  float* li_l = (float*)(lds + WS_OFF) + wid * 64;
  if (hi == 0) li_l[r32] = l_reg; asm volatile("s_waitcnt lgkmcnt(0)" ::: "memory");
#pragma unroll
  for (int r = 0; r < 16; ++r) rli[r] = __builtin_amdgcn_rcpf(li_l[crow(r, hi)]);
}
template <bool SILU> __device__ __forceinline__ void store_rows_gated(const f32x16 (&v)[4], char* stg, bf16_t* Yrow0  , const bf16_t* Grow0, int gpitch, int lane, int r32, int hi) {
  bf16_t* st = (bf16_t*)stg;
#pragma unroll
  for (int r = 0; r < 16; ++r) { const int orow = crow(r, hi);
#pragma unroll
    for (int d0 = 0; d0 < 4; ++d0) st[orow * 128 + d0 * 32 + r32] = (bf16_t)f2bf(v[d0][r]); }
  asm volatile("s_waitcnt lgkmcnt(0)" ::: "memory");
  const bf16_t* gp = Grow0 + (size_t)(lane >> 4) * gpitch + (lane & 15) * 8; bf16_t* yp = Yrow0 + (size_t)(lane >> 4) * DM + (lane & 15) * 8; const bf16_t* sp = st + (lane >> 4) * 128 + (lane & 15) * 8;
  u32x4 g[8];
#pragma unroll
  for (int i = 0; i < 8; ++i) { g[i] = __builtin_nontemporal_load((const u32x4*)gp); gp += 4 * (size_t)gpitch; asm volatile("" : "+v"(gp)); }
#pragma unroll
  for (int i = 0; i < 8; ++i) {
    const u32x4 x = *(const u32x4*)(sp + i * 4 * 128);
    u32x4 w; w.x = pk2(bflo(x.x) * GATE(bflo(g[i].x)), bfhi(x.x) * GATE(bfhi(g[i].x))); w.y = pk2(bflo(x.y) * GATE(bflo(g[i].y)), bfhi(x.y) * GATE(bfhi(g[i].y)));
    w.z = pk2(bflo(x.z) * GATE(bflo(g[i].z)), bfhi(x.z) * GATE(bfhi(g[i].z))); w.w = pk2(bflo(x.w) * GATE(bflo(g[i].w)), bfhi(x.w) * GATE(bfhi(g[i].w)));
    *(u32x4*)yp = w; yp += 4 * DM; asm volatile("" : "+v"(yp)); }
  asm volatile("s_waitcnt lgkmcnt(0)" ::: "memory");
}
__device__ __forceinline__ void gqa_unit(const Params& p, char* lds, int m0, int hq, const bf16_t* Kh, const bf16_t* Vh, int seq, const int wid) {
  const int lane = fresh_lane(), r32 = lane & 31, hi = lane >> 5;
  const bf16_t* QC = (const bf16_t*)(p.ws + WS_Q); const bf16_t* PR = (const bf16_t*)(p.ws + WS_PR); bf16_t* Y = (bf16_t*)(p.ws + WS_HY);
  f32x16 o[4]; float l_reg;
  attn_core<8>(QC + (size_t)(m0 + wid * QBLK + r32) * DM + hq * 128 + hi * 8, Kh, Vh, seq, 0, lds, o, l_reg, wid, lane);
  float rli[16]; row_inv_l(l_reg, lds, wid, r32, hi, rli);
#pragma unroll
  for (int d0 = 0; d0 < 4; ++d0)
#pragma unroll
    for (int r = 0; r < 16; ++r) o[d0][r] *= rli[r];
  __syncthreads();
  const size_t row0 = (size_t)(m0 + wid * QBLK);
  store_rows_gated<false>(o, lds + wid * 8192, Y + row0 * DM + hq * 128, (const bf16_t*)(p.ws + WS_SG) + row0 * DM + hq * 128, DM, lane, r32, hi);
  __syncthreads();
}
constexpr int RES_WS = 131072 + 1024, RES_EX = 131072 + 4096;
__device__ __forceinline__ void load_kv_resident(const bf16_t* __restrict__ Kh, const bf16_t* __restrict__ Vh, char* lds, int tid) {
  bf16x8 kr[8], vr[8];
#pragma unroll
  for (int i = 0; i < 8; ++i) { const int c = tid + 512 * i; kr[i] = __builtin_nontemporal_load(reinterpret_cast<const bf16x8*>(Kh + (size_t)c * 8)); vr[i] = __builtin_nontemporal_load(reinterpret_cast<const bf16x8*>(Vh + (size_t)c * 8)); }
#pragma unroll
  for (int i = 0; i < 8; ++i) { const int c = tid + 512 * i, key = c >> 4, col = (c & 15) * 8, t = key >> 6, k = key & 63;
    *(bf16x8*)(lds + 65536 + t * 16384 + v_st(k, col)) = vr[i];
    *(bf16x8*)(lds + t * 16384 + KSWZ(k, col * 2)) = kr[i]; }
}
template <int ND0>
__device__ __forceinline__ void attn_core_res(const bf16_t* Qw, int kcol0, char* lds, f32x16 (&o)[4], float& l_reg, const int wid, const int lane) {
  const int r32 = lane & 31, hi = lane >> 5;
  const char* K_lds = lds; float* al_l = (float*)(lds + RES_WS) + wid * 64 + 32;
  float m_reg = -1e30f; l_reg = 0; bf16x8 qr[ND0];
  f32x16 cinit; for (int r = 0; r < 16; ++r) cinit[r] = -SOFT_OFF;
#pragma unroll
  for (int d = 0; d < 4; ++d) o[d] = f32x16{};
#pragma unroll
  for (int d0 = 0; d0 < ND0; ++d0) qr[d0] = __builtin_nontemporal_load(reinterpret_cast<const bf16x8*>(Qw + d0 * 16));
  const int vb0 = (int)(uintptr_t)(lds + 65536) + v_rd_base(lane);
#define RESC(a) do { if (__any((a) < 1.f)) { if (hi == 0) al_l[r32] = (a); asm volatile("s_waitcnt lgkmcnt(0)" ::: "memory"); \
    for (int d = 0; d < 4; ++d) for (int r = 0; r < 16; ++r) o[d][r] *= al_l[crow(r, hi)]; } } while (0)
  f32x16 pA0, pA1, pB0, pB1; float mnA, mnB, alA, alB; bf16x8 pa0, pa1, pa2, pa3;
  qkt<ND0>(pA0, pA1, K_lds, qr, r32, hi, kcol0, cinit); partialSM(pA0, pA1, m_reg, mnA, alA);
  SBAR(); qkt<ND0>(pB0, pB1, K_lds + 16384, qr, r32, hi, kcol0, cinit);
  finishSM(pA0, pA1, alA, l_reg, pa0, pa1, pa2, pa3); SBAR();
  pv_d0(o, vb0, pa0, pa1, pa2, pa3); partialSM(pB0, pB1, m_reg, mnB, alB); RESC(alB);
  SBAR(); qkt<ND0>(pA0, pA1, K_lds + 2 * 16384, qr, r32, hi, kcol0, cinit);
  finishSM(pB0, pB1, alB, l_reg, pa0, pa1, pa2, pa3); SBAR();
  pv_d0(o, vb0 + 16384, pa0, pa1, pa2, pa3); partialSM(pA0, pA1, m_reg, mnA, alA); RESC(alA);
  SBAR(); qkt<ND0>(pB0, pB1, K_lds + 3 * 16384, qr, r32, hi, kcol0, cinit);
  finishSM(pA0, pA1, alA, l_reg, pa0, pa1, pa2, pa3); SBAR();
  pv_d0(o, vb0 + 2 * 16384, pa0, pa1, pa2, pa3); partialSM(pB0, pB1, m_reg, mnB, alB); RESC(alB);
  finishSM(pB0, pB1, alB, l_reg, pa0, pa1, pa2, pa3); SBAR();
  pv_d0(o, vb0 + 3 * 16384, pa0, pa1, pa2, pa3);
#undef RESC
}
__device__ __forceinline__ void row_inv_l_res(float l_reg, char* lds, int wid, int r32, int hi, float (&rli)[16]) {
  float* li_l = (float*)(lds + RES_WS) + wid * 64;
  if (hi == 0) li_l[r32] = l_reg; asm volatile("s_waitcnt lgkmcnt(0)" ::: "memory");
#pragma unroll
  for (int r = 0; r < 16; ++r) rli[r] = __builtin_amdgcn_rcpf(li_l[crow(r, hi)]);
}
template <bool SILU> __device__ __forceinline__ void store_direct_gated(const f32x16 (&v)[4], char* stg  , bf16_t* Y0  , const bf16_t* G0, int gpitch, int lane, int r32, int hi) {
  bf16_t* st = (bf16_t*)stg;
  const bf16_t* gp = G0 + (size_t)(lane >> 4) * gpitch + (lane & 15) * 8; bf16_t* yp = Y0 + (size_t)(lane >> 4) * DM + (lane & 15) * 8; const bf16_t* sp = st + (lane >> 4) * 128 + (lane & 15) * 8;
  u32x4 g[8];
#pragma unroll
  for (int i = 0; i < 8; ++i) { g[i] = __builtin_nontemporal_load((const u32x4*)gp); gp += 4 * (size_t)gpitch; asm volatile("" : "+v"(gp)); }
#pragma unroll
  for (int j = 0; j < 4; ++j) {
#pragma unroll
    for (int rr = 0; rr < 4; ++rr)
#pragma unroll
      for (int d0 = 0; d0 < 4; ++d0) st[(rr + 4 * hi) * 128 + d0 * 32 + r32] = (bf16_t)f2bf(v[d0][4 * j + rr]);
    asm volatile("s_waitcnt lgkmcnt(0)" ::: "memory");
#pragma unroll
    for (int i = 0; i < 2; ++i) {
      const u32x4 x = *(const u32x4*)(sp + i * 4 * 128); const u32x4 gg = g[2 * j + i];
      u32x4 w; w.x = pk2(bflo(x.x) * GATE(bflo(gg.x)), bfhi(x.x) * GATE(bfhi(gg.x))); w.y = pk2(bflo(x.y) * GATE(bflo(gg.y)), bfhi(x.y) * GATE(bfhi(gg.y)));
      w.z = pk2(bflo(x.z) * GATE(bflo(gg.z)), bfhi(x.z) * GATE(bfhi(gg.z))); w.w = pk2(bflo(x.w) * GATE(bflo(gg.w)), bfhi(x.w) * GATE(bfhi(gg.w)));
      *(u32x4*)yp = w; yp += 4 * DM; asm volatile("" : "+v"(yp)); }
    asm volatile("s_waitcnt lgkmcnt(0)" ::: "memory");
  }
}
__device__ __forceinline__ void gqa_prompt_slot(const Params& p, char* lds, int bk, const int wid) {
  const int lane = fresh_lane(), r32 = lane & 31, hi = lane >> 5;
  const bf16_t* QC = (const bf16_t*)(p.ws + WS_Q); const bf16_t* PR = (const bf16_t*)(p.ws + WS_PR); bf16_t* Y = (bf16_t*)(p.ws + WS_HY);
  load_kv_resident((const bf16_t*)(p.ws + WS_KP) + (size_t)bk * SEQP * 128, (const bf16_t*)(p.ws + WS_VP) + (size_t)bk * SEQP * 128, lds, wid * 64 + lane);
  __syncthreads();
  const int m0 = (bk >> 2) * SEQP;
  for (int g = 0; g < 4; ++g) {
    const int lane = fresh_lane(), r32 = lane & 31, hi = lane >> 5;
    const int hq = (bk & 3) * 4 + g;
    f32x16 o[4]; float l_reg;
    const size_t row0 = (size_t)(m0 + wid * QBLK);
    attn_core_res<8>(QC + (row0 + r32) * DM + hq * 128 + hi * 8, 0, lds, o, l_reg, wid, lane);
    float rli[16]; row_inv_l_res(l_reg, lds, wid, r32, hi, rli);
#pragma unroll
    for (int d0 = 0; d0 < 4; ++d0)
#pragma unroll
      for (int r = 0; r < 16; ++r) o[d0][r] *= rli[r];
    store_direct_gated<false>(o, lds + RES_EX + wid * 2048, Y + row0 * DM + hq * 128, (const bf16_t*)(p.ws + WS_SG) + row0 * DM + hq * 128, DM, lane, r32, hi);
  }
  __syncthreads();
}
__device__ __forceinline__ void diff_prompt_slot(const Params& p, char* lds, int slot  , float lam, const int wid) {
  const bf16_t* QA = (const bf16_t*)(p.ws + WS_Q); bf16_t* Y = (bf16_t*)(p.ws + WS_HY);
  for (int hh = 0; hh < 2; ++hh) {
    const int lane = fresh_lane(), r32 = lane & 31, hi = lane >> 5;
    const int bh = slot * 2 + hh, h = bh & 7, b = bh >> 3;
    load_kv_resident((const bf16_t*)(p.ws + WS_KP) + (size_t)bh * SEQP * 128, (const bf16_t*)(p.ws + WS_VP) + (size_t)bh * SEQP * 128, lds, wid * 64 + lane);
    __syncthreads();
    const size_t row0 = (size_t)(b * SEQP + wid * QBLK);
    const bf16_t* Qw = QA + (row0 + r32) * 1024 + h * 128 + hi * 8;
    bf16x8 q1[4], q2[4];
#pragma unroll
    for (int d0 = 0; d0 < 4; ++d0) { q1[d0] = __builtin_nontemporal_load(reinterpret_cast<const bf16x8*>(Qw + d0 * 16)); q2[d0] = __builtin_nontemporal_load(reinterpret_cast<const bf16x8*>(Qw + 64 + d0 * 16)); }
    f32x16 o1[4], o2[4];
#pragma unroll
    for (int d = 0; d < 4; ++d) { o1[d] = f32x16{}; o2[d] = f32x16{}; }
    float m1 = -1e30f, m2 = -1e30f, l1 = 0.f, l2 = 0.f;
    float* al_l = (float*)(lds + RES_WS) + wid * 64 + 32;
    const int vb0 = (int)(uintptr_t)(lds + 65536) + v_rd_base(lane);
    f32x16 cz; for (int r = 0; r < 16; ++r) cz[r] = 0.f;
#define RESC2(o, a) do { if (__any((a) < 1.f)) { if (hi == 0) al_l[r32] = (a); asm volatile("s_waitcnt lgkmcnt(0)" ::: "memory"); \
    for (int d = 0; d < 4; ++d) for (int r = 0; r < 16; ++r) o[d][r] *= al_l[crow(r, hi)]; asm volatile("s_waitcnt lgkmcnt(0)" ::: "memory"); } } while (0)
#pragma unroll 1
    for (int t = 0; t < 4; ++t) {
      f32x16 p0, p1; float mn, al; bf16x8 pa0, pa1, pa2, pa3;
      qkt<4>(p0, p1, lds + t * 16384, q1, r32, hi, 0, cz); partialSM(p0, p1, m1, mn, al); finishSM(p0, p1, al, l1, pa0, pa1, pa2, pa3); RESC2(o1, al); SBAR();
      pv_d0(o1, vb0 + t * 16384, pa0, pa1, pa2, pa3); SBAR();
      qkt<4>(p0, p1, lds + t * 16384, q2, r32, hi, 64, cz); partialSM(p0, p1, m2, mn, al); finishSM(p0, p1, al, l2, pa0, pa1, pa2, pa3); RESC2(o2, al); SBAR();
      pv_d0(o2, vb0 + t * 16384, pa0, pa1, pa2, pa3); SBAR();
    }
#undef RESC2
    float ra[16], rb[16];
    row_inv_l_res(l1, lds, wid, r32, hi, ra);
    asm volatile("s_waitcnt lgkmcnt(0)" ::: "memory");
    row_inv_l_res(l2, lds, wid, r32, hi, rb);
    float ss[16];
#pragma unroll
    for (int r = 0; r < 16; ++r) { ss[r] = 0.f; rb[r] *= lam; }
#pragma unroll
    for (int d0 = 0; d0 < 4; ++d0)
#pragma unroll
      for (int r = 0; r < 16; ++r) { const float v = o1[d0][r] * ra[r] - o2[d0][r] * rb[r]; o1[d0][r] = v; ss[r] += v * v; }
#pragma unroll
    for (int r = 0; r < 16; ++r) {
#pragma unroll
      for (int of = 1; of < 32; of <<= 1) ss[r] += __shfl_xor(ss[r], of);
      ss[r] = 0.8f * __builtin_amdgcn_rsqf(ss[r] * (1.f / 128.f) + EPS); }
#pragma unroll
    for (int d0 = 0; d0 < 4; ++d0) { const float sw = p.subln_w[d0 * 32 + r32];
#pragma unroll
      for (int r = 0; r < 16; ++r) o1[d0][r] *= ss[r] * sw; }
    store_direct_gated<false>(o1, lds + RES_EX + wid * 2048, Y + row0 * DM + h * 128, (const bf16_t*)(p.ws + WS_SG) + row0 * DM + h * 128, DM, lane, r32, hi);
    __syncthreads();
  }
}
__device__ __forceinline__ void gqa_phase(const Params& p, char* lds, int vcu, int G, const int wid, const int mode) {
  for (int v = vcu; v < 256; v += G) {
    if (v < 128) { if (mode & 1) continue;
      const int qb = v & 3, g = (v >> 2) & 3, bk = v >> 4;
      gqa_unit(p, lds, MP + (bk >> 2) * SEQS + qb * 256, (bk & 3) * 4 + g, (const bf16_t*)(p.ws + WS_KSC) + (size_t)bk * LKS * 128, (const bf16_t*)(p.ws + WS_VSC) + (size_t)bk * LKS * 128, LKS, wid); }
    else { if (mode & 2) continue; gqa_prompt_slot(p, lds, v - 128, wid); }
  }
}
__device__ __forceinline__ void diff_unit(const Params& p, char* lds, int m0, int h, const bf16_t* Kh, const bf16_t* Vh, int seq, float lam, const int wid) {
  const int lane = fresh_lane(), r32 = lane & 31, hi = lane >> 5, rg = wid & 3, mp = wid >> 2;
  const bf16_t* QA = (const bf16_t*)(p.ws + WS_Q); const bf16_t* PR = (const bf16_t*)(p.ws + WS_PR); bf16_t* Y = (bf16_t*)(p.ws + WS_HY);
  f32x16 o[4]; float l_reg;
  attn_core<4>(QA + (size_t)(m0 + rg * QBLK + r32) * 1024 + h * 128 + mp * 64 + hi * 8, Kh, Vh, seq, mp * 64, lds, o, l_reg, wid, lane);
  float rli[16]; row_inv_l(l_reg, lds, wid, r32, hi, rli);
  __syncthreads();
  float* ex = (float*)lds + rg * 4096 + lane;
  if (mp == 1) {
#pragma unroll
    for (int d0 = 0; d0 < 4; ++d0)
#pragma unroll
      for (int r = 0; r < 16; ++r) ex[(d0 * 16 + r) * 64] = o[d0][r] * (rli[r] * lam);
  }
  __syncthreads();
  if (mp == 0) {
    float ss[16];
#pragma unroll
    for (int r = 0; r < 16; ++r) ss[r] = 0.f;
#pragma unroll
    for (int d0 = 0; d0 < 4; ++d0)
#pragma unroll
      for (int r = 0; r < 16; ++r) { const float v = o[d0][r] * rli[r] - ex[(d0 * 16 + r) * 64]; o[d0][r] = v; ss[r] += v * v; }
#pragma unroll
    for (int r = 0; r < 16; ++r) {
#pragma unroll
      for (int of = 1; of < 32; of <<= 1) ss[r] += __shfl_xor(ss[r], of);
      ss[r] = 0.8f / sqrtf(ss[r] * (1.f / 128.f) + EPS); }
#pragma unroll
    for (int d0 = 0; d0 < 4; ++d0) { const float sw = p.subln_w[d0 * 32 + r32];
#pragma unroll
      for (int r = 0; r < 16; ++r) o[d0][r] *= ss[r] * sw; }
    const size_t row0 = (size_t)(m0 + rg * QBLK);
    store_rows_gated<false>(o, lds + STG_OFF + rg * 8192, Y + row0 * DM + h * 128, (const bf16_t*)(p.ws + WS_SG) + row0 * DM + h * 128, DM, lane, r32, hi);
  }
  __syncthreads();
}
__device__ __forceinline__ void diff_phase(const Params& p, char* lds, int vcu, int G, const int wid, const int mode) {
  const int lane = fresh_lane();
  const float lam = expf(wave_sum(p.lam_q1[lane] * p.lam_k1[lane])) - expf(wave_sum(p.lam_q2[lane] * p.lam_k2[lane])) + 0.2f;
  for (int v = vcu; v < 256; v += G) {
    if (v < 128) { if (mode & 1) continue;
      const int qb = v & 7, bh = v >> 3;
      diff_unit(p, lds, MP + (bh >> 3) * SEQS + qb * 128, bh & 7, (const bf16_t*)(p.ws + WS_KSA) + (size_t)bh * LKS * 128, (const bf16_t*)(p.ws + WS_VSA) + (size_t)bh * LKS * 128, LKS, lam, wid);
      if (!(mode & 4)) pool_apply_slot(p, v * 80, 12, wid * 64 + fresh_lane()); }
    else { if (mode & 2) continue; diff_prompt_slot(p, lds, v - 128, lam, wid); if (!(mode & 4)) pool_apply_slot(p, (v - 128) * 80 + 48, 8, wid * 64 + fresh_lane()); }
  }
}
#undef KSWZ
#undef SBAR
}

constexpr int NWAVES = 8;
constexpr int RING_OFF = 0, RING_BYTES = 131072;
constexpr int LDSCTL_OFF = RING_BYTES, MISC_OFF = LDSCTL_OFF + 320;
constexpr int LDS_BYTES = 163840;
constexpr int RES_WS_OFF = RING_BYTES + 1024, RES_EX_OFF = RING_BYTES + 4096;
constexpr int CW_BAR = 4096;
#define GAS __attribute__((address_space(1)))
#define LAS __attribute__((address_space(3)))
typedef GAS unsigned gu32;
#define RLX_AGENT __ATOMIC_RELAXED, __HIP_MEMORY_SCOPE_AGENT
#define XB_TMO      128
#define XB_XCNT(j)  (256  + 64 * (j))
#define XB_XSUB(j)  (1280 + 64 * (j))
#define XB_XGEN(j)  (2304 + 64 * (j))
#define XB_TOP      3328
#define XB_TOPGEN   3392
#define XCD_BAR_WORDS 3456
#define XB_SPIN_CAP (1u << 18)
__device__ __forceinline__ unsigned xb_ld(unsigned* p)              { return __hip_atomic_load(p, __ATOMIC_RELAXED, __HIP_MEMORY_SCOPE_AGENT); }
__device__ __forceinline__ unsigned xb_add(unsigned* p, unsigned v) { return __hip_atomic_fetch_add(p, v, __ATOMIC_RELAXED, __HIP_MEMORY_SCOPE_AGENT); }
__device__ __forceinline__ unsigned xb_xcc_id() { return (unsigned)__builtin_amdgcn_s_getreg((3 << 11) | 20) & 0xFu; }
#define XB_SPIN(cond, bar) do { unsigned _sp = 0; while (cond) { __builtin_amdgcn_s_sleep(1); \
    if ((++_sp & 255u) == 0u) { if (xb_ld(&(bar)[XB_TMO])) break; if (_sp > XB_SPIN_CAP) { atomicAdd(&(bar)[XB_TMO], 1u); break; } } } } while (0)
struct XcdBarrier { unsigned* bar; unsigned x; volatile LAS unsigned* st; };
__device__ __forceinline__ XcdBarrier xcd_barrier_post(unsigned* bar, volatile LAS unsigned* st) {
    XcdBarrier b; b.bar = bar; b.x = xb_xcc_id(); b.st = st;
    if (threadIdx.x == 0) (void)xb_add(&bar[XB_XCNT(b.x)], 1u);
    return b;
}
__device__ __forceinline__ void xcd_barrier_complete(unsigned* bar, unsigned x, unsigned& nloc, unsigned& nx) {
    const unsigned G = gridDim.x * gridDim.y * gridDim.z;
    unsigned sum, cnt, mine, sp = 0u;
    for (;;) {
        sum = 0u; cnt = 0u; mine = 0u;
#pragma unroll
        for (unsigned j = 0; j < 16; ++j) { const unsigned c = xb_ld(&bar[XB_XCNT(j)]); sum += c; cnt += (c > 0u) ? 1u : 0u; mine = (j == x) ? c : mine; }
        if (sum == G) break;
        __builtin_amdgcn_s_sleep(1);
        if ((++sp & 255u) == 0u) { if (xb_ld(&bar[XB_TMO])) break; if (sp > XB_SPIN_CAP) { atomicAdd(&bar[XB_TMO], 1u); break; } }
    }
    nloc = mine > 0u ? mine : 1u; nx = cnt > 0u ? cnt : 1u;
}
__device__ __forceinline__ void xcd_barrier(const XcdBarrier& b, const int wave) {
    asm volatile("s_waitcnt vmcnt(0)" ::: "memory");
    __syncthreads();
    if (wave == 0 && fresh_lane() == 0) {
        unsigned* bar = b.bar;
        __builtin_amdgcn_s_waitcnt(0);
        unsigned nloc = b.st[0], nx = b.st[1];
        if (nloc == 0u) { xcd_barrier_complete(bar, b.x, nloc, nx); b.st[0] = nloc; b.st[1] = nx; }
        const unsigned old = xb_add(&bar[XB_XSUB(b.x)], 1u);
        const unsigned gen = old / nloc;
        if (old + 1u == (gen + 1u) * nloc) {
            __builtin_amdgcn_fence(__ATOMIC_RELEASE, "agent");
            asm volatile("s_waitcnt vmcnt(0)" ::: "memory");
            const unsigned og = xb_add(&bar[XB_TOP], 1u);
            const unsigned tg = og / nx;
            if (og + 1u == (tg + 1u) * nx) xb_add(&bar[XB_TOPGEN], 1u);
            else XB_SPIN(xb_ld(&bar[XB_TOPGEN]) == tg, bar);
            __builtin_amdgcn_fence(__ATOMIC_ACQUIRE, "agent");
            xb_add(&bar[XB_XGEN(b.x)], 1u);
            asm volatile("s_waitcnt vmcnt(0)" ::: "memory");
        } else {
            XB_SPIN(xb_ld(&bar[XB_XGEN(b.x)]) == gen, bar);
            __builtin_amdgcn_fence(__ATOMIC_ACQUIRE, "agent");
            asm volatile("s_waitcnt vmcnt(0)" ::: "memory");
        }
    }
    __syncthreads();
}

constexpr size_t WS_SLAB = WS_PR + 40 * MiB;
constexpr size_t CTL_TAIL = 256 * 1024;
template <int KIND> __device__ __forceinline__ void tail_reduce(const Params& p, const pg8::StaticOrder& S, int slot, int wave, int lane) {
    if (S.split <= 1) return;
    const int c = S.c, xcd = c % 8, q = c / 8, split = S.split, ks = q % split, j = (q / split) * 8 + xcd;
    pg8::Unit u; S.tile(S.nfull + j, u);
    unsigned* cnt = (unsigned*)(p.ws + WS_CTL + CTL_TAIL) + slot * 4096 + 64 * j;
    asm volatile("s_waitcnt vmcnt(0)" ::: "memory");
    __syncthreads();
    if (threadIdx.x == 0) {
        __builtin_amdgcn_fence(__ATOMIC_RELEASE, "agent");
        asm volatile("s_waitcnt vmcnt(0)" ::: "memory");
        __hip_atomic_fetch_add(cnt, 1u, __ATOMIC_RELAXED, __HIP_MEMORY_SCOPE_AGENT);
        unsigned sp = 0;
        while (__hip_atomic_load(cnt, __ATOMIC_RELAXED, __HIP_MEMORY_SCOPE_AGENT) < (unsigned)split) { __builtin_amdgcn_s_sleep(1); if (++sp > (1u << 22)) break; }
        __builtin_amdgcn_fence(__ATOMIC_ACQUIRE, "agent");
        asm volatile("s_waitcnt vmcnt(0)" ::: "memory");
    }
    __syncthreads();
    const int R = 256 / split, rpw = R / 8;
    const float* sb = (const float*)(p.ws + WS_SLAB) + (size_t)(j * split) * 65536 + 4 * lane;
    const int col = u.pn * 256 + 4 * lane;
    for (int i = 0; i < rpw; ++i) {
        const int rl = ks * R + wave * rpw + i, r = u.pm * 256 + rl, cr = cond_row(r);
        f32x4 sum = {0.f, 0.f, 0.f, 0.f};
        for (int sidx = 0; sidx < split; ++sidx) sum += *(const f32x4*)(sb + (size_t)sidx * 65536 + (size_t)rl * 256);
        if (KIND == 0) {
            const f32x4 x = *(const f32x4*)(xrow_ptr(p, r) + col), gt = *(const f32x4*)((const float*)(p.ws + WS_MOD) + 4096 + (size_t)cr * 6144 + col), cw = *(const f32x4*)((const float*)(p.ws + WS_CW1) + (size_t)cr * DM + col);
            const f32x4 y = x + gt * sum;
            *(f32x4*)(p.out + (size_t)r * DM + col) = y;
            const f32x4 h = y * cw; u32x2 o; o.x = pk2(h[0], h[1]); o.y = pk2(h[2], h[3]);
            *(u32x2*)((bf16_t*)(p.ws + WS_H1) + (size_t)r * DM + col) = o;
            const float ss = wave_sum((y[0] * y[0] + y[1] * y[1]) + (y[2] * y[2] + y[3] * y[3]));
            if (lane == 0) atomicAdd((float*)(p.ws + WS_RSS) + r, ss);
        } else if (KIND == 1) {
            const f32x4 gt = *(const f32x4*)((const float*)(p.ws + WS_MOD) + 3 * 6144 + 4096 + (size_t)cr * 6144 + col);
            float* op = p.out + (size_t)r * DM + col; *(f32x4*)op = *(const f32x4*)op + gt * sum;
        } else {
            const float rstd = 1.0f / sqrtf(((const float*)(p.ws + WS_RSS))[r] * (1.f / DM) + EPS);
            const f32x4 v = sum * rstd + *(const f32x4*)((const float*)(p.ws + WS_B2P) + (size_t)cr * ODD_IN + col);
            u32x2 o; o.x = pk2(siluf(v[0]), siluf(v[1])); o.y = pk2(siluf(v[2]), siluf(v[3]));
            *(u32x2*)((bf16_t*)(p.ws + WS_SG) + (size_t)r * DM + (col - 12 * 256)) = o;
        }
    }
}

struct MegaArgs { Params p; int ph_lo, ph_hi, mode, pad; };
constexpr int N_PHASES = 11;
#ifndef DUP_PHASE
#define DUP_PHASE -1
#endif
__device__ __forceinline__ Params load_params() {
#if defined(__HIP_DEVICE_COMPILE__)
    typedef __attribute__((address_space(4))) const unsigned long long* KPtr;
    KPtr a = (KPtr)__builtin_amdgcn_kernarg_segment_ptr();
    asm volatile("" : "+s"(a));
#define GPF(i) ((const float*)(__attribute__((address_space(1))) const float*)(a[i]))
    Params p;
    p.x_prompt = GPF(0); p.x_sample = GPF(1); p.cache_a_k = GPF(2); p.cache_a_v = GPF(3); p.cache_c_k = GPF(4); p.cache_c_v = GPF(5);
    p.c = GPF(6); p.c_ctx = GPF(7); p.norm_w = GPF(8); p.ada_w = GPF(9); p.ada_b = GPF(10);
    p.even_w_in = GPF(11); p.even_q_norm_w = GPF(12); p.even_k_norm_w = GPF(13); p.lam_q1 = GPF(14); p.lam_k1 = GPF(15); p.lam_q2 = GPF(16); p.lam_k2 = GPF(17);
    p.subln_w = GPF(18); p.pool_w = GPF(19); p.pool_scale = GPF(20); p.even_w_out = GPF(21);
    p.gqa_w_in = GPF(22); p.gqa_q_norm_w = GPF(23); p.gqa_k_norm_w = GPF(24); p.gqa_w_out = GPF(25);
    p.out = (float*)(__attribute__((address_space(1))) float*)(a[26]); p.ws = (unsigned char*)(__attribute__((address_space(1))) unsigned char*)(a[27]);
#undef GPF
    return p;
#else
    return Params{};
#endif
}
__global__ void __launch_bounds__(NWAVES * 64, 2) mega_fwd(MegaArgs args) {
    extern __shared__ __attribute__((aligned(16))) unsigned char lds[];
    LAS unsigned char* ldsl = (LAS unsigned char*)lds;
    volatile LAS unsigned* MISC = (volatile LAS unsigned*)(ldsl + MISC_OFF);
    const int wave = __builtin_amdgcn_readfirstlane(threadIdx.x >> 6);
    const int G = gridDim.x, bx = blockIdx.x;
    const int vcu = (G % 8 == 0) ? (bx % 8) * (G / 8) + bx / 8 : bx;
    for (int u = threadIdx.x; u < (LDS_BYTES - LDSCTL_OFF) / 4; u += NWAVES * 64) ((LAS unsigned*)(ldsl + LDSCTL_OFF))[u] = 0u;
    __syncthreads();
    XcdBarrier bar; { const Params p0 = load_params(); bar = xcd_barrier_post((unsigned*)(p0.ws + WS_CTL) + CW_BAR, MISC + 8); }
    const int lo = args.ph_lo, hi = args.ph_hi, mode = args.mode;
    const int gw = vcu * NWAVES + wave, ngw = G * NWAVES;
#define IN(k) (lo <= (k) && (k) < hi)
#define SEAM(k) do { if (IN(k) && (IN((k) + 1) || ((k) == 7 && IN(9)) || ((k) == 5 && IN(7)) || ((k) == 2 && IN(4)))) xcd_barrier(bar, wave); } while (0)
    if (IN(0)) {
        const Params p = load_params();
        float* scr = (float*)lds; const int lane = fresh_lane(), tid = wave * 64 + lane;
        if (G == 256 && bx >= 248) {
            unsigned long long pc; asm volatile("s_getpc_b64 %0" : "=s"(pc));
            const char* cb = (const char*)(pc & ~127ull) + lane * 128 + wave * (3 * 8192); unsigned acc_ = 0u;
#pragma unroll
            for (int i = 0; i < 3; ++i) acc_ ^= *(const volatile unsigned*)(cb + i * 8192);
            if (acc_ == 0x5a17c0deu) ((volatile unsigned*)(p.ws + WS_CTL))[8191] = acc_;
        }
        if (!(mode & 8)) mod_items(p, scr, bx, G, tid, NWAVES * 64, 0);
        __syncthreads();
        if (!(mode & 16)) weights_items(p, (float*)(lds + wave * 16384), gw, ngw, lane, 0);
    }
    SEAM(0);
    if (IN(1)) {
        const Params p = load_params(); unsigned char* const ws = p.ws;
        if (bx < 32) {
            pg8::Gemm g{(const bf16_t*)(ws + WS_POOLW), (const bf16_t*)(ws + WS_WU), 1024, DM, 256, 256, 1024, 0, 256, 0}; pg8::StaticOrder S; S.init(1024, DM, 256, G, bx, false);
            pg8::EpiBf16 E{(bf16_t*)(ws + WS_WINE) + (size_t)3072 * DM, DM, 0};
            pg8::gemm_phase<pg8::EpiBf16, pg8::StaticOrder, true, true>(ldsl + RING_OFF, g, S, E, wave * 64 + fresh_lane());
            if (G == 256) { const int ln = fresh_lane(), wv = bx * NWAVES + wave, vid = 224 * NWAVES + (wv >> 1), nv = 224 * NWAVES + 128, st = vid + (wv & 1) * nv;
                modulate_rows(p, 0, st, 2 * nv, ln);
                weights_items(p, (float*)(lds + wave * 16384), st, 2 * nv, ln, 1); }
        } else { const int ln = fresh_lane(), rk = bx - 32, nr = G - 32, g2 = rk * NWAVES + wave, n2 = (G == 256) ? 224 * NWAVES + 128 : nr * NWAVES;
            modulate_rows(p, 0, g2, n2, ln);
            weights_items(p, (float*)(lds + wave * 16384), g2, n2, ln, 1);
            __syncthreads();
            mod_items(p, (float*)lds, rk, nr, wave * 64 + ln, NWAVES * 64, 1);
            caches_rope_items(p, (long)rk * 512 + wave * 64 + ln, (long)nr * 512); }
    }
    SEAM(1);
    if (IN(2)) {
        const Params p = load_params(); unsigned char* const ws = p.ws;
        pg8::Gemm g{(const bf16_t*)(ws + WS_HY), (const bf16_t*)(ws + WS_WINE), MT, EVEN_IN, DM, DM, DM, 0, 0, 0}; pg8::StaticOrder S; S.init(MT, EVEN_IN, DM, G, bx, false);
        float* nak = p.out + (size_t)MT * DM;
        pg8::EpiProj0 E{ws, p.even_q_norm_w, p.even_k_norm_w, nak, nak + (size_t)NBP * HA * SEQP * 128};
        pg8::gemm_phase<pg8::EpiProj0, pg8::StaticOrder, true, true>(ldsl + RING_OFF, g, S, E, wave * 64 + fresh_lane());
        if (G == 256) { if (bx >= 192) { const Params p2 = load_params(); mod1_tables(p2, (bx - 192) * NWAVES + wave, 64 * NWAVES, fresh_lane()); } }
        else { const Params p2 = load_params(); mod1_tables(p2, gw, ngw, fresh_lane()); }
    }
    SEAM(2);
    if (IN(4)) { const Params p = load_params(); att::diff_phase(p, (char*)lds, vcu, G, wave, mode); }
    SEAM(4);
    constexpr size_t CTL_PANEL = 320 * 1024;
    const bool stagger = (G == 256) && IN(5) && IN(7);
    if (IN(5)) {
        for (int part = 0; part < (stagger ? 2 : 1); ++part) {
            const Params p = load_params(); unsigned char* const ws = p.ws;
            pg8::Gemm g{(const bf16_t*)(ws + WS_HY), (const bf16_t*)(ws + WS_WOUTE), MT, DM, DM, DM, DM, 0, 0, 0};
            pg8::EpiResid0 E{p.x_prompt, p.x_sample, (const float*)(ws + WS_MOD) + 4096, (const float*)(ws + WS_CW1), (bf16_t*)(ws + WS_Y1B), (bf16_t*)(ws + WS_H1), (float*)(ws + WS_RSS), (float*)(ws + WS_SLAB)};
            if (stagger) {
                if (part == 1 && bx >= 64) break;
                pg8::OutOrder S{bx, part};
                pg8::gemm_phase<pg8::EpiResid0, pg8::OutOrder, true, true>(ldsl + RING_OFF, g, S, E, wave * 64 + fresh_lane());
                if (part == 0) xcd_barrier(bar, wave);
                else {
                    asm volatile("s_waitcnt vmcnt(0)" ::: "memory"); __syncthreads();
                    if (wave == 0 && fresh_lane() == 0) { __builtin_amdgcn_fence(__ATOMIC_RELEASE, "agent"); asm volatile("s_waitcnt vmcnt(0)" ::: "memory");
                        __hip_atomic_fetch_add((unsigned*)(ws + WS_CTL + CTL_PANEL) + 64 * (bx / 8), 1u, __ATOMIC_RELAXED, __HIP_MEMORY_SCOPE_AGENT); }
                }
            } else {
                pg8::StaticOrder S; S.init(MT, DM, DM, G, bx, false);
                pg8::gemm_phase<pg8::EpiResid0, pg8::StaticOrder, true, true>(ldsl + RING_OFF, g, S, E, wave * 64 + fresh_lane());
            }
        }
    }
    if (!stagger) SEAM(5);
    if (IN(7)) {
        const Params p = load_params(); unsigned char* const ws = p.ws;
        pg8::Gemm g{(const bf16_t*)(ws + WS_H1), (const bf16_t*)(ws + WS_WINO), MT, ODD_IN, DM, DM, DM, 0, 0, 0};
        float* nck = p.out + (size_t)MT * DM + 2 * (size_t)NBP * HA * SEQP * 128;
        pg8::EpiProj1 E{ws, p.gqa_q_norm_w, p.gqa_k_norm_w, nck, nck + (size_t)NBP * KVH * SEQP * 128, (LAS float*)(ldsl + RES_EX_OFF), (float*)(ws + WS_SLAB)};
        if (stagger) { pg8::StaggerOrder S{bx, (const unsigned*)(ws + WS_CTL + CTL_PANEL), true, wave};
            pg8::gemm_phase<pg8::EpiProj1, pg8::StaggerOrder, true, true>(ldsl + RING_OFF, g, S, E, wave * 64 + fresh_lane()); }
        else { pg8::StaticOrder S; S.init(MT, ODD_IN, DM, G, bx, false);
            pg8::gemm_phase<pg8::EpiProj1, pg8::StaticOrder, true, true>(ldsl + RING_OFF, g, S, E, wave * 64 + fresh_lane()); }
    }
    SEAM(7);
    if (IN(9)) { const Params p = load_params(); att::gqa_phase(p, (char*)lds, vcu, G, wave, mode); }
    SEAM(9);
    if (IN(10)) {
        const Params p = load_params(); unsigned char* const ws = p.ws;
        pg8::Gemm g{(const bf16_t*)(ws + WS_HY), (const bf16_t*)(ws + WS_WOUTO), MT, DM, DM, DM, DM, 0, 0, 0};
        pg8::EpiResidF E{(const bf16_t*)(ws + WS_Y1B), (const float*)(ws + WS_MOD) + 3 * 6144 + 4096, p.out, (float*)(ws + WS_SLAB)};
        if (G == 256) { pg8::LastOrder S{bx}; pg8::gemm_phase<pg8::EpiResidF, pg8::LastOrder, true, true>(ldsl + RING_OFF, g, S, E, wave * 64 + fresh_lane()); }
        else { pg8::StaticOrder S; S.init(MT, DM, DM, G, bx, false); pg8::gemm_phase<pg8::EpiResidF, pg8::StaticOrder, true, true>(ldsl + RING_OFF, g, S, E, wave * 64 + fresh_lane()); }
    }
#undef IN
#undef SEAM
}

#ifndef MK_PER_PHASE
#define MK_PER_PHASE 0
#endif
extern "C" void kernel_launch(void* const* d_in, const int* in_sizes, int n_in, void* d_out, int out_size, void* d_ws, size_t ws_size, hipStream_t stream) {
    if (n_in != 26 || ws_size < WS_END || out_size != MT * DM + 2 * NBP * HA * SEQP * 128 + 2 * NBP * KVH * SEQP * 128) {
        fprintf(stderr, "kernel_launch: unexpected shapes n_in %d ws %zu out %d\n", n_in, ws_size, out_size); return; }
    static int ready = 0;
    if (!ready) {
        if (hipFuncSetAttribute((const void*)mega_fwd, hipFuncAttributeMaxDynamicSharedMemorySize, LDS_BYTES) != hipSuccess) { fprintf(stderr, "kernel_launch: hipFuncSetAttribute failed\n"); return; }
        ready = 1;
    }
    MegaArgs a{};
    const float** pin = (const float**)&a.p;
    for (int i = 0; i < 26; ++i) pin[i] = (const float*)d_in[i];
    a.p.out = (float*)d_out; a.p.ws = (unsigned char*)d_ws;
#ifdef EXTRA_PHASE
    (void)hipMemsetAsync((unsigned char*)d_ws + WS_CTL, 0, 2 * MiB, stream);
    a.ph_lo = EXTRA_PHASE; a.ph_hi = EXTRA_PHASE + 1; hipLaunchKernelGGL(mega_fwd, dim3(256), dim3(NWAVES * 64), LDS_BYTES, stream, a);
#endif
    (void)hipMemsetAsync((unsigned char*)d_ws + WS_CTL, 0, 2 * MiB, stream);
#if MK_PER_PHASE
    for (int ph = 0; ph < N_PHASES; ++ph) { a.ph_lo = ph; a.ph_hi = ph + 1; hipLaunchKernelGGL(mega_fwd, dim3(256), dim3(NWAVES * 64), LDS_BYTES, stream, a); }
#else
    a.ph_lo = 0; a.ph_hi = N_PHASES; hipLaunchKernelGGL(mega_fwd, dim3(256), dim3(NWAVES * 64), LDS_BYTES, stream, a);
#endif
#ifdef EXTRA_AFTER
    (void)hipMemsetAsync((unsigned char*)d_ws + WS_CTL, 0, 1 * MiB, stream);
    a.ph_lo = EXTRA_AFTER; a.ph_hi = EXTRA_AFTER + 1; a.mode = EXTRA_MODE; hipLaunchKernelGGL(mega_fwd, dim3(256), dim3(NWAVES * 64), LDS_BYTES, stream, a);
#endif
}
```
